# Optimizing an MI355X kernel written in HIP

```python
import math
import jax, jax.numpy as jnp
from jax import lax
import numpy as np

D_MODEL = 1024
BATCH = 1
SEQ = 16384
DEPTH = 1

N_META = 16
NORM_EPS = 1e-6

DA_HEADS = 8
DA_HEAD_DIM = 64
DA_V_DIM = 2 * DA_HEAD_DIM
DA_QK = DA_HEADS * 2 * DA_HEAD_DIM
DA_V = DA_HEADS * DA_V_DIM
Q_BLOCK = 128
ALIBI_SLOPES = tuple(2.0 ** (-8.0 * (h + 1) / DA_HEADS) for h in range(DA_HEADS))

DN_HEADS = 8
DN_HEAD_DIM = 128
DN_QK = DN_HEADS * DN_HEAD_DIM
DN_V = DN_HEADS * DN_HEAD_DIM
DN_CONV = 4
DN_CHUNK = 64

N_GROUPS = 4
EXPERTS_PER_GROUP = 8
N_EXPERTS = N_GROUPS * EXPERTS_PER_GROUP
D_EXPERT = 256
TOP_K = 2

IN_SIZES = (DA_QK, DA_QK, DA_V, DN_QK, DN_QK, DN_V, DN_V, DN_HEADS, DN_HEADS, D_MODEL, D_MODEL)
IN_OFFSETS = tuple(int(s) for s in np.cumsum(IN_SIZES)[:-1])
W_IN_COLS = int(sum(IN_SIZES))

kernel_name = "hybrid_diffattn_gdn_hmoe_block"

F32 = jnp.float32


def rms_norm(x, w):
    xf = x.astype(F32)
    y = xf * lax.rsqrt(jnp.mean(xf * xf, axis=-1, keepdims=True) + NORM_EPS)
    return (y * w.astype(F32)).astype(x.dtype)


def l2_normalize(x):
    return x * lax.rsqrt(jnp.sum(x * x, axis=-1, keepdims=True) + 1e-6)


def differential_attention(q, k, v, lq1, lk1, lq2, lk2, subln_w, lambda_init):
    B, L, _ = q.shape
    n_blk = -(-L // Q_BLOCK)
    Lp = n_blk * Q_BLOCK
    pad = ((0, 0), (0, Lp - L), (0, 0))
    qb = jnp.pad(q, pad).reshape(B, n_blk, Q_BLOCK, DA_HEADS, 2, DA_HEAD_DIM)
    qb = jnp.moveaxis(qb, 1, 0)
    kk = jnp.pad(k, pad).reshape(B, Lp, DA_HEADS, 2, DA_HEAD_DIM)
    vv = jnp.pad(v, pad).reshape(B, Lp, DA_HEADS, DA_V_DIM)
    lam = (jnp.exp(jnp.sum(lq1.astype(F32) * lk1.astype(F32)))
           - jnp.exp(jnp.sum(lq2.astype(F32) * lk2.astype(F32))) + lambda_init)
    slopes = jnp.asarray(ALIBI_SLOPES, dtype=F32)[:, None, None]
    k_pos = jnp.arange(Lp, dtype=jnp.int32)
    scale = DA_HEAD_DIM ** -0.5

    def attend_block(args):
        q_blk, start = args
        q_pos = start + jnp.arange(Q_BLOCK, dtype=jnp.int32)
        dist = (q_pos[:, None] - k_pos[None, :]).astype(F32)
        bias = jnp.where(dist >= 0, -slopes * dist, -jnp.inf)
        s = jnp.einsum('bqhmd,bkhmd->bhmqk', q_blk, kk, preferred_element_type=F32) * scale
        p = jax.nn.softmax(s + bias[None, :, None], axis=-1)
        w = p[:, :, 0] - lam * p[:, :, 1]
        return jnp.einsum('bhqk,bkhe->bqhe', w.astype(vv.dtype), vv, preferred_element_type=F32)

    starts = jnp.arange(n_blk, dtype=jnp.int32) * Q_BLOCK
    o = lax.map(attend_block, (qb, starts))
    o = jnp.moveaxis(o, 0, 1).reshape(B, Lp, DA_HEADS, DA_V_DIM)[:, :L]
    o = rms_norm(o, subln_w) * (1.0 - lambda_init)
    return o.reshape(B, L, DA_V).astype(v.dtype)


def chunk_gated_delta_rule(q, k, v, beta, g):
    B, Lc, H, _ = q.shape
    dv = v.shape[-1]
    C = DN_CHUNK
    N = Lc // C

    def to_chunks(t):
        return jnp.moveaxis(t.reshape((B, N, C, H) + t.shape[3:]), 3, 1)

    q, k, v, beta, g = (to_chunks(t) for t in (q, k, v, beta, g))
    gc = jnp.cumsum(g, axis=-1)
    incl = jnp.tril(jnp.ones((C, C), dtype=bool))
    strict = jnp.tril(jnp.ones((C, C), dtype=bool), -1)
    diff = gc[..., :, None] - gc[..., None, :]
    decay = jnp.where(incl, jnp.exp(jnp.where(incl, diff, 0.0)), 0.0)
    kb = k * beta[..., None]
    A = jnp.where(strict, jnp.einsum('bhnid,bhnjd->bhnij', kb, k) * decay, 0.0)
    eye = jnp.eye(C, dtype=F32)
    T = lax.linalg.triangular_solve(A + eye, jnp.broadcast_to(eye, A.shape),
                                    left_side=True, lower=True, unit_diagonal=True)
    u = jnp.einsum('bhnij,bhnje->bhnie', T, v * beta[..., None])
    w = jnp.einsum('bhnij,bhnjd->bhnid', T, kb * jnp.exp(gc)[..., None])
    qk = jnp.einsum('bhnid,bhnjd->bhnij', q, k) * decay
    q_dec = q * jnp.exp(gc)[..., None]
    k_dec = k * jnp.exp(gc[..., -1:] - gc)[..., None]
    g_tot = jnp.exp(gc[..., -1])
    xs = tuple(jnp.moveaxis(t, 2, 0) for t in (u, w, q_dec, k_dec, qk, g_tot))

    def step(S, inp):
        u_n, w_n, qd_n, kd_n, qk_n, gt_n = inp
        v_new = u_n - jnp.einsum('bhcd,bhde->bhce', w_n, S)
        o_n = jnp.einsum('bhcd,bhde->bhce', qd_n, S) + jnp.einsum('bhij,bhje->bhie', qk_n, v_new)
        S = S * gt_n[..., None, None] + jnp.einsum('bhcd,bhce->bhde', kd_n, v_new)
        return S, o_n

    S0 = jnp.zeros((B, H, q.shape[-1], dv), dtype=F32)
    _, o = lax.scan(step, S0, xs)
    o = jnp.moveaxis(o, 0, 2)
    return jnp.moveaxis(o, 1, 3).reshape(B, Lc, H, dv)


def gated_deltanet(q, k, v, gate, beta_logit, a_logit, conv_w, A_log, dt_bias, norm_w):
    B, L, _ = q.shape
    qkv = jnp.concatenate([q, k, v], axis=-1)
    ch = qkv.shape[-1]
    qkv = lax.conv_general_dilated(qkv, conv_w[:, None, :].astype(qkv.dtype), (1,), [(DN_CONV - 1, 0)],
                                   dimension_numbers=('NWC', 'WIO', 'NWC'), feature_group_count=ch)
    qkv = jax.nn.silu(qkv.astype(F32))
    qc, kc, vc = jnp.split(qkv, [DN_QK, 2 * DN_QK], axis=-1)
    qc = l2_normalize(qc.reshape(B, L, DN_HEADS, DN_HEAD_DIM)) * (DN_HEAD_DIM ** -0.5)
    kc = l2_normalize(kc.reshape(B, L, DN_HEADS, DN_HEAD_DIM))
    vc = vc.reshape(B, L, DN_HEADS, DN_HEAD_DIM)
    beta = jax.nn.sigmoid(beta_logit.astype(F32))
    g = -jnp.exp(A_log.astype(F32)) * jax.nn.softplus(a_logit.astype(F32) + dt_bias.astype(F32))
    front = (-N_META) % DN_CHUNK
    total = front + L
    back = (-total) % DN_CHUNK

    def pad(t):
        return jnp.pad(t, ((0, 0), (front, back)) + ((0, 0),) * (t.ndim - 2))

    o = chunk_gated_delta_rule(pad(qc), pad(kc), pad(vc), pad(beta), pad(g))[:, front:front + L]
    o = rms_norm(o, norm_w) * jax.nn.silu(gate.astype(F32).reshape(B, L, DN_HEADS, DN_HEAD_DIM))
    return o.reshape(B, L, DN_V).astype(gate.dtype)


def hierarchical_moe(x, wg_r, bg_r, we_r, be_r, w_gate, w_up, w_down):
    B, L, D = x.shape
    xt = x.reshape(B * L, D)
    g_prob = jax.nn.softmax((xt @ wg_r).astype(F32) + bg_r.astype(F32), axis=-1)
    g_w, g_i = lax.top_k(g_prob, 1)
    e_logit = ((xt @ we_r).astype(F32) + be_r.astype(F32)).reshape(-1, N_GROUPS, EXPERTS_PER_GROUP)
    e_logit = jnp.einsum('tg,tge->te', jax.nn.one_hot(g_i[:, 0], N_GROUPS, dtype=F32), e_logit)
    e_prob = jax.nn.softmax(e_logit, axis=-1)
    e_w, e_i = lax.top_k(e_prob, TOP_K)
    e_w = e_w / jnp.sum(e_w, axis=-1, keepdims=True)
    weights = g_w * e_w
    expert_ids = g_i * EXPERTS_PER_GROUP + e_i
    combine = jnp.sum(jax.nn.one_hot(expert_ids, N_EXPERTS, dtype=F32) * weights[..., None], axis=1)
    y = jnp.zeros((B * L, D), dtype=F32)
    for e in range(N_EXPERTS):
        h = jax.nn.silu(xt @ w_gate[e]) * (xt @ w_up[e])
        y = y + combine[:, e:e + 1] * (h @ w_down[e]).astype(F32)
    return y.reshape(B, L, D).astype(x.dtype)


def setup_inputs(seed: int = 0) -> dict:
    key = jax.random.key(seed)
    ks = jax.random.split(key, 26)
    nrm = jax.random.normal
    Ld = DEPTH
    dt = jnp.exp(jax.random.uniform(ks[11], (Ld, DN_HEADS)) * (math.log(0.1) - math.log(0.001)) + math.log(0.001))
    return {
        "x": nrm(ks[0], (BATCH, SEQ, D_MODEL), F32),
        "meta_tokens": nrm(ks[1], (N_META, D_MODEL), F32),
        "norm1_w": 1.0 + 0.02 * nrm(ks[2], (Ld, D_MODEL), F32),
        "w_in": nrm(ks[3], (Ld, D_MODEL, W_IN_COLS), F32) * D_MODEL ** -0.5,
        "lambda_q1": 0.1 * nrm(ks[4], (Ld, DA_HEAD_DIM), F32),
        "lambda_k1": 0.1 * nrm(ks[5], (Ld, DA_HEAD_DIM), F32),
        "lambda_q2": 0.1 * nrm(ks[6], (Ld, DA_HEAD_DIM), F32),
        "lambda_k2": 0.1 * nrm(ks[7], (Ld, DA_HEAD_DIM), F32),
        "da_subln_w": 1.0 + 0.02 * nrm(ks[8], (Ld, DA_V_DIM), F32),
        "dn_conv_w": nrm(ks[9], (Ld, DN_CONV, 2 * DN_QK + DN_V), F32) * DN_CONV ** -0.5,
        "dn_A_log": jnp.log(jax.random.uniform(ks[10], (Ld, DN_HEADS), F32, 1.0, 16.0)),
        "dn_dt_bias": dt + jnp.log(-jnp.expm1(-dt)),
        "dn_norm_w": 1.0 + 0.02 * nrm(ks[12], (Ld, DN_HEAD_DIM), F32),
        "w_branch_attn": nrm(ks[13], (Ld, DA_V, D_MODEL), F32) * DA_V ** -0.5,
        "w_branch_dn": nrm(ks[14], (Ld, DN_V, D_MODEL), F32) * DN_V ** -0.5,
        "w_out": nrm(ks[15], (Ld, D_MODEL, D_MODEL), F32) * D_MODEL ** -0.5,
        "norm2_w": 1.0 + 0.02 * nrm(ks[16], (Ld, D_MODEL), F32),
        "router_group_w": nrm(ks[17], (Ld, D_MODEL, N_GROUPS), F32) * D_MODEL ** -0.5,
        "router_group_b": 0.01 * nrm(ks[18], (Ld, N_GROUPS), F32),
        "router_expert_w": nrm(ks[19], (Ld, D_MODEL, N_EXPERTS), F32) * D_MODEL ** -0.5,
        "router_expert_b": 0.01 * nrm(ks[20], (Ld, N_EXPERTS), F32),
        "expert_w_gate": nrm(ks[21], (Ld, N_EXPERTS, D_MODEL, D_EXPERT), F32) * D_MODEL ** -0.5,
        "expert_w_up": nrm(ks[22], (Ld, N_EXPERTS, D_MODEL, D_EXPERT), F32) * D_MODEL ** -0.5,
        "expert_w_down": nrm(ks[23], (Ld, N_EXPERTS, D_EXPERT, D_MODEL), F32) * D_EXPERT ** -0.5,
        "final_norm_w": 1.0 + 0.02 * nrm(ks[24], (D_MODEL,), F32),
    }


def reference(x, meta_tokens, norm1_w, w_in, lambda_q1, lambda_k1, lambda_q2, lambda_k2, da_subln_w,
              dn_conv_w, dn_A_log, dn_dt_bias, dn_norm_w, w_branch_attn, w_branch_dn, w_out, norm2_w,
              router_group_w, router_group_b, router_expert_w, router_expert_b,
              expert_w_gate, expert_w_up, expert_w_down, final_norm_w):
    B = x.shape[0]
    meta = jnp.broadcast_to(meta_tokens[None].astype(x.dtype), (B, N_META, D_MODEL))
    h = jnp.concatenate([meta, x], axis=1)
    for layer in range(DEPTH):
        lambda_init = 0.8 - 0.6 * math.exp(-0.3 * layer)
        u = rms_norm(h, norm1_w[layer])
        proj = jnp.einsum('bld,dn->bln', u, w_in[layer])
        (a_q, a_k, a_v, d_q, d_k, d_v, d_gate, d_beta, d_a, gate_a, gate_d) = jnp.split(proj, IN_OFFSETS, axis=-1)
        y_a = differential_attention(a_q, a_k, a_v, lambda_q1[layer], lambda_k1[layer], lambda_q2[layer],
                                     lambda_k2[layer], da_subln_w[layer], lambda_init)
        y_d = gated_deltanet(d_q, d_k, d_v, d_gate, d_beta, d_a, dn_conv_w[layer], dn_A_log[layer],
                             dn_dt_bias[layer], dn_norm_w[layer])
        y_a = jnp.einsum('ble,ed->bld', y_a, w_branch_attn[layer])
        y_d = jnp.einsum('ble,ed->bld', y_d, w_branch_dn[layer])
        mixed = jax.nn.sigmoid(gate_a) * y_a + jax.nn.sigmoid(gate_d) * y_d
        h = h + jnp.einsum('bld,de->ble', mixed, w_out[layer])
        h = h + hierarchical_moe(rms_norm(h, norm2_w[layer]), router_group_w[layer], router_group_b[layer],
                                 router_expert_w[layer], router_expert_b[layer], expert_w_gate[layer],
                                 expert_w_up[layer], expert_w_down[layer])
    h = rms_norm(h, final_norm_w)
    return h[:, N_META:]
```

```cpp
#ifndef EMU
#include <hip/hip_runtime.h>
#include <hip/hip_cooperative_groups.h>
#include <cstdio>
#include <cstdint>
#include <cmath>
#endif

#ifndef SEQ
#define SEQ 16384
#endif

typedef unsigned short bf16;
typedef short bf16x8 __attribute__((ext_vector_type(8)));
typedef short bf16x4 __attribute__((ext_vector_type(4)));
typedef float f32x16 __attribute__((ext_vector_type(16)));
typedef float f32x4 __attribute__((ext_vector_type(4)));
typedef unsigned u32x4 __attribute__((ext_vector_type(4)));
typedef unsigned u32x2 __attribute__((ext_vector_type(2)));

#ifdef EMU
#define MFMA32(a, b, c) emu_mfma_32x32x16((a), (b), (c))
#define MFMA16(a, b, c) emu_mfma_16x16x32((a), (b), (c))
#define DI static inline
#define EXP2F(x) exp2f(x)
#define WAVE_SYNC() emu_wave_sync()
#define LD_NT(p) (*(p))
#define LD_ATOMIC(p) (*(p))
#define SCHED_FENCE() do {} while (0)
#else
#define WAVE_SYNC() do { __builtin_amdgcn_fence(__ATOMIC_RELEASE, "wavefront"); __builtin_amdgcn_wave_barrier(); __builtin_amdgcn_fence(__ATOMIC_ACQUIRE, "wavefront"); } while (0)
#define MFMA32(a, b, c) __builtin_amdgcn_mfma_f32_32x32x16_bf16((a), (b), (c), 0, 0, 0)
#define LD_NT(p) __builtin_nontemporal_load(p)
#define LD_ATOMIC(p) __hip_atomic_load((p), __ATOMIC_RELAXED, __HIP_MEMORY_SCOPE_AGENT)
#define SCHED_FENCE() __builtin_amdgcn_sched_barrier(0)
#define MFMA16(a, b, c) __builtin_amdgcn_mfma_f32_16x16x32_bf16((a), (b), (c), 0, 0, 0)
#define DI __device__ __forceinline__
#define EXP2F(x) __builtin_amdgcn_exp2f(x)
#endif

constexpr int D = 1024;
constexpr int NMETA = 16;
constexpr int LTOK = SEQ + NMETA;
constexpr int NCH = SEQ / 64 + 1;
constexpr int NT = 512;
constexpr int W_IN_COLS = 9232;
constexpr float NORM_EPS = 1e-6f;
constexpr float LOG2E = 1.4426950408889634f;

constexpr size_t UNIT = (size_t)SEQ * D * 2;
constexpr size_t OFF_WTIN = 0;
constexpr size_t OFF_WTBA = OFF_WTIN + (size_t)9216 * 1024 * 2;
constexpr size_t OFF_WTBD = OFF_WTBA + (size_t)1024 * 1024 * 2;
constexpr size_t OFF_WTOUT = OFF_WTBD + (size_t)1024 * 1024 * 2;
constexpr size_t OFF_SMALL = OFF_WTOUT + (size_t)1024 * 1024 * 2;
constexpr size_t SM_CTL = 0;
constexpr size_t SM_UMETA = SM_CTL + 65536;
constexpr size_t SM_AKMETA = SM_UMETA + 16 * 1024 * 2;
constexpr size_t SM_AVTMETA = SM_AKMETA + 16 * 1024 * 2;
constexpr size_t SM_C0Q = SM_AVTMETA + 8 * 128 * 16 * 2;
constexpr size_t SM_C0K = SM_C0Q + 64 * 1024 * 2;
constexpr size_t SM_C0V = SM_C0K + 64 * 1024 * 2;
constexpr size_t SM_C0W = SM_C0V + 64 * 1024 * 2;
constexpr size_t SM_BETA = SM_C0W + 8 * 64 * 128 * 2;
constexpr size_t SM_G = SM_BETA + (size_t)NCH * 64 * 8 * 4;
constexpr size_t SM_GC = SM_G + (size_t)NCH * 64 * 8 * 4;
constexpr size_t SM_WR = SM_GC + (size_t)NCH * 8 * 64 * 4;
constexpr size_t SM_RIDS = SM_WR + 1024 * 40 * 4;
constexpr size_t SM_RW = SM_RIDS + 0;
constexpr size_t SM_TAILS = SM_RW + (size_t)SEQ * 2 * 4;
constexpr size_t SM_TAILS_BYTES = ((size_t)NCH * 3 * 3072 * 2 > (size_t)32 * SEQ * 4) ? (size_t)NCH * 3 * 3072 * 2 : (size_t)32 * SEQ * 4;
constexpr size_t SM_END = SM_TAILS + SM_TAILS_BYTES;
constexpr size_t SMALL_BYTES = (SM_END + 255) & ~(size_t)255;
constexpr size_t OFF_U = ((OFF_SMALL + SMALL_BYTES + (1u << 20) - 1) >> 20) << 20;
constexpr size_t OFF_W = OFF_U + UNIT;
constexpr size_t OFF_KN = OFF_W + UNIT;
constexpr size_t OFF_QN = OFF_KN + UNIT;
constexpr size_t OFF_DG = OFF_QN + UNIT;
constexpr size_t OFF_V = OFF_DG + UNIT;
constexpr size_t OFF_AQ = OFF_V + UNIT;
constexpr size_t WS_BASE_END = OFF_AQ + UNIT;
constexpr size_t EXPERT_BYTES = (size_t)32 * 3 * 1024 * 256 * 2;
constexpr size_t OFF_EXP = (2 * UNIT >= EXPERT_BYTES) ? OFF_W : WS_BASE_END;
constexpr size_t WS_END = (OFF_EXP == OFF_W) ? WS_BASE_END : WS_BASE_END + EXPERT_BYTES;
constexpr size_t OFF_EXG = OFF_EXP, OFF_EXU = OFF_EXP + EXPERT_BYTES / 3, OFF_EXD = OFF_EXP + 2 * (EXPERT_BYTES / 3);
constexpr size_t OFF_OD = OFF_QN;
constexpr size_t OFF_Y = OFF_V;
#if SEQ == 16384
static_assert(WS_END <= (size_t)256 << 20, "workspace map exceeds 256 MiB");
static_assert(EXPERT_BYTES <= 2 * UNIT, "experts fit R2+R3");
#endif
constexpr int CW_ATTQ = 64;
constexpr int CW_ECNT = 128;
constexpr int CW_BAR = 1024;

struct Params {
    const float* in[25];
    float* out;
    unsigned char* ws;
};

DI unsigned f2bf(float f) { unsigned u = __builtin_bit_cast(unsigned, f); return (u + 0x7fffu + ((u >> 16) & 1u)) >> 16; }
DI float bf2f(unsigned b) { return __builtin_bit_cast(float, (b & 0xffffu) << 16); }
DI unsigned pk2(float lo, float hi) { return f2bf(lo) | (f2bf(hi) << 16); }
DI float bflo(unsigned w) { return __builtin_bit_cast(float, w << 16); }
DI float bfhi(unsigned w) { return __builtin_bit_cast(float, w & 0xffff0000u); }
DI float sigmoidf_(float x) { return 1.0f / (1.0f + __expf(-x)); }
DI float siluf_(float x) { return x / (1.0f + __expf(-x)); }
DI float wave_sum(float v) {
#pragma unroll
    for (int o = 1; o < 64; o <<= 1) v += __shfl_xor(v, o);
    return v;
}
DI int fresh_tid() {
    int t = threadIdx.x;
#ifndef EMU
    asm volatile("" : "+v"(t));
#endif
    return t;
}
DI f32x16 zero16() { f32x16 z; for (int i = 0; i < 16; ++i) z[i] = 0.f; return z; }
DI f32x4 zero4() { f32x4 z; for (int i = 0; i < 4; ++i) z[i] = 0.f; return z; }
DI int swz128(int row, int c) { return row * 128 + ((c ^ ((row >> 1) & 7)) << 4); }
DI int swz128_8(int row, int s) { return row * 128 + ((s ^ (((row >> 1) & 7) << 1)) << 3); }
DI int swzrow(int row, int pitch, int c) { return row * pitch + ((c ^ (row & 15)) << 4); }

#ifdef EMU
#define SMEM_DECL char* smem = emu_smem()
#else
#define SMEM_DECL extern __shared__ __attribute__((aligned(16))) char smem[]
#endif

DI void transpose_item(const float* W, int ldw, int K, bf16* Wt, int k0, int src_n0, int dst_n0, float* scr, int lane) {
#pragma unroll 8
    for (int i = 0; i < 32; ++i) { const int kk = 2 * i + (lane >> 5); scr[kk * 33 + (lane & 31)] = W[(size_t)(k0 + kk) * ldw + src_n0 + (lane & 31)]; }
    WAVE_SYNC();
    const int c = lane & 7;
#pragma unroll
    for (int j = 0; j < 4; ++j) {
        const int n = (lane >> 3) + 8 * j; const float* s = scr + (8 * c) * 33 + n;
        u32x4 o; o.x = pk2(s[0 * 33], s[1 * 33]); o.y = pk2(s[2 * 33], s[3 * 33]); o.z = pk2(s[4 * 33], s[5 * 33]); o.w = pk2(s[6 * 33], s[7 * 33]);
        *(u32x4*)(Wt + (size_t)(dst_n0 + n) * K + k0 + 8 * c) = o;
    }
    WAVE_SYNC();
}

DI void phase0(const Params& p, char* smem, int bid, int nblk) {
    const int tid = fresh_tid(), lane = tid & 63, wave = tid >> 6;
    const int gw = bid * 8 + wave, NGW = nblk * 8;
    unsigned char* ws = p.ws;
    if (bid == 0) {
        unsigned* ctl = (unsigned*)(ws + OFF_SMALL + SM_CTL);
        for (int i = tid; i < 1024; i += NT) ctl[i] = 0u;
        float* be = (float*)(ws + OFF_SMALL + SM_BETA); float* gg = (float*)(ws + OFF_SMALL + SM_G);
        for (int i = tid; i < 48 * 8; i += NT) { be[i] = 0.f; gg[i] = 0.f; }
    }
    {
        float* scr = (float*)(smem + 65536) + wave * (64 * 33);
        constexpr int I_IN = 16 * (9216 / 32), I_SQ = 16 * 32;
        constexpr int NITEMS = I_IN + 3 * I_SQ;
        for (int it = gw; it < NITEMS; it += NGW) {
            int r = it;
            if (r < I_IN) { const int kb = r / 288, nb = r % 288; const int dn = nb * 32; const int sn = dn < 7168 ? dn : dn + 16;
                transpose_item(p.in[3], W_IN_COLS, 1024, (bf16*)(ws + OFF_WTIN), kb * 64, sn, dn, scr, lane); continue; }
            r -= I_IN;
            const int m = r / I_SQ; r %= I_SQ;
            const float* src = m == 0 ? p.in[13] : (m == 1 ? p.in[14] : p.in[15]);
            bf16* dst = (bf16*)(ws + (m == 0 ? OFF_WTBA : (m == 1 ? OFF_WTBD : OFF_WTOUT)));
            transpose_item(src, 1024, 1024, dst, (r / 32) * 64, (r % 32) * 32, (r % 32) * 32, scr, lane);
        }
    }
    {
        float* WR = (float*)(ws + OFF_SMALL + SM_WR);
        for (int i = bid * NT + tid; i < 1024 * 40; i += nblk * NT) {
            const int k = i / 40, c = i % 40; float v = 0.f;
            if (c < 4) v = p.in[17][k * 4 + c]; else if (c < 36) v = p.in[19][k * 32 + (c - 4)];
            WR[i] = v * p.in[16][k];
        }
    }
    float* wbd = (float*)smem;
    for (int i = tid; i < 1024 * 16; i += NT) { const int k = i >> 4, c = i & 15; wbd[i] = p.in[3][(size_t)k * W_IN_COLS + 7168 + c]; }
    __syncthreads();
    const float* nw = p.in[2];
    for (int R = gw; R < LTOK; R += NGW) {
        const float* xrow = R < NMETA ? p.in[1] + (size_t)R * D : p.in[0] + (size_t)(R - NMETA) * D;
        bf16* urow = R < NMETA ? (bf16*)(ws + OFF_SMALL + SM_UMETA) + (size_t)R * D : (bf16*)(ws + OFF_U) + (size_t)(R - NMETA) * D;
        float ss = 0.f;
#pragma unroll
        for (int j = 0; j < 4; ++j) { const float4 v = *(const float4*)(xrow + 4 * lane + 256 * j); ss += v.x * v.x + v.y * v.y + v.z * v.z + v.w * v.w; }
        ss = wave_sum(ss);
        const float rstd = rsqrtf(ss * (1.0f / D) + NORM_EPS);
        float acc[16];
#pragma unroll
        for (int c = 0; c < 16; ++c) acc[c] = 0.f;
#pragma unroll 1
        for (int j = 0; j < 4; ++j) {
            const float4 w4 = *(const float4*)(nw + 4 * lane + 256 * j);
            const float4 xv = *(const float4*)(xrow + 4 * lane + 256 * j);
            float uu[4] = {xv.x * rstd * w4.x, xv.y * rstd * w4.y, xv.z * rstd * w4.z, xv.w * rstd * w4.w};
            u32x2 o; o.x = pk2(uu[0], uu[1]); o.y = pk2(uu[2], uu[3]);
            *(u32x2*)(urow + 4 * lane + 256 * j) = o;
#pragma unroll
            for (int e = 0; e < 4; ++e) {
                const float* wr = wbd + (size_t)(4 * lane + 256 * j + e) * 16;
#pragma unroll
                for (int c = 0; c < 16; ++c) acc[c] += uu[e] * wr[c];
            }
        }
#pragma unroll
        for (int c = 0; c < 16; ++c) acc[c] = wave_sum(acc[c]);
        if (lane < 16) {
            float a = 0.f;
#pragma unroll
            for (int c = 0; c < 16; ++c) a = (lane == c) ? acc[c] : a;
            const size_t pos = 48 + R;
            if (lane < 8) { ((float*)(ws + OFF_SMALL + SM_BETA))[pos * 8 + lane] = sigmoidf_(a); }
            else { const int hh = lane - 8; const float z = a + p.in[11][hh]; const float sp = fmaxf(z, 0.f) + log1pf(__expf(-fabsf(z)));
                   ((float*)(ws + OFF_SMALL + SM_G))[pos * 8 + hh] = -__expf(p.in[10][hh]) * sp; }
        }
    }
}

constexpr int G_BM = 256, G_BN = 128, G_BK = 64;
constexpr int G_LDS_A = G_BM * G_BK * 2, G_LDS_B = G_BN * G_BK * 2;
constexpr int G_STAGE_PITCH = 132;
constexpr int G_LDS_BYTES = G_BM * G_STAGE_PITCH * 4;
constexpr int G_MT = SEQ / 256 + 1, G_NTILES = 56;

DI void gemm_inproj_tile(const Params& p, char* smem, int mt, int nt) {
    const int tid = fresh_tid(), lane = tid & 63, wave = tid >> 6;
    const int wm = wave >> 1, wn = wave & 1, r32 = lane & 31, h = lane >> 5;
    unsigned char* ws = p.ws;
    const bool meta = (mt == G_MT - 1);
    const bf16* A = meta ? (const bf16*)(ws + OFF_SMALL + SM_UMETA) : (const bf16*)(ws + OFF_U) + (size_t)mt * 256 * D;
    const int vrows = meta ? NMETA : 256;
    const bf16* Bt = (const bf16*)(ws + OFF_WTIN) + (size_t)nt * 128 * D;
    char* ldsA[2] = {smem, smem + G_LDS_A + G_LDS_B};
    char* ldsB[2] = {smem + G_LDS_A, smem + 2 * G_LDS_A + G_LDS_B};
    f32x16 acc[2][2];
#pragma unroll
    for (int i = 0; i < 2; ++i)
#pragma unroll
        for (int j = 0; j < 2; ++j) acc[i][j] = zero16();
    const int lrow = tid >> 3, lc = tid & 7;
    u32x4 ra[4], rb[2];
    auto gload = [&](int kt) {
#pragma unroll
        for (int i = 0; i < 4; ++i) { const int row = lrow + 64 * i; ra[i] = row < vrows ? *(const u32x4*)(A + (size_t)row * D + kt * 64 + lc * 8) : (u32x4){0u, 0u, 0u, 0u}; }
#pragma unroll
        for (int i = 0; i < 2; ++i) { const int row = lrow + 64 * i; rb[i] = *(const u32x4*)(Bt + (size_t)row * D + kt * 64 + lc * 8); }
    };
    auto lstore = [&](int buf) {
#pragma unroll
        for (int i = 0; i < 4; ++i) *(u32x4*)(ldsA[buf] + swz128(lrow + 64 * i, lc)) = ra[i];
#pragma unroll
        for (int i = 0; i < 2; ++i) *(u32x4*)(ldsB[buf] + swz128(lrow + 64 * i, lc)) = rb[i];
    };
    gload(0); lstore(0); __syncthreads();
    for (int kt = 0; kt < 16; ++kt) {
        const int buf = kt & 1;
        if (kt + 1 < 16) gload(kt + 1);
#pragma unroll
        for (int ks = 0; ks < 4; ++ks) {
            bf16x8 af[2], bfr[2];
#pragma unroll
            for (int i = 0; i < 2; ++i) af[i] = *(const bf16x8*)(ldsA[buf] + swz128(64 * wm + 32 * i + r32, 2 * ks + h));
#pragma unroll
            for (int j = 0; j < 2; ++j) bfr[j] = *(const bf16x8*)(ldsB[buf] + swz128(64 * wn + 32 * j + r32, 2 * ks + h));
#pragma unroll
            for (int i = 0; i < 2; ++i)
#pragma unroll
                for (int j = 0; j < 2; ++j) acc[i][j] = MFMA32(af[i], bfr[j], acc[i][j]);
        }
        if (kt + 1 < 16) lstore(buf ^ 1);
        __syncthreads();
    }
    float* st = (float*)smem;
#pragma unroll
    for (int i = 0; i < 2; ++i)
#pragma unroll
        for (int j = 0; j < 2; ++j)
#pragma unroll
            for (int r = 0; r < 16; ++r) {
                const int row = 64 * wm + 32 * i + (r & 3) + 8 * (r >> 2) + 4 * h, col = 64 * wn + 32 * j + r32;
                st[row * G_STAGE_PITCH + col] = acc[i][j][r];
            }
    __syncthreads();
    const int tid2 = fresh_tid();
    const int sec = nt >> 3, cb = (nt & 7) * 128;
    if (sec == 2) {
        const int head = nt & 7, e = tid2 >> 2, sub = tid2 & 3;
        if (!meta) {
            bf16* dst = (bf16*)p.out + (size_t)SEQ * D + ((size_t)head * 128 + e) * SEQ + (size_t)mt * 256;
#pragma unroll
            for (int i = 0; i < 8; ++i) {
                const int row0 = 32 * i + 8 * sub; float f[8];
#pragma unroll
                for (int j = 0; j < 8; ++j) f[j] = st[(row0 + j) * G_STAGE_PITCH + e];
                u32x4 o; o.x = pk2(f[0], f[1]); o.y = pk2(f[2], f[3]); o.z = pk2(f[4], f[5]); o.w = pk2(f[6], f[7]);
                *(u32x4*)(dst + row0) = o;
            }
        } else if (sub < 2) {
            bf16* dst = (bf16*)(ws + OFF_SMALL + SM_AVTMETA) + ((size_t)head * 128 + e) * 16;
            const int row0 = 8 * sub; float f[8];
#pragma unroll
            for (int j = 0; j < 8; ++j) f[j] = st[(row0 + j) * G_STAGE_PITCH + e];
            u32x4 o; o.x = pk2(f[0], f[1]); o.y = pk2(f[2], f[3]); o.z = pk2(f[4], f[5]); o.w = pk2(f[6], f[7]);
            *(u32x4*)(dst + row0) = o;
        }
    } else {
        bf16* base; bool has_meta = true; bf16* mbase = nullptr; int mrow0 = 0;
        if (sec == 0) { base = (bf16*)(ws + OFF_AQ); has_meta = false; }
        else if (sec == 1) { base = (bf16*)p.out; mbase = (bf16*)(ws + OFF_SMALL + SM_AKMETA); }
        else if (sec == 3) { base = (bf16*)(ws + OFF_QN); mbase = (bf16*)(ws + OFF_SMALL + SM_C0Q); mrow0 = 48; }
        else if (sec == 4) { base = (bf16*)(ws + OFF_KN); mbase = (bf16*)(ws + OFF_SMALL + SM_C0K); mrow0 = 48; }
        else if (sec == 5) { base = (bf16*)(ws + OFF_V); mbase = (bf16*)(ws + OFF_SMALL + SM_C0V); mrow0 = 48; }
        else { base = (bf16*)(ws + OFF_DG); has_meta = false; }
        const bool dqkv = (sec >= 3 && sec <= 5);
        bf16* tails = (bf16*)(ws + OFF_SMALL + SM_TAILS);
        if (!meta || has_meta) {
#pragma unroll
            for (int i = 0; i < 8; ++i) {
                const int idx = tid2 + NT * i, row = idx >> 4, cg = idx & 15;
                if (row < vrows) {
                    const float* s = st + row * G_STAGE_PITCH + cg * 8;
                    const f32x4 a = *(const f32x4*)s, b = *(const f32x4*)(s + 4);
                    u32x4 o; o.x = pk2(a[0], a[1]); o.y = pk2(a[2], a[3]); o.z = pk2(b[0], b[1]); o.w = pk2(b[2], b[3]);
                    if (!meta) {
                        const int j = mt * 256 + row;
                        *(u32x4*)(base + (size_t)j * D + cb + cg * 8) = o;
                        if (dqkv && (j & 63) >= 61) *(u32x4*)(tails + ((size_t)(j / 64 + 1) * 3 + ((j & 63) - 61)) * 3072 + (sec - 3) * 1024 + cb + cg * 8) = o;
                    } else {
                        *(u32x4*)(mbase + (size_t)(mrow0 + row) * D + cb + cg * 8) = o;
                        if (dqkv && row >= 13) *(u32x4*)(tails + ((size_t)0 * 3 + (row - 13)) * 3072 + (sec - 3) * 1024 + cb + cg * 8) = o;
                    }
                }
            }
        }
    }
    __syncthreads();
}

DI void phase1(const Params& p, char* smem, int bid, int nblk) {
    const int ntiles = G_MT * G_NTILES;
    for (int t = bid; t < ntiles; t += nblk) {
        const int mt = t / G_NTILES, nt = t % G_NTILES;
        gemm_inproj_tile(p, smem, mt, nt);
    }
}

constexpr int P2_KN = 0, P2_KB = 16384, P2_KBGT = 32768, P2_VBT = 49152, P2_ALDS = 65536, P2_TLDS = P2_ALDS + 64 * 68 * 4, P2_GC = P2_TLDS + 8192, P2_BET = P2_GC + 256, P2_EG = P2_BET + 256;

DI void prep_item(const Params& p, char* smem, int chunk, int head) {
    int tid_ = threadIdx.x;
#ifndef EMU
    asm volatile("" : "+v"(tid_));
#endif
    const int tid = tid_, lane = tid & 63, wave = tid >> 6, r32 = lane & 31, h = lane >> 5;
    unsigned char* ws = p.ws;
    float* gcl = (float*)(smem + P2_GC); float* betl = (float*)(smem + P2_BET); float* egl = (float*)(smem + P2_EG);
    if (wave == 0) {
        const size_t pos = (size_t)chunk * 64 + lane;
        float v = ((const float*)(ws + OFF_SMALL + SM_G))[pos * 8 + head];
        const float b = ((const float*)(ws + OFF_SMALL + SM_BETA))[pos * 8 + head];
#pragma unroll
        for (int o = 1; o < 64; o <<= 1) { const float t = __shfl_up(v, o); if (lane >= o) v += t; }
        gcl[lane] = v; betl[lane] = b; egl[lane] = __expf(v);
        ((float*)(ws + OFF_SMALL + SM_GC))[((size_t)chunk * 8 + head) * 64 + lane] = v;
    }
    __syncthreads();
    {
        const int r = tid >> 3, cg = tid & 7, col0 = head * 128 + 16 * cg;
        const bool zero_row = (chunk == 0 && r < 48);
        const float beta = betl[r], eg = egl[r];
        const bf16* tails = (const bf16*)(ws + OFF_SMALL + SM_TAILS);
#pragma unroll 1
        for (int mat = 0; mat < 3; ++mat) {
            bf16* mainb = (bf16*)(ws + (mat == 0 ? OFF_QN : (mat == 1 ? OFF_KN : OFF_V)));
            bf16* c0b = (bf16*)(ws + OFF_SMALL + (mat == 0 ? SM_C0Q : (mat == 1 ? SM_C0K : SM_C0V)));
            float y[16];
#pragma unroll
            for (int c = 0; c < 16; ++c) y[c] = 0.f;
#pragma unroll
            for (int jj = 0; jj < 4; ++jj) {
                const int rr = r - 3 + jj;
                const bf16* src = nullptr;
                if (chunk == 0) { if (rr >= 48) src = c0b + (size_t)rr * D + col0; }
                else if (rr >= 0) src = mainb + ((size_t)(chunk - 1) * 64 + rr) * D + col0;
                else src = tails + ((size_t)(chunk - 1) * 3 + (3 + rr)) * 3072 + mat * 1024 + col0;
                u32x4 a = {0u, 0u, 0u, 0u}, b = {0u, 0u, 0u, 0u};
                if (src) { a = *(const u32x4*)src; b = *(const u32x4*)(src + 8); }
                const float* cw = p.in[9] + (size_t)jj * 3072 + mat * 1024 + col0;
                const f32x4 w0 = *(const f32x4*)cw, w1 = *(const f32x4*)(cw + 4), w2 = *(const f32x4*)(cw + 8), w3 = *(const f32x4*)(cw + 12);
                y[0] += w0[0] * bflo(a.x); y[1] += w0[1] * bfhi(a.x); y[2] += w0[2] * bflo(a.y); y[3] += w0[3] * bfhi(a.y);
                y[4] += w1[0] * bflo(a.z); y[5] += w1[1] * bfhi(a.z); y[6] += w1[2] * bflo(a.w); y[7] += w1[3] * bfhi(a.w);
                y[8] += w2[0] * bflo(b.x); y[9] += w2[1] * bfhi(b.x); y[10] += w2[2] * bflo(b.y); y[11] += w2[3] * bfhi(b.y);
                y[12] += w3[0] * bflo(b.z); y[13] += w3[1] * bfhi(b.z); y[14] += w3[2] * bflo(b.w); y[15] += w3[3] * bfhi(b.w);
            }
            float ss = 0.f;
#pragma unroll
            for (int c = 0; c < 16; ++c) { y[c] = zero_row ? 0.f : siluf_(y[c]); ss += y[c] * y[c]; }
            if (mat < 2) {
                ss += __shfl_xor(ss, 1); ss += __shfl_xor(ss, 2); ss += __shfl_xor(ss, 4);
                const float sc = rsqrtf(ss + 1e-6f) * (mat == 0 ? 0.08838834764831845f : 1.0f);
                unsigned pk[8];
#pragma unroll
                for (int c = 0; c < 8; ++c) pk[c] = pk2(y[2 * c] * sc, y[2 * c + 1] * sc);
                bf16* dst = (chunk == 0) ? c0b + (size_t)r * D + col0 : mainb + ((size_t)(chunk - 1) * 64 + r) * D + col0;
                *(u32x4*)dst = (u32x4){pk[0], pk[1], pk[2], pk[3]}; *(u32x4*)(dst + 8) = (u32x4){pk[4], pk[5], pk[6], pk[7]};
                if (mat == 1) {
                    *(u32x4*)(smem + P2_KN + swzrow(r, 256, 2 * cg)) = (u32x4){pk[0], pk[1], pk[2], pk[3]};
                    *(u32x4*)(smem + P2_KN + swzrow(r, 256, 2 * cg + 1)) = (u32x4){pk[4], pk[5], pk[6], pk[7]};
                    unsigned kb[8];
#pragma unroll
                    for (int c = 0; c < 8; ++c) {
                        const float k0 = bflo(pk[c]) * beta, k1 = bfhi(pk[c]) * beta;
                        kb[c] = pk2(k0, k1);
                        const int d0 = 16 * cg + 2 * c;
                        *(bf16*)(smem + P2_KBGT + swz128(d0, r >> 3) + (r & 7) * 2) = (bf16)f2bf(k0 * eg);
                        *(bf16*)(smem + P2_KBGT + swz128(d0 + 1, r >> 3) + (r & 7) * 2) = (bf16)f2bf(k1 * eg);
                    }
                    *(u32x4*)(smem + P2_KB + swzrow(r, 256, 2 * cg)) = (u32x4){kb[0], kb[1], kb[2], kb[3]};
                    *(u32x4*)(smem + P2_KB + swzrow(r, 256, 2 * cg + 1)) = (u32x4){kb[4], kb[5], kb[6], kb[7]};
                }
            } else {
#pragma unroll
                for (int c = 0; c < 16; ++c) {
                    const int e = 16 * cg + c;
                    *(bf16*)(smem + P2_VBT + swz128(e, r >> 3) + (r & 7) * 2) = (bf16)f2bf(y[c] * beta);
                }
            }
        }
    }
    __syncthreads();
    if (wave < 4) {
        const int mi = wave >> 1, ni = wave & 1;
        f32x16 acc = zero16();
        if (ni <= mi) {
#pragma unroll
            for (int ks = 0; ks < 8; ++ks) {
                const bf16x8 a = *(const bf16x8*)(smem + P2_KB + swzrow(32 * mi + r32, 256, 2 * ks + h));
                const bf16x8 b = *(const bf16x8*)(smem + P2_KN + swzrow(32 * ni + r32, 256, 2 * ks + h));
                acc = MFMA32(a, b, acc);
            }
        }
        float* Al = (float*)(smem + P2_ALDS);
        const int j = 32 * ni + r32; const float gj = gcl[j];
#pragma unroll
        for (int r = 0; r < 16; ++r) {
            const int i = 32 * mi + (r & 3) + 8 * (r >> 2) + 4 * h;
            const float dv = acc[r] * __expf(gcl[i] - gj);
            Al[i * 68 + j] = (j < i) ? dv : 0.f;
        }
    }
    __syncthreads();
    if (wave == 0) {
        const float* Al = (const float*)(smem + P2_ALDS);
        float t[64];
#pragma unroll
        for (int i = 0; i < 64; ++i) {
            float s = (i == lane) ? 1.f : 0.f;
#pragma unroll
            for (int j = 0; j < i; ++j) s -= Al[i * 68 + j] * t[j];
            t[i] = s;
#ifndef EMU
            if ((i & 3) == 3) asm volatile("" ::: "memory");
#endif
        }
#pragma unroll
        for (int i = 0; i < 64; ++i) *(bf16*)(smem + P2_TLDS + swz128(i, lane >> 3) + (lane & 7) * 2) = (bf16)f2bf(t[i]);
    }
    __syncthreads();
    {
        const int mi = wave >> 2, ni = wave & 3;
        f32x16 acc = zero16();
#pragma unroll
        for (int ks = 0; ks < 4; ++ks) {
            const bf16x8 a = *(const bf16x8*)(smem + P2_TLDS + swz128(32 * mi + r32, 2 * ks + h));
            const bf16x8 b = *(const bf16x8*)(smem + P2_VBT + swz128(32 * ni + r32, 2 * ks + h));
            acc = MFMA32(a, b, acc);
        }
        const int e = 32 * ni + r32;
        bf16* base = (chunk == 0) ? (bf16*)(ws + OFF_SMALL + SM_C0V) : (bf16*)(ws + OFF_V) + (size_t)(chunk - 1) * 64 * D;
        bf16* dst = base + (size_t)(e >> 1) * D + head * 128 + (e & 1) * 64;
#pragma unroll
        for (int q4 = 0; q4 < 4; ++q4) {
            const int c0 = 32 * mi + 8 * q4 + 4 * h;
            *(u32x2*)(dst + c0) = (u32x2){pk2(acc[4 * q4], acc[4 * q4 + 1]), pk2(acc[4 * q4 + 2], acc[4 * q4 + 3])};
        }
    }
    {
        const int mi = wave >> 1, ni = wave & 1;
        f32x16 acc = zero16();
#pragma unroll
        for (int ks = 0; ks < 4; ++ks) {
            const bf16x8 a = *(const bf16x8*)(smem + P2_KBGT + swz128(32 * mi + r32, 2 * ks + h));
            const bf16x8 b = *(const bf16x8*)(smem + P2_TLDS + swz128(32 * ni + r32, 2 * ks + h));
            acc = MFMA32(a, b, acc);
        }
        const int c = 32 * ni + r32;
        bf16* wb = (chunk == 0) ? (bf16*)(ws + OFF_SMALL + SM_C0W) + (size_t)head * 8192 : (bf16*)(ws + OFF_W) + ((size_t)(chunk - 1) * 8 + head) * 8192;
#pragma unroll
        for (int q4 = 0; q4 < 4; ++q4) {
            const int dk0 = 32 * mi + 8 * q4 + 4 * h;
            *(u32x2*)(wb + c * 128 + dk0) = (u32x2){pk2(acc[4 * q4], acc[4 * q4 + 1]), pk2(acc[4 * q4 + 2], acc[4 * q4 + 3])};
        }
    }
    __syncthreads();
}

DI void phase2(const Params& p, char* smem, int bid, int nblk) {
    for (int it = bid; it < NCH * 8; it += nblk) prep_item(p, smem, it >> 3, it & 7);
}

DI int swzrow8(int row, int pitch, int s) { return row * pitch + ((((s >> 1) ^ (row & 15)) << 4) | ((s & 1) << 3)); }
DI bf16x8 pack8(f32x4 a, f32x4 b) {
    u32x4 o; o.x = pk2(a[0], a[1]); o.y = pk2(a[2], a[3]); o.z = pk2(b[0], b[1]); o.w = pk2(b[2], b[3]);
    return __builtin_bit_cast(bf16x8, o);
}
DI bf16x8 ld2x8(const char* p0, const char* p1) {
    const u32x2 a = *(const u32x2*)p0, b = *(const u32x2*)p1; u32x4 o; o.x = a.x; o.y = a.y; o.z = b.x; o.w = b.y;
    return __builtin_bit_cast(bf16x8, o);
}
constexpr int SC_W = 0, SC_QN = 16384, SC_KN = 32768, SC_KNT = 49152, SC_QK = 65536, SC_GC = 73728;

DI void scan_head(const Params& p, char* smem, int head) {
    const int tid = fresh_tid(), lane = tid & 63, wave = tid >> 6, r16 = lane & 15, g = lane >> 4;
    unsigned char* ws = p.ws;
    const int lrow = tid >> 3, lch = (tid & 7) * 2;
    f32x4 S[8];
#pragma unroll
    for (int i = 0; i < 8; ++i) S[i] = zero4();
    u32x4 rw[2], rq[2], rk[2]; u32x2 ru[4]; float rgc = 0.f;
    auto srcrow = [&](int n, size_t off_main, size_t off_c0) -> const bf16* {
        return n == 0 ? (const bf16*)(ws + OFF_SMALL + off_c0) + (size_t)lrow * D + head * 128 + lch * 8
                      : (const bf16*)(ws + off_main) + ((size_t)(n - 1) * 64 + lrow) * D + head * 128 + lch * 8;
    };
    auto uaddr = [&](int n, int mt) -> bf16* {
        const int e = 16 * wave + r16;
        bf16* base = n == 0 ? (bf16*)(ws + OFF_SMALL + SM_C0V) : (bf16*)(ws + OFF_V) + (size_t)(n - 1) * 64 * D;
        return base + (size_t)(e >> 1) * D + head * 128 + (e & 1) * 64 + 16 * mt + 4 * g;
    };
    auto gload = [&](int n) {
        const bf16* wsrc = (n == 0 ? (const bf16*)(ws + OFF_SMALL + SM_C0W) + (size_t)head * 8192 : (const bf16*)(ws + OFF_W) + ((size_t)(n - 1) * 8 + head) * 8192) + lrow * 128 + lch * 8;
        rw[0] = *(const u32x4*)wsrc; rw[1] = *(const u32x4*)(wsrc + 8);
        const bf16* qs = srcrow(n, OFF_QN, SM_C0Q); rq[0] = *(const u32x4*)qs; rq[1] = *(const u32x4*)(qs + 8);
        const bf16* ks = srcrow(n, OFF_KN, SM_C0K); rk[0] = *(const u32x4*)ks; rk[1] = *(const u32x4*)(ks + 8);
#pragma unroll
        for (int mt = 0; mt < 4; ++mt) ru[mt] = *(const u32x2*)uaddr(n, mt);
        if (tid < 64) rgc = ((const float*)(ws + OFF_SMALL + SM_GC))[((size_t)n * 8 + head) * 64 + tid];
    };
    gload(0);
    for (int n = 0; n < NCH; ++n) {
        __syncthreads();
        *(u32x4*)(smem + SC_W + swzrow(lrow, 256, lch)) = rw[0]; *(u32x4*)(smem + SC_W + swzrow(lrow, 256, lch + 1)) = rw[1];
        *(u32x4*)(smem + SC_QN + swzrow(lrow, 256, lch)) = rq[0]; *(u32x4*)(smem + SC_QN + swzrow(lrow, 256, lch + 1)) = rq[1];
        *(u32x4*)(smem + SC_KN + swzrow(lrow, 256, lch)) = rk[0]; *(u32x4*)(smem + SC_KN + swzrow(lrow, 256, lch + 1)) = rk[1];
        {
            const unsigned kk[8] = {rk[0].x, rk[0].y, rk[0].z, rk[0].w, rk[1].x, rk[1].y, rk[1].z, rk[1].w};
#pragma unroll
            for (int c = 0; c < 8; ++c) {
                const int dk = lch * 8 + 2 * c;
                *(bf16*)(smem + SC_KNT + swz128_8(dk, lrow >> 2) + (lrow & 3) * 2) = (bf16)(kk[c] & 0xffffu);
                *(bf16*)(smem + SC_KNT + swz128_8(dk + 1, lrow >> 2) + (lrow & 3) * 2) = (bf16)(kk[c] >> 16);
            }
        }
        if (tid < 64) ((float*)(smem + SC_GC))[tid] = rgc;
        u32x2 ucur[4];
#pragma unroll
        for (int mt = 0; mt < 4; ++mt) ucur[mt] = ru[mt];
        __syncthreads();
        if (n + 1 < NCH) gload(n + 1);
        const float* gcl = (const float*)(smem + SC_GC);
        {
            const int mt = wave >> 1;
#pragma unroll
            for (int t2 = 0; t2 < 2; ++t2) {
                const int nt = 2 * (wave & 1) + t2;
                f32x4 acc = zero4();
                if (nt <= mt) {
#pragma unroll
                    for (int ks = 0; ks < 4; ++ks) {
                        const bf16x8 a = *(const bf16x8*)(smem + SC_QN + swzrow(16 * mt + r16, 256, 4 * ks + g));
                        const bf16x8 b = *(const bf16x8*)(smem + SC_KN + swzrow(16 * nt + r16, 256, 4 * ks + g));
                        acc = MFMA16(a, b, acc);
                    }
                }
                const int j = 16 * nt + r16; const float gj = gcl[j];
#pragma unroll
                for (int r = 0; r < 4; ++r) {
                    const int i = 16 * mt + 4 * g + r;
                    const float v = (j <= i) ? acc[r] * __expf(gcl[i] - gj) : 0.f;
                    *(bf16*)(smem + SC_QK + swz128_8(i, j >> 2) + (j & 3) * 2) = (bf16)f2bf(v);
                }
            }
        }
        __syncthreads();
        const float gl = gcl[63], gtot = __expf(gl);
        bf16x8 sf[4];
#pragma unroll
        for (int kb = 0; kb < 4; ++kb) sf[kb] = pack8(S[2 * kb], S[2 * kb + 1]);
        f32x4 Vn[4], O[4];
#pragma unroll
        for (int mt = 0; mt < 4; ++mt) {
            f32x4 P = zero4(), Q = zero4();
            const int row = 16 * mt + r16;
#pragma unroll
            for (int kb = 0; kb < 4; ++kb) {
                const bf16x8 wf = ld2x8(smem + SC_W + swzrow8(row, 256, 8 * kb + g), smem + SC_W + swzrow8(row, 256, 8 * kb + 4 + g));
                const bf16x8 qf = ld2x8(smem + SC_QN + swzrow8(row, 256, 8 * kb + g), smem + SC_QN + swzrow8(row, 256, 8 * kb + 4 + g));
                P = MFMA16(wf, sf[kb], P);
                Q = MFMA16(qf, sf[kb], Q);
            }
            const float u0 = bflo(ucur[mt].x), u1 = bfhi(ucur[mt].x), u2 = bflo(ucur[mt].y), u3 = bfhi(ucur[mt].y);
            Vn[mt] = (f32x4){u0 - P[0], u1 - P[1], u2 - P[2], u3 - P[3]};
#pragma unroll
            for (int r = 0; r < 4; ++r) Q[r] *= __expf(gcl[16 * mt + 4 * g + r]);
            O[mt] = Q;
        }
        bf16x8 vf[2] = {pack8(Vn[0], Vn[1]), pack8(Vn[2], Vn[3])};
#pragma unroll
        for (int mt = 0; mt < 4; ++mt) {
            const int row = 16 * mt + r16;
#pragma unroll
            for (int kb = 0; kb < 2; ++kb) {
                const bf16x8 qk = ld2x8(smem + SC_QK + swz128_8(row, 8 * kb + g), smem + SC_QK + swz128_8(row, 8 * kb + 4 + g));
                O[mt] = MFMA16(qk, vf[kb], O[mt]);
            }
            if (n >= 1) *(u32x2*)uaddr(n, mt) = (u32x2){pk2(O[mt][0], O[mt][1]), pk2(O[mt][2], O[mt][3])};
        }
#pragma unroll
        for (int mt = 0; mt < 4; ++mt)
#pragma unroll
            for (int r = 0; r < 4; ++r) Vn[mt][r] *= __expf(gl - gcl[16 * mt + 4 * g + r]);
        vf[0] = pack8(Vn[0], Vn[1]); vf[1] = pack8(Vn[2], Vn[3]);
#pragma unroll
        for (int mt = 0; mt < 8; ++mt) {
            const int row = 16 * mt + r16;
            f32x4 acc = S[mt] * gtot;
#pragma unroll
            for (int kb = 0; kb < 2; ++kb) {
                const bf16x8 kf = ld2x8(smem + SC_KNT + swz128_8(row, 8 * kb + g), smem + SC_KNT + swz128_8(row, 8 * kb + 4 + g));
                acc = MFMA16(kf, vf[kb], acc);
            }
            S[mt] = acc;
        }
    }
    __syncthreads();
}

constexpr int AT_BUF = 32768, AT_MISC = 65536, NQB = SEQ / 128, AT_UNITS = 8 * NQB;
DI int vt_off8(int e, int s) { return e * 128 + ((s ^ ((e >> 1) & 15)) << 3); }

DI void attention_unit(const Params& p, char* smem, int head, int qb, float lam) {
    const int tid = fresh_tid(), lane = tid & 63, wave = tid >> 6, r32 = lane & 31, h = lane >> 5;
    const int wq = wave & 3, mp = wave >> 2;
    unsigned char* ws = p.ws;
    const bf16* AK = (const bf16*)p.out; const bf16* AVT = (const bf16*)p.out + (size_t)SEQ * D;
    const int q0 = 128 * qb, qpos = q0 + 32 * wq + r32;
    const float c1 = 0.125f * LOG2E, c2 = exp2f(-(float)(head + 1)) * LOG2E;
    bf16x8 Qf[4];
    {
        const bf16* qsrc = (const bf16*)(ws + OFF_AQ) + (size_t)qpos * D + head * 128 + mp * 64 + 8 * h;
#pragma unroll
        for (int ks = 0; ks < 4; ++ks) {
            const u32x4 v = *(const u32x4*)(qsrc + 16 * ks); u32x4 o;
            o.x = pk2(bflo(v.x) * c1, bfhi(v.x) * c1); o.y = pk2(bflo(v.y) * c1, bfhi(v.y) * c1); o.z = pk2(bflo(v.z) * c1, bfhi(v.z) * c1); o.w = pk2(bflo(v.w) * c1, bfhi(v.w) * c1);
            Qf[ks] = __builtin_bit_cast(bf16x8, o);
        }
    }
    f32x16 O[4];
#pragma unroll
    for (int i = 0; i < 4; ++i) O[i] = zero16();
    float m_run = -1e30f, l_run = 0.f;
    const int ntiles = 2 * qb + 3;
    const int kkey = tid >> 3, kcc = (tid & 7) * 2;
    const int ve = tid >> 2, vcc = (tid & 3) * 2;
    u32x4 rk[2], rv[2];
    auto gload = [&](int it) {
        const int kt = 2 * qb + 1 - it;
        if (kt >= 0) {
            const bf16* ks = AK + ((size_t)kt * 64 + kkey) * D + head * 128 + kcc * 8;
            rk[0] = *(const u32x4*)ks; rk[1] = *(const u32x4*)(ks + 8);
            const bf16* vs = AVT + ((size_t)head * 128 + ve) * SEQ + (size_t)kt * 64 + vcc * 8;
            rv[0] = *(const u32x4*)vs; rv[1] = *(const u32x4*)(vs + 8);
        } else {
            rk[0] = rk[1] = rv[0] = rv[1] = (u32x4){0u, 0u, 0u, 0u};
            if (kkey < NMETA) { const bf16* ks = (const bf16*)(ws + OFF_SMALL + SM_AKMETA) + (size_t)kkey * D + head * 128 + kcc * 8; rk[0] = *(const u32x4*)ks; rk[1] = *(const u32x4*)(ks + 8); }
            if (vcc == 0) { const bf16* vs = (const bf16*)(ws + OFF_SMALL + SM_AVTMETA) + ((size_t)head * 128 + ve) * 16; rv[0] = *(const u32x4*)vs; rv[1] = *(const u32x4*)(vs + 8); }
        }
    };
    auto lwrite = [&](int buf) {
        char* kb = smem + buf * AT_BUF + (kcc >> 3) * 8192;
        *(u32x4*)(kb + swz128(kkey, kcc & 7)) = rk[0]; *(u32x4*)(kb + swz128(kkey, (kcc & 7) + 1)) = rk[1];
        char* vb = smem + buf * AT_BUF + 16384;
        *(u32x2*)(vb + vt_off8(ve, 2 * vcc)) = (u32x2){rv[0].x, rv[0].y}; *(u32x2*)(vb + vt_off8(ve, 2 * vcc + 1)) = (u32x2){rv[0].z, rv[0].w};
        *(u32x2*)(vb + vt_off8(ve, 2 * vcc + 2)) = (u32x2){rv[1].x, rv[1].y}; *(u32x2*)(vb + vt_off8(ve, 2 * vcc + 3)) = (u32x2){rv[1].z, rv[1].w};
    };
    gload(0); lwrite(0); __syncthreads();
    for (int it = 0; it < ntiles; ++it) {
        const int buf = it & 1, kt = 2 * qb + 1 - it;
        if (it + 1 < ntiles) gload(it + 1);
        const bool meta = kt < 0;
        const int k0 = kt * 64;
        const bool skip = !meta && (k0 > q0 + 32 * wq + 31);
        if (!skip) {
            const char* kb = smem + buf * AT_BUF + mp * 8192;
            const char* vb = smem + buf * AT_BUF + 16384;
            const bool need_mask = !meta && (k0 + 63 > q0 + 32 * wq);
            f32x16 s[2];
            float mx = -1e30f;
#pragma unroll
            for (int sub = 0; sub < 2; ++sub) {
                f32x16 acc;
                const float base = meta ? -c2 * (float)(NMETA + qpos - 32 * sub - 4 * h) : -c2 * (float)(qpos - k0 - 32 * sub - 4 * h);
#pragma unroll
                for (int r = 0; r < 16; ++r) acc[r] = base + c2 * (float)((r & 3) + 8 * (r >> 2));
#pragma unroll
                for (int ks = 0; ks < 4; ++ks) {
                    const bf16x8 a = *(const bf16x8*)(kb + swz128(32 * sub + r32, 2 * ks + h));
                    acc = MFMA32(a, Qf[ks], acc);
                }
                if (meta) {
#pragma unroll
                    for (int r = 0; r < 16; ++r) { const int key = 32 * sub + (r & 3) + 8 * (r >> 2) + 4 * h; if (key >= NMETA) acc[r] = -1e30f; }
                } else if (need_mask) {
#pragma unroll
                    for (int r = 0; r < 16; ++r) { const int key = k0 + 32 * sub + (r & 3) + 8 * (r >> 2) + 4 * h; if (key > qpos) acc[r] = -1e30f; }
                }
#pragma unroll
                for (int r = 0; r < 16; ++r) mx = fmaxf(mx, acc[r]);
                s[sub] = acc;
            }
            mx = fmaxf(mx, __shfl_xor(mx, 32));
            const float m_new = fmaxf(m_run, mx);
            const float alpha = EXP2F(m_run - m_new);
            m_run = m_new;
            float ls = 0.f;
#pragma unroll
            for (int sub = 0; sub < 2; ++sub)
#pragma unroll
                for (int r = 0; r < 16; ++r) { const float pv = EXP2F(s[sub][r] - m_new); s[sub][r] = pv; ls += pv; }
            l_run = l_run * alpha + ls;
#pragma unroll
            for (int et = 0; et < 4; ++et) O[et] = O[et] * alpha;
            bf16x8 Pf[2][2];
#pragma unroll
            for (int sub = 0; sub < 2; ++sub)
#pragma unroll
                for (int ss = 0; ss < 2; ++ss) {
                    u32x4 o; o.x = pk2(s[sub][8 * ss], s[sub][8 * ss + 1]); o.y = pk2(s[sub][8 * ss + 2], s[sub][8 * ss + 3]);
                    o.z = pk2(s[sub][8 * ss + 4], s[sub][8 * ss + 5]); o.w = pk2(s[sub][8 * ss + 6], s[sub][8 * ss + 7]);
                    Pf[sub][ss] = __builtin_bit_cast(bf16x8, o);
                }
#pragma unroll
            for (int et = 0; et < 4; ++et) {
                const int e = 32 * et + r32;
#pragma unroll
                for (int sub = 0; sub < 2; ++sub)
#pragma unroll
                    for (int ss = 0; ss < 2; ++ss) {
                        const int sl = 8 * sub + 4 * ss + h;
                        const bf16x8 a = ld2x8(vb + vt_off8(e, sl), vb + vt_off8(e, sl + 2));
                        O[et] = MFMA32(a, Pf[sub][ss], O[et]);
                    }
                SCHED_FENCE();
            }
        }
        if (it + 1 < ntiles) lwrite(buf ^ 1);
        __syncthreads();
    }
    {
        const float lt = l_run + __shfl_xor(l_run, 32);
        const float inv = 1.0f / lt;
        float* X = (float*)smem;
        if (mp == 1) {
#pragma unroll
            for (int et = 0; et < 4; ++et)
#pragma unroll
                for (int r = 0; r < 16; ++r) { const int e = 32 * et + (r & 3) + 8 * (r >> 2) + 4 * h; X[(wq * 128 + e) * 32 + r32] = O[et][r] * inv; }
        }
        __syncthreads();
        if (mp == 0) {
            float ssq = 0.f;
#pragma unroll
            for (int et = 0; et < 4; ++et)
#pragma unroll
                for (int r = 0; r < 16; ++r) { const int e = 32 * et + (r & 3) + 8 * (r >> 2) + 4 * h; const float d = O[et][r] * inv - lam * X[(wq * 128 + e) * 32 + r32]; O[et][r] = d; ssq += d * d; }
            ssq += __shfl_xor(ssq, 32);
            const float rstd = rsqrtf(ssq * (1.0f / 128.0f) + NORM_EPS) * 0.8f;
            bf16* dst = (bf16*)(ws + OFF_AQ) + (size_t)qpos * D + head * 128;
            const float* sw = p.in[8];
#pragma unroll
            for (int et = 0; et < 4; ++et)
#pragma unroll
                for (int q4 = 0; q4 < 4; ++q4) {
                    const int e0 = 32 * et + 8 * q4 + 4 * h;
                    const f32x4 w4 = *(const f32x4*)(sw + e0);
                    *(u32x2*)(dst + e0) = (u32x2){pk2(O[et][4 * q4] * rstd * w4[0], O[et][4 * q4 + 1] * rstd * w4[1]), pk2(O[et][4 * q4 + 2] * rstd * w4[2], O[et][4 * q4 + 3] * rstd * w4[3])};
                }
        }
        __syncthreads();
    }
}

DI void phase3(const Params& p, char* smem, int bid, int nblk) {
    for (int hh = bid; hh < 8; hh += nblk) scan_head(p, smem, hh);
    float d1 = 0.f, d2 = 0.f;
    for (int i = 0; i < 64; ++i) { d1 += p.in[4][i] * p.in[5][i]; d2 += p.in[6][i] * p.in[7][i]; }
    const float lam = __expf(d1) - __expf(d2) + 0.2f;
    unsigned* q = (unsigned*)(p.ws + OFF_SMALL + SM_CTL) + CW_ATTQ;
    for (;;) {
        if (threadIdx.x == 0) *(unsigned*)(smem + AT_MISC) = atomicAdd(q, 1u);
        __syncthreads();
        const unsigned u = *(unsigned*)(smem + AT_MISC);
        __syncthreads();
        if (u >= (unsigned)AT_UNITS) break;
        attention_unit(p, smem, (int)(u & 7u), NQB - 1 - (int)(u >> 3), lam);
    }
}

DI void phase4(const Params& p, char* smem, int bid, int nblk) {
    const int tid = fresh_tid(), lane = tid & 63, wave = tid >> 6;
    const int gw = bid * 8 + wave, NGW = nblk * 8;
    unsigned char* ws = p.ws;
    char* wl = smem + wave * 16384;
    for (int it = gw; it < 32 * 384; it += NGW) {
        const int e = it / 384, r = it % 384, m = r >> 7, q = r & 127;
        if (m < 2) transpose_item(p.in[21 + m] + (size_t)e * 1024 * 256, 256, 1024, (bf16*)(ws + (m == 0 ? OFF_EXG : OFF_EXU)) + (size_t)e * 256 * 1024, (q >> 3) * 64, (q & 7) * 32, (q & 7) * 32, (float*)wl, lane);
        else transpose_item(p.in[23] + (size_t)e * 256 * 1024, 1024, 256, (bf16*)(ws + OFF_EXD) + (size_t)e * 1024 * 256, (q >> 5) * 64, (q & 31) * 32, (q & 31) * 32, (float*)wl, lane);
    }
    for (int it = gw; it < (NCH - 1) * 8; it += NGW) {
        const int cm1 = it >> 3, head = it & 7;
        const bf16* reg = (const bf16*)(ws + OFF_V) + (size_t)cm1 * 64 * D + head * 128;
#pragma unroll 4
        for (int i = 0; i < 16; ++i) { const int row = i * 4 + (lane >> 4), ch = lane & 15; *(u32x4*)(wl + row * 256 + ch * 16) = *(const u32x4*)(reg + (size_t)row * D + ch * 8); }
        WAVE_SYNC();
        float ss = 0.f;
#pragma unroll 8
        for (int dv = 0; dv < 128; ++dv) { const float v = bf2f(*(const bf16*)(wl + (dv >> 1) * 256 + ((dv & 1) * 64 + lane) * 2)); ss += v * v; }
        const float rstd = rsqrtf(ss * (1.0f / 128.0f) + NORM_EPS);
        const size_t j = (size_t)cm1 * 64 + lane;
        const bf16* gsrc = (const bf16*)(ws + OFF_DG) + j * D + head * 128;
        bf16* dst = (bf16*)(ws + OFF_OD) + j * D + head * 128;
#pragma unroll 2
        for (int d8 = 0; d8 < 16; ++d8) {
            const u32x4 gv = *(const u32x4*)(gsrc + 8 * d8);
            const f32x4 w0 = *(const f32x4*)(p.in[12] + 8 * d8), w1 = *(const f32x4*)(p.in[12] + 8 * d8 + 4);
            float o[8];
#pragma unroll
            for (int c = 0; c < 8; ++c) { const int dv = 8 * d8 + c; o[c] = bf2f(*(const bf16*)(wl + (dv >> 1) * 256 + ((dv & 1) * 64 + lane) * 2)) * rstd; }
            o[0] *= w0[0] * siluf_(bflo(gv.x)); o[1] *= w0[1] * siluf_(bfhi(gv.x)); o[2] *= w0[2] * siluf_(bflo(gv.y)); o[3] *= w0[3] * siluf_(bfhi(gv.y));
            o[4] *= w1[0] * siluf_(bflo(gv.z)); o[5] *= w1[1] * siluf_(bfhi(gv.z)); o[6] *= w1[2] * siluf_(bflo(gv.w)); o[7] *= w1[3] * siluf_(bfhi(gv.w));
            *(u32x4*)(dst + 8 * d8) = (u32x4){pk2(o[0], o[1]), pk2(o[2], o[3]), pk2(o[4], o[5]), pk2(o[6], o[7])};
        }
        WAVE_SYNC();
    }
}

template <int NB, int NI>
DI void rowgemm64(const bf16* arow, const bf16* const (&bptr)[NB], char* stg, f32x16 (&acc)[NB][2][NI]) {
    const int tid = fresh_tid(), lane = tid & 63, r32 = lane & 31, h = lane >> 5;
    const int lrow = tid >> 3, lc = tid & 7;
    u32x4 ra = arow ? *(const u32x4*)arow : (u32x4){0u, 0u, 0u, 0u};
    *(u32x4*)(stg + swz128(lrow, lc)) = ra;
    __syncthreads();
    for (int kc = 0; kc < 16; ++kc) {
        const int buf = kc & 1;
        if (kc + 1 < 16) ra = arow ? *(const u32x4*)(arow + (kc + 1) * 64) : (u32x4){0u, 0u, 0u, 0u};
#pragma unroll
        for (int ks = 0; ks < 4; ++ks) {
            bf16x8 af[2];
#pragma unroll
            for (int mi = 0; mi < 2; ++mi) af[mi] = *(const bf16x8*)(stg + buf * 8192 + swz128(32 * mi + r32, 2 * ks + h));
#pragma unroll
            for (int b = 0; b < NB; ++b)
#pragma unroll
                for (int ni = 0; ni < NI; ++ni) {
                    const bf16x8 bfr = *(const bf16x8*)(bptr[b] + (size_t)ni * 32 * 1024 + kc * 64 + ks * 16);
#pragma unroll
                    for (int mi = 0; mi < 2; ++mi) acc[b][mi][ni] = MFMA32(af[mi], bfr, acc[b][mi][ni]);
                }
        }
        if (kc + 1 < 16) *(u32x4*)(stg + (buf ^ 1) * 8192 + swz128(lrow, lc)) = ra;
        __syncthreads();
    }
}

constexpr int P5_MIX = 0, P5_PITCH = 2064, P5_STG = 64 * P5_PITCH, P5_MISC = P5_STG + 16384;
DI void post_block(const Params& p, char* smem, int rb) {
    int tid_ = threadIdx.x;
#ifndef EMU
    asm volatile("" : "+v"(tid_));
#endif
    const int tid = tid_, lane = tid & 63, wave = tid >> 6, r32 = lane & 31, h = lane >> 5;
    unsigned char* ws = p.ws;
    const int row0 = rb * 64, lrow = tid >> 3, lc = tid & 7;
    const bf16* Wt_in = (const bf16*)(ws + OFF_WTIN);
    char* stg = smem + P5_STG;
#pragma unroll 1
    for (int ps = 0; ps < 4; ++ps) {
        const int n0 = 128 * wave + 32 * ps + r32;
        f32x16 G[2][2][1];
#pragma unroll
        for (int b = 0; b < 2; ++b)
#pragma unroll
            for (int mi = 0; mi < 2; ++mi) G[b][mi][0] = zero16();
        {
            const bf16* const bp[2] = {Wt_in + (size_t)(7168 + n0) * 1024 + 8 * h, Wt_in + (size_t)(8192 + n0) * 1024 + 8 * h};
            rowgemm64<2, 1>((const bf16*)(ws + OFF_U) + (size_t)(row0 + lrow) * D + lc * 8, bp, stg, G);
        }
#pragma unroll
        for (int b = 0; b < 2; ++b)
#pragma unroll
            for (int mi = 0; mi < 2; ++mi)
#pragma unroll
                for (int r = 0; r < 16; ++r) G[b][mi][0][r] = sigmoidf_(G[b][mi][0][r]);
#pragma unroll 1
        for (int br = 0; br < 2; ++br) {
            f32x16 Y[1][2][1];
#pragma unroll
            for (int mi = 0; mi < 2; ++mi) Y[0][mi][0] = zero16();
            const bf16* const bp[1] = {(const bf16*)(ws + (br == 0 ? OFF_WTBA : OFF_WTBD)) + (size_t)n0 * 1024 + 8 * h};
            rowgemm64<1, 1>((const bf16*)(ws + (br == 0 ? OFF_AQ : OFF_OD)) + (size_t)(row0 + lrow) * D + lc * 8, bp, stg, Y);
            if (br == 0) {
#pragma unroll
                for (int mi = 0; mi < 2; ++mi) G[0][mi][0] = G[0][mi][0] * Y[0][mi][0];
            } else {
#pragma unroll
                for (int mi = 0; mi < 2; ++mi) G[0][mi][0] = G[0][mi][0] + G[1][mi][0] * Y[0][mi][0];
            }
        }
#pragma unroll
        for (int mi = 0; mi < 2; ++mi)
#pragma unroll
            for (int r = 0; r < 16; ++r) {
                const int row = 32 * mi + (r & 3) + 8 * (r >> 2) + 4 * h, col = 128 * wave + 32 * ps + r32;
                *(bf16*)(smem + P5_MIX + row * P5_PITCH + col * 2) = (bf16)f2bf(G[0][mi][0][r]);
            }
    }
    __syncthreads();
    float* partial = (float*)(smem + P5_MISC); float* rstdl = (float*)(smem + P5_MISC + 2048); float* logl = (float*)(smem + P5_MISC + 2048 + 256);
    {
        float rs[2][16];
#pragma unroll
        for (int mi = 0; mi < 2; ++mi)
#pragma unroll
            for (int r = 0; r < 16; ++r) rs[mi][r] = 0.f;
#pragma unroll 1
        for (int ps = 0; ps < 2; ++ps) {
            f32x16 H[2][2];
#pragma unroll
            for (int mi = 0; mi < 2; ++mi)
#pragma unroll
                for (int ni = 0; ni < 2; ++ni) H[mi][ni] = zero16();
            const bf16* bp = (const bf16*)(ws + OFF_WTOUT) + (size_t)(128 * wave + 64 * ps + r32) * 1024 + 8 * h;
#pragma unroll 2
            for (int ks = 0; ks < 64; ++ks) {
                bf16x8 af[2];
#pragma unroll
                for (int mi = 0; mi < 2; ++mi) af[mi] = *(const bf16x8*)(smem + P5_MIX + (32 * mi + r32) * P5_PITCH + (2 * ks + h) * 16);
#pragma unroll
                for (int ni = 0; ni < 2; ++ni) {
                    const bf16x8 bfr = *(const bf16x8*)(bp + (size_t)ni * 32 * 1024 + ks * 16);
#pragma unroll
                    for (int mi = 0; mi < 2; ++mi) H[mi][ni] = MFMA32(af[mi], bfr, H[mi][ni]);
                }
            }
#pragma unroll
            for (int mi = 0; mi < 2; ++mi)
#pragma unroll
                for (int ni = 0; ni < 2; ++ni)
#pragma unroll
                    for (int r = 0; r < 16; ++r) {
                        const int row = 32 * mi + (r & 3) + 8 * (r >> 2) + 4 * h, col = 128 * wave + 64 * ps + 32 * ni + r32;
                        const float hv = H[mi][ni][r] + p.in[0][(size_t)(row0 + row) * D + col];
                        rs[mi][r] += hv * hv;
                        p.out[(size_t)(row0 + row) * D + col] = hv;
                    }
        }
#pragma unroll
        for (int mi = 0; mi < 2; ++mi)
#pragma unroll
            for (int r = 0; r < 16; ++r) {
                float v = rs[mi][r];
                v += __shfl_xor(v, 1); v += __shfl_xor(v, 2); v += __shfl_xor(v, 4); v += __shfl_xor(v, 8); v += __shfl_xor(v, 16);
                if (r32 == 0) partial[(32 * mi + (r & 3) + 8 * (r >> 2) + 4 * h) * 8 + wave] = v;
            }
    }
    __threadfence();
    __syncthreads();
    if (tid < 64) { float s = 0.f;
#pragma unroll
        for (int w = 0; w < 8; ++w) s += partial[tid * 8 + w];
        rstdl[tid] = rsqrtf(s * (1.0f / D) + NORM_EPS); }
    __syncthreads();
#pragma unroll 2
    for (int i = 0; i < 16; ++i) {
        const int idx = tid + NT * i, row = idx >> 7, ch = idx & 127;
        const float* hp = p.out + (size_t)(row0 + row) * D + ch * 8;
        const f32x4 a = LD_NT((const f32x4*)hp), b = LD_NT((const f32x4*)(hp + 4));
        const f32x4 w0 = *(const f32x4*)(p.in[16] + ch * 8), w1 = *(const f32x4*)(p.in[16] + ch * 8 + 4);
        const float rs = rstdl[row];
        *(u32x4*)((bf16*)(ws + OFF_OD) + (size_t)(row0 + row) * D + ch * 8) =
            (u32x4){pk2(a[0] * rs * w0[0], a[1] * rs * w0[1]), pk2(a[2] * rs * w0[2], a[3] * rs * w0[3]), pk2(b[0] * rs * w1[0], b[1] * rs * w1[1]), pk2(b[2] * rs * w1[2], b[3] * rs * w1[3])};
    }
    float lg[36];
#pragma unroll
    for (int c = 0; c < 36; ++c) lg[c] = 0.f;
    float* HL = (float*)(smem + P5_MIX);
    const float* WR = (const float*)(ws + OFF_SMALL + SM_WR);
#pragma unroll 1
    for (int half = 0; half < 2; ++half) {
        __syncthreads();
#pragma unroll 4
        for (int i = 0; i < 16; ++i) {
            const int idx = tid + NT * i, row = idx >> 7, c4 = idx & 127;
            const f32x4 a = LD_NT((const f32x4*)(p.out + (size_t)(row0 + row) * D + 512 * half + c4 * 4));
            float* d = HL + row * 513 + c4 * 4; d[0] = a[0]; d[1] = a[1]; d[2] = a[2]; d[3] = a[3];
        }
        __syncthreads();
        const int kb = 64 * wave;
#pragma unroll 1
        for (int kk = 0; kk < 64; ++kk) {
            const float hv = HL[lane * 513 + kb + kk];
            const float* wr = WR + (size_t)(512 * half + kb + kk) * 40;
#pragma unroll
            for (int c = 0; c < 36; ++c) lg[c] += hv * wr[c];
        }
    }
    __syncthreads();
    float* PL = (float*)(smem + P5_MIX);
#pragma unroll
    for (int c = 0; c < 36; ++c) PL[(lane * 8 + wave) * 36 + c] = lg[c];
    __syncthreads();
    if (tid < 64) {
        const float rs = rstdl[tid];
        for (int c = 0; c < 36; ++c) { float s = 0.f; for (int w = 0; w < 8; ++w) s += PL[(tid * 8 + w) * 36 + c]; logl[tid * 40 + c] = s * rs + (c < 4 ? p.in[18][c] : p.in[20][c - 4]); }
        const float* L = logl + tid * 40;
        int gi = 0; float gm = L[0];
        for (int c = 1; c < 4; ++c) if (L[c] > gm) { gm = L[c]; gi = c; }
        float gs = 0.f; for (int c = 0; c < 4; ++c) gs += __expf(L[c] - gm);
        const float gw = 1.0f / gs;
        const float* E = L + 4 + 8 * gi;
        int i1 = 0; float l1 = E[0];
        for (int c = 1; c < 8; ++c) if (E[c] > l1) { l1 = E[c]; i1 = c; }
        int i2 = -1; float l2 = -3.0e38f;
        for (int c = 0; c < 8; ++c) if (c != i1 && E[c] > l2) { l2 = E[c]; i2 = c; }
        const float t = __expf(l2 - l1), w1 = 1.0f / (1.0f + t), w2 = t / (1.0f + t);
        unsigned* cnt = (unsigned*)(ws + OFF_SMALL + SM_CTL) + CW_ECNT;
        int* lists = (int*)(ws + OFF_SMALL + SM_TAILS); float* RW = (float*)(ws + OFF_SMALL + SM_RW);
        const int j = row0 + tid;
        const int e1 = 8 * gi + i1, e2 = 8 * gi + i2;
        const unsigned p1 = atomicAdd(cnt + e1, 1u); lists[(size_t)e1 * SEQ + p1] = (j << 1); RW[2 * j] = gw * w1;
        const unsigned p2 = atomicAdd(cnt + e2, 1u); lists[(size_t)e2 * SEQ + p2] = (j << 1) | 1; RW[2 * j + 1] = gw * w2;
    }
    __syncthreads();
}
DI void phase5(const Params& p, char* smem, int bid, int nblk) {
    for (int rb = bid; rb < SEQ / 64; rb += nblk) post_block(p, smem, rb);
}

constexpr int P6_HL = 0, P6_PITCH = 528, P6_STG = 64 * P6_PITCH, P6_TOK = P6_STG + 16384, P6_RW = P6_TOK + 256, P6_TS = P6_RW + 256;
DI void moe_item(const Params& p, char* smem, int e, int mt, int cnt_e) {
    const int tid = fresh_tid(), lane = tid & 63, wave = tid >> 6, r32 = lane & 31, h = lane >> 5;
    unsigned char* ws = p.ws;
    int* tokl = (int*)(smem + P6_TOK); float* rwl = (float*)(smem + P6_RW);
    if (tid < 64) {
        const int idx = 64 * mt + tid; int ent = -1; float w = 0.f;
        if (idx < cnt_e) { ent = ((const int*)(ws + OFF_SMALL + SM_TAILS))[(size_t)e * SEQ + idx]; w = ((const float*)(ws + OFF_SMALL + SM_RW))[ent]; }
        tokl[tid] = ent; rwl[tid] = w;
    }
    __syncthreads();
    const int lrow = tid >> 3, lc = tid & 7;
    const int lent = tokl[lrow];
    f32x16 GU[2][2][1];
#pragma unroll
    for (int b = 0; b < 2; ++b)
#pragma unroll
        for (int mi = 0; mi < 2; ++mi) GU[b][mi][0] = zero16();
    {
        const bf16* const bp[2] = {(const bf16*)(ws + OFF_EXG) + ((size_t)e * 256 + 32 * wave + r32) * 1024 + 8 * h, (const bf16*)(ws + OFF_EXU) + ((size_t)e * 256 + 32 * wave + r32) * 1024 + 8 * h};
        rowgemm64<2, 1>(lent >= 0 ? (const bf16*)(ws + OFF_OD) + (size_t)(lent >> 1) * D + lc * 8 : nullptr, bp, smem + P6_STG, GU);
    }
#pragma unroll
    for (int mi = 0; mi < 2; ++mi)
#pragma unroll
        for (int r = 0; r < 16; ++r) {
            const int row = 32 * mi + (r & 3) + 8 * (r >> 2) + 4 * h, col = 32 * wave + r32;
            *(bf16*)(smem + P6_HL + row * P6_PITCH + col * 2) = (bf16)f2bf(siluf_(GU[0][mi][0][r]) * GU[1][mi][0][r]);
        }
    __syncthreads();
#pragma unroll 1
    for (int ps = 0; ps < 2; ++ps) {
        f32x16 Y[2][2];
#pragma unroll
        for (int mi = 0; mi < 2; ++mi)
#pragma unroll
            for (int ni = 0; ni < 2; ++ni) Y[mi][ni] = zero16();
        const bf16* bp = (const bf16*)(ws + OFF_EXD) + ((size_t)e * 1024 + 128 * wave + 64 * ps + r32) * 256 + 8 * h;
#pragma unroll 4
        for (int ks = 0; ks < 16; ++ks) {
            bf16x8 af[2];
#pragma unroll
            for (int mi = 0; mi < 2; ++mi) af[mi] = *(const bf16x8*)(smem + P6_HL + (32 * mi + r32) * P6_PITCH + (2 * ks + h) * 16);
#pragma unroll
            for (int ni = 0; ni < 2; ++ni) {
                const bf16x8 bfr = *(const bf16x8*)(bp + (size_t)ni * 32 * 256 + ks * 16);
#pragma unroll
                for (int mi = 0; mi < 2; ++mi) Y[mi][ni] = MFMA32(af[mi], bfr, Y[mi][ni]);
            }
        }
#pragma unroll
        for (int mi = 0; mi < 2; ++mi)
#pragma unroll
            for (int r = 0; r < 16; ++r) {
                const int row = 32 * mi + (r & 3) + 8 * (r >> 2) + 4 * h; const int ent = tokl[row];
                if (ent >= 0) {
                    const float w = rwl[row]; bf16* dst = (bf16*)(ws + OFF_Y) + (size_t)ent * D + 128 * wave + 64 * ps + r32;
#pragma unroll
                    for (int ni = 0; ni < 2; ++ni) dst[32 * ni] = (bf16)f2bf(Y[mi][ni][r] * w);
                }
            }
    }
    __syncthreads();
}
DI void phase6(const Params& p, char* smem, int bid, int nblk) {
    int* ts = (int*)(smem + P6_TS);
    unsigned* cnt = (unsigned*)(p.ws + OFF_SMALL + SM_CTL) + CW_ECNT;
    int* tc = (int*)(smem + P6_TS + 256);
    if (threadIdx.x < 32) tc[threadIdx.x] = (int)LD_ATOMIC(cnt + threadIdx.x);
    __syncthreads();
    if (threadIdx.x == 0) { int s = 0; for (int e = 0; e < 32; ++e) { ts[e] = s; s += (tc[e] + 63) >> 6; } ts[32] = s; }
    __syncthreads();
    const int total = ts[32];
    for (int t = bid; t < total; t += nblk) {
        int e = 0;
        for (int q = 1; q < 32; ++q) if (ts[q] <= t) e = q;
        moe_item(p, smem, e, t - ts[e], tc[e]);
    }
}

DI void phase7(const Params& p, char* smem, int bid, int nblk) {
    const int tid = fresh_tid(), lane = tid & 63, wave = tid >> 6;
    const int gw = bid * 8 + wave, NGW = nblk * 8;
    for (int j = gw; j < SEQ; j += NGW) {
        float* hrow = p.out + (size_t)j * D;
        const bf16* y0 = (const bf16*)(p.ws + OFF_Y) + (size_t)j * 2 * D;
        float4 v[4]; float ss = 0.f;
#pragma unroll
        for (int q = 0; q < 4; ++q) {
            const int c = 4 * lane + 256 * q;
            v[q] = *(const float4*)(hrow + c);
            const u32x2 a = *(const u32x2*)(y0 + c), b = *(const u32x2*)(y0 + D + c);
            v[q].x += bflo(a.x) + bflo(b.x); v[q].y += bfhi(a.x) + bfhi(b.x); v[q].z += bflo(a.y) + bflo(b.y); v[q].w += bfhi(a.y) + bfhi(b.y);
            ss += v[q].x * v[q].x + v[q].y * v[q].y + v[q].z * v[q].z + v[q].w * v[q].w;
        }
        ss = wave_sum(ss);
        const float rstd = rsqrtf(ss * (1.0f / D) + NORM_EPS);
#pragma unroll
        for (int q = 0; q < 4; ++q) {
            const int c = 4 * lane + 256 * q; const float4 w4 = *(const float4*)(p.in[24] + c);
            *(float4*)(hrow + c) = make_float4(v[q].x * rstd * w4.x, v[q].y * rstd * w4.y, v[q].z * rstd * w4.z, v[q].w * rstd * w4.w);
        }
    }
}

__global__ void __launch_bounds__(NT) k_phase0(Params p) { SMEM_DECL; phase0(p, smem, blockIdx.x, gridDim.x); }
__global__ void __launch_bounds__(NT) k_phase1(Params p) { SMEM_DECL; phase1(p, smem, blockIdx.x, gridDim.x); }
__global__ void __launch_bounds__(NT) k_phase2(Params p) { SMEM_DECL; phase2(p, smem, blockIdx.x, gridDim.x); }
__global__ void __launch_bounds__(NT) k_phase3(Params p) { SMEM_DECL; phase3(p, smem, blockIdx.x, gridDim.x); }
__global__ void __launch_bounds__(NT) k_phase4(Params p) { SMEM_DECL; phase4(p, smem, blockIdx.x, gridDim.x); }
__global__ void __launch_bounds__(NT) k_phase5(Params p) { SMEM_DECL; phase5(p, smem, blockIdx.x, gridDim.x); }
__global__ void __launch_bounds__(NT) k_phase6(Params p) { SMEM_DECL; phase6(p, smem, blockIdx.x, gridDim.x); }
__global__ void __launch_bounds__(NT) k_phase7(Params p) { SMEM_DECL; phase7(p, smem, blockIdx.x, gridDim.x); }

constexpr int LDS_BYTES = 160 * 1024 - 256;

#ifdef EMU
#define GRID_SYNC() emu_grid_sync()
#else
#define GRID_SYNC() do { \
    asm volatile("s_waitcnt vmcnt(0)" ::: "memory"); \
    __syncthreads(); \
    cooperative_groups::this_grid().sync(); \
    if (threadIdx.x == 0) { __builtin_amdgcn_fence(__ATOMIC_ACQUIRE, "agent"); asm volatile("s_waitcnt vmcnt(0)" ::: "memory"); } \
    __syncthreads(); \
} while (0)
#endif
__global__ void __launch_bounds__(NT) fwd_megakernel(Params p) {
    SMEM_DECL;
    const int bid = blockIdx.x, nblk = gridDim.x;
    phase0(p, smem, bid, nblk); GRID_SYNC();
    phase1(p, smem, bid, nblk); GRID_SYNC();
    phase2(p, smem, bid, nblk); GRID_SYNC();
    phase3(p, smem, bid, nblk); GRID_SYNC();
    phase4(p, smem, bid, nblk); GRID_SYNC();
    phase5(p, smem, bid, nblk); GRID_SYNC();
    phase6(p, smem, bid, nblk); GRID_SYNC();
    phase7(p, smem, bid, nblk);
}

#ifndef EMU
extern "C" void kernel_launch(void* const* d_in, const int* in_sizes, int n_in, void* d_out, int out_size, void* d_ws, size_t ws_size, hipStream_t stream) {
    static int grid = 0;
    if (grid == 0) {
        if (n_in != 25 || ws_size < WS_END || out_size != SEQ * D) { fprintf(stderr, "kernel_launch: unexpected problem (n_in %d, ws %zu, out %d)\n", n_in, ws_size, out_size); grid = -1; return; }
        int dev = 0, cus = 0, per_cu = 0;
        (void)hipGetDevice(&dev);
        (void)hipDeviceGetAttribute(&cus, hipDeviceAttributeMultiprocessorCount, dev);
        (void)hipFuncSetAttribute((const void*)fwd_megakernel, hipFuncAttributeMaxDynamicSharedMemorySize, LDS_BYTES);
        (void)hipOccupancyMaxActiveBlocksPerMultiprocessor(&per_cu, (const void*)fwd_megakernel, NT, LDS_BYTES);
        if (per_cu < 1) { fprintf(stderr, "kernel_launch: occupancy query returned %d\n", per_cu); per_cu = 1; }
        grid = cus * per_cu;
    }
    if (grid < 0) return;
    Params p{};
    for (int i = 0; i < 25; ++i) p.in[i] = (const float*)d_in[i];
    p.out = (float*)d_out; p.ws = (unsigned char*)d_ws;
    void* args[] = {&p};
    hipError_t e = hipLaunchCooperativeKernel((const void*)fwd_megakernel, dim3(grid), dim3(NT), args, LDS_BYTES, stream);
    if (e != hipSuccess) fprintf(stderr, "cooperative launch failed: %s (grid %d)\n", hipGetErrorString(e), grid);
}
#endif

#ifdef EMU
static void run_phases(Params p, int upto, int grid) {
    if (upto == 100) { emu::launch([=] { fwd_megakernel(p); }, grid, NT, LDS_BYTES, true); return; }
    if (upto >= 0) emu::launch([=] { k_phase0(p); }, grid, NT, LDS_BYTES, false);
    if (upto >= 1) emu::launch([=] { k_phase1(p); }, grid, NT, LDS_BYTES, false);
    if (upto >= 2) emu::launch([=] { k_phase2(p); }, grid, NT, LDS_BYTES, false);
    if (upto >= 3) emu::launch([=] { k_phase3(p); }, grid, NT, LDS_BYTES, false);
    if (upto >= 4) emu::launch([=] { k_phase4(p); }, grid, NT, LDS_BYTES, false);
    if (upto >= 5) emu::launch([=] { k_phase5(p); }, grid, NT, LDS_BYTES, false);
    if (upto >= 6) emu::launch([=] { k_phase6(p); }, grid, NT, LDS_BYTES, false);
    if (upto >= 7) emu::launch([=] { k_phase7(p); }, grid, NT, LDS_BYTES, false);
}
#endif
```

```cpp
#ifndef EMU
#include <hip/hip_runtime.h>
#include <hip/hip_cooperative_groups.h>
#include <cstdio>
#include <cstdint>
#include <cmath>
#endif

#ifndef SEQ
#define SEQ 16384
#endif

typedef unsigned short bf16;
typedef short bf16x8 __attribute__((ext_vector_type(8)));
typedef short bf16x4 __attribute__((ext_vector_type(4)));
typedef float f32x16 __attribute__((ext_vector_type(16)));
typedef float f32x4 __attribute__((ext_vector_type(4)));
typedef unsigned u32x4 __attribute__((ext_vector_type(4)));
typedef unsigned u32x2 __attribute__((ext_vector_type(2)));

#ifdef EMU
#define MFMA32(a, b, c) emu_mfma_32x32x16((a), (b), (c))
#define MFMA16(a, b, c) emu_mfma_16x16x32((a), (b), (c))
#define DI static inline
#define EXP2F(x) exp2f(x)
#define WAVE_SYNC() emu_wave_sync()
#define LD_NT(p) (*(p))
#define LD_ATOMIC(p) (*(p))
#define ST_ATOMIC(p, v) (*(p) = (v))
#define SCHED_FENCE() do {} while (0)
#else
#define WAVE_SYNC() do { __builtin_amdgcn_fence(__ATOMIC_RELEASE, "wavefront"); __builtin_amdgcn_wave_barrier(); __builtin_amdgcn_fence(__ATOMIC_ACQUIRE, "wavefront"); } while (0)
#define MFMA32(a, b, c) __builtin_amdgcn_mfma_f32_32x32x16_bf16((a), (b), (c), 0, 0, 0)
#define LD_NT(p) __builtin_nontemporal_load(p)
#define LD_ATOMIC(p) __hip_atomic_load((p), __ATOMIC_RELAXED, __HIP_MEMORY_SCOPE_AGENT)
#define ST_ATOMIC(p, v) __hip_atomic_store((p), (v), __ATOMIC_RELAXED, __HIP_MEMORY_SCOPE_AGENT)
#define SCHED_FENCE() __builtin_amdgcn_sched_barrier(0)
#define MFMA16(a, b, c) __builtin_amdgcn_mfma_f32_16x16x32_bf16((a), (b), (c), 0, 0, 0)
#define DI __device__ __forceinline__
#define EXP2F(x) __builtin_amdgcn_exp2f(x)
#endif

constexpr int D = 1024;
constexpr int NMETA = 16;
constexpr int LTOK = SEQ + NMETA;
constexpr int NCH = SEQ / 64 + 1;
constexpr int NT = 512;
constexpr int W_IN_COLS = 9232;
constexpr float NORM_EPS = 1e-6f;
constexpr float LOG2E = 1.4426950408889634f;

constexpr size_t UNIT = (size_t)SEQ * D * 2;
constexpr size_t OFF_WTIN = 0;
constexpr size_t OFF_WTBA = OFF_WTIN + (size_t)9216 * 1024 * 2;
constexpr size_t OFF_WTBD = OFF_WTBA + (size_t)1024 * 1024 * 2;
constexpr size_t OFF_WTOUT = OFF_WTBD + (size_t)1024 * 1024 * 2;
constexpr size_t OFF_SMALL = OFF_WTOUT + (size_t)1024 * 1024 * 2;
constexpr size_t SM_CTL = 0;
constexpr size_t SM_UMETA = SM_CTL + 65536;
constexpr size_t SM_AKMETA = SM_UMETA + 16 * 1024 * 2;
constexpr size_t SM_AVTMETA = SM_AKMETA + 16 * 1024 * 2;
constexpr size_t SM_C0Q = SM_AVTMETA + 8 * 128 * 16 * 2;
constexpr size_t SM_C0K = SM_C0Q + 64 * 1024 * 2;
constexpr size_t SM_C0V = SM_C0K + 64 * 1024 * 2;
constexpr size_t SM_C0W = SM_C0V + 64 * 1024 * 2;
constexpr size_t SM_BETA = SM_C0W + 8 * 64 * 128 * 2;
constexpr size_t SM_G = SM_BETA + (size_t)NCH * 64 * 8 * 4;
constexpr size_t SM_GC = SM_G + (size_t)NCH * 64 * 8 * 4;
constexpr size_t SM_WR = SM_GC + (size_t)NCH * 8 * 64 * 4;
constexpr size_t SM_RIDS = SM_WR + 1024 * 40 * 4;
constexpr size_t SM_RW = SM_RIDS + 0;
constexpr size_t SM_TAILS = SM_RW + (size_t)SEQ * 2 * 4;
constexpr size_t SM_TAILS_BYTES = ((size_t)NCH * 3 * 3072 * 2 > (size_t)32 * SEQ * 4) ? (size_t)NCH * 3 * 3072 * 2 : (size_t)32 * SEQ * 4;
constexpr size_t SM_END = SM_TAILS + SM_TAILS_BYTES;
constexpr size_t SMALL_BYTES = (SM_END + 255) & ~(size_t)255;
constexpr size_t OFF_U = ((OFF_SMALL + SMALL_BYTES + (1u << 20) - 1) >> 20) << 20;
constexpr size_t OFF_W = OFF_U + UNIT;
constexpr size_t OFF_KN = OFF_W + UNIT;
constexpr size_t OFF_QN = OFF_KN + UNIT;
constexpr size_t OFF_DG = OFF_QN + UNIT;
constexpr size_t OFF_V = OFF_DG + UNIT;
constexpr size_t OFF_AQ = OFF_V + UNIT;
constexpr size_t WS_BASE_END = OFF_AQ + UNIT;
constexpr size_t EXPERT_BYTES = (size_t)32 * 3 * 1024 * 256 * 2;
constexpr size_t OFF_EXP = (2 * UNIT >= EXPERT_BYTES) ? OFF_W : WS_BASE_END;
constexpr size_t WS_END = (OFF_EXP == OFF_W) ? WS_BASE_END : WS_BASE_END + EXPERT_BYTES;
constexpr size_t OFF_EXG = OFF_EXP, OFF_EXU = OFF_EXP + EXPERT_BYTES / 3, OFF_EXD = OFF_EXP + 2 * (EXPERT_BYTES / 3);
constexpr size_t OFF_OD = OFF_QN;
constexpr size_t OFF_Y = OFF_V;
#if SEQ == 16384
static_assert(WS_END <= (size_t)256 << 20, "workspace map exceeds 256 MiB");
static_assert(EXPERT_BYTES <= 2 * UNIT, "experts fit R2+R3");
#endif
constexpr int CW_ATTQ = 64;
constexpr int CW_ECNT = 128;
constexpr int CW_BAR = 1024;

struct Params {
    const float* in[25];
    float* out;
    unsigned char* ws;
};

DI unsigned f2bf(float f) { unsigned u = __builtin_bit_cast(unsigned, f); return (u + 0x7fffu + ((u >> 16) & 1u)) >> 16; }
DI float bf2f(unsigned b) { return __builtin_bit_cast(float, (b & 0xffffu) << 16); }
DI unsigned pk2(float lo, float hi) { return f2bf(lo) | (f2bf(hi) << 16); }
DI float bflo(unsigned w) { return __builtin_bit_cast(float, w << 16); }
DI float bfhi(unsigned w) { return __builtin_bit_cast(float, w & 0xffff0000u); }
DI float sigmoidf_(float x) { return 1.0f / (1.0f + __expf(-x)); }
DI float siluf_(float x) { return x / (1.0f + __expf(-x)); }
DI float wave_sum(float v) {
#pragma unroll
    for (int o = 1; o < 64; o <<= 1) v += __shfl_xor(v, o);
    return v;
}
DI int fresh_tid() {
    int t = threadIdx.x;
#ifndef EMU
    asm volatile("" : "+v"(t));
#endif
    return t;
}
DI f32x16 zero16() { f32x16 z; for (int i = 0; i < 16; ++i) z[i] = 0.f; return z; }
DI f32x4 zero4() { f32x4 z; for (int i = 0; i < 4; ++i) z[i] = 0.f; return z; }
DI int swz128(int row, int c) { return row * 128 + ((c ^ ((row >> 1) & 7)) << 4); }
DI int swz128_8(int row, int s) { return row * 128 + ((s ^ (((row >> 1) & 7) << 1)) << 3); }
DI int swzrow(int row, int pitch, int c) { return row * pitch + ((c ^ (row & 15)) << 4); }

#ifdef EMU
#define SMEM_DECL char* smem = emu_smem()
#else
#define SMEM_DECL extern __shared__ __attribute__((aligned(16))) char smem[]
#endif

DI void transpose_item(const float* W, int ldw, int K, bf16* Wt, int k0, int src_n0, int dst_n0, float* scr, int lane) {
#pragma unroll 8
    for (int i = 0; i < 32; ++i) { const int kk = 2 * i + (lane >> 5); scr[kk * 33 + (lane & 31)] = W[(size_t)(k0 + kk) * ldw + src_n0 + (lane & 31)]; }
    WAVE_SYNC();
    const int c = lane & 7;
#pragma unroll
    for (int j = 0; j < 4; ++j) {
        const int n = (lane >> 3) + 8 * j; const float* s = scr + (8 * c) * 33 + n;
        u32x4 o; o.x = pk2(s[0 * 33], s[1 * 33]); o.y = pk2(s[2 * 33], s[3 * 33]); o.z = pk2(s[4 * 33], s[5 * 33]); o.w = pk2(s[6 * 33], s[7 * 33]);
        *(u32x4*)(Wt + (size_t)(dst_n0 + n) * K + k0 + 8 * c) = o;
    }
    WAVE_SYNC();
}

DI void phase0(const Params& p, char* smem, int bid, int nblk) {
    const int tid = fresh_tid(), lane = tid & 63, wave = tid >> 6;
    const int gw = bid * 8 + wave, NGW = nblk * 8;
    unsigned char* ws = p.ws;
    if (bid == 0) {
        unsigned* ctl = (unsigned*)(ws + OFF_SMALL + SM_CTL);
        for (int i = tid; i < 1024; i += NT) ctl[i] = 0u;
        float* be = (float*)(ws + OFF_SMALL + SM_BETA); float* gg = (float*)(ws + OFF_SMALL + SM_G);
        for (int i = tid; i < 48 * 8; i += NT) { be[i] = 0.f; gg[i] = 0.f; }
    }
    {
        float* scr = (float*)(smem + 65536) + wave * (64 * 33);
        constexpr int I_IN = 16 * (9216 / 32), I_SQ = 16 * 32;
        constexpr int NITEMS = I_IN + 3 * I_SQ;
        for (int it = gw; it < NITEMS; it += NGW) {
            int r = it;
            if (r < I_IN) { const int kb = r / 288, nb = r % 288; const int dn = nb * 32; const int sn = dn < 7168 ? dn : dn + 16;
                transpose_item(p.in[3], W_IN_COLS, 1024, (bf16*)(ws + OFF_WTIN), kb * 64, sn, dn, scr, lane); continue; }
            r -= I_IN;
            const int m = r / I_SQ; r %= I_SQ;
            const float* src = m == 0 ? p.in[13] : (m == 1 ? p.in[14] : p.in[15]);
            bf16* dst = (bf16*)(ws + (m == 0 ? OFF_WTBA : (m == 1 ? OFF_WTBD : OFF_WTOUT)));
            transpose_item(src, 1024, 1024, dst, (r / 32) * 64, (r % 32) * 32, (r % 32) * 32, scr, lane);
        }
    }
    {
        float* WR = (float*)(ws + OFF_SMALL + SM_WR);
        for (int i = bid * NT + tid; i < 1024 * 40; i += nblk * NT) {
            const int k = i / 40, c = i % 40; float v = 0.f;
            if (c < 4) v = p.in[17][k * 4 + c]; else if (c < 36) v = p.in[19][k * 32 + (c - 4)];
            WR[i] = v * p.in[16][k];
        }
    }
    float* wbd = (float*)smem;
    for (int i = tid; i < 1024 * 16; i += NT) { const int k = i >> 4, c = i & 15; wbd[i] = p.in[3][(size_t)k * W_IN_COLS + 7168 + c]; }
    __syncthreads();
    const float* nw = p.in[2];
    for (int R = gw; R < LTOK; R += NGW) {
        const float* xrow = R < NMETA ? p.in[1] + (size_t)R * D : p.in[0] + (size_t)(R - NMETA) * D;
        bf16* urow = R < NMETA ? (bf16*)(ws + OFF_SMALL + SM_UMETA) + (size_t)R * D : (bf16*)(ws + OFF_U) + (size_t)(R - NMETA) * D;
        float ss = 0.f;
#pragma unroll
        for (int j = 0; j < 4; ++j) { const float4 v = *(const float4*)(xrow + 4 * lane + 256 * j); ss += v.x * v.x + v.y * v.y + v.z * v.z + v.w * v.w; }
        ss = wave_sum(ss);
        const float rstd = rsqrtf(ss * (1.0f / D) + NORM_EPS);
        float acc[16];
#pragma unroll
        for (int c = 0; c < 16; ++c) acc[c] = 0.f;
#pragma unroll 1
        for (int j = 0; j < 4; ++j) {
            const float4 w4 = *(const float4*)(nw + 4 * lane + 256 * j);
            const float4 xv = *(const float4*)(xrow + 4 * lane + 256 * j);
            float uu[4] = {xv.x * rstd * w4.x, xv.y * rstd * w4.y, xv.z * rstd * w4.z, xv.w * rstd * w4.w};
            u32x2 o; o.x = pk2(uu[0], uu[1]); o.y = pk2(uu[2], uu[3]);
            *(u32x2*)(urow + 4 * lane + 256 * j) = o;
#pragma unroll
            for (int e = 0; e < 4; ++e) {
                const float* wr = wbd + (size_t)(4 * lane + 256 * j + e) * 16;
#pragma unroll
                for (int c = 0; c < 16; ++c) acc[c] += uu[e] * wr[c];
            }
        }
#pragma unroll
        for (int c = 0; c < 16; ++c) acc[c] = wave_sum(acc[c]);
        if (lane < 16) {
            float a = 0.f;
#pragma unroll
            for (int c = 0; c < 16; ++c) a = (lane == c) ? acc[c] : a;
            const size_t pos = 48 + R;
            if (lane < 8) { ((float*)(ws + OFF_SMALL + SM_BETA))[pos * 8 + lane] = sigmoidf_(a); }
            else { const int hh = lane - 8; const float z = a + p.in[11][hh]; const float sp = fmaxf(z, 0.f) + log1pf(__expf(-fabsf(z)));
                   ((float*)(ws + OFF_SMALL + SM_G))[pos * 8 + hh] = -__expf(p.in[10][hh]) * sp; }
        }
    }
}

constexpr int G_BM = 256, G_BN = 128, G_BK = 64;
constexpr int G_LDS_A = G_BM * G_BK * 2, G_LDS_B = G_BN * G_BK * 2;
constexpr int G_STAGE_PITCH = 132;
constexpr int G_LDS_BYTES = G_BM * G_STAGE_PITCH * 4;
constexpr int G_MT = SEQ / 256 + 1, G_NTILES = 56;

DI void gemm_inproj_tile(const Params& p, char* smem, int mt, int nt) {
    const int tid = fresh_tid(), lane = tid & 63, wave = tid >> 6;
    const int wm = wave >> 1, wn = wave & 1, r32 = lane & 31, h = lane >> 5;
    unsigned char* ws = p.ws;
    const bool meta = (mt == G_MT - 1);
    const bf16* A = meta ? (const bf16*)(ws + OFF_SMALL + SM_UMETA) : (const bf16*)(ws + OFF_U) + (size_t)mt * 256 * D;
    const int vrows = meta ? NMETA : 256;
    const bf16* Bt = (const bf16*)(ws + OFF_WTIN) + (size_t)nt * 128 * D;
    char* ldsA[2] = {smem, smem + G_LDS_A + G_LDS_B};
    char* ldsB[2] = {smem + G_LDS_A, smem + 2 * G_LDS_A + G_LDS_B};
    f32x16 acc[2][2];
#pragma unroll
    for (int i = 0; i < 2; ++i)
#pragma unroll
        for (int j = 0; j < 2; ++j) acc[i][j] = zero16();
    const int lrow = tid >> 3, lc = tid & 7;
    u32x4 ra[4], rb[2];
    auto gload = [&](int kt) {
#pragma unroll
        for (int i = 0; i < 4; ++i) { const int row = lrow + 64 * i; ra[i] = row < vrows ? *(const u32x4*)(A + (size_t)row * D + kt * 64 + lc * 8) : (u32x4){0u, 0u, 0u, 0u}; }
#pragma unroll
        for (int i = 0; i < 2; ++i) { const int row = lrow + 64 * i; rb[i] = *(const u32x4*)(Bt + (size_t)row * D + kt * 64 + lc * 8); }
    };
    auto lstore = [&](int buf) {
#pragma unroll
        for (int i = 0; i < 4; ++i) *(u32x4*)(ldsA[buf] + swz128(lrow + 64 * i, lc)) = ra[i];
#pragma unroll
        for (int i = 0; i < 2; ++i) *(u32x4*)(ldsB[buf] + swz128(lrow + 64 * i, lc)) = rb[i];
    };
    gload(0); lstore(0); __syncthreads();
    for (int kt = 0; kt < 16; ++kt) {
        const int buf = kt & 1;
        if (kt + 1 < 16) gload(kt + 1);
#pragma unroll
        for (int ks = 0; ks < 4; ++ks) {
            bf16x8 af[2], bfr[2];
#pragma unroll
            for (int i = 0; i < 2; ++i) af[i] = *(const bf16x8*)(ldsA[buf] + swz128(64 * wm + 32 * i + r32, 2 * ks + h));
#pragma unroll
            for (int j = 0; j < 2; ++j) bfr[j] = *(const bf16x8*)(ldsB[buf] + swz128(64 * wn + 32 * j + r32, 2 * ks + h));
#pragma unroll
            for (int i = 0; i < 2; ++i)
#pragma unroll
                for (int j = 0; j < 2; ++j) acc[i][j] = MFMA32(af[i], bfr[j], acc[i][j]);
        }
        if (kt + 1 < 16) lstore(buf ^ 1);
        __syncthreads();
    }
    float* st = (float*)smem;
#pragma unroll
    for (int i = 0; i < 2; ++i)
#pragma unroll
        for (int j = 0; j < 2; ++j)
#pragma unroll
            for (int r = 0; r < 16; ++r) {
                const int row = 64 * wm + 32 * i + (r & 3) + 8 * (r >> 2) + 4 * h, col = 64 * wn + 32 * j + r32;
                st[row * G_STAGE_PITCH + col] = acc[i][j][r];
            }
    __syncthreads();
    const int tid2 = fresh_tid();
    const int sec = nt >> 3, cb = (nt & 7) * 128;
    if (sec == 2) {
        const int head = nt & 7, e = tid2 >> 2, sub = tid2 & 3;
        if (!meta) {
            bf16* dst = (bf16*)p.out + (size_t)SEQ * D + ((size_t)head * 128 + e) * SEQ + (size_t)mt * 256;
#pragma unroll
            for (int i = 0; i < 8; ++i) {
                const int row0 = 32 * i + 8 * sub; float f[8];
#pragma unroll
                for (int j = 0; j < 8; ++j) f[j] = st[(row0 + j) * G_STAGE_PITCH + e];
                u32x4 o; o.x = pk2(f[0], f[1]); o.y = pk2(f[2], f[3]); o.z = pk2(f[4], f[5]); o.w = pk2(f[6], f[7]);
                *(u32x4*)(dst + row0) = o;
            }
        } else if (sub < 2) {
            bf16* dst = (bf16*)(ws + OFF_SMALL + SM_AVTMETA) + ((size_t)head * 128 + e) * 16;
            const int row0 = 8 * sub; float f[8];
#pragma unroll
            for (int j = 0; j < 8; ++j) f[j] = st[(row0 + j) * G_STAGE_PITCH + e];
            u32x4 o; o.x = pk2(f[0], f[1]); o.y = pk2(f[2], f[3]); o.z = pk2(f[4], f[5]); o.w = pk2(f[6], f[7]);
            *(u32x4*)(dst + row0) = o;
        }
    } else {
        bf16* base; bool has_meta = true; bf16* mbase = nullptr; int mrow0 = 0;
        if (sec == 0) { base = (bf16*)(ws + OFF_AQ); has_meta = false; }
        else if (sec == 1) { base = (bf16*)p.out; mbase = (bf16*)(ws + OFF_SMALL + SM_AKMETA); }
        else if (sec == 3) { base = (bf16*)(ws + OFF_QN); mbase = (bf16*)(ws + OFF_SMALL + SM_C0Q); mrow0 = 48; }
        else if (sec == 4) { base = (bf16*)(ws + OFF_KN); mbase = (bf16*)(ws + OFF_SMALL + SM_C0K); mrow0 = 48; }
        else if (sec == 5) { base = (bf16*)(ws + OFF_V); mbase = (bf16*)(ws + OFF_SMALL + SM_C0V); mrow0 = 48; }
        else { base = (bf16*)(ws + OFF_DG); has_meta = false; }
        const bool dqkv = (sec >= 3 && sec <= 5);
        bf16* tails = (bf16*)(ws + OFF_SMALL + SM_TAILS);
        if (!meta || has_meta) {
#pragma unroll
            for (int i = 0; i < 8; ++i) {
                const int idx = tid2 + NT * i, row = idx >> 4, cg = idx & 15;
                if (row < vrows) {
                    const float* s = st + row * G_STAGE_PITCH + cg * 8;
                    const f32x4 a = *(const f32x4*)s, b = *(const f32x4*)(s + 4);
                    u32x4 o; o.x = pk2(a[0], a[1]); o.y = pk2(a[2], a[3]); o.z = pk2(b[0], b[1]); o.w = pk2(b[2], b[3]);
                    if (!meta) {
                        const int j = mt * 256 + row;
                        *(u32x4*)(base + (size_t)j * D + cb + cg * 8) = o;
                        if (dqkv && (j & 63) >= 61) *(u32x4*)(tails + ((size_t)(j / 64 + 1) * 3 + ((j & 63) - 61)) * 3072 + (sec - 3) * 1024 + cb + cg * 8) = o;
                    } else {
                        *(u32x4*)(mbase + (size_t)(mrow0 + row) * D + cb + cg * 8) = o;
                        if (dqkv && row >= 13) *(u32x4*)(tails + ((size_t)0 * 3 + (row - 13)) * 3072 + (sec - 3) * 1024 + cb + cg * 8) = o;
                    }
                }
            }
        }
    }
    __syncthreads();
}

DI void phase1(const Params& p, char* smem, int bid, int nblk) {
    const int ntiles = G_MT * G_NTILES;
    for (int t = bid; t < ntiles; t += nblk) {
        const int mt = t / G_NTILES, nt = t % G_NTILES;
        gemm_inproj_tile(p, smem, mt, nt);
    }
}

constexpr int P2_KN = 0, P2_KB = 16384, P2_KBGT = 32768, P2_VBT = 49152, P2_ALDS = 65536, P2_TLDS = P2_ALDS + 64 * 68 * 4, P2_GC = P2_TLDS + 8192, P2_BET = P2_GC + 256, P2_EG = P2_BET + 256;

DI void prep_item(const Params& p, char* smem, int chunk, int head, int dry) {
    int tid_ = threadIdx.x;
#ifndef EMU
    asm volatile("" : "+v"(tid_));
#endif
    const int tid = tid_, lane = tid & 63, wave = tid >> 6, r32 = lane & 31, h = lane >> 5;
    unsigned char* ws = p.ws;
    float* gcl = (float*)(smem + P2_GC); float* betl = (float*)(smem + P2_BET); float* egl = (float*)(smem + P2_EG);
    if (wave == 0) {
        const size_t pos = (size_t)chunk * 64 + lane;
        float v = ((const float*)(ws + OFF_SMALL + SM_G))[pos * 8 + head];
        const float b = ((const float*)(ws + OFF_SMALL + SM_BETA))[pos * 8 + head];
#pragma unroll
        for (int o = 1; o < 64; o <<= 1) { const float t = __shfl_up(v, o); if (lane >= o) v += t; }
        gcl[lane] = v; betl[lane] = b; egl[lane] = __expf(v);
        if (!dry) ((float*)(ws + OFF_SMALL + SM_GC))[((size_t)chunk * 8 + head) * 64 + lane] = v;
    }
    __syncthreads();
    {
        const int r = tid >> 3, cg = tid & 7, col0 = head * 128 + 16 * cg;
        const bool zero_row = (chunk == 0 && r < 48);
        const float beta = betl[r], eg = egl[r];
        const bf16* tails = (const bf16*)(ws + OFF_SMALL + SM_TAILS);
#pragma unroll 1
        for (int mat = 0; mat < 3; ++mat) {
            bf16* mainb = (bf16*)(ws + (mat == 0 ? OFF_QN : (mat == 1 ? OFF_KN : OFF_V)));
            bf16* c0b = (bf16*)(ws + OFF_SMALL + (mat == 0 ? SM_C0Q : (mat == 1 ? SM_C0K : SM_C0V)));
            float y[16];
#pragma unroll
            for (int c = 0; c < 16; ++c) y[c] = 0.f;
#pragma unroll
            for (int jj = 0; jj < 4; ++jj) {
                const int rr = r - 3 + jj;
                const bf16* src = nullptr;
                if (chunk == 0) { if (rr >= 48) src = c0b + (size_t)rr * D + col0; }
                else if (rr >= 0) src = mainb + ((size_t)(chunk - 1) * 64 + rr) * D + col0;
                else src = tails + ((size_t)(chunk - 1) * 3 + (3 + rr)) * 3072 + mat * 1024 + col0;
                u32x4 a = {0u, 0u, 0u, 0u}, b = {0u, 0u, 0u, 0u};
                if (src) { a = *(const u32x4*)src; b = *(const u32x4*)(src + 8); }
                const float* cw = p.in[9] + (size_t)jj * 3072 + mat * 1024 + col0;
                const f32x4 w0 = *(const f32x4*)cw, w1 = *(const f32x4*)(cw + 4), w2 = *(const f32x4*)(cw + 8), w3 = *(const f32x4*)(cw + 12);
                y[0] += w0[0] * bflo(a.x); y[1] += w0[1] * bfhi(a.x); y[2] += w0[2] * bflo(a.y); y[3] += w0[3] * bfhi(a.y);
                y[4] += w1[0] * bflo(a.z); y[5] += w1[1] * bfhi(a.z); y[6] += w1[2] * bflo(a.w); y[7] += w1[3] * bfhi(a.w);
                y[8] += w2[0] * bflo(b.x); y[9] += w2[1] * bfhi(b.x); y[10] += w2[2] * bflo(b.y); y[11] += w2[3] * bfhi(b.y);
                y[12] += w3[0] * bflo(b.z); y[13] += w3[1] * bfhi(b.z); y[14] += w3[2] * bflo(b.w); y[15] += w3[3] * bfhi(b.w);
            }
            __syncthreads();
            float ss = 0.f;
#pragma unroll
            for (int c = 0; c < 16; ++c) { y[c] = zero_row ? 0.f : siluf_(y[c]); ss += y[c] * y[c]; }
            if (mat < 2) {
                ss += __shfl_xor(ss, 1); ss += __shfl_xor(ss, 2); ss += __shfl_xor(ss, 4);
                const float sc = rsqrtf(ss + 1e-6f) * (mat == 0 ? 0.08838834764831845f : 1.0f);
                unsigned pk[8];
#pragma unroll
                for (int c = 0; c < 8; ++c) pk[c] = pk2(y[2 * c] * sc, y[2 * c + 1] * sc);
                bf16* dst = (chunk == 0) ? c0b + (size_t)r * D + col0 : mainb + ((size_t)(chunk - 1) * 64 + r) * D + col0;
                if (!dry) { *(u32x4*)dst = (u32x4){pk[0], pk[1], pk[2], pk[3]}; *(u32x4*)(dst + 8) = (u32x4){pk[4], pk[5], pk[6], pk[7]}; }
                if (mat == 1) {
                    *(u32x4*)(smem + P2_KN + swzrow(r, 256, 2 * cg)) = (u32x4){pk[0], pk[1], pk[2], pk[3]};
                    *(u32x4*)(smem + P2_KN + swzrow(r, 256, 2 * cg + 1)) = (u32x4){pk[4], pk[5], pk[6], pk[7]};
                    unsigned kb[8];
#pragma unroll
                    for (int c = 0; c < 8; ++c) {
                        const float k0 = bflo(pk[c]) * beta, k1 = bfhi(pk[c]) * beta;
                        kb[c] = pk2(k0, k1);
                        const int d0 = 16 * cg + 2 * c;
                        *(bf16*)(smem + P2_KBGT + swz128(d0, r >> 3) + (r & 7) * 2) = (bf16)f2bf(k0 * eg);
                        *(bf16*)(smem + P2_KBGT + swz128(d0 + 1, r >> 3) + (r & 7) * 2) = (bf16)f2bf(k1 * eg);
                    }
                    *(u32x4*)(smem + P2_KB + swzrow(r, 256, 2 * cg)) = (u32x4){kb[0], kb[1], kb[2], kb[3]};
                    *(u32x4*)(smem + P2_KB + swzrow(r, 256, 2 * cg + 1)) = (u32x4){kb[4], kb[5], kb[6], kb[7]};
                }
            } else {
#pragma unroll
                for (int c = 0; c < 16; ++c) {
                    const int e = 16 * cg + c;
                    *(bf16*)(smem + P2_VBT + swz128(e, r >> 3) + (r & 7) * 2) = (bf16)f2bf(y[c] * beta);
                }
            }
        }
    }
    __syncthreads();
    if (wave < 4) {
        const int mi = wave >> 1, ni = wave & 1;
        f32x16 acc = zero16();
        if (ni <= mi) {
#pragma unroll
            for (int ks = 0; ks < 8; ++ks) {
                const bf16x8 a = *(const bf16x8*)(smem + P2_KB + swzrow(32 * mi + r32, 256, 2 * ks + h));
                const bf16x8 b = *(const bf16x8*)(smem + P2_KN + swzrow(32 * ni + r32, 256, 2 * ks + h));
                acc = MFMA32(a, b, acc);
            }
        }
        float* Al = (float*)(smem + P2_ALDS);
        const int j = 32 * ni + r32; const float gj = gcl[j];
#pragma unroll
        for (int r = 0; r < 16; ++r) {
            const int i = 32 * mi + (r & 3) + 8 * (r >> 2) + 4 * h;
            const float dv = acc[r] * __expf(gcl[i] - gj);
            Al[i * 68 + j] = (j < i) ? dv : 0.f;
        }
    }
    __syncthreads();
    if (wave == 0) {
        const float* Al = (const float*)(smem + P2_ALDS);
        float t[64];
#pragma unroll
        for (int i = 0; i < 64; ++i) {
            float s = (i == lane) ? 1.f : 0.f;
#pragma unroll
            for (int j = 0; j < i; ++j) s -= Al[i * 68 + j] * t[j];
            t[i] = s;
#ifndef EMU
            if ((i & 3) == 3) asm volatile("" ::: "memory");
#endif
        }
#pragma unroll
        for (int i = 0; i < 64; ++i) *(bf16*)(smem + P2_TLDS + swz128(i, lane >> 3) + (lane & 7) * 2) = (bf16)f2bf(t[i]);
    }
    __syncthreads();
    {
        const int mi = wave >> 2, ni = wave & 3;
        f32x16 acc = zero16();
#pragma unroll
        for (int ks = 0; ks < 4; ++ks) {
            const bf16x8 a = *(const bf16x8*)(smem + P2_TLDS + swz128(32 * mi + r32, 2 * ks + h));
            const bf16x8 b = *(const bf16x8*)(smem + P2_VBT + swz128(32 * ni + r32, 2 * ks + h));
            acc = MFMA32(a, b, acc);
        }
        const int e = 32 * ni + r32;
        bf16* base = (chunk == 0) ? (bf16*)(ws + OFF_SMALL + SM_C0V) : (bf16*)(ws + OFF_V) + (size_t)(chunk - 1) * 64 * D;
        bf16* dst = base + (size_t)(e >> 1) * D + head * 128 + (e & 1) * 64;
#pragma unroll
        for (int q4 = 0; q4 < 4; ++q4) {
            const int c0 = 32 * mi + 8 * q4 + 4 * h;
            if (!dry) *(u32x2*)(dst + c0) = (u32x2){pk2(acc[4 * q4], acc[4 * q4 + 1]), pk2(acc[4 * q4 + 2], acc[4 * q4 + 3])};
        }
    }
    {
        const int mi = wave >> 1, ni = wave & 1;
        f32x16 acc = zero16();
#pragma unroll
        for (int ks = 0; ks < 4; ++ks) {
            const bf16x8 a = *(const bf16x8*)(smem + P2_KBGT + swz128(32 * mi + r32, 2 * ks + h));
            const bf16x8 b = *(const bf16x8*)(smem + P2_TLDS + swz128(32 * ni + r32, 2 * ks + h));
            acc = MFMA32(a, b, acc);
        }
        const int c = 32 * ni + r32;
        bf16* wb = (chunk == 0) ? (bf16*)(ws + OFF_SMALL + SM_C0W) + (size_t)head * 8192 : (bf16*)(ws + OFF_W) + ((size_t)(chunk - 1) * 8 + head) * 8192;
#pragma unroll
        for (int q4 = 0; q4 < 4; ++q4) {
            const int dk0 = 32 * mi + 8 * q4 + 4 * h;
            if (!dry) *(u32x2*)(wb + c * 128 + dk0) = (u32x2){pk2(acc[4 * q4], acc[4 * q4 + 1]), pk2(acc[4 * q4 + 2], acc[4 * q4 + 3])};
        }
    }
    __syncthreads();
}

DI void phase2(const Params& p, char* smem, int bid, int nblk, int dry = 0) {
    for (int it = bid; it < NCH * 8; it += nblk) prep_item(p, smem, it >> 3, it & 7, dry);
}

DI int swzrow8(int row, int pitch, int s) { return row * pitch + ((((s >> 1) ^ (row & 15)) << 4) | ((s & 1) << 3)); }
DI bf16x8 pack8(f32x4 a, f32x4 b) {
    u32x4 o; o.x = pk2(a[0], a[1]); o.y = pk2(a[2], a[3]); o.z = pk2(b[0], b[1]); o.w = pk2(b[2], b[3]);
    return __builtin_bit_cast(bf16x8, o);
}
DI bf16x8 ld2x8(const char* p0, const char* p1) {
    const u32x2 a = *(const u32x2*)p0, b = *(const u32x2*)p1; u32x4 o; o.x = a.x; o.y = a.y; o.z = b.x; o.w = b.y;
    return __builtin_bit_cast(bf16x8, o);
}
constexpr int SC_W = 0, SC_QN = 16384, SC_KN = 32768, SC_KNT = 49152, SC_QK = 65536, SC_GC = 73728;

DI void scan_head(const Params& p, char* smem, int head, int dry) {
    const int tid = fresh_tid(), lane = tid & 63, wave = tid >> 6, r16 = lane & 15, g = lane >> 4;
    unsigned char* ws = p.ws;
    const int lrow = tid >> 3, lch = (tid & 7) * 2;
    f32x4 S[8];
#pragma unroll
    for (int i = 0; i < 8; ++i) S[i] = zero4();
    u32x4 rw[2], rq[2], rk[2]; u32x2 ru[4]; float rgc = 0.f;
    auto srcrow = [&](int n, size_t off_main, size_t off_c0) -> const bf16* {
        return n == 0 ? (const bf16*)(ws + OFF_SMALL + off_c0) + (size_t)lrow * D + head * 128 + lch * 8
                      : (const bf16*)(ws + off_main) + ((size_t)(n - 1) * 64 + lrow) * D + head * 128 + lch * 8;
    };
    auto uaddr = [&](int n, int mt) -> bf16* {
        const int e = 16 * wave + r16;
        bf16* base = n == 0 ? (bf16*)(ws + OFF_SMALL + SM_C0V) : (bf16*)(ws + OFF_V) + (size_t)(n - 1) * 64 * D;
        return base + (size_t)(e >> 1) * D + head * 128 + (e & 1) * 64 + 16 * mt + 4 * g;
    };
    auto gload = [&](int n) {
        const bf16* wsrc = (n == 0 ? (const bf16*)(ws + OFF_SMALL + SM_C0W) + (size_t)head * 8192 : (const bf16*)(ws + OFF_W) + ((size_t)(n - 1) * 8 + head) * 8192) + lrow * 128 + lch * 8;
        rw[0] = *(const u32x4*)wsrc; rw[1] = *(const u32x4*)(wsrc + 8);
        const bf16* qs = srcrow(n, OFF_QN, SM_C0Q); rq[0] = *(const u32x4*)qs; rq[1] = *(const u32x4*)(qs + 8);
        const bf16* ks = srcrow(n, OFF_KN, SM_C0K); rk[0] = *(const u32x4*)ks; rk[1] = *(const u32x4*)(ks + 8);
#pragma unroll
        for (int mt = 0; mt < 4; ++mt) ru[mt] = *(const u32x2*)uaddr(n, mt);
        if (tid < 64) rgc = ((const float*)(ws + OFF_SMALL + SM_GC))[((size_t)n * 8 + head) * 64 + tid];
    };
    gload(0);
    for (int n = 0; n < NCH; ++n) {
        __syncthreads();
        *(u32x4*)(smem + SC_W + swzrow(lrow, 256, lch)) = rw[0]; *(u32x4*)(smem + SC_W + swzrow(lrow, 256, lch + 1)) = rw[1];
        *(u32x4*)(smem + SC_QN + swzrow(lrow, 256, lch)) = rq[0]; *(u32x4*)(smem + SC_QN + swzrow(lrow, 256, lch + 1)) = rq[1];
        *(u32x4*)(smem + SC_KN + swzrow(lrow, 256, lch)) = rk[0]; *(u32x4*)(smem + SC_KN + swzrow(lrow, 256, lch + 1)) = rk[1];
        {
            const unsigned kk[8] = {rk[0].x, rk[0].y, rk[0].z, rk[0].w, rk[1].x, rk[1].y, rk[1].z, rk[1].w};
#pragma unroll
            for (int c = 0; c < 8; ++c) {
                const int dk = lch * 8 + 2 * c;
                *(bf16*)(smem + SC_KNT + swz128_8(dk, lrow >> 2) + (lrow & 3) * 2) = (bf16)(kk[c] & 0xffffu);
                *(bf16*)(smem + SC_KNT + swz128_8(dk + 1, lrow >> 2) + (lrow & 3) * 2) = (bf16)(kk[c] >> 16);
            }
        }
        if (tid < 64) ((float*)(smem + SC_GC))[tid] = rgc;
        u32x2 ucur[4];
#pragma unroll
        for (int mt = 0; mt < 4; ++mt) ucur[mt] = ru[mt];
        __syncthreads();
        if (n + 1 < NCH) gload(n + 1);
        const float* gcl = (const float*)(smem + SC_GC);
        {
            const int mt = wave >> 1;
#pragma unroll
            for (int t2 = 0; t2 < 2; ++t2) {
                const int nt = 2 * (wave & 1) + t2;
                f32x4 acc = zero4();
                if (nt <= mt) {
#pragma unroll
                    for (int ks = 0; ks < 4; ++ks) {
                        const bf16x8 a = *(const bf16x8*)(smem + SC_QN + swzrow(16 * mt + r16, 256, 4 * ks + g));
                        const bf16x8 b = *(const bf16x8*)(smem + SC_KN + swzrow(16 * nt + r16, 256, 4 * ks + g));
                        acc = MFMA16(a, b, acc);
                    }
                }
                const int j = 16 * nt + r16; const float gj = gcl[j];
#pragma unroll
                for (int r = 0; r < 4; ++r) {
                    const int i = 16 * mt + 4 * g + r;
                    const float v = (j <= i) ? acc[r] * __expf(gcl[i] - gj) : 0.f;
                    *(bf16*)(smem + SC_QK + swz128_8(i, j >> 2) + (j & 3) * 2) = (bf16)f2bf(v);
                }
            }
        }
        __syncthreads();
        const float gl = gcl[63], gtot = __expf(gl);
        bf16x8 sf[4];
#pragma unroll
        for (int kb = 0; kb < 4; ++kb) sf[kb] = pack8(S[2 * kb], S[2 * kb + 1]);
        f32x4 Vn[4], O[4];
#pragma unroll
        for (int mt = 0; mt < 4; ++mt) {
            f32x4 P = zero4(), Q = zero4();
            const int row = 16 * mt + r16;
#pragma unroll
            for (int kb = 0; kb < 4; ++kb) {
                const bf16x8 wf = ld2x8(smem + SC_W + swzrow8(row, 256, 8 * kb + g), smem + SC_W + swzrow8(row, 256, 8 * kb + 4 + g));
                const bf16x8 qf = ld2x8(smem + SC_QN + swzrow8(row, 256, 8 * kb + g), smem + SC_QN + swzrow8(row, 256, 8 * kb + 4 + g));
                P = MFMA16(wf, sf[kb], P);
                Q = MFMA16(qf, sf[kb], Q);
            }
            const float u0 = bflo(ucur[mt].x), u1 = bfhi(ucur[mt].x), u2 = bflo(ucur[mt].y), u3 = bfhi(ucur[mt].y);
            Vn[mt] = (f32x4){u0 - P[0], u1 - P[1], u2 - P[2], u3 - P[3]};
#pragma unroll
            for (int r = 0; r < 4; ++r) Q[r] *= __expf(gcl[16 * mt + 4 * g + r]);
            O[mt] = Q;
        }
        bf16x8 vf[2] = {pack8(Vn[0], Vn[1]), pack8(Vn[2], Vn[3])};
#pragma unroll
        for (int mt = 0; mt < 4; ++mt) {
            const int row = 16 * mt + r16;
#pragma unroll
            for (int kb = 0; kb < 2; ++kb) {
                const bf16x8 qk = ld2x8(smem + SC_QK + swz128_8(row, 8 * kb + g), smem + SC_QK + swz128_8(row, 8 * kb + 4 + g));
                O[mt] = MFMA16(qk, vf[kb], O[mt]);
            }
            if (n >= 1 && !dry) *(u32x2*)uaddr(n, mt) = (u32x2){pk2(O[mt][0], O[mt][1]), pk2(O[mt][2], O[mt][3])};
        }
#pragma unroll
        for (int mt = 0; mt < 4; ++mt)
#pragma unroll
            for (int r = 0; r < 4; ++r) Vn[mt][r] *= __expf(gl - gcl[16 * mt + 4 * g + r]);
        vf[0] = pack8(Vn[0], Vn[1]); vf[1] = pack8(Vn[2], Vn[3]);
#pragma unroll
        for (int mt = 0; mt < 8; ++mt) {
            const int row = 16 * mt + r16;
            f32x4 acc = S[mt] * gtot;
#pragma unroll
            for (int kb = 0; kb < 2; ++kb) {
                const bf16x8 kf = ld2x8(smem + SC_KNT + swz128_8(row, 8 * kb + g), smem + SC_KNT + swz128_8(row, 8 * kb + 4 + g));
                acc = MFMA16(kf, vf[kb], acc);
            }
            S[mt] = acc;
        }
    }
    __syncthreads();
}

constexpr int AT_BUF = 32768, AT_MISC = 65536, NQB = SEQ / 128, AT_UNITS = 8 * NQB;
DI int vt_off8(int e, int s) { return e * 128 + ((s ^ ((e >> 1) & 15)) << 3); }

DI void attention_unit(const Params& p, char* smem, int head, int qb, float lam, int dry) {
    const int tid = fresh_tid(), lane = tid & 63, wave = tid >> 6, r32 = lane & 31, h = lane >> 5;
    const int wq = wave & 3, mp = wave >> 2;
    unsigned char* ws = p.ws;
    const bf16* AK = (const bf16*)p.out; const bf16* AVT = (const bf16*)p.out + (size_t)SEQ * D;
    const int q0 = 128 * qb, qpos = q0 + 32 * wq + r32;
    const float c1 = 0.125f * LOG2E, c2 = exp2f(-(float)(head + 1)) * LOG2E;
    bf16x8 Qf[4];
    {
        const bf16* qsrc = (const bf16*)(ws + OFF_AQ) + (size_t)qpos * D + head * 128 + mp * 64 + 8 * h;
#pragma unroll
        for (int ks = 0; ks < 4; ++ks) {
            const u32x4 v = *(const u32x4*)(qsrc + 16 * ks); u32x4 o;
            o.x = pk2(bflo(v.x) * c1, bfhi(v.x) * c1); o.y = pk2(bflo(v.y) * c1, bfhi(v.y) * c1); o.z = pk2(bflo(v.z) * c1, bfhi(v.z) * c1); o.w = pk2(bflo(v.w) * c1, bfhi(v.w) * c1);
            Qf[ks] = __builtin_bit_cast(bf16x8, o);
        }
    }
    f32x16 O[4];
#pragma unroll
    for (int i = 0; i < 4; ++i) O[i] = zero16();
    float m_run = -1e30f, l_run = 0.f;
    const int ntiles = 2 * qb + 3;
    const int kkey = tid >> 3, kcc = (tid & 7) * 2;
    const int ve = tid >> 2, vcc = (tid & 3) * 2;
    u32x4 rk[2], rv[2];
    auto gload = [&](int it) {
        const int kt = 2 * qb + 1 - it;
        if (kt >= 0) {
            const bf16* ks = AK + ((size_t)kt * 64 + kkey) * D + head * 128 + kcc * 8;
            rk[0] = *(const u32x4*)ks; rk[1] = *(const u32x4*)(ks + 8);
            const bf16* vs = AVT + ((size_t)head * 128 + ve) * SEQ + (size_t)kt * 64 + vcc * 8;
            rv[0] = *(const u32x4*)vs; rv[1] = *(const u32x4*)(vs + 8);
        } else {
            rk[0] = rk[1] = rv[0] = rv[1] = (u32x4){0u, 0u, 0u, 0u};
            if (kkey < NMETA) { const bf16* ks = (const bf16*)(ws + OFF_SMALL + SM_AKMETA) + (size_t)kkey * D + head * 128 + kcc * 8; rk[0] = *(const u32x4*)ks; rk[1] = *(const u32x4*)(ks + 8); }
            if (vcc == 0) { const bf16* vs = (const bf16*)(ws + OFF_SMALL + SM_AVTMETA) + ((size_t)head * 128 + ve) * 16; rv[0] = *(const u32x4*)vs; rv[1] = *(const u32x4*)(vs + 8); }
        }
    };
    auto lwrite = [&](int buf) {
        char* kb = smem + buf * AT_BUF + (kcc >> 3) * 8192;
        *(u32x4*)(kb + swz128(kkey, kcc & 7)) = rk[0]; *(u32x4*)(kb + swz128(kkey, (kcc & 7) + 1)) = rk[1];
        char* vb = smem + buf * AT_BUF + 16384;
        *(u32x2*)(vb + vt_off8(ve, 2 * vcc)) = (u32x2){rv[0].x, rv[0].y}; *(u32x2*)(vb + vt_off8(ve, 2 * vcc + 1)) = (u32x2){rv[0].z, rv[0].w};
        *(u32x2*)(vb + vt_off8(ve, 2 * vcc + 2)) = (u32x2){rv[1].x, rv[1].y}; *(u32x2*)(vb + vt_off8(ve, 2 * vcc + 3)) = (u32x2){rv[1].z, rv[1].w};
    };
    gload(0); lwrite(0); __syncthreads();
    for (int it = 0; it < ntiles; ++it) {
        const int buf = it & 1, kt = 2 * qb + 1 - it;
        if (it + 1 < ntiles) gload(it + 1);
        const bool meta = kt < 0;
        const int k0 = kt * 64;
        const bool skip = !meta && (k0 > q0 + 32 * wq + 31);
        if (!skip) {
            const char* kb = smem + buf * AT_BUF + mp * 8192;
            const char* vb = smem + buf * AT_BUF + 16384;
            const bool need_mask = !meta && (k0 + 63 > q0 + 32 * wq);
            f32x16 s[2];
            float mx = -1e30f;
#pragma unroll
            for (int sub = 0; sub < 2; ++sub) {
                f32x16 acc;
                const float base = meta ? -c2 * (float)(NMETA + qpos - 32 * sub - 4 * h) : -c2 * (float)(qpos - k0 - 32 * sub - 4 * h);
#pragma unroll
                for (int r = 0; r < 16; ++r) acc[r] = base + c2 * (float)((r & 3) + 8 * (r >> 2));
#pragma unroll
                for (int ks = 0; ks < 4; ++ks) {
                    const bf16x8 a = *(const bf16x8*)(kb + swz128(32 * sub + r32, 2 * ks + h));
                    acc = MFMA32(a, Qf[ks], acc);
                }
                if (meta) {
#pragma unroll
                    for (int r = 0; r < 16; ++r) { const int key = 32 * sub + (r & 3) + 8 * (r >> 2) + 4 * h; if (key >= NMETA) acc[r] = -1e30f; }
                } else if (need_mask) {
#pragma unroll
                    for (int r = 0; r < 16; ++r) { const int key = k0 + 32 * sub + (r & 3) + 8 * (r >> 2) + 4 * h; if (key > qpos) acc[r] = -1e30f; }
                }
#pragma unroll
                for (int r = 0; r < 16; ++r) mx = fmaxf(mx, acc[r]);
                s[sub] = acc;
            }
            mx = fmaxf(mx, __shfl_xor(mx, 32));
            const float m_new = fmaxf(m_run, mx);
            const float alpha = EXP2F(m_run - m_new);
            m_run = m_new;
            float ls = 0.f;
#pragma unroll
            for (int sub = 0; sub < 2; ++sub)
#pragma unroll
                for (int r = 0; r < 16; ++r) { const float pv = EXP2F(s[sub][r] - m_new); s[sub][r] = pv; ls += pv; }
            l_run = l_run * alpha + ls;
#pragma unroll
            for (int et = 0; et < 4; ++et) O[et] = O[et] * alpha;
            bf16x8 Pf[2][2];
#pragma unroll
            for (int sub = 0; sub < 2; ++sub)
#pragma unroll
                for (int ss = 0; ss < 2; ++ss) {
                    u32x4 o; o.x = pk2(s[sub][8 * ss], s[sub][8 * ss + 1]); o.y = pk2(s[sub][8 * ss + 2], s[sub][8 * ss + 3]);
                    o.z = pk2(s[sub][8 * ss + 4], s[sub][8 * ss + 5]); o.w = pk2(s[sub][8 * ss + 6], s[sub][8 * ss + 7]);
                    Pf[sub][ss] = __builtin_bit_cast(bf16x8, o);
                }
#pragma unroll
            for (int et = 0; et < 4; ++et) {
                const int e = 32 * et + r32;
#pragma unroll
                for (int sub = 0; sub < 2; ++sub)
#pragma unroll
                    for (int ss = 0; ss < 2; ++ss) {
                        const int sl = 8 * sub + 4 * ss + h;
                        const bf16x8 a = ld2x8(vb + vt_off8(e, sl), vb + vt_off8(e, sl + 2));
                        O[et] = MFMA32(a, Pf[sub][ss], O[et]);
                    }
                SCHED_FENCE();
            }
        }
        if (it + 1 < ntiles) lwrite(buf ^ 1);
        __syncthreads();
    }
    {
        const float lt = l_run + __shfl_xor(l_run, 32);
        const float inv = 1.0f / lt;
        float* X = (float*)smem;
        if (mp == 1) {
#pragma unroll
            for (int et = 0; et < 4; ++et)
#pragma unroll
                for (int r = 0; r < 16; ++r) { const int e = 32 * et + (r & 3) + 8 * (r >> 2) + 4 * h; X[(wq * 128 + e) * 32 + r32] = O[et][r] * inv; }
        }
        __syncthreads();
        if (mp == 0) {
            float ssq = 0.f;
#pragma unroll
            for (int et = 0; et < 4; ++et)
#pragma unroll
                for (int r = 0; r < 16; ++r) { const int e = 32 * et + (r & 3) + 8 * (r >> 2) + 4 * h; const float d = O[et][r] * inv - lam * X[(wq * 128 + e) * 32 + r32]; O[et][r] = d; ssq += d * d; }
            ssq += __shfl_xor(ssq, 32);
            const float rstd = rsqrtf(ssq * (1.0f / 128.0f) + NORM_EPS) * 0.8f;
            bf16* dst = (bf16*)(ws + OFF_AQ) + (size_t)qpos * D + head * 128;
            const float* sw = p.in[8];
#pragma unroll
            for (int et = 0; et < 4; ++et)
#pragma unroll
                for (int q4 = 0; q4 < 4; ++q4) {
                    const int e0 = 32 * et + 8 * q4 + 4 * h;
                    const f32x4 w4 = *(const f32x4*)(sw + e0);
                    if (!dry) *(u32x2*)(dst + e0) = (u32x2){pk2(O[et][4 * q4] * rstd * w4[0], O[et][4 * q4 + 1] * rstd * w4[1]), pk2(O[et][4 * q4 + 2] * rstd * w4[2], O[et][4 * q4 + 3] * rstd * w4[3])};
                }
        }
        __syncthreads();
    }
}

DI void phase3(const Params& p, char* smem, int bid, int nblk, int dry = 0, int mode = 3) {
    if (mode & 1) for (int hh = bid; hh < 8; hh += nblk) scan_head(p, smem, hh, dry);
    if (!(mode & 2)) return;
    float d1 = 0.f, d2 = 0.f;
    for (int i = 0; i < 64; ++i) { d1 += p.in[4][i] * p.in[5][i]; d2 += p.in[6][i] * p.in[7][i]; }
    const float lam = __expf(d1) - __expf(d2) + 0.2f;
    unsigned* q = (unsigned*)(p.ws + OFF_SMALL + SM_CTL) + CW_ATTQ + (dry ? 16 : 0);
    for (;;) {
        if (threadIdx.x == 0) *(unsigned*)(smem + AT_MISC) = atomicAdd(q, 1u);
        __syncthreads();
        const unsigned u = *(unsigned*)(smem + AT_MISC);
        __syncthreads();
        if (u >= (unsigned)AT_UNITS) break;
        attention_unit(p, smem, (int)(u & 7u), NQB - 1 - (int)(u >> 3), lam, dry);
    }
}

DI void phase4(const Params& p, char* smem, int bid, int nblk) {
    const int tid = fresh_tid(), lane = tid & 63, wave = tid >> 6;
    const int gw = bid * 8 + wave, NGW = nblk * 8;
    unsigned char* ws = p.ws;
    char* wl = smem + wave * 16384;
    for (int it = gw; it < 32 * 384; it += NGW) {
        const int e = it / 384, r = it % 384, m = r >> 7, q = r & 127;
        if (m < 2) transpose_item(p.in[21 + m] + (size_t)e * 1024 * 256, 256, 1024, (bf16*)(ws + (m == 0 ? OFF_EXG : OFF_EXU)) + (size_t)e * 256 * 1024, (q >> 3) * 64, (q & 7) * 32, (q & 7) * 32, (float*)wl, lane);
        else transpose_item(p.in[23] + (size_t)e * 256 * 1024, 1024, 256, (bf16*)(ws + OFF_EXD) + (size_t)e * 1024 * 256, (q >> 5) * 64, (q & 31) * 32, (q & 31) * 32, (float*)wl, lane);
    }
    for (int it = gw; it < (NCH - 1) * 8; it += NGW) {
        const int cm1 = it >> 3, head = it & 7;
        const bf16* reg = (const bf16*)(ws + OFF_V) + (size_t)cm1 * 64 * D + head * 128;
#pragma unroll 4
        for (int i = 0; i < 16; ++i) { const int row = i * 4 + (lane >> 4), ch = lane & 15; *(u32x4*)(wl + row * 256 + ch * 16) = *(const u32x4*)(reg + (size_t)row * D + ch * 8); }
        WAVE_SYNC();
        float ss = 0.f;
#pragma unroll 8
        for (int dv = 0; dv < 128; ++dv) { const float v = bf2f(*(const bf16*)(wl + (dv >> 1) * 256 + ((dv & 1) * 64 + lane) * 2)); ss += v * v; }
        const float rstd = rsqrtf(ss * (1.0f / 128.0f) + NORM_EPS);
        const size_t j = (size_t)cm1 * 64 + lane;
        const bf16* gsrc = (const bf16*)(ws + OFF_DG) + j * D + head * 128;
        bf16* dst = (bf16*)(ws + OFF_OD) + j * D + head * 128;
#pragma unroll 2
        for (int d8 = 0; d8 < 16; ++d8) {
            const u32x4 gv = *(const u32x4*)(gsrc + 8 * d8);
            const f32x4 w0 = *(const f32x4*)(p.in[12] + 8 * d8), w1 = *(const f32x4*)(p.in[12] + 8 * d8 + 4);
            float o[8];
#pragma unroll
            for (int c = 0; c < 8; ++c) { const int dv = 8 * d8 + c; o[c] = bf2f(*(const bf16*)(wl + (dv >> 1) * 256 + ((dv & 1) * 64 + lane) * 2)) * rstd; }
            o[0] *= w0[0] * siluf_(bflo(gv.x)); o[1] *= w0[1] * siluf_(bfhi(gv.x)); o[2] *= w0[2] * siluf_(bflo(gv.y)); o[3] *= w0[3] * siluf_(bfhi(gv.y));
            o[4] *= w1[0] * siluf_(bflo(gv.z)); o[5] *= w1[1] * siluf_(bfhi(gv.z)); o[6] *= w1[2] * siluf_(bflo(gv.w)); o[7] *= w1[3] * siluf_(bfhi(gv.w));
            *(u32x4*)(dst + 8 * d8) = (u32x4){pk2(o[0], o[1]), pk2(o[2], o[3]), pk2(o[4], o[5]), pk2(o[6], o[7])};
        }
        WAVE_SYNC();
    }
}

template <int NB, int NI>
DI void rowgemm64(const bf16* arow, const bf16* const (&bptr)[NB], char* stg, f32x16 (&acc)[NB][2][NI]) {
    const int tid = fresh_tid(), lane = tid & 63, r32 = lane & 31, h = lane >> 5;
    const int lrow = tid >> 3, lc = tid & 7;
    u32x4 ra = arow ? *(const u32x4*)arow : (u32x4){0u, 0u, 0u, 0u};
    *(u32x4*)(stg + swz128(lrow, lc)) = ra;
    __syncthreads();
    for (int kc = 0; kc < 16; ++kc) {
        const int buf = kc & 1;
        if (kc + 1 < 16) ra = arow ? *(const u32x4*)(arow + (kc + 1) * 64) : (u32x4){0u, 0u, 0u, 0u};
#pragma unroll
        for (int ks = 0; ks < 4; ++ks) {
            bf16x8 af[2];
#pragma unroll
            for (int mi = 0; mi < 2; ++mi) af[mi] = *(const bf16x8*)(stg + buf * 8192 + swz128(32 * mi + r32, 2 * ks + h));
#pragma unroll
            for (int b = 0; b < NB; ++b)
#pragma unroll
                for (int ni = 0; ni < NI; ++ni) {
                    const bf16x8 bfr = *(const bf16x8*)(bptr[b] + (size_t)ni * 32 * 1024 + kc * 64 + ks * 16);
#pragma unroll
                    for (int mi = 0; mi < 2; ++mi) acc[b][mi][ni] = MFMA32(af[mi], bfr, acc[b][mi][ni]);
                }
        }
        if (kc + 1 < 16) *(u32x4*)(stg + (buf ^ 1) * 8192 + swz128(lrow, lc)) = ra;
        __syncthreads();
    }
}

constexpr int P5_MIX = 0, P5_PITCH = 2064, P5_STG = 64 * P5_PITCH, P5_MISC = P5_STG + 16384;
DI void post_block(const Params& p, char* smem, int rb, int dry) {
    int tid_ = threadIdx.x;
#ifndef EMU
    asm volatile("" : "+v"(tid_));
#endif
    const int tid = tid_, lane = tid & 63, wave = tid >> 6, r32 = lane & 31, h = lane >> 5;
    unsigned char* ws = p.ws;
    const int row0 = rb * 64, lrow = tid >> 3, lc = tid & 7;
    const bf16* Wt_in = (const bf16*)(ws + OFF_WTIN);
    char* stg = smem + P5_STG;
#pragma unroll 1
    for (int ps = 0; ps < 4; ++ps) {
        const int n0 = 128 * wave + 32 * ps + r32;
        f32x16 G[2][2][1];
#pragma unroll
        for (int b = 0; b < 2; ++b)
#pragma unroll
            for (int mi = 0; mi < 2; ++mi) G[b][mi][0] = zero16();
        {
            const bf16* const bp[2] = {Wt_in + (size_t)(7168 + n0) * 1024 + 8 * h, Wt_in + (size_t)(8192 + n0) * 1024 + 8 * h};
            rowgemm64<2, 1>((const bf16*)(ws + OFF_U) + (size_t)(row0 + lrow) * D + lc * 8, bp, stg, G);
        }
#pragma unroll
        for (int b = 0; b < 2; ++b)
#pragma unroll
            for (int mi = 0; mi < 2; ++mi)
#pragma unroll
                for (int r = 0; r < 16; ++r) G[b][mi][0][r] = sigmoidf_(G[b][mi][0][r]);
#pragma unroll 1
        for (int br = 0; br < 2; ++br) {
            f32x16 Y[1][2][1];
#pragma unroll
            for (int mi = 0; mi < 2; ++mi) Y[0][mi][0] = zero16();
            const bf16* const bp[1] = {(const bf16*)(ws + (br == 0 ? OFF_WTBA : OFF_WTBD)) + (size_t)n0 * 1024 + 8 * h};
            rowgemm64<1, 1>((const bf16*)(ws + (br == 0 ? OFF_AQ : OFF_OD)) + (size_t)(row0 + lrow) * D + lc * 8, bp, stg, Y);
            if (br == 0) {
#pragma unroll
                for (int mi = 0; mi < 2; ++mi) G[0][mi][0] = G[0][mi][0] * Y[0][mi][0];
            } else {
#pragma unroll
                for (int mi = 0; mi < 2; ++mi) G[0][mi][0] = G[0][mi][0] + G[1][mi][0] * Y[0][mi][0];
            }
        }
#pragma unroll
        for (int mi = 0; mi < 2; ++mi)
#pragma unroll
            for (int r = 0; r < 16; ++r) {
                const int row = 32 * mi + (r & 3) + 8 * (r >> 2) + 4 * h, col = 128 * wave + 32 * ps + r32;
                *(bf16*)(smem + P5_MIX + row * P5_PITCH + col * 2) = (bf16)f2bf(G[0][mi][0][r]);
            }
    }
    __syncthreads();
    float* partial = (float*)(smem + P5_MISC); float* rstdl = (float*)(smem + P5_MISC + 2048); float* logl = (float*)(smem + P5_MISC + 2048 + 256);
    {
        float rs[2][16];
#pragma unroll
        for (int mi = 0; mi < 2; ++mi)
#pragma unroll
            for (int r = 0; r < 16; ++r) rs[mi][r] = 0.f;
#pragma unroll 1
        for (int ps = 0; ps < 2; ++ps) {
            f32x16 H[2][2];
#pragma unroll
            for (int mi = 0; mi < 2; ++mi)
#pragma unroll
                for (int ni = 0; ni < 2; ++ni) H[mi][ni] = zero16();
            const bf16* bp = (const bf16*)(ws + OFF_WTOUT) + (size_t)(128 * wave + 64 * ps + r32) * 1024 + 8 * h;
#pragma unroll 2
            for (int ks = 0; ks < 64; ++ks) {
                bf16x8 af[2];
#pragma unroll
                for (int mi = 0; mi < 2; ++mi) af[mi] = *(const bf16x8*)(smem + P5_MIX + (32 * mi + r32) * P5_PITCH + (2 * ks + h) * 16);
#pragma unroll
                for (int ni = 0; ni < 2; ++ni) {
                    const bf16x8 bfr = *(const bf16x8*)(bp + (size_t)ni * 32 * 1024 + ks * 16);
#pragma unroll
                    for (int mi = 0; mi < 2; ++mi) H[mi][ni] = MFMA32(af[mi], bfr, H[mi][ni]);
                }
            }
#pragma unroll
            for (int mi = 0; mi < 2; ++mi)
#pragma unroll
                for (int ni = 0; ni < 2; ++ni)
#pragma unroll
                    for (int r = 0; r < 16; ++r) {
                        const int row = 32 * mi + (r & 3) + 8 * (r >> 2) + 4 * h, col = 128 * wave + 64 * ps + 32 * ni + r32;
                        const float hv = H[mi][ni][r] + p.in[0][(size_t)(row0 + row) * D + col];
                        rs[mi][r] += hv * hv;
                        if (!dry) p.out[(size_t)(row0 + row) * D + col] = hv;
                    }
        }
#pragma unroll
        for (int mi = 0; mi < 2; ++mi)
#pragma unroll
            for (int r = 0; r < 16; ++r) {
                float v = rs[mi][r];
                v += __shfl_xor(v, 1); v += __shfl_xor(v, 2); v += __shfl_xor(v, 4); v += __shfl_xor(v, 8); v += __shfl_xor(v, 16);
                if (r32 == 0) partial[(32 * mi + (r & 3) + 8 * (r >> 2) + 4 * h) * 8 + wave] = v;
            }
    }
    __threadfence();
    __syncthreads();
    if (tid < 64) { float s = 0.f;
#pragma unroll
        for (int w = 0; w < 8; ++w) s += partial[tid * 8 + w];
        rstdl[tid] = rsqrtf(s * (1.0f / D) + NORM_EPS); }
    __syncthreads();
#pragma unroll 2
    for (int i = 0; i < 16; ++i) {
        const int idx = tid + NT * i, row = idx >> 7, ch = idx & 127;
        const float* hp = p.out + (size_t)(row0 + row) * D + ch * 8;
        const f32x4 a = LD_NT((const f32x4*)hp), b = LD_NT((const f32x4*)(hp + 4));
        const f32x4 w0 = *(const f32x4*)(p.in[16] + ch * 8), w1 = *(const f32x4*)(p.in[16] + ch * 8 + 4);
        const float rs = rstdl[row];
        if (!dry) *(u32x4*)((bf16*)(ws + OFF_OD) + (size_t)(row0 + row) * D + ch * 8) =
            (u32x4){pk2(a[0] * rs * w0[0], a[1] * rs * w0[1]), pk2(a[2] * rs * w0[2], a[3] * rs * w0[3]), pk2(b[0] * rs * w1[0], b[1] * rs * w1[1]), pk2(b[2] * rs * w1[2], b[3] * rs * w1[3])};
    }
    float lg[36];
#pragma unroll
    for (int c = 0; c < 36; ++c) lg[c] = 0.f;
    float* HL = (float*)(smem + P5_MIX);
    const float* WR = (const float*)(ws + OFF_SMALL + SM_WR);
#pragma unroll 1
    for (int half = 0; half < 2; ++half) {
        __syncthreads();
#pragma unroll 4
        for (int i = 0; i < 16; ++i) {
            const int idx = tid + NT * i, row = idx >> 7, c4 = idx & 127;
            const f32x4 a = LD_NT((const f32x4*)(p.out + (size_t)(row0 + row) * D + 512 * half + c4 * 4));
            float* d = HL + row * 513 + c4 * 4; d[0] = a[0]; d[1] = a[1]; d[2] = a[2]; d[3] = a[3];
        }
        __syncthreads();
        const int kb = 64 * wave;
#pragma unroll 1
        for (int kk = 0; kk < 64; ++kk) {
            const float hv = HL[lane * 513 + kb + kk];
            const float* wr = WR + (size_t)(512 * half + kb + kk) * 40;
#pragma unroll
            for (int c = 0; c < 36; ++c) lg[c] += hv * wr[c];
        }
    }
    __syncthreads();
    float* PL = (float*)(smem + P5_MIX);
#pragma unroll
    for (int c = 0; c < 36; ++c) PL[(lane * 8 + wave) * 36 + c] = lg[c];
    __syncthreads();
    if (tid < 64) {
        const float rs = rstdl[tid];
        for (int c = 0; c < 36; ++c) { float s = 0.f; for (int w = 0; w < 8; ++w) s += PL[(tid * 8 + w) * 36 + c]; logl[tid * 40 + c] = s * rs + (c < 4 ? p.in[18][c] : p.in[20][c - 4]); }
        const float* L = logl + tid * 40;
        int gi = 0; float gm = L[0];
        for (int c = 1; c < 4; ++c) if (L[c] > gm) { gm = L[c]; gi = c; }
        float gs = 0.f; for (int c = 0; c < 4; ++c) gs += __expf(L[c] - gm);
        const float gw = 1.0f / gs;
        const float* E = L + 4 + 8 * gi;
        int i1 = 0; float l1 = E[0];
        for (int c = 1; c < 8; ++c) if (E[c] > l1) { l1 = E[c]; i1 = c; }
        int i2 = -1; float l2 = -3.0e38f;
        for (int c = 0; c < 8; ++c) if (c != i1 && E[c] > l2) { l2 = E[c]; i2 = c; }
        const float t = __expf(l2 - l1), w1 = 1.0f / (1.0f + t), w2 = t / (1.0f + t);
        unsigned* cnt = (unsigned*)(ws + OFF_SMALL + SM_CTL) + CW_ECNT;
        int* lists = (int*)(ws + OFF_SMALL + SM_TAILS); float* RW = (float*)(ws + OFF_SMALL + SM_RW);
        const int j = row0 + tid;
        const int e1 = 8 * gi + i1, e2 = 8 * gi + i2;
        if (!dry) {
        const unsigned p1 = atomicAdd(cnt + e1, 1u); ST_ATOMIC(lists + (size_t)e1 * SEQ + p1, (j << 1)); RW[2 * j] = gw * w1;
        const unsigned p2 = atomicAdd(cnt + e2, 1u); ST_ATOMIC(lists + (size_t)e2 * SEQ + p2, (j << 1) | 1); RW[2 * j + 1] = gw * w2;
        } else { asm volatile("" :: "v"(e1), "v"(e2), "v"(gw * w1), "v"(gw * w2)); }
    }
    __syncthreads();
}
DI void phase5(const Params& p, char* smem, int bid, int nblk, int dry = 0) {
    for (int rb = bid; rb < SEQ / 64; rb += nblk) post_block(p, smem, rb, dry);
}

constexpr int P6_HL = 0, P6_PITCH = 528, P6_STG = 64 * P6_PITCH, P6_TOK = P6_STG + 16384, P6_RW = P6_TOK + 256, P6_TS = P6_RW + 256;
DI void moe_item(const Params& p, char* smem, int e, int mt, int cnt_e) {
    const int tid = fresh_tid(), lane = tid & 63, wave = tid >> 6, r32 = lane & 31, h = lane >> 5;
    unsigned char* ws = p.ws;
    int* tokl = (int*)(smem + P6_TOK); float* rwl = (float*)(smem + P6_RW);
    if (tid < 64) {
        const int idx = 64 * mt + tid; int ent = -1; float w = 0.f;
        if (idx < cnt_e) { ent = ((const int*)(ws + OFF_SMALL + SM_TAILS))[(size_t)e * SEQ + idx]; w = ((const float*)(ws + OFF_SMALL + SM_RW))[ent]; }
        tokl[tid] = ent; rwl[tid] = w;
    }
    __syncthreads();
    const int lrow = tid >> 3, lc = tid & 7;
    const int lent = tokl[lrow];
    f32x16 GU[2][2][1];
#pragma unroll
    for (int b = 0; b < 2; ++b)
#pragma unroll
        for (int mi = 0; mi < 2; ++mi) GU[b][mi][0] = zero16();
    {
        const bf16* const bp[2] = {(const bf16*)(ws + OFF_EXG) + ((size_t)e * 256 + 32 * wave + r32) * 1024 + 8 * h, (const bf16*)(ws + OFF_EXU) + ((size_t)e * 256 + 32 * wave + r32) * 1024 + 8 * h};
        rowgemm64<2, 1>(lent >= 0 ? (const bf16*)(ws + OFF_OD) + (size_t)(lent >> 1) * D + lc * 8 : nullptr, bp, smem + P6_STG, GU);
    }
#pragma unroll
    for (int mi = 0; mi < 2; ++mi)
#pragma unroll
        for (int r = 0; r < 16; ++r) {
            const int row = 32 * mi + (r & 3) + 8 * (r >> 2) + 4 * h, col = 32 * wave + r32;
            *(bf16*)(smem + P6_HL + row * P6_PITCH + col * 2) = (bf16)f2bf(siluf_(GU[0][mi][0][r]) * GU[1][mi][0][r]);
        }
    __syncthreads();
#pragma unroll 1
    for (int ps = 0; ps < 2; ++ps) {
        f32x16 Y[2][2];
#pragma unroll
        for (int mi = 0; mi < 2; ++mi)
#pragma unroll
            for (int ni = 0; ni < 2; ++ni) Y[mi][ni] = zero16();
        const bf16* bp = (const bf16*)(ws + OFF_EXD) + ((size_t)e * 1024 + 128 * wave + 64 * ps + r32) * 256 + 8 * h;
#pragma unroll 4
        for (int ks = 0; ks < 16; ++ks) {
            bf16x8 af[2];
#pragma unroll
            for (int mi = 0; mi < 2; ++mi) af[mi] = *(const bf16x8*)(smem + P6_HL + (32 * mi + r32) * P6_PITCH + (2 * ks + h) * 16);
#pragma unroll
            for (int ni = 0; ni < 2; ++ni) {
                const bf16x8 bfr = *(const bf16x8*)(bp + (size_t)ni * 32 * 256 + ks * 16);
#pragma unroll
                for (int mi = 0; mi < 2; ++mi) Y[mi][ni] = MFMA32(af[mi], bfr, Y[mi][ni]);
            }
        }
#pragma unroll
        for (int mi = 0; mi < 2; ++mi)
#pragma unroll
            for (int r = 0; r < 16; ++r) {
                const int row = 32 * mi + (r & 3) + 8 * (r >> 2) + 4 * h; const int ent = tokl[row];
                if (ent >= 0) {
                    const float w = rwl[row]; bf16* dst = (bf16*)(ws + OFF_Y) + (size_t)ent * D + 128 * wave + 64 * ps + r32;
#pragma unroll
                    for (int ni = 0; ni < 2; ++ni) dst[32 * ni] = (bf16)f2bf(Y[mi][ni][r] * w);
                }
            }
    }
    __syncthreads();
}
DI void phase6(const Params& p, char* smem, int bid, int nblk) {
    int* ts = (int*)(smem + P6_TS);
    unsigned* cnt = (unsigned*)(p.ws + OFF_SMALL + SM_CTL) + CW_ECNT;
    int* tc = (int*)(smem + P6_TS + 256);
    if (threadIdx.x < 32) tc[threadIdx.x] = (int)LD_ATOMIC(cnt + threadIdx.x);
    __syncthreads();
    if (threadIdx.x == 0) { int s = 0; for (int e = 0; e < 32; ++e) { ts[e] = s; s += (tc[e] + 63) >> 6; } ts[32] = s; }
    __syncthreads();
    const int total = ts[32];
    for (int t = bid; t < total; t += nblk) {
        int e = 0;
        for (int q = 1; q < 32; ++q) if (ts[q] <= t) e = q;
        moe_item(p, smem, e, t - ts[e], tc[e]);
    }
}

DI void phase7(const Params& p, char* smem, int bid, int nblk, int dry = 0) {
    const int tid = fresh_tid(), lane = tid & 63, wave = tid >> 6;
    const int gw = bid * 8 + wave, NGW = nblk * 8;
    for (int j = gw; j < SEQ; j += NGW) {
        float* hrow = p.out + (size_t)j * D;
        const bf16* y0 = (const bf16*)(p.ws + OFF_Y) + (size_t)j * 2 * D;
        float4 v[4]; float ss = 0.f;
#pragma unroll
        for (int q = 0; q < 4; ++q) {
            const int c = 4 * lane + 256 * q;
            v[q] = *(const float4*)(hrow + c);
            const u32x2 a = *(const u32x2*)(y0 + c), b = *(const u32x2*)(y0 + D + c);
            v[q].x += bflo(a.x) + bflo(b.x); v[q].y += bfhi(a.x) + bfhi(b.x); v[q].z += bflo(a.y) + bflo(b.y); v[q].w += bfhi(a.y) + bfhi(b.y);
            ss += v[q].x * v[q].x + v[q].y * v[q].y + v[q].z * v[q].z + v[q].w * v[q].w;
        }
        ss = wave_sum(ss);
        const float rstd = rsqrtf(ss * (1.0f / D) + NORM_EPS);
#pragma unroll
        for (int q = 0; q < 4; ++q) {
            const int c = 4 * lane + 256 * q; const float4 w4 = *(const float4*)(p.in[24] + c);
            if (!dry) *(float4*)(hrow + c) = make_float4(v[q].x * rstd * w4.x, v[q].y * rstd * w4.y, v[q].z * rstd * w4.z, v[q].w * rstd * w4.w);
        }
    }
}

__global__ void __launch_bounds__(NT) k_phase0(Params p) { SMEM_DECL; phase0(p, smem, blockIdx.x, gridDim.x); }
__global__ void __launch_bounds__(NT) k_phase1(Params p) { SMEM_DECL; phase1(p, smem, blockIdx.x, gridDim.x); }
__global__ void __launch_bounds__(NT) k_phase2(Params p) { SMEM_DECL; phase2(p, smem, blockIdx.x, gridDim.x, 0); }
__global__ void __launch_bounds__(NT) k_phase3(Params p) { SMEM_DECL; phase3(p, smem, blockIdx.x, gridDim.x); }
__global__ void __launch_bounds__(NT) k_phase4(Params p) { SMEM_DECL; phase4(p, smem, blockIdx.x, gridDim.x); }
__global__ void __launch_bounds__(NT) k_phase5(Params p) { SMEM_DECL; phase5(p, smem, blockIdx.x, gridDim.x); }
__global__ void __launch_bounds__(NT) k_phase6(Params p) { SMEM_DECL; phase6(p, smem, blockIdx.x, gridDim.x); }
__global__ void __launch_bounds__(NT) k_phase7(Params p) { SMEM_DECL; phase7(p, smem, blockIdx.x, gridDim.x); }

constexpr int LDS_BYTES = 160 * 1024 - 256;
constexpr int LDS_BARST = LDS_BYTES - 16;

#ifndef EMU
#define LAS __attribute__((address_space(3)))
#define XB_TMO      128
#define XB_XCNT(j)  (256  + 64 * (j))
#define XB_XSUB(j)  (1280 + 64 * (j))
#define XB_XGEN(j)  (2304 + 64 * (j))
#define XB_TOP      3328
#define XB_TOPGEN   3392
#define XCD_BAR_WORDS 3456
#define XB_SPIN_CAP (1u << 22)
__device__ __forceinline__ unsigned xb_ld(unsigned* p)              { return __hip_atomic_load(p, __ATOMIC_RELAXED, __HIP_MEMORY_SCOPE_AGENT); }
__device__ __forceinline__ unsigned xb_add(unsigned* p, unsigned v) { return __hip_atomic_fetch_add(p, v, __ATOMIC_RELAXED, __HIP_MEMORY_SCOPE_AGENT); }
__device__ __forceinline__ unsigned xb_xcc_id() { return (unsigned)__builtin_amdgcn_s_getreg((3 << 11) | 20) & 0xFu; }
#define XB_SPIN(cond, bar) do { unsigned _sp = 0; while (cond) { __builtin_amdgcn_s_sleep(1); \
    if ((++_sp & 255u) == 0u) { if (xb_ld(&(bar)[XB_TMO])) break; if (_sp > XB_SPIN_CAP) { atomicAdd(&(bar)[XB_TMO], 1u); break; } } } } while (0)
struct XcdBarrier { unsigned* bar; unsigned x; volatile LAS unsigned* st; };
__device__ __forceinline__ XcdBarrier xcd_barrier_post(unsigned* bar, volatile LAS unsigned* st) {
    XcdBarrier b; b.bar = bar; b.x = xb_xcc_id(); b.st = st;
    if (threadIdx.x == 0) (void)xb_add(&bar[XB_XCNT(b.x)], 1u);
    return b;
}
__device__ __forceinline__ void xcd_barrier_complete(unsigned* bar, unsigned x, unsigned& nloc, unsigned& nx) {
    const unsigned G = gridDim.x * gridDim.y * gridDim.z;
    unsigned sum, cnt, mine, sp = 0u;
    for (;;) {
        sum = 0u; cnt = 0u; mine = 0u;
#pragma unroll
        for (unsigned j = 0; j < 16; ++j) { const unsigned c = xb_ld(&bar[XB_XCNT(j)]); sum += c; cnt += (c > 0u) ? 1u : 0u; mine = (j == x) ? c : mine; }
        if (sum == G) break;
        __builtin_amdgcn_s_sleep(1);
        if ((++sp & 255u) == 0u) { if (xb_ld(&bar[XB_TMO])) break; if (sp > XB_SPIN_CAP) { atomicAdd(&bar[XB_TMO], 1u); break; } }
    }
    nloc = mine > 0u ? mine : 1u; nx = cnt > 0u ? cnt : 1u;
}
__device__ __forceinline__ void xcd_barrier(const XcdBarrier& b) {
    asm volatile("s_waitcnt vmcnt(0)" ::: "memory");
    __syncthreads();
    if (threadIdx.x == 0) {
        unsigned* bar = b.bar;
        __builtin_amdgcn_s_waitcnt(0);
        unsigned nloc = b.st[0], nx = b.st[1];
        if (nloc == 0u) { xcd_barrier_complete(bar, b.x, nloc, nx); b.st[0] = nloc; b.st[1] = nx; }
        const unsigned old = xb_add(&bar[XB_XSUB(b.x)], 1u);
        const unsigned gen = old / nloc;
        if (old + 1u == (gen + 1u) * nloc) {
            __builtin_amdgcn_fence(__ATOMIC_RELEASE, "agent");
            asm volatile("s_waitcnt vmcnt(0)" ::: "memory");
            const unsigned og = xb_add(&bar[XB_TOP], 1u);
            const unsigned tg = og / nx;
            if (og + 1u == (tg + 1u) * nx) xb_add(&bar[XB_TOPGEN], 1u);
            else XB_SPIN(xb_ld(&bar[XB_TOPGEN]) == tg, bar);
            __builtin_amdgcn_fence(__ATOMIC_ACQUIRE, "agent");
            xb_add(&bar[XB_XGEN(b.x)], 1u);
            asm volatile("s_waitcnt vmcnt(0)" ::: "memory");
        } else {
            XB_SPIN(xb_ld(&bar[XB_XGEN(b.x)]) == gen, bar);
            __builtin_amdgcn_fence(__ATOMIC_ACQUIRE, "agent");
            asm volatile("s_waitcnt vmcnt(0)" ::: "memory");
        }
    }
    __syncthreads();
}
#endif

#ifdef EMU
#define GRID_SYNC() emu_grid_sync()
#define GRID_SYNC_CG() emu_grid_sync()
#else
#define GRID_SYNC_CG() do { \
    asm volatile("s_waitcnt vmcnt(0)" ::: "memory"); \
    __syncthreads(); \
    cooperative_groups::this_grid().sync(); \
    if (threadIdx.x == 0) { __builtin_amdgcn_fence(__ATOMIC_ACQUIRE, "agent"); asm volatile("s_waitcnt vmcnt(0)" ::: "memory"); } \
    __syncthreads(); \
} while (0)
#define GRID_SYNC() xcd_barrier(xbar)
#endif
__global__ void __launch_bounds__(NT) fwd_megakernel(Params p) {
    SMEM_DECL;
    const int bid = blockIdx.x, nblk = gridDim.x;
#ifndef EMU
    if (threadIdx.x < 4) ((volatile LAS unsigned*)(smem + LDS_BARST))[threadIdx.x] = 0u;
    __syncthreads();
    const XcdBarrier xbar = xcd_barrier_post((unsigned*)(p.ws + OFF_SMALL + SM_CTL) + CW_BAR, (volatile LAS unsigned*)(smem + LDS_BARST));
#endif
#if defined(DRY_PHASE) && !defined(EMU)
    int dryflag = 1; asm volatile("" : "+s"(dryflag));
#define EXTRA(k, call) do { if (DRY_PHASE == (k)) { call; GRID_SYNC(); } } while (0)
#else
#define EXTRA(k, call) do {} while (0)
    const int dryflag = 0; (void)dryflag;
#endif
    EXTRA(0, phase0(p, smem, bid, nblk));
    phase0(p, smem, bid, nblk); GRID_SYNC_CG();
    EXTRA(1, phase1(p, smem, bid, nblk));
    phase1(p, smem, bid, nblk); GRID_SYNC();
    EXTRA(2, phase2(p, smem, bid, nblk, dryflag));
    phase2(p, smem, bid, nblk); GRID_SYNC();
    EXTRA(3, phase3(p, smem, bid, nblk, dryflag));
    EXTRA(8, phase3(p, smem, bid, nblk, dryflag, 1));
    EXTRA(9, phase3(p, smem, bid, nblk, dryflag, 2));
    phase3(p, smem, bid, nblk); GRID_SYNC();
    EXTRA(4, phase4(p, smem, bid, nblk));
    phase4(p, smem, bid, nblk); GRID_SYNC();
    EXTRA(5, phase5(p, smem, bid, nblk, dryflag));
    phase5(p, smem, bid, nblk); GRID_SYNC();
    EXTRA(6, phase6(p, smem, bid, nblk));
    phase6(p, smem, bid, nblk); GRID_SYNC();
    EXTRA(7, phase7(p, smem, bid, nblk, dryflag));
    phase7(p, smem, bid, nblk);
}

#ifndef EMU
extern "C" void kernel_launch(void* const* d_in, const int* in_sizes, int n_in, void* d_out, int out_size, void* d_ws, size_t ws_size, hipStream_t stream) {
    static int grid = 0;
    if (grid == 0) {
        if (n_in != 25 || ws_size < WS_END || out_size != SEQ * D) { fprintf(stderr, "kernel_launch: unexpected problem (n_in %d, ws %zu, out %d)\n", n_in, ws_size, out_size); grid = -1; return; }
        int dev = 0, cus = 0, per_cu = 0;
        (void)hipGetDevice(&dev);
        (void)hipDeviceGetAttribute(&cus, hipDeviceAttributeMultiprocessorCount, dev);
        (void)hipFuncSetAttribute((const void*)fwd_megakernel, hipFuncAttributeMaxDynamicSharedMemorySize, LDS_BYTES);
        (void)hipOccupancyMaxActiveBlocksPerMultiprocessor(&per_cu, (const void*)fwd_megakernel, NT, LDS_BYTES);
        if (per_cu < 1) { fprintf(stderr, "kernel_launch: occupancy query returned %d\n", per_cu); per_cu = 1; }
        grid = cus * per_cu;
    }
    if (grid < 0) return;
    Params p{};
    for (int i = 0; i < 25; ++i) p.in[i] = (const float*)d_in[i];
    p.out = (float*)d_out; p.ws = (unsigned char*)d_ws;
    (void)hipMemsetAsync((unsigned char*)d_ws + OFF_SMALL + SM_CTL + (size_t)CW_BAR * 4, 0, (size_t)XCD_BAR_WORDS * 4, stream);
    void* args[] = {&p};
    hipError_t e = hipLaunchCooperativeKernel((const void*)fwd_megakernel, dim3(grid), dim3(NT), args, LDS_BYTES, stream);
    if (e != hipSuccess) fprintf(stderr, "cooperative launch failed: %s (grid %d)\n", hipGetErrorString(e), grid);
}
#endif

#ifdef EMU
static void run_phases(Params p, int upto, int grid) {
    if (upto == 100) { emu::launch([=] { fwd_megakernel(p); }, grid, NT, LDS_BYTES, true); return; }
    if (upto >= 0) emu::launch([=] { k_phase0(p); }, grid, NT, LDS_BYTES, false);
    if (upto >= 1) emu::launch([=] { k_phase1(p); }, grid, NT, LDS_BYTES, false);
    if (upto >= 2) emu::launch([=] { k_phase2(p); }, grid, NT, LDS_BYTES, false);
    if (upto >= 3) emu::launch([=] { k_phase3(p); }, grid, NT, LDS_BYTES, false);
    if (upto >= 4) emu::launch([=] { k_phase4(p); }, grid, NT, LDS_BYTES, false);
    if (upto >= 5) emu::launch([=] { k_phase5(p); }, grid, NT, LDS_BYTES, false);
    if (upto >= 6) emu::launch([=] { k_phase6(p); }, grid, NT, LDS_BYTES, false);
    if (upto >= 7) emu::launch([=] { k_phase7(p); }, grid, NT, LDS_BYTES, false);
}
#endif
```

```cpp
#ifndef EMU
#include <hip/hip_runtime.h>
#include <hip/hip_cooperative_groups.h>
#include <cstdio>
#include <cstdint>
#include <cmath>
#endif

#ifndef SEQ
#define SEQ 16384
#endif

typedef unsigned short bf16;
typedef short bf16x8 __attribute__((ext_vector_type(8)));
typedef short bf16x4 __attribute__((ext_vector_type(4)));
typedef float f32x16 __attribute__((ext_vector_type(16)));
typedef float f32x4 __attribute__((ext_vector_type(4)));
typedef unsigned u32x4 __attribute__((ext_vector_type(4)));
typedef unsigned u32x2 __attribute__((ext_vector_type(2)));

#ifdef EMU
#define MFMA32(a, b, c) emu_mfma_32x32x16((a), (b), (c))
#define MFMA16(a, b, c) emu_mfma_16x16x32((a), (b), (c))
#define DI static inline
#define EXP2F(x) exp2f(x)
#define WAVE_SYNC() emu_wave_sync()
#define LD_NT(p) (*(p))
#define LD_ATOMIC(p) (*(p))
#define ST_ATOMIC(p, v) (*(p) = (v))
#define SCHED_FENCE() do {} while (0)
#else
#define WAVE_SYNC() do { __builtin_amdgcn_fence(__ATOMIC_RELEASE, "wavefront"); __builtin_amdgcn_wave_barrier(); __builtin_amdgcn_fence(__ATOMIC_ACQUIRE, "wavefront"); } while (0)
#define MFMA32(a, b, c) __builtin_amdgcn_mfma_f32_32x32x16_bf16((a), (b), (c), 0, 0, 0)
#define LD_NT(p) __builtin_nontemporal_load(p)
#define LD_ATOMIC(p) __hip_atomic_load((p), __ATOMIC_RELAXED, __HIP_MEMORY_SCOPE_AGENT)
#define ST_ATOMIC(p, v) __hip_atomic_store((p), (v), __ATOMIC_RELAXED, __HIP_MEMORY_SCOPE_AGENT)
#define SCHED_FENCE() __builtin_amdgcn_sched_barrier(0)
#define MFMA16(a, b, c) __builtin_amdgcn_mfma_f32_16x16x32_bf16((a), (b), (c), 0, 0, 0)
#define DI __device__ __forceinline__
#define EXP2F(x) __builtin_amdgcn_exp2f(x)
#endif

constexpr int D = 1024;
constexpr int NMETA = 16;
constexpr int LTOK = SEQ + NMETA;
constexpr int NCH = SEQ / 64 + 1;
constexpr int NT = 512;
constexpr int W_IN_COLS = 9232;
constexpr float NORM_EPS = 1e-6f;
constexpr float LOG2E = 1.4426950408889634f;

constexpr size_t UNIT = (size_t)SEQ * D * 2;
constexpr size_t OFF_WTIN = 0;
constexpr size_t OFF_WTBA = OFF_WTIN + (size_t)9216 * 1024 * 2;
constexpr size_t OFF_WTBD = OFF_WTBA + (size_t)1024 * 1024 * 2;
constexpr size_t OFF_WTOUT = OFF_WTBD + (size_t)1024 * 1024 * 2;
constexpr size_t OFF_SMALL = OFF_WTOUT + (size_t)1024 * 1024 * 2;
constexpr size_t SM_CTL = 0;
constexpr size_t SM_UMETA = SM_CTL + 65536;
constexpr size_t SM_AKMETA = SM_UMETA + 16 * 1024 * 2;
constexpr size_t SM_AVTMETA = SM_AKMETA + 16 * 1024 * 2;
constexpr size_t SM_C0Q = SM_AVTMETA + 8 * 128 * 16 * 2;
constexpr size_t SM_C0K = SM_C0Q + 64 * 1024 * 2;
constexpr size_t SM_C0V = SM_C0K + 64 * 1024 * 2;
constexpr size_t SM_C0W = SM_C0V + 64 * 1024 * 2;
constexpr size_t SM_C0QK = SM_C0W + 8 * 64 * 128 * 2;
constexpr size_t SM_BETA = SM_C0QK + 8 * 64 * 64 * 2;
constexpr size_t SM_G = SM_BETA + (size_t)NCH * 64 * 8 * 4;
constexpr size_t SM_GC = SM_G + (size_t)NCH * 64 * 8 * 4;
constexpr size_t SM_WR = SM_GC + (size_t)NCH * 8 * 64 * 4;
constexpr size_t SM_RIDS = SM_WR + 1024 * 40 * 4;
constexpr size_t SM_RW = SM_RIDS + 0;
constexpr size_t SM_TAILS = SM_RW + (size_t)SEQ * 2 * 4;
constexpr size_t SM_TAILS_BYTES = ((size_t)NCH * 3 * 3072 * 2 > (size_t)32 * SEQ * 4) ? (size_t)NCH * 3 * 3072 * 2 : (size_t)32 * SEQ * 4;
constexpr size_t SM_END = SM_TAILS + SM_TAILS_BYTES;
constexpr size_t SMALL_BYTES = (SM_END + 255) & ~(size_t)255;
constexpr size_t OFF_U = ((OFF_SMALL + SMALL_BYTES + (1u << 20) - 1) >> 20) << 20;
constexpr size_t OFF_W = OFF_U + UNIT;
constexpr size_t OFF_KN = OFF_W + UNIT;
constexpr size_t OFF_QN = OFF_KN + UNIT;
constexpr size_t OFF_DG = OFF_QN + UNIT;
constexpr size_t OFF_V = OFF_DG + UNIT;
constexpr size_t OFF_AQ = OFF_V + UNIT;
constexpr size_t WS_BASE_END = OFF_AQ + UNIT;
constexpr size_t EXPERT_BYTES = (size_t)32 * 3 * 1024 * 256 * 2;
constexpr size_t OFF_EXP = (2 * UNIT >= EXPERT_BYTES) ? OFF_W : WS_BASE_END;
constexpr size_t WS_END = (OFF_EXP == OFF_W) ? WS_BASE_END : WS_BASE_END + EXPERT_BYTES;
constexpr size_t OFF_EXG = OFF_EXP, OFF_EXU = OFF_EXP + EXPERT_BYTES / 3, OFF_EXD = OFF_EXP + 2 * (EXPERT_BYTES / 3);
constexpr size_t OFF_QKB = OFF_U;
constexpr size_t OFF_OD = OFF_QN;
constexpr size_t OFF_Y = OFF_V;
#if SEQ == 16384
static_assert(WS_END <= (size_t)256 << 20, "workspace map exceeds 256 MiB");
static_assert(EXPERT_BYTES <= 2 * UNIT, "experts fit R2+R3");
#endif
constexpr int CW_ATTQ = 64;
constexpr int CW_ECNT = 128;
constexpr int CW_NRM = 256;
constexpr int CW_BAR = 1024;

struct Params {
    const float* in[25];
    float* out;
    unsigned char* ws;
};

DI unsigned f2bf(float f) { unsigned u = __builtin_bit_cast(unsigned, f); return (u + 0x7fffu + ((u >> 16) & 1u)) >> 16; }
DI float bf2f(unsigned b) { return __builtin_bit_cast(float, (b & 0xffffu) << 16); }
#ifdef EMU
DI unsigned pk2(float lo, float hi) { return f2bf(lo) | (f2bf(hi) << 16); }
DI bool wave_any(bool pr) { int v = pr ? 1 : 0;
    for (int o = 1; o < 64; o <<= 1) v |= __shfl_xor(v, o);
    return v != 0; }
#else
typedef __bf16 hwbf2 __attribute__((ext_vector_type(2)));
typedef float f32x2_ __attribute__((ext_vector_type(2)));
DI unsigned pk2(float lo, float hi) { return __builtin_bit_cast(unsigned, __builtin_convertvector((f32x2_){lo, hi}, hwbf2)); }
DI bool wave_any(bool pr) { return __any(pr) != 0; }
#endif
DI float bflo(unsigned w) { return __builtin_bit_cast(float, w << 16); }
DI float bfhi(unsigned w) { return __builtin_bit_cast(float, w & 0xffff0000u); }
DI float sigmoidf_(float x) { return 1.0f / (1.0f + __expf(-x)); }
DI float siluf_(float x) { return x / (1.0f + __expf(-x)); }
DI float wave_sum(float v) {
#pragma unroll
    for (int o = 1; o < 64; o <<= 1) v += __shfl_xor(v, o);
    return v;
}
DI int fresh_tid() {
    int t = threadIdx.x;
#ifndef EMU
    asm volatile("" : "+v"(t));
#endif
    return t;
}
DI f32x16 zero16() { f32x16 z; for (int i = 0; i < 16; ++i) z[i] = 0.f; return z; }
DI f32x4 zero4() { f32x4 z; for (int i = 0; i < 4; ++i) z[i] = 0.f; return z; }
DI int swz128(int row, int c) { return row * 128 + ((c ^ ((row >> 1) & 7)) << 4); }
DI int swz128_8(int row, int s) { return row * 128 + ((s ^ (((row >> 1) & 7) << 1)) << 3); }
DI int swzrow(int row, int pitch, int c) { return row * pitch + ((c ^ (row & 15)) << 4); }

#ifdef EMU
#define SMEM_DECL char* smem = emu_smem()
#else
#define SMEM_DECL extern __shared__ __attribute__((aligned(16))) char smem[]
#endif

DI void transpose_item(const float* W, int ldw, int K, bf16* Wt, int k0, int src_n0, int dst_n0, float* scr, int lane) {
#pragma unroll 8
    for (int i = 0; i < 32; ++i) { const int kk = 2 * i + (lane >> 5); scr[kk * 33 + (lane & 31)] = W[(size_t)(k0 + kk) * ldw + src_n0 + (lane & 31)]; }
    WAVE_SYNC();
    const int c = lane & 7;
#pragma unroll
    for (int j = 0; j < 4; ++j) {
        const int n = (lane >> 3) + 8 * j; const float* s = scr + (8 * c) * 33 + n;
        u32x4 o; o.x = pk2(s[0 * 33], s[1 * 33]); o.y = pk2(s[2 * 33], s[3 * 33]); o.z = pk2(s[4 * 33], s[5 * 33]); o.w = pk2(s[6 * 33], s[7 * 33]);
        *(u32x4*)(Wt + (size_t)(dst_n0 + n) * K + k0 + 8 * c) = o;
    }
    WAVE_SYNC();
}

DI void phase0(const Params& p, char* smem, int bid, int nblk) {
    const int tid = fresh_tid(), lane = tid & 63, wave = tid >> 6;
    const int gw = bid * 8 + wave, NGW = nblk * 8;
    unsigned char* ws = p.ws;
    if (bid == 0) {
        unsigned* ctl = (unsigned*)(ws + OFF_SMALL + SM_CTL);
        for (int i = tid; i < 1024; i += NT) ctl[i] = 0u;
        float* be = (float*)(ws + OFF_SMALL + SM_BETA); float* gg = (float*)(ws + OFF_SMALL + SM_G);
        for (int i = tid; i < 48 * 8; i += NT) { be[i] = 0.f; gg[i] = 0.f; }
    }
    {
        float* scr = (float*)(smem + 65536) + wave * (64 * 33);
        constexpr int I_IN = 16 * (9216 / 32), I_SQ = 16 * 32;
        constexpr int NITEMS = I_IN + 3 * I_SQ;
        for (int it = gw; it < NITEMS; it += NGW) {
            int r = it;
            if (r < I_IN) { const int kb = r / 288, nb = r % 288; const int dn = nb * 32; const int sn = dn < 7168 ? dn : dn + 16;
                transpose_item(p.in[3], W_IN_COLS, 1024, (bf16*)(ws + OFF_WTIN), kb * 64, sn, dn, scr, lane); continue; }
            r -= I_IN;
            const int m = r / I_SQ; r %= I_SQ;
            const float* src = m == 0 ? p.in[13] : (m == 1 ? p.in[14] : p.in[15]);
            bf16* dst = (bf16*)(ws + (m == 0 ? OFF_WTBA : (m == 1 ? OFF_WTBD : OFF_WTOUT)));
            transpose_item(src, 1024, 1024, dst, (r / 32) * 64, (r % 32) * 32, (r % 32) * 32, scr, lane);
        }
    }
    {
        float* WR = (float*)(ws + OFF_SMALL + SM_WR);
        for (int i = bid * NT + tid; i < 1024 * 40; i += nblk * NT) {
            const int k = i / 40, c = i % 40; float v = 0.f;
            if (c < 4) v = p.in[17][k * 4 + c]; else if (c < 36) v = p.in[19][k * 32 + (c - 4)];
            WR[i] = v * p.in[16][k];
        }
    }
    float* wbd = (float*)smem;
    for (int i = tid; i < 1024 * 16; i += NT) { const int k = i >> 4, c = i & 15; wbd[i] = p.in[3][(size_t)k * W_IN_COLS + 7168 + c]; }
    __syncthreads();
    const float* nw = p.in[2];
    for (int R = gw; R < LTOK; R += NGW) {
        const float* xrow = R < NMETA ? p.in[1] + (size_t)R * D : p.in[0] + (size_t)(R - NMETA) * D;
        bf16* urow = R < NMETA ? (bf16*)(ws + OFF_SMALL + SM_UMETA) + (size_t)R * D : (bf16*)(ws + OFF_U) + (size_t)(R - NMETA) * D;
        float ss = 0.f;
#pragma unroll
        for (int j = 0; j < 4; ++j) { const float4 v = *(const float4*)(xrow + 4 * lane + 256 * j); ss += v.x * v.x + v.y * v.y + v.z * v.z + v.w * v.w; }
        ss = wave_sum(ss);
        const float rstd = rsqrtf(ss * (1.0f / D) + NORM_EPS);
        float acc[16];
#pragma unroll
        for (int c = 0; c < 16; ++c) acc[c] = 0.f;
#pragma unroll 1
        for (int j = 0; j < 4; ++j) {
            const float4 w4 = *(const float4*)(nw + 4 * lane + 256 * j);
            const float4 xv = *(const float4*)(xrow + 4 * lane + 256 * j);
            float uu[4] = {xv.x * rstd * w4.x, xv.y * rstd * w4.y, xv.z * rstd * w4.z, xv.w * rstd * w4.w};
            u32x2 o; o.x = pk2(uu[0], uu[1]); o.y = pk2(uu[2], uu[3]);
            *(u32x2*)(urow + 4 * lane + 256 * j) = o;
#pragma unroll
            for (int e = 0; e < 4; ++e) {
                const float* wr = wbd + (size_t)(4 * lane + 256 * j + e) * 16;
#pragma unroll
                for (int c = 0; c < 16; ++c) acc[c] += uu[e] * wr[c];
            }
        }
#pragma unroll
        for (int c = 0; c < 16; ++c) acc[c] = wave_sum(acc[c]);
        if (lane < 16) {
            float a = 0.f;
#pragma unroll
            for (int c = 0; c < 16; ++c) a = (lane == c) ? acc[c] : a;
            const size_t pos = 48 + R;
            if (lane < 8) { ((float*)(ws + OFF_SMALL + SM_BETA))[pos * 8 + lane] = sigmoidf_(a); }
            else { const int hh = lane - 8; const float z = a + p.in[11][hh]; const float sp = fmaxf(z, 0.f) + log1pf(__expf(-fabsf(z)));
                   ((float*)(ws + OFF_SMALL + SM_G))[pos * 8 + hh] = -__expf(p.in[10][hh]) * sp; }
        }
    }
}

constexpr int G_BM = 256, G_BN = 128, G_BK = 64;
constexpr int G_LDS_A = G_BM * G_BK * 2, G_LDS_B = G_BN * G_BK * 2;
constexpr int G_STAGE_PITCH = 132;
constexpr int G_LDS_BYTES = G_BM * G_STAGE_PITCH * 4;
constexpr int G_MT = SEQ / 256 + 1, G_NTILES = 56;

DI void gemm_inproj_tile(const Params& p, char* smem, int mt, int nt) {
    const int tid = fresh_tid(), lane = tid & 63, wave = tid >> 6;
    const int wm = wave >> 1, wn = wave & 1, r32 = lane & 31, h = lane >> 5;
    unsigned char* ws = p.ws;
    const bool meta = (mt == G_MT - 1);
    const bf16* A = meta ? (const bf16*)(ws + OFF_SMALL + SM_UMETA) : (const bf16*)(ws + OFF_U) + (size_t)mt * 256 * D;
    const int vrows = meta ? NMETA : 256;
    const bf16* Bt = (const bf16*)(ws + OFF_WTIN) + (size_t)nt * 128 * D;
    char* ldsA[2] = {smem, smem + G_LDS_A + G_LDS_B};
    char* ldsB[2] = {smem + G_LDS_A, smem + 2 * G_LDS_A + G_LDS_B};
    f32x16 acc[2][2];
#pragma unroll
    for (int i = 0; i < 2; ++i)
#pragma unroll
        for (int j = 0; j < 2; ++j) acc[i][j] = zero16();
    const int lrow = tid >> 3, lc = tid & 7;
    u32x4 ra[4], rb[2];
    auto gload = [&](int kt) {
#pragma unroll
        for (int i = 0; i < 4; ++i) { const int row = lrow + 64 * i; ra[i] = row < vrows ? *(const u32x4*)(A + (size_t)row * D + kt * 64 + lc * 8) : (u32x4){0u, 0u, 0u, 0u}; }
#pragma unroll
        for (int i = 0; i < 2; ++i) { const int row = lrow + 64 * i; rb[i] = *(const u32x4*)(Bt + (size_t)row * D + kt * 64 + lc * 8); }
    };
    auto lstore = [&](int buf) {
#pragma unroll
        for (int i = 0; i < 4; ++i) *(u32x4*)(ldsA[buf] + swz128(lrow + 64 * i, lc)) = ra[i];
#pragma unroll
        for (int i = 0; i < 2; ++i) *(u32x4*)(ldsB[buf] + swz128(lrow + 64 * i, lc)) = rb[i];
    };
    gload(0); lstore(0); __syncthreads();
    for (int kt = 0; kt < 16; ++kt) {
        const int buf = kt & 1;
        if (kt + 1 < 16) gload(kt + 1);
#pragma unroll
        for (int ks = 0; ks < 4; ++ks) {
            bf16x8 af[2], bfr[2];
#pragma unroll
            for (int i = 0; i < 2; ++i) af[i] = *(const bf16x8*)(ldsA[buf] + swz128(64 * wm + 32 * i + r32, 2 * ks + h));
#pragma unroll
            for (int j = 0; j < 2; ++j) bfr[j] = *(const bf16x8*)(ldsB[buf] + swz128(64 * wn + 32 * j + r32, 2 * ks + h));
#pragma unroll
            for (int i = 0; i < 2; ++i)
#pragma unroll
                for (int j = 0; j < 2; ++j) acc[i][j] = MFMA32(af[i], bfr[j], acc[i][j]);
        }
        if (kt + 1 < 16) lstore(buf ^ 1);
        __syncthreads();
    }
    float* st = (float*)smem;
#pragma unroll
    for (int i = 0; i < 2; ++i)
#pragma unroll
        for (int j = 0; j < 2; ++j)
#pragma unroll
            for (int r = 0; r < 16; ++r) {
                const int row = 64 * wm + 32 * i + (r & 3) + 8 * (r >> 2) + 4 * h, col = 64 * wn + 32 * j + r32;
                st[row * G_STAGE_PITCH + col] = acc[i][j][r];
            }
    __syncthreads();
    const int tid2 = fresh_tid();
    const int sec = nt >> 3, cb = (nt & 7) * 128;
    if (sec == 2) {
        const int head = nt & 7, e = tid2 >> 2, sub = tid2 & 3;
        if (!meta) {
            bf16* dst = (bf16*)p.out + (size_t)SEQ * D + ((size_t)head * 128 + e) * SEQ + (size_t)mt * 256;
#pragma unroll
            for (int i = 0; i < 8; ++i) {
                const int row0 = 32 * i + 8 * sub; float f[8];
#pragma unroll
                for (int j = 0; j < 8; ++j) f[j] = st[(row0 + j) * G_STAGE_PITCH + e];
                u32x4 o; o.x = pk2(f[0], f[1]); o.y = pk2(f[2], f[3]); o.z = pk2(f[4], f[5]); o.w = pk2(f[6], f[7]);
                *(u32x4*)(dst + row0) = o;
            }
        } else if (sub < 2) {
            bf16* dst = (bf16*)(ws + OFF_SMALL + SM_AVTMETA) + ((size_t)head * 128 + e) * 16;
            const int row0 = 8 * sub; float f[8];
#pragma unroll
            for (int j = 0; j < 8; ++j) f[j] = st[(row0 + j) * G_STAGE_PITCH + e];
            u32x4 o; o.x = pk2(f[0], f[1]); o.y = pk2(f[2], f[3]); o.z = pk2(f[4], f[5]); o.w = pk2(f[6], f[7]);
            *(u32x4*)(dst + row0) = o;
        }
    } else {
        bf16* base; bool has_meta = true; bf16* mbase = nullptr; int mrow0 = 0;
        if (sec == 0) { base = (bf16*)(ws + OFF_AQ); has_meta = false; }
        else if (sec == 1) { base = (bf16*)p.out; mbase = (bf16*)(ws + OFF_SMALL + SM_AKMETA); }
        else if (sec == 3) { base = (bf16*)(ws + OFF_QN); mbase = (bf16*)(ws + OFF_SMALL + SM_C0Q); mrow0 = 48; }
        else if (sec == 4) { base = (bf16*)(ws + OFF_KN); mbase = (bf16*)(ws + OFF_SMALL + SM_C0K); mrow0 = 48; }
        else if (sec == 5) { base = (bf16*)(ws + OFF_V); mbase = (bf16*)(ws + OFF_SMALL + SM_C0V); mrow0 = 48; }
        else { base = (bf16*)(ws + OFF_DG); has_meta = false; }
        const bool dqkv = (sec >= 3 && sec <= 5);
        bf16* tails = (bf16*)(ws + OFF_SMALL + SM_TAILS);
        if (!meta || has_meta) {
#pragma unroll
            for (int i = 0; i < 8; ++i) {
                const int idx = tid2 + NT * i, row = idx >> 4, cg = idx & 15;
                if (row < vrows) {
                    const float* s = st + row * G_STAGE_PITCH + cg * 8;
                    const f32x4 a = *(const f32x4*)s, b = *(const f32x4*)(s + 4);
                    u32x4 o; o.x = pk2(a[0], a[1]); o.y = pk2(a[2], a[3]); o.z = pk2(b[0], b[1]); o.w = pk2(b[2], b[3]);
                    if (!meta) {
                        const int j = mt * 256 + row;
                        *(u32x4*)(base + (size_t)j * D + cb + cg * 8) = o;
                        if (dqkv && (j & 63) >= 61) *(u32x4*)(tails + ((size_t)(j / 64 + 1) * 3 + ((j & 63) - 61)) * 3072 + (sec - 3) * 1024 + cb + cg * 8) = o;
                    } else {
                        *(u32x4*)(mbase + (size_t)(mrow0 + row) * D + cb + cg * 8) = o;
                        if (dqkv && row >= 13) *(u32x4*)(tails + ((size_t)0 * 3 + (row - 13)) * 3072 + (sec - 3) * 1024 + cb + cg * 8) = o;
                    }
                }
            }
        }
    }
    __syncthreads();
}

DI void phase1(const Params& p, char* smem, int bid, int nblk) {
    const int ntiles = G_MT * G_NTILES;
    for (int t = bid; t < ntiles; t += nblk) {
        const int mt = t / G_NTILES, nt = t % G_NTILES;
        gemm_inproj_tile(p, smem, mt, nt);
    }
}

constexpr int P2_KN = 0, P2_KB = 16384, P2_QN = 32768, P2_KBGT = 49152, P2_VBT = 65536, P2_KDT = 81920, P2_ALDS = 98304, P2_TLDS = P2_ALDS + 64 * 68 * 4,
              P2_GC = P2_TLDS + 8192, P2_BET = P2_GC + 256, P2_EG = P2_BET + 256, P2_EKD = P2_EG + 256;

DI void prep_item(const Params& p, char* smem, int chunk, int head, int dry) {
    const int tid = fresh_tid(), lane = tid & 63, wave = tid >> 6, r32 = lane & 31, h = lane >> 5;
    unsigned char* ws = p.ws;
    float* gcl = (float*)(smem + P2_GC); float* betl = (float*)(smem + P2_BET); float* egl = (float*)(smem + P2_EG); float* ekdl = (float*)(smem + P2_EKD);
    if (wave == 0) {
        const size_t pos = (size_t)chunk * 64 + lane;
        float v = ((const float*)(ws + OFF_SMALL + SM_G))[pos * 8 + head];
        const float b = ((const float*)(ws + OFF_SMALL + SM_BETA))[pos * 8 + head];
#pragma unroll
        for (int o = 1; o < 64; o <<= 1) { const float t = __shfl_up(v, o); if (lane >= o) v += t; }
        const float gl = __shfl(v, 63);
        gcl[lane] = v; betl[lane] = b; egl[lane] = __expf(v); ekdl[lane] = __expf(gl - v);
        if (!dry) ((float*)(ws + OFF_SMALL + SM_GC))[((size_t)chunk * 8 + head) * 64 + lane] = v;
    }
    __syncthreads();
    {
        const int r = tid >> 3, cg = tid & 7, col0 = head * 128 + 16 * cg;
        const bool zero_row = (chunk == 0 && r < 48);
        const float beta = betl[r], eg = egl[r], ekd = ekdl[r];
        const bf16* tails = (const bf16*)(ws + OFF_SMALL + SM_TAILS);
#pragma unroll 1
        for (int mat = 0; mat < 3; ++mat) {
            bf16* mainb = (bf16*)(ws + (mat == 0 ? OFF_QN : (mat == 1 ? OFF_KN : OFF_V)));
            bf16* c0b = (bf16*)(ws + OFF_SMALL + (mat == 0 ? SM_C0Q : (mat == 1 ? SM_C0K : SM_C0V)));
            float y[16];
#pragma unroll
            for (int c = 0; c < 16; ++c) y[c] = 0.f;
#pragma unroll
            for (int jj = 0; jj < 4; ++jj) {
                const int rr = r - 3 + jj;
                const bf16* src = nullptr;
                if (chunk == 0) { if (rr >= 48) src = c0b + (size_t)rr * D + col0; }
                else if (rr >= 0) src = mainb + ((size_t)(chunk - 1) * 64 + rr) * D + col0;
                else src = tails + ((size_t)(chunk - 1) * 3 + (3 + rr)) * 3072 + mat * 1024 + col0;
                u32x4 a = {0u, 0u, 0u, 0u}, b = {0u, 0u, 0u, 0u};
                if (src) { a = *(const u32x4*)src; b = *(const u32x4*)(src + 8); }
                const float* cw = p.in[9] + (size_t)jj * 3072 + mat * 1024 + col0;
                const f32x4 w0 = *(const f32x4*)cw, w1 = *(const f32x4*)(cw + 4), w2 = *(const f32x4*)(cw + 8), w3 = *(const f32x4*)(cw + 12);
                y[0] += w0[0] * bflo(a.x); y[1] += w0[1] * bfhi(a.x); y[2] += w0[2] * bflo(a.y); y[3] += w0[3] * bfhi(a.y);
                y[4] += w1[0] * bflo(a.z); y[5] += w1[1] * bfhi(a.z); y[6] += w1[2] * bflo(a.w); y[7] += w1[3] * bfhi(a.w);
                y[8] += w2[0] * bflo(b.x); y[9] += w2[1] * bfhi(b.x); y[10] += w2[2] * bflo(b.y); y[11] += w2[3] * bfhi(b.y);
                y[12] += w3[0] * bflo(b.z); y[13] += w3[1] * bfhi(b.z); y[14] += w3[2] * bflo(b.w); y[15] += w3[3] * bfhi(b.w);
            }
            __syncthreads();
            float ss = 0.f;
#pragma unroll
            for (int c = 0; c < 16; ++c) { y[c] = zero_row ? 0.f : siluf_(y[c]); ss += y[c] * y[c]; }
            if (mat < 2) {
                ss += __shfl_xor(ss, 1); ss += __shfl_xor(ss, 2); ss += __shfl_xor(ss, 4);
                const float sc = rsqrtf(ss + 1e-6f) * (mat == 0 ? 0.08838834764831845f : 1.0f);
                unsigned pk[8];
#pragma unroll
                for (int c = 0; c < 8; ++c) pk[c] = pk2(y[2 * c] * sc, y[2 * c + 1] * sc);
                if (mat == 0) {
                    *(u32x4*)(smem + P2_QN + swzrow(r, 256, 2 * cg)) = (u32x4){pk[0], pk[1], pk[2], pk[3]};
                    *(u32x4*)(smem + P2_QN + swzrow(r, 256, 2 * cg + 1)) = (u32x4){pk[4], pk[5], pk[6], pk[7]};
                    unsigned qd[8];
#pragma unroll
                    for (int c = 0; c < 8; ++c) qd[c] = pk2(bflo(pk[c]) * eg, bfhi(pk[c]) * eg);
                    bf16* dst = (chunk == 0) ? c0b + (size_t)r * D + col0 : mainb + ((size_t)(chunk - 1) * 64 + r) * D + col0;
                    if (!dry) { *(u32x4*)dst = (u32x4){qd[0], qd[1], qd[2], qd[3]}; *(u32x4*)(dst + 8) = (u32x4){qd[4], qd[5], qd[6], qd[7]}; }
                } else {
                    *(u32x4*)(smem + P2_KN + swzrow(r, 256, 2 * cg)) = (u32x4){pk[0], pk[1], pk[2], pk[3]};
                    *(u32x4*)(smem + P2_KN + swzrow(r, 256, 2 * cg + 1)) = (u32x4){pk[4], pk[5], pk[6], pk[7]};
                    unsigned kb[8];
#pragma unroll
                    for (int c = 0; c < 8; ++c) {
                        const float kr0 = bflo(pk[c]), kr1 = bfhi(pk[c]);
                        const float k0 = kr0 * beta, k1 = kr1 * beta;
                        kb[c] = pk2(k0, k1);
                        const int d0 = 16 * cg + 2 * c;
                        *(bf16*)(smem + P2_KBGT + swz128(d0, r >> 3) + (r & 7) * 2) = (bf16)f2bf(k0 * eg);
                        *(bf16*)(smem + P2_KBGT + swz128(d0 + 1, r >> 3) + (r & 7) * 2) = (bf16)f2bf(k1 * eg);
                        *(bf16*)(smem + P2_KDT + swz128(d0, r >> 3) + (r & 7) * 2) = (bf16)f2bf(kr0 * ekd);
                        *(bf16*)(smem + P2_KDT + swz128(d0 + 1, r >> 3) + (r & 7) * 2) = (bf16)f2bf(kr1 * ekd);
                    }
                    *(u32x4*)(smem + P2_KB + swzrow(r, 256, 2 * cg)) = (u32x4){kb[0], kb[1], kb[2], kb[3]};
                    *(u32x4*)(smem + P2_KB + swzrow(r, 256, 2 * cg + 1)) = (u32x4){kb[4], kb[5], kb[6], kb[7]};
                }
            } else {
#pragma unroll
                for (int c = 0; c < 16; ++c) {
                    const int e = 16 * cg + c;
                    *(bf16*)(smem + P2_VBT + swz128(e, r >> 3) + (r & 7) * 2) = (bf16)f2bf(y[c] * beta);
                }
            }
        }
    }
    __syncthreads();
    {
        const int tile = wave & 3, m0 = tile >> 1, n0 = tile & 1;
        f32x16 acc = zero16();
        if (wave < 4) {
            if (n0 <= m0) {
#pragma unroll
                for (int ks = 0; ks < 8; ++ks) {
                    const bf16x8 a = *(const bf16x8*)(smem + P2_KB + swzrow(32 * m0 + r32, 256, 2 * ks + h));
                    const bf16x8 b = *(const bf16x8*)(smem + P2_KN + swzrow(32 * n0 + r32, 256, 2 * ks + h));
                    acc = MFMA32(a, b, acc);
                }
            }
            float* Al = (float*)(smem + P2_ALDS);
            const int j = 32 * n0 + r32; const float gj = gcl[j];
#pragma unroll
            for (int r = 0; r < 16; ++r) {
                const int i = 32 * m0 + (r & 3) + 8 * (r >> 2) + 4 * h;
                const float dv = acc[r] * __expf(gcl[i] - gj);
                Al[i * 68 + j] = (j < i) ? dv : 0.f;
            }
        } else {
            if (m0 <= n0) {
#pragma unroll
                for (int ks = 0; ks < 8; ++ks) {
                    const bf16x8 a = *(const bf16x8*)(smem + P2_KN + swzrow(32 * m0 + r32, 256, 2 * ks + h));
                    const bf16x8 b = *(const bf16x8*)(smem + P2_QN + swzrow(32 * n0 + r32, 256, 2 * ks + h));
                    acc = MFMA32(a, b, acc);
                }
            }
            const int i = 32 * n0 + r32; const float gi = gcl[i];
            bf16* qkb = (chunk == 0) ? (bf16*)(ws + OFF_SMALL + SM_C0QK) + (size_t)head * 4096 : (bf16*)(ws + OFF_QKB) + ((size_t)(chunk - 1) * 8 + head) * 4096;
#pragma unroll
            for (int q4 = 0; q4 < 4; ++q4) {
                const int j0 = 32 * m0 + 8 * q4 + 4 * h; float v[4];
#pragma unroll
                for (int c = 0; c < 4; ++c) { const int j = j0 + c; const float dv = acc[4 * q4 + c] * __expf(gi - gcl[j]); v[c] = (j <= i) ? dv : 0.f; }
                if (!dry) *(u32x2*)(qkb + i * 64 + j0) = (u32x2){pk2(v[0], v[1]), pk2(v[2], v[3])};
            }
        }
        bf16* kbase = (chunk == 0) ? (bf16*)(ws + OFF_SMALL + SM_C0K) : (bf16*)(ws + OFF_KN) + (size_t)(chunk - 1) * 64 * D;
#pragma unroll
        for (int i2 = 0; i2 < 2; ++i2) {
            const int idx = tid + NT * i2, dk = idx >> 3, ch = idx & 7;
            const u32x4 v = *(const u32x4*)(smem + P2_KDT + swz128(dk, ch));
            if (!dry) *(u32x4*)(kbase + (size_t)(dk >> 1) * D + head * 128 + (dk & 1) * 64 + ch * 8) = v;
        }
    }
    __syncthreads();
    if (wave == 0) {
        const float* Al = (const float*)(smem + P2_ALDS);
        float t[64];
#pragma unroll
        for (int i = 0; i < 64; ++i) {
            float s0 = (i == lane) ? 1.f : 0.f, s1 = 0.f, s2 = 0.f, s3 = 0.f;
#pragma unroll
            for (int j = 0; j < i; ++j) { const float pr = Al[i * 68 + j] * t[j]; if ((j & 3) == 0) s0 -= pr; else if ((j & 3) == 1) s1 -= pr; else if ((j & 3) == 2) s2 -= pr; else s3 -= pr; }
            t[i] = (s0 + s1) + (s2 + s3);
#ifndef EMU
            if ((i & 3) == 3) asm volatile("" ::: "memory");
#endif
        }
#pragma unroll
        for (int i = 0; i < 64; ++i) *(bf16*)(smem + P2_TLDS + swz128(i, lane >> 3) + (lane & 7) * 2) = (bf16)f2bf(t[i]);
    }
    __syncthreads();
    {
        const int mi = wave >> 2, ni = wave & 3;
        f32x16 acc = zero16();
#pragma unroll
        for (int ks = 0; ks < 4; ++ks) {
            const bf16x8 a = *(const bf16x8*)(smem + P2_TLDS + swz128(32 * mi + r32, 2 * ks + h));
            const bf16x8 b = *(const bf16x8*)(smem + P2_VBT + swz128(32 * ni + r32, 2 * ks + h));
            acc = MFMA32(a, b, acc);
        }
        const int e = 32 * ni + r32;
        bf16* base = (chunk == 0) ? (bf16*)(ws + OFF_SMALL + SM_C0V) : (bf16*)(ws + OFF_V) + (size_t)(chunk - 1) * 64 * D;
        bf16* dst = base + (size_t)(e >> 1) * D + head * 128 + (e & 1) * 64;
#pragma unroll
        for (int q4 = 0; q4 < 4; ++q4) {
            const int c0 = 32 * mi + 8 * q4 + 4 * h;
            if (!dry) *(u32x2*)(dst + c0) = (u32x2){pk2(acc[4 * q4], acc[4 * q4 + 1]), pk2(acc[4 * q4 + 2], acc[4 * q4 + 3])};
        }
    }
    {
        const int mi = wave >> 1, ni = wave & 1;
        f32x16 acc = zero16();
#pragma unroll
        for (int ks = 0; ks < 4; ++ks) {
            const bf16x8 a = *(const bf16x8*)(smem + P2_KBGT + swz128(32 * mi + r32, 2 * ks + h));
            const bf16x8 b = *(const bf16x8*)(smem + P2_TLDS + swz128(32 * ni + r32, 2 * ks + h));
            acc = MFMA32(a, b, acc);
        }
        const int c = 32 * ni + r32;
        bf16* wb = (chunk == 0) ? (bf16*)(ws + OFF_SMALL + SM_C0W) + (size_t)head * 8192 : (bf16*)(ws + OFF_W) + ((size_t)(chunk - 1) * 8 + head) * 8192;
#pragma unroll
        for (int q4 = 0; q4 < 4; ++q4) {
            const int dk0 = 32 * mi + 8 * q4 + 4 * h;
            if (!dry) *(u32x2*)(wb + c * 128 + dk0) = (u32x2){pk2(acc[4 * q4], acc[4 * q4 + 1]), pk2(acc[4 * q4 + 2], acc[4 * q4 + 3])};
        }
    }
    __syncthreads();
}

DI void phase2(const Params& p, char* smem, int bid, int nblk, int dry = 0) {
    for (int it = bid; it < NCH * 8; it += nblk) prep_item(p, smem, it >> 3, it & 7, dry);
    {
        const int tid = fresh_tid(), lane = tid & 63, wave = tid >> 6;
        const int gw = bid * 8 + wave, NGW = nblk * 8;
        float mq = 0.f, mk = 0.f;
        for (int j = gw; j < SEQ + NMETA; j += NGW) {
            const bf16* kr = j < SEQ ? (const bf16*)p.out + (size_t)j * D + lane * 16 : (const bf16*)(p.ws + OFF_SMALL + SM_AKMETA) + (size_t)(j - SEQ) * D + lane * 16;
            const u32x4 a = *(const u32x4*)kr, b = *(const u32x4*)(kr + 8);
            float s = bflo(a.x) * bflo(a.x) + bfhi(a.x) * bfhi(a.x) + bflo(a.y) * bflo(a.y) + bfhi(a.y) * bfhi(a.y) + bflo(a.z) * bflo(a.z) + bfhi(a.z) * bfhi(a.z) + bflo(a.w) * bflo(a.w) + bfhi(a.w) * bfhi(a.w)
                    + bflo(b.x) * bflo(b.x) + bfhi(b.x) * bfhi(b.x) + bflo(b.y) * bflo(b.y) + bfhi(b.y) * bfhi(b.y) + bflo(b.z) * bflo(b.z) + bfhi(b.z) * bfhi(b.z) + bflo(b.w) * bflo(b.w) + bfhi(b.w) * bfhi(b.w);
            s += __shfl_xor(s, 1); s += __shfl_xor(s, 2);
            mk = fmaxf(mk, s);
            if (j < SEQ) {
                const bf16* qr = (const bf16*)(p.ws + OFF_AQ) + (size_t)j * D + lane * 16;
                const u32x4 c = *(const u32x4*)qr, d = *(const u32x4*)(qr + 8);
                float t = bflo(c.x) * bflo(c.x) + bfhi(c.x) * bfhi(c.x) + bflo(c.y) * bflo(c.y) + bfhi(c.y) * bfhi(c.y) + bflo(c.z) * bflo(c.z) + bfhi(c.z) * bfhi(c.z) + bflo(c.w) * bflo(c.w) + bfhi(c.w) * bfhi(c.w)
                        + bflo(d.x) * bflo(d.x) + bfhi(d.x) * bfhi(d.x) + bflo(d.y) * bflo(d.y) + bfhi(d.y) * bfhi(d.y) + bflo(d.z) * bflo(d.z) + bfhi(d.z) * bfhi(d.z) + bflo(d.w) * bflo(d.w) + bfhi(d.w) * bfhi(d.w);
                t += __shfl_xor(t, 1); t += __shfl_xor(t, 2);
                mq = fmaxf(mq, t);
            }
        }
        if ((lane & 3) == 0) {
            unsigned* nrm = (unsigned*)(p.ws + OFF_SMALL + SM_CTL) + CW_NRM;
            atomicMax(nrm + (lane >> 2), __builtin_bit_cast(unsigned, mq));
            atomicMax(nrm + 16 + (lane >> 2), __builtin_bit_cast(unsigned, mk));
        }
    }
}

DI int swzrow8(int row, int pitch, int s) { return row * pitch + ((((s >> 1) ^ (row & 15)) << 4) | ((s & 1) << 3)); }
DI bf16x8 pack8(f32x4 a, f32x4 b) {
    u32x4 o; o.x = pk2(a[0], a[1]); o.y = pk2(a[2], a[3]); o.z = pk2(b[0], b[1]); o.w = pk2(b[2], b[3]);
    return __builtin_bit_cast(bf16x8, o);
}
DI bf16x8 ld2x8(const char* p0, const char* p1) {
    const u32x2 a = *(const u32x2*)p0, b = *(const u32x2*)p1; u32x4 o; o.x = a.x; o.y = a.y; o.z = b.x; o.w = b.y;
    return __builtin_bit_cast(bf16x8, o);
}
constexpr int SC_W = 0, SC_QD = 16384, SC_KDT = 32768, SC_QK = 49152, SC_BUF = 57344;

DI void scan_head(const Params& p, char* smem, int head, int dry) {
    const int tid = fresh_tid(), lane = tid & 63, wave = tid >> 6, r16 = lane & 15, g = lane >> 4;
    unsigned char* ws = p.ws;
    const int lrow = tid >> 3, lch = (tid & 7) * 2;
    f32x4 S[8];
#pragma unroll
    for (int i = 0; i < 8; ++i) S[i] = zero4();
    u32x4 rw[2], rq[2], rk[2], rqk; u32x2 unext[4], ucur[4]; float gnext = 0.f, gcur = 0.f;
    auto uaddr = [&](int n, int mt) -> bf16* {
        const int e = 16 * wave + r16;
        bf16* base = n == 0 ? (bf16*)(ws + OFF_SMALL + SM_C0V) : (bf16*)(ws + OFF_V) + (size_t)(n - 1) * 64 * D;
        return base + (size_t)(e >> 1) * D + head * 128 + (e & 1) * 64 + 16 * mt + 4 * g;
    };
    auto gloadA = [&](int n) {
        const bf16* wsrc = (n == 0 ? (const bf16*)(ws + OFF_SMALL + SM_C0W) + (size_t)head * 8192 : (const bf16*)(ws + OFF_W) + ((size_t)(n - 1) * 8 + head) * 8192) + lrow * 128 + lch * 8;
        rw[0] = *(const u32x4*)wsrc; rw[1] = *(const u32x4*)(wsrc + 8);
        const bf16* qs = (n == 0 ? (const bf16*)(ws + OFF_SMALL + SM_C0Q) : (const bf16*)(ws + OFF_QN) + (size_t)(n - 1) * 64 * D) + (size_t)lrow * D + head * 128 + lch * 8;
        rq[0] = *(const u32x4*)qs; rq[1] = *(const u32x4*)(qs + 8);
        const bf16* ks = (n == 0 ? (const bf16*)(ws + OFF_SMALL + SM_C0K) : (const bf16*)(ws + OFF_KN) + (size_t)(n - 1) * 64 * D) + (size_t)lrow * D + head * 128 + lch * 8;
        rk[0] = *(const u32x4*)ks; rk[1] = *(const u32x4*)(ks + 8);
        const bf16* qk = (n == 0 ? (const bf16*)(ws + OFF_SMALL + SM_C0QK) + (size_t)head * 4096 : (const bf16*)(ws + OFF_QKB) + ((size_t)(n - 1) * 8 + head) * 4096) + tid * 8;
        rqk = *(const u32x4*)qk;
    };
    auto gloadU = [&](int n) {
#pragma unroll
        for (int mt = 0; mt < 4; ++mt) unext[mt] = *(const u32x2*)uaddr(n, mt);
        gnext = ((const float*)(ws + OFF_SMALL + SM_GC))[((size_t)n * 8 + head) * 64 + 63];
    };
    auto lwrite = [&](int buf) {
        char* b = smem + buf * SC_BUF;
        const int c7 = tid & 7, kb = c7 >> 1, hf = c7 & 1;
        {
            char* w = b + SC_W + lrow * 256 + hf * 8; char* q = b + SC_QD + lrow * 256 + hf * 8; const int x = lrow & 15;
            *(u32x2*)(w + (((4 * kb + 0) ^ x) << 4)) = (u32x2){rw[0].x, rw[0].y}; *(u32x2*)(w + (((4 * kb + 1) ^ x) << 4)) = (u32x2){rw[0].z, rw[0].w};
            *(u32x2*)(w + (((4 * kb + 2) ^ x) << 4)) = (u32x2){rw[1].x, rw[1].y}; *(u32x2*)(w + (((4 * kb + 3) ^ x) << 4)) = (u32x2){rw[1].z, rw[1].w};
            *(u32x2*)(q + (((4 * kb + 0) ^ x) << 4)) = (u32x2){rq[0].x, rq[0].y}; *(u32x2*)(q + (((4 * kb + 1) ^ x) << 4)) = (u32x2){rq[0].z, rq[0].w};
            *(u32x2*)(q + (((4 * kb + 2) ^ x) << 4)) = (u32x2){rq[1].x, rq[1].y}; *(u32x2*)(q + (((4 * kb + 3) ^ x) << 4)) = (u32x2){rq[1].z, rq[1].w};
        }
        {
            const int dk = 2 * lrow + (c7 >> 2), kb2 = (c7 & 3) >> 1, x = (dk >> 1) & 7;
            char* kt = b + SC_KDT + dk * 128 + hf * 8;
            *(u32x2*)(kt + (((4 * kb2 + 0) ^ x) << 4)) = (u32x2){rk[0].x, rk[0].y}; *(u32x2*)(kt + (((4 * kb2 + 1) ^ x) << 4)) = (u32x2){rk[0].z, rk[0].w};
            *(u32x2*)(kt + (((4 * kb2 + 2) ^ x) << 4)) = (u32x2){rk[1].x, rk[1].y}; *(u32x2*)(kt + (((4 * kb2 + 3) ^ x) << 4)) = (u32x2){rk[1].z, rk[1].w};
        }
        {
            const int row = tid >> 3, kb2 = c7 >> 2, g0 = 2 * (c7 & 1), hf2 = (c7 >> 1) & 1, x = (row >> 1) & 7;
            char* qk = b + SC_QK + row * 128 + hf2 * 8;
            *(u32x2*)(qk + (((4 * kb2 + g0) ^ x) << 4)) = (u32x2){rqk.x, rqk.y}; *(u32x2*)(qk + (((4 * kb2 + g0 + 1) ^ x) << 4)) = (u32x2){rqk.z, rqk.w};
        }
    };
    gloadA(0); gloadU(0);
    lwrite(0);
#pragma unroll
    for (int mt = 0; mt < 4; ++mt) ucur[mt] = unext[mt];
    gcur = gnext;
    if (NCH > 1) gloadA(1);
    __syncthreads();
    for (int n = 0; n < NCH; ++n) {
        const char* b = smem + (n & 1) * SC_BUF;
        if (n + 1 < NCH) { lwrite((n + 1) & 1); gloadU(n + 1); }
        if (n + 2 < NCH) gloadA(n + 2);
        const float gtot = __expf(gcur);
        bf16x8 sf[4];
#pragma unroll
        for (int kb = 0; kb < 4; ++kb) sf[kb] = pack8(S[2 * kb], S[2 * kb + 1]);
        f32x4 Vn[4], O[4];
#pragma unroll
        for (int mt = 0; mt < 4; ++mt) {
            f32x4 P = zero4(), Q = zero4();
            const int row = 16 * mt + r16;
#pragma unroll
            for (int kb = 0; kb < 4; ++kb) {
                const bf16x8 wf = *(const bf16x8*)(b + SC_W + swzrow(row, 256, 4 * kb + g));
                const bf16x8 qf = *(const bf16x8*)(b + SC_QD + swzrow(row, 256, 4 * kb + g));
                P = MFMA16(wf, sf[kb], P);
                Q = MFMA16(qf, sf[kb], Q);
            }
            const float u0 = bflo(ucur[mt].x), u1 = bfhi(ucur[mt].x), u2 = bflo(ucur[mt].y), u3 = bfhi(ucur[mt].y);
            Vn[mt] = (f32x4){u0 - P[0], u1 - P[1], u2 - P[2], u3 - P[3]};
            O[mt] = Q;
        }
        const bf16x8 vf[2] = {pack8(Vn[0], Vn[1]), pack8(Vn[2], Vn[3])};
#pragma unroll
        for (int mt = 0; mt < 8; ++mt) {
            const int row = 16 * mt + r16;
            f32x4 acc = S[mt] * gtot;
#pragma unroll
            for (int kb = 0; kb < 2; ++kb) {
                const bf16x8 kf = *(const bf16x8*)(b + SC_KDT + swz128(row, 4 * kb + g));
                acc = MFMA16(kf, vf[kb], acc);
            }
            S[mt] = acc;
        }
#pragma unroll
        for (int mt = 0; mt < 4; ++mt) {
            const int row = 16 * mt + r16;
#pragma unroll
            for (int kb = 0; kb < 2; ++kb) {
                const bf16x8 qk = *(const bf16x8*)(b + SC_QK + swz128(row, 4 * kb + g));
                O[mt] = MFMA16(qk, vf[kb], O[mt]);
            }
            if (n >= 1 && !dry) *(u32x2*)uaddr(n, mt) = (u32x2){pk2(O[mt][0], O[mt][1]), pk2(O[mt][2], O[mt][3])};
        }
#pragma unroll
        for (int mt = 0; mt < 4; ++mt) ucur[mt] = unext[mt];
        gcur = gnext;
        __syncthreads();
    }
}

constexpr int AT_BUF = 32768, AT_MISC = 65536, NQB = SEQ / 128, AT_UNITS = 8 * NQB;
DI int vt_off8(int e, int s) { return e * 128 + ((s ^ ((e >> 1) & 15)) << 3); }

DI void attention_unit(const Params& p, char* smem, int head, int qb, float lam, int dry, float bound) {
    const int tid = fresh_tid(), lane = tid & 63, wave = tid >> 6, r32 = lane & 31, h = lane >> 5;
    const int wq = wave & 3, mp = wave >> 2;
    unsigned char* ws = p.ws;
    const bf16* AK = (const bf16*)p.out; const bf16* AVT = (const bf16*)p.out + (size_t)SEQ * D;
    const int q0 = 128 * qb, qpos = q0 + 32 * wq + r32;
    const float c1 = 0.125f * LOG2E, c2 = exp2f(-(float)(head + 1)) * LOG2E;
    bf16x8 Qf[4];
    {
        const bf16* qsrc = (const bf16*)(ws + OFF_AQ) + (size_t)qpos * D + head * 128 + mp * 64 + 8 * h;
#pragma unroll
        for (int ks = 0; ks < 4; ++ks) {
            const u32x4 v = *(const u32x4*)(qsrc + 16 * ks); u32x4 o;
            o.x = pk2(bflo(v.x) * c1, bfhi(v.x) * c1); o.y = pk2(bflo(v.y) * c1, bfhi(v.y) * c1); o.z = pk2(bflo(v.z) * c1, bfhi(v.z) * c1); o.w = pk2(bflo(v.w) * c1, bfhi(v.w) * c1);
            Qf[ks] = __builtin_bit_cast(bf16x8, o);
        }
    }
    f32x16 O[4];
#pragma unroll
    for (int i = 0; i < 4; ++i) O[i] = zero16();
    float m_run = 0.f, l_run = 0.f; bool first = true;
    const float wdist = (150.0f + 2.0f * bound) / c2;
    int ntiles = 2 * qb + 3;
    {
        const float lim = (float)q0 - 63.0f - wdist;
        int ktmin = 0;
        if (lim > 0.f) ktmin = (int)(lim * (1.0f / 64.0f));
        const bool keep_meta = !((float)(q0 + NMETA - 15) > wdist);
        if (ktmin > 0 || !keep_meta) ntiles = (2 * qb + 1 - ktmin + 1) + (keep_meta ? 1 : 0);
    }
    const int nreal = (ntiles == 2 * qb + 3) ? 2 * qb + 2 : ntiles;
    const int kkey = tid >> 3, kcc = (tid & 7) * 2;
    const int ve = tid >> 2, vcc = (tid & 3) * 2;
    u32x4 rk[2], rv[2];
    auto tile_kt = [&](int it) -> int { return it < nreal ? 2 * qb + 1 - it : -1; };
    auto gload = [&](int it) {
        const int kt = tile_kt(it);
        if (kt >= 0) {
            const bf16* ks = AK + ((size_t)kt * 64 + kkey) * D + head * 128 + kcc * 8;
            rk[0] = *(const u32x4*)ks; rk[1] = *(const u32x4*)(ks + 8);
            const bf16* vs = AVT + ((size_t)head * 128 + ve) * SEQ + (size_t)kt * 64 + vcc * 8;
            rv[0] = *(const u32x4*)vs; rv[1] = *(const u32x4*)(vs + 8);
        } else {
            rk[0] = rk[1] = rv[0] = rv[1] = (u32x4){0u, 0u, 0u, 0u};
            if (kkey < NMETA) { const bf16* ks = (const bf16*)(ws + OFF_SMALL + SM_AKMETA) + (size_t)kkey * D + head * 128 + kcc * 8; rk[0] = *(const u32x4*)ks; rk[1] = *(const u32x4*)(ks + 8); }
            if (vcc == 0) { const bf16* vs = (const bf16*)(ws + OFF_SMALL + SM_AVTMETA) + ((size_t)head * 128 + ve) * 16; rv[0] = *(const u32x4*)vs; rv[1] = *(const u32x4*)(vs + 8); }
        }
    };
    auto lwrite = [&](int buf) {
        char* kb = smem + buf * AT_BUF + (kcc >> 3) * 8192;
        *(u32x4*)(kb + swz128(kkey, kcc & 7)) = rk[0]; *(u32x4*)(kb + swz128(kkey, (kcc & 7) + 1)) = rk[1];
        char* vb = smem + buf * AT_BUF + 16384 + ve * 128; const int x = (ve >> 1) & 7;
        const unsigned pc[8] = {rv[0].x, rv[0].y, rv[0].z, rv[0].w, rv[1].x, rv[1].y, rv[1].z, rv[1].w};
#pragma unroll
        for (int i = 0; i < 4; ++i) {
            const int ag = 2 * vcc + i, sub = ag >> 3, a = ag & 7, a2 = (a & 4) | ((a & 1) << 1) | ((a >> 1) & 1);
            *(u32x2*)(vb + (((4 * sub + (a2 >> 1)) ^ x) << 4) + (a2 & 1) * 8) = (u32x2){pc[2 * i], pc[2 * i + 1]};
        }
    };
    gload(0); lwrite(0); __syncthreads();
    for (int it = 0; it < ntiles; ++it) {
        const int buf = it & 1, kt = tile_kt(it);
        if (it + 1 < ntiles) gload(it + 1);
        const bool meta = kt < 0;
        const int k0 = kt * 64;
        const bool skip = !meta && (k0 > q0 + 32 * wq + 31);
        if (!skip) {
            const char* kb = smem + buf * AT_BUF + mp * 8192;
            const char* vb = smem + buf * AT_BUF + 16384;
            const bool need_mask = !meta && (k0 + 63 > q0 + 32 * wq);
            f32x16 s[2];
            float mx = -3.0e38f;
            const float mref = first ? 0.f : m_run;
#pragma unroll
            for (int sub = 0; sub < 2; ++sub) {
                f32x16 acc;
                const float base = (meta ? -c2 * (float)(NMETA + qpos - 32 * sub - 4 * h) : -c2 * (float)(qpos - k0 - 32 * sub - 4 * h)) - mref;
#pragma unroll
                for (int r = 0; r < 16; ++r) acc[r] = base + c2 * (float)((r & 3) + 8 * (r >> 2));
#pragma unroll
                for (int ks = 0; ks < 4; ++ks) {
                    const bf16x8 a = *(const bf16x8*)(kb + swz128(32 * sub + r32, 2 * ks + h));
                    acc = MFMA32(a, Qf[ks], acc);
                }
                if (meta) {
#pragma unroll
                    for (int r = 0; r < 16; ++r) { const int key = 32 * sub + (r & 3) + 8 * (r >> 2) + 4 * h; if (key >= NMETA) acc[r] = -1e30f; }
                } else if (need_mask) {
#pragma unroll
                    for (int r = 0; r < 16; ++r) { const int key = k0 + 32 * sub + (r & 3) + 8 * (r >> 2) + 4 * h; if (key > qpos) acc[r] = -1e30f; }
                }
#pragma unroll
                for (int r = 0; r < 16; ++r) mx = fmaxf(mx, acc[r]);
                s[sub] = acc;
            }
            mx = fmaxf(mx, __shfl_xor(mx, 32));
            const float dlt = first ? mx : fmaxf(mx, 0.f);
            m_run = mref + dlt;
            float ls = 0.f;
            const float alpha = EXP2F(-dlt);
#pragma unroll
            for (int sub = 0; sub < 2; ++sub)
#pragma unroll
                for (int r = 0; r < 16; ++r) { const float pv = EXP2F(s[sub][r] - dlt); s[sub][r] = pv; ls += pv; }
            l_run = l_run * alpha + ls;
            if (wave_any(dlt != 0.f)) {
#pragma unroll
                for (int et = 0; et < 4; ++et) O[et] = O[et] * alpha;
            }
            first = false;
            bf16x8 Pf[2][2];
#pragma unroll
            for (int sub = 0; sub < 2; ++sub)
#pragma unroll
                for (int ss = 0; ss < 2; ++ss) {
                    u32x4 o; o.x = pk2(s[sub][8 * ss], s[sub][8 * ss + 1]); o.y = pk2(s[sub][8 * ss + 2], s[sub][8 * ss + 3]);
                    o.z = pk2(s[sub][8 * ss + 4], s[sub][8 * ss + 5]); o.w = pk2(s[sub][8 * ss + 6], s[sub][8 * ss + 7]);
                    Pf[sub][ss] = __builtin_bit_cast(bf16x8, o);
                }
#pragma unroll
            for (int et = 0; et < 4; ++et) {
                const int e = 32 * et + r32;
#pragma unroll
                for (int sub = 0; sub < 2; ++sub)
#pragma unroll
                    for (int ss = 0; ss < 2; ++ss) {
                        const bf16x8 a = *(const bf16x8*)(vb + swz128(e, 4 * sub + 2 * ss + h));
                        O[et] = MFMA32(a, Pf[sub][ss], O[et]);
                    }
                SCHED_FENCE();
            }
        }
        if (it + 1 < ntiles) lwrite(buf ^ 1);
        __syncthreads();
    }
    {
        const float lt = l_run + __shfl_xor(l_run, 32);
        const float inv = 1.0f / lt;
        float* X = (float*)smem;
        if (mp == 1) {
#pragma unroll
            for (int et = 0; et < 4; ++et)
#pragma unroll
                for (int r = 0; r < 16; ++r) { const int e = 32 * et + (r & 3) + 8 * (r >> 2) + 4 * h; X[(wq * 128 + e) * 32 + r32] = O[et][r] * inv; }
        }
        __syncthreads();
        if (mp == 0) {
            float ssq = 0.f;
#pragma unroll
            for (int et = 0; et < 4; ++et)
#pragma unroll
                for (int r = 0; r < 16; ++r) { const int e = 32 * et + (r & 3) + 8 * (r >> 2) + 4 * h; const float d = O[et][r] * inv - lam * X[(wq * 128 + e) * 32 + r32]; O[et][r] = d; ssq += d * d; }
            ssq += __shfl_xor(ssq, 32);
            const float rstd = rsqrtf(ssq * (1.0f / 128.0f) + NORM_EPS) * 0.8f;
            bf16* dst = (bf16*)(ws + OFF_AQ) + (size_t)qpos * D + head * 128;
            const float* sw = p.in[8];
#pragma unroll
            for (int et = 0; et < 4; ++et)
#pragma unroll
                for (int q4 = 0; q4 < 4; ++q4) {
                    const int e0 = 32 * et + 8 * q4 + 4 * h;
                    const f32x4 w4 = *(const f32x4*)(sw + e0);
                    if (!dry) *(u32x2*)(dst + e0) = (u32x2){pk2(O[et][4 * q4] * rstd * w4[0], O[et][4 * q4 + 1] * rstd * w4[1]), pk2(O[et][4 * q4 + 2] * rstd * w4[2], O[et][4 * q4 + 3] * rstd * w4[3])};
                }
        }
        __syncthreads();
    }
}

DI void phase3(const Params& p, char* smem, int bid, int nblk, int dry = 0, int mode = 3) {
    if (mode & 1) for (int hh = bid; hh < 8; hh += nblk) scan_head(p, smem, hh, dry);
    if (!(mode & 2)) return;
    float d1 = 0.f, d2 = 0.f;
    for (int i = 0; i < 64; ++i) { d1 += p.in[4][i] * p.in[5][i]; d2 += p.in[6][i] * p.in[7][i]; }
    const float lam = __expf(d1) - __expf(d2) + 0.2f;
    unsigned* q = (unsigned*)(p.ws + OFF_SMALL + SM_CTL) + CW_ATTQ + (dry ? 16 : 0);
    for (;;) {
        if (threadIdx.x == 0) *(unsigned*)(smem + AT_MISC) = atomicAdd(q, 1u);
        __syncthreads();
        const unsigned u = *(unsigned*)(smem + AT_MISC);
        __syncthreads();
        if (u >= (unsigned)AT_UNITS) break;
        const int hd = (int)(u & 7u);
        const unsigned* nrm = (const unsigned*)(p.ws + OFF_SMALL + SM_CTL) + CW_NRM;
        float bnd = 0.f;
        for (int m2 = 0; m2 < 2; ++m2) {
            const float q2 = __builtin_bit_cast(float, LD_ATOMIC(nrm + 2 * hd + m2)), k2 = __builtin_bit_cast(float, LD_ATOMIC(nrm + 16 + 2 * hd + m2));
            bnd = fmaxf(bnd, sqrtf(q2 * k2) * (0.125f * LOG2E) * 1.02f);
        }
        attention_unit(p, smem, hd, NQB - 1 - (int)(u >> 3), lam, dry, bnd);
    }
}

DI void phase4(const Params& p, char* smem, int bid, int nblk) {
    const int tid = fresh_tid(), lane = tid & 63, wave = tid >> 6;
    const int gw = bid * 8 + wave, NGW = nblk * 8;
    unsigned char* ws = p.ws;
    char* wl = smem + wave * 16384;
    for (int it = gw; it < 32 * 384; it += NGW) {
        const int e = it / 384, r = it % 384, m = r >> 7, q = r & 127;
        if (m < 2) transpose_item(p.in[21 + m] + (size_t)e * 1024 * 256, 256, 1024, (bf16*)(ws + (m == 0 ? OFF_EXG : OFF_EXU)) + (size_t)e * 256 * 1024, (q >> 3) * 64, (q & 7) * 32, (q & 7) * 32, (float*)wl, lane);
        else transpose_item(p.in[23] + (size_t)e * 256 * 1024, 1024, 256, (bf16*)(ws + OFF_EXD) + (size_t)e * 1024 * 256, (q >> 5) * 64, (q & 31) * 32, (q & 31) * 32, (float*)wl, lane);
    }
    for (int R = gw; R < SEQ; R += NGW) {
        const float* xrow = p.in[0] + (size_t)R * D; bf16* urow = (bf16*)(ws + OFF_U) + (size_t)R * D;
        float4 v[4]; float ss = 0.f;
#pragma unroll
        for (int j = 0; j < 4; ++j) { v[j] = *(const float4*)(xrow + 4 * lane + 256 * j); ss += v[j].x * v[j].x + v[j].y * v[j].y + v[j].z * v[j].z + v[j].w * v[j].w; }
        ss = wave_sum(ss);
        const float rstd = rsqrtf(ss * (1.0f / D) + NORM_EPS);
#pragma unroll
        for (int j = 0; j < 4; ++j) {
            const float4 w4 = *(const float4*)(p.in[2] + 4 * lane + 256 * j);
            *(u32x2*)(urow + 4 * lane + 256 * j) = (u32x2){pk2(v[j].x * rstd * w4.x, v[j].y * rstd * w4.y), pk2(v[j].z * rstd * w4.z, v[j].w * rstd * w4.w)};
        }
    }
    for (int it = gw; it < (NCH - 1) * 8; it += NGW) {
        const int cm1 = it >> 3, head = it & 7;
        const bf16* reg = (const bf16*)(ws + OFF_V) + (size_t)cm1 * 64 * D + head * 128;
#pragma unroll 4
        for (int i = 0; i < 16; ++i) { const int row = i * 4 + (lane >> 4), ch = lane & 15; *(u32x4*)(wl + row * 256 + ch * 16) = *(const u32x4*)(reg + (size_t)row * D + ch * 8); }
        WAVE_SYNC();
        float ss = 0.f;
#pragma unroll 8
        for (int dv = 0; dv < 128; ++dv) { const float v = bf2f(*(const bf16*)(wl + (dv >> 1) * 256 + ((dv & 1) * 64 + lane) * 2)); ss += v * v; }
        const float rstd = rsqrtf(ss * (1.0f / 128.0f) + NORM_EPS);
        const size_t j = (size_t)cm1 * 64 + lane;
        const bf16* gsrc = (const bf16*)(ws + OFF_DG) + j * D + head * 128;
        bf16* dst = (bf16*)(ws + OFF_OD) + j * D + head * 128;
#pragma unroll 2
        for (int d8 = 0; d8 < 16; ++d8) {
            const u32x4 gv = *(const u32x4*)(gsrc + 8 * d8);
            const f32x4 w0 = *(const f32x4*)(p.in[12] + 8 * d8), w1 = *(const f32x4*)(p.in[12] + 8 * d8 + 4);
            float o[8];
#pragma unroll
            for (int c = 0; c < 8; ++c) { const int dv = 8 * d8 + c; o[c] = bf2f(*(const bf16*)(wl + (dv >> 1) * 256 + ((dv & 1) * 64 + lane) * 2)) * rstd; }
            o[0] *= w0[0] * siluf_(bflo(gv.x)); o[1] *= w0[1] * siluf_(bfhi(gv.x)); o[2] *= w0[2] * siluf_(bflo(gv.y)); o[3] *= w0[3] * siluf_(bfhi(gv.y));
            o[4] *= w1[0] * siluf_(bflo(gv.z)); o[5] *= w1[1] * siluf_(bfhi(gv.z)); o[6] *= w1[2] * siluf_(bflo(gv.w)); o[7] *= w1[3] * siluf_(bfhi(gv.w));
            *(u32x4*)(dst + 8 * d8) = (u32x4){pk2(o[0], o[1]), pk2(o[2], o[3]), pk2(o[4], o[5]), pk2(o[6], o[7])};
        }
        WAVE_SYNC();
    }
}

template <int NB, int NI>
DI void rowgemm64(const bf16* arow, const bf16* const (&bptr)[NB], char* stg, f32x16 (&acc)[NB][2][NI]) {
    const int tid = fresh_tid(), lane = tid & 63, r32 = lane & 31, h = lane >> 5;
    const int lrow = tid >> 3, lc = tid & 7;
    u32x4 ra = arow ? *(const u32x4*)arow : (u32x4){0u, 0u, 0u, 0u};
    *(u32x4*)(stg + swz128(lrow, lc)) = ra;
    __syncthreads();
    for (int kc = 0; kc < 16; ++kc) {
        const int buf = kc & 1;
        if (kc + 1 < 16) ra = arow ? *(const u32x4*)(arow + (kc + 1) * 64) : (u32x4){0u, 0u, 0u, 0u};
#pragma unroll
        for (int ks = 0; ks < 4; ++ks) {
            bf16x8 af[2];
#pragma unroll
            for (int mi = 0; mi < 2; ++mi) af[mi] = *(const bf16x8*)(stg + buf * 8192 + swz128(32 * mi + r32, 2 * ks + h));
#pragma unroll
            for (int b = 0; b < NB; ++b)
#pragma unroll
                for (int ni = 0; ni < NI; ++ni) {
                    const bf16x8 bfr = *(const bf16x8*)(bptr[b] + (size_t)ni * 32 * 1024 + kc * 64 + ks * 16);
#pragma unroll
                    for (int mi = 0; mi < 2; ++mi) acc[b][mi][ni] = MFMA32(af[mi], bfr, acc[b][mi][ni]);
                }
        }
        if (kc + 1 < 16) *(u32x4*)(stg + (buf ^ 1) * 8192 + swz128(lrow, lc)) = ra;
        __syncthreads();
    }
}

constexpr int P5_MIX = 0, P5_PITCH = 2064, P5_STG = 64 * P5_PITCH, P5_MISC = P5_STG + 16384;
DI void post_block(const Params& p, char* smem, int rb, int dry) {
    int tid_ = threadIdx.x;
#ifndef EMU
    asm volatile("" : "+v"(tid_));
#endif
    const int tid = tid_, lane = tid & 63, wave = tid >> 6, r32 = lane & 31, h = lane >> 5;
    unsigned char* ws = p.ws;
    const int row0 = rb * 64, lrow = tid >> 3, lc = tid & 7;
    const bf16* Wt_in = (const bf16*)(ws + OFF_WTIN);
    char* stg = smem + P5_STG;
#pragma unroll 1
    for (int ps = 0; ps < 4; ++ps) {
        const int n0 = 128 * wave + 32 * ps + r32;
        f32x16 G[2][2][1];
#pragma unroll
        for (int b = 0; b < 2; ++b)
#pragma unroll
            for (int mi = 0; mi < 2; ++mi) G[b][mi][0] = zero16();
        {
            const bf16* const bp[2] = {Wt_in + (size_t)(7168 + n0) * 1024 + 8 * h, Wt_in + (size_t)(8192 + n0) * 1024 + 8 * h};
            rowgemm64<2, 1>((const bf16*)(ws + OFF_U) + (size_t)(row0 + lrow) * D + lc * 8, bp, stg, G);
        }
#pragma unroll
        for (int b = 0; b < 2; ++b)
#pragma unroll
            for (int mi = 0; mi < 2; ++mi)
#pragma unroll
                for (int r = 0; r < 16; ++r) G[b][mi][0][r] = sigmoidf_(G[b][mi][0][r]);
#pragma unroll 1
        for (int br = 0; br < 2; ++br) {
            f32x16 Y[1][2][1];
#pragma unroll
            for (int mi = 0; mi < 2; ++mi) Y[0][mi][0] = zero16();
            const bf16* const bp[1] = {(const bf16*)(ws + (br == 0 ? OFF_WTBA : OFF_WTBD)) + (size_t)n0 * 1024 + 8 * h};
            rowgemm64<1, 1>((const bf16*)(ws + (br == 0 ? OFF_AQ : OFF_OD)) + (size_t)(row0 + lrow) * D + lc * 8, bp, stg, Y);
            if (br == 0) {
#pragma unroll
                for (int mi = 0; mi < 2; ++mi) G[0][mi][0] = G[0][mi][0] * Y[0][mi][0];
            } else {
#pragma unroll
                for (int mi = 0; mi < 2; ++mi) G[0][mi][0] = G[0][mi][0] + G[1][mi][0] * Y[0][mi][0];
            }
        }
#pragma unroll
        for (int mi = 0; mi < 2; ++mi)
#pragma unroll
            for (int r = 0; r < 16; ++r) {
                const int row = 32 * mi + (r & 3) + 8 * (r >> 2) + 4 * h, col = 128 * wave + 32 * ps + r32;
                *(bf16*)(smem + P5_MIX + row * P5_PITCH + col * 2) = (bf16)f2bf(G[0][mi][0][r]);
            }
    }
    __syncthreads();
    float* partial = (float*)(smem + P5_MISC); float* rstdl = (float*)(smem + P5_MISC + 2048); float* logl = (float*)(smem + P5_MISC + 2048 + 256);
    {
        float rs[2][16];
#pragma unroll
        for (int mi = 0; mi < 2; ++mi)
#pragma unroll
            for (int r = 0; r < 16; ++r) rs[mi][r] = 0.f;
#pragma unroll 1
        for (int ps = 0; ps < 2; ++ps) {
            f32x16 H[2][2];
#pragma unroll
            for (int mi = 0; mi < 2; ++mi)
#pragma unroll
                for (int ni = 0; ni < 2; ++ni) H[mi][ni] = zero16();
            const bf16* bp = (const bf16*)(ws + OFF_WTOUT) + (size_t)(128 * wave + 64 * ps + r32) * 1024 + 8 * h;
#pragma unroll 2
            for (int ks = 0; ks < 64; ++ks) {
                bf16x8 af[2];
#pragma unroll
                for (int mi = 0; mi < 2; ++mi) af[mi] = *(const bf16x8*)(smem + P5_MIX + (32 * mi + r32) * P5_PITCH + (2 * ks + h) * 16);
#pragma unroll
                for (int ni = 0; ni < 2; ++ni) {
                    const bf16x8 bfr = *(const bf16x8*)(bp + (size_t)ni * 32 * 1024 + ks * 16);
#pragma unroll
                    for (int mi = 0; mi < 2; ++mi) H[mi][ni] = MFMA32(af[mi], bfr, H[mi][ni]);
                }
            }
#pragma unroll
            for (int mi = 0; mi < 2; ++mi)
#pragma unroll
                for (int ni = 0; ni < 2; ++ni)
#pragma unroll
                    for (int r = 0; r < 16; ++r) {
                        const int row = 32 * mi + (r & 3) + 8 * (r >> 2) + 4 * h, col = 128 * wave + 64 * ps + 32 * ni + r32;
                        const float hv = H[mi][ni][r] + p.in[0][(size_t)(row0 + row) * D + col];
                        rs[mi][r] += hv * hv;
                        if (!dry) p.out[(size_t)(row0 + row) * D + col] = hv;
                    }
        }
#pragma unroll
        for (int mi = 0; mi < 2; ++mi)
#pragma unroll
            for (int r = 0; r < 16; ++r) {
                float v = rs[mi][r];
                v += __shfl_xor(v, 1); v += __shfl_xor(v, 2); v += __shfl_xor(v, 4); v += __shfl_xor(v, 8); v += __shfl_xor(v, 16);
                if (r32 == 0) partial[(32 * mi + (r & 3) + 8 * (r >> 2) + 4 * h) * 8 + wave] = v;
            }
    }
    __threadfence();
    __syncthreads();
    if (tid < 64) { float s = 0.f;
#pragma unroll
        for (int w = 0; w < 8; ++w) s += partial[tid * 8 + w];
        rstdl[tid] = rsqrtf(s * (1.0f / D) + NORM_EPS); }
    __syncthreads();
#pragma unroll 2
    for (int i = 0; i < 16; ++i) {
        const int idx = tid + NT * i, row = idx >> 7, ch = idx & 127;
        const float* hp = p.out + (size_t)(row0 + row) * D + ch * 8;
        const f32x4 a = LD_NT((const f32x4*)hp), b = LD_NT((const f32x4*)(hp + 4));
        const f32x4 w0 = *(const f32x4*)(p.in[16] + ch * 8), w1 = *(const f32x4*)(p.in[16] + ch * 8 + 4);
        const float rs = rstdl[row];
        if (!dry) *(u32x4*)((bf16*)(ws + OFF_OD) + (size_t)(row0 + row) * D + ch * 8) =
            (u32x4){pk2(a[0] * rs * w0[0], a[1] * rs * w0[1]), pk2(a[2] * rs * w0[2], a[3] * rs * w0[3]), pk2(b[0] * rs * w1[0], b[1] * rs * w1[1]), pk2(b[2] * rs * w1[2], b[3] * rs * w1[3])};
    }
    float lg[36];
#pragma unroll
    for (int c = 0; c < 36; ++c) lg[c] = 0.f;
    float* HL = (float*)(smem + P5_MIX);
    const float* WR = (const float*)(ws + OFF_SMALL + SM_WR);
#pragma unroll 1
    for (int half = 0; half < 2; ++half) {
        __syncthreads();
#pragma unroll 4
        for (int i = 0; i < 16; ++i) {
            const int idx = tid + NT * i, row = idx >> 7, c4 = idx & 127;
            const f32x4 a = LD_NT((const f32x4*)(p.out + (size_t)(row0 + row) * D + 512 * half + c4 * 4));
            float* d = HL + row * 513 + c4 * 4; d[0] = a[0]; d[1] = a[1]; d[2] = a[2]; d[3] = a[3];
        }
        __syncthreads();
        const int kb = 64 * wave;
#pragma unroll 1
        for (int kk = 0; kk < 64; ++kk) {
            const float hv = HL[lane * 513 + kb + kk];
            const float* wr = WR + (size_t)(512 * half + kb + kk) * 40;
#pragma unroll
            for (int c = 0; c < 36; ++c) lg[c] += hv * wr[c];
        }
    }
    __syncthreads();
    float* PL = (float*)(smem + P5_MIX);
#pragma unroll
    for (int c = 0; c < 36; ++c) PL[(lane * 8 + wave) * 36 + c] = lg[c];
    __syncthreads();
    if (tid < 64) {
        const float rs = rstdl[tid];
        for (int c = 0; c < 36; ++c) { float s = 0.f; for (int w = 0; w < 8; ++w) s += PL[(tid * 8 + w) * 36 + c]; logl[tid * 40 + c] = s * rs + (c < 4 ? p.in[18][c] : p.in[20][c - 4]); }
        const float* L = logl + tid * 40;
        int gi = 0; float gm = L[0];
        for (int c = 1; c < 4; ++c) if (L[c] > gm) { gm = L[c]; gi = c; }
        float gs = 0.f; for (int c = 0; c < 4; ++c) gs += __expf(L[c] - gm);
        const float gw = 1.0f / gs;
        const float* E = L + 4 + 8 * gi;
        int i1 = 0; float l1 = E[0];
        for (int c = 1; c < 8; ++c) if (E[c] > l1) { l1 = E[c]; i1 = c; }
        int i2 = -1; float l2 = -3.0e38f;
        for (int c = 0; c < 8; ++c) if (c != i1 && E[c] > l2) { l2 = E[c]; i2 = c; }
        const float t = __expf(l2 - l1), w1 = 1.0f / (1.0f + t), w2 = t / (1.0f + t);
        unsigned* cnt = (unsigned*)(ws + OFF_SMALL + SM_CTL) + CW_ECNT;
        int* lists = (int*)(ws + OFF_SMALL + SM_TAILS); float* RW = (float*)(ws + OFF_SMALL + SM_RW);
        const int j = row0 + tid;
        const int e1 = 8 * gi + i1, e2 = 8 * gi + i2;
        if (!dry) {
        const unsigned p1 = atomicAdd(cnt + e1, 1u); ST_ATOMIC(lists + (size_t)e1 * SEQ + p1, (j << 1)); RW[2 * j] = gw * w1;
        const unsigned p2 = atomicAdd(cnt + e2, 1u); ST_ATOMIC(lists + (size_t)e2 * SEQ + p2, (j << 1) | 1); RW[2 * j + 1] = gw * w2;
        } else { asm volatile("" :: "v"(e1), "v"(e2), "v"(gw * w1), "v"(gw * w2)); }
    }
    __syncthreads();
}
DI void phase5(const Params& p, char* smem, int bid, int nblk, int dry = 0) {
    for (int rb = bid; rb < SEQ / 64; rb += nblk) post_block(p, smem, rb, dry);
}

constexpr int P6_HL = 0, P6_PITCH = 528, P6_STG = 64 * P6_PITCH, P6_TOK = P6_STG + 16384, P6_RW = P6_TOK + 256, P6_TS = P6_RW + 256;
DI void moe_item(const Params& p, char* smem, int e, int mt, int cnt_e) {
    const int tid = fresh_tid(), lane = tid & 63, wave = tid >> 6, r32 = lane & 31, h = lane >> 5;
    unsigned char* ws = p.ws;
    int* tokl = (int*)(smem + P6_TOK); float* rwl = (float*)(smem + P6_RW);
    if (tid < 64) {
        const int idx = 64 * mt + tid; int ent = -1; float w = 0.f;
        if (idx < cnt_e) { ent = ((const int*)(ws + OFF_SMALL + SM_TAILS))[(size_t)e * SEQ + idx]; w = ((const float*)(ws + OFF_SMALL + SM_RW))[ent]; }
        tokl[tid] = ent; rwl[tid] = w;
    }
    __syncthreads();
    const int lrow = tid >> 3, lc = tid & 7;
    const int lent = tokl[lrow];
    f32x16 GU[2][2][1];
#pragma unroll
    for (int b = 0; b < 2; ++b)
#pragma unroll
        for (int mi = 0; mi < 2; ++mi) GU[b][mi][0] = zero16();
    {
        const bf16* const bp[2] = {(const bf16*)(ws + OFF_EXG) + ((size_t)e * 256 + 32 * wave + r32) * 1024 + 8 * h, (const bf16*)(ws + OFF_EXU) + ((size_t)e * 256 + 32 * wave + r32) * 1024 + 8 * h};
        rowgemm64<2, 1>(lent >= 0 ? (const bf16*)(ws + OFF_OD) + (size_t)(lent >> 1) * D + lc * 8 : nullptr, bp, smem + P6_STG, GU);
    }
#pragma unroll
    for (int mi = 0; mi < 2; ++mi)
#pragma unroll
        for (int r = 0; r < 16; ++r) {
            const int row = 32 * mi + (r & 3) + 8 * (r >> 2) + 4 * h, col = 32 * wave + r32;
            *(bf16*)(smem + P6_HL + row * P6_PITCH + col * 2) = (bf16)f2bf(siluf_(GU[0][mi][0][r]) * GU[1][mi][0][r]);
        }
    __syncthreads();
#pragma unroll 1
    for (int ps = 0; ps < 2; ++ps) {
        f32x16 Y[2][2];
#pragma unroll
        for (int mi = 0; mi < 2; ++mi)
#pragma unroll
            for (int ni = 0; ni < 2; ++ni) Y[mi][ni] = zero16();
        const bf16* bp = (const bf16*)(ws + OFF_EXD) + ((size_t)e * 1024 + 128 * wave + 64 * ps + r32) * 256 + 8 * h;
#pragma unroll 4
        for (int ks = 0; ks < 16; ++ks) {
            bf16x8 af[2];
#pragma unroll
            for (int mi = 0; mi < 2; ++mi) af[mi] = *(const bf16x8*)(smem + P6_HL + (32 * mi + r32) * P6_PITCH + (2 * ks + h) * 16);
#pragma unroll
            for (int ni = 0; ni < 2; ++ni) {
                const bf16x8 bfr = *(const bf16x8*)(bp + (size_t)ni * 32 * 256 + ks * 16);
#pragma unroll
                for (int mi = 0; mi < 2; ++mi) Y[mi][ni] = MFMA32(af[mi], bfr, Y[mi][ni]);
            }
        }
#pragma unroll
        for (int mi = 0; mi < 2; ++mi)
#pragma unroll
            for (int r = 0; r < 16; ++r) {
                const int row = 32 * mi + (r & 3) + 8 * (r >> 2) + 4 * h; const int ent = tokl[row];
                if (ent >= 0) {
                    const float w = rwl[row]; bf16* dst = (bf16*)(ws + OFF_Y) + (size_t)ent * D + 128 * wave + 64 * ps + r32;
#pragma unroll
                    for (int ni = 0; ni < 2; ++ni) dst[32 * ni] = (bf16)f2bf(Y[mi][ni][r] * w);
                }
            }
    }
    __syncthreads();
}
DI void phase6(const Params& p, char* smem, int bid, int nblk) {
    int* ts = (int*)(smem + P6_TS);
    unsigned* cnt = (unsigned*)(p.ws + OFF_SMALL + SM_CTL) + CW_ECNT;
    int* tc = (int*)(smem + P6_TS + 256);
    if (threadIdx.x < 32) tc[threadIdx.x] = (int)LD_ATOMIC(cnt + threadIdx.x);
    __syncthreads();
    if (threadIdx.x == 0) { int s = 0; for (int e = 0; e < 32; ++e) { ts[e] = s; s += (tc[e] + 63) >> 6; } ts[32] = s; }
    __syncthreads();
    const int total = ts[32];
    for (int t = bid; t < total; t += nblk) {
        int e = 0;
        for (int q = 1; q < 32; ++q) if (ts[q] <= t) e = q;
        moe_item(p, smem, e, t - ts[e], tc[e]);
    }
}

DI void phase7(const Params& p, char* smem, int bid, int nblk, int dry = 0) {
    const int tid = fresh_tid(), lane = tid & 63, wave = tid >> 6;
    const int gw = bid * 8 + wave, NGW = nblk * 8;
    for (int j = gw; j < SEQ; j += NGW) {
        float* hrow = p.out + (size_t)j * D;
        const bf16* y0 = (const bf16*)(p.ws + OFF_Y) + (size_t)j * 2 * D;
        float4 v[4]; float ss = 0.f;
#pragma unroll
        for (int q = 0; q < 4; ++q) {
            const int c = 4 * lane + 256 * q;
            v[q] = *(const float4*)(hrow + c);
            const u32x2 a = *(const u32x2*)(y0 + c), b = *(const u32x2*)(y0 + D + c);
            v[q].x += bflo(a.x) + bflo(b.x); v[q].y += bfhi(a.x) + bfhi(b.x); v[q].z += bflo(a.y) + bflo(b.y); v[q].w += bfhi(a.y) + bfhi(b.y);
            ss += v[q].x * v[q].x + v[q].y * v[q].y + v[q].z * v[q].z + v[q].w * v[q].w;
        }
        ss = wave_sum(ss);
        const float rstd = rsqrtf(ss * (1.0f / D) + NORM_EPS);
#pragma unroll
        for (int q = 0; q < 4; ++q) {
            const int c = 4 * lane + 256 * q; const float4 w4 = *(const float4*)(p.in[24] + c);
            if (!dry) *(float4*)(hrow + c) = make_float4(v[q].x * rstd * w4.x, v[q].y * rstd * w4.y, v[q].z * rstd * w4.z, v[q].w * rstd * w4.w);
        }
    }
}

__global__ void __launch_bounds__(NT) k_phase0(Params p) { SMEM_DECL; phase0(p, smem, blockIdx.x, gridDim.x); }
__global__ void __launch_bounds__(NT) k_phase1(Params p) { SMEM_DECL; phase1(p, smem, blockIdx.x, gridDim.x); }
__global__ void __launch_bounds__(NT) k_phase2(Params p) { SMEM_DECL; phase2(p, smem, blockIdx.x, gridDim.x, 0); }
__global__ void __launch_bounds__(NT) k_phase3(Params p) { SMEM_DECL; phase3(p, smem, blockIdx.x, gridDim.x); }
__global__ void __launch_bounds__(NT) k_phase4(Params p) { SMEM_DECL; phase4(p, smem, blockIdx.x, gridDim.x); }
__global__ void __launch_bounds__(NT) k_phase5(Params p) { SMEM_DECL; phase5(p, smem, blockIdx.x, gridDim.x); }
__global__ void __launch_bounds__(NT) k_phase6(Params p) { SMEM_DECL; phase6(p, smem, blockIdx.x, gridDim.x); }
__global__ void __launch_bounds__(NT) k_phase7(Params p) { SMEM_DECL; phase7(p, smem, blockIdx.x, gridDim.x); }

constexpr int LDS_BYTES = 160 * 1024 - 256;
constexpr int LDS_BARST = LDS_BYTES - 16;

#ifndef EMU
#define LAS __attribute__((address_space(3)))
#define XB_TMO      128
#define XB_XCNT(j)  (256  + 64 * (j))
#define XB_XSUB(j)  (1280 + 64 * (j))
#define XB_XGEN(j)  (2304 + 64 * (j))
#define XB_TOP      3328
#define XB_TOPGEN   3392
#define XCD_BAR_WORDS 3456
#define XB_SPIN_CAP (1u << 22)
__device__ __forceinline__ unsigned xb_ld(unsigned* p)              { return __hip_atomic_load(p, __ATOMIC_RELAXED, __HIP_MEMORY_SCOPE_AGENT); }
__device__ __forceinline__ unsigned xb_add(unsigned* p, unsigned v) { return __hip_atomic_fetch_add(p, v, __ATOMIC_RELAXED, __HIP_MEMORY_SCOPE_AGENT); }
__device__ __forceinline__ unsigned xb_xcc_id() { return (unsigned)__builtin_amdgcn_s_getreg((3 << 11) | 20) & 0xFu; }
#define XB_SPIN(cond, bar) do { unsigned _sp = 0; while (cond) { __builtin_amdgcn_s_sleep(1); \
    if ((++_sp & 255u) == 0u) { if (xb_ld(&(bar)[XB_TMO])) break; if (_sp > XB_SPIN_CAP) { atomicAdd(&(bar)[XB_TMO], 1u); break; } } } } while (0)
struct XcdBarrier { unsigned* bar; unsigned x; volatile LAS unsigned* st; };
__device__ __forceinline__ XcdBarrier xcd_barrier_post(unsigned* bar, volatile LAS unsigned* st) {
    XcdBarrier b; b.bar = bar; b.x = xb_xcc_id(); b.st = st;
    if (threadIdx.x == 0) (void)xb_add(&bar[XB_XCNT(b.x)], 1u);
    return b;
}
__device__ __forceinline__ void xcd_barrier_complete(unsigned* bar, unsigned x, unsigned& nloc, unsigned& nx) {
    const unsigned G = gridDim.x * gridDim.y * gridDim.z;
    unsigned sum, cnt, mine, sp = 0u;
    for (;;) {
        sum = 0u; cnt = 0u; mine = 0u;
#pragma unroll
        for (unsigned j = 0; j < 16; ++j) { const unsigned c = xb_ld(&bar[XB_XCNT(j)]); sum += c; cnt += (c > 0u) ? 1u : 0u; mine = (j == x) ? c : mine; }
        if (sum == G) break;
        __builtin_amdgcn_s_sleep(1);
        if ((++sp & 255u) == 0u) { if (xb_ld(&bar[XB_TMO])) break; if (sp > XB_SPIN_CAP) { atomicAdd(&bar[XB_TMO], 1u); break; } }
    }
    nloc = mine > 0u ? mine : 1u; nx = cnt > 0u ? cnt : 1u;
}
__device__ __forceinline__ void xcd_barrier(const XcdBarrier& b) {
    asm volatile("s_waitcnt vmcnt(0)" ::: "memory");
    __syncthreads();
    if (threadIdx.x == 0) {
        unsigned* bar = b.bar;
        __builtin_amdgcn_s_waitcnt(0);
        unsigned nloc = b.st[0], nx = b.st[1];
        if (nloc == 0u) { xcd_barrier_complete(bar, b.x, nloc, nx); b.st[0] = nloc; b.st[1] = nx; }
        const unsigned old = xb_add(&bar[XB_XSUB(b.x)], 1u);
        const unsigned gen = old / nloc;
        if (old + 1u == (gen + 1u) * nloc) {
            __builtin_amdgcn_fence(__ATOMIC_RELEASE, "agent");
            asm volatile("s_waitcnt vmcnt(0)" ::: "memory");
            const unsigned og = xb_add(&bar[XB_TOP], 1u);
            const unsigned tg = og / nx;
            if (og + 1u == (tg + 1u) * nx) xb_add(&bar[XB_TOPGEN], 1u);
            else XB_SPIN(xb_ld(&bar[XB_TOPGEN]) == tg, bar);
            __builtin_amdgcn_fence(__ATOMIC_ACQUIRE, "agent");
            xb_add(&bar[XB_XGEN(b.x)], 1u);
            asm volatile("s_waitcnt vmcnt(0)" ::: "memory");
        } else {
            XB_SPIN(xb_ld(&bar[XB_XGEN(b.x)]) == gen, bar);
            __builtin_amdgcn_fence(__ATOMIC_ACQUIRE, "agent");
            asm volatile("s_waitcnt vmcnt(0)" ::: "memory");
        }
    }
    __syncthreads();
}
#endif

#ifdef EMU
#define GRID_SYNC() emu_grid_sync()
#define GRID_SYNC_CG() emu_grid_sync()
#else
#define GRID_SYNC_CG() do { \
    asm volatile("s_waitcnt vmcnt(0)" ::: "memory"); \
    __syncthreads(); \
    cooperative_groups::this_grid().sync(); \
    if (threadIdx.x == 0) { __builtin_amdgcn_fence(__ATOMIC_ACQUIRE, "agent"); asm volatile("s_waitcnt vmcnt(0)" ::: "memory"); } \
    __syncthreads(); \
} while (0)
#define GRID_SYNC() xcd_barrier(xbar)
#endif
__global__ void __launch_bounds__(NT) fwd_megakernel(Params p) {
    SMEM_DECL;
    const int bid = blockIdx.x, nblk = gridDim.x;
#ifndef EMU
    if (threadIdx.x < 4) ((volatile LAS unsigned*)(smem + LDS_BARST))[threadIdx.x] = 0u;
    __syncthreads();
    const XcdBarrier xbar = xcd_barrier_post((unsigned*)(p.ws + OFF_SMALL + SM_CTL) + CW_BAR, (volatile LAS unsigned*)(smem + LDS_BARST));
#endif
#if defined(DRY_PHASE) && !defined(EMU)
    int dryflag = 1; asm volatile("" : "+s"(dryflag));
#define EXTRA(k, call) do { if (DRY_PHASE == (k)) { call; GRID_SYNC(); } } while (0)
#else
#define EXTRA(k, call) do {} while (0)
    const int dryflag = 0; (void)dryflag;
#endif
    EXTRA(0, phase0(p, smem, bid, nblk));
    phase0(p, smem, bid, nblk); GRID_SYNC_CG();
    EXTRA(1, phase1(p, smem, bid, nblk));
    phase1(p, smem, bid, nblk); GRID_SYNC();
    EXTRA(2, phase2(p, smem, bid, nblk, dryflag));
    phase2(p, smem, bid, nblk); GRID_SYNC();
    EXTRA(3, phase3(p, smem, bid, nblk, dryflag));
    EXTRA(8, phase3(p, smem, bid, nblk, dryflag, 1));
    EXTRA(9, phase3(p, smem, bid, nblk, dryflag, 2));
    phase3(p, smem, bid, nblk); GRID_SYNC();
    EXTRA(4, phase4(p, smem, bid, nblk));
    phase4(p, smem, bid, nblk); GRID_SYNC();
    EXTRA(5, phase5(p, smem, bid, nblk, dryflag));
    phase5(p, smem, bid, nblk); GRID_SYNC();
    EXTRA(6, phase6(p, smem, bid, nblk));
    phase6(p, smem, bid, nblk); GRID_SYNC();
    EXTRA(7, phase7(p, smem, bid, nblk, dryflag));
    phase7(p, smem, bid, nblk);
}

#ifndef EMU
extern "C" void kernel_launch(void* const* d_in, const int* in_sizes, int n_in, void* d_out, int out_size, void* d_ws, size_t ws_size, hipStream_t stream) {
    static int grid = 0;
    if (grid == 0) {
        if (n_in != 25 || ws_size < WS_END || out_size != SEQ * D) { fprintf(stderr, "kernel_launch: unexpected problem (n_in %d, ws %zu, out %d)\n", n_in, ws_size, out_size); grid = -1; return; }
        int dev = 0, cus = 0, per_cu = 0;
        (void)hipGetDevice(&dev);
        (void)hipDeviceGetAttribute(&cus, hipDeviceAttributeMultiprocessorCount, dev);
        (void)hipFuncSetAttribute((const void*)fwd_megakernel, hipFuncAttributeMaxDynamicSharedMemorySize, LDS_BYTES);
        (void)hipOccupancyMaxActiveBlocksPerMultiprocessor(&per_cu, (const void*)fwd_megakernel, NT, LDS_BYTES);
        if (per_cu < 1) { fprintf(stderr, "kernel_launch: occupancy query returned %d\n", per_cu); per_cu = 1; }
        grid = cus * per_cu;
    }
    if (grid < 0) return;
    Params p{};
    for (int i = 0; i < 25; ++i) p.in[i] = (const float*)d_in[i];
    p.out = (float*)d_out; p.ws = (unsigned char*)d_ws;
    (void)hipMemsetAsync((unsigned char*)d_ws + OFF_SMALL + SM_CTL + (size_t)CW_BAR * 4, 0, (size_t)XCD_BAR_WORDS * 4, stream);
    void* args[] = {&p};
    hipError_t e = hipLaunchCooperativeKernel((const void*)fwd_megakernel, dim3(grid), dim3(NT), args, LDS_BYTES, stream);
    if (e != hipSuccess) fprintf(stderr, "cooperative launch failed: %s (grid %d)\n", hipGetErrorString(e), grid);
}
#endif

#ifdef EMU
static void run_phases(Params p, int upto, int grid) {
    if (upto == 100) { emu::launch([=] { fwd_megakernel(p); }, grid, NT, LDS_BYTES, true); return; }
    if (upto >= 0) emu::launch([=] { k_phase0(p); }, grid, NT, LDS_BYTES, false);
    if (upto >= 1) emu::launch([=] { k_phase1(p); }, grid, NT, LDS_BYTES, false);
    if (upto >= 2) emu::launch([=] { k_phase2(p); }, grid, NT, LDS_BYTES, false);
    if (upto >= 3) emu::launch([=] { k_phase3(p); }, grid, NT, LDS_BYTES, false);
    if (upto >= 4) emu::launch([=] { k_phase4(p); }, grid, NT, LDS_BYTES, false);
    if (upto >= 5) emu::launch([=] { k_phase5(p); }, grid, NT, LDS_BYTES, false);
    if (upto >= 6) emu::launch([=] { k_phase6(p); }, grid, NT, LDS_BYTES, false);
    if (upto >= 7) emu::launch([=] { k_phase7(p); }, grid, NT, LDS_BYTES, false);
}
#endif
```

```cpp
#ifndef EMU
#include <hip/hip_runtime.h>
#include <hip/hip_cooperative_groups.h>
#include <cstdio>
#include <cstdint>
#include <cmath>
#endif

#ifndef SEQ
#define SEQ 16384
#endif

typedef unsigned short bf16;
typedef short bf16x8 __attribute__((ext_vector_type(8)));
typedef short bf16x4 __attribute__((ext_vector_type(4)));
typedef float f32x16 __attribute__((ext_vector_type(16)));
typedef float f32x4 __attribute__((ext_vector_type(4)));
typedef unsigned u32x4 __attribute__((ext_vector_type(4)));
typedef unsigned u32x2 __attribute__((ext_vector_type(2)));

#ifdef EMU
#define MFMA32(a, b, c) emu_mfma_32x32x16((a), (b), (c))
#define MFMA16(a, b, c) emu_mfma_16x16x32((a), (b), (c))
#define DI static inline
#define DM inline
#define EXP2F(x) exp2f(x)
#define WAVE_SYNC() emu_wave_sync()
#define LD_NT(p) (*(p))
#define LD_ATOMIC(p) (*(p))
#define ST_ATOMIC(p, v) (*(p) = (v))
#define SCHED_FENCE() do {} while (0)
#else
#define WAVE_SYNC() do { __builtin_amdgcn_fence(__ATOMIC_RELEASE, "wavefront"); __builtin_amdgcn_wave_barrier(); __builtin_amdgcn_fence(__ATOMIC_ACQUIRE, "wavefront"); } while (0)
#define MFMA32(a, b, c) __builtin_amdgcn_mfma_f32_32x32x16_bf16((a), (b), (c), 0, 0, 0)
#define LD_NT(p) __builtin_nontemporal_load(p)
#define LD_ATOMIC(p) __hip_atomic_load((p), __ATOMIC_RELAXED, __HIP_MEMORY_SCOPE_AGENT)
#define ST_ATOMIC(p, v) __hip_atomic_store((p), (v), __ATOMIC_RELAXED, __HIP_MEMORY_SCOPE_AGENT)
#define SCHED_FENCE() __builtin_amdgcn_sched_barrier(0)
#define MFMA16(a, b, c) __builtin_amdgcn_mfma_f32_16x16x32_bf16((a), (b), (c), 0, 0, 0)
#define DI __device__ __forceinline__
#define DM __device__ __forceinline__
#define EXP2F(x) __builtin_amdgcn_exp2f(x)
#endif

constexpr int D = 1024;
constexpr int NMETA = 16;
constexpr int LTOK = SEQ + NMETA;
constexpr int NCH = SEQ / 64 + 1;
constexpr int NT = 512;
constexpr int W_IN_COLS = 9232;
constexpr float NORM_EPS = 1e-6f;
constexpr float LOG2E = 1.4426950408889634f;

constexpr size_t UNIT = (size_t)SEQ * D * 2;
constexpr size_t OFF_WTIN = 0;
constexpr size_t OFF_WTBA = OFF_WTIN + (size_t)9216 * 1024 * 2;
constexpr size_t OFF_WTBD = OFF_WTBA + (size_t)1024 * 1024 * 2;
constexpr size_t OFF_WTOUT = OFF_WTBD + (size_t)1024 * 1024 * 2;
constexpr size_t OFF_SMALL = OFF_WTOUT + (size_t)1024 * 1024 * 2;
constexpr size_t SM_CTL = 0;
constexpr size_t SM_UMETA = SM_CTL + 65536;
constexpr size_t SM_AKMETA = SM_UMETA + 16 * 1024 * 2;
constexpr size_t SM_AVTMETA = SM_AKMETA + 16 * 1024 * 2;
constexpr size_t SM_C0Q = SM_AVTMETA + 8 * 128 * 16 * 2;
constexpr size_t SM_C0K = SM_C0Q + 64 * 1024 * 2;
constexpr size_t SM_C0V = SM_C0K + 64 * 1024 * 2;
constexpr size_t SM_C0W = SM_C0V + 64 * 1024 * 2;
constexpr size_t SM_C0QK = SM_C0W + 8 * 64 * 128 * 2;
constexpr size_t SM_BETA = SM_C0QK + 8 * 64 * 64 * 2;
constexpr size_t SM_G = SM_BETA + (size_t)NCH * 64 * 8 * 4;
constexpr size_t SM_GC = SM_G + (size_t)NCH * 64 * 8 * 4;
constexpr size_t SM_WR = SM_GC + (size_t)NCH * 8 * 64 * 4;
constexpr size_t SM_RIDS = SM_WR + 1024 * 40 * 4;
constexpr size_t SM_RW = SM_RIDS + 0;
constexpr size_t SM_TAILS = SM_RW + (size_t)SEQ * 2 * 4;
constexpr size_t SM_TAILS_BYTES = ((size_t)NCH * 3 * 3072 * 2 > (size_t)32 * SEQ * 4) ? (size_t)NCH * 3 * 3072 * 2 : (size_t)32 * SEQ * 4;
constexpr size_t SM_END = SM_TAILS + SM_TAILS_BYTES;
constexpr size_t SMALL_BYTES = (SM_END + 255) & ~(size_t)255;
constexpr size_t OFF_U = ((OFF_SMALL + SMALL_BYTES + (1u << 20) - 1) >> 20) << 20;
constexpr size_t OFF_W = OFF_U + UNIT;
constexpr size_t OFF_KN = OFF_W + UNIT;
constexpr size_t OFF_QN = OFF_KN + UNIT;
constexpr size_t OFF_DG = OFF_QN + UNIT;
constexpr size_t OFF_V = OFF_DG + UNIT;
constexpr size_t OFF_AQ = OFF_V + UNIT;
constexpr size_t WS_BASE_END = OFF_AQ + UNIT;
constexpr size_t EXPERT_BYTES = (size_t)32 * 3 * 1024 * 256 * 2;
constexpr size_t OFF_EXP = (2 * UNIT >= EXPERT_BYTES) ? OFF_W : WS_BASE_END;
constexpr size_t WS_END = (OFF_EXP == OFF_W) ? WS_BASE_END : WS_BASE_END + EXPERT_BYTES;
constexpr size_t OFF_EXG = OFF_EXP, OFF_EXU = OFF_EXP + EXPERT_BYTES / 3, OFF_EXD = OFF_EXP + 2 * (EXPERT_BYTES / 3);
constexpr size_t OFF_QKB = OFF_U;
constexpr size_t OFF_OD = OFF_QN;
constexpr size_t OFF_Y = OFF_V;
#if SEQ == 16384
static_assert(WS_END <= (size_t)256 << 20, "workspace map exceeds 256 MiB");
static_assert(EXPERT_BYTES <= 2 * UNIT, "experts fit R2+R3");
#endif
constexpr int CW_ATTQ = 64;
constexpr int CW_ECNT = 128;
constexpr int CW_NRM = 256;
constexpr int CW_BAR = 1024;

struct Params {
    const float* in[25];
    float* out;
    unsigned char* ws;
};

DI unsigned f2bf(float f) { unsigned u = __builtin_bit_cast(unsigned, f); return (u + 0x7fffu + ((u >> 16) & 1u)) >> 16; }
DI float bf2f(unsigned b) { return __builtin_bit_cast(float, (b & 0xffffu) << 16); }
#ifdef EMU
DI unsigned pk2(float lo, float hi) { return f2bf(lo) | (f2bf(hi) << 16); }
DI bool wave_any(bool pr) { int v = pr ? 1 : 0;
    for (int o = 1; o < 64; o <<= 1) v |= __shfl_xor(v, o);
    return v != 0; }
#else
typedef __bf16 hwbf2 __attribute__((ext_vector_type(2)));
typedef float f32x2_ __attribute__((ext_vector_type(2)));
DI unsigned pk2(float lo, float hi) { return __builtin_bit_cast(unsigned, __builtin_convertvector((f32x2_){lo, hi}, hwbf2)); }
DI bool wave_any(bool pr) { return __any(pr) != 0; }
#endif
DI float bflo(unsigned w) { return __builtin_bit_cast(float, w << 16); }
DI float bfhi(unsigned w) { return __builtin_bit_cast(float, w & 0xffff0000u); }
DI float sigmoidf_(float x) { return 1.0f / (1.0f + __expf(-x)); }
DI float siluf_(float x) { return x / (1.0f + __expf(-x)); }
DI float wave_sum(float v) {
#pragma unroll
    for (int o = 1; o < 64; o <<= 1) v += __shfl_xor(v, o);
    return v;
}
DI int fresh_tid() {
    int t = threadIdx.x;
#ifndef EMU
    asm volatile("" : "+v"(t));
#endif
    return t;
}
DI f32x16 zero16() { f32x16 z; for (int i = 0; i < 16; ++i) z[i] = 0.f; return z; }
DI f32x4 zero4() { f32x4 z; for (int i = 0; i < 4; ++i) z[i] = 0.f; return z; }
DI int swz128(int row, int c) { return row * 128 + ((c ^ ((row >> 1) & 7)) << 4); }
DI int swz128_8(int row, int s) { return row * 128 + ((s ^ (((row >> 1) & 7) << 1)) << 3); }
DI int swzrow(int row, int pitch, int c) { return row * pitch + ((c ^ (row & 15)) << 4); }

#ifdef EMU
#define SMEM_DECL char* smem = emu_smem()
#else
#define SMEM_DECL extern __shared__ __attribute__((aligned(16))) char smem[]
#endif

DI void transpose_item(const float* W, int ldw, int K, bf16* Wt, int k0, int src_n0, int dst_n0, float* scr, int lane) {
#pragma unroll 8
    for (int i = 0; i < 32; ++i) { const int kk = 2 * i + (lane >> 5); scr[kk * 33 + (lane & 31)] = W[(size_t)(k0 + kk) * ldw + src_n0 + (lane & 31)]; }
    WAVE_SYNC();
    const int c = lane & 7;
#pragma unroll
    for (int j = 0; j < 4; ++j) {
        const int n = (lane >> 3) + 8 * j; const float* s = scr + (8 * c) * 33 + n;
        u32x4 o; o.x = pk2(s[0 * 33], s[1 * 33]); o.y = pk2(s[2 * 33], s[3 * 33]); o.z = pk2(s[4 * 33], s[5 * 33]); o.w = pk2(s[6 * 33], s[7 * 33]);
        *(u32x4*)(Wt + (size_t)(dst_n0 + n) * K + k0 + 8 * c) = o;
    }
    WAVE_SYNC();
}

DI void phase0(const Params& p, char* smem, int bid, int nblk) {
    const int tid = fresh_tid(), lane = tid & 63, wave = tid >> 6;
    const int gw = bid * 8 + wave, NGW = nblk * 8;
    unsigned char* ws = p.ws;
    if (bid == 0) {
        unsigned* ctl = (unsigned*)(ws + OFF_SMALL + SM_CTL);
        for (int i = tid; i < 1024; i += NT) ctl[i] = 0u;
        float* be = (float*)(ws + OFF_SMALL + SM_BETA); float* gg = (float*)(ws + OFF_SMALL + SM_G);
        for (int i = tid; i < 48 * 8; i += NT) { be[i] = 0.f; gg[i] = 0.f; }
    }
    {
        float* scr = (float*)(smem + 65536) + wave * (64 * 33);
        constexpr int I_IN = 16 * (9216 / 32), I_SQ = 16 * 32;
        constexpr int NITEMS = I_IN + 3 * I_SQ;
        for (int it = gw; it < NITEMS; it += NGW) {
            int r = it;
            if (r < I_IN) { const int kb = r / 288, nb = r % 288; const int dn = nb * 32; const int sn = dn < 7168 ? dn : dn + 16;
                transpose_item(p.in[3], W_IN_COLS, 1024, (bf16*)(ws + OFF_WTIN), kb * 64, sn, dn, scr, lane); continue; }
            r -= I_IN;
            const int m = r / I_SQ; r %= I_SQ;
            const float* src = m == 0 ? p.in[13] : (m == 1 ? p.in[14] : p.in[15]);
            bf16* dst = (bf16*)(ws + (m == 0 ? OFF_WTBA : (m == 1 ? OFF_WTBD : OFF_WTOUT)));
            transpose_item(src, 1024, 1024, dst, (r / 32) * 64, (r % 32) * 32, (r % 32) * 32, scr, lane);
        }
    }
    {
        float* WR = (float*)(ws + OFF_SMALL + SM_WR);
        for (int i = bid * NT + tid; i < 1024 * 40; i += nblk * NT) {
            const int k = i / 40, c = i % 40; float v = 0.f;
            if (c < 4) v = p.in[17][k * 4 + c]; else if (c < 36) v = p.in[19][k * 32 + (c - 4)];
            WR[i] = v * p.in[16][k];
        }
    }
    float* wbd = (float*)smem;
    for (int i = tid; i < 1024 * 16; i += NT) { const int k = i >> 4, c = i & 15; wbd[i] = p.in[3][(size_t)k * W_IN_COLS + 7168 + c]; }
    __syncthreads();
    const float* nw = p.in[2];
    for (int R = gw; R < LTOK; R += NGW) {
        const float* xrow = R < NMETA ? p.in[1] + (size_t)R * D : p.in[0] + (size_t)(R - NMETA) * D;
        bf16* urow = R < NMETA ? (bf16*)(ws + OFF_SMALL + SM_UMETA) + (size_t)R * D : (bf16*)(ws + OFF_U) + (size_t)(R - NMETA) * D;
        float ss = 0.f;
#pragma unroll
        for (int j = 0; j < 4; ++j) { const float4 v = *(const float4*)(xrow + 4 * lane + 256 * j); ss += v.x * v.x + v.y * v.y + v.z * v.z + v.w * v.w; }
        ss = wave_sum(ss);
        const float rstd = rsqrtf(ss * (1.0f / D) + NORM_EPS);
        float acc[16];
#pragma unroll
        for (int c = 0; c < 16; ++c) acc[c] = 0.f;
#pragma unroll 1
        for (int j = 0; j < 4; ++j) {
            const float4 w4 = *(const float4*)(nw + 4 * lane + 256 * j);
            const float4 xv = *(const float4*)(xrow + 4 * lane + 256 * j);
            float uu[4] = {xv.x * rstd * w4.x, xv.y * rstd * w4.y, xv.z * rstd * w4.z, xv.w * rstd * w4.w};
            u32x2 o; o.x = pk2(uu[0], uu[1]); o.y = pk2(uu[2], uu[3]);
            *(u32x2*)(urow + 4 * lane + 256 * j) = o;
#pragma unroll
            for (int e = 0; e < 4; ++e) {
                const float* wr = wbd + (size_t)(4 * lane + 256 * j + e) * 16;
#pragma unroll
                for (int c = 0; c < 16; ++c) acc[c] += uu[e] * wr[c];
            }
        }
#pragma unroll
        for (int c = 0; c < 16; ++c) acc[c] = wave_sum(acc[c]);
        if (lane < 16) {
            float a = 0.f;
#pragma unroll
            for (int c = 0; c < 16; ++c) a = (lane == c) ? acc[c] : a;
            const size_t pos = 48 + R;
            if (lane < 8) { ((float*)(ws + OFF_SMALL + SM_BETA))[pos * 8 + lane] = sigmoidf_(a); }
            else { const int hh = lane - 8; const float z = a + p.in[11][hh]; const float sp = fmaxf(z, 0.f) + log1pf(__expf(-fabsf(z)));
                   ((float*)(ws + OFF_SMALL + SM_G))[pos * 8 + hh] = -__expf(p.in[10][hh]) * sp; }
        }
    }
}

namespace pg8 {
constexpr int BM = 256, BK = 64, HALF = 128, HTB = HALF * BK * 2, NXCD = 8, WGM = 8;
DI int lds_byte(int r, int c) { const int st = (r >> 4) * 2 + (c >> 5), rr = r & 15, cc = c & 31, ob = rr * 64 + cc * 2; return st * 1024 + (ob ^ (((ob >> 9) & 1) << 5)); }
DI void stage_rc(int b, int& R, int& C) { const int st = b / 1024, sb = b % 1024, swz = sb ^ (((sb >> 9) & 1) << 5); R = (st >> 1) * 16 + swz / 64; C = (st & 1) * 32 + (swz % 64) / 2; }
DI int perm32(int rho) { const int n = rho >> 4, i = rho & 15; return 8 * (i >> 2) + 4 * n + (i & 3); }
struct Unit { int pm, pn; };
struct Gemm { const bf16* A; const bf16* Bt; int M, N, K; };
struct StaticOrder {
    int nM, nN, nwg, G, c;
    DM void init(int M, int N, int G_, int c_) { nM = M / BM; nN = N / BM; nwg = nM * nN; G = G_; c = c_; }
    DM bool next(int i, Unit& u) const {
        const long L = (long)i * G + c; if (L >= nwg) return false;
        int wgid = (int)L; { const int q = nwg / NXCD, r = nwg % NXCD, xcd = wgid % NXCD, off = wgid / NXCD; wgid = (xcd < r ? xcd * (q + 1) : r * (q + 1) + (xcd - r) * q) + off; }
        const int nig = WGM * nN, gid = wgid / nig, fm = gid * WGM, gsz = (nM - fm) < WGM ? (nM - fm) : WGM;
        u.pm = fm + ((wgid % nig) % gsz); u.pn = (wgid % nig) / gsz; return true;
    }
};
#ifdef EMU
template <class Epi>
DI void gemm_phase(char* lds, const Gemm g, const StaticOrder& S, const Epi& E) {
    const int tid = threadIdx.x, wid = tid >> 6, lane = tid & 63, wr = wid >> 2, wc = wid & 3, fr = lane & 15, fq = lane >> 4;
    Unit u;
    for (int ui = 0; S.next(ui, u); ++ui) {
        f32x4 acc[2][2][4][2];
        for (int ai = 0; ai < 2; ++ai) for (int bj = 0; bj < 2; ++bj) for (int m = 0; m < 4; ++m) for (int n = 0; n < 2; ++n) for (int e = 0; e < 4; ++e) {
            const int r = 256 * u.pm + 128 * ai + 64 * wr + 16 * m + fr;
            const int c = 256 * u.pn + 128 * bj + 32 * wc + (Epi::PERM ? 8 * fq + 4 * n : 16 * n + 4 * fq) + e;
            const bf16* a = g.A + (size_t)r * g.K; const bf16* b = g.Bt + (size_t)c * g.K; float s = 0.f;
            for (int k = 0; k < g.K; ++k) s += bf2f(a[k]) * bf2f(b[k]);
            acc[ai][bj][m][n][e] = s;
        }
        E(acc, u, wr, wc, fr, fq);
    }
    __syncthreads();
}
#else
#define PG8_LAS __attribute__((address_space(3)))
template <class Epi>
__device__ __forceinline__ void gemm_phase(char* lds_, const Gemm g, const StaticOrder& S, const Epi& E) {
    PG8_LAS unsigned char* lds = (PG8_LAS unsigned char*)lds_;
    const int tid = threadIdx.x, wid = __builtin_amdgcn_readfirstlane(tid >> 6), lane = tid & 63, wr = wid >> 2, wc = wid & 3, fr = lane & 15, fq = lane >> 4;
    const int K = g.K, nt = K / BK;
    unsigned voffA[2], voffB[2];
#pragma unroll
    for (int i = 0; i < 2; ++i) { int R, C; stage_rc(tid * 16 + i * 8192, R, C); const int Rb = Epi::PERM ? ((R & ~31) + perm32(R & 31)) : R;
        voffA[i] = (unsigned)(R * K + C) * 2u; voffB[i] = (unsigned)(Rb * K + C) * 2u; }
    const size_t kstep = (size_t)(BK * 2);
    const size_t hstep = (size_t)HALF * K * 2;
    const size_t tstep = 2 * hstep;
    const unsigned ldsw = (unsigned)wid * 1024u;
    const int aoff = lds_byte(wr * 64 + fr, fq * 8), boff = lds_byte(wc * 32 + fr, fq * 8);
#define PG8_SA(b, h) (((b) * 2 + (h)) * HTB)
#define PG8_SB(b, h) ((4 + (b) * 2 + (h)) * HTB)
#define PG8_STAGE(bufoff, gbase, voff) do { _Pragma("unroll") for (int _i = 0; _i < 2; ++_i) \
        __builtin_amdgcn_global_load_lds((const unsigned*)((const char*)(gbase) + (voff)[_i]), (PG8_LAS unsigned*)(lds + (bufoff) + ldsw + _i * 8192), 16, 0, 0); } while (0)
#define PG8_LDA(dst, b, h) do { _Pragma("unroll") for (int m = 0; m < 4; ++m) _Pragma("unroll") for (int k = 0; k < 2; ++k) dst[m][k] = *(const PG8_LAS bf16x8*)(lds + PG8_SA(b, h) + aoff + m * 2048 + k * 1024); } while (0)
#define PG8_LDB(dst, b, h) do { _Pragma("unroll") for (int n = 0; n < 2; ++n) _Pragma("unroll") for (int k = 0; k < 2; ++k) dst[n][k] = *(const PG8_LAS bf16x8*)(lds + PG8_SB(b, h) + boff + n * 2048 + k * 1024); } while (0)
#define PG8_MMA(ai, bj, At, Bt) do { __builtin_amdgcn_s_setprio(1); _Pragma("unroll") for (int m = 0; m < 4; ++m) _Pragma("unroll") for (int n = 0; n < 2; ++n) _Pragma("unroll") for (int k = 0; k < 2; ++k) \
        acc[ai][bj][m][n] = __builtin_amdgcn_mfma_f32_16x16x32_bf16(Bt[n][k], At[m][k], acc[ai][bj][m][n], 0, 0, 0); __builtin_amdgcn_s_setprio(0); } while (0)
#define PG8_WAIT_V(n) asm volatile("s_waitcnt vmcnt(" #n ")" ::: "memory")
#define PG8_WAIT_L(n) asm volatile("s_waitcnt lgkmcnt(" #n ")" ::: "memory")
#define PG8_BAR __builtin_amdgcn_s_barrier()
#define PG8_SCHED __builtin_amdgcn_sched_barrier(0)
    Unit cur, nxt; int ui = 0;
    if (S.next(0, cur)) {
    f32x4 acc[2][2][4][2];
#pragma unroll
    for (int a = 0; a < 2; ++a)
#pragma unroll
        for (int b = 0; b < 2; ++b)
#pragma unroll
            for (int m = 0; m < 4; ++m)
#pragma unroll
                for (int n = 0; n < 2; ++n) acc[a][b][m][n] = (f32x4){0.f, 0.f, 0.f, 0.f};
    bf16x8 At[4][2], B0[2][2], B1[2][2];
    const char* cA = (const char*)g.A + (size_t)cur.pm * tstep; const char* cB = (const char*)g.Bt + (size_t)cur.pn * tstep;
    PG8_STAGE(PG8_SB(0, 0), cB, voffB); PG8_STAGE(PG8_SA(0, 0), cA, voffA); PG8_STAGE(PG8_SB(0, 1), cB + hstep, voffB); PG8_STAGE(PG8_SA(0, 1), cA + hstep, voffA);
    if (wr == 1) PG8_BAR;
    PG8_WAIT_V(4); PG8_BAR;
    PG8_STAGE(PG8_SB(1, 0), cB + kstep, voffB); PG8_STAGE(PG8_SA(1, 0), cA + kstep, voffA); PG8_STAGE(PG8_SB(1, 1), cB + hstep + kstep, voffB);
    PG8_WAIT_V(6); PG8_BAR;
    for (;;) {
        const bool has_next = S.next(ui + 1, nxt);
        const char* nA = has_next ? (const char*)g.A + (size_t)nxt.pm * tstep : cA; const char* nB = has_next ? (const char*)g.Bt + (size_t)nxt.pn * tstep : cB;
        for (int t = 0; t < nt; t += 2) {
            const bool last = (t == nt - 2);
            const char* a1 = cA + (size_t)(t + 1) * kstep;
            const char* a2 = last ? nA : cA + (size_t)(t + 2) * kstep; const char* b2 = last ? nB : cB + (size_t)(t + 2) * kstep;
            const char* a3 = a2 + kstep; const char* b3 = b2 + kstep;
            PG8_LDB(B0, 0, 0); PG8_SCHED; PG8_LDA(At, 0, 0); PG8_STAGE(PG8_SA(1, 1), a1 + hstep, voffA);
            PG8_WAIT_L(8); PG8_BAR; PG8_WAIT_L(0); PG8_MMA(0, 0, At, B0); PG8_BAR; PG8_SCHED;
            PG8_LDB(B1, 0, 1); PG8_STAGE(PG8_SB(0, 0), b2, voffB);
            PG8_BAR; PG8_WAIT_L(0); PG8_MMA(0, 1, At, B1); PG8_BAR;
            PG8_LDA(At, 0, 1); PG8_STAGE(PG8_SA(0, 0), a2, voffA);
            PG8_BAR; PG8_WAIT_L(0); PG8_MMA(1, 0, At, B0); PG8_BAR; PG8_SCHED;
            PG8_STAGE(PG8_SB(0, 1), b2 + hstep, voffB);
            PG8_WAIT_V(6); PG8_BAR; PG8_MMA(1, 1, At, B1); PG8_BAR;
            PG8_LDB(B0, 1, 0); PG8_SCHED; PG8_LDA(At, 1, 0); PG8_STAGE(PG8_SA(0, 1), a2 + hstep, voffA);
            PG8_WAIT_L(8); PG8_BAR; PG8_WAIT_L(0); PG8_MMA(0, 0, At, B0); PG8_BAR; PG8_SCHED;
            PG8_LDB(B1, 1, 1); PG8_STAGE(PG8_SB(1, 0), b3, voffB);
            PG8_BAR; PG8_WAIT_L(0); PG8_MMA(0, 1, At, B1); PG8_BAR;
            PG8_LDA(At, 1, 1); PG8_STAGE(PG8_SA(1, 0), a3, voffA);
            PG8_BAR; PG8_WAIT_L(0); PG8_MMA(1, 0, At, B0); PG8_BAR; PG8_SCHED;
            PG8_STAGE(PG8_SB(1, 1), b3 + hstep, voffB);
            PG8_WAIT_V(6); PG8_BAR; PG8_MMA(1, 1, At, B1); PG8_BAR;
        }
        E(acc, cur, wr, wc, fr, fq);
        if (!has_next) break;
#pragma unroll
        for (int a = 0; a < 2; ++a)
#pragma unroll
            for (int b = 0; b < 2; ++b)
#pragma unroll
                for (int m = 0; m < 4; ++m)
#pragma unroll
                    for (int n = 0; n < 2; ++n) acc[a][b][m][n] = (f32x4){0.f, 0.f, 0.f, 0.f};
        cur = nxt; cA = nA; cB = nB; ++ui;
    }
    PG8_WAIT_V(0);
    if (wr == 0) PG8_BAR;
    PG8_BAR;
    }
    __syncthreads();
#undef PG8_SA
#undef PG8_SB
#undef PG8_STAGE
#undef PG8_LDA
#undef PG8_LDB
#undef PG8_MMA
#undef PG8_WAIT_V
#undef PG8_WAIT_L
#undef PG8_BAR
#undef PG8_SCHED
}
#endif
}

constexpr int G_BM = 256, G_BN = 128, G_BK = 64;
constexpr int G_LDS_A = G_BM * G_BK * 2, G_LDS_B = G_BN * G_BK * 2;
constexpr int G_STAGE_PITCH = 132;
constexpr int G_LDS_BYTES = G_BM * G_STAGE_PITCH * 4;
constexpr int G_MT = SEQ / 256 + 1, G_NTILES = 56;

DI void gemm_inproj_tile(const Params& p, char* smem, int mt, int nt) {
    const int tid = fresh_tid(), lane = tid & 63, wave = tid >> 6;
    const int wm = wave >> 1, wn = wave & 1, r32 = lane & 31, h = lane >> 5;
    unsigned char* ws = p.ws;
    const bool meta = (mt == G_MT - 1);
    const bf16* A = meta ? (const bf16*)(ws + OFF_SMALL + SM_UMETA) : (const bf16*)(ws + OFF_U) + (size_t)mt * 256 * D;
    const int vrows = meta ? NMETA : 256;
    const bf16* Bt = (const bf16*)(ws + OFF_WTIN) + (size_t)nt * 128 * D;
    char* ldsA[2] = {smem, smem + G_LDS_A + G_LDS_B};
    char* ldsB[2] = {smem + G_LDS_A, smem + 2 * G_LDS_A + G_LDS_B};
    f32x16 acc[2][2];
#pragma unroll
    for (int i = 0; i < 2; ++i)
#pragma unroll
        for (int j = 0; j < 2; ++j) acc[i][j] = zero16();
    const int lrow = tid >> 3, lc = tid & 7;
    u32x4 ra[4], rb[2];
    auto gload = [&](int kt) {
#pragma unroll
        for (int i = 0; i < 4; ++i) { const int row = lrow + 64 * i; ra[i] = row < vrows ? *(const u32x4*)(A + (size_t)row * D + kt * 64 + lc * 8) : (u32x4){0u, 0u, 0u, 0u}; }
#pragma unroll
        for (int i = 0; i < 2; ++i) { const int row = lrow + 64 * i; rb[i] = *(const u32x4*)(Bt + (size_t)row * D + kt * 64 + lc * 8); }
    };
    auto lstore = [&](int buf) {
#pragma unroll
        for (int i = 0; i < 4; ++i) *(u32x4*)(ldsA[buf] + swz128(lrow + 64 * i, lc)) = ra[i];
#pragma unroll
        for (int i = 0; i < 2; ++i) *(u32x4*)(ldsB[buf] + swz128(lrow + 64 * i, lc)) = rb[i];
    };
    gload(0); lstore(0); __syncthreads();
    for (int kt = 0; kt < 16; ++kt) {
        const int buf = kt & 1;
        if (kt + 1 < 16) gload(kt + 1);
#pragma unroll
        for (int ks = 0; ks < 4; ++ks) {
            bf16x8 af[2], bfr[2];
#pragma unroll
            for (int i = 0; i < 2; ++i) af[i] = *(const bf16x8*)(ldsA[buf] + swz128(64 * wm + 32 * i + r32, 2 * ks + h));
#pragma unroll
            for (int j = 0; j < 2; ++j) bfr[j] = *(const bf16x8*)(ldsB[buf] + swz128(64 * wn + 32 * j + r32, 2 * ks + h));
#pragma unroll
            for (int i = 0; i < 2; ++i)
#pragma unroll
                for (int j = 0; j < 2; ++j) acc[i][j] = MFMA32(af[i], bfr[j], acc[i][j]);
        }
        if (kt + 1 < 16) lstore(buf ^ 1);
        __syncthreads();
    }
    float* st = (float*)smem;
#pragma unroll
    for (int i = 0; i < 2; ++i)
#pragma unroll
        for (int j = 0; j < 2; ++j)
#pragma unroll
            for (int r = 0; r < 16; ++r) {
                const int row = 64 * wm + 32 * i + (r & 3) + 8 * (r >> 2) + 4 * h, col = 64 * wn + 32 * j + r32;
                st[row * G_STAGE_PITCH + col] = acc[i][j][r];
            }
    __syncthreads();
    const int tid2 = fresh_tid();
    const int sec = nt >> 3, cb = (nt & 7) * 128;
    {
        bf16* base; bool has_meta = true; bf16* mbase = nullptr; int mrow0 = 0;
        if (sec == 0) { base = (bf16*)(ws + OFF_AQ); has_meta = false; }
        else if (sec == 1) { base = (bf16*)p.out; mbase = (bf16*)(ws + OFF_SMALL + SM_AKMETA); }
        else if (sec == 2) { base = (bf16*)p.out + (size_t)SEQ * D; mbase = (bf16*)(ws + OFF_SMALL + SM_AVTMETA); }
        else if (sec == 3) { base = (bf16*)(ws + OFF_QN); mbase = (bf16*)(ws + OFF_SMALL + SM_C0Q); mrow0 = 48; }
        else if (sec == 4) { base = (bf16*)(ws + OFF_KN); mbase = (bf16*)(ws + OFF_SMALL + SM_C0K); mrow0 = 48; }
        else if (sec == 5) { base = (bf16*)(ws + OFF_V); mbase = (bf16*)(ws + OFF_SMALL + SM_C0V); mrow0 = 48; }
        else { base = (bf16*)(ws + OFF_DG); has_meta = false; }
        const bool dqkv = (sec >= 3 && sec <= 5);
        bf16* tails = (bf16*)(ws + OFF_SMALL + SM_TAILS);
        if (!meta || has_meta) {
#pragma unroll
            for (int i = 0; i < 8; ++i) {
                const int idx = tid2 + NT * i, row = idx >> 4, cg = idx & 15;
                if (row < vrows) {
                    const float* s = st + row * G_STAGE_PITCH + cg * 8;
                    const f32x4 a = *(const f32x4*)s, b = *(const f32x4*)(s + 4);
                    u32x4 o; o.x = pk2(a[0], a[1]); o.y = pk2(a[2], a[3]); o.z = pk2(b[0], b[1]); o.w = pk2(b[2], b[3]);
                    if (!meta) {
                        const int j = mt * 256 + row;
                        *(u32x4*)(base + (size_t)j * D + cb + cg * 8) = o;
                        if (dqkv && (j & 63) >= 61) *(u32x4*)(tails + ((size_t)(j / 64 + 1) * 3 + ((j & 63) - 61)) * 3072 + (sec - 3) * 1024 + cb + cg * 8) = o;
                    } else {
                        *(u32x4*)(mbase + (size_t)(mrow0 + row) * D + cb + cg * 8) = o;
                        if (dqkv && row >= 13) *(u32x4*)(tails + ((size_t)0 * 3 + (row - 13)) * 3072 + (sec - 3) * 1024 + cb + cg * 8) = o;
                    }
                }
            }
        }
    }
    __syncthreads();
}

struct EpiInproj {
    static constexpr bool PERM = true;
    unsigned char* ws; bf16* out16;
    DM void operator()(const f32x4 (&acc)[2][2][4][2], const pg8::Unit& u, int wr, int wc, int fr, int fq) const {
        const int colt = u.pn * 256, sec = colt >> 10, cb = colt & 1023;
        bf16* base = sec == 0 ? (bf16*)(ws + OFF_AQ) : sec == 1 ? out16 : sec == 2 ? out16 + (size_t)SEQ * D : sec == 3 ? (bf16*)(ws + OFF_QN) : sec == 4 ? (bf16*)(ws + OFF_KN)
                   : sec == 5 ? (bf16*)(ws + OFF_V) : (bf16*)(ws + OFF_DG);
        const bool dqkv = sec >= 3 && sec <= 5;
        bf16* tails = (bf16*)(ws + OFF_SMALL + SM_TAILS) + (sec - 3) * 1024;
        const int row0 = u.pm * 256 + wr * 64 + fr, col0 = cb + wc * 32 + 8 * fq;
#pragma unroll
        for (int ai = 0; ai < 2; ++ai)
#pragma unroll
            for (int m = 0; m < 4; ++m) {
                const int j = row0 + ai * 128 + m * 16;
                bf16* rowp = base + (size_t)j * D + col0;
                const bool tl = dqkv && (j & 63) >= 61;
#pragma unroll
                for (int bj = 0; bj < 2; ++bj) {
                    const f32x4 v0 = acc[ai][bj][m][0], v1 = acc[ai][bj][m][1];
                    const u32x4 w = {pk2(v0[0], v0[1]), pk2(v0[2], v0[3]), pk2(v1[0], v1[1]), pk2(v1[2], v1[3])};
                    *(u32x4*)(rowp + bj * 128) = w;
                    if (tl) *(u32x4*)(tails + ((size_t)(j / 64 + 1) * 3 + ((j & 63) - 61)) * 3072 + col0 + bj * 128) = w;
                }
            }
    }
};
DI void phase1(const Params& p, char* smem, int bid, int nblk) {
    for (int it = bid; it < 40; it += nblk) gemm_inproj_tile(p, smem, G_MT - 1, 8 + it);
    pg8::Gemm g{(const bf16*)(p.ws + OFF_U), (const bf16*)(p.ws + OFF_WTIN), SEQ, 7168, 1024};
    pg8::StaticOrder S; S.init(SEQ, 7168, nblk, bid);
    EpiInproj E{p.ws, (bf16*)p.out};
    pg8::gemm_phase(smem, g, S, E);
}

constexpr int P2_KN = 0, P2_KB = 16384, P2_QN = 32768, P2_KBGT = 49152, P2_VBT = 65536, P2_KDT = 81920, P2_ALDS = 98304, P2_TLDS = P2_ALDS + 64 * 68 * 4,
              P2_GC = P2_TLDS + 8192, P2_BET = P2_GC + 256, P2_EG = P2_BET + 256, P2_EKD = P2_EG + 256;

DI void prep_item(const Params& p, char* smem, int chunk, int head, int dry) {
    const int tid = fresh_tid(), lane = tid & 63, wave = tid >> 6, r32 = lane & 31, h = lane >> 5;
    unsigned char* ws = p.ws;
    float* gcl = (float*)(smem + P2_GC); float* betl = (float*)(smem + P2_BET); float* egl = (float*)(smem + P2_EG); float* ekdl = (float*)(smem + P2_EKD);
    if (wave == 0) {
        const size_t pos = (size_t)chunk * 64 + lane;
        float v = ((const float*)(ws + OFF_SMALL + SM_G))[pos * 8 + head];
        const float b = ((const float*)(ws + OFF_SMALL + SM_BETA))[pos * 8 + head];
#pragma unroll
        for (int o = 1; o < 64; o <<= 1) { const float t = __shfl_up(v, o); if (lane >= o) v += t; }
        const float gl = __shfl(v, 63);
        gcl[lane] = v; betl[lane] = b; egl[lane] = __expf(v); ekdl[lane] = __expf(gl - v);
        if (!dry) ((float*)(ws + OFF_SMALL + SM_GC))[((size_t)chunk * 8 + head) * 64 + lane] = v;
    }
    __syncthreads();
    {
        const int r = tid >> 3, cg = tid & 7, col0 = head * 128 + 16 * cg;
        const bool zero_row = (chunk == 0 && r < 48);
        const float beta = betl[r], eg = egl[r], ekd = ekdl[r];
        const bf16* tails = (const bf16*)(ws + OFF_SMALL + SM_TAILS);
#pragma unroll 1
        for (int mat = 0; mat < 3; ++mat) {
            bf16* mainb = (bf16*)(ws + (mat == 0 ? OFF_QN : (mat == 1 ? OFF_KN : OFF_V)));
            bf16* c0b = (bf16*)(ws + OFF_SMALL + (mat == 0 ? SM_C0Q : (mat == 1 ? SM_C0K : SM_C0V)));
            float y[16];
#pragma unroll
            for (int c = 0; c < 16; ++c) y[c] = 0.f;
#pragma unroll
            for (int jj = 0; jj < 4; ++jj) {
                const int rr = r - 3 + jj;
                const bf16* src = nullptr;
                if (chunk == 0) { if (rr >= 48) src = c0b + (size_t)rr * D + col0; }
                else if (rr >= 0) src = mainb + ((size_t)(chunk - 1) * 64 + rr) * D + col0;
                else src = tails + ((size_t)(chunk - 1) * 3 + (3 + rr)) * 3072 + mat * 1024 + col0;
                u32x4 a = {0u, 0u, 0u, 0u}, b = {0u, 0u, 0u, 0u};
                if (src) { a = *(const u32x4*)src; b = *(const u32x4*)(src + 8); }
                const float* cw = p.in[9] + (size_t)jj * 3072 + mat * 1024 + col0;
                const f32x4 w0 = *(const f32x4*)cw, w1 = *(const f32x4*)(cw + 4), w2 = *(const f32x4*)(cw + 8), w3 = *(const f32x4*)(cw + 12);
                y[0] += w0[0] * bflo(a.x); y[1] += w0[1] * bfhi(a.x); y[2] += w0[2] * bflo(a.y); y[3] += w0[3] * bfhi(a.y);
                y[4] += w1[0] * bflo(a.z); y[5] += w1[1] * bfhi(a.z); y[6] += w1[2] * bflo(a.w); y[7] += w1[3] * bfhi(a.w);
                y[8] += w2[0] * bflo(b.x); y[9] += w2[1] * bfhi(b.x); y[10] += w2[2] * bflo(b.y); y[11] += w2[3] * bfhi(b.y);
                y[12] += w3[0] * bflo(b.z); y[13] += w3[1] * bfhi(b.z); y[14] += w3[2] * bflo(b.w); y[15] += w3[3] * bfhi(b.w);
            }
            __syncthreads();
            float ss = 0.f;
#pragma unroll
            for (int c = 0; c < 16; ++c) { y[c] = zero_row ? 0.f : siluf_(y[c]); ss += y[c] * y[c]; }
            if (mat < 2) {
                ss += __shfl_xor(ss, 1); ss += __shfl_xor(ss, 2); ss += __shfl_xor(ss, 4);
                const float sc = rsqrtf(ss + 1e-6f) * (mat == 0 ? 0.08838834764831845f : 1.0f);
                unsigned pk[8];
#pragma unroll
                for (int c = 0; c < 8; ++c) pk[c] = pk2(y[2 * c] * sc, y[2 * c + 1] * sc);
                if (mat == 0) {
                    *(u32x4*)(smem + P2_QN + swzrow(r, 256, 2 * cg)) = (u32x4){pk[0], pk[1], pk[2], pk[3]};
                    *(u32x4*)(smem + P2_QN + swzrow(r, 256, 2 * cg + 1)) = (u32x4){pk[4], pk[5], pk[6], pk[7]};
                    unsigned qd[8];
#pragma unroll
                    for (int c = 0; c < 8; ++c) qd[c] = pk2(bflo(pk[c]) * eg, bfhi(pk[c]) * eg);
                    bf16* dst = (chunk == 0) ? c0b + (size_t)r * D + col0 : mainb + ((size_t)(chunk - 1) * 64 + r) * D + col0;
                    if (!dry) { *(u32x4*)dst = (u32x4){qd[0], qd[1], qd[2], qd[3]}; *(u32x4*)(dst + 8) = (u32x4){qd[4], qd[5], qd[6], qd[7]}; }
                } else {
                    *(u32x4*)(smem + P2_KN + swzrow(r, 256, 2 * cg)) = (u32x4){pk[0], pk[1], pk[2], pk[3]};
                    *(u32x4*)(smem + P2_KN + swzrow(r, 256, 2 * cg + 1)) = (u32x4){pk[4], pk[5], pk[6], pk[7]};
                    unsigned kb[8];
#pragma unroll
                    for (int c = 0; c < 8; ++c) {
                        const float kr0 = bflo(pk[c]), kr1 = bfhi(pk[c]);
                        const float k0 = kr0 * beta, k1 = kr1 * beta;
                        kb[c] = pk2(k0, k1);
                        const int d0 = 16 * cg + 2 * c;
                        *(bf16*)(smem + P2_KBGT + swz128(d0, r >> 3) + (r & 7) * 2) = (bf16)f2bf(k0 * eg);
                        *(bf16*)(smem + P2_KBGT + swz128(d0 + 1, r >> 3) + (r & 7) * 2) = (bf16)f2bf(k1 * eg);
                        *(bf16*)(smem + P2_KDT + swz128(d0, r >> 3) + (r & 7) * 2) = (bf16)f2bf(kr0 * ekd);
                        *(bf16*)(smem + P2_KDT + swz128(d0 + 1, r >> 3) + (r & 7) * 2) = (bf16)f2bf(kr1 * ekd);
                    }
                    *(u32x4*)(smem + P2_KB + swzrow(r, 256, 2 * cg)) = (u32x4){kb[0], kb[1], kb[2], kb[3]};
                    *(u32x4*)(smem + P2_KB + swzrow(r, 256, 2 * cg + 1)) = (u32x4){kb[4], kb[5], kb[6], kb[7]};
                }
            } else {
#pragma unroll
                for (int c = 0; c < 16; ++c) {
                    const int e = 16 * cg + c;
                    *(bf16*)(smem + P2_VBT + swz128(e, r >> 3) + (r & 7) * 2) = (bf16)f2bf(y[c] * beta);
                }
            }
        }
    }
    __syncthreads();
    {
        const int tile = wave & 3, m0 = tile >> 1, n0 = tile & 1;
        f32x16 acc = zero16();
        if (wave < 4) {
            if (n0 <= m0) {
#pragma unroll
                for (int ks = 0; ks < 8; ++ks) {
                    const bf16x8 a = *(const bf16x8*)(smem + P2_KB + swzrow(32 * m0 + r32, 256, 2 * ks + h));
                    const bf16x8 b = *(const bf16x8*)(smem + P2_KN + swzrow(32 * n0 + r32, 256, 2 * ks + h));
                    acc = MFMA32(a, b, acc);
                }
            }
            float* Al = (float*)(smem + P2_ALDS);
            const int j = 32 * n0 + r32; const float gj = gcl[j];
#pragma unroll
            for (int r = 0; r < 16; ++r) {
                const int i = 32 * m0 + (r & 3) + 8 * (r >> 2) + 4 * h;
                const float dv = acc[r] * __expf(gcl[i] - gj);
                Al[i * 68 + j] = (j < i) ? dv : 0.f;
            }
        } else {
            if (m0 <= n0) {
#pragma unroll
                for (int ks = 0; ks < 8; ++ks) {
                    const bf16x8 a = *(const bf16x8*)(smem + P2_KN + swzrow(32 * m0 + r32, 256, 2 * ks + h));
                    const bf16x8 b = *(const bf16x8*)(smem + P2_QN + swzrow(32 * n0 + r32, 256, 2 * ks + h));
                    acc = MFMA32(a, b, acc);
                }
            }
            const int i = 32 * n0 + r32; const float gi = gcl[i];
            bf16* qkb = (chunk == 0) ? (bf16*)(ws + OFF_SMALL + SM_C0QK) + (size_t)head * 4096 : (bf16*)(ws + OFF_QKB) + ((size_t)(chunk - 1) * 8 + head) * 4096;
#pragma unroll
            for (int q4 = 0; q4 < 4; ++q4) {
                const int j0 = 32 * m0 + 8 * q4 + 4 * h; float v[4];
#pragma unroll
                for (int c = 0; c < 4; ++c) { const int j = j0 + c; const float dv = acc[4 * q4 + c] * __expf(gi - gcl[j]); v[c] = (j <= i) ? dv : 0.f; }
                if (!dry) *(u32x2*)(qkb + i * 64 + j0) = (u32x2){pk2(v[0], v[1]), pk2(v[2], v[3])};
            }
        }
        bf16* kbase = (chunk == 0) ? (bf16*)(ws + OFF_SMALL + SM_C0K) : (bf16*)(ws + OFF_KN) + (size_t)(chunk - 1) * 64 * D;
#pragma unroll
        for (int i2 = 0; i2 < 2; ++i2) {
            const int idx = tid + NT * i2, dk = idx >> 3, ch = idx & 7;
            const u32x4 v = *(const u32x4*)(smem + P2_KDT + swz128(dk, ch));
            if (!dry) *(u32x4*)(kbase + (size_t)(dk >> 1) * D + head * 128 + (dk & 1) * 64 + ch * 8) = v;
        }
    }
    __syncthreads();
    if (wave == 0) {
        const float* Al = (const float*)(smem + P2_ALDS);
        float t[64];
#pragma unroll
        for (int i = 0; i < 64; ++i) {
            float s0 = (i == lane) ? 1.f : 0.f, s1 = 0.f, s2 = 0.f, s3 = 0.f;
#pragma unroll
            for (int j = 0; j < i; ++j) { const float pr = Al[i * 68 + j] * t[j]; if ((j & 3) == 0) s0 -= pr; else if ((j & 3) == 1) s1 -= pr; else if ((j & 3) == 2) s2 -= pr; else s3 -= pr; }
            t[i] = (s0 + s1) + (s2 + s3);
#ifndef EMU
            if ((i & 3) == 3) asm volatile("" ::: "memory");
#endif
        }
#pragma unroll
        for (int i = 0; i < 64; ++i) *(bf16*)(smem + P2_TLDS + swz128(i, lane >> 3) + (lane & 7) * 2) = (bf16)f2bf(t[i]);
    }
    __syncthreads();
    {
        const int mi = wave >> 2, ni = wave & 3;
        f32x16 acc = zero16();
#pragma unroll
        for (int ks = 0; ks < 4; ++ks) {
            const bf16x8 a = *(const bf16x8*)(smem + P2_TLDS + swz128(32 * mi + r32, 2 * ks + h));
            const bf16x8 b = *(const bf16x8*)(smem + P2_VBT + swz128(32 * ni + r32, 2 * ks + h));
            acc = MFMA32(a, b, acc);
        }
        const int e = 32 * ni + r32;
        bf16* base = (chunk == 0) ? (bf16*)(ws + OFF_SMALL + SM_C0V) : (bf16*)(ws + OFF_V) + (size_t)(chunk - 1) * 64 * D;
        bf16* dst = base + (size_t)(e >> 1) * D + head * 128 + (e & 1) * 64;
#pragma unroll
        for (int q4 = 0; q4 < 4; ++q4) {
            const int c0 = 32 * mi + 8 * q4 + 4 * h;
            if (!dry) *(u32x2*)(dst + c0) = (u32x2){pk2(acc[4 * q4], acc[4 * q4 + 1]), pk2(acc[4 * q4 + 2], acc[4 * q4 + 3])};
        }
    }
    {
        const int mi = wave >> 1, ni = wave & 1;
        f32x16 acc = zero16();
#pragma unroll
        for (int ks = 0; ks < 4; ++ks) {
            const bf16x8 a = *(const bf16x8*)(smem + P2_KBGT + swz128(32 * mi + r32, 2 * ks + h));
            const bf16x8 b = *(const bf16x8*)(smem + P2_TLDS + swz128(32 * ni + r32, 2 * ks + h));
            acc = MFMA32(a, b, acc);
        }
        const int c = 32 * ni + r32;
        bf16* wb = (chunk == 0) ? (bf16*)(ws + OFF_SMALL + SM_C0W) + (size_t)head * 8192 : (bf16*)(ws + OFF_W) + ((size_t)(chunk - 1) * 8 + head) * 8192;
#pragma unroll
        for (int q4 = 0; q4 < 4; ++q4) {
            const int dk0 = 32 * mi + 8 * q4 + 4 * h;
            if (!dry) *(u32x2*)(wb + c * 128 + dk0) = (u32x2){pk2(acc[4 * q4], acc[4 * q4 + 1]), pk2(acc[4 * q4 + 2], acc[4 * q4 + 3])};
        }
    }
    __syncthreads();
}

DI void phase2(const Params& p, char* smem, int bid, int nblk, int dry = 0) {
    for (int it = bid; it < NCH * 8; it += nblk) prep_item(p, smem, it >> 3, it & 7, dry);
    {
        const int tid = fresh_tid(), lane = tid & 63, wave = tid >> 6;
        const int gw = bid * 8 + wave, NGW = nblk * 8;
        float mq = 0.f, mk = 0.f;
        for (int j = gw; j < SEQ + NMETA; j += NGW) {
            const bf16* kr = j < SEQ ? (const bf16*)p.out + (size_t)j * D + lane * 16 : (const bf16*)(p.ws + OFF_SMALL + SM_AKMETA) + (size_t)(j - SEQ) * D + lane * 16;
            const u32x4 a = *(const u32x4*)kr, b = *(const u32x4*)(kr + 8);
            float s = bflo(a.x) * bflo(a.x) + bfhi(a.x) * bfhi(a.x) + bflo(a.y) * bflo(a.y) + bfhi(a.y) * bfhi(a.y) + bflo(a.z) * bflo(a.z) + bfhi(a.z) * bfhi(a.z) + bflo(a.w) * bflo(a.w) + bfhi(a.w) * bfhi(a.w)
                    + bflo(b.x) * bflo(b.x) + bfhi(b.x) * bfhi(b.x) + bflo(b.y) * bflo(b.y) + bfhi(b.y) * bfhi(b.y) + bflo(b.z) * bflo(b.z) + bfhi(b.z) * bfhi(b.z) + bflo(b.w) * bflo(b.w) + bfhi(b.w) * bfhi(b.w);
            s += __shfl_xor(s, 1); s += __shfl_xor(s, 2);
            mk = fmaxf(mk, s);
            if (j < SEQ) {
                const bf16* qr = (const bf16*)(p.ws + OFF_AQ) + (size_t)j * D + lane * 16;
                const u32x4 c = *(const u32x4*)qr, d = *(const u32x4*)(qr + 8);
                float t = bflo(c.x) * bflo(c.x) + bfhi(c.x) * bfhi(c.x) + bflo(c.y) * bflo(c.y) + bfhi(c.y) * bfhi(c.y) + bflo(c.z) * bflo(c.z) + bfhi(c.z) * bfhi(c.z) + bflo(c.w) * bflo(c.w) + bfhi(c.w) * bfhi(c.w)
                        + bflo(d.x) * bflo(d.x) + bfhi(d.x) * bfhi(d.x) + bflo(d.y) * bflo(d.y) + bfhi(d.y) * bfhi(d.y) + bflo(d.z) * bflo(d.z) + bfhi(d.z) * bfhi(d.z) + bflo(d.w) * bflo(d.w) + bfhi(d.w) * bfhi(d.w);
                t += __shfl_xor(t, 1); t += __shfl_xor(t, 2);
                mq = fmaxf(mq, t);
            }
        }
        if ((lane & 3) == 0) {
            unsigned* nrm = (unsigned*)(p.ws + OFF_SMALL + SM_CTL) + CW_NRM;
            atomicMax(nrm + (lane >> 2), __builtin_bit_cast(unsigned, mq));
            atomicMax(nrm + 16 + (lane >> 2), __builtin_bit_cast(unsigned, mk));
        }
    }
}

DI int swzrow8(int row, int pitch, int s) { return row * pitch + ((((s >> 1) ^ (row & 15)) << 4) | ((s & 1) << 3)); }
DI bf16x8 pack8(f32x4 a, f32x4 b) {
    u32x4 o; o.x = pk2(a[0], a[1]); o.y = pk2(a[2], a[3]); o.z = pk2(b[0], b[1]); o.w = pk2(b[2], b[3]);
    return __builtin_bit_cast(bf16x8, o);
}
DI bf16x8 ld2x8(const char* p0, const char* p1) {
    const u32x2 a = *(const u32x2*)p0, b = *(const u32x2*)p1; u32x4 o; o.x = a.x; o.y = a.y; o.z = b.x; o.w = b.y;
    return __builtin_bit_cast(bf16x8, o);
}
constexpr int SC_W = 0, SC_QD = 16384, SC_KDT = 32768, SC_QK = 49152, SC_BUF = 57344;

DI void scan_head(const Params& p, char* smem, int head, int dry) {
    const int tid = fresh_tid(), lane = tid & 63, wave = tid >> 6, r16 = lane & 15, g = lane >> 4;
    unsigned char* ws = p.ws;
    const int lrow = tid >> 3, lch = (tid & 7) * 2;
    f32x4 S[8];
#pragma unroll
    for (int i = 0; i < 8; ++i) S[i] = zero4();
    u32x4 rw[2], rq[2], rk[2], rqk; u32x2 unext[4], ucur[4]; float gnext = 0.f, gcur = 0.f;
    auto uaddr = [&](int n, int mt) -> bf16* {
        const int e = 16 * wave + r16;
        bf16* base = n == 0 ? (bf16*)(ws + OFF_SMALL + SM_C0V) : (bf16*)(ws + OFF_V) + (size_t)(n - 1) * 64 * D;
        return base + (size_t)(e >> 1) * D + head * 128 + (e & 1) * 64 + 16 * mt + 4 * g;
    };
    auto gloadA = [&](int n) {
        const bf16* wsrc = (n == 0 ? (const bf16*)(ws + OFF_SMALL + SM_C0W) + (size_t)head * 8192 : (const bf16*)(ws + OFF_W) + ((size_t)(n - 1) * 8 + head) * 8192) + lrow * 128 + lch * 8;
        rw[0] = *(const u32x4*)wsrc; rw[1] = *(const u32x4*)(wsrc + 8);
        const bf16* qs = (n == 0 ? (const bf16*)(ws + OFF_SMALL + SM_C0Q) : (const bf16*)(ws + OFF_QN) + (size_t)(n - 1) * 64 * D) + (size_t)lrow * D + head * 128 + lch * 8;
        rq[0] = *(const u32x4*)qs; rq[1] = *(const u32x4*)(qs + 8);
        const bf16* ks = (n == 0 ? (const bf16*)(ws + OFF_SMALL + SM_C0K) : (const bf16*)(ws + OFF_KN) + (size_t)(n - 1) * 64 * D) + (size_t)lrow * D + head * 128 + lch * 8;
        rk[0] = *(const u32x4*)ks; rk[1] = *(const u32x4*)(ks + 8);
        const bf16* qk = (n == 0 ? (const bf16*)(ws + OFF_SMALL + SM_C0QK) + (size_t)head * 4096 : (const bf16*)(ws + OFF_QKB) + ((size_t)(n - 1) * 8 + head) * 4096) + tid * 8;
        rqk = *(const u32x4*)qk;
    };
    auto gloadU = [&](int n) {
#pragma unroll
        for (int mt = 0; mt < 4; ++mt) unext[mt] = *(const u32x2*)uaddr(n, mt);
        gnext = ((const float*)(ws + OFF_SMALL + SM_GC))[((size_t)n * 8 + head) * 64 + 63];
    };
    auto lwrite = [&](int buf) {
        char* b = smem + buf * SC_BUF;
        const int c7 = tid & 7, kb = c7 >> 1, hf = c7 & 1;
        {
            char* w = b + SC_W + lrow * 256 + hf * 8; char* q = b + SC_QD + lrow * 256 + hf * 8; const int x = lrow & 15;
            *(u32x2*)(w + (((4 * kb + 0) ^ x) << 4)) = (u32x2){rw[0].x, rw[0].y}; *(u32x2*)(w + (((4 * kb + 1) ^ x) << 4)) = (u32x2){rw[0].z, rw[0].w};
            *(u32x2*)(w + (((4 * kb + 2) ^ x) << 4)) = (u32x2){rw[1].x, rw[1].y}; *(u32x2*)(w + (((4 * kb + 3) ^ x) << 4)) = (u32x2){rw[1].z, rw[1].w};
            *(u32x2*)(q + (((4 * kb + 0) ^ x) << 4)) = (u32x2){rq[0].x, rq[0].y}; *(u32x2*)(q + (((4 * kb + 1) ^ x) << 4)) = (u32x2){rq[0].z, rq[0].w};
            *(u32x2*)(q + (((4 * kb + 2) ^ x) << 4)) = (u32x2){rq[1].x, rq[1].y}; *(u32x2*)(q + (((4 * kb + 3) ^ x) << 4)) = (u32x2){rq[1].z, rq[1].w};
        }
        {
            const int dk = 2 * lrow + (c7 >> 2), kb2 = (c7 & 3) >> 1, x = (dk >> 1) & 7;
            char* kt = b + SC_KDT + dk * 128 + hf * 8;
            *(u32x2*)(kt + (((4 * kb2 + 0) ^ x) << 4)) = (u32x2){rk[0].x, rk[0].y}; *(u32x2*)(kt + (((4 * kb2 + 1) ^ x) << 4)) = (u32x2){rk[0].z, rk[0].w};
            *(u32x2*)(kt + (((4 * kb2 + 2) ^ x) << 4)) = (u32x2){rk[1].x, rk[1].y}; *(u32x2*)(kt + (((4 * kb2 + 3) ^ x) << 4)) = (u32x2){rk[1].z, rk[1].w};
        }
        {
            const int row = tid >> 3, kb2 = c7 >> 2, g0 = 2 * (c7 & 1), hf2 = (c7 >> 1) & 1, x = (row >> 1) & 7;
            char* qk = b + SC_QK + row * 128 + hf2 * 8;
            *(u32x2*)(qk + (((4 * kb2 + g0) ^ x) << 4)) = (u32x2){rqk.x, rqk.y}; *(u32x2*)(qk + (((4 * kb2 + g0 + 1) ^ x) << 4)) = (u32x2){rqk.z, rqk.w};
        }
    };
    gloadA(0); gloadU(0);
    lwrite(0);
#pragma unroll
    for (int mt = 0; mt < 4; ++mt) ucur[mt] = unext[mt];
    gcur = gnext;
    if (NCH > 1) gloadA(1);
    __syncthreads();
    for (int n = 0; n < NCH; ++n) {
        const char* b = smem + (n & 1) * SC_BUF;
        if (n + 1 < NCH) { lwrite((n + 1) & 1); gloadU(n + 1); }
        if (n + 2 < NCH) gloadA(n + 2);
        const float gtot = __expf(gcur);
        bf16x8 sf[4];
#pragma unroll
        for (int kb = 0; kb < 4; ++kb) sf[kb] = pack8(S[2 * kb], S[2 * kb + 1]);
        f32x4 Vn[4], O[4];
#pragma unroll
        for (int mt = 0; mt < 4; ++mt) {
            f32x4 P = zero4(), Q = zero4();
            const int row = 16 * mt + r16;
#pragma unroll
            for (int kb = 0; kb < 4; ++kb) {
                const bf16x8 wf = *(const bf16x8*)(b + SC_W + swzrow(row, 256, 4 * kb + g));
                const bf16x8 qf = *(const bf16x8*)(b + SC_QD + swzrow(row, 256, 4 * kb + g));
                P = MFMA16(wf, sf[kb], P);
                Q = MFMA16(qf, sf[kb], Q);
            }
            const float u0 = bflo(ucur[mt].x), u1 = bfhi(ucur[mt].x), u2 = bflo(ucur[mt].y), u3 = bfhi(ucur[mt].y);
            Vn[mt] = (f32x4){u0 - P[0], u1 - P[1], u2 - P[2], u3 - P[3]};
            O[mt] = Q;
        }
        const bf16x8 vf[2] = {pack8(Vn[0], Vn[1]), pack8(Vn[2], Vn[3])};
#pragma unroll
        for (int mt = 0; mt < 8; ++mt) {
            const int row = 16 * mt + r16;
            f32x4 acc = S[mt] * gtot;
#pragma unroll
            for (int kb = 0; kb < 2; ++kb) {
                const bf16x8 kf = *(const bf16x8*)(b + SC_KDT + swz128(row, 4 * kb + g));
                acc = MFMA16(kf, vf[kb], acc);
            }
            S[mt] = acc;
        }
#pragma unroll
        for (int mt = 0; mt < 4; ++mt) {
            const int row = 16 * mt + r16;
#pragma unroll
            for (int kb = 0; kb < 2; ++kb) {
                const bf16x8 qk = *(const bf16x8*)(b + SC_QK + swz128(row, 4 * kb + g));
                O[mt] = MFMA16(qk, vf[kb], O[mt]);
            }
            if (n >= 1 && !dry) *(u32x2*)uaddr(n, mt) = (u32x2){pk2(O[mt][0], O[mt][1]), pk2(O[mt][2], O[mt][3])};
        }
#pragma unroll
        for (int mt = 0; mt < 4; ++mt) ucur[mt] = unext[mt];
        gcur = gnext;
        __syncthreads();
    }
}

constexpr int AT_BUF = 32768, AT_MISC = 65536, NQB = SEQ / 128, AT_UNITS = 8 * NQB;
DI int vt_off8(int e, int s) { return e * 128 + ((s ^ ((e >> 1) & 15)) << 3); }

DI void attention_unit(const Params& p, char* smem, int head, int qb, float lam, int dry, float bound) {
    const int tid = fresh_tid(), lane = tid & 63, wave = tid >> 6, r32 = lane & 31, h = lane >> 5;
    const int wq = wave & 3, mp = wave >> 2;
    unsigned char* ws = p.ws;
    const bf16* AK = (const bf16*)p.out; const bf16* AVT = (const bf16*)p.out + (size_t)SEQ * D;
    const int q0 = 128 * qb, qpos = q0 + 32 * wq + r32;
    const float c1 = 0.125f * LOG2E, c2 = exp2f(-(float)(head + 1)) * LOG2E;
    bf16x8 Qf[4];
    {
        const bf16* qsrc = (const bf16*)(ws + OFF_AQ) + (size_t)qpos * D + head * 128 + mp * 64 + 8 * h;
#pragma unroll
        for (int ks = 0; ks < 4; ++ks) {
            const u32x4 v = *(const u32x4*)(qsrc + 16 * ks); u32x4 o;
            o.x = pk2(bflo(v.x) * c1, bfhi(v.x) * c1); o.y = pk2(bflo(v.y) * c1, bfhi(v.y) * c1); o.z = pk2(bflo(v.z) * c1, bfhi(v.z) * c1); o.w = pk2(bflo(v.w) * c1, bfhi(v.w) * c1);
            Qf[ks] = __builtin_bit_cast(bf16x8, o);
        }
    }
    f32x16 O[4];
#pragma unroll
    for (int i = 0; i < 4; ++i) O[i] = zero16();
    float m_run = 0.f, l_run = 0.f; bool first = true;
    const float wdist = (150.0f + 2.0f * bound) / c2;
    int ntiles = 2 * qb + 3;
    {
        const float lim = (float)q0 - 63.0f - wdist;
        int ktmin = 0;
        if (lim > 0.f) ktmin = (int)(lim * (1.0f / 64.0f));
        const bool keep_meta = !((float)(q0 + NMETA - 15) > wdist);
        if (ktmin > 0 || !keep_meta) ntiles = (2 * qb + 1 - ktmin + 1) + (keep_meta ? 1 : 0);
    }
    const int nreal = (ntiles == 2 * qb + 3) ? 2 * qb + 2 : ntiles;
    const int kkey = tid >> 3, kcc = (tid & 7) * 2;
    const int va = tid >> 5, vb4 = tid & 31;
    u32x4 rk[2]; u32x2 rv[4];
    auto tile_kt = [&](int it) -> int { return it < nreal ? 2 * qb + 1 - it : -1; };
    auto gload = [&](int it) {
        const int kt = tile_kt(it);
        if (kt >= 0) {
            const bf16* ks = AK + ((size_t)kt * 64 + kkey) * D + head * 128 + kcc * 8;
            rk[0] = *(const u32x4*)ks; rk[1] = *(const u32x4*)(ks + 8);
            const bf16* vs = AVT + ((size_t)kt * 64 + 4 * va) * D + head * 128 + 4 * vb4;
#pragma unroll
            for (int i = 0; i < 4; ++i) rv[i] = *(const u32x2*)(vs + (size_t)i * D);
        } else {
            rk[0] = rk[1] = (u32x4){0u, 0u, 0u, 0u};
#pragma unroll
            for (int i = 0; i < 4; ++i) rv[i] = (u32x2){0u, 0u};
            if (kkey < NMETA) { const bf16* ks = (const bf16*)(ws + OFF_SMALL + SM_AKMETA) + (size_t)kkey * D + head * 128 + kcc * 8; rk[0] = *(const u32x4*)ks; rk[1] = *(const u32x4*)(ks + 8); }
            if (va < NMETA / 4) { const bf16* vs = (const bf16*)(ws + OFF_SMALL + SM_AVTMETA) + (size_t)(4 * va) * D + head * 128 + 4 * vb4;
#pragma unroll
                for (int i = 0; i < 4; ++i) rv[i] = *(const u32x2*)(vs + (size_t)i * D); }
        }
    };
    auto lwrite = [&](int buf) {
        char* kb = smem + buf * AT_BUF + (kcc >> 3) * 8192;
        *(u32x4*)(kb + swz128(kkey, kcc & 7)) = rk[0]; *(u32x4*)(kb + swz128(kkey, (kcc & 7) + 1)) = rk[1];
        const unsigned t0x = (rv[0].x & 0xffffu) | (rv[1].x << 16), t1x = (rv[0].x >> 16) | (rv[1].x & 0xffff0000u), t0y = (rv[2].x & 0xffffu) | (rv[3].x << 16), t1y = (rv[2].x >> 16) | (rv[3].x & 0xffff0000u);
        const unsigned t2x = (rv[0].y & 0xffffu) | (rv[1].y << 16), t3x = (rv[0].y >> 16) | (rv[1].y & 0xffff0000u), t2y = (rv[2].y & 0xffffu) | (rv[3].y << 16), t3y = (rv[2].y >> 16) | (rv[3].y & 0xffff0000u);
        const int sub = va >> 3, a = va & 7, a2 = (a & 4) | ((a & 1) << 1) | ((a >> 1) & 1);
        char* vbase = smem + buf * AT_BUF + 16384 + (a2 & 1) * 8;
        const int s16 = 4 * sub + (a2 >> 1), e0 = 4 * vb4;
        *(u32x2*)(vbase + (e0 + 0) * 128 + ((s16 ^ (((e0 + 0) >> 1) & 7)) << 4)) = (u32x2){t0x, t0y};
        *(u32x2*)(vbase + (e0 + 1) * 128 + ((s16 ^ (((e0 + 1) >> 1) & 7)) << 4)) = (u32x2){t1x, t1y};
        *(u32x2*)(vbase + (e0 + 2) * 128 + ((s16 ^ (((e0 + 2) >> 1) & 7)) << 4)) = (u32x2){t2x, t2y};
        *(u32x2*)(vbase + (e0 + 3) * 128 + ((s16 ^ (((e0 + 3) >> 1) & 7)) << 4)) = (u32x2){t3x, t3y};
    };
    gload(0); lwrite(0); __syncthreads();
    for (int it = 0; it < ntiles; ++it) {
        const int buf = it & 1, kt = tile_kt(it);
        if (it + 1 < ntiles) gload(it + 1);
        const bool meta = kt < 0;
        const int k0 = kt * 64;
        const bool skip = !meta && (k0 > q0 + 32 * wq + 31);
        if (!skip) {
            const char* kb = smem + buf * AT_BUF + mp * 8192;
            const char* vb = smem + buf * AT_BUF + 16384;
            const bool need_mask = !meta && (k0 + 63 > q0 + 32 * wq);
            f32x16 s[2];
            float mx = -3.0e38f;
            const float mref = first ? 0.f : m_run;
#pragma unroll
            for (int sub = 0; sub < 2; ++sub) {
                f32x16 acc;
                const float base = (meta ? -c2 * (float)(NMETA + qpos - 32 * sub - 4 * h) : -c2 * (float)(qpos - k0 - 32 * sub - 4 * h)) - mref;
#pragma unroll
                for (int r = 0; r < 16; ++r) acc[r] = base + c2 * (float)((r & 3) + 8 * (r >> 2));
#pragma unroll
                for (int ks = 0; ks < 4; ++ks) {
                    const bf16x8 a = *(const bf16x8*)(kb + swz128(32 * sub + r32, 2 * ks + h));
                    acc = MFMA32(a, Qf[ks], acc);
                }
                if (meta) {
#pragma unroll
                    for (int r = 0; r < 16; ++r) { const int key = 32 * sub + (r & 3) + 8 * (r >> 2) + 4 * h; if (key >= NMETA) acc[r] = -1e30f; }
                } else if (need_mask) {
#pragma unroll
                    for (int r = 0; r < 16; ++r) { const int key = k0 + 32 * sub + (r & 3) + 8 * (r >> 2) + 4 * h; if (key > qpos) acc[r] = -1e30f; }
                }
#pragma unroll
                for (int r = 0; r < 16; ++r) mx = fmaxf(mx, acc[r]);
                s[sub] = acc;
            }
            mx = fmaxf(mx, __shfl_xor(mx, 32));
            const float dlt = first ? mx : fmaxf(mx, 0.f);
            m_run = mref + dlt;
            float ls = 0.f;
            const float alpha = EXP2F(-dlt);
#pragma unroll
            for (int sub = 0; sub < 2; ++sub)
#pragma unroll
                for (int r = 0; r < 16; ++r) { const float pv = EXP2F(s[sub][r] - dlt); s[sub][r] = pv; ls += pv; }
            l_run = l_run * alpha + ls;
            if (wave_any(dlt != 0.f)) {
#pragma unroll
                for (int et = 0; et < 4; ++et) O[et] = O[et] * alpha;
            }
            first = false;
            bf16x8 Pf[2][2];
#pragma unroll
            for (int sub = 0; sub < 2; ++sub)
#pragma unroll
                for (int ss = 0; ss < 2; ++ss) {
                    u32x4 o; o.x = pk2(s[sub][8 * ss], s[sub][8 * ss + 1]); o.y = pk2(s[sub][8 * ss + 2], s[sub][8 * ss + 3]);
                    o.z = pk2(s[sub][8 * ss + 4], s[sub][8 * ss + 5]); o.w = pk2(s[sub][8 * ss + 6], s[sub][8 * ss + 7]);
                    Pf[sub][ss] = __builtin_bit_cast(bf16x8, o);
                }
#pragma unroll
            for (int et = 0; et < 4; ++et) {
                const int e = 32 * et + r32;
#pragma unroll
                for (int sub = 0; sub < 2; ++sub)
#pragma unroll
                    for (int ss = 0; ss < 2; ++ss) {
                        const bf16x8 a = *(const bf16x8*)(vb + swz128(e, 4 * sub + 2 * ss + h));
                        O[et] = MFMA32(a, Pf[sub][ss], O[et]);
                    }
                SCHED_FENCE();
            }
        }
        if (it + 1 < ntiles) lwrite(buf ^ 1);
        __syncthreads();
    }
    {
        const float lt = l_run + __shfl_xor(l_run, 32);
        const float inv = 1.0f / lt;
        float* X = (float*)smem;
        if (mp == 1) {
#pragma unroll
            for (int et = 0; et < 4; ++et)
#pragma unroll
                for (int r = 0; r < 16; ++r) { const int e = 32 * et + (r & 3) + 8 * (r >> 2) + 4 * h; X[(wq * 128 + e) * 32 + r32] = O[et][r] * inv; }
        }
        __syncthreads();
        if (mp == 0) {
            float ssq = 0.f;
#pragma unroll
            for (int et = 0; et < 4; ++et)
#pragma unroll
                for (int r = 0; r < 16; ++r) { const int e = 32 * et + (r & 3) + 8 * (r >> 2) + 4 * h; const float d = O[et][r] * inv - lam * X[(wq * 128 + e) * 32 + r32]; O[et][r] = d; ssq += d * d; }
            ssq += __shfl_xor(ssq, 32);
            const float rstd = rsqrtf(ssq * (1.0f / 128.0f) + NORM_EPS) * 0.8f;
            bf16* dst = (bf16*)(ws + OFF_AQ) + (size_t)qpos * D + head * 128;
            const float* sw = p.in[8];
#pragma unroll
            for (int et = 0; et < 4; ++et)
#pragma unroll
                for (int q4 = 0; q4 < 4; ++q4) {
                    const int e0 = 32 * et + 8 * q4 + 4 * h;
                    const f32x4 w4 = *(const f32x4*)(sw + e0);
                    if (!dry) *(u32x2*)(dst + e0) = (u32x2){pk2(O[et][4 * q4] * rstd * w4[0], O[et][4 * q4 + 1] * rstd * w4[1]), pk2(O[et][4 * q4 + 2] * rstd * w4[2], O[et][4 * q4 + 3] * rstd * w4[3])};
                }
        }
        __syncthreads();
    }
}

DI void phase3(const Params& p, char* smem, int bid, int nblk, int dry = 0, int mode = 3) {
    if (mode & 1) for (int hh = bid; hh < 8; hh += nblk) scan_head(p, smem, hh, dry);
    if (!(mode & 2)) return;
    float d1 = 0.f, d2 = 0.f;
    for (int i = 0; i < 64; ++i) { d1 += p.in[4][i] * p.in[5][i]; d2 += p.in[6][i] * p.in[7][i]; }
    const float lam = __expf(d1) - __expf(d2) + 0.2f;
    unsigned* q = (unsigned*)(p.ws + OFF_SMALL + SM_CTL) + CW_ATTQ + (dry ? 16 : 0);
    for (;;) {
        if (threadIdx.x == 0) *(unsigned*)(smem + AT_MISC) = atomicAdd(q, 1u);
        __syncthreads();
        const unsigned u = *(unsigned*)(smem + AT_MISC);
        __syncthreads();
        if (u >= (unsigned)AT_UNITS) break;
        const int hd = (int)(u & 7u);
        const unsigned* nrm = (const unsigned*)(p.ws + OFF_SMALL + SM_CTL) + CW_NRM;
        float bnd = 0.f;
        for (int m2 = 0; m2 < 2; ++m2) {
            const float q2 = __builtin_bit_cast(float, LD_ATOMIC(nrm + 2 * hd + m2)), k2 = __builtin_bit_cast(float, LD_ATOMIC(nrm + 16 + 2 * hd + m2));
            bnd = fmaxf(bnd, sqrtf(q2 * k2) * (0.125f * LOG2E) * 1.02f);
        }
        attention_unit(p, smem, hd, NQB - 1 - (int)(u >> 3), lam, dry, bnd);
    }
}

DI void phase4(const Params& p, char* smem, int bid, int nblk) {
    const int tid = fresh_tid(), lane = tid & 63, wave = tid >> 6;
    const int gw = bid * 8 + wave, NGW = nblk * 8;
    unsigned char* ws = p.ws;
    char* wl = smem + wave * 16384;
    for (int it = gw; it < 32 * 384; it += NGW) {
        const int e = it / 384, r = it % 384, m = r >> 7, q = r & 127;
        if (m < 2) transpose_item(p.in[21 + m] + (size_t)e * 1024 * 256, 256, 1024, (bf16*)(ws + (m == 0 ? OFF_EXG : OFF_EXU)) + (size_t)e * 256 * 1024, (q >> 3) * 64, (q & 7) * 32, (q & 7) * 32, (float*)wl, lane);
        else transpose_item(p.in[23] + (size_t)e * 256 * 1024, 1024, 256, (bf16*)(ws + OFF_EXD) + (size_t)e * 1024 * 256, (q >> 5) * 64, (q & 31) * 32, (q & 31) * 32, (float*)wl, lane);
    }
    for (int R = gw; R < SEQ; R += NGW) {
        const float* xrow = p.in[0] + (size_t)R * D; bf16* urow = (bf16*)(ws + OFF_U) + (size_t)R * D;
        float4 v[4]; float ss = 0.f;
#pragma unroll
        for (int j = 0; j < 4; ++j) { v[j] = *(const float4*)(xrow + 4 * lane + 256 * j); ss += v[j].x * v[j].x + v[j].y * v[j].y + v[j].z * v[j].z + v[j].w * v[j].w; }
        ss = wave_sum(ss);
        const float rstd = rsqrtf(ss * (1.0f / D) + NORM_EPS);
#pragma unroll
        for (int j = 0; j < 4; ++j) {
            const float4 w4 = *(const float4*)(p.in[2] + 4 * lane + 256 * j);
            *(u32x2*)(urow + 4 * lane + 256 * j) = (u32x2){pk2(v[j].x * rstd * w4.x, v[j].y * rstd * w4.y), pk2(v[j].z * rstd * w4.z, v[j].w * rstd * w4.w)};
        }
    }
    for (int it = gw; it < (NCH - 1) * 8; it += NGW) {
        const int cm1 = it >> 3, head = it & 7;
        const bf16* reg = (const bf16*)(ws + OFF_V) + (size_t)cm1 * 64 * D + head * 128;
#pragma unroll 4
        for (int i = 0; i < 16; ++i) { const int row = i * 4 + (lane >> 4), ch = lane & 15; *(u32x4*)(wl + row * 256 + ch * 16) = *(const u32x4*)(reg + (size_t)row * D + ch * 8); }
        WAVE_SYNC();
        float ss = 0.f;
#pragma unroll 8
        for (int dv = 0; dv < 128; ++dv) { const float v = bf2f(*(const bf16*)(wl + (dv >> 1) * 256 + ((dv & 1) * 64 + lane) * 2)); ss += v * v; }
        const float rstd = rsqrtf(ss * (1.0f / 128.0f) + NORM_EPS);
        const size_t j = (size_t)cm1 * 64 + lane;
        const bf16* gsrc = (const bf16*)(ws + OFF_DG) + j * D + head * 128;
        bf16* dst = (bf16*)(ws + OFF_OD) + j * D + head * 128;
#pragma unroll 2
        for (int d8 = 0; d8 < 16; ++d8) {
            const u32x4 gv = *(const u32x4*)(gsrc + 8 * d8);
            const f32x4 w0 = *(const f32x4*)(p.in[12] + 8 * d8), w1 = *(const f32x4*)(p.in[12] + 8 * d8 + 4);
            float o[8];
#pragma unroll
            for (int c = 0; c < 8; ++c) { const int dv = 8 * d8 + c; o[c] = bf2f(*(const bf16*)(wl + (dv >> 1) * 256 + ((dv & 1) * 64 + lane) * 2)) * rstd; }
            o[0] *= w0[0] * siluf_(bflo(gv.x)); o[1] *= w0[1] * siluf_(bfhi(gv.x)); o[2] *= w0[2] * siluf_(bflo(gv.y)); o[3] *= w0[3] * siluf_(bfhi(gv.y));
            o[4] *= w1[0] * siluf_(bflo(gv.z)); o[5] *= w1[1] * siluf_(bfhi(gv.z)); o[6] *= w1[2] * siluf_(bflo(gv.w)); o[7] *= w1[3] * siluf_(bfhi(gv.w));
            *(u32x4*)(dst + 8 * d8) = (u32x4){pk2(o[0], o[1]), pk2(o[2], o[3]), pk2(o[4], o[5]), pk2(o[6], o[7])};
        }
        WAVE_SYNC();
    }
}

template <int NB, int NI>
DI void rowgemm64(const bf16* arow, const bf16* const (&bptr)[NB], char* stg, f32x16 (&acc)[NB][2][NI]) {
    const int tid = fresh_tid(), lane = tid & 63, r32 = lane & 31, h = lane >> 5;
    const int lrow = tid >> 3, lc = tid & 7;
    u32x4 ra = arow ? *(const u32x4*)arow : (u32x4){0u, 0u, 0u, 0u};
    *(u32x4*)(stg + swz128(lrow, lc)) = ra;
    __syncthreads();
    for (int kc = 0; kc < 16; ++kc) {
        const int buf = kc & 1;
        if (kc + 1 < 16) ra = arow ? *(const u32x4*)(arow + (kc + 1) * 64) : (u32x4){0u, 0u, 0u, 0u};
#pragma unroll
        for (int ks = 0; ks < 4; ++ks) {
            bf16x8 af[2];
#pragma unroll
            for (int mi = 0; mi < 2; ++mi) af[mi] = *(const bf16x8*)(stg + buf * 8192 + swz128(32 * mi + r32, 2 * ks + h));
#pragma unroll
            for (int b = 0; b < NB; ++b)
#pragma unroll
                for (int ni = 0; ni < NI; ++ni) {
                    const bf16x8 bfr = *(const bf16x8*)(bptr[b] + (size_t)ni * 32 * 1024 + kc * 64 + ks * 16);
#pragma unroll
                    for (int mi = 0; mi < 2; ++mi) acc[b][mi][ni] = MFMA32(af[mi], bfr, acc[b][mi][ni]);
                }
        }
        if (kc + 1 < 16) *(u32x4*)(stg + (buf ^ 1) * 8192 + swz128(lrow, lc)) = ra;
        __syncthreads();
    }
}

constexpr size_t OFF_MIX = OFF_V;
struct EpiSig {
    static constexpr bool PERM = true;
    bf16* sg;
    DM void operator()(const f32x4 (&acc)[2][2][4][2], const pg8::Unit& u, int wr, int wc, int fr, int fq) const {
        const int row0 = u.pm * 256 + wr * 64 + fr, col0 = u.pn * 256 + wc * 32 + 8 * fq;
#pragma unroll
        for (int ai = 0; ai < 2; ++ai)
#pragma unroll
            for (int m = 0; m < 4; ++m) {
                bf16* rowp = sg + (size_t)(row0 + ai * 128 + m * 16) * 2048 + col0;
#pragma unroll
                for (int bj = 0; bj < 2; ++bj) {
                    const f32x4 v0 = acc[ai][bj][m][0], v1 = acc[ai][bj][m][1];
                    *(u32x4*)(rowp + bj * 128) = (u32x4){pk2(sigmoidf_(v0[0]), sigmoidf_(v0[1])), pk2(sigmoidf_(v0[2]), sigmoidf_(v0[3])), pk2(sigmoidf_(v1[0]), sigmoidf_(v1[1])), pk2(sigmoidf_(v1[2]), sigmoidf_(v1[3]))};
                }
            }
    }
};
template <bool ADD> struct EpiGate {
    static constexpr bool PERM = true;
    const bf16* sg; bf16* mix; int goff;
    DM void operator()(const f32x4 (&acc)[2][2][4][2], const pg8::Unit& u, int wr, int wc, int fr, int fq) const {
        const int row0 = u.pm * 256 + wr * 64 + fr, col0 = u.pn * 256 + wc * 32 + 8 * fq;
#pragma unroll
        for (int ai = 0; ai < 2; ++ai)
#pragma unroll
            for (int m = 0; m < 4; ++m) {
                const size_t j = (size_t)(row0 + ai * 128 + m * 16);
#pragma unroll
                for (int bj = 0; bj < 2; ++bj) {
                    const u32x4 g = *(const u32x4*)(sg + j * 2048 + goff + col0 + bj * 128);
                    const f32x4 v0 = acc[ai][bj][m][0], v1 = acc[ai][bj][m][1];
                    float o[8] = {bflo(g.x) * v0[0], bfhi(g.x) * v0[1], bflo(g.y) * v0[2], bfhi(g.y) * v0[3], bflo(g.z) * v1[0], bfhi(g.z) * v1[1], bflo(g.w) * v1[2], bfhi(g.w) * v1[3]};
                    bf16* dst = mix + j * D + col0 + bj * 128;
                    if (ADD) { const u32x4 q = *(const u32x4*)dst; o[0] += bflo(q.x); o[1] += bfhi(q.x); o[2] += bflo(q.y); o[3] += bfhi(q.y); o[4] += bflo(q.z); o[5] += bfhi(q.z); o[6] += bflo(q.w); o[7] += bfhi(q.w); }
                    *(u32x4*)dst = (u32x4){pk2(o[0], o[1]), pk2(o[2], o[3]), pk2(o[4], o[5]), pk2(o[6], o[7])};
                }
            }
    }
};
struct EpiRes {
    static constexpr bool PERM = false;
    const float* x; float* hout;
    DM void operator()(const f32x4 (&acc)[2][2][4][2], const pg8::Unit& u, int wr, int wc, int fr, int fq) const {
        const int row0 = u.pm * 256 + wr * 64 + fr, col0 = u.pn * 256 + wc * 32 + 4 * fq;
#pragma unroll
        for (int ai = 0; ai < 2; ++ai)
#pragma unroll
            for (int m = 0; m < 4; ++m) {
                const size_t off = (size_t)(row0 + ai * 128 + m * 16) * D + col0;
#pragma unroll
                for (int bj = 0; bj < 2; ++bj)
#pragma unroll
                    for (int n = 0; n < 2; ++n) *(f32x4*)(hout + off + bj * 128 + n * 16) = *(const f32x4*)(x + off + bj * 128 + n * 16) + acc[ai][bj][m][n];
            }
    }
};
DI void phase5a(const Params& p, char* smem, int bid, int nblk) {
    pg8::Gemm g{(const bf16*)(p.ws + OFF_U), (const bf16*)(p.ws + OFF_WTIN) + (size_t)7168 * 1024, SEQ, 2048, 1024};
    pg8::StaticOrder S; S.init(SEQ, 2048, nblk, bid);
    EpiSig E{(bf16*)p.out};
    pg8::gemm_phase(smem, g, S, E);
}
DI void phase5b(const Params& p, char* smem, int bid, int nblk) {
    pg8::StaticOrder S; S.init(SEQ, 1024, nblk, bid);
    {
        pg8::Gemm g{(const bf16*)(p.ws + OFF_AQ), (const bf16*)(p.ws + OFF_WTBA), SEQ, 1024, 1024};
        EpiGate<false> E{(const bf16*)p.out, (bf16*)(p.ws + OFF_MIX), 0};
        pg8::gemm_phase(smem, g, S, E);
    }
    {
        pg8::Gemm g{(const bf16*)(p.ws + OFF_OD), (const bf16*)(p.ws + OFF_WTBD), SEQ, 1024, 1024};
        EpiGate<true> E{(const bf16*)p.out, (bf16*)(p.ws + OFF_MIX), 1024};
        pg8::gemm_phase(smem, g, S, E);
    }
}
DI void phase5c(const Params& p, char* smem, int bid, int nblk) {
    pg8::Gemm g{(const bf16*)(p.ws + OFF_MIX), (const bf16*)(p.ws + OFF_WTOUT), SEQ, 1024, 1024};
    pg8::StaticOrder S; S.init(SEQ, 1024, nblk, bid);
    EpiRes E{p.in[0], p.out};
    pg8::gemm_phase(smem, g, S, E);
}
constexpr int P5_HL = 0, P5_MISC = 64 * 513 * 4 + 256;
DI void post_rows(const Params& p, char* smem, int rb, int dry) {
    const int tid = fresh_tid(), lane = tid & 63, wave = tid >> 6;
    unsigned char* ws = p.ws;
    const int row0 = rb * 64;
    float* rstdl = (float*)(smem + P5_MISC); float* logl = (float*)(smem + P5_MISC + 256);
    {
        const int row = tid >> 3, seg = tid & 7;
        const float* hp = p.out + (size_t)(row0 + row) * D + seg * 128;
        float ss = 0.f;
#pragma unroll 8
        for (int i = 0; i < 32; ++i) { const f32x4 a = *(const f32x4*)(hp + 4 * i); ss += a[0] * a[0] + a[1] * a[1] + a[2] * a[2] + a[3] * a[3]; }
        ss += __shfl_xor(ss, 1); ss += __shfl_xor(ss, 2); ss += __shfl_xor(ss, 4);
        if (seg == 0) rstdl[row] = rsqrtf(ss * (1.0f / D) + NORM_EPS);
    }
    __syncthreads();
#pragma unroll 2
    for (int i = 0; i < 16; ++i) {
        const int idx = tid + NT * i, row = idx >> 7, ch = idx & 127;
        const float* hp = p.out + (size_t)(row0 + row) * D + ch * 8;
        const f32x4 a = *(const f32x4*)hp, b = *(const f32x4*)(hp + 4);
        const f32x4 w0 = *(const f32x4*)(p.in[16] + ch * 8), w1 = *(const f32x4*)(p.in[16] + ch * 8 + 4);
        const float rs = rstdl[row];
        if (!dry) *(u32x4*)((bf16*)(ws + OFF_OD) + (size_t)(row0 + row) * D + ch * 8) =
            (u32x4){pk2(a[0] * rs * w0[0], a[1] * rs * w0[1]), pk2(a[2] * rs * w0[2], a[3] * rs * w0[3]), pk2(b[0] * rs * w1[0], b[1] * rs * w1[1]), pk2(b[2] * rs * w1[2], b[3] * rs * w1[3])};
    }
    float lg[36];
#pragma unroll
    for (int c = 0; c < 36; ++c) lg[c] = 0.f;
    float* HL = (float*)(smem + P5_HL);
    const float* WR = (const float*)(ws + OFF_SMALL + SM_WR);
#pragma unroll 1
    for (int half = 0; half < 2; ++half) {
        __syncthreads();
#pragma unroll 4
        for (int i = 0; i < 16; ++i) {
            const int idx = tid + NT * i, row = idx >> 7, c4 = idx & 127;
            const f32x4 a = *(const f32x4*)(p.out + (size_t)(row0 + row) * D + 512 * half + c4 * 4);
            float* d = HL + row * 513 + c4 * 4; d[0] = a[0]; d[1] = a[1]; d[2] = a[2]; d[3] = a[3];
        }
        __syncthreads();
        const int kb = 64 * wave;
#pragma unroll 1
        for (int kk = 0; kk < 64; ++kk) {
            const float hv = HL[lane * 513 + kb + kk];
            const float* wr = WR + (size_t)(512 * half + kb + kk) * 40;
#pragma unroll
            for (int c = 0; c < 36; ++c) lg[c] += hv * wr[c];
        }
    }
    __syncthreads();
    float* PL = (float*)(smem + P5_HL);
#pragma unroll
    for (int c = 0; c < 36; ++c) PL[(lane * 8 + wave) * 36 + c] = lg[c];
    __syncthreads();
    if (tid < 64) {
        const float rs = rstdl[tid];
        for (int c = 0; c < 36; ++c) { float s = 0.f; for (int w = 0; w < 8; ++w) s += PL[(tid * 8 + w) * 36 + c]; logl[tid * 40 + c] = s * rs + (c < 4 ? p.in[18][c] : p.in[20][c - 4]); }
        const float* L = logl + tid * 40;
        int gi = 0; float gm = L[0];
        for (int c = 1; c < 4; ++c) if (L[c] > gm) { gm = L[c]; gi = c; }
        float gs = 0.f; for (int c = 0; c < 4; ++c) gs += __expf(L[c] - gm);
        const float gw = 1.0f / gs;
        const float* E = L + 4 + 8 * gi;
        int i1 = 0; float l1 = E[0];
        for (int c = 1; c < 8; ++c) if (E[c] > l1) { l1 = E[c]; i1 = c; }
        int i2 = -1; float l2 = -3.0e38f;
        for (int c = 0; c < 8; ++c) if (c != i1 && E[c] > l2) { l2 = E[c]; i2 = c; }
        const float t = __expf(l2 - l1), w1 = 1.0f / (1.0f + t), w2 = t / (1.0f + t);
        unsigned* cnt = (unsigned*)(ws + OFF_SMALL + SM_CTL) + CW_ECNT;
        int* lists = (int*)(ws + OFF_SMALL + SM_TAILS); float* RW = (float*)(ws + OFF_SMALL + SM_RW);
        const int j = row0 + tid;
        const int e1 = 8 * gi + i1, e2 = 8 * gi + i2;
        if (!dry) {
        const unsigned p1 = atomicAdd(cnt + e1, 1u); ST_ATOMIC(lists + (size_t)e1 * SEQ + p1, (j << 1)); RW[2 * j] = gw * w1;
        const unsigned p2 = atomicAdd(cnt + e2, 1u); ST_ATOMIC(lists + (size_t)e2 * SEQ + p2, (j << 1) | 1); RW[2 * j + 1] = gw * w2;
        } else { asm volatile("" :: "v"(e1), "v"(e2), "v"(gw * w1), "v"(gw * w2)); }
    }
    __syncthreads();
}
DI void phase5d(const Params& p, char* smem, int bid, int nblk, int dry = 0) {
    for (int rb = bid; rb < SEQ / 64; rb += nblk) post_rows(p, smem, rb, dry);
}

constexpr int P6_HL = 0, P6_PITCH = 528, P6_STG = 64 * P6_PITCH, P6_TOK = P6_STG + 16384, P6_RW = P6_TOK + 256, P6_TS = P6_RW + 256;
DI void moe_item(const Params& p, char* smem, int e, int mt, int cnt_e) {
    const int tid = fresh_tid(), lane = tid & 63, wave = tid >> 6, r32 = lane & 31, h = lane >> 5;
    unsigned char* ws = p.ws;
    int* tokl = (int*)(smem + P6_TOK); float* rwl = (float*)(smem + P6_RW);
    if (tid < 64) {
        const int idx = 64 * mt + tid; int ent = -1; float w = 0.f;
        if (idx < cnt_e) { ent = ((const int*)(ws + OFF_SMALL + SM_TAILS))[(size_t)e * SEQ + idx]; w = ((const float*)(ws + OFF_SMALL + SM_RW))[ent]; }
        tokl[tid] = ent; rwl[tid] = w;
    }
    __syncthreads();
    const int lrow = tid >> 3, lc = tid & 7;
    const int lent = tokl[lrow];
    f32x16 GU[2][2][1];
#pragma unroll
    for (int b = 0; b < 2; ++b)
#pragma unroll
        for (int mi = 0; mi < 2; ++mi) GU[b][mi][0] = zero16();
    {
        const bf16* const bp[2] = {(const bf16*)(ws + OFF_EXG) + ((size_t)e * 256 + 32 * wave + r32) * 1024 + 8 * h, (const bf16*)(ws + OFF_EXU) + ((size_t)e * 256 + 32 * wave + r32) * 1024 + 8 * h};
        rowgemm64<2, 1>(lent >= 0 ? (const bf16*)(ws + OFF_OD) + (size_t)(lent >> 1) * D + lc * 8 : nullptr, bp, smem + P6_STG, GU);
    }
#pragma unroll
    for (int mi = 0; mi < 2; ++mi)
#pragma unroll
        for (int r = 0; r < 16; ++r) {
            const int row = 32 * mi + (r & 3) + 8 * (r >> 2) + 4 * h, col = 32 * wave + r32;
            *(bf16*)(smem + P6_HL + row * P6_PITCH + col * 2) = (bf16)f2bf(siluf_(GU[0][mi][0][r]) * GU[1][mi][0][r]);
        }
    __syncthreads();
#pragma unroll 1
    for (int ps = 0; ps < 2; ++ps) {
        f32x16 Y[2][2];
#pragma unroll
        for (int mi = 0; mi < 2; ++mi)
#pragma unroll
            for (int ni = 0; ni < 2; ++ni) Y[mi][ni] = zero16();
        const bf16* bp = (const bf16*)(ws + OFF_EXD) + ((size_t)e * 1024 + 128 * wave + 64 * ps + r32) * 256 + 8 * h;
#pragma unroll 4
        for (int ks = 0; ks < 16; ++ks) {
            bf16x8 af[2];
#pragma unroll
            for (int mi = 0; mi < 2; ++mi) af[mi] = *(const bf16x8*)(smem + P6_HL + (32 * mi + r32) * P6_PITCH + (2 * ks + h) * 16);
#pragma unroll
            for (int ni = 0; ni < 2; ++ni) {
                const bf16x8 bfr = *(const bf16x8*)(bp + (size_t)ni * 32 * 256 + ks * 16);
#pragma unroll
                for (int mi = 0; mi < 2; ++mi) Y[mi][ni] = MFMA32(af[mi], bfr, Y[mi][ni]);
            }
        }
#pragma unroll
        for (int mi = 0; mi < 2; ++mi)
#pragma unroll
            for (int r = 0; r < 16; ++r) {
                const int row = 32 * mi + (r & 3) + 8 * (r >> 2) + 4 * h; const int ent = tokl[row];
                if (ent >= 0) {
                    const float w = rwl[row]; bf16* dst = (bf16*)(ws + OFF_Y) + (size_t)ent * D + 128 * wave + 64 * ps + r32;
#pragma unroll
                    for (int ni = 0; ni < 2; ++ni) dst[32 * ni] = (bf16)f2bf(Y[mi][ni][r] * w);
                }
            }
    }
    __syncthreads();
}
DI void phase6(const Params& p, char* smem, int bid, int nblk) {
    int* ts = (int*)(smem + P6_TS);
    unsigned* cnt = (unsigned*)(p.ws + OFF_SMALL + SM_CTL) + CW_ECNT;
    int* tc = (int*)(smem + P6_TS + 256);
    if (threadIdx.x < 32) tc[threadIdx.x] = (int)LD_ATOMIC(cnt + threadIdx.x);
    __syncthreads();
    if (threadIdx.x == 0) { int s = 0; for (int e = 0; e < 32; ++e) { ts[e] = s; s += (tc[e] + 63) >> 6; } ts[32] = s; }
    __syncthreads();
    const int total = ts[32];
    for (int t = bid; t < total; t += nblk) {
        int e = 0;
        for (int q = 1; q < 32; ++q) if (ts[q] <= t) e = q;
        moe_item(p, smem, e, t - ts[e], tc[e]);
    }
}

DI void phase7(const Params& p, char* smem, int bid, int nblk, int dry = 0) {
    const int tid = fresh_tid(), lane = tid & 63, wave = tid >> 6;
    const int gw = bid * 8 + wave, NGW = nblk * 8;
    for (int j = gw; j < SEQ; j += NGW) {
        float* hrow = p.out + (size_t)j * D;
        const bf16* y0 = (const bf16*)(p.ws + OFF_Y) + (size_t)j * 2 * D;
        float4 v[4]; float ss = 0.f;
#pragma unroll
        for (int q = 0; q < 4; ++q) {
            const int c = 4 * lane + 256 * q;
            v[q] = *(const float4*)(hrow + c);
            const u32x2 a = *(const u32x2*)(y0 + c), b = *(const u32x2*)(y0 + D + c);
            v[q].x += bflo(a.x) + bflo(b.x); v[q].y += bfhi(a.x) + bfhi(b.x); v[q].z += bflo(a.y) + bflo(b.y); v[q].w += bfhi(a.y) + bfhi(b.y);
            ss += v[q].x * v[q].x + v[q].y * v[q].y + v[q].z * v[q].z + v[q].w * v[q].w;
        }
        ss = wave_sum(ss);
        const float rstd = rsqrtf(ss * (1.0f / D) + NORM_EPS);
#pragma unroll
        for (int q = 0; q < 4; ++q) {
            const int c = 4 * lane + 256 * q; const float4 w4 = *(const float4*)(p.in[24] + c);
            if (!dry) *(float4*)(hrow + c) = make_float4(v[q].x * rstd * w4.x, v[q].y * rstd * w4.y, v[q].z * rstd * w4.z, v[q].w * rstd * w4.w);
        }
    }
}

__global__ void __launch_bounds__(NT) k_phase0(Params p) { SMEM_DECL; phase0(p, smem, blockIdx.x, gridDim.x); }
__global__ void __launch_bounds__(NT) k_phase1(Params p) { SMEM_DECL; phase1(p, smem, blockIdx.x, gridDim.x); }
__global__ void __launch_bounds__(NT) k_phase2(Params p) { SMEM_DECL; phase2(p, smem, blockIdx.x, gridDim.x, 0); }
__global__ void __launch_bounds__(NT) k_phase3(Params p) { SMEM_DECL; phase3(p, smem, blockIdx.x, gridDim.x); }
__global__ void __launch_bounds__(NT) k_phase4(Params p) { SMEM_DECL; phase4(p, smem, blockIdx.x, gridDim.x); }
__global__ void __launch_bounds__(NT) k_phase5a(Params p) { SMEM_DECL; phase5a(p, smem, blockIdx.x, gridDim.x); }
__global__ void __launch_bounds__(NT) k_phase5b(Params p) { SMEM_DECL; phase5b(p, smem, blockIdx.x, gridDim.x); }
__global__ void __launch_bounds__(NT) k_phase5c(Params p) { SMEM_DECL; phase5c(p, smem, blockIdx.x, gridDim.x); }
__global__ void __launch_bounds__(NT) k_phase5d(Params p) { SMEM_DECL; phase5d(p, smem, blockIdx.x, gridDim.x); }
__global__ void __launch_bounds__(NT) k_phase6(Params p) { SMEM_DECL; phase6(p, smem, blockIdx.x, gridDim.x); }
__global__ void __launch_bounds__(NT) k_phase7(Params p) { SMEM_DECL; phase7(p, smem, blockIdx.x, gridDim.x); }

constexpr int LDS_BYTES = 160 * 1024 - 256;
constexpr int LDS_BARST = LDS_BYTES - 16;

#ifndef EMU
#define LAS __attribute__((address_space(3)))
#define XB_TMO      128
#define XB_XCNT(j)  (256  + 64 * (j))
#define XB_XSUB(j)  (1280 + 64 * (j))
#define XB_XGEN(j)  (2304 + 64 * (j))
#define XB_TOP      3328
#define XB_TOPGEN   3392
#define XCD_BAR_WORDS 3456
#define XB_SPIN_CAP (1u << 22)
__device__ __forceinline__ unsigned xb_ld(unsigned* p)              { return __hip_atomic_load(p, __ATOMIC_RELAXED, __HIP_MEMORY_SCOPE_AGENT); }
__device__ __forceinline__ unsigned xb_add(unsigned* p, unsigned v) { return __hip_atomic_fetch_add(p, v, __ATOMIC_RELAXED, __HIP_MEMORY_SCOPE_AGENT); }
__device__ __forceinline__ unsigned xb_xcc_id() { return (unsigned)__builtin_amdgcn_s_getreg((3 << 11) | 20) & 0xFu; }
#define XB_SPIN(cond, bar) do { unsigned _sp = 0; while (cond) { __builtin_amdgcn_s_sleep(1); \
    if ((++_sp & 255u) == 0u) { if (xb_ld(&(bar)[XB_TMO])) break; if (_sp > XB_SPIN_CAP) { atomicAdd(&(bar)[XB_TMO], 1u); break; } } } } while (0)
struct XcdBarrier { unsigned* bar; unsigned x; volatile LAS unsigned* st; };
__device__ __forceinline__ XcdBarrier xcd_barrier_post(unsigned* bar, volatile LAS unsigned* st) {
    XcdBarrier b; b.bar = bar; b.x = xb_xcc_id(); b.st = st;
    if (threadIdx.x == 0) (void)xb_add(&bar[XB_XCNT(b.x)], 1u);
    return b;
}
__device__ __forceinline__ void xcd_barrier_complete(unsigned* bar, unsigned x, unsigned& nloc, unsigned& nx) {
    const unsigned G = gridDim.x * gridDim.y * gridDim.z;
    unsigned sum, cnt, mine, sp = 0u;
    for (;;) {
        sum = 0u; cnt = 0u; mine = 0u;
#pragma unroll
        for (unsigned j = 0; j < 16; ++j) { const unsigned c = xb_ld(&bar[XB_XCNT(j)]); sum += c; cnt += (c > 0u) ? 1u : 0u; mine = (j == x) ? c : mine; }
        if (sum == G) break;
        __builtin_amdgcn_s_sleep(1);
        if ((++sp & 255u) == 0u) { if (xb_ld(&bar[XB_TMO])) break; if (sp > XB_SPIN_CAP) { atomicAdd(&bar[XB_TMO], 1u); break; } }
    }
    nloc = mine > 0u ? mine : 1u; nx = cnt > 0u ? cnt : 1u;
}
__device__ __forceinline__ void xcd_barrier(const XcdBarrier& b) {
    asm volatile("s_waitcnt vmcnt(0)" ::: "memory");
    __syncthreads();
    if (threadIdx.x == 0) {
        unsigned* bar = b.bar;
        __builtin_amdgcn_s_waitcnt(0);
        unsigned nloc = b.st[0], nx = b.st[1];
        if (nloc == 0u) { xcd_barrier_complete(bar, b.x, nloc, nx); b.st[0] = nloc; b.st[1] = nx; }
        const unsigned old = xb_add(&bar[XB_XSUB(b.x)], 1u);
        const unsigned gen = old / nloc;
        if (old + 1u == (gen + 1u) * nloc) {
            __builtin_amdgcn_fence(__ATOMIC_RELEASE, "agent");
            asm volatile("s_waitcnt vmcnt(0)" ::: "memory");
            const unsigned og = xb_add(&bar[XB_TOP], 1u);
            const unsigned tg = og / nx;
            if (og + 1u == (tg + 1u) * nx) xb_add(&bar[XB_TOPGEN], 1u);
            else XB_SPIN(xb_ld(&bar[XB_TOPGEN]) == tg, bar);
            __builtin_amdgcn_fence(__ATOMIC_ACQUIRE, "agent");
            xb_add(&bar[XB_XGEN(b.x)], 1u);
            asm volatile("s_waitcnt vmcnt(0)" ::: "memory");
        } else {
            XB_SPIN(xb_ld(&bar[XB_XGEN(b.x)]) == gen, bar);
            __builtin_amdgcn_fence(__ATOMIC_ACQUIRE, "agent");
            asm volatile("s_waitcnt vmcnt(0)" ::: "memory");
        }
    }
    __syncthreads();
}
#endif

#ifdef EMU
#define GRID_SYNC() emu_grid_sync()
#define GRID_SYNC_CG() emu_grid_sync()
#else
#define GRID_SYNC_CG() do { \
    asm volatile("s_waitcnt vmcnt(0)" ::: "memory"); \
    __syncthreads(); \
    cooperative_groups::this_grid().sync(); \
    if (threadIdx.x == 0) { __builtin_amdgcn_fence(__ATOMIC_ACQUIRE, "agent"); asm volatile("s_waitcnt vmcnt(0)" ::: "memory"); } \
    __syncthreads(); \
} while (0)
#define GRID_SYNC() xcd_barrier(xbar)
#endif
__global__ void __launch_bounds__(NT) fwd_megakernel(Params p) {
    SMEM_DECL;
    const int bid = blockIdx.x, nblk = gridDim.x;
#ifndef EMU
    if (threadIdx.x < 4) ((volatile LAS unsigned*)(smem + LDS_BARST))[threadIdx.x] = 0u;
    __syncthreads();
    const XcdBarrier xbar = xcd_barrier_post((unsigned*)(p.ws + OFF_SMALL + SM_CTL) + CW_BAR, (volatile LAS unsigned*)(smem + LDS_BARST));
#endif
#if defined(DRY_PHASE) && !defined(EMU)
    int dryflag = 1; asm volatile("" : "+s"(dryflag));
#define EXTRA(k, call) do { if (DRY_PHASE == (k)) { call; GRID_SYNC(); } } while (0)
#else
#define EXTRA(k, call) do {} while (0)
    const int dryflag = 0; (void)dryflag;
#endif
    EXTRA(0, phase0(p, smem, bid, nblk));
    phase0(p, smem, bid, nblk); GRID_SYNC_CG();
    EXTRA(1, phase1(p, smem, bid, nblk));
    phase1(p, smem, bid, nblk); GRID_SYNC();
    EXTRA(2, phase2(p, smem, bid, nblk, dryflag));
    phase2(p, smem, bid, nblk); GRID_SYNC();
    EXTRA(3, phase3(p, smem, bid, nblk, dryflag));
    EXTRA(8, phase3(p, smem, bid, nblk, dryflag, 1));
    EXTRA(9, phase3(p, smem, bid, nblk, dryflag, 2));
    phase3(p, smem, bid, nblk); GRID_SYNC();
    EXTRA(4, phase4(p, smem, bid, nblk));
    phase4(p, smem, bid, nblk); GRID_SYNC();
    EXTRA(5, phase5a(p, smem, bid, nblk));
    phase5a(p, smem, bid, nblk); GRID_SYNC();
    EXTRA(10, phase5b(p, smem, bid, nblk));
    phase5b(p, smem, bid, nblk); GRID_SYNC();
    EXTRA(11, phase5c(p, smem, bid, nblk));
    phase5c(p, smem, bid, nblk); GRID_SYNC();
    EXTRA(12, phase5d(p, smem, bid, nblk, dryflag));
    phase5d(p, smem, bid, nblk); GRID_SYNC();
    EXTRA(6, phase6(p, smem, bid, nblk));
    phase6(p, smem, bid, nblk); GRID_SYNC();
    EXTRA(7, phase7(p, smem, bid, nblk, dryflag));
    phase7(p, smem, bid, nblk);
}

#ifndef EMU
extern "C" void kernel_launch(void* const* d_in, const int* in_sizes, int n_in, void* d_out, int out_size, void* d_ws, size_t ws_size, hipStream_t stream) {
    static int grid = 0;
    if (grid == 0) {
        if (n_in != 25 || ws_size < WS_END || out_size != SEQ * D) { fprintf(stderr, "kernel_launch: unexpected problem (n_in %d, ws %zu, out %d)\n", n_in, ws_size, out_size); grid = -1; return; }
        int dev = 0, cus = 0, per_cu = 0;
        (void)hipGetDevice(&dev);
        (void)hipDeviceGetAttribute(&cus, hipDeviceAttributeMultiprocessorCount, dev);
        (void)hipFuncSetAttribute((const void*)fwd_megakernel, hipFuncAttributeMaxDynamicSharedMemorySize, LDS_BYTES);
        (void)hipOccupancyMaxActiveBlocksPerMultiprocessor(&per_cu, (const void*)fwd_megakernel, NT, LDS_BYTES);
        if (per_cu < 1) { fprintf(stderr, "kernel_launch: occupancy query returned %d\n", per_cu); per_cu = 1; }
        grid = cus * per_cu;
    }
    if (grid < 0) return;
    Params p{};
    for (int i = 0; i < 25; ++i) p.in[i] = (const float*)d_in[i];
    p.out = (float*)d_out; p.ws = (unsigned char*)d_ws;
    (void)hipMemsetAsync((unsigned char*)d_ws + OFF_SMALL + SM_CTL + (size_t)CW_BAR * 4, 0, (size_t)XCD_BAR_WORDS * 4, stream);
    void* args[] = {&p};
    hipError_t e = hipLaunchCooperativeKernel((const void*)fwd_megakernel, dim3(grid), dim3(NT), args, LDS_BYTES, stream);
    if (e != hipSuccess) fprintf(stderr, "cooperative launch failed: %s (grid %d)\n", hipGetErrorString(e), grid);
}
#endif

#ifdef EMU
static void run_phases(Params p, int upto, int grid) {
    if (upto == 100) { emu::launch([=] { fwd_megakernel(p); }, grid, NT, LDS_BYTES, true); return; }
    if (upto >= 0) emu::launch([=] { k_phase0(p); }, grid, NT, LDS_BYTES, false);
    if (upto >= 1) emu::launch([=] { k_phase1(p); }, grid, NT, LDS_BYTES, false);
    if (upto >= 2) emu::launch([=] { k_phase2(p); }, grid, NT, LDS_BYTES, false);
    if (upto >= 3) emu::launch([=] { k_phase3(p); }, grid, NT, LDS_BYTES, false);
    if (upto >= 4) emu::launch([=] { k_phase4(p); }, grid, NT, LDS_BYTES, false);
    if (upto >= 5) { emu::launch([=] { k_phase5a(p); }, grid, NT, LDS_BYTES, false); emu::launch([=] { k_phase5b(p); }, grid, NT, LDS_BYTES, false); emu::launch([=] { k_phase5c(p); }, grid, NT, LDS_BYTES, false); emu::launch([=] { k_phase5d(p); }, grid, NT, LDS_BYTES, false); }
    if (upto >= 6) emu::launch([=] { k_phase6(p); }, grid, NT, LDS_BYTES, false);
    if (upto >= 7) emu::launch([=] { k_phase7(p); }, grid, NT, LDS_BYTES, false);
}
#endif
```

```cpp
#include <type_traits>
#ifndef EMU
#include <hip/hip_runtime.h>
#include <hip/hip_cooperative_groups.h>
#include <cstdio>
#include <cstdint>
#include <cmath>
#endif

#ifndef SEQ
#define SEQ 16384
#endif

typedef unsigned short bf16;
typedef short bf16x8 __attribute__((ext_vector_type(8)));
typedef short bf16x4 __attribute__((ext_vector_type(4)));
typedef float f32x16 __attribute__((ext_vector_type(16)));
typedef float f32x4 __attribute__((ext_vector_type(4)));
typedef unsigned u32x4 __attribute__((ext_vector_type(4)));
typedef unsigned u32x2 __attribute__((ext_vector_type(2)));

#ifdef EMU
#define MFMA32(a, b, c) emu_mfma_32x32x16((a), (b), (c))
#define MFMA16(a, b, c) emu_mfma_16x16x32((a), (b), (c))
#define DI static inline
#define DM inline
#define EXP2F(x) exp2f(x)
#define WAVE_SYNC() emu_wave_sync()
#define LD_NT(p) (*(p))
#define LD_ATOMIC(p) (*(p))
#define ST_ATOMIC(p, v) (*(p) = (v))
#define SCHED_FENCE() do {} while (0)
#else
#define WAVE_SYNC() do { __builtin_amdgcn_fence(__ATOMIC_RELEASE, "wavefront"); __builtin_amdgcn_wave_barrier(); __builtin_amdgcn_fence(__ATOMIC_ACQUIRE, "wavefront"); } while (0)
#define MFMA32(a, b, c) __builtin_amdgcn_mfma_f32_32x32x16_bf16((a), (b), (c), 0, 0, 0)
#define LD_NT(p) __builtin_nontemporal_load(p)
#define LD_ATOMIC(p) __hip_atomic_load((p), __ATOMIC_RELAXED, __HIP_MEMORY_SCOPE_AGENT)
#define ST_ATOMIC(p, v) __hip_atomic_store((p), (v), __ATOMIC_RELAXED, __HIP_MEMORY_SCOPE_AGENT)
#define SCHED_FENCE() __builtin_amdgcn_sched_barrier(0)
#define MFMA16(a, b, c) __builtin_amdgcn_mfma_f32_16x16x32_bf16((a), (b), (c), 0, 0, 0)
#define DI __device__ __forceinline__
#define DM __device__ __forceinline__
#define EXP2F(x) __builtin_amdgcn_exp2f(x)
#endif

constexpr int D = 1024;
constexpr int NMETA = 16;
constexpr int LTOK = SEQ + NMETA;
constexpr int NCH = SEQ / 64 + 1;
constexpr int NT = 512;
constexpr int W_IN_COLS = 9232;
constexpr float NORM_EPS = 1e-6f;
constexpr float LOG2E = 1.4426950408889634f;

constexpr size_t UNIT = (size_t)SEQ * D * 2;
constexpr size_t OFF_WTIN = 0;
constexpr size_t OFF_WTBA = OFF_WTIN + (size_t)9216 * 1024 * 2;
constexpr size_t OFF_WTBD = OFF_WTBA + (size_t)1024 * 1024 * 2;
constexpr size_t OFF_WTOUT = OFF_WTBD + (size_t)1024 * 1024 * 2;
constexpr size_t OFF_SMALL = OFF_WTOUT + (size_t)1024 * 1024 * 2;
constexpr size_t SM_CTL = 0;
constexpr size_t SM_UMETA = SM_CTL + 65536;
constexpr size_t SM_AKMETA = SM_UMETA + 16 * 1024 * 2;
constexpr size_t SM_AVTMETA = SM_AKMETA + 16 * 1024 * 2;
constexpr size_t SM_C0Q = SM_AVTMETA + 8 * 128 * 16 * 2;
constexpr size_t SM_C0K = SM_C0Q + 64 * 1024 * 2;
constexpr size_t SM_C0V = SM_C0K + 64 * 1024 * 2;
constexpr size_t SM_C0W = SM_C0V + 64 * 1024 * 2;
constexpr size_t SM_C0QK = SM_C0W + 8 * 64 * 128 * 2;
constexpr size_t SM_BETA = SM_C0QK + 8 * 64 * 64 * 2;
constexpr size_t SM_G = SM_BETA + (size_t)NCH * 64 * 8 * 4;
constexpr size_t SM_GC = SM_G + (size_t)NCH * 64 * 8 * 4;
constexpr size_t SM_WR = SM_GC + (size_t)NCH * 8 * 64 * 4;
constexpr size_t SM_RIDS = SM_WR + 1024 * 40 * 4;
constexpr size_t SM_RW = SM_RIDS + 0;
constexpr size_t SM_TAILS = SM_RW + (size_t)SEQ * 2 * 4;
constexpr size_t SM_TAILS_BYTES = ((size_t)NCH * 3 * 3072 * 2 > (size_t)32 * SEQ * 4) ? (size_t)NCH * 3 * 3072 * 2 : (size_t)32 * SEQ * 4;
constexpr size_t SM_END = SM_TAILS + SM_TAILS_BYTES;
constexpr size_t SMALL_BYTES = (SM_END + 255) & ~(size_t)255;
constexpr size_t OFF_U = ((OFF_SMALL + SMALL_BYTES + (1u << 20) - 1) >> 20) << 20;
constexpr size_t OFF_W = OFF_U + UNIT;
constexpr size_t OFF_KN = OFF_W + UNIT;
constexpr size_t OFF_QN = OFF_KN + UNIT;
constexpr size_t OFF_DG = OFF_QN + UNIT;
constexpr size_t OFF_V = OFF_DG + UNIT;
constexpr size_t OFF_AQ = OFF_V + UNIT;
constexpr size_t WS_BASE_END = OFF_AQ + UNIT;
constexpr size_t EXPERT_BYTES = (size_t)32 * 3 * 1024 * 256 * 2;
constexpr size_t OFF_EXP = (2 * UNIT >= EXPERT_BYTES) ? OFF_W : WS_BASE_END;
constexpr size_t WS_END = (OFF_EXP == OFF_W) ? WS_BASE_END : WS_BASE_END + EXPERT_BYTES;
constexpr size_t OFF_EXG = OFF_EXP, OFF_EXU = OFF_EXP + EXPERT_BYTES / 3, OFF_EXD = OFF_EXP + 2 * (EXPERT_BYTES / 3);
constexpr size_t OFF_QKB = OFF_U;
constexpr size_t OFF_OD = OFF_QN;
constexpr size_t OFF_Y = OFF_V;
#if SEQ == 16384
static_assert(WS_END <= (size_t)256 << 20, "workspace map exceeds 256 MiB");
static_assert(EXPERT_BYTES <= 2 * UNIT, "experts fit R2+R3");
#endif
constexpr int CW_ATTQ = 64;
constexpr int CW_ECNT = 128;
constexpr int CW_NRM = 256;
constexpr int CW_BAR = 1024;

struct Params {
    const float* in[25];
    float* out;
    unsigned char* ws;
};

#ifdef EMU
DI unsigned f2bf(float f) { unsigned u = __builtin_bit_cast(unsigned, f); return (u + 0x7fffu + ((u >> 16) & 1u)) >> 16; }
#else
DI unsigned f2bf(float f) { return (unsigned)__builtin_bit_cast(unsigned short, (__bf16)f); }
#endif

DI float bf2f(unsigned b) { return __builtin_bit_cast(float, (b & 0xffffu) << 16); }
#ifdef EMU
DI unsigned pk2(float lo, float hi) { return f2bf(lo) | (f2bf(hi) << 16); }
DI bool wave_any(bool pr) { int v = pr ? 1 : 0;
    for (int o = 1; o < 64; o <<= 1) v |= __shfl_xor(v, o);
    return v != 0; }
#else
typedef __bf16 hwbf2 __attribute__((ext_vector_type(2)));
typedef float f32x2_ __attribute__((ext_vector_type(2)));
DI unsigned pk2(float lo, float hi) { return __builtin_bit_cast(unsigned, __builtin_convertvector((f32x2_){lo, hi}, hwbf2)); }
DI bool wave_any(bool pr) { return __any(pr) != 0; }
#endif
DI float bflo(unsigned w) { return __builtin_bit_cast(float, w << 16); }
DI float bfhi(unsigned w) { return __builtin_bit_cast(float, w & 0xffff0000u); }
DI float sigmoidf_(float x) { return 1.0f / (1.0f + __expf(-x)); }
DI float siluf_(float x) { return x / (1.0f + __expf(-x)); }
DI float wave_sum(float v) {
#pragma unroll
    for (int o = 1; o < 64; o <<= 1) v += __shfl_xor(v, o);
    return v;
}
DI int fresh_tid() {
    int t = threadIdx.x;
#ifndef EMU
    asm volatile("" : "+v"(t));
#endif
    return t;
}
#ifdef EMU
DI float xhalf(float v) { return __shfl_xor(v, 32); }
#else
DI float xhalf(float v) { const unsigned u = __builtin_bit_cast(unsigned, v); const auto r = __builtin_amdgcn_permlane32_swap(u, u, false, false); return __builtin_bit_cast(float, (threadIdx.x & 32) ? r[0] : r[1]); }
#endif
DI f32x16 zero16() { f32x16 z; for (int i = 0; i < 16; ++i) z[i] = 0.f; return z; }
DI f32x4 zero4() { f32x4 z; for (int i = 0; i < 4; ++i) z[i] = 0.f; return z; }
DI int swz128(int row, int c) { return row * 128 + ((c ^ ((row >> 1) & 7)) << 4); }
DI int swz128t(int row, int c) { return row * 128 + ((c ^ ((row >> 1) & 7) ^ ((row >> 4) & 7)) << 4); }
DI int swz128_8(int row, int s) { return row * 128 + ((s ^ (((row >> 1) & 7) << 1)) << 3); }
DI int swzrow(int row, int pitch, int c) { return row * pitch + ((c ^ (row & 15)) << 4); }

#ifdef EMU
#define SMEM_DECL char* smem = emu_smem()
#else
#define SMEM_DECL extern __shared__ __attribute__((aligned(16))) char smem[]
#endif

DI void transpose_item(const float* W, int ldw, int K, bf16* Wt, int k0, int src_n0, int dst_n0, float* scr, int lane) {
#pragma unroll 8
    for (int i = 0; i < 32; ++i) { const int kk = 2 * i + (lane >> 5); scr[kk * 33 + (lane & 31)] = W[(size_t)(k0 + kk) * ldw + src_n0 + (lane & 31)]; }
    WAVE_SYNC();
    const int c = lane & 7;
#pragma unroll
    for (int j = 0; j < 4; ++j) {
        const int n = (lane >> 3) + 8 * j; const float* s = scr + (8 * c) * 33 + n;
        u32x4 o; o.x = pk2(s[0 * 33], s[1 * 33]); o.y = pk2(s[2 * 33], s[3 * 33]); o.z = pk2(s[4 * 33], s[5 * 33]); o.w = pk2(s[6 * 33], s[7 * 33]);
        *(u32x4*)(Wt + (size_t)(dst_n0 + n) * K + k0 + 8 * c) = o;
    }
    WAVE_SYNC();
}

DI void phase0(const Params& p, char* smem, int bid, int nblk) {
    const int tid = fresh_tid(), lane = tid & 63, wave = tid >> 6;
    const int gw = bid * 8 + wave, NGW = nblk * 8;
    unsigned char* ws = p.ws;
    if (bid == 0) {
        unsigned* ctl = (unsigned*)(ws + OFF_SMALL + SM_CTL);
        for (int i = tid; i < 1024; i += NT) ctl[i] = 0u;
        float* be = (float*)(ws + OFF_SMALL + SM_BETA); float* gg = (float*)(ws + OFF_SMALL + SM_G);
        for (int i = tid; i < 48 * 8; i += NT) { be[i] = 0.f; gg[i] = 0.f; }
    }
    {
        float* scr = (float*)(smem + 65536) + wave * (64 * 33);
        constexpr int I_IN = 16 * (9216 / 32), I_SQ = 16 * 32;
        constexpr int NITEMS = I_IN + 3 * I_SQ;
        for (int it = gw; it < NITEMS; it += NGW) {
            int r = it;
            if (r < I_IN) { const int kb = r / 288, nb = r % 288; const int dn = nb * 32; const int sn = dn < 7168 ? dn : dn + 16;
                transpose_item(p.in[3], W_IN_COLS, 1024, (bf16*)(ws + OFF_WTIN), kb * 64, sn, dn, scr, lane); continue; }
            r -= I_IN;
            const int m = r / I_SQ; r %= I_SQ;
            const float* src = m == 0 ? p.in[13] : (m == 1 ? p.in[14] : p.in[15]);
            bf16* dst = (bf16*)(ws + (m == 0 ? OFF_WTBA : (m == 1 ? OFF_WTBD : OFF_WTOUT)));
            transpose_item(src, 1024, 1024, dst, (r / 32) * 64, (r % 32) * 32, (r % 32) * 32, scr, lane);
        }
    }
    {
        float* WR = (float*)(ws + OFF_SMALL + SM_WR);
        for (int i = bid * NT + tid; i < 1024 * 40; i += nblk * NT) {
            const int k = i / 40, c = i % 40; float v = 0.f;
            if (c < 4) v = p.in[17][k * 4 + c]; else if (c < 36) v = p.in[19][k * 32 + (c - 4)];
            WR[i] = v * p.in[16][k];
        }
    }
    float* wbd = (float*)smem;
    for (int i = tid; i < 1024 * 16; i += NT) { const int k = i >> 4, c = i & 15; wbd[i] = p.in[3][(size_t)k * W_IN_COLS + 7168 + c]; }
    __syncthreads();
    const float* nw = p.in[2];
    for (int R = gw; R < LTOK; R += NGW) {
        const float* xrow = R < NMETA ? p.in[1] + (size_t)R * D : p.in[0] + (size_t)(R - NMETA) * D;
        bf16* urow = R < NMETA ? (bf16*)(ws + OFF_SMALL + SM_UMETA) + (size_t)R * D : (bf16*)(ws + OFF_U) + (size_t)(R - NMETA) * D;
        float ss = 0.f;
#pragma unroll
        for (int j = 0; j < 4; ++j) { const float4 v = *(const float4*)(xrow + 4 * lane + 256 * j); ss += v.x * v.x + v.y * v.y + v.z * v.z + v.w * v.w; }
        ss = wave_sum(ss);
        const float rstd = rsqrtf(ss * (1.0f / D) + NORM_EPS);
        float acc[16];
#pragma unroll
        for (int c = 0; c < 16; ++c) acc[c] = 0.f;
#pragma unroll 1
        for (int j = 0; j < 4; ++j) {
            const float4 w4 = *(const float4*)(nw + 4 * lane + 256 * j);
            const float4 xv = *(const float4*)(xrow + 4 * lane + 256 * j);
            float uu[4] = {xv.x * rstd * w4.x, xv.y * rstd * w4.y, xv.z * rstd * w4.z, xv.w * rstd * w4.w};
            u32x2 o; o.x = pk2(uu[0], uu[1]); o.y = pk2(uu[2], uu[3]);
            *(u32x2*)(urow + 4 * lane + 256 * j) = o;
#pragma unroll
            for (int e = 0; e < 4; ++e) {
                const float* wr = wbd + (size_t)(4 * lane + 256 * j + e) * 16;
#pragma unroll
                for (int c = 0; c < 16; ++c) acc[c] += uu[e] * wr[c];
            }
        }
#pragma unroll
        for (int c = 0; c < 16; ++c) acc[c] = wave_sum(acc[c]);
        if (lane < 16) {
            float a = 0.f;
#pragma unroll
            for (int c = 0; c < 16; ++c) a = (lane == c) ? acc[c] : a;
            const size_t pos = 48 + R;
            if (lane < 8) { ((float*)(ws + OFF_SMALL + SM_BETA))[pos * 8 + lane] = sigmoidf_(a); }
            else { const int hh = lane - 8; const float z = a + p.in[11][hh]; const float sp = fmaxf(z, 0.f) + log1pf(__expf(-fabsf(z)));
                   ((float*)(ws + OFF_SMALL + SM_G))[pos * 8 + hh] = -__expf(p.in[10][hh]) * sp; }
        }
    }
}

namespace pg8 {
constexpr int BM = 256, BK = 64, HALF = 128, HTB = HALF * BK * 2, NXCD = 8, WGM = 8;
DI int lds_byte(int r, int c) { const int st = (r >> 4) * 2 + (c >> 5), rr = r & 15, cc = c & 31, ob = rr * 64 + cc * 2; return st * 1024 + (ob ^ (((ob >> 9) & 1) << 5)); }
DI void stage_rc(int b, int& R, int& C) { const int st = b / 1024, sb = b % 1024, swz = sb ^ (((sb >> 9) & 1) << 5); R = (st >> 1) * 16 + swz / 64; C = (st & 1) * 32 + (swz % 64) / 2; }
DI int perm32(int rho) { const int n = rho >> 4, i = rho & 15; return 8 * (i >> 2) + 4 * n + (i & 3); }
struct Unit { int pm, pn; };
struct Gemm { const bf16* A; const bf16* Bt; int M, N, K; };
struct StaticOrder {
    int nM, nN, nwg, G, c;
    DM void init(int M, int N, int G_, int c_) { nM = M / BM; nN = N / BM; nwg = nM * nN; G = G_; c = c_; }
    DM bool next(int i, Unit& u) const {
        const long L = (long)i * G + c; if (L >= nwg) return false;
        int wgid = (int)L; { const int q = nwg / NXCD, r = nwg % NXCD, xcd = wgid % NXCD, off = wgid / NXCD; wgid = (xcd < r ? xcd * (q + 1) : r * (q + 1) + (xcd - r) * q) + off; }
        const int nig = WGM * nN, gid = wgid / nig, fm = gid * WGM, gsz = (nM - fm) < WGM ? (nM - fm) : WGM;
        u.pm = fm + ((wgid % nig) % gsz); u.pn = (wgid % nig) / gsz; return true;
    }
};
#ifdef EMU
template <class Epi>
DI void gemm_phase(char* lds, const Gemm g, const StaticOrder& S, const Epi& E) {
    const int tid = threadIdx.x, wid = tid >> 6, lane = tid & 63, wr = wid >> 2, wc = wid & 3, fr = lane & 15, fq = lane >> 4;
    Unit u;
    for (int ui = 0; S.next(ui, u); ++ui) {
        f32x4 acc[2][2][4][2];
        for (int ai = 0; ai < 2; ++ai) for (int bj = 0; bj < 2; ++bj) for (int m = 0; m < 4; ++m) for (int n = 0; n < 2; ++n) for (int e = 0; e < 4; ++e) {
            const int r = 256 * u.pm + 128 * ai + 64 * wr + 16 * m + fr;
            const int c = 256 * u.pn + 128 * bj + 32 * wc + (Epi::PERM ? 8 * fq + 4 * n : 16 * n + 4 * fq) + e;
            const bf16* a = g.A + (size_t)r * g.K; const bf16* b = g.Bt + (size_t)c * g.K; float s = 0.f;
            for (int k = 0; k < g.K; ++k) s += bf2f(a[k]) * bf2f(b[k]);
            acc[ai][bj][m][n][e] = s;
        }
        E(acc, u, wr, wc, fr, fq);
    }
    __syncthreads();
}
#else
#define PG8_LAS __attribute__((address_space(3)))
template <class Epi>
__device__ __forceinline__ void gemm_phase(char* lds_, const Gemm g, const StaticOrder& S, const Epi& E) {
    PG8_LAS unsigned char* lds = (PG8_LAS unsigned char*)lds_;
    const int tid = fresh_tid(), wid = __builtin_amdgcn_readfirstlane(tid >> 6), lane = tid & 63, wr = wid >> 2, wc = wid & 3, fr = lane & 15, fq = lane >> 4;
    const int K = g.K, nt = K / BK;
    unsigned voffA[2], voffB[2];
#pragma unroll
    for (int i = 0; i < 2; ++i) { int R, C; stage_rc(tid * 16 + i * 8192, R, C); const int Rb = Epi::PERM ? ((R & ~31) + perm32(R & 31)) : R;
        voffA[i] = (unsigned)(R * K + C) * 2u; voffB[i] = (unsigned)(Rb * K + C) * 2u; }
    const size_t kstep = (size_t)(BK * 2);
    const size_t hstep = (size_t)HALF * K * 2;
    const size_t tstep = 2 * hstep;
    const unsigned ldsw = (unsigned)wid * 1024u;
    const int aoff = lds_byte(wr * 64 + fr, fq * 8), boff = lds_byte(wc * 32 + fr, fq * 8);
#define PG8_SA(b, h) (((b) * 2 + (h)) * HTB)
#define PG8_SB(b, h) ((4 + (b) * 2 + (h)) * HTB)
#define PG8_STAGE(bufoff, gbase, voff) do { _Pragma("unroll") for (int _i = 0; _i < 2; ++_i) \
        __builtin_amdgcn_global_load_lds((const unsigned*)((const char*)(gbase) + (voff)[_i]), (PG8_LAS unsigned*)(lds + (bufoff) + ldsw + _i * 8192), 16, 0, 0); } while (0)
#define PG8_LDA(dst, b, h) do { _Pragma("unroll") for (int m = 0; m < 4; ++m) _Pragma("unroll") for (int k = 0; k < 2; ++k) dst[m][k] = *(const PG8_LAS bf16x8*)(lds + PG8_SA(b, h) + aoff + m * 2048 + k * 1024); } while (0)
#define PG8_LDB(dst, b, h) do { _Pragma("unroll") for (int n = 0; n < 2; ++n) _Pragma("unroll") for (int k = 0; k < 2; ++k) dst[n][k] = *(const PG8_LAS bf16x8*)(lds + PG8_SB(b, h) + boff + n * 2048 + k * 1024); } while (0)
#define PG8_MMA(ai, bj, At, Bt) do { __builtin_amdgcn_s_setprio(1); _Pragma("unroll") for (int m = 0; m < 4; ++m) _Pragma("unroll") for (int n = 0; n < 2; ++n) _Pragma("unroll") for (int k = 0; k < 2; ++k) \
        acc[ai][bj][m][n] = __builtin_amdgcn_mfma_f32_16x16x32_bf16(Bt[n][k], At[m][k], acc[ai][bj][m][n], 0, 0, 0); __builtin_amdgcn_s_setprio(0); } while (0)
#define PG8_WAIT_V(n) asm volatile("s_waitcnt vmcnt(" #n ")" ::: "memory")
#define PG8_WAIT_L(n) asm volatile("s_waitcnt lgkmcnt(" #n ")" ::: "memory")
#define PG8_BAR __builtin_amdgcn_s_barrier()
#define PG8_SCHED __builtin_amdgcn_sched_barrier(0)
    Unit cur, nxt; int ui = 0;
    if (S.next(0, cur)) {
    f32x4 acc[2][2][4][2];
#pragma unroll
    for (int a = 0; a < 2; ++a)
#pragma unroll
        for (int b = 0; b < 2; ++b)
#pragma unroll
            for (int m = 0; m < 4; ++m)
#pragma unroll
                for (int n = 0; n < 2; ++n) acc[a][b][m][n] = (f32x4){0.f, 0.f, 0.f, 0.f};
    bf16x8 At[4][2], B0[2][2], B1[2][2];
    const char* cA = (const char*)g.A + (size_t)cur.pm * tstep; const char* cB = (const char*)g.Bt + (size_t)cur.pn * tstep;
    PG8_STAGE(PG8_SB(0, 0), cB, voffB); PG8_STAGE(PG8_SA(0, 0), cA, voffA); PG8_STAGE(PG8_SB(0, 1), cB + hstep, voffB); PG8_STAGE(PG8_SA(0, 1), cA + hstep, voffA);
    if (wr == 1) PG8_BAR;
    PG8_WAIT_V(4); PG8_BAR;
    PG8_STAGE(PG8_SB(1, 0), cB + kstep, voffB); PG8_STAGE(PG8_SA(1, 0), cA + kstep, voffA); PG8_STAGE(PG8_SB(1, 1), cB + hstep + kstep, voffB);
    PG8_WAIT_V(6); PG8_BAR;
    for (;;) {
        const bool has_next = S.next(ui + 1, nxt);
        const char* nA = has_next ? (const char*)g.A + (size_t)nxt.pm * tstep : cA; const char* nB = has_next ? (const char*)g.Bt + (size_t)nxt.pn * tstep : cB;
        for (int t = 0; t < nt; t += 2) {
            const bool last = (t == nt - 2);
            const char* a1 = cA + (size_t)(t + 1) * kstep;
            const char* a2 = last ? nA : cA + (size_t)(t + 2) * kstep; const char* b2 = last ? nB : cB + (size_t)(t + 2) * kstep;
            const char* a3 = a2 + kstep; const char* b3 = b2 + kstep;
            PG8_LDB(B0, 0, 0); PG8_SCHED; PG8_LDA(At, 0, 0); PG8_STAGE(PG8_SA(1, 1), a1 + hstep, voffA);
            PG8_WAIT_L(8); PG8_BAR; PG8_WAIT_L(0); PG8_MMA(0, 0, At, B0); PG8_BAR; PG8_SCHED;
            PG8_LDB(B1, 0, 1); PG8_STAGE(PG8_SB(0, 0), b2, voffB);
            PG8_BAR; PG8_WAIT_L(0); PG8_MMA(0, 1, At, B1); PG8_BAR;
            PG8_LDA(At, 0, 1); PG8_STAGE(PG8_SA(0, 0), a2, voffA);
            PG8_BAR; PG8_WAIT_L(0); PG8_MMA(1, 0, At, B0); PG8_BAR; PG8_SCHED;
            PG8_STAGE(PG8_SB(0, 1), b2 + hstep, voffB);
            PG8_WAIT_V(6); PG8_BAR; PG8_MMA(1, 1, At, B1); PG8_BAR;
            PG8_LDB(B0, 1, 0); PG8_SCHED; PG8_LDA(At, 1, 0); PG8_STAGE(PG8_SA(0, 1), a2 + hstep, voffA);
            PG8_WAIT_L(8); PG8_BAR; PG8_WAIT_L(0); PG8_MMA(0, 0, At, B0); PG8_BAR; PG8_SCHED;
            PG8_LDB(B1, 1, 1); PG8_STAGE(PG8_SB(1, 0), b3, voffB);
            PG8_BAR; PG8_WAIT_L(0); PG8_MMA(0, 1, At, B1); PG8_BAR;
            PG8_LDA(At, 1, 1); PG8_STAGE(PG8_SA(1, 0), a3, voffA);
            PG8_BAR; PG8_WAIT_L(0); PG8_MMA(1, 0, At, B0); PG8_BAR; PG8_SCHED;
            PG8_STAGE(PG8_SB(1, 1), b3 + hstep, voffB);
            PG8_WAIT_V(6); PG8_BAR; PG8_MMA(1, 1, At, B1); PG8_BAR;
        }
        E(acc, cur, wr, wc, fr, fq);
        if (!has_next) break;
#pragma unroll
        for (int a = 0; a < 2; ++a)
#pragma unroll
            for (int b = 0; b < 2; ++b)
#pragma unroll
                for (int m = 0; m < 4; ++m)
#pragma unroll
                    for (int n = 0; n < 2; ++n) acc[a][b][m][n] = (f32x4){0.f, 0.f, 0.f, 0.f};
        cur = nxt; cA = nA; cB = nB; ++ui;
    }
    PG8_WAIT_V(0);
    if (wr == 0) PG8_BAR;
    PG8_BAR;
    }
    __syncthreads();
#undef PG8_SA
#undef PG8_SB
#undef PG8_STAGE
#undef PG8_LDA
#undef PG8_LDB
#undef PG8_MMA
#undef PG8_WAIT_V
#undef PG8_WAIT_L
#undef PG8_BAR
#undef PG8_SCHED
}
#endif
}

constexpr int G_BM = 256, G_BN = 128, G_BK = 64;
constexpr int G_LDS_A = G_BM * G_BK * 2, G_LDS_B = G_BN * G_BK * 2;
constexpr int G_STAGE_PITCH = 132;
constexpr int G_LDS_BYTES = G_BM * G_STAGE_PITCH * 4;
constexpr int G_MT = SEQ / 256 + 1, G_NTILES = 56;

DI void gemm_inproj_tile(const Params& p, char* smem, int mt, int nt) {
    const int tid = fresh_tid(), lane = tid & 63, wave = tid >> 6;
    const int wm = wave >> 1, wn = wave & 1, r32 = lane & 31, h = lane >> 5;
    unsigned char* ws = p.ws;
    const bool meta = (mt == G_MT - 1);
    const bf16* A = meta ? (const bf16*)(ws + OFF_SMALL + SM_UMETA) : (const bf16*)(ws + OFF_U) + (size_t)mt * 256 * D;
    const int vrows = meta ? NMETA : 256;
    const bf16* Bt = (const bf16*)(ws + OFF_WTIN) + (size_t)nt * 128 * D;
    char* ldsA[2] = {smem, smem + G_LDS_A + G_LDS_B};
    char* ldsB[2] = {smem + G_LDS_A, smem + 2 * G_LDS_A + G_LDS_B};
    f32x16 acc[2][2];
#pragma unroll
    for (int i = 0; i < 2; ++i)
#pragma unroll
        for (int j = 0; j < 2; ++j) acc[i][j] = zero16();
    const int lrow = tid >> 3, lc = tid & 7;
    u32x4 ra[4], rb[2];
    auto gload = [&](int kt) {
#pragma unroll
        for (int i = 0; i < 4; ++i) { const int row = lrow + 64 * i; ra[i] = row < vrows ? *(const u32x4*)(A + (size_t)row * D + kt * 64 + lc * 8) : (u32x4){0u, 0u, 0u, 0u}; }
#pragma unroll
        for (int i = 0; i < 2; ++i) { const int row = lrow + 64 * i; rb[i] = *(const u32x4*)(Bt + (size_t)row * D + kt * 64 + lc * 8); }
    };
    auto lstore = [&](int buf) {
#pragma unroll
        for (int i = 0; i < 4; ++i) *(u32x4*)(ldsA[buf] + swz128(lrow + 64 * i, lc)) = ra[i];
#pragma unroll
        for (int i = 0; i < 2; ++i) *(u32x4*)(ldsB[buf] + swz128(lrow + 64 * i, lc)) = rb[i];
    };
    gload(0); lstore(0); __syncthreads();
    for (int kt = 0; kt < 16; ++kt) {
        const int buf = kt & 1;
        if (kt + 1 < 16) gload(kt + 1);
#pragma unroll
        for (int ks = 0; ks < 4; ++ks) {
            bf16x8 af[2], bfr[2];
#pragma unroll
            for (int i = 0; i < 2; ++i) af[i] = *(const bf16x8*)(ldsA[buf] + swz128(64 * wm + 32 * i + r32, 2 * ks + h));
#pragma unroll
            for (int j = 0; j < 2; ++j) bfr[j] = *(const bf16x8*)(ldsB[buf] + swz128(64 * wn + 32 * j + r32, 2 * ks + h));
#pragma unroll
            for (int i = 0; i < 2; ++i)
#pragma unroll
                for (int j = 0; j < 2; ++j) acc[i][j] = MFMA32(af[i], bfr[j], acc[i][j]);
        }
        if (kt + 1 < 16) lstore(buf ^ 1);
        __syncthreads();
    }
    float* st = (float*)smem;
#pragma unroll
    for (int i = 0; i < 2; ++i)
#pragma unroll
        for (int j = 0; j < 2; ++j)
#pragma unroll
            for (int r = 0; r < 16; ++r) {
                const int row = 64 * wm + 32 * i + (r & 3) + 8 * (r >> 2) + 4 * h, col = 64 * wn + 32 * j + r32;
                st[row * G_STAGE_PITCH + col] = acc[i][j][r];
            }
    __syncthreads();
    const int tid2 = fresh_tid();
    const int sec = nt >> 3, cb = (nt & 7) * 128;
    {
        bf16* base; bool has_meta = true; bf16* mbase = nullptr; int mrow0 = 0;
        if (sec == 0) { base = (bf16*)(ws + OFF_AQ); has_meta = false; }
        else if (sec == 1) { base = (bf16*)p.out; mbase = (bf16*)(ws + OFF_SMALL + SM_AKMETA); }
        else if (sec == 2) { base = (bf16*)p.out + (size_t)SEQ * D; mbase = (bf16*)(ws + OFF_SMALL + SM_AVTMETA); }
        else if (sec == 3) { base = (bf16*)(ws + OFF_QN); mbase = (bf16*)(ws + OFF_SMALL + SM_C0Q); mrow0 = 48; }
        else if (sec == 4) { base = (bf16*)(ws + OFF_KN); mbase = (bf16*)(ws + OFF_SMALL + SM_C0K); mrow0 = 48; }
        else if (sec == 5) { base = (bf16*)(ws + OFF_V); mbase = (bf16*)(ws + OFF_SMALL + SM_C0V); mrow0 = 48; }
        else { base = (bf16*)(ws + OFF_DG); has_meta = false; }
        const bool dqkv = (sec >= 3 && sec <= 5);
        bf16* tails = (bf16*)(ws + OFF_SMALL + SM_TAILS);
        if (!meta || has_meta) {
#pragma unroll
            for (int i = 0; i < 8; ++i) {
                const int idx = tid2 + NT * i, row = idx >> 4, cg = idx & 15;
                if (row < vrows) {
                    const float* s = st + row * G_STAGE_PITCH + cg * 8;
                    const f32x4 a = *(const f32x4*)s, b = *(const f32x4*)(s + 4);
                    u32x4 o; o.x = pk2(a[0], a[1]); o.y = pk2(a[2], a[3]); o.z = pk2(b[0], b[1]); o.w = pk2(b[2], b[3]);
                    if (!meta) {
                        const int j = mt * 256 + row;
                        *(u32x4*)(base + (size_t)j * D + cb + cg * 8) = o;
                        if (dqkv && (j & 63) >= 61) *(u32x4*)(tails + ((size_t)(j / 64 + 1) * 3 + ((j & 63) - 61)) * 3072 + (sec - 3) * 1024 + cb + cg * 8) = o;
                    } else {
                        *(u32x4*)(mbase + (size_t)(mrow0 + row) * D + cb + cg * 8) = o;
                        if (dqkv && row >= 13) *(u32x4*)(tails + ((size_t)0 * 3 + (row - 13)) * 3072 + (sec - 3) * 1024 + cb + cg * 8) = o;
                    }
                }
            }
        }
    }
    __syncthreads();
}

struct EpiInproj {
    static constexpr bool PERM = true;
    unsigned char* ws; bf16* out16;
    DM void operator()(const f32x4 (&acc)[2][2][4][2], const pg8::Unit& u, int wr, int wc, int fr, int fq) const {
        const int colt = u.pn * 256, sec = colt >> 10, cb = colt & 1023;
        bf16* base = sec == 0 ? (bf16*)(ws + OFF_AQ) : sec == 1 ? out16 : sec == 2 ? out16 + (size_t)SEQ * D : sec == 3 ? (bf16*)(ws + OFF_QN) : sec == 4 ? (bf16*)(ws + OFF_KN)
                   : sec == 5 ? (bf16*)(ws + OFF_V) : (bf16*)(ws + OFF_DG);
        const bool dqkv = sec >= 3 && sec <= 5;
        bf16* tails = (bf16*)(ws + OFF_SMALL + SM_TAILS) + (sec - 3) * 1024;
        const int row0 = u.pm * 256 + wr * 64 + fr, col0 = cb + wc * 32 + 8 * fq;
#pragma unroll
        for (int ai = 0; ai < 2; ++ai)
#pragma unroll
            for (int m = 0; m < 4; ++m) {
                const int j = row0 + ai * 128 + m * 16;
                bf16* rowp = base + (size_t)j * D + col0;
                const bool tl = dqkv && (j & 63) >= 61;
#pragma unroll
                for (int bj = 0; bj < 2; ++bj) {
                    const f32x4 v0 = acc[ai][bj][m][0], v1 = acc[ai][bj][m][1];
                    const u32x4 w = {pk2(v0[0], v0[1]), pk2(v0[2], v0[3]), pk2(v1[0], v1[1]), pk2(v1[2], v1[3])};
                    *(u32x4*)(rowp + bj * 128) = w;
                    if (tl) *(u32x4*)(tails + ((size_t)(j / 64 + 1) * 3 + ((j & 63) - 61)) * 3072 + col0 + bj * 128) = w;
                }
            }
    }
};
DI void phase1(const Params& p, char* smem, int bid, int nblk) {
    for (int it = bid; it < 40; it += nblk) gemm_inproj_tile(p, smem, G_MT - 1, 8 + it);
    pg8::Gemm g{(const bf16*)(p.ws + OFF_U), (const bf16*)(p.ws + OFF_WTIN), SEQ, 7168, 1024};
    pg8::StaticOrder S; S.init(SEQ, 7168, nblk, bid);
    EpiInproj E{p.ws, (bf16*)p.out};
    pg8::gemm_phase(smem, g, S, E);
}

constexpr int P2_KN = 0, P2_KB = 16384, P2_QN = 32768, P2_KBGT = 49152, P2_VBT = 65536, P2_KDT = 81920, P2_ALDS = 98304, P2_TLDS = P2_ALDS + 64 * 64 * 4,
              P2_GC = P2_TLDS + 8192, P2_BET = P2_GC + 256, P2_EG = P2_BET + 256, P2_EKD = P2_EG + 256;

DI void prep_item(const Params& p, char* smem, int chunk, int head, int dry) {
    const int tid = fresh_tid(), lane = tid & 63, wave = tid >> 6, r32 = lane & 31, h = lane >> 5;
    unsigned char* ws = p.ws;
    float* gcl = (float*)(smem + P2_GC); float* betl = (float*)(smem + P2_BET); float* egl = (float*)(smem + P2_EG); float* ekdl = (float*)(smem + P2_EKD);
    if (wave == 0) {
        const size_t pos = (size_t)chunk * 64 + lane;
        float v = ((const float*)(ws + OFF_SMALL + SM_G))[pos * 8 + head];
        const float b = ((const float*)(ws + OFF_SMALL + SM_BETA))[pos * 8 + head];
#pragma unroll
        for (int o = 1; o < 64; o <<= 1) { const float t = __shfl_up(v, o); if (lane >= o) v += t; }
        const float gl = __shfl(v, 63);
        gcl[lane] = v; betl[lane] = b; egl[lane] = __expf(v); ekdl[lane] = __expf(gl - v);
        if (!dry) ((float*)(ws + OFF_SMALL + SM_GC))[((size_t)chunk * 8 + head) * 64 + lane] = v;
    }
    __syncthreads();
    {
        const int r = tid >> 3, cg = tid & 7, col0 = head * 128 + 16 * cg;
        const bool zero_row = (chunk == 0 && r < 48);
        const float beta = betl[r], eg = egl[r], ekd = ekdl[r];
        const bf16* tails = (const bf16*)(ws + OFF_SMALL + SM_TAILS);
#pragma unroll 1
        for (int mat = 0; mat < 3; ++mat) {
            bf16* mainb = (bf16*)(ws + (mat == 0 ? OFF_QN : (mat == 1 ? OFF_KN : OFF_V)));
            bf16* c0b = (bf16*)(ws + OFF_SMALL + (mat == 0 ? SM_C0Q : (mat == 1 ? SM_C0K : SM_C0V)));
            float y[16];
#pragma unroll
            for (int c = 0; c < 16; ++c) y[c] = 0.f;
#pragma unroll
            for (int jj = 0; jj < 4; ++jj) {
                const int rr = r - 3 + jj;
                const bf16* src = nullptr;
                if (chunk == 0) { if (rr >= 48) src = c0b + (size_t)rr * D + col0; }
                else if (rr >= 0) src = mainb + ((size_t)(chunk - 1) * 64 + rr) * D + col0;
                else src = tails + ((size_t)(chunk - 1) * 3 + (3 + rr)) * 3072 + mat * 1024 + col0;
                u32x4 a = {0u, 0u, 0u, 0u}, b = {0u, 0u, 0u, 0u};
                if (src) { a = *(const u32x4*)src; b = *(const u32x4*)(src + 8); }
                const float* cw = p.in[9] + (size_t)jj * 3072 + mat * 1024 + col0;
                const f32x4 w0 = *(const f32x4*)cw, w1 = *(const f32x4*)(cw + 4), w2 = *(const f32x4*)(cw + 8), w3 = *(const f32x4*)(cw + 12);
                y[0] += w0[0] * bflo(a.x); y[1] += w0[1] * bfhi(a.x); y[2] += w0[2] * bflo(a.y); y[3] += w0[3] * bfhi(a.y);
                y[4] += w1[0] * bflo(a.z); y[5] += w1[1] * bfhi(a.z); y[6] += w1[2] * bflo(a.w); y[7] += w1[3] * bfhi(a.w);
                y[8] += w2[0] * bflo(b.x); y[9] += w2[1] * bfhi(b.x); y[10] += w2[2] * bflo(b.y); y[11] += w2[3] * bfhi(b.y);
                y[12] += w3[0] * bflo(b.z); y[13] += w3[1] * bfhi(b.z); y[14] += w3[2] * bflo(b.w); y[15] += w3[3] * bfhi(b.w);
            }
            __syncthreads();
            float ss = 0.f;
#pragma unroll
            for (int c = 0; c < 16; ++c) { y[c] = zero_row ? 0.f : siluf_(y[c]); ss += y[c] * y[c]; }
            if (mat < 2) {
                ss += __shfl_xor(ss, 1); ss += __shfl_xor(ss, 2); ss += __shfl_xor(ss, 4);
                const float sc = rsqrtf(ss + 1e-6f) * (mat == 0 ? 0.08838834764831845f : 1.0f);
                unsigned pk[8];
#pragma unroll
                for (int c = 0; c < 8; ++c) pk[c] = pk2(y[2 * c] * sc, y[2 * c + 1] * sc);
                if (mat == 0) {
                    *(u32x4*)(smem + P2_QN + swzrow(r, 256, 2 * cg)) = (u32x4){pk[0], pk[1], pk[2], pk[3]};
                    *(u32x4*)(smem + P2_QN + swzrow(r, 256, 2 * cg + 1)) = (u32x4){pk[4], pk[5], pk[6], pk[7]};
                    unsigned qd[8];
#pragma unroll
                    for (int c = 0; c < 8; ++c) qd[c] = pk2(bflo(pk[c]) * eg, bfhi(pk[c]) * eg);
                    bf16* dst = (chunk == 0) ? c0b + (size_t)r * D + col0 : mainb + ((size_t)(chunk - 1) * 64 + r) * D + col0;
                    if (!dry) { *(u32x4*)dst = (u32x4){qd[0], qd[1], qd[2], qd[3]}; *(u32x4*)(dst + 8) = (u32x4){qd[4], qd[5], qd[6], qd[7]}; }
                } else {
                    *(u32x4*)(smem + P2_KN + swzrow(r, 256, 2 * cg)) = (u32x4){pk[0], pk[1], pk[2], pk[3]};
                    *(u32x4*)(smem + P2_KN + swzrow(r, 256, 2 * cg + 1)) = (u32x4){pk[4], pk[5], pk[6], pk[7]};
                    unsigned kb[8];
#pragma unroll
                    for (int c = 0; c < 8; ++c) {
                        const float kr0 = bflo(pk[c]), kr1 = bfhi(pk[c]);
                        const float k0 = kr0 * beta, k1 = kr1 * beta;
                        kb[c] = pk2(k0, k1);
                        const int d0 = 16 * cg + 2 * c;
                        *(bf16*)(smem + P2_KBGT + swz128t(d0, r >> 3) + (r & 7) * 2) = (bf16)f2bf(k0 * eg);
                        *(bf16*)(smem + P2_KBGT + swz128t(d0 + 1, r >> 3) + (r & 7) * 2) = (bf16)f2bf(k1 * eg);
                        *(bf16*)(smem + P2_KDT + swz128t(d0, r >> 3) + (r & 7) * 2) = (bf16)f2bf(kr0 * ekd);
                        *(bf16*)(smem + P2_KDT + swz128t(d0 + 1, r >> 3) + (r & 7) * 2) = (bf16)f2bf(kr1 * ekd);
                    }
                    *(u32x4*)(smem + P2_KB + swzrow(r, 256, 2 * cg)) = (u32x4){kb[0], kb[1], kb[2], kb[3]};
                    *(u32x4*)(smem + P2_KB + swzrow(r, 256, 2 * cg + 1)) = (u32x4){kb[4], kb[5], kb[6], kb[7]};
                }
            } else {
#pragma unroll
                for (int c = 0; c < 16; ++c) {
                    const int e = 16 * cg + c;
                    *(bf16*)(smem + P2_VBT + swz128t(e, r >> 3) + (r & 7) * 2) = (bf16)f2bf(y[c] * beta);
                }
            }
        }
    }
    __syncthreads();
    {
        const int tile = wave & 3, m0 = tile >> 1, n0 = tile & 1;
        f32x16 acc = zero16();
        if (wave < 4) {
            if (n0 <= m0) {
#pragma unroll
                for (int ks = 0; ks < 8; ++ks) {
                    const bf16x8 a = *(const bf16x8*)(smem + P2_KB + swzrow(32 * m0 + r32, 256, 2 * ks + h));
                    const bf16x8 b = *(const bf16x8*)(smem + P2_KN + swzrow(32 * n0 + r32, 256, 2 * ks + h));
                    acc = MFMA32(a, b, acc);
                }
            }
            float* Al = (float*)(smem + P2_ALDS);
            const int j = 32 * n0 + r32; const float gj = gcl[j];
#pragma unroll
            for (int r = 0; r < 16; ++r) {
                const int i = 32 * m0 + (r & 3) + 8 * (r >> 2) + 4 * h;
                const float dv = acc[r] * __expf(gcl[i] - gj);
                Al[i * 64 + (j & 3) * 16 + (j >> 2)] = (j < i) ? dv : 0.f;
            }
        } else {
            if (m0 <= n0) {
#pragma unroll
                for (int ks = 0; ks < 8; ++ks) {
                    const bf16x8 a = *(const bf16x8*)(smem + P2_KN + swzrow(32 * m0 + r32, 256, 2 * ks + h));
                    const bf16x8 b = *(const bf16x8*)(smem + P2_QN + swzrow(32 * n0 + r32, 256, 2 * ks + h));
                    acc = MFMA32(a, b, acc);
                }
            }
            const int i = 32 * n0 + r32; const float gi = gcl[i];
            bf16* qkb = (chunk == 0) ? (bf16*)(ws + OFF_SMALL + SM_C0QK) + (size_t)head * 4096 : (bf16*)(ws + OFF_QKB) + ((size_t)(chunk - 1) * 8 + head) * 4096;
#pragma unroll
            for (int q4 = 0; q4 < 4; ++q4) {
                const int j0 = 32 * m0 + 8 * q4 + 4 * h; float v[4];
#pragma unroll
                for (int c = 0; c < 4; ++c) { const int j = j0 + c; const float dv = acc[4 * q4 + c] * __expf(gi - gcl[j]); v[c] = (j <= i) ? dv : 0.f; }
                if (!dry) *(u32x2*)(qkb + i * 64 + j0) = (u32x2){pk2(v[0], v[1]), pk2(v[2], v[3])};
            }
        }
        bf16* kbase = (chunk == 0) ? (bf16*)(ws + OFF_SMALL + SM_C0K) : (bf16*)(ws + OFF_KN) + (size_t)(chunk - 1) * 64 * D;
#pragma unroll
        for (int i2 = 0; i2 < 2; ++i2) {
            const int idx = tid + NT * i2, dk = idx >> 3, ch = idx & 7;
            const u32x4 v = *(const u32x4*)(smem + P2_KDT + swz128t(dk, ch));
            if (!dry) *(u32x4*)(kbase + (size_t)(dk >> 1) * D + head * 128 + (dk & 1) * 64 + ch * 8) = v;
        }
    }
    __syncthreads();
    if (wave < 4) {
        const float* Al = (const float*)(smem + P2_ALDS);
        const int c = lane >> 2, q = lane & 3, C = 16 * wave + c;
        float tq[16];
#pragma unroll
        for (int m = 0; m < 16; ++m) tq[m] = 0.f;
#pragma unroll
        for (int i = 0; i < 64; ++i) {
            constexpr int dummy = 0; (void)dummy;
            const int nm = (i + 3) >> 2;
            float s0 = 0.f, s1 = 0.f;
            const float* ar = Al + i * 64 + q * 16;
#pragma unroll
            for (int m = 0; m < 16; ++m) if (m < nm) { if (m & 1) s1 += ar[m] * tq[m]; else s0 += ar[m] * tq[m]; }
            float s = s0 + s1;
            s += __shfl_xor(s, 1); s += __shfl_xor(s, 2);
            const float ti = ((i == C) ? 1.f : 0.f) - s;
            if (q == (i & 3)) tq[i >> 2] = ti;
        }
#pragma unroll
        for (int m = 0; m < 16; ++m) { const int row = 4 * m + q; *(bf16*)(smem + P2_TLDS + swz128(row, C >> 3) + (C & 7) * 2) = (bf16)f2bf(tq[m]); }
    }
    __syncthreads();
    {
        const int mi = wave >> 2, ni = wave & 3;
        f32x16 acc = zero16();
#pragma unroll
        for (int ks = 0; ks < 4; ++ks) {
            const bf16x8 a = *(const bf16x8*)(smem + P2_TLDS + swz128(32 * mi + r32, 2 * ks + h));
            const bf16x8 b = *(const bf16x8*)(smem + P2_VBT + swz128t(32 * ni + r32, 2 * ks + h));
            acc = MFMA32(a, b, acc);
        }
        const int e = 32 * ni + r32;
        bf16* base = (chunk == 0) ? (bf16*)(ws + OFF_SMALL + SM_C0V) : (bf16*)(ws + OFF_V) + (size_t)(chunk - 1) * 64 * D;
        bf16* dst = base + (size_t)(e >> 1) * D + head * 128 + (e & 1) * 64;
#pragma unroll
        for (int q4 = 0; q4 < 4; ++q4) {
            const int c0 = 32 * mi + 8 * q4 + 4 * h;
            if (!dry) *(u32x2*)(dst + c0) = (u32x2){pk2(acc[4 * q4], acc[4 * q4 + 1]), pk2(acc[4 * q4 + 2], acc[4 * q4 + 3])};
        }
    }
    {
        const int mi = wave >> 1, ni = wave & 1;
        f32x16 acc = zero16();
#pragma unroll
        for (int ks = 0; ks < 4; ++ks) {
            const bf16x8 a = *(const bf16x8*)(smem + P2_KBGT + swz128t(32 * mi + r32, 2 * ks + h));
            const bf16x8 b = *(const bf16x8*)(smem + P2_TLDS + swz128(32 * ni + r32, 2 * ks + h));
            acc = MFMA32(a, b, acc);
        }
        const int c = 32 * ni + r32;
        bf16* wb = (chunk == 0) ? (bf16*)(ws + OFF_SMALL + SM_C0W) + (size_t)head * 8192 : (bf16*)(ws + OFF_W) + ((size_t)(chunk - 1) * 8 + head) * 8192;
#pragma unroll
        for (int q4 = 0; q4 < 4; ++q4) {
            const int dk0 = 32 * mi + 8 * q4 + 4 * h;
            if (!dry) *(u32x2*)(wb + c * 128 + dk0) = (u32x2){pk2(acc[4 * q4], acc[4 * q4 + 1]), pk2(acc[4 * q4 + 2], acc[4 * q4 + 3])};
        }
    }
    __syncthreads();
}

DI void phase2(const Params& p, char* smem, int bid, int nblk, int dry = 0) {
    for (int it = bid; it < NCH * 8; it += nblk) prep_item(p, smem, it >> 3, it & 7, dry);
    {
        const int tid = fresh_tid(), lane = tid & 63, wave = tid >> 6;
        const int gw = bid * 8 + wave, NGW = nblk * 8;
        float mq = 0.f, mk = 0.f;
        for (int j = gw; j < SEQ + NMETA; j += NGW) {
            const bf16* kr = j < SEQ ? (const bf16*)p.out + (size_t)j * D + lane * 16 : (const bf16*)(p.ws + OFF_SMALL + SM_AKMETA) + (size_t)(j - SEQ) * D + lane * 16;
            const u32x4 a = *(const u32x4*)kr, b = *(const u32x4*)(kr + 8);
            float s = bflo(a.x) * bflo(a.x) + bfhi(a.x) * bfhi(a.x) + bflo(a.y) * bflo(a.y) + bfhi(a.y) * bfhi(a.y) + bflo(a.z) * bflo(a.z) + bfhi(a.z) * bfhi(a.z) + bflo(a.w) * bflo(a.w) + bfhi(a.w) * bfhi(a.w)
                    + bflo(b.x) * bflo(b.x) + bfhi(b.x) * bfhi(b.x) + bflo(b.y) * bflo(b.y) + bfhi(b.y) * bfhi(b.y) + bflo(b.z) * bflo(b.z) + bfhi(b.z) * bfhi(b.z) + bflo(b.w) * bflo(b.w) + bfhi(b.w) * bfhi(b.w);
            s += __shfl_xor(s, 1); s += __shfl_xor(s, 2);
            mk = fmaxf(mk, s);
            if (j < SEQ) {
                const bf16* qr = (const bf16*)(p.ws + OFF_AQ) + (size_t)j * D + lane * 16;
                const u32x4 c = *(const u32x4*)qr, d = *(const u32x4*)(qr + 8);
                float t = bflo(c.x) * bflo(c.x) + bfhi(c.x) * bfhi(c.x) + bflo(c.y) * bflo(c.y) + bfhi(c.y) * bfhi(c.y) + bflo(c.z) * bflo(c.z) + bfhi(c.z) * bfhi(c.z) + bflo(c.w) * bflo(c.w) + bfhi(c.w) * bfhi(c.w)
                        + bflo(d.x) * bflo(d.x) + bfhi(d.x) * bfhi(d.x) + bflo(d.y) * bflo(d.y) + bfhi(d.y) * bfhi(d.y) + bflo(d.z) * bflo(d.z) + bfhi(d.z) * bfhi(d.z) + bflo(d.w) * bflo(d.w) + bfhi(d.w) * bfhi(d.w);
                t += __shfl_xor(t, 1); t += __shfl_xor(t, 2);
                mq = fmaxf(mq, t);
            }
        }
        if ((lane & 3) == 0) {
            unsigned* nrm = (unsigned*)(p.ws + OFF_SMALL + SM_CTL) + CW_NRM;
            atomicMax(nrm + (lane >> 2), __builtin_bit_cast(unsigned, mq));
            atomicMax(nrm + 16 + (lane >> 2), __builtin_bit_cast(unsigned, mk));
        }
    }
}

DI int swzrow8(int row, int pitch, int s) { return row * pitch + ((((s >> 1) ^ (row & 15)) << 4) | ((s & 1) << 3)); }
DI bf16x8 pack8(f32x4 a, f32x4 b) {
    u32x4 o; o.x = pk2(a[0], a[1]); o.y = pk2(a[2], a[3]); o.z = pk2(b[0], b[1]); o.w = pk2(b[2], b[3]);
    return __builtin_bit_cast(bf16x8, o);
}
DI bf16x8 ld2x8(const char* p0, const char* p1) {
    const u32x2 a = *(const u32x2*)p0, b = *(const u32x2*)p1; u32x4 o; o.x = a.x; o.y = a.y; o.z = b.x; o.w = b.y;
    return __builtin_bit_cast(bf16x8, o);
}
constexpr int SC_W = 0, SC_QD = 16384, SC_KDT = 32768, SC_QK = 49152, SC_BUF = 57344;

constexpr int SCAN_SPLIT = 4;
DI void scan_head(const Params& p, char* smem, int head, int sidx, int dry) {
    const int tid = fresh_tid(), lane = tid & 63, wave = tid >> 6, r16 = lane & 15, g = lane >> 4;
    const bool active = wave < 8 / SCAN_SPLIT; const int slice = sidx * (8 / SCAN_SPLIT) + (active ? wave : 0);
    unsigned char* ws = p.ws;
    const int lrow = tid >> 3, lch = (tid & 7) * 2;
    f32x4 S[8];
#pragma unroll
    for (int i = 0; i < 8; ++i) S[i] = zero4();
    u32x4 rw[2], rq[2], rk[2], rqk; u32x2 unext[4], ucur[4]; float gnext = 0.f, gcur = 0.f;
    auto uaddr = [&](int n, int mt) -> bf16* {
        const int e = 16 * slice + r16;
        bf16* base = n == 0 ? (bf16*)(ws + OFF_SMALL + SM_C0V) : (bf16*)(ws + OFF_V) + (size_t)(n - 1) * 64 * D;
        return base + (size_t)(e >> 1) * D + head * 128 + (e & 1) * 64 + 16 * mt + 4 * g;
    };
    auto gloadA = [&](int n) {
        const bf16* wsrc = (n == 0 ? (const bf16*)(ws + OFF_SMALL + SM_C0W) + (size_t)head * 8192 : (const bf16*)(ws + OFF_W) + ((size_t)(n - 1) * 8 + head) * 8192) + lrow * 128 + lch * 8;
        rw[0] = *(const u32x4*)wsrc; rw[1] = *(const u32x4*)(wsrc + 8);
        const bf16* qs = (n == 0 ? (const bf16*)(ws + OFF_SMALL + SM_C0Q) : (const bf16*)(ws + OFF_QN) + (size_t)(n - 1) * 64 * D) + (size_t)lrow * D + head * 128 + lch * 8;
        rq[0] = *(const u32x4*)qs; rq[1] = *(const u32x4*)(qs + 8);
        const bf16* ks = (n == 0 ? (const bf16*)(ws + OFF_SMALL + SM_C0K) : (const bf16*)(ws + OFF_KN) + (size_t)(n - 1) * 64 * D) + (size_t)lrow * D + head * 128 + lch * 8;
        rk[0] = *(const u32x4*)ks; rk[1] = *(const u32x4*)(ks + 8);
        const bf16* qk = (n == 0 ? (const bf16*)(ws + OFF_SMALL + SM_C0QK) + (size_t)head * 4096 : (const bf16*)(ws + OFF_QKB) + ((size_t)(n - 1) * 8 + head) * 4096) + tid * 8;
        rqk = *(const u32x4*)qk;
    };
    auto gloadU = [&](int n) {
#pragma unroll
        for (int mt = 0; mt < 4; ++mt) unext[mt] = *(const u32x2*)uaddr(n, mt);
        gnext = ((const float*)(ws + OFF_SMALL + SM_GC))[((size_t)n * 8 + head) * 64 + 63];
    };
    auto lwrite = [&](int buf) {
        char* b = smem + buf * SC_BUF;
        const int c7 = tid & 7, kb = c7 >> 1, hf = c7 & 1;
        {
            char* w = b + SC_W + lrow * 256 + hf * 8; char* q = b + SC_QD + lrow * 256 + hf * 8; const int x = lrow & 15;
            *(u32x2*)(w + (((4 * kb + 0) ^ x) << 4)) = (u32x2){rw[0].x, rw[0].y}; *(u32x2*)(w + (((4 * kb + 1) ^ x) << 4)) = (u32x2){rw[0].z, rw[0].w};
            *(u32x2*)(w + (((4 * kb + 2) ^ x) << 4)) = (u32x2){rw[1].x, rw[1].y}; *(u32x2*)(w + (((4 * kb + 3) ^ x) << 4)) = (u32x2){rw[1].z, rw[1].w};
            *(u32x2*)(q + (((4 * kb + 0) ^ x) << 4)) = (u32x2){rq[0].x, rq[0].y}; *(u32x2*)(q + (((4 * kb + 1) ^ x) << 4)) = (u32x2){rq[0].z, rq[0].w};
            *(u32x2*)(q + (((4 * kb + 2) ^ x) << 4)) = (u32x2){rq[1].x, rq[1].y}; *(u32x2*)(q + (((4 * kb + 3) ^ x) << 4)) = (u32x2){rq[1].z, rq[1].w};
        }
        {
            const int dk = 2 * lrow + (c7 >> 2), kb2 = (c7 & 3) >> 1, x = (dk >> 1) & 7;
            char* kt = b + SC_KDT + dk * 128 + hf * 8;
            *(u32x2*)(kt + (((4 * kb2 + 0) ^ x) << 4)) = (u32x2){rk[0].x, rk[0].y}; *(u32x2*)(kt + (((4 * kb2 + 1) ^ x) << 4)) = (u32x2){rk[0].z, rk[0].w};
            *(u32x2*)(kt + (((4 * kb2 + 2) ^ x) << 4)) = (u32x2){rk[1].x, rk[1].y}; *(u32x2*)(kt + (((4 * kb2 + 3) ^ x) << 4)) = (u32x2){rk[1].z, rk[1].w};
        }
        {
            const int row = tid >> 3, kb2 = c7 >> 2, g0 = 2 * (c7 & 1), hf2 = (c7 >> 1) & 1, x = (row >> 1) & 7;
            char* qk = b + SC_QK + row * 128 + hf2 * 8;
            *(u32x2*)(qk + (((4 * kb2 + g0) ^ x) << 4)) = (u32x2){rqk.x, rqk.y}; *(u32x2*)(qk + (((4 * kb2 + g0 + 1) ^ x) << 4)) = (u32x2){rqk.z, rqk.w};
        }
    };
    gloadA(0); gloadU(0);
    lwrite(0);
#pragma unroll
    for (int mt = 0; mt < 4; ++mt) ucur[mt] = unext[mt];
    gcur = gnext;
    if (NCH > 1) gloadA(1);
    __syncthreads();
    for (int n = 0; n < NCH; ++n) {
        const char* b = smem + (n & 1) * SC_BUF;
        if (n + 1 < NCH) { lwrite((n + 1) & 1); gloadU(n + 1); }
        if (n + 2 < NCH) gloadA(n + 2);
        if (active) {
        const float gtot = __expf(gcur);
        bf16x8 sf[4];
#pragma unroll
        for (int kb = 0; kb < 4; ++kb) sf[kb] = pack8(S[2 * kb], S[2 * kb + 1]);
        f32x4 Vn[4], O[4];
#pragma unroll
        for (int mt = 0; mt < 4; ++mt) {
            f32x4 P = zero4(), Q = zero4();
            const int row = 16 * mt + r16;
#pragma unroll
            for (int kb = 0; kb < 4; ++kb) {
                const bf16x8 wf = *(const bf16x8*)(b + SC_W + swzrow(row, 256, 4 * kb + g));
                const bf16x8 qf = *(const bf16x8*)(b + SC_QD + swzrow(row, 256, 4 * kb + g));
                P = MFMA16(wf, sf[kb], P);
                Q = MFMA16(qf, sf[kb], Q);
            }
            const float u0 = bflo(ucur[mt].x), u1 = bfhi(ucur[mt].x), u2 = bflo(ucur[mt].y), u3 = bfhi(ucur[mt].y);
            Vn[mt] = (f32x4){u0 - P[0], u1 - P[1], u2 - P[2], u3 - P[3]};
            O[mt] = Q;
        }
        const bf16x8 vf[2] = {pack8(Vn[0], Vn[1]), pack8(Vn[2], Vn[3])};
#pragma unroll
        for (int mt = 0; mt < 8; ++mt) {
            const int row = 16 * mt + r16;
            f32x4 acc = S[mt] * gtot;
#pragma unroll
            for (int kb = 0; kb < 2; ++kb) {
                const bf16x8 kf = *(const bf16x8*)(b + SC_KDT + swz128(row, 4 * kb + g));
                acc = MFMA16(kf, vf[kb], acc);
            }
            S[mt] = acc;
        }
#pragma unroll
        for (int mt = 0; mt < 4; ++mt) {
            const int row = 16 * mt + r16;
#pragma unroll
            for (int kb = 0; kb < 2; ++kb) {
                const bf16x8 qk = *(const bf16x8*)(b + SC_QK + swz128(row, 4 * kb + g));
                O[mt] = MFMA16(qk, vf[kb], O[mt]);
            }
            if (n >= 1 && !dry) *(u32x2*)uaddr(n, mt) = (u32x2){pk2(O[mt][0], O[mt][1]), pk2(O[mt][2], O[mt][3])};
        }
        }
#pragma unroll
        for (int mt = 0; mt < 4; ++mt) ucur[mt] = unext[mt];
        gcur = gnext;
        __syncthreads();
    }
}

constexpr int AT_BUF = 32768, AT_MISC = 65536, NQB = SEQ / 128, AT_UNITS = 8 * NQB;
DI int vt_off8(int e, int s) { return e * 128 + ((s ^ ((e >> 1) & 15)) << 3); }

DI void attention_unit(const Params& p, char* smem, int head, int qb, float lam, int dry, float bound) {
    const int tid = fresh_tid(), lane = tid & 63, wave = tid >> 6, r32 = lane & 31, h = lane >> 5;
    const int wq = wave & 3, mp = wave >> 2;
    unsigned char* ws = p.ws;
    const bf16* AK = (const bf16*)p.out; const bf16* AVT = (const bf16*)p.out + (size_t)SEQ * D;
    const int q0 = 128 * qb, qpos = q0 + 32 * wq + r32;
    const float c1 = 0.125f * LOG2E, c2 = exp2f(-(float)(head + 1)) * LOG2E;
    bf16x8 Qf[4];
    {
        const bf16* qsrc = (const bf16*)(ws + OFF_AQ) + (size_t)qpos * D + head * 128 + mp * 64 + 8 * h;
#pragma unroll
        for (int ks = 0; ks < 4; ++ks) {
            const u32x4 v = *(const u32x4*)(qsrc + 16 * ks); u32x4 o;
            o.x = pk2(bflo(v.x) * c1, bfhi(v.x) * c1); o.y = pk2(bflo(v.y) * c1, bfhi(v.y) * c1); o.z = pk2(bflo(v.z) * c1, bfhi(v.z) * c1); o.w = pk2(bflo(v.w) * c1, bfhi(v.w) * c1);
            Qf[ks] = __builtin_bit_cast(bf16x8, o);
        }
    }
    f32x16 O[4];
#pragma unroll
    for (int i = 0; i < 4; ++i) O[i] = zero16();
    float m_run = 0.f, l_run = 0.f; bool first = true;
    const float wdist = (150.0f + 2.0f * bound) / c2;
    int ntiles = 2 * qb + 3;
    {
        const float lim = (float)q0 - 63.0f - wdist;
        int ktmin = 0;
        if (lim > 0.f) ktmin = (int)(lim * (1.0f / 64.0f));
        const bool keep_meta = !((float)(q0 + NMETA - 15) > wdist);
        if (ktmin > 0 || !keep_meta) ntiles = (2 * qb + 1 - ktmin + 1) + (keep_meta ? 1 : 0);
    }
    const int nreal = (ntiles == 2 * qb + 3) ? 2 * qb + 2 : ntiles;
    const int kkey = tid >> 3, kcc = (tid & 7) * 2;
    const int va = tid >> 5, vb4 = tid & 31;
    u32x4 rk[2]; u32x2 rv[4];
    auto tile_kt = [&](int it) -> int { return it < nreal ? 2 * qb + 1 - it : -1; };
    auto gload = [&](int it) {
        const int kt = tile_kt(it);
        if (kt >= 0) {
            const bf16* ks = AK + ((size_t)kt * 64 + kkey) * D + head * 128 + kcc * 8;
            rk[0] = *(const u32x4*)ks; rk[1] = *(const u32x4*)(ks + 8);
            const bf16* vs = AVT + ((size_t)kt * 64 + 4 * va) * D + head * 128 + 4 * vb4;
#pragma unroll
            for (int i = 0; i < 4; ++i) rv[i] = *(const u32x2*)(vs + (size_t)i * D);
        } else {
            rk[0] = rk[1] = (u32x4){0u, 0u, 0u, 0u};
#pragma unroll
            for (int i = 0; i < 4; ++i) rv[i] = (u32x2){0u, 0u};
            if (kkey < NMETA) { const bf16* ks = (const bf16*)(ws + OFF_SMALL + SM_AKMETA) + (size_t)kkey * D + head * 128 + kcc * 8; rk[0] = *(const u32x4*)ks; rk[1] = *(const u32x4*)(ks + 8); }
            if (va < NMETA / 4) { const bf16* vs = (const bf16*)(ws + OFF_SMALL + SM_AVTMETA) + (size_t)(4 * va) * D + head * 128 + 4 * vb4;
#pragma unroll
                for (int i = 0; i < 4; ++i) rv[i] = *(const u32x2*)(vs + (size_t)i * D); }
        }
    };
    auto lwrite = [&](int buf) {
        char* kb = smem + buf * AT_BUF + (kcc >> 3) * 8192;
        *(u32x4*)(kb + swz128(kkey, kcc & 7)) = rk[0]; *(u32x4*)(kb + swz128(kkey, (kcc & 7) + 1)) = rk[1];
        const unsigned t0x = (rv[0].x & 0xffffu) | (rv[1].x << 16), t1x = (rv[0].x >> 16) | (rv[1].x & 0xffff0000u), t0y = (rv[2].x & 0xffffu) | (rv[3].x << 16), t1y = (rv[2].x >> 16) | (rv[3].x & 0xffff0000u);
        const unsigned t2x = (rv[0].y & 0xffffu) | (rv[1].y << 16), t3x = (rv[0].y >> 16) | (rv[1].y & 0xffff0000u), t2y = (rv[2].y & 0xffffu) | (rv[3].y << 16), t3y = (rv[2].y >> 16) | (rv[3].y & 0xffff0000u);
        const int sub = va >> 3, a = va & 7, a2 = (a & 4) | ((a & 1) << 1) | ((a >> 1) & 1);
        char* vbase = smem + buf * AT_BUF + 16384 + (a2 & 1) * 8;
        const int s16 = 4 * sub + (a2 >> 1), e0 = 4 * vb4;
        *(u32x2*)(vbase + (e0 + 0) * 128 + ((s16 ^ (((e0 + 0) >> 1) & 7)) << 4)) = (u32x2){t0x, t0y};
        *(u32x2*)(vbase + (e0 + 1) * 128 + ((s16 ^ (((e0 + 1) >> 1) & 7)) << 4)) = (u32x2){t1x, t1y};
        *(u32x2*)(vbase + (e0 + 2) * 128 + ((s16 ^ (((e0 + 2) >> 1) & 7)) << 4)) = (u32x2){t2x, t2y};
        *(u32x2*)(vbase + (e0 + 3) * 128 + ((s16 ^ (((e0 + 3) >> 1) & 7)) << 4)) = (u32x2){t3x, t3y};
    };
    auto tile_body = [&](auto mode_tag, int buf, int kdist0, int klim) {
        constexpr bool MASKED = decltype(mode_tag)::value;
        const char* kb = smem + buf * AT_BUF + mp * 8192;
        const char* vb = smem + buf * AT_BUF + 16384;
        f32x16 s[2];
        float mx = -3.0e38f;
        const float mref = first ? 0.f : m_run;
#pragma unroll
        for (int sub = 0; sub < 2; ++sub) {
            f32x16 acc;
            const float base = -c2 * (float)(kdist0 - 32 * sub - 4 * h) - mref;
#pragma unroll
            for (int r = 0; r < 16; ++r) acc[r] = base + c2 * (float)((r & 3) + 8 * (r >> 2));
#pragma unroll
            for (int ks = 0; ks < 4; ++ks) {
                const bf16x8 a = *(const bf16x8*)(kb + swz128(32 * sub + r32, 2 * ks + h));
                acc = MFMA32(a, Qf[ks], acc);
            }
            if (MASKED) {
#pragma unroll
                for (int r = 0; r < 16; ++r) { const int key = 32 * sub + (r & 3) + 8 * (r >> 2) + 4 * h; if (key > klim) acc[r] = -1e30f; }
            }
#pragma unroll
            for (int r = 0; r < 16; ++r) mx = fmaxf(mx, acc[r]);
            s[sub] = acc;
        }
        mx = fmaxf(mx, xhalf(mx));
        const float dlt = first ? mx : fmaxf(mx, 0.f);
        m_run = mref + dlt;
        first = false;
        if (wave_any(dlt != 0.f)) {
            const float alpha = EXP2F(-dlt);
#pragma unroll
            for (int sub = 0; sub < 2; ++sub)
#pragma unroll
                for (int r = 0; r < 16; ++r) s[sub][r] -= dlt;
            l_run *= alpha;
#pragma unroll
            for (int et = 0; et < 4; ++et) O[et] = O[et] * alpha;
        }
        float ls = 0.f;
#pragma unroll
        for (int sub = 0; sub < 2; ++sub)
#pragma unroll
            for (int r = 0; r < 16; ++r) { const float pv = EXP2F(s[sub][r]); s[sub][r] = pv; ls += pv; }
        l_run += ls;
        bf16x8 Pf[2][2];
#pragma unroll
        for (int sub = 0; sub < 2; ++sub)
#pragma unroll
            for (int ss = 0; ss < 2; ++ss) {
                u32x4 o; o.x = pk2(s[sub][8 * ss], s[sub][8 * ss + 1]); o.y = pk2(s[sub][8 * ss + 2], s[sub][8 * ss + 3]);
                o.z = pk2(s[sub][8 * ss + 4], s[sub][8 * ss + 5]); o.w = pk2(s[sub][8 * ss + 6], s[sub][8 * ss + 7]);
                Pf[sub][ss] = __builtin_bit_cast(bf16x8, o);
            }
#pragma unroll
        for (int et = 0; et < 4; ++et) {
            const int e = 32 * et + r32;
#pragma unroll
            for (int sub = 0; sub < 2; ++sub)
#pragma unroll
                for (int ss = 0; ss < 2; ++ss) {
                    const bf16x8 a = *(const bf16x8*)(vb + swz128(e, 4 * sub + 2 * ss + h));
                    O[et] = MFMA32(a, Pf[sub][ss], O[et]);
                }
            SCHED_FENCE();
        }
    };
    gload(0); lwrite(0); __syncthreads();
    for (int it = 0; it < ntiles; ++it) {
        const int buf = it & 1, kt = tile_kt(it);
        if (it + 1 < ntiles) gload(it + 1);
        const int k0 = kt * 64;
        if (kt >= 0 && k0 > q0 + 32 * wq + 31) {   }
        else if (kt >= 0 && k0 + 63 <= q0 + 32 * wq) tile_body(std::false_type{}, buf, qpos - k0, 0);
        else tile_body(std::true_type{}, buf, kt < 0 ? NMETA + qpos : qpos - k0, kt < 0 ? NMETA - 1 : qpos - k0);
        if (it + 1 < ntiles) lwrite(buf ^ 1);
        __syncthreads();
    }
    {
        const int tid = fresh_tid(), lane = tid & 63, wave = tid >> 6, r32 = lane & 31, h = lane >> 5, wq = wave & 3, mp = wave >> 2;
        const int qpos = 128 * qb + 32 * wq + r32;
        const float lt = l_run + xhalf(l_run);
        const float inv = 1.0f / lt;
        float* X = (float*)smem;
        if (mp == 1) {
#pragma unroll
            for (int et = 0; et < 4; ++et)
#pragma unroll
                for (int r = 0; r < 16; ++r) { const int e = 32 * et + (r & 3) + 8 * (r >> 2) + 4 * h; X[(wq * 128 + e) * 32 + r32] = O[et][r] * inv; }
        }
        __syncthreads();
        if (mp == 0) {
            float ssq = 0.f;
#pragma unroll
            for (int et = 0; et < 4; ++et)
#pragma unroll
                for (int r = 0; r < 16; ++r) { const int e = 32 * et + (r & 3) + 8 * (r >> 2) + 4 * h; const float d = O[et][r] * inv - lam * X[(wq * 128 + e) * 32 + r32]; O[et][r] = d; ssq += d * d; }
            ssq += xhalf(ssq);
            const float rstd = rsqrtf(ssq * (1.0f / 128.0f) + NORM_EPS) * 0.8f;
            bf16* dst = (bf16*)(ws + OFF_AQ) + (size_t)qpos * D + head * 128;
            const float* sw = p.in[8];
#pragma unroll
            for (int et = 0; et < 4; ++et)
#pragma unroll
                for (int q4 = 0; q4 < 4; ++q4) {
                    const int e0 = 32 * et + 8 * q4 + 4 * h;
                    const f32x4 w4 = *(const f32x4*)(sw + e0);
                    if (!dry) *(u32x2*)(dst + e0) = (u32x2){pk2(O[et][4 * q4] * rstd * w4[0], O[et][4 * q4 + 1] * rstd * w4[1]), pk2(O[et][4 * q4 + 2] * rstd * w4[2], O[et][4 * q4 + 3] * rstd * w4[3])};
                }
        }
        __syncthreads();
    }
}

DI void phase3(const Params& p, char* smem, int bid, int nblk, int dry = 0, int mode = 3) {
    if (mode & 1) for (int it = bid; it < 8 * SCAN_SPLIT; it += nblk) scan_head(p, smem, it / SCAN_SPLIT, it % SCAN_SPLIT, dry);
    if (!(mode & 2)) return;
    float d1 = 0.f, d2 = 0.f;
    for (int i = 0; i < 64; ++i) { d1 += p.in[4][i] * p.in[5][i]; d2 += p.in[6][i] * p.in[7][i]; }
    const float lam = __expf(d1) - __expf(d2) + 0.2f;
    unsigned* q = (unsigned*)(p.ws + OFF_SMALL + SM_CTL) + CW_ATTQ + (dry ? 16 : 0);
    for (;;) {
        if (threadIdx.x == 0) *(unsigned*)(smem + AT_MISC) = atomicAdd(q, 1u);
        __syncthreads();
        const unsigned u = *(unsigned*)(smem + AT_MISC);
        __syncthreads();
        if (u >= (unsigned)AT_UNITS) break;
        const int hd = (int)(u & 7u);
        const unsigned* nrm = (const unsigned*)(p.ws + OFF_SMALL + SM_CTL) + CW_NRM;
        float bnd = 0.f;
        for (int m2 = 0; m2 < 2; ++m2) {
            const float q2 = __builtin_bit_cast(float, LD_ATOMIC(nrm + 2 * hd + m2)), k2 = __builtin_bit_cast(float, LD_ATOMIC(nrm + 16 + 2 * hd + m2));
            bnd = fmaxf(bnd, sqrtf(q2 * k2) * (0.125f * LOG2E) * 1.02f);
        }
        attention_unit(p, smem, hd, NQB - 1 - (int)(u >> 3), lam, dry, bnd);
    }
}

DI void phase4(const Params& p, char* smem, int bid, int nblk) {
    const int tid = fresh_tid(), lane = tid & 63, wave = tid >> 6;
    const int gw = bid * 8 + wave, NGW = nblk * 8;
    unsigned char* ws = p.ws;
    char* wl = smem + wave * 16384;
    for (int it = gw; it < 32 * 384; it += NGW) {
        const int e = it / 384, r = it % 384, m = r >> 7, q = r & 127;
        if (m < 2) transpose_item(p.in[21 + m] + (size_t)e * 1024 * 256, 256, 1024, (bf16*)(ws + (m == 0 ? OFF_EXG : OFF_EXU)) + (size_t)e * 256 * 1024, (q >> 3) * 64, (q & 7) * 32, (q & 7) * 32, (float*)wl, lane);
        else transpose_item(p.in[23] + (size_t)e * 256 * 1024, 1024, 256, (bf16*)(ws + OFF_EXD) + (size_t)e * 1024 * 256, (q >> 5) * 64, (q & 31) * 32, (q & 31) * 32, (float*)wl, lane);
    }
    for (int R = gw; R < SEQ; R += NGW) {
        const float* xrow = p.in[0] + (size_t)R * D; bf16* urow = (bf16*)(ws + OFF_U) + (size_t)R * D;
        float4 v[4]; float ss = 0.f;
#pragma unroll
        for (int j = 0; j < 4; ++j) { v[j] = *(const float4*)(xrow + 4 * lane + 256 * j); ss += v[j].x * v[j].x + v[j].y * v[j].y + v[j].z * v[j].z + v[j].w * v[j].w; }
        ss = wave_sum(ss);
        const float rstd = rsqrtf(ss * (1.0f / D) + NORM_EPS);
#pragma unroll
        for (int j = 0; j < 4; ++j) {
            const float4 w4 = *(const float4*)(p.in[2] + 4 * lane + 256 * j);
            *(u32x2*)(urow + 4 * lane + 256 * j) = (u32x2){pk2(v[j].x * rstd * w4.x, v[j].y * rstd * w4.y), pk2(v[j].z * rstd * w4.z, v[j].w * rstd * w4.w)};
        }
    }
    for (int it = gw; it < (NCH - 1) * 8; it += NGW) {
        const int cm1 = it >> 3, head = it & 7;
        const bf16* reg = (const bf16*)(ws + OFF_V) + (size_t)cm1 * 64 * D + head * 128;
#pragma unroll 4
        for (int i = 0; i < 16; ++i) { const int row = i * 4 + (lane >> 4), ch = lane & 15; *(u32x4*)(wl + row * 256 + ch * 16) = *(const u32x4*)(reg + (size_t)row * D + ch * 8); }
        WAVE_SYNC();
        float ss = 0.f;
#pragma unroll 8
        for (int dv = 0; dv < 128; ++dv) { const float v = bf2f(*(const bf16*)(wl + (dv >> 1) * 256 + ((dv & 1) * 64 + lane) * 2)); ss += v * v; }
        const float rstd = rsqrtf(ss * (1.0f / 128.0f) + NORM_EPS);
        const size_t j = (size_t)cm1 * 64 + lane;
        const bf16* gsrc = (const bf16*)(ws + OFF_DG) + j * D + head * 128;
        bf16* dst = (bf16*)(ws + OFF_OD) + j * D + head * 128;
#pragma unroll 2
        for (int d8 = 0; d8 < 16; ++d8) {
            const u32x4 gv = *(const u32x4*)(gsrc + 8 * d8);
            const f32x4 w0 = *(const f32x4*)(p.in[12] + 8 * d8), w1 = *(const f32x4*)(p.in[12] + 8 * d8 + 4);
            float o[8];
#pragma unroll
            for (int c = 0; c < 8; ++c) { const int dv = 8 * d8 + c; o[c] = bf2f(*(const bf16*)(wl + (dv >> 1) * 256 + ((dv & 1) * 64 + lane) * 2)) * rstd; }
            o[0] *= w0[0] * siluf_(bflo(gv.x)); o[1] *= w0[1] * siluf_(bfhi(gv.x)); o[2] *= w0[2] * siluf_(bflo(gv.y)); o[3] *= w0[3] * siluf_(bfhi(gv.y));
            o[4] *= w1[0] * siluf_(bflo(gv.z)); o[5] *= w1[1] * siluf_(bfhi(gv.z)); o[6] *= w1[2] * siluf_(bflo(gv.w)); o[7] *= w1[3] * siluf_(bfhi(gv.w));
            *(u32x4*)(dst + 8 * d8) = (u32x4){pk2(o[0], o[1]), pk2(o[2], o[3]), pk2(o[4], o[5]), pk2(o[6], o[7])};
        }
        WAVE_SYNC();
    }
}

template <int NB, int NI>
DI void rowgemm64(const bf16* arow, const bf16* const (&bptr)[NB], char* stg, f32x16 (&acc)[NB][2][NI]) {
    const int tid = fresh_tid(), lane = tid & 63, r32 = lane & 31, h = lane >> 5;
    const int lrow = tid >> 3, lc = tid & 7;
    u32x4 ra = arow ? *(const u32x4*)arow : (u32x4){0u, 0u, 0u, 0u};
    *(u32x4*)(stg + swz128(lrow, lc)) = ra;
    __syncthreads();
    for (int kc = 0; kc < 16; ++kc) {
        const int buf = kc & 1;
        if (kc + 1 < 16) ra = arow ? *(const u32x4*)(arow + (kc + 1) * 64) : (u32x4){0u, 0u, 0u, 0u};
#pragma unroll
        for (int ks = 0; ks < 4; ++ks) {
            bf16x8 af[2];
#pragma unroll
            for (int mi = 0; mi < 2; ++mi) af[mi] = *(const bf16x8*)(stg + buf * 8192 + swz128(32 * mi + r32, 2 * ks + h));
#pragma unroll
            for (int b = 0; b < NB; ++b)
#pragma unroll
                for (int ni = 0; ni < NI; ++ni) {
                    const bf16x8 bfr = *(const bf16x8*)(bptr[b] + (size_t)ni * 32 * 1024 + kc * 64 + ks * 16);
#pragma unroll
                    for (int mi = 0; mi < 2; ++mi) acc[b][mi][ni] = MFMA32(af[mi], bfr, acc[b][mi][ni]);
                }
        }
        if (kc + 1 < 16) *(u32x4*)(stg + (buf ^ 1) * 8192 + swz128(lrow, lc)) = ra;
        __syncthreads();
    }
}

constexpr size_t OFF_MIX = OFF_V;
struct EpiSig {
    static constexpr bool PERM = true;
    bf16* sg;
    DM void operator()(const f32x4 (&acc)[2][2][4][2], const pg8::Unit& u, int wr, int wc, int fr, int fq) const {
        const int row0 = u.pm * 256 + wr * 64 + fr, col0 = u.pn * 256 + wc * 32 + 8 * fq;
#pragma unroll
        for (int ai = 0; ai < 2; ++ai)
#pragma unroll
            for (int m = 0; m < 4; ++m) {
                bf16* rowp = sg + (size_t)(row0 + ai * 128 + m * 16) * 2048 + col0;
#pragma unroll
                for (int bj = 0; bj < 2; ++bj) {
                    const f32x4 v0 = acc[ai][bj][m][0], v1 = acc[ai][bj][m][1];
                    *(u32x4*)(rowp + bj * 128) = (u32x4){pk2(sigmoidf_(v0[0]), sigmoidf_(v0[1])), pk2(sigmoidf_(v0[2]), sigmoidf_(v0[3])), pk2(sigmoidf_(v1[0]), sigmoidf_(v1[1])), pk2(sigmoidf_(v1[2]), sigmoidf_(v1[3]))};
                }
            }
    }
};
template <bool ADD> struct EpiGate {
    static constexpr bool PERM = true;
    const bf16* sg; bf16* mix; int goff;
    DM void operator()(const f32x4 (&acc)[2][2][4][2], const pg8::Unit& u, int wr, int wc, int fr, int fq) const {
        const int row0 = u.pm * 256 + wr * 64 + fr, col0 = u.pn * 256 + wc * 32 + 8 * fq;
#pragma unroll
        for (int ai = 0; ai < 2; ++ai)
#pragma unroll
            for (int m = 0; m < 4; ++m) {
                const size_t j = (size_t)(row0 + ai * 128 + m * 16);
#pragma unroll
                for (int bj = 0; bj < 2; ++bj) {
                    const u32x4 g = *(const u32x4*)(sg + j * 2048 + goff + col0 + bj * 128);
                    const f32x4 v0 = acc[ai][bj][m][0], v1 = acc[ai][bj][m][1];
                    float o[8] = {bflo(g.x) * v0[0], bfhi(g.x) * v0[1], bflo(g.y) * v0[2], bfhi(g.y) * v0[3], bflo(g.z) * v1[0], bfhi(g.z) * v1[1], bflo(g.w) * v1[2], bfhi(g.w) * v1[3]};
                    bf16* dst = mix + j * D + col0 + bj * 128;
                    if (ADD) { const u32x4 q = *(const u32x4*)dst; o[0] += bflo(q.x); o[1] += bfhi(q.x); o[2] += bflo(q.y); o[3] += bfhi(q.y); o[4] += bflo(q.z); o[5] += bfhi(q.z); o[6] += bflo(q.w); o[7] += bfhi(q.w); }
                    *(u32x4*)dst = (u32x4){pk2(o[0], o[1]), pk2(o[2], o[3]), pk2(o[4], o[5]), pk2(o[6], o[7])};
                }
            }
    }
};
struct EpiRes {
    static constexpr bool PERM = false;
    const float* x; float* hout;
    DM void operator()(const f32x4 (&acc)[2][2][4][2], const pg8::Unit& u, int wr, int wc, int fr, int fq) const {
        const int row0 = u.pm * 256 + wr * 64 + fr, col0 = u.pn * 256 + wc * 32 + 4 * fq;
#pragma unroll
        for (int ai = 0; ai < 2; ++ai)
#pragma unroll
            for (int m = 0; m < 4; ++m) {
                const size_t off = (size_t)(row0 + ai * 128 + m * 16) * D + col0;
#pragma unroll
                for (int bj = 0; bj < 2; ++bj)
#pragma unroll
                    for (int n = 0; n < 2; ++n) *(f32x4*)(hout + off + bj * 128 + n * 16) = *(const f32x4*)(x + off + bj * 128 + n * 16) + acc[ai][bj][m][n];
            }
    }
};
DI void phase5a(const Params& p, char* smem, int bid, int nblk) {
    pg8::Gemm g{(const bf16*)(p.ws + OFF_U), (const bf16*)(p.ws + OFF_WTIN) + (size_t)7168 * 1024, SEQ, 2048, 1024};
    pg8::StaticOrder S; S.init(SEQ, 2048, nblk, bid);
    EpiSig E{(bf16*)p.out};
    pg8::gemm_phase(smem, g, S, E);
}
DI void phase5b(const Params& p, char* smem, int bid, int nblk) {
    pg8::StaticOrder S; S.init(SEQ, 1024, nblk, bid);
    {
        pg8::Gemm g{(const bf16*)(p.ws + OFF_AQ), (const bf16*)(p.ws + OFF_WTBA), SEQ, 1024, 1024};
        EpiGate<false> E{(const bf16*)p.out, (bf16*)(p.ws + OFF_MIX), 0};
        pg8::gemm_phase(smem, g, S, E);
    }
    {
        pg8::Gemm g{(const bf16*)(p.ws + OFF_OD), (const bf16*)(p.ws + OFF_WTBD), SEQ, 1024, 1024};
        EpiGate<true> E{(const bf16*)p.out, (bf16*)(p.ws + OFF_MIX), 1024};
        pg8::gemm_phase(smem, g, S, E);
    }
}
DI void phase5c(const Params& p, char* smem, int bid, int nblk) {
    pg8::Gemm g{(const bf16*)(p.ws + OFF_MIX), (const bf16*)(p.ws + OFF_WTOUT), SEQ, 1024, 1024};
    pg8::StaticOrder S; S.init(SEQ, 1024, nblk, bid);
    EpiRes E{p.in[0], p.out};
    pg8::gemm_phase(smem, g, S, E);
}
constexpr int P5_HL = 0, P5_MISC = 64 * 513 * 4 + 256;
DI void post_rows(const Params& p, char* smem, int rb, int dry) {
    const int tid = fresh_tid(), lane = tid & 63, wave = tid >> 6;
    unsigned char* ws = p.ws;
    const int row0 = rb * 64;
    float* rstdl = (float*)(smem + P5_MISC); float* logl = (float*)(smem + P5_MISC + 256);
    {
        const int row = tid >> 3, seg = tid & 7;
        const float* hp = p.out + (size_t)(row0 + row) * D + seg * 128;
        float ss = 0.f;
#pragma unroll 8
        for (int i = 0; i < 32; ++i) { const f32x4 a = *(const f32x4*)(hp + 4 * i); ss += a[0] * a[0] + a[1] * a[1] + a[2] * a[2] + a[3] * a[3]; }
        ss += __shfl_xor(ss, 1); ss += __shfl_xor(ss, 2); ss += __shfl_xor(ss, 4);
        if (seg == 0) rstdl[row] = rsqrtf(ss * (1.0f / D) + NORM_EPS);
    }
    __syncthreads();
#pragma unroll 2
    for (int i = 0; i < 16; ++i) {
        const int idx = tid + NT * i, row = idx >> 7, ch = idx & 127;
        const float* hp = p.out + (size_t)(row0 + row) * D + ch * 8;
        const f32x4 a = *(const f32x4*)hp, b = *(const f32x4*)(hp + 4);
        const f32x4 w0 = *(const f32x4*)(p.in[16] + ch * 8), w1 = *(const f32x4*)(p.in[16] + ch * 8 + 4);
        const float rs = rstdl[row];
        if (!dry) *(u32x4*)((bf16*)(ws + OFF_OD) + (size_t)(row0 + row) * D + ch * 8) =
            (u32x4){pk2(a[0] * rs * w0[0], a[1] * rs * w0[1]), pk2(a[2] * rs * w0[2], a[3] * rs * w0[3]), pk2(b[0] * rs * w1[0], b[1] * rs * w1[1]), pk2(b[2] * rs * w1[2], b[3] * rs * w1[3])};
    }
    float lg[36];
#pragma unroll
    for (int c = 0; c < 36; ++c) lg[c] = 0.f;
    float* HL = (float*)(smem + P5_HL);
    const float* WR = (const float*)(ws + OFF_SMALL + SM_WR);
#pragma unroll 1
    for (int half = 0; half < 2; ++half) {
        __syncthreads();
#pragma unroll 4
        for (int i = 0; i < 16; ++i) {
            const int idx = tid + NT * i, row = idx >> 7, c4 = idx & 127;
            const f32x4 a = *(const f32x4*)(p.out + (size_t)(row0 + row) * D + 512 * half + c4 * 4);
            float* d = HL + row * 513 + c4 * 4; d[0] = a[0]; d[1] = a[1]; d[2] = a[2]; d[3] = a[3];
        }
        __syncthreads();
        const int kb = 64 * wave;
#pragma unroll 1
        for (int kk = 0; kk < 64; ++kk) {
            const float hv = HL[lane * 513 + kb + kk];
            const float* wr = WR + (size_t)(512 * half + kb + kk) * 40;
#pragma unroll
            for (int c = 0; c < 36; ++c) lg[c] += hv * wr[c];
        }
    }
    __syncthreads();
    float* PL = (float*)(smem + P5_HL);
#pragma unroll
    for (int c = 0; c < 36; ++c) PL[(lane * 8 + wave) * 36 + c] = lg[c];
    __syncthreads();
    if (tid < 64) {
        const float rs = rstdl[tid];
        for (int c = 0; c < 36; ++c) { float s = 0.f; for (int w = 0; w < 8; ++w) s += PL[(tid * 8 + w) * 36 + c]; logl[tid * 40 + c] = s * rs + (c < 4 ? p.in[18][c] : p.in[20][c - 4]); }
        const float* L = logl + tid * 40;
        int gi = 0; float gm = L[0];
        for (int c = 1; c < 4; ++c) if (L[c] > gm) { gm = L[c]; gi = c; }
        float gs = 0.f; for (int c = 0; c < 4; ++c) gs += __expf(L[c] - gm);
        const float gw = 1.0f / gs;
        const float* E = L + 4 + 8 * gi;
        int i1 = 0; float l1 = E[0];
        for (int c = 1; c < 8; ++c) if (E[c] > l1) { l1 = E[c]; i1 = c; }
        int i2 = -1; float l2 = -3.0e38f;
        for (int c = 0; c < 8; ++c) if (c != i1 && E[c] > l2) { l2 = E[c]; i2 = c; }
        const float t = __expf(l2 - l1), w1 = 1.0f / (1.0f + t), w2 = t / (1.0f + t);
        unsigned* cnt = (unsigned*)(ws + OFF_SMALL + SM_CTL) + CW_ECNT;
        int* lists = (int*)(ws + OFF_SMALL + SM_TAILS); float* RW = (float*)(ws + OFF_SMALL + SM_RW);
        const int j = row0 + tid;
        const int e1 = 8 * gi + i1, e2 = 8 * gi + i2;
        if (!dry) {
        const unsigned p1 = atomicAdd(cnt + e1, 1u); ST_ATOMIC(lists + (size_t)e1 * SEQ + p1, (j << 1)); RW[2 * j] = gw * w1;
        const unsigned p2 = atomicAdd(cnt + e2, 1u); ST_ATOMIC(lists + (size_t)e2 * SEQ + p2, (j << 1) | 1); RW[2 * j + 1] = gw * w2;
        } else { asm volatile("" :: "v"(e1), "v"(e2), "v"(gw * w1), "v"(gw * w2)); }
    }
    __syncthreads();
}
DI void phase5d(const Params& p, char* smem, int bid, int nblk, int dry = 0) {
    for (int rb = bid; rb < SEQ / 64; rb += nblk) post_rows(p, smem, rb, dry);
}

constexpr int P6_HL = 0, P6_PITCH = 528, P6_STG = 64 * P6_PITCH, P6_TOK = P6_STG + 16384, P6_RW = P6_TOK + 256, P6_TS = P6_RW + 256;
DI void moe_item(const Params& p, char* smem, int e, int mt, int cnt_e) {
    const int tid = fresh_tid(), lane = tid & 63, wave = tid >> 6, r32 = lane & 31, h = lane >> 5;
    unsigned char* ws = p.ws;
    int* tokl = (int*)(smem + P6_TOK); float* rwl = (float*)(smem + P6_RW);
    if (tid < 64) {
        const int idx = 64 * mt + tid; int ent = -1; float w = 0.f;
        if (idx < cnt_e) { ent = ((const int*)(ws + OFF_SMALL + SM_TAILS))[(size_t)e * SEQ + idx]; w = ((const float*)(ws + OFF_SMALL + SM_RW))[ent]; }
        tokl[tid] = ent; rwl[tid] = w;
    }
    __syncthreads();
    const int lrow = tid >> 3, lc = tid & 7;
    const int lent = tokl[lrow];
    f32x16 GU[2][2][1];
#pragma unroll
    for (int b = 0; b < 2; ++b)
#pragma unroll
        for (int mi = 0; mi < 2; ++mi) GU[b][mi][0] = zero16();
    {
        const bf16* const bp[2] = {(const bf16*)(ws + OFF_EXG) + ((size_t)e * 256 + 32 * wave + r32) * 1024 + 8 * h, (const bf16*)(ws + OFF_EXU) + ((size_t)e * 256 + 32 * wave + r32) * 1024 + 8 * h};
        rowgemm64<2, 1>(lent >= 0 ? (const bf16*)(ws + OFF_OD) + (size_t)(lent >> 1) * D + lc * 8 : nullptr, bp, smem + P6_STG, GU);
    }
#pragma unroll
    for (int mi = 0; mi < 2; ++mi)
#pragma unroll
        for (int r = 0; r < 16; ++r) {
            const int row = 32 * mi + (r & 3) + 8 * (r >> 2) + 4 * h, col = 32 * wave + r32;
            *(bf16*)(smem + P6_HL + row * P6_PITCH + col * 2) = (bf16)f2bf(siluf_(GU[0][mi][0][r]) * GU[1][mi][0][r]);
        }
    __syncthreads();
#pragma unroll 1
    for (int ps = 0; ps < 2; ++ps) {
        f32x16 Y[2][2];
#pragma unroll
        for (int mi = 0; mi < 2; ++mi)
#pragma unroll
            for (int ni = 0; ni < 2; ++ni) Y[mi][ni] = zero16();
        const bf16* bp = (const bf16*)(ws + OFF_EXD) + ((size_t)e * 1024 + 128 * wave + 64 * ps + r32) * 256 + 8 * h;
#pragma unroll 4
        for (int ks = 0; ks < 16; ++ks) {
            bf16x8 af[2];
#pragma unroll
            for (int mi = 0; mi < 2; ++mi) af[mi] = *(const bf16x8*)(smem + P6_HL + (32 * mi + r32) * P6_PITCH + (2 * ks + h) * 16);
#pragma unroll
            for (int ni = 0; ni < 2; ++ni) {
                const bf16x8 bfr = *(const bf16x8*)(bp + (size_t)ni * 32 * 256 + ks * 16);
#pragma unroll
                for (int mi = 0; mi < 2; ++mi) Y[mi][ni] = MFMA32(af[mi], bfr, Y[mi][ni]);
            }
        }
#pragma unroll
        for (int mi = 0; mi < 2; ++mi)
#pragma unroll
            for (int r = 0; r < 16; ++r) {
                const int row = 32 * mi + (r & 3) + 8 * (r >> 2) + 4 * h; const int ent = tokl[row];
                if (ent >= 0) {
                    const float w = rwl[row]; bf16* dst = (bf16*)(ws + OFF_Y) + (size_t)ent * D + 128 * wave + 64 * ps + r32;
#pragma unroll
                    for (int ni = 0; ni < 2; ++ni) dst[32 * ni] = (bf16)f2bf(Y[mi][ni][r] * w);
                }
            }
    }
    __syncthreads();
}
DI void phase6(const Params& p, char* smem, int bid, int nblk) {
    int* ts = (int*)(smem + P6_TS);
    unsigned* cnt = (unsigned*)(p.ws + OFF_SMALL + SM_CTL) + CW_ECNT;
    int* tc = (int*)(smem + P6_TS + 256);
    if (threadIdx.x < 32) tc[threadIdx.x] = (int)LD_ATOMIC(cnt + threadIdx.x);
    __syncthreads();
    if (threadIdx.x == 0) { int s = 0; for (int e = 0; e < 32; ++e) { ts[e] = s; s += (tc[e] + 63) >> 6; } ts[32] = s; }
    __syncthreads();
    const int total = ts[32];
    for (int t = bid; t < total; t += nblk) {
        int e = 0;
        for (int q = 1; q < 32; ++q) if (ts[q] <= t) e = q;
        moe_item(p, smem, e, t - ts[e], tc[e]);
    }
}

DI void phase7(const Params& p, char* smem, int bid, int nblk, int dry = 0) {
    const int tid = fresh_tid(), lane = tid & 63, wave = tid >> 6;
    const int gw = bid * 8 + wave, NGW = nblk * 8;
    for (int j = gw; j < SEQ; j += NGW) {
        float* hrow = p.out + (size_t)j * D;
        const bf16* y0 = (const bf16*)(p.ws + OFF_Y) + (size_t)j * 2 * D;
        float4 v[4]; float ss = 0.f;
#pragma unroll
        for (int q = 0; q < 4; ++q) {
            const int c = 4 * lane + 256 * q;
            v[q] = *(const float4*)(hrow + c);
            const u32x2 a = *(const u32x2*)(y0 + c), b = *(const u32x2*)(y0 + D + c);
            v[q].x += bflo(a.x) + bflo(b.x); v[q].y += bfhi(a.x) + bfhi(b.x); v[q].z += bflo(a.y) + bflo(b.y); v[q].w += bfhi(a.y) + bfhi(b.y);
            ss += v[q].x * v[q].x + v[q].y * v[q].y + v[q].z * v[q].z + v[q].w * v[q].w;
        }
        ss = wave_sum(ss);
        const float rstd = rsqrtf(ss * (1.0f / D) + NORM_EPS);
#pragma unroll
        for (int q = 0; q < 4; ++q) {
            const int c = 4 * lane + 256 * q; const float4 w4 = *(const float4*)(p.in[24] + c);
            if (!dry) *(float4*)(hrow + c) = make_float4(v[q].x * rstd * w4.x, v[q].y * rstd * w4.y, v[q].z * rstd * w4.z, v[q].w * rstd * w4.w);
        }
    }
}

__global__ void __launch_bounds__(NT) k_phase0(Params p) { SMEM_DECL; phase0(p, smem, blockIdx.x, gridDim.x); }
__global__ void __launch_bounds__(NT) k_phase1(Params p) { SMEM_DECL; phase1(p, smem, blockIdx.x, gridDim.x); }
__global__ void __launch_bounds__(NT) k_phase2(Params p) { SMEM_DECL; phase2(p, smem, blockIdx.x, gridDim.x, 0); }
__global__ void __launch_bounds__(NT) k_phase3(Params p) { SMEM_DECL; phase3(p, smem, blockIdx.x, gridDim.x); }
__global__ void __launch_bounds__(NT) k_phase4(Params p) { SMEM_DECL; phase4(p, smem, blockIdx.x, gridDim.x); }
__global__ void __launch_bounds__(NT) k_phase5a(Params p) { SMEM_DECL; phase5a(p, smem, blockIdx.x, gridDim.x); }
__global__ void __launch_bounds__(NT) k_phase5b(Params p) { SMEM_DECL; phase5b(p, smem, blockIdx.x, gridDim.x); }
__global__ void __launch_bounds__(NT) k_phase5c(Params p) { SMEM_DECL; phase5c(p, smem, blockIdx.x, gridDim.x); }
__global__ void __launch_bounds__(NT) k_phase5d(Params p) { SMEM_DECL; phase5d(p, smem, blockIdx.x, gridDim.x); }
__global__ void __launch_bounds__(NT) k_phase6(Params p) { SMEM_DECL; phase6(p, smem, blockIdx.x, gridDim.x); }
__global__ void __launch_bounds__(NT) k_phase7(Params p) { SMEM_DECL; phase7(p, smem, blockIdx.x, gridDim.x); }

constexpr int LDS_BYTES = 160 * 1024 - 256;
constexpr int LDS_BARST = LDS_BYTES - 16;

#ifndef EMU
#define LAS __attribute__((address_space(3)))
#define XB_TMO      128
#define XB_XCNT(j)  (256  + 64 * (j))
#define XB_XSUB(j)  (1280 + 64 * (j))
#define XB_XGEN(j)  (2304 + 64 * (j))
#define XB_TOP      3328
#define XB_TOPGEN   3392
#define XCD_BAR_WORDS 3456
#define XB_SPIN_CAP (1u << 22)
__device__ __forceinline__ unsigned xb_ld(unsigned* p)              { return __hip_atomic_load(p, __ATOMIC_RELAXED, __HIP_MEMORY_SCOPE_AGENT); }
__device__ __forceinline__ unsigned xb_add(unsigned* p, unsigned v) { return __hip_atomic_fetch_add(p, v, __ATOMIC_RELAXED, __HIP_MEMORY_SCOPE_AGENT); }
__device__ __forceinline__ unsigned xb_xcc_id() { return (unsigned)__builtin_amdgcn_s_getreg((3 << 11) | 20) & 0xFu; }
#define XB_SPIN(cond, bar) do { unsigned _sp = 0; while (cond) { __builtin_amdgcn_s_sleep(1); \
    if ((++_sp & 255u) == 0u) { if (xb_ld(&(bar)[XB_TMO])) break; if (_sp > XB_SPIN_CAP) { atomicAdd(&(bar)[XB_TMO], 1u); break; } } } } while (0)
struct XcdBarrier { unsigned* bar; unsigned x; volatile LAS unsigned* st; };
__device__ __forceinline__ XcdBarrier xcd_barrier_post(unsigned* bar, volatile LAS unsigned* st) {
    XcdBarrier b; b.bar = bar; b.x = xb_xcc_id(); b.st = st;
    if (threadIdx.x == 0) (void)xb_add(&bar[XB_XCNT(b.x)], 1u);
    return b;
}
__device__ __forceinline__ void xcd_barrier_complete(unsigned* bar, unsigned x, unsigned& nloc, unsigned& nx) {
    const unsigned G = gridDim.x * gridDim.y * gridDim.z;
    unsigned sum, cnt, mine, sp = 0u;
    for (;;) {
        sum = 0u; cnt = 0u; mine = 0u;
#pragma unroll
        for (unsigned j = 0; j < 16; ++j) { const unsigned c = xb_ld(&bar[XB_XCNT(j)]); sum += c; cnt += (c > 0u) ? 1u : 0u; mine = (j == x) ? c : mine; }
        if (sum == G) break;
        __builtin_amdgcn_s_sleep(1);
        if ((++sp & 255u) == 0u) { if (xb_ld(&bar[XB_TMO])) break; if (sp > XB_SPIN_CAP) { atomicAdd(&bar[XB_TMO], 1u); break; } }
    }
    nloc = mine > 0u ? mine : 1u; nx = cnt > 0u ? cnt : 1u;
}
__device__ __forceinline__ void xcd_barrier(const XcdBarrier& b) {
    asm volatile("s_waitcnt vmcnt(0)" ::: "memory");
    __syncthreads();
    if (threadIdx.x == 0) {
        unsigned* bar = b.bar;
        __builtin_amdgcn_s_waitcnt(0);
        unsigned nloc = b.st[0], nx = b.st[1];
        if (nloc == 0u) { xcd_barrier_complete(bar, b.x, nloc, nx); b.st[0] = nloc; b.st[1] = nx; }
        const unsigned old = xb_add(&bar[XB_XSUB(b.x)], 1u);
        const unsigned gen = old / nloc;
        if (old + 1u == (gen + 1u) * nloc) {
            __builtin_amdgcn_fence(__ATOMIC_RELEASE, "agent");
            asm volatile("s_waitcnt vmcnt(0)" ::: "memory");
            const unsigned og = xb_add(&bar[XB_TOP], 1u);
            const unsigned tg = og / nx;
            if (og + 1u == (tg + 1u) * nx) xb_add(&bar[XB_TOPGEN], 1u);
            else XB_SPIN(xb_ld(&bar[XB_TOPGEN]) == tg, bar);
            __builtin_amdgcn_fence(__ATOMIC_ACQUIRE, "agent");
            xb_add(&bar[XB_XGEN(b.x)], 1u);
            asm volatile("s_waitcnt vmcnt(0)" ::: "memory");
        } else {
            XB_SPIN(xb_ld(&bar[XB_XGEN(b.x)]) == gen, bar);
            __builtin_amdgcn_fence(__ATOMIC_ACQUIRE, "agent");
            asm volatile("s_waitcnt vmcnt(0)" ::: "memory");
        }
    }
    __syncthreads();
}
#endif

#ifdef EMU
#define GRID_SYNC() emu_grid_sync()
#define GRID_SYNC_CG() emu_grid_sync()
#else
#define GRID_SYNC_CG() do { \
    asm volatile("s_waitcnt vmcnt(0)" ::: "memory"); \
    __syncthreads(); \
    cooperative_groups::this_grid().sync(); \
    if (threadIdx.x == 0) { __builtin_amdgcn_fence(__ATOMIC_ACQUIRE, "agent"); asm volatile("s_waitcnt vmcnt(0)" ::: "memory"); } \
    __syncthreads(); \
} while (0)
#define GRID_SYNC() xcd_barrier(xbar)
#endif
__global__ void __launch_bounds__(NT) fwd_megakernel(Params p) {
    SMEM_DECL;
    const int bid = blockIdx.x, nblk = gridDim.x;
#ifndef EMU
    if (threadIdx.x < 4) ((volatile LAS unsigned*)(smem + LDS_BARST))[threadIdx.x] = 0u;
    __syncthreads();
    const XcdBarrier xbar = xcd_barrier_post((unsigned*)(p.ws + OFF_SMALL + SM_CTL) + CW_BAR, (volatile LAS unsigned*)(smem + LDS_BARST));
#endif
#if defined(DRY_PHASE) && !defined(EMU)
    int dryflag = 1; asm volatile("" : "+s"(dryflag));
#define EXTRA(k, call) do { if (DRY_PHASE == (k)) { call; GRID_SYNC(); } } while (0)
#else
#define EXTRA(k, call) do {} while (0)
    const int dryflag = 0; (void)dryflag;
#endif
    EXTRA(0, phase0(p, smem, bid, nblk));
    phase0(p, smem, bid, nblk); GRID_SYNC_CG();
    EXTRA(1, phase1(p, smem, bid, nblk));
    phase1(p, smem, bid, nblk); GRID_SYNC();
    EXTRA(2, phase2(p, smem, bid, nblk, dryflag));
    phase2(p, smem, bid, nblk); GRID_SYNC();
    EXTRA(3, phase3(p, smem, bid, nblk, dryflag));
    EXTRA(8, phase3(p, smem, bid, nblk, dryflag, 1));
    EXTRA(9, phase3(p, smem, bid, nblk, dryflag, 2));
    phase3(p, smem, bid, nblk); GRID_SYNC();
    EXTRA(4, phase4(p, smem, bid, nblk));
    phase4(p, smem, bid, nblk); GRID_SYNC();
    EXTRA(5, phase5a(p, smem, bid, nblk));
    phase5a(p, smem, bid, nblk); GRID_SYNC();
    EXTRA(10, phase5b(p, smem, bid, nblk));
    phase5b(p, smem, bid, nblk); GRID_SYNC();
    EXTRA(11, phase5c(p, smem, bid, nblk));
    phase5c(p, smem, bid, nblk); GRID_SYNC();
    EXTRA(12, phase5d(p, smem, bid, nblk, dryflag));
    phase5d(p, smem, bid, nblk); GRID_SYNC();
    EXTRA(6, phase6(p, smem, bid, nblk));
    phase6(p, smem, bid, nblk); GRID_SYNC();
    EXTRA(7, phase7(p, smem, bid, nblk, dryflag));
    phase7(p, smem, bid, nblk);
}

#ifndef EMU
extern "C" void kernel_launch(void* const* d_in, const int* in_sizes, int n_in, void* d_out, int out_size, void* d_ws, size_t ws_size, hipStream_t stream) {
    static int grid = 0;
    if (grid == 0) {
        if (n_in != 25 || ws_size < WS_END || out_size != SEQ * D) { fprintf(stderr, "kernel_launch: unexpected problem (n_in %d, ws %zu, out %d)\n", n_in, ws_size, out_size); grid = -1; return; }
        int dev = 0, cus = 0, per_cu = 0;
        (void)hipGetDevice(&dev);
        (void)hipDeviceGetAttribute(&cus, hipDeviceAttributeMultiprocessorCount, dev);
        (void)hipFuncSetAttribute((const void*)fwd_megakernel, hipFuncAttributeMaxDynamicSharedMemorySize, LDS_BYTES);
        (void)hipOccupancyMaxActiveBlocksPerMultiprocessor(&per_cu, (const void*)fwd_megakernel, NT, LDS_BYTES);
        if (per_cu < 1) { fprintf(stderr, "kernel_launch: occupancy query returned %d\n", per_cu); per_cu = 1; }
        grid = cus * per_cu;
    }
    if (grid < 0) return;
    Params p{};
    for (int i = 0; i < 25; ++i) p.in[i] = (const float*)d_in[i];
    p.out = (float*)d_out; p.ws = (unsigned char*)d_ws;
    (void)hipMemsetAsync((unsigned char*)d_ws + OFF_SMALL + SM_CTL + (size_t)CW_BAR * 4, 0, (size_t)XCD_BAR_WORDS * 4, stream);
    void* args[] = {&p};
    hipError_t e = hipLaunchCooperativeKernel((const void*)fwd_megakernel, dim3(grid), dim3(NT), args, LDS_BYTES, stream);
    if (e != hipSuccess) fprintf(stderr, "cooperative launch failed: %s (grid %d)\n", hipGetErrorString(e), grid);
}
#endif

#ifdef EMU
static void run_phases(Params p, int upto, int grid) {
    if (upto == 100) { emu::launch([=] { fwd_megakernel(p); }, grid, NT, LDS_BYTES, true); return; }
    if (upto >= 0) emu::launch([=] { k_phase0(p); }, grid, NT, LDS_BYTES, false);
    if (upto >= 1) emu::launch([=] { k_phase1(p); }, grid, NT, LDS_BYTES, false);
    if (upto >= 2) emu::launch([=] { k_phase2(p); }, grid, NT, LDS_BYTES, false);
    if (upto >= 3) emu::launch([=] { k_phase3(p); }, grid, NT, LDS_BYTES, false);
    if (upto >= 4) emu::launch([=] { k_phase4(p); }, grid, NT, LDS_BYTES, false);
    if (upto >= 5) { emu::launch([=] { k_phase5a(p); }, grid, NT, LDS_BYTES, false); emu::launch([=] { k_phase5b(p); }, grid, NT, LDS_BYTES, false); emu::launch([=] { k_phase5c(p); }, grid, NT, LDS_BYTES, false); emu::launch([=] { k_phase5d(p); }, grid, NT, LDS_BYTES, false); }
    if (upto >= 6) emu::launch([=] { k_phase6(p); }, grid, NT, LDS_BYTES, false);
    if (upto >= 7) emu::launch([=] { k_phase7(p); }, grid, NT, LDS_BYTES, false);
}
#endif
```

```cpp
#include <type_traits>
#ifndef EMU
#include <hip/hip_runtime.h>
#include <hip/hip_cooperative_groups.h>
#include <cstdio>
#include <cstdint>
#include <cmath>
#endif

#ifndef SEQ
#define SEQ 16384
#endif

typedef unsigned short bf16;
typedef short bf16x8 __attribute__((ext_vector_type(8)));
typedef short bf16x4 __attribute__((ext_vector_type(4)));
typedef float f32x16 __attribute__((ext_vector_type(16)));
typedef float f32x4 __attribute__((ext_vector_type(4)));
typedef unsigned u32x4 __attribute__((ext_vector_type(4)));
typedef unsigned u32x2 __attribute__((ext_vector_type(2)));

#ifdef EMU
#define MFMA32(a, b, c) emu_mfma_32x32x16((a), (b), (c))
#define MFMA16(a, b, c) emu_mfma_16x16x32((a), (b), (c))
#define DI static inline
#define DM inline
#define EXP2F(x) exp2f(x)
#define WAVE_SYNC() emu_wave_sync()
#define LD_NT(p) (*(p))
#define LD_ATOMIC(p) (*(p))
#define ST_ATOMIC(p, v) (*(p) = (v))
#define SCHED_FENCE() do {} while (0)
#else
#define WAVE_SYNC() do { __builtin_amdgcn_fence(__ATOMIC_RELEASE, "wavefront"); __builtin_amdgcn_wave_barrier(); __builtin_amdgcn_fence(__ATOMIC_ACQUIRE, "wavefront"); } while (0)
#define MFMA32(a, b, c) __builtin_amdgcn_mfma_f32_32x32x16_bf16((a), (b), (c), 0, 0, 0)
#define LD_NT(p) __builtin_nontemporal_load(p)
#define LD_ATOMIC(p) __hip_atomic_load((p), __ATOMIC_RELAXED, __HIP_MEMORY_SCOPE_AGENT)
#define ST_ATOMIC(p, v) __hip_atomic_store((p), (v), __ATOMIC_RELAXED, __HIP_MEMORY_SCOPE_AGENT)
#define SCHED_FENCE() __builtin_amdgcn_sched_barrier(0)
#define MFMA16(a, b, c) __builtin_amdgcn_mfma_f32_16x16x32_bf16((a), (b), (c), 0, 0, 0)
#define DI __device__ __forceinline__
#define DM __device__ __forceinline__
#define EXP2F(x) __builtin_amdgcn_exp2f(x)
#endif

constexpr int D = 1024;
constexpr int NMETA = 16;
constexpr int LTOK = SEQ + NMETA;
constexpr int NCH = SEQ / 64 + 1;
constexpr int NT = 512;
constexpr int W_IN_COLS = 9232;
constexpr float NORM_EPS = 1e-6f;
constexpr float LOG2E = 1.4426950408889634f;

constexpr size_t UNIT = (size_t)SEQ * D * 2;
constexpr size_t OFF_WTIN = 0;
constexpr size_t OFF_WTBA = OFF_WTIN + (size_t)9216 * 1024 * 2;
constexpr size_t OFF_WTBD = OFF_WTBA + (size_t)1024 * 1024 * 2;
constexpr size_t OFF_WTOUT = OFF_WTBD + (size_t)1024 * 1024 * 2;
constexpr size_t OFF_SMALL = OFF_WTOUT + (size_t)1024 * 1024 * 2;
constexpr size_t SM_CTL = 0;
constexpr size_t SM_UMETA = SM_CTL + 65536;
constexpr size_t SM_AKMETA = SM_UMETA + 16 * 1024 * 2;
constexpr size_t SM_AVTMETA = SM_AKMETA + 16 * 1024 * 2;
constexpr size_t SM_C0Q = SM_AVTMETA + 8 * 128 * 16 * 2;
constexpr size_t SM_C0K = SM_C0Q + 64 * 1024 * 2;
constexpr size_t SM_C0V = SM_C0K + 64 * 1024 * 2;
constexpr size_t SM_C0W = SM_C0V + 64 * 1024 * 2;
constexpr size_t SM_C0QK = SM_C0W + 8 * 64 * 128 * 2;
constexpr size_t SM_BETA = SM_C0QK + 8 * 64 * 64 * 2;
constexpr size_t SM_G = SM_BETA + (size_t)NCH * 64 * 8 * 4;
constexpr size_t SM_GC = SM_G + (size_t)NCH * 64 * 8 * 4;
constexpr size_t SM_WR = SM_GC + (size_t)NCH * 8 * 64 * 4;
constexpr size_t SM_RIDS = SM_WR + 2 * 64 * 1024 * 2;
constexpr size_t SM_RW = SM_RIDS + 0;
constexpr size_t SM_TAILS = SM_RW + (size_t)SEQ * 2 * 4;
constexpr size_t SM_TAILS_BYTES = ((size_t)NCH * 3 * 3072 * 2 > (size_t)32 * SEQ * 4) ? (size_t)NCH * 3 * 3072 * 2 : (size_t)32 * SEQ * 4;
constexpr size_t SM_END = SM_TAILS + SM_TAILS_BYTES;
constexpr size_t SMALL_BYTES = (SM_END + 255) & ~(size_t)255;
constexpr size_t OFF_U = ((OFF_SMALL + SMALL_BYTES + (1u << 20) - 1) >> 20) << 20;
constexpr size_t OFF_W = OFF_U + UNIT;
constexpr size_t OFF_KN = OFF_W + UNIT;
constexpr size_t OFF_QN = OFF_KN + UNIT;
constexpr size_t OFF_DG = OFF_QN + UNIT;
constexpr size_t OFF_V = OFF_DG + UNIT;
constexpr size_t OFF_AQ = OFF_V + UNIT;
constexpr size_t WS_BASE_END = OFF_AQ + UNIT;
constexpr size_t EXPERT_BYTES = (size_t)32 * 3 * 1024 * 256 * 2;
constexpr size_t OFF_EXP = (2 * UNIT >= EXPERT_BYTES) ? OFF_W : WS_BASE_END;
constexpr size_t WS_END = (OFF_EXP == OFF_W) ? WS_BASE_END : WS_BASE_END + EXPERT_BYTES;
constexpr size_t OFF_EXG = OFF_EXP, OFF_EXU = OFF_EXP + EXPERT_BYTES / 3, OFF_EXD = OFF_EXP + 2 * (EXPERT_BYTES / 3);
constexpr size_t OFF_QKB = OFF_U;
constexpr size_t OFF_OD = OFF_QN;
constexpr size_t OFF_Y = OFF_V;
#if SEQ == 16384
static_assert(WS_END <= (size_t)256 << 20, "workspace map exceeds 256 MiB");
static_assert(EXPERT_BYTES <= 2 * UNIT, "experts fit R2+R3");
#endif
constexpr int CW_ATTQ = 64;
constexpr int CW_ECNT = 128;
constexpr int CW_NRM = 256;
constexpr int CW_BAR = 1024;

struct Params {
    const float* in[25];
    float* out;
    unsigned char* ws;
};

#ifdef EMU
DI unsigned f2bf(float f) { unsigned u = __builtin_bit_cast(unsigned, f); return (u + 0x7fffu + ((u >> 16) & 1u)) >> 16; }
#else
DI unsigned f2bf(float f) { return (unsigned)__builtin_bit_cast(unsigned short, (__bf16)f); }
#endif

DI float bf2f(unsigned b) { return __builtin_bit_cast(float, (b & 0xffffu) << 16); }
#ifdef EMU
DI unsigned pk2(float lo, float hi) { return f2bf(lo) | (f2bf(hi) << 16); }
DI bool wave_any(bool pr) { int v = pr ? 1 : 0;
    for (int o = 1; o < 64; o <<= 1) v |= __shfl_xor(v, o);
    return v != 0; }
#else
typedef __bf16 hwbf2 __attribute__((ext_vector_type(2)));
typedef float f32x2_ __attribute__((ext_vector_type(2)));
DI unsigned pk2(float lo, float hi) { return __builtin_bit_cast(unsigned, __builtin_convertvector((f32x2_){lo, hi}, hwbf2)); }
DI bool wave_any(bool pr) { return __any(pr) != 0; }
#endif
DI float bflo(unsigned w) { return __builtin_bit_cast(float, w << 16); }
DI float bfhi(unsigned w) { return __builtin_bit_cast(float, w & 0xffff0000u); }
DI float sigmoidf_(float x) { return 1.0f / (1.0f + __expf(-x)); }
DI float siluf_(float x) { return x / (1.0f + __expf(-x)); }
DI float wave_sum(float v) {
#pragma unroll
    for (int o = 1; o < 64; o <<= 1) v += __shfl_xor(v, o);
    return v;
}
DI int fresh_tid() {
    int t = threadIdx.x;
#ifndef EMU
    asm volatile("" : "+v"(t));
#endif
    return t;
}
#ifdef EMU
DI float xhalf(float v) { return __shfl_xor(v, 32); }
#else
DI float xhalf(float v) { const unsigned u = __builtin_bit_cast(unsigned, v); const auto r = __builtin_amdgcn_permlane32_swap(u, u, false, false); return __builtin_bit_cast(float, (threadIdx.x & 32) ? r[0] : r[1]); }
#endif
DI f32x16 zero16() { f32x16 z; for (int i = 0; i < 16; ++i) z[i] = 0.f; return z; }
DI f32x4 zero4() { f32x4 z; for (int i = 0; i < 4; ++i) z[i] = 0.f; return z; }
DI int swz128(int row, int c) { return row * 128 + ((c ^ ((row >> 1) & 7)) << 4); }
DI int swz128t(int row, int c) { return row * 128 + ((c ^ ((row >> 1) & 7) ^ ((row >> 4) & 7)) << 4); }
DI int swz128_8(int row, int s) { return row * 128 + ((s ^ (((row >> 1) & 7) << 1)) << 3); }
DI int swzrow(int row, int pitch, int c) { return row * pitch + ((c ^ (row & 15)) << 4); }

#ifdef EMU
#define SMEM_DECL char* smem = emu_smem()
#else
#define SMEM_DECL extern __shared__ __attribute__((aligned(16))) char smem[]
#endif

DI void transpose_item(const float* W, int ldw, int K, bf16* Wt, int k0, int src_n0, int dst_n0, float* scr, int lane) {
#pragma unroll 8
    for (int i = 0; i < 32; ++i) { const int kk = 2 * i + (lane >> 5); scr[kk * 33 + (lane & 31)] = W[(size_t)(k0 + kk) * ldw + src_n0 + (lane & 31)]; }
    WAVE_SYNC();
    const int c = lane & 7;
#pragma unroll
    for (int j = 0; j < 4; ++j) {
        const int n = (lane >> 3) + 8 * j; const float* s = scr + (8 * c) * 33 + n;
        u32x4 o; o.x = pk2(s[0 * 33], s[1 * 33]); o.y = pk2(s[2 * 33], s[3 * 33]); o.z = pk2(s[4 * 33], s[5 * 33]); o.w = pk2(s[6 * 33], s[7 * 33]);
        *(u32x4*)(Wt + (size_t)(dst_n0 + n) * K + k0 + 8 * c) = o;
    }
    WAVE_SYNC();
}

DI void phase0(const Params& p, char* smem, int bid, int nblk) {
    const int tid = fresh_tid(), lane = tid & 63, wave = tid >> 6;
    const int gw = bid * 8 + wave, NGW = nblk * 8;
    unsigned char* ws = p.ws;
    if (bid == 0) {
        unsigned* ctl = (unsigned*)(ws + OFF_SMALL + SM_CTL);
        for (int i = tid; i < 1024; i += NT) ctl[i] = 0u;
        float* be = (float*)(ws + OFF_SMALL + SM_BETA); float* gg = (float*)(ws + OFF_SMALL + SM_G);
        for (int i = tid; i < 48 * 8; i += NT) { be[i] = 0.f; gg[i] = 0.f; }
    }
    {
        float* scr = (float*)(smem + 65536) + wave * (64 * 33);
        constexpr int I_IN = 16 * (9216 / 32), I_SQ = 16 * 32;
        constexpr int NITEMS = I_IN + 3 * I_SQ;
        for (int it = gw; it < NITEMS; it += NGW) {
            int r = it;
            if (r < I_IN) { const int kb = r / 288, nb = r % 288; const int dn = nb * 32; const int sn = dn < 7168 ? dn : dn + 16;
                transpose_item(p.in[3], W_IN_COLS, 1024, (bf16*)(ws + OFF_WTIN), kb * 64, sn, dn, scr, lane); continue; }
            r -= I_IN;
            const int m = r / I_SQ; r %= I_SQ;
            const float* src = m == 0 ? p.in[13] : (m == 1 ? p.in[14] : p.in[15]);
            bf16* dst = (bf16*)(ws + (m == 0 ? OFF_WTBA : (m == 1 ? OFF_WTBD : OFF_WTOUT)));
            transpose_item(src, 1024, 1024, dst, (r / 32) * 64, (r % 32) * 32, (r % 32) * 32, scr, lane);
        }
    }
    {
        bf16* WH = (bf16*)(ws + OFF_SMALL + SM_WR); bf16* WL = WH + 64 * 1024;
        for (int i = bid * NT + tid; i < 64 * 1024; i += nblk * NT) {
            const int n = i >> 10, kk = i & 1023; float v = 0.f;
            if (n < 4) v = p.in[17][kk * 4 + n]; else if (n < 36) v = p.in[19][kk * 32 + (n - 4)];
            v *= p.in[16][kk];
            const unsigned hb = f2bf(v); const float lo = v - bf2f(hb);
            WH[i] = (bf16)hb; WL[i] = (bf16)f2bf(lo);
        }
    }
    float* wbd = (float*)smem;
    for (int i = tid; i < 1024 * 16; i += NT) { const int k = i >> 4, c = i & 15; wbd[c * 1024 + k] = p.in[3][(size_t)k * W_IN_COLS + 7168 + c]; }
    __syncthreads();
    const float* nw = p.in[2];
    for (int R = gw; R < LTOK; R += NGW) {
        const float* xrow = R < NMETA ? p.in[1] + (size_t)R * D : p.in[0] + (size_t)(R - NMETA) * D;
        bf16* urow = R < NMETA ? (bf16*)(ws + OFF_SMALL + SM_UMETA) + (size_t)R * D : (bf16*)(ws + OFF_U) + (size_t)(R - NMETA) * D;
        float ss = 0.f;
#pragma unroll
        for (int j = 0; j < 4; ++j) { const float4 v = *(const float4*)(xrow + 4 * lane + 256 * j); ss += v.x * v.x + v.y * v.y + v.z * v.z + v.w * v.w; }
        ss = wave_sum(ss);
        const float rstd = rsqrtf(ss * (1.0f / D) + NORM_EPS);
        float acc[16];
#pragma unroll
        for (int c = 0; c < 16; ++c) acc[c] = 0.f;
#pragma unroll 1
        for (int j = 0; j < 4; ++j) {
            const float4 w4 = *(const float4*)(nw + 4 * lane + 256 * j);
            const float4 xv = *(const float4*)(xrow + 4 * lane + 256 * j);
            float uu[4] = {xv.x * rstd * w4.x, xv.y * rstd * w4.y, xv.z * rstd * w4.z, xv.w * rstd * w4.w};
            u32x2 o; o.x = pk2(uu[0], uu[1]); o.y = pk2(uu[2], uu[3]);
            *(u32x2*)(urow + 4 * lane + 256 * j) = o;
#pragma unroll
            for (int c = 0; c < 16; ++c) {
                const f32x4 w = *(const f32x4*)(wbd + c * 1024 + 4 * lane + 256 * j);
                acc[c] += uu[0] * w[0] + uu[1] * w[1] + uu[2] * w[2] + uu[3] * w[3];
            }
        }
        float v8[8], v4[4], v2[2], a;
        {
            const bool b0 = lane & 1, b1 = lane & 2, b2 = lane & 4, b3 = lane & 8;
#pragma unroll
            for (int i = 0; i < 8; ++i) { const float keep = b0 ? acc[i + 8] : acc[i], send = b0 ? acc[i] : acc[i + 8]; v8[i] = keep + __shfl_xor(send, 1); }
#pragma unroll
            for (int i = 0; i < 4; ++i) { const float keep = b1 ? v8[i + 4] : v8[i], send = b1 ? v8[i] : v8[i + 4]; v4[i] = keep + __shfl_xor(send, 2); }
#pragma unroll
            for (int i = 0; i < 2; ++i) { const float keep = b2 ? v4[i + 2] : v4[i], send = b2 ? v4[i] : v4[i + 2]; v2[i] = keep + __shfl_xor(send, 4); }
            { const float keep = b3 ? v2[1] : v2[0], send = b3 ? v2[0] : v2[1]; a = keep + __shfl_xor(send, 8); }
            a += __shfl_xor(a, 16); a += __shfl_xor(a, 32);
        }
        if (lane < 16) {
            const int cc = ((lane & 1) << 3) | ((lane & 2) << 1) | ((lane & 4) >> 1) | ((lane & 8) >> 3);
            const size_t pos = 48 + R;
            if (cc < 8) { ((float*)(ws + OFF_SMALL + SM_BETA))[pos * 8 + cc] = sigmoidf_(a); }
            else { const int hh = cc - 8; const float z = a + p.in[11][hh]; const float sp = fmaxf(z, 0.f) + log1pf(__expf(-fabsf(z)));
                   ((float*)(ws + OFF_SMALL + SM_G))[pos * 8 + hh] = -__expf(p.in[10][hh]) * sp; }
        }
    }
}

namespace pg8 {
constexpr int BM = 256, BK = 64, HALF = 128, HTB = HALF * BK * 2, NXCD = 8, WGM = 8;
DI int lds_byte(int r, int c) { const int st = (r >> 4) * 2 + (c >> 5), rr = r & 15, cc = c & 31, ob = rr * 64 + cc * 2; return st * 1024 + (ob ^ (((ob >> 9) & 1) << 5)); }
DI void stage_rc(int b, int& R, int& C) { const int st = b / 1024, sb = b % 1024, swz = sb ^ (((sb >> 9) & 1) << 5); R = (st >> 1) * 16 + swz / 64; C = (st & 1) * 32 + (swz % 64) / 2; }
DI int perm32(int rho) { const int n = rho >> 4, i = rho & 15; return 8 * (i >> 2) + 4 * n + (i & 3); }
struct Unit { int pm, pn; };
struct Gemm { const bf16* A; const bf16* Bt; int M, N, K; };
struct StaticOrder {
    int nM, nN, nwg, G, c;
    DM void init(int M, int N, int G_, int c_) { nM = M / BM; nN = N / BM; nwg = nM * nN; G = G_; c = c_; }
    DM bool next(int i, Unit& u) const {
        const long L = (long)i * G + c; if (L >= nwg) return false;
        int wgid = (int)L; { const int q = nwg / NXCD, r = nwg % NXCD, xcd = wgid % NXCD, off = wgid / NXCD; wgid = (xcd < r ? xcd * (q + 1) : r * (q + 1) + (xcd - r) * q) + off; }
        const int nig = WGM * nN, gid = wgid / nig, fm = gid * WGM, gsz = (nM - fm) < WGM ? (nM - fm) : WGM;
        u.pm = fm + ((wgid % nig) % gsz); u.pn = (wgid % nig) / gsz; return true;
    }
};
#ifdef EMU
template <class Epi>
DI void gemm_phase(char* lds, const Gemm g, const StaticOrder& S, const Epi& E) {
    const int tid = threadIdx.x, wid = tid >> 6, lane = tid & 63, wr = wid >> 2, wc = wid & 3, fr = lane & 15, fq = lane >> 4;
    Unit u;
    for (int ui = 0; S.next(ui, u); ++ui) {
        f32x4 acc[2][2][4][2];
        for (int ai = 0; ai < 2; ++ai) for (int bj = 0; bj < 2; ++bj) for (int m = 0; m < 4; ++m) for (int n = 0; n < 2; ++n) for (int e = 0; e < 4; ++e) {
            const int r = 256 * u.pm + 128 * ai + 64 * wr + 16 * m + fr;
            const int c = 256 * u.pn + 128 * bj + 32 * wc + (Epi::PERM ? 8 * fq + 4 * n : 16 * n + 4 * fq) + e;
            const bf16* a = g.A + (size_t)r * g.K; const bf16* b = g.Bt + (size_t)c * g.K; float s = 0.f;
            for (int k = 0; k < g.K; ++k) s += bf2f(a[k]) * bf2f(b[k]);
            acc[ai][bj][m][n][e] = s;
        }
        E(acc, u, wr, wc, fr, fq);
    }
    __syncthreads();
}
#else
#define PG8_LAS __attribute__((address_space(3)))
template <class Epi>
__device__ __forceinline__ void gemm_phase(char* lds_, const Gemm g, const StaticOrder& S, const Epi& E) {
    PG8_LAS unsigned char* lds = (PG8_LAS unsigned char*)lds_;
    const int tid = fresh_tid(), wid = __builtin_amdgcn_readfirstlane(tid >> 6), lane = tid & 63, wr = wid >> 2, wc = wid & 3, fr = lane & 15, fq = lane >> 4;
    const int K = g.K, nt = K / BK;
    unsigned voffA[2], voffB[2];
#pragma unroll
    for (int i = 0; i < 2; ++i) { int R, C; stage_rc(tid * 16 + i * 8192, R, C); const int Rb = Epi::PERM ? ((R & ~31) + perm32(R & 31)) : R;
        voffA[i] = (unsigned)(R * K + C) * 2u; voffB[i] = (unsigned)(Rb * K + C) * 2u; }
    const size_t kstep = (size_t)(BK * 2);
    const size_t hstep = (size_t)HALF * K * 2;
    const size_t tstep = 2 * hstep;
    const unsigned ldsw = (unsigned)wid * 1024u;
    const int aoff = lds_byte(wr * 64 + fr, fq * 8), boff = lds_byte(wc * 32 + fr, fq * 8);
#define PG8_SA(b, h) (((b) * 2 + (h)) * HTB)
#define PG8_SB(b, h) ((4 + (b) * 2 + (h)) * HTB)
#define PG8_STAGE(bufoff, gbase, voff) do { _Pragma("unroll") for (int _i = 0; _i < 2; ++_i) \
        __builtin_amdgcn_global_load_lds((const unsigned*)((const char*)(gbase) + (voff)[_i]), (PG8_LAS unsigned*)(lds + (bufoff) + ldsw + _i * 8192), 16, 0, 0); } while (0)
#define PG8_LDA(dst, b, h) do { _Pragma("unroll") for (int m = 0; m < 4; ++m) _Pragma("unroll") for (int k = 0; k < 2; ++k) dst[m][k] = *(const PG8_LAS bf16x8*)(lds + PG8_SA(b, h) + aoff + m * 2048 + k * 1024); } while (0)
#define PG8_LDB(dst, b, h) do { _Pragma("unroll") for (int n = 0; n < 2; ++n) _Pragma("unroll") for (int k = 0; k < 2; ++k) dst[n][k] = *(const PG8_LAS bf16x8*)(lds + PG8_SB(b, h) + boff + n * 2048 + k * 1024); } while (0)
#define PG8_MMA(ai, bj, At, Bt) do { __builtin_amdgcn_s_setprio(1); _Pragma("unroll") for (int m = 0; m < 4; ++m) _Pragma("unroll") for (int n = 0; n < 2; ++n) _Pragma("unroll") for (int k = 0; k < 2; ++k) \
        acc[ai][bj][m][n] = __builtin_amdgcn_mfma_f32_16x16x32_bf16(Bt[n][k], At[m][k], acc[ai][bj][m][n], 0, 0, 0); __builtin_amdgcn_s_setprio(0); } while (0)
#define PG8_WAIT_V(n) asm volatile("s_waitcnt vmcnt(" #n ")" ::: "memory")
#define PG8_WAIT_L(n) asm volatile("s_waitcnt lgkmcnt(" #n ")" ::: "memory")
#define PG8_BAR __builtin_amdgcn_s_barrier()
#define PG8_SCHED __builtin_amdgcn_sched_barrier(0)
    Unit cur, nxt; int ui = 0;
    if (S.next(0, cur)) {
    f32x4 acc[2][2][4][2];
#pragma unroll
    for (int a = 0; a < 2; ++a)
#pragma unroll
        for (int b = 0; b < 2; ++b)
#pragma unroll
            for (int m = 0; m < 4; ++m)
#pragma unroll
                for (int n = 0; n < 2; ++n) acc[a][b][m][n] = (f32x4){0.f, 0.f, 0.f, 0.f};
    bf16x8 At[4][2], B0[2][2], B1[2][2];
    const char* cA = (const char*)g.A + (size_t)cur.pm * tstep; const char* cB = (const char*)g.Bt + (size_t)cur.pn * tstep;
    PG8_STAGE(PG8_SB(0, 0), cB, voffB); PG8_STAGE(PG8_SA(0, 0), cA, voffA); PG8_STAGE(PG8_SB(0, 1), cB + hstep, voffB); PG8_STAGE(PG8_SA(0, 1), cA + hstep, voffA);
    if (wr == 1) PG8_BAR;
    PG8_WAIT_V(4); PG8_BAR;
    PG8_STAGE(PG8_SB(1, 0), cB + kstep, voffB); PG8_STAGE(PG8_SA(1, 0), cA + kstep, voffA); PG8_STAGE(PG8_SB(1, 1), cB + hstep + kstep, voffB);
    PG8_WAIT_V(6); PG8_BAR;
    for (;;) {
        const bool has_next = S.next(ui + 1, nxt);
        const char* nA = has_next ? (const char*)g.A + (size_t)nxt.pm * tstep : cA; const char* nB = has_next ? (const char*)g.Bt + (size_t)nxt.pn * tstep : cB;
        for (int t = 0; t < nt; t += 2) {
            const bool last = (t == nt - 2);
            const char* a1 = cA + (size_t)(t + 1) * kstep;
            const char* a2 = last ? nA : cA + (size_t)(t + 2) * kstep; const char* b2 = last ? nB : cB + (size_t)(t + 2) * kstep;
            const char* a3 = a2 + kstep; const char* b3 = b2 + kstep;
            PG8_LDB(B0, 0, 0); PG8_SCHED; PG8_LDA(At, 0, 0); PG8_STAGE(PG8_SA(1, 1), a1 + hstep, voffA);
            PG8_WAIT_L(8); PG8_BAR; PG8_WAIT_L(0); PG8_MMA(0, 0, At, B0); PG8_BAR; PG8_SCHED;
            PG8_LDB(B1, 0, 1); PG8_STAGE(PG8_SB(0, 0), b2, voffB);
            PG8_BAR; PG8_WAIT_L(0); PG8_MMA(0, 1, At, B1); PG8_BAR;
            PG8_LDA(At, 0, 1); PG8_STAGE(PG8_SA(0, 0), a2, voffA);
            PG8_BAR; PG8_WAIT_L(0); PG8_MMA(1, 0, At, B0); PG8_BAR; PG8_SCHED;
            PG8_STAGE(PG8_SB(0, 1), b2 + hstep, voffB);
            PG8_WAIT_V(6); PG8_BAR; PG8_MMA(1, 1, At, B1); PG8_BAR;
            PG8_LDB(B0, 1, 0); PG8_SCHED; PG8_LDA(At, 1, 0); PG8_STAGE(PG8_SA(0, 1), a2 + hstep, voffA);
            PG8_WAIT_L(8); PG8_BAR; PG8_WAIT_L(0); PG8_MMA(0, 0, At, B0); PG8_BAR; PG8_SCHED;
            PG8_LDB(B1, 1, 1); PG8_STAGE(PG8_SB(1, 0), b3, voffB);
            PG8_BAR; PG8_WAIT_L(0); PG8_MMA(0, 1, At, B1); PG8_BAR;
            PG8_LDA(At, 1, 1); PG8_STAGE(PG8_SA(1, 0), a3, voffA);
            PG8_BAR; PG8_WAIT_L(0); PG8_MMA(1, 0, At, B0); PG8_BAR; PG8_SCHED;
            PG8_STAGE(PG8_SB(1, 1), b3 + hstep, voffB);
            PG8_WAIT_V(6); PG8_BAR; PG8_MMA(1, 1, At, B1); PG8_BAR;
        }
        E(acc, cur, wr, wc, fr, fq);
        if (!has_next) break;
#pragma unroll
        for (int a = 0; a < 2; ++a)
#pragma unroll
            for (int b = 0; b < 2; ++b)
#pragma unroll
                for (int m = 0; m < 4; ++m)
#pragma unroll
                    for (int n = 0; n < 2; ++n) acc[a][b][m][n] = (f32x4){0.f, 0.f, 0.f, 0.f};
        cur = nxt; cA = nA; cB = nB; ++ui;
    }
    PG8_WAIT_V(0);
    if (wr == 0) PG8_BAR;
    PG8_BAR;
    }
    __syncthreads();
#undef PG8_SA
#undef PG8_SB
#undef PG8_STAGE
#undef PG8_LDA
#undef PG8_LDB
#undef PG8_MMA
#undef PG8_WAIT_V
#undef PG8_WAIT_L
#undef PG8_BAR
#undef PG8_SCHED
}
#endif
}

constexpr int G_BM = 256, G_BN = 128, G_BK = 64;
constexpr int G_LDS_A = G_BM * G_BK * 2, G_LDS_B = G_BN * G_BK * 2;
constexpr int G_STAGE_PITCH = 132;
constexpr int G_LDS_BYTES = G_BM * G_STAGE_PITCH * 4;
constexpr int G_MT = SEQ / 256 + 1, G_NTILES = 56;

DI void gemm_inproj_tile(const Params& p, char* smem, int mt, int nt) {
    const int tid = fresh_tid(), lane = tid & 63, wave = tid >> 6;
    const int wm = wave >> 1, wn = wave & 1, r32 = lane & 31, h = lane >> 5;
    unsigned char* ws = p.ws;
    const bool meta = (mt == G_MT - 1);
    const bf16* A = meta ? (const bf16*)(ws + OFF_SMALL + SM_UMETA) : (const bf16*)(ws + OFF_U) + (size_t)mt * 256 * D;
    const int vrows = meta ? NMETA : 256;
    const bf16* Bt = (const bf16*)(ws + OFF_WTIN) + (size_t)nt * 128 * D;
    char* ldsA[2] = {smem, smem + G_LDS_A + G_LDS_B};
    char* ldsB[2] = {smem + G_LDS_A, smem + 2 * G_LDS_A + G_LDS_B};
    f32x16 acc[2][2];
#pragma unroll
    for (int i = 0; i < 2; ++i)
#pragma unroll
        for (int j = 0; j < 2; ++j) acc[i][j] = zero16();
    const int lrow = tid >> 3, lc = tid & 7;
    u32x4 ra[4], rb[2];
    auto gload = [&](int kt) {
#pragma unroll
        for (int i = 0; i < 4; ++i) { const int row = lrow + 64 * i; ra[i] = row < vrows ? *(const u32x4*)(A + (size_t)row * D + kt * 64 + lc * 8) : (u32x4){0u, 0u, 0u, 0u}; }
#pragma unroll
        for (int i = 0; i < 2; ++i) { const int row = lrow + 64 * i; rb[i] = *(const u32x4*)(Bt + (size_t)row * D + kt * 64 + lc * 8); }
    };
    auto lstore = [&](int buf) {
#pragma unroll
        for (int i = 0; i < 4; ++i) *(u32x4*)(ldsA[buf] + swz128(lrow + 64 * i, lc)) = ra[i];
#pragma unroll
        for (int i = 0; i < 2; ++i) *(u32x4*)(ldsB[buf] + swz128(lrow + 64 * i, lc)) = rb[i];
    };
    gload(0); lstore(0); __syncthreads();
    for (int kt = 0; kt < 16; ++kt) {
        const int buf = kt & 1;
        if (kt + 1 < 16) gload(kt + 1);
#pragma unroll
        for (int ks = 0; ks < 4; ++ks) {
            bf16x8 af[2], bfr[2];
#pragma unroll
            for (int i = 0; i < 2; ++i) af[i] = *(const bf16x8*)(ldsA[buf] + swz128(64 * wm + 32 * i + r32, 2 * ks + h));
#pragma unroll
            for (int j = 0; j < 2; ++j) bfr[j] = *(const bf16x8*)(ldsB[buf] + swz128(64 * wn + 32 * j + r32, 2 * ks + h));
#pragma unroll
            for (int i = 0; i < 2; ++i)
#pragma unroll
                for (int j = 0; j < 2; ++j) acc[i][j] = MFMA32(af[i], bfr[j], acc[i][j]);
        }
        if (kt + 1 < 16) lstore(buf ^ 1);
        __syncthreads();
    }
    float* st = (float*)smem;
#pragma unroll
    for (int i = 0; i < 2; ++i)
#pragma unroll
        for (int j = 0; j < 2; ++j)
#pragma unroll
            for (int r = 0; r < 16; ++r) {
                const int row = 64 * wm + 32 * i + (r & 3) + 8 * (r >> 2) + 4 * h, col = 64 * wn + 32 * j + r32;
                st[row * G_STAGE_PITCH + col] = acc[i][j][r];
            }
    __syncthreads();
    const int tid2 = fresh_tid();
    const int sec = nt >> 3, cb = (nt & 7) * 128;
    {
        bf16* base; bool has_meta = true; bf16* mbase = nullptr; int mrow0 = 0;
        if (sec == 0) { base = (bf16*)(ws + OFF_AQ); has_meta = false; }
        else if (sec == 1) { base = (bf16*)p.out; mbase = (bf16*)(ws + OFF_SMALL + SM_AKMETA); }
        else if (sec == 2) { base = (bf16*)p.out + (size_t)SEQ * D; mbase = (bf16*)(ws + OFF_SMALL + SM_AVTMETA); }
        else if (sec == 3) { base = (bf16*)(ws + OFF_QN); mbase = (bf16*)(ws + OFF_SMALL + SM_C0Q); mrow0 = 48; }
        else if (sec == 4) { base = (bf16*)(ws + OFF_KN); mbase = (bf16*)(ws + OFF_SMALL + SM_C0K); mrow0 = 48; }
        else if (sec == 5) { base = (bf16*)(ws + OFF_V); mbase = (bf16*)(ws + OFF_SMALL + SM_C0V); mrow0 = 48; }
        else { base = (bf16*)(ws + OFF_DG); has_meta = false; }
        const bool dqkv = (sec >= 3 && sec <= 5);
        bf16* tails = (bf16*)(ws + OFF_SMALL + SM_TAILS);
        if (!meta || has_meta) {
#pragma unroll
            for (int i = 0; i < 8; ++i) {
                const int idx = tid2 + NT * i, row = idx >> 4, cg = idx & 15;
                if (row < vrows) {
                    const float* s = st + row * G_STAGE_PITCH + cg * 8;
                    const f32x4 a = *(const f32x4*)s, b = *(const f32x4*)(s + 4);
                    u32x4 o; o.x = pk2(a[0], a[1]); o.y = pk2(a[2], a[3]); o.z = pk2(b[0], b[1]); o.w = pk2(b[2], b[3]);
                    if (!meta) {
                        const int j = mt * 256 + row;
                        *(u32x4*)(base + (size_t)j * D + cb + cg * 8) = o;
                        if (dqkv && (j & 63) >= 61) *(u32x4*)(tails + ((size_t)(j / 64 + 1) * 3 + ((j & 63) - 61)) * 3072 + (sec - 3) * 1024 + cb + cg * 8) = o;
                    } else {
                        *(u32x4*)(mbase + (size_t)(mrow0 + row) * D + cb + cg * 8) = o;
                        if (dqkv && row >= 13) *(u32x4*)(tails + ((size_t)0 * 3 + (row - 13)) * 3072 + (sec - 3) * 1024 + cb + cg * 8) = o;
                    }
                }
            }
        }
    }
    __syncthreads();
}

struct EpiInproj {
    static constexpr bool PERM = true;
    unsigned char* ws; bf16* out16;
    DM void operator()(const f32x4 (&acc)[2][2][4][2], const pg8::Unit& u, int wr, int wc, int fr, int fq) const {
        const int colt = u.pn * 256, sec = colt >> 10, cb = colt & 1023;
        bf16* base = sec == 0 ? (bf16*)(ws + OFF_AQ) : sec == 1 ? out16 : sec == 2 ? out16 + (size_t)SEQ * D : sec == 3 ? (bf16*)(ws + OFF_QN) : sec == 4 ? (bf16*)(ws + OFF_KN)
                   : sec == 5 ? (bf16*)(ws + OFF_V) : (bf16*)(ws + OFF_DG);
        const bool dqkv = sec >= 3 && sec <= 5;
        bf16* tails = (bf16*)(ws + OFF_SMALL + SM_TAILS) + (sec - 3) * 1024;
        const int row0 = u.pm * 256 + wr * 64 + fr, col0 = cb + wc * 32 + 8 * fq;
#pragma unroll
        for (int ai = 0; ai < 2; ++ai)
#pragma unroll
            for (int m = 0; m < 4; ++m) {
                const int j = row0 + ai * 128 + m * 16;
                bf16* rowp = base + (size_t)j * D + col0;
                const bool tl = dqkv && (j & 63) >= 61;
#pragma unroll
                for (int bj = 0; bj < 2; ++bj) {
                    const f32x4 v0 = acc[ai][bj][m][0], v1 = acc[ai][bj][m][1];
                    const u32x4 w = {pk2(v0[0], v0[1]), pk2(v0[2], v0[3]), pk2(v1[0], v1[1]), pk2(v1[2], v1[3])};
                    *(u32x4*)(rowp + bj * 128) = w;
                    if (tl) *(u32x4*)(tails + ((size_t)(j / 64 + 1) * 3 + ((j & 63) - 61)) * 3072 + col0 + bj * 128) = w;
                }
            }
    }
};
DI void phase1(const Params& p, char* smem, int bid, int nblk) {
    for (int it = bid; it < 40; it += nblk) gemm_inproj_tile(p, smem, G_MT - 1, 8 + it);
    pg8::Gemm g{(const bf16*)(p.ws + OFF_U), (const bf16*)(p.ws + OFF_WTIN), SEQ, 7168, 1024};
    pg8::StaticOrder S; S.init(SEQ, 7168, nblk, bid);
    EpiInproj E{p.ws, (bf16*)p.out};
    pg8::gemm_phase(smem, g, S, E);
}

constexpr int P2_KN = 0, P2_KB = 16384, P2_QN = 32768, P2_KBGT = 49152, P2_VBT = 65536, P2_KDT = 81920, P2_ALDS = 98304, P2_TLDS = P2_ALDS + 64 * 64 * 4,
              P2_GC = P2_TLDS + 8192, P2_BET = P2_GC + 256, P2_EG = P2_BET + 256, P2_EKD = P2_EG + 256;

DI void prep_item(const Params& p, char* smem, int chunk, int head, int dry) {
    const int tid = fresh_tid(), lane = tid & 63, wave = tid >> 6, r32 = lane & 31, h = lane >> 5;
    unsigned char* ws = p.ws;
    float* gcl = (float*)(smem + P2_GC); float* betl = (float*)(smem + P2_BET); float* egl = (float*)(smem + P2_EG); float* ekdl = (float*)(smem + P2_EKD);
    if (wave == 0) {
        const size_t pos = (size_t)chunk * 64 + lane;
        float v = ((const float*)(ws + OFF_SMALL + SM_G))[pos * 8 + head];
        const float b = ((const float*)(ws + OFF_SMALL + SM_BETA))[pos * 8 + head];
#pragma unroll
        for (int o = 1; o < 64; o <<= 1) { const float t = __shfl_up(v, o); if (lane >= o) v += t; }
        const float gl = __shfl(v, 63);
        gcl[lane] = v; betl[lane] = b; egl[lane] = __expf(v); ekdl[lane] = __expf(gl - v);
        if (!dry) ((float*)(ws + OFF_SMALL + SM_GC))[((size_t)chunk * 8 + head) * 64 + lane] = v;
    }
    __syncthreads();
    {
        const int r = tid >> 3, cg = tid & 7, col0 = head * 128 + 16 * cg;
        const bool zero_row = (chunk == 0 && r < 48);
        const float beta = betl[r], eg = egl[r], ekd = ekdl[r];
        const bf16* tails = (const bf16*)(ws + OFF_SMALL + SM_TAILS);
#pragma unroll 1
        for (int mat = 0; mat < 3; ++mat) {
            bf16* mainb = (bf16*)(ws + (mat == 0 ? OFF_QN : (mat == 1 ? OFF_KN : OFF_V)));
            bf16* c0b = (bf16*)(ws + OFF_SMALL + (mat == 0 ? SM_C0Q : (mat == 1 ? SM_C0K : SM_C0V)));
            float y[16];
#pragma unroll
            for (int c = 0; c < 16; ++c) y[c] = 0.f;
#pragma unroll
            for (int jj = 0; jj < 4; ++jj) {
                const int rr = r - 3 + jj;
                const bf16* src = nullptr;
                if (chunk == 0) { if (rr >= 48) src = c0b + (size_t)rr * D + col0; }
                else if (rr >= 0) src = mainb + ((size_t)(chunk - 1) * 64 + rr) * D + col0;
                else src = tails + ((size_t)(chunk - 1) * 3 + (3 + rr)) * 3072 + mat * 1024 + col0;
                u32x4 a = {0u, 0u, 0u, 0u}, b = {0u, 0u, 0u, 0u};
                if (src) { a = *(const u32x4*)src; b = *(const u32x4*)(src + 8); }
                const float* cw = p.in[9] + (size_t)jj * 3072 + mat * 1024 + col0;
                const f32x4 w0 = *(const f32x4*)cw, w1 = *(const f32x4*)(cw + 4), w2 = *(const f32x4*)(cw + 8), w3 = *(const f32x4*)(cw + 12);
                y[0] += w0[0] * bflo(a.x); y[1] += w0[1] * bfhi(a.x); y[2] += w0[2] * bflo(a.y); y[3] += w0[3] * bfhi(a.y);
                y[4] += w1[0] * bflo(a.z); y[5] += w1[1] * bfhi(a.z); y[6] += w1[2] * bflo(a.w); y[7] += w1[3] * bfhi(a.w);
                y[8] += w2[0] * bflo(b.x); y[9] += w2[1] * bfhi(b.x); y[10] += w2[2] * bflo(b.y); y[11] += w2[3] * bfhi(b.y);
                y[12] += w3[0] * bflo(b.z); y[13] += w3[1] * bfhi(b.z); y[14] += w3[2] * bflo(b.w); y[15] += w3[3] * bfhi(b.w);
            }
            if (mat == 0) __syncthreads();
            float ss = 0.f;
#pragma unroll
            for (int c = 0; c < 16; ++c) { y[c] = zero_row ? 0.f : siluf_(y[c]); ss += y[c] * y[c]; }
            if (mat < 2) {
                ss += __shfl_xor(ss, 1); ss += __shfl_xor(ss, 2); ss += __shfl_xor(ss, 4);
                const float sc = rsqrtf(ss + 1e-6f) * (mat == 0 ? 0.08838834764831845f : 1.0f);
                unsigned pk[8];
#pragma unroll
                for (int c = 0; c < 8; ++c) pk[c] = pk2(y[2 * c] * sc, y[2 * c + 1] * sc);
                if (mat == 0) {
                    *(u32x4*)(smem + P2_QN + swzrow(r, 256, 2 * cg)) = (u32x4){pk[0], pk[1], pk[2], pk[3]};
                    *(u32x4*)(smem + P2_QN + swzrow(r, 256, 2 * cg + 1)) = (u32x4){pk[4], pk[5], pk[6], pk[7]};
                    unsigned qd[8];
#pragma unroll
                    for (int c = 0; c < 8; ++c) qd[c] = pk2(bflo(pk[c]) * eg, bfhi(pk[c]) * eg);
                    bf16* dst = (chunk == 0) ? c0b + (size_t)r * D + col0 : mainb + ((size_t)(chunk - 1) * 64 + r) * D + col0;
                    if (!dry) { *(u32x4*)dst = (u32x4){qd[0], qd[1], qd[2], qd[3]}; *(u32x4*)(dst + 8) = (u32x4){qd[4], qd[5], qd[6], qd[7]}; }
                } else {
                    *(u32x4*)(smem + P2_KN + swzrow(r, 256, 2 * cg)) = (u32x4){pk[0], pk[1], pk[2], pk[3]};
                    *(u32x4*)(smem + P2_KN + swzrow(r, 256, 2 * cg + 1)) = (u32x4){pk[4], pk[5], pk[6], pk[7]};
                    unsigned kb[8];
#pragma unroll
                    for (int c = 0; c < 8; ++c) {
                        const float kr0 = bflo(pk[c]), kr1 = bfhi(pk[c]);
                        const float k0 = kr0 * beta, k1 = kr1 * beta;
                        kb[c] = pk2(k0, k1);
                        const int d0 = 16 * cg + 2 * c;
                        *(bf16*)(smem + P2_KBGT + swz128t(d0, r >> 3) + (r & 7) * 2) = (bf16)f2bf(k0 * eg);
                        *(bf16*)(smem + P2_KBGT + swz128t(d0 + 1, r >> 3) + (r & 7) * 2) = (bf16)f2bf(k1 * eg);
                        *(bf16*)(smem + P2_KDT + swz128t(d0, r >> 3) + (r & 7) * 2) = (bf16)f2bf(kr0 * ekd);
                        *(bf16*)(smem + P2_KDT + swz128t(d0 + 1, r >> 3) + (r & 7) * 2) = (bf16)f2bf(kr1 * ekd);
                    }
                    *(u32x4*)(smem + P2_KB + swzrow(r, 256, 2 * cg)) = (u32x4){kb[0], kb[1], kb[2], kb[3]};
                    *(u32x4*)(smem + P2_KB + swzrow(r, 256, 2 * cg + 1)) = (u32x4){kb[4], kb[5], kb[6], kb[7]};
                }
            } else {
#pragma unroll
                for (int c = 0; c < 16; ++c) {
                    const int e = 16 * cg + c;
                    *(bf16*)(smem + P2_VBT + swz128t(e, r >> 3) + (r & 7) * 2) = (bf16)f2bf(y[c] * beta);
                }
            }
        }
    }
    __syncthreads();
    {
        const int tile = wave & 3, m0 = tile >> 1, n0 = tile & 1;
        f32x16 acc = zero16();
        if (wave < 4) {
            if (n0 <= m0) {
#pragma unroll
                for (int ks = 0; ks < 8; ++ks) {
                    const bf16x8 a = *(const bf16x8*)(smem + P2_KB + swzrow(32 * m0 + r32, 256, 2 * ks + h));
                    const bf16x8 b = *(const bf16x8*)(smem + P2_KN + swzrow(32 * n0 + r32, 256, 2 * ks + h));
                    acc = MFMA32(a, b, acc);
                }
            }
            float* Al = (float*)(smem + P2_ALDS);
            const int j = 32 * n0 + r32; const float gj = gcl[j];
#pragma unroll
            for (int r = 0; r < 16; ++r) {
                const int i = 32 * m0 + (r & 3) + 8 * (r >> 2) + 4 * h;
                const float dv = acc[r] * __expf(gcl[i] - gj);
                Al[i * 64 + (j & 3) * 16 + (j >> 2)] = (j < i) ? dv : 0.f;
            }
        } else {
            if (m0 <= n0) {
#pragma unroll
                for (int ks = 0; ks < 8; ++ks) {
                    const bf16x8 a = *(const bf16x8*)(smem + P2_KN + swzrow(32 * m0 + r32, 256, 2 * ks + h));
                    const bf16x8 b = *(const bf16x8*)(smem + P2_QN + swzrow(32 * n0 + r32, 256, 2 * ks + h));
                    acc = MFMA32(a, b, acc);
                }
            }
            const int i = 32 * n0 + r32; const float gi = gcl[i];
            bf16* qkb = (chunk == 0) ? (bf16*)(ws + OFF_SMALL + SM_C0QK) + (size_t)head * 4096 : (bf16*)(ws + OFF_QKB) + ((size_t)(chunk - 1) * 8 + head) * 4096;
#pragma unroll
            for (int q4 = 0; q4 < 4; ++q4) {
                const int j0 = 32 * m0 + 8 * q4 + 4 * h; float v[4];
#pragma unroll
                for (int c = 0; c < 4; ++c) { const int j = j0 + c; const float dv = acc[4 * q4 + c] * __expf(gi - gcl[j]); v[c] = (j <= i) ? dv : 0.f; }
                if (!dry) *(u32x2*)(qkb + i * 64 + j0) = (u32x2){pk2(v[0], v[1]), pk2(v[2], v[3])};
            }
        }
        bf16* kbase = (chunk == 0) ? (bf16*)(ws + OFF_SMALL + SM_C0K) : (bf16*)(ws + OFF_KN) + (size_t)(chunk - 1) * 64 * D;
#pragma unroll
        for (int i2 = 0; i2 < 2; ++i2) {
            const int idx = tid + NT * i2, dk = idx >> 3, ch = idx & 7;
            const u32x4 v = *(const u32x4*)(smem + P2_KDT + swz128t(dk, ch));
            if (!dry) *(u32x4*)(kbase + (size_t)(dk >> 1) * D + head * 128 + (dk & 1) * 64 + ch * 8) = v;
        }
    }
    __syncthreads();
    if (wave < 4) {
        const float* Al = (const float*)(smem + P2_ALDS);
        const int c = lane >> 2, q = lane & 3, C = 16 * wave + c;
        float tq[16];
#pragma unroll
        for (int m = 0; m < 16; ++m) tq[m] = 0.f;
#pragma unroll
        for (int i = 0; i < 64; ++i) {
            constexpr int dummy = 0; (void)dummy;
            const int nm = (i + 3) >> 2;
            float s0 = 0.f, s1 = 0.f;
            const float* ar = Al + i * 64 + q * 16;
#pragma unroll
            for (int m = 0; m < 16; ++m) if (m < nm) { if (m & 1) s1 += ar[m] * tq[m]; else s0 += ar[m] * tq[m]; }
            float s = s0 + s1;
            s += __shfl_xor(s, 1); s += __shfl_xor(s, 2);
            const float ti = ((i == C) ? 1.f : 0.f) - s;
            if (q == (i & 3)) tq[i >> 2] = ti;
        }
#pragma unroll
        for (int m = 0; m < 16; ++m) { const int row = 4 * m + q; *(bf16*)(smem + P2_TLDS + swz128(row, C >> 3) + (C & 7) * 2) = (bf16)f2bf(tq[m]); }
    }
    __syncthreads();
    {
        const int mi = wave >> 2, ni = wave & 3;
        f32x16 acc = zero16();
#pragma unroll
        for (int ks = 0; ks < 4; ++ks) {
            const bf16x8 a = *(const bf16x8*)(smem + P2_TLDS + swz128(32 * mi + r32, 2 * ks + h));
            const bf16x8 b = *(const bf16x8*)(smem + P2_VBT + swz128t(32 * ni + r32, 2 * ks + h));
            acc = MFMA32(a, b, acc);
        }
        const int e = 32 * ni + r32;
        bf16* base = (chunk == 0) ? (bf16*)(ws + OFF_SMALL + SM_C0V) : (bf16*)(ws + OFF_V) + (size_t)(chunk - 1) * 64 * D;
        bf16* dst = base + (size_t)(e >> 1) * D + head * 128 + (e & 1) * 64;
#pragma unroll
        for (int q4 = 0; q4 < 4; ++q4) {
            const int c0 = 32 * mi + 8 * q4 + 4 * h;
            if (!dry) *(u32x2*)(dst + c0) = (u32x2){pk2(acc[4 * q4], acc[4 * q4 + 1]), pk2(acc[4 * q4 + 2], acc[4 * q4 + 3])};
        }
    }
    {
        const int mi = wave >> 1, ni = wave & 1;
        f32x16 acc = zero16();
#pragma unroll
        for (int ks = 0; ks < 4; ++ks) {
            const bf16x8 a = *(const bf16x8*)(smem + P2_KBGT + swz128t(32 * mi + r32, 2 * ks + h));
            const bf16x8 b = *(const bf16x8*)(smem + P2_TLDS + swz128(32 * ni + r32, 2 * ks + h));
            acc = MFMA32(a, b, acc);
        }
        const int c = 32 * ni + r32;
        bf16* wb = (chunk == 0) ? (bf16*)(ws + OFF_SMALL + SM_C0W) + (size_t)head * 8192 : (bf16*)(ws + OFF_W) + ((size_t)(chunk - 1) * 8 + head) * 8192;
#pragma unroll
        for (int q4 = 0; q4 < 4; ++q4) {
            const int dk0 = 32 * mi + 8 * q4 + 4 * h;
            if (!dry) *(u32x2*)(wb + c * 128 + dk0) = (u32x2){pk2(acc[4 * q4], acc[4 * q4 + 1]), pk2(acc[4 * q4 + 2], acc[4 * q4 + 3])};
        }
    }
    __syncthreads();
}

DI void phase2(const Params& p, char* smem, int bid, int nblk, int dry = 0) {
    for (int it = bid; it < NCH * 8; it += nblk) prep_item(p, smem, it >> 3, it & 7, dry);
    {
        const int tid = fresh_tid(), lane = tid & 63, wave = tid >> 6;
        const int gw = bid * 8 + wave, NGW = nblk * 8;
        float mq = 0.f, mk = 0.f;
        for (int j = gw; j < SEQ + NMETA; j += NGW) {
            const bf16* kr = j < SEQ ? (const bf16*)p.out + (size_t)j * D + lane * 16 : (const bf16*)(p.ws + OFF_SMALL + SM_AKMETA) + (size_t)(j - SEQ) * D + lane * 16;
            const u32x4 a = *(const u32x4*)kr, b = *(const u32x4*)(kr + 8);
            float s = bflo(a.x) * bflo(a.x) + bfhi(a.x) * bfhi(a.x) + bflo(a.y) * bflo(a.y) + bfhi(a.y) * bfhi(a.y) + bflo(a.z) * bflo(a.z) + bfhi(a.z) * bfhi(a.z) + bflo(a.w) * bflo(a.w) + bfhi(a.w) * bfhi(a.w)
                    + bflo(b.x) * bflo(b.x) + bfhi(b.x) * bfhi(b.x) + bflo(b.y) * bflo(b.y) + bfhi(b.y) * bfhi(b.y) + bflo(b.z) * bflo(b.z) + bfhi(b.z) * bfhi(b.z) + bflo(b.w) * bflo(b.w) + bfhi(b.w) * bfhi(b.w);
            s += __shfl_xor(s, 1); s += __shfl_xor(s, 2);
            mk = fmaxf(mk, s);
            if (j < SEQ) {
                const bf16* qr = (const bf16*)(p.ws + OFF_AQ) + (size_t)j * D + lane * 16;
                const u32x4 c = *(const u32x4*)qr, d = *(const u32x4*)(qr + 8);
                float t = bflo(c.x) * bflo(c.x) + bfhi(c.x) * bfhi(c.x) + bflo(c.y) * bflo(c.y) + bfhi(c.y) * bfhi(c.y) + bflo(c.z) * bflo(c.z) + bfhi(c.z) * bfhi(c.z) + bflo(c.w) * bflo(c.w) + bfhi(c.w) * bfhi(c.w)
                        + bflo(d.x) * bflo(d.x) + bfhi(d.x) * bfhi(d.x) + bflo(d.y) * bflo(d.y) + bfhi(d.y) * bfhi(d.y) + bflo(d.z) * bflo(d.z) + bfhi(d.z) * bfhi(d.z) + bflo(d.w) * bflo(d.w) + bfhi(d.w) * bfhi(d.w);
                t += __shfl_xor(t, 1); t += __shfl_xor(t, 2);
                mq = fmaxf(mq, t);
            }
        }
        if ((lane & 3) == 0) {
            unsigned* nrm = (unsigned*)(p.ws + OFF_SMALL + SM_CTL) + CW_NRM;
            atomicMax(nrm + (lane >> 2), __builtin_bit_cast(unsigned, mq));
            atomicMax(nrm + 16 + (lane >> 2), __builtin_bit_cast(unsigned, mk));
        }
    }
}

DI int swzrow8(int row, int pitch, int s) { return row * pitch + ((((s >> 1) ^ (row & 15)) << 4) | ((s & 1) << 3)); }
DI bf16x8 pack8(f32x4 a, f32x4 b) {
    u32x4 o; o.x = pk2(a[0], a[1]); o.y = pk2(a[2], a[3]); o.z = pk2(b[0], b[1]); o.w = pk2(b[2], b[3]);
    return __builtin_bit_cast(bf16x8, o);
}
DI bf16x8 ld2x8(const char* p0, const char* p1) {
    const u32x2 a = *(const u32x2*)p0, b = *(const u32x2*)p1; u32x4 o; o.x = a.x; o.y = a.y; o.z = b.x; o.w = b.y;
    return __builtin_bit_cast(bf16x8, o);
}
constexpr int SC_W = 0, SC_QD = 16384, SC_KDT = 32768, SC_QK = 49152, SC_BUF = 57344;

constexpr int SCAN_SPLIT = 4;
DI void scan_head(const Params& p, char* smem, int head, int sidx, int dry) {
    const int tid = fresh_tid(), lane = tid & 63, wave = tid >> 6, r16 = lane & 15, g = lane >> 4;
    const bool active = wave < 8 / SCAN_SPLIT; const int slice = sidx * (8 / SCAN_SPLIT) + (active ? wave : 0);
    unsigned char* ws = p.ws;
    const int lrow = tid >> 3, lch = (tid & 7) * 2;
    f32x4 S[8];
#pragma unroll
    for (int i = 0; i < 8; ++i) S[i] = zero4();
    u32x4 rw[2], rq[2], rk[2], rqk; u32x2 unext[4], ucur[4]; float gnext = 0.f, gcur = 0.f;
    auto uaddr = [&](int n, int mt) -> bf16* {
        const int e = 16 * slice + r16;
        bf16* base = n == 0 ? (bf16*)(ws + OFF_SMALL + SM_C0V) : (bf16*)(ws + OFF_V) + (size_t)(n - 1) * 64 * D;
        return base + (size_t)(e >> 1) * D + head * 128 + (e & 1) * 64 + 16 * mt + 4 * g;
    };
    auto gloadA = [&](int n) {
        const bf16* wsrc = (n == 0 ? (const bf16*)(ws + OFF_SMALL + SM_C0W) + (size_t)head * 8192 : (const bf16*)(ws + OFF_W) + ((size_t)(n - 1) * 8 + head) * 8192) + lrow * 128 + lch * 8;
        rw[0] = *(const u32x4*)wsrc; rw[1] = *(const u32x4*)(wsrc + 8);
        const bf16* qs = (n == 0 ? (const bf16*)(ws + OFF_SMALL + SM_C0Q) : (const bf16*)(ws + OFF_QN) + (size_t)(n - 1) * 64 * D) + (size_t)lrow * D + head * 128 + lch * 8;
        rq[0] = *(const u32x4*)qs; rq[1] = *(const u32x4*)(qs + 8);
        const bf16* ks = (n == 0 ? (const bf16*)(ws + OFF_SMALL + SM_C0K) : (const bf16*)(ws + OFF_KN) + (size_t)(n - 1) * 64 * D) + (size_t)lrow * D + head * 128 + lch * 8;
        rk[0] = *(const u32x4*)ks; rk[1] = *(const u32x4*)(ks + 8);
        const bf16* qk = (n == 0 ? (const bf16*)(ws + OFF_SMALL + SM_C0QK) + (size_t)head * 4096 : (const bf16*)(ws + OFF_QKB) + ((size_t)(n - 1) * 8 + head) * 4096) + tid * 8;
        rqk = *(const u32x4*)qk;
    };
    auto gloadU = [&](int n) {
#pragma unroll
        for (int mt = 0; mt < 4; ++mt) unext[mt] = *(const u32x2*)uaddr(n, mt);
        gnext = ((const float*)(ws + OFF_SMALL + SM_GC))[((size_t)n * 8 + head) * 64 + 63];
    };
    auto lwrite = [&](int buf) {
        char* b = smem + buf * SC_BUF;
        const int c7 = tid & 7, kb = c7 >> 1, hf = c7 & 1;
        {
            char* w = b + SC_W + lrow * 256 + hf * 8; char* q = b + SC_QD + lrow * 256 + hf * 8; const int x = lrow & 15;
            *(u32x2*)(w + (((4 * kb + 0) ^ x) << 4)) = (u32x2){rw[0].x, rw[0].y}; *(u32x2*)(w + (((4 * kb + 1) ^ x) << 4)) = (u32x2){rw[0].z, rw[0].w};
            *(u32x2*)(w + (((4 * kb + 2) ^ x) << 4)) = (u32x2){rw[1].x, rw[1].y}; *(u32x2*)(w + (((4 * kb + 3) ^ x) << 4)) = (u32x2){rw[1].z, rw[1].w};
            *(u32x2*)(q + (((4 * kb + 0) ^ x) << 4)) = (u32x2){rq[0].x, rq[0].y}; *(u32x2*)(q + (((4 * kb + 1) ^ x) << 4)) = (u32x2){rq[0].z, rq[0].w};
            *(u32x2*)(q + (((4 * kb + 2) ^ x) << 4)) = (u32x2){rq[1].x, rq[1].y}; *(u32x2*)(q + (((4 * kb + 3) ^ x) << 4)) = (u32x2){rq[1].z, rq[1].w};
        }
        {
            const int dk = 2 * lrow + (c7 >> 2), kb2 = (c7 & 3) >> 1, x = (dk >> 1) & 7;
            char* kt = b + SC_KDT + dk * 128 + hf * 8;
            *(u32x2*)(kt + (((4 * kb2 + 0) ^ x) << 4)) = (u32x2){rk[0].x, rk[0].y}; *(u32x2*)(kt + (((4 * kb2 + 1) ^ x) << 4)) = (u32x2){rk[0].z, rk[0].w};
            *(u32x2*)(kt + (((4 * kb2 + 2) ^ x) << 4)) = (u32x2){rk[1].x, rk[1].y}; *(u32x2*)(kt + (((4 * kb2 + 3) ^ x) << 4)) = (u32x2){rk[1].z, rk[1].w};
        }
        {
            const int row = tid >> 3, kb2 = c7 >> 2, g0 = 2 * (c7 & 1), hf2 = (c7 >> 1) & 1, x = (row >> 1) & 7;
            char* qk = b + SC_QK + row * 128 + hf2 * 8;
            *(u32x2*)(qk + (((4 * kb2 + g0) ^ x) << 4)) = (u32x2){rqk.x, rqk.y}; *(u32x2*)(qk + (((4 * kb2 + g0 + 1) ^ x) << 4)) = (u32x2){rqk.z, rqk.w};
        }
    };
    gloadA(0); gloadU(0);
    lwrite(0);
#pragma unroll
    for (int mt = 0; mt < 4; ++mt) ucur[mt] = unext[mt];
    gcur = gnext;
    if (NCH > 1) gloadA(1);
    __syncthreads();
    for (int n = 0; n < NCH; ++n) {
        const char* b = smem + (n & 1) * SC_BUF;
        if (n + 1 < NCH) { lwrite((n + 1) & 1); gloadU(n + 1); }
        if (n + 2 < NCH) gloadA(n + 2);
        if (active) {
        const float gtot = __expf(gcur);
        bf16x8 sf[4];
#pragma unroll
        for (int kb = 0; kb < 4; ++kb) sf[kb] = pack8(S[2 * kb], S[2 * kb + 1]);
        f32x4 Vn[4], O[4];
#pragma unroll
        for (int mt = 0; mt < 4; ++mt) {
            f32x4 P = zero4(), Q = zero4();
            const int row = 16 * mt + r16;
#pragma unroll
            for (int kb = 0; kb < 4; ++kb) {
                const bf16x8 wf = *(const bf16x8*)(b + SC_W + swzrow(row, 256, 4 * kb + g));
                const bf16x8 qf = *(const bf16x8*)(b + SC_QD + swzrow(row, 256, 4 * kb + g));
                P = MFMA16(wf, sf[kb], P);
                Q = MFMA16(qf, sf[kb], Q);
            }
            const float u0 = bflo(ucur[mt].x), u1 = bfhi(ucur[mt].x), u2 = bflo(ucur[mt].y), u3 = bfhi(ucur[mt].y);
            Vn[mt] = (f32x4){u0 - P[0], u1 - P[1], u2 - P[2], u3 - P[3]};
            O[mt] = Q;
        }
        const bf16x8 vf[2] = {pack8(Vn[0], Vn[1]), pack8(Vn[2], Vn[3])};
#pragma unroll
        for (int mt = 0; mt < 8; ++mt) {
            const int row = 16 * mt + r16;
            f32x4 acc = S[mt] * gtot;
#pragma unroll
            for (int kb = 0; kb < 2; ++kb) {
                const bf16x8 kf = *(const bf16x8*)(b + SC_KDT + swz128(row, 4 * kb + g));
                acc = MFMA16(kf, vf[kb], acc);
            }
            S[mt] = acc;
        }
#pragma unroll
        for (int mt = 0; mt < 4; ++mt) {
            const int row = 16 * mt + r16;
#pragma unroll
            for (int kb = 0; kb < 2; ++kb) {
                const bf16x8 qk = *(const bf16x8*)(b + SC_QK + swz128(row, 4 * kb + g));
                O[mt] = MFMA16(qk, vf[kb], O[mt]);
            }
            if (n >= 1 && !dry) *(u32x2*)uaddr(n, mt) = (u32x2){pk2(O[mt][0], O[mt][1]), pk2(O[mt][2], O[mt][3])};
        }
        }
#pragma unroll
        for (int mt = 0; mt < 4; ++mt) ucur[mt] = unext[mt];
        gcur = gnext;
        __syncthreads();
    }
}

constexpr int AT_BUF = 32768, AT_MISC = 65536, NQB = SEQ / 128, AT_UNITS = 8 * NQB;
DI int vt_off8(int e, int s) { return e * 128 + ((s ^ ((e >> 1) & 15)) << 3); }

DI void attention_unit(const Params& p, char* smem, int head, int qb, float lam, int dry, float bound) {
    const int tid = fresh_tid(), lane = tid & 63, wave = tid >> 6, r32 = lane & 31, h = lane >> 5;
    const int wq = wave & 3, mp = wave >> 2;
    unsigned char* ws = p.ws;
    const bf16* AK = (const bf16*)p.out; const bf16* AVT = (const bf16*)p.out + (size_t)SEQ * D;
    const int q0 = 128 * qb, qpos = q0 + 32 * wq + r32;
    const float c1 = 0.125f * LOG2E, c2 = exp2f(-(float)(head + 1)) * LOG2E;
    bf16x8 Qf[4];
    {
        const bf16* qsrc = (const bf16*)(ws + OFF_AQ) + (size_t)qpos * D + head * 128 + mp * 64 + 8 * h;
#pragma unroll
        for (int ks = 0; ks < 4; ++ks) {
            const u32x4 v = *(const u32x4*)(qsrc + 16 * ks); u32x4 o;
            o.x = pk2(bflo(v.x) * c1, bfhi(v.x) * c1); o.y = pk2(bflo(v.y) * c1, bfhi(v.y) * c1); o.z = pk2(bflo(v.z) * c1, bfhi(v.z) * c1); o.w = pk2(bflo(v.w) * c1, bfhi(v.w) * c1);
            Qf[ks] = __builtin_bit_cast(bf16x8, o);
        }
    }
    f32x16 O[4];
#pragma unroll
    for (int i = 0; i < 4; ++i) O[i] = zero16();
    float l_run = 0.f; const float mfix = fminf(bound, 40.0f);
    const float wdist = (150.0f + 2.0f * bound) / c2;
    int ntiles = 2 * qb + 3;
    {
        const float lim = (float)q0 - 63.0f - wdist;
        int ktmin = 0;
        if (lim > 0.f) ktmin = (int)(lim * (1.0f / 64.0f));
        const bool keep_meta = !((float)(q0 + NMETA - 15) > wdist);
        if (ktmin > 0 || !keep_meta) ntiles = (2 * qb + 1 - ktmin + 1) + (keep_meta ? 1 : 0);
    }
    const int nreal = (ntiles == 2 * qb + 3) ? 2 * qb + 2 : ntiles;
    const int kkey = tid >> 3, kcc = (tid & 7) * 2;
    const int va = tid >> 5, vb4 = tid & 31;
    u32x4 rk[2]; u32x2 rv[4];
    auto tile_kt = [&](int it) -> int { return it < nreal ? 2 * qb + 1 - it : -1; };
    auto gload = [&](int it) {
        const int kt = tile_kt(it);
        if (kt >= 0) {
            const bf16* ks = AK + ((size_t)kt * 64 + kkey) * D + head * 128 + kcc * 8;
            rk[0] = *(const u32x4*)ks; rk[1] = *(const u32x4*)(ks + 8);
            const bf16* vs = AVT + ((size_t)kt * 64 + 4 * va) * D + head * 128 + 4 * vb4;
#pragma unroll
            for (int i = 0; i < 4; ++i) rv[i] = *(const u32x2*)(vs + (size_t)i * D);
        } else {
            rk[0] = rk[1] = (u32x4){0u, 0u, 0u, 0u};
#pragma unroll
            for (int i = 0; i < 4; ++i) rv[i] = (u32x2){0u, 0u};
            if (kkey < NMETA) { const bf16* ks = (const bf16*)(ws + OFF_SMALL + SM_AKMETA) + (size_t)kkey * D + head * 128 + kcc * 8; rk[0] = *(const u32x4*)ks; rk[1] = *(const u32x4*)(ks + 8); }
            if (va < NMETA / 4) { const bf16* vs = (const bf16*)(ws + OFF_SMALL + SM_AVTMETA) + (size_t)(4 * va) * D + head * 128 + 4 * vb4;
#pragma unroll
                for (int i = 0; i < 4; ++i) rv[i] = *(const u32x2*)(vs + (size_t)i * D); }
        }
    };
    auto lwrite = [&](int buf) {
        char* kb = smem + buf * AT_BUF + (kcc >> 3) * 8192;
        *(u32x4*)(kb + swz128(kkey, kcc & 7)) = rk[0]; *(u32x4*)(kb + swz128(kkey, (kcc & 7) + 1)) = rk[1];
        const unsigned t0x = (rv[0].x & 0xffffu) | (rv[1].x << 16), t1x = (rv[0].x >> 16) | (rv[1].x & 0xffff0000u), t0y = (rv[2].x & 0xffffu) | (rv[3].x << 16), t1y = (rv[2].x >> 16) | (rv[3].x & 0xffff0000u);
        const unsigned t2x = (rv[0].y & 0xffffu) | (rv[1].y << 16), t3x = (rv[0].y >> 16) | (rv[1].y & 0xffff0000u), t2y = (rv[2].y & 0xffffu) | (rv[3].y << 16), t3y = (rv[2].y >> 16) | (rv[3].y & 0xffff0000u);
        const int sub = va >> 3, a = va & 7, a2 = (a & 4) | ((a & 1) << 1) | ((a >> 1) & 1);
        char* vbase = smem + buf * AT_BUF + 16384 + (a2 & 1) * 8;
        const int s16 = 4 * sub + (a2 >> 1), e0 = 4 * vb4;
        *(u32x2*)(vbase + (e0 + 0) * 128 + ((s16 ^ (((e0 + 0) >> 1) & 7)) << 4)) = (u32x2){t0x, t0y};
        *(u32x2*)(vbase + (e0 + 1) * 128 + ((s16 ^ (((e0 + 1) >> 1) & 7)) << 4)) = (u32x2){t1x, t1y};
        *(u32x2*)(vbase + (e0 + 2) * 128 + ((s16 ^ (((e0 + 2) >> 1) & 7)) << 4)) = (u32x2){t2x, t2y};
        *(u32x2*)(vbase + (e0 + 3) * 128 + ((s16 ^ (((e0 + 3) >> 1) & 7)) << 4)) = (u32x2){t3x, t3y};
    };
    auto tile_body = [&](auto mode_tag, int buf, int kdist0, int klim) {
        constexpr bool MASKED = decltype(mode_tag)::value;
        const char* kb = smem + buf * AT_BUF + mp * 8192;
        const char* vb = smem + buf * AT_BUF + 16384;
        f32x16 s[2];
#pragma unroll
        for (int sub = 0; sub < 2; ++sub) {
            f32x16 acc;
            const float base = -c2 * (float)(kdist0 - 32 * sub - 4 * h) - mfix;
#pragma unroll
            for (int r = 0; r < 16; ++r) acc[r] = base + c2 * (float)((r & 3) + 8 * (r >> 2));
#pragma unroll
            for (int ks = 0; ks < 4; ++ks) {
                const bf16x8 a = *(const bf16x8*)(kb + swz128(32 * sub + r32, 2 * ks + h));
                acc = MFMA32(a, Qf[ks], acc);
            }
            if (MASKED) {
#pragma unroll
                for (int r = 0; r < 16; ++r) { const int key = 32 * sub + (r & 3) + 8 * (r >> 2) + 4 * h; if (key > klim) acc[r] = -1e30f; }
            }
            s[sub] = acc;
        }
        float ls = 0.f;
#pragma unroll
        for (int sub = 0; sub < 2; ++sub)
#pragma unroll
            for (int r = 0; r < 16; ++r) { const float pv = EXP2F(s[sub][r]); s[sub][r] = pv; ls += pv; }
        l_run += ls;
        bf16x8 Pf[2][2];
#pragma unroll
        for (int sub = 0; sub < 2; ++sub)
#pragma unroll
            for (int ss = 0; ss < 2; ++ss) {
                u32x4 o; o.x = pk2(s[sub][8 * ss], s[sub][8 * ss + 1]); o.y = pk2(s[sub][8 * ss + 2], s[sub][8 * ss + 3]);
                o.z = pk2(s[sub][8 * ss + 4], s[sub][8 * ss + 5]); o.w = pk2(s[sub][8 * ss + 6], s[sub][8 * ss + 7]);
                Pf[sub][ss] = __builtin_bit_cast(bf16x8, o);
            }
#pragma unroll
        for (int et = 0; et < 4; ++et) {
            const int e = 32 * et + r32;
#pragma unroll
            for (int sub = 0; sub < 2; ++sub)
#pragma unroll
                for (int ss = 0; ss < 2; ++ss) {
                    const bf16x8 a = *(const bf16x8*)(vb + swz128(e, 4 * sub + 2 * ss + h));
                    O[et] = MFMA32(a, Pf[sub][ss], O[et]);
                }
            SCHED_FENCE();
        }
    };
    gload(0); lwrite(0); __syncthreads();
    for (int it = 0; it < ntiles; ++it) {
        const int buf = it & 1, kt = tile_kt(it);
        if (it + 1 < ntiles) gload(it + 1);
        const int k0 = kt * 64;
        if (kt >= 0 && k0 > q0 + 32 * wq + 31) {   }
        else if (kt >= 0 && k0 + 63 <= q0 + 32 * wq) tile_body(std::false_type{}, buf, qpos - k0, 0);
        else tile_body(std::true_type{}, buf, kt < 0 ? NMETA + qpos : qpos - k0, kt < 0 ? NMETA - 1 : qpos - k0);
        if (it + 1 < ntiles) lwrite(buf ^ 1);
        __syncthreads();
    }
    {
        const int tid = fresh_tid(), lane = tid & 63, wave = tid >> 6, r32 = lane & 31, h = lane >> 5, wq = wave & 3, mp = wave >> 2;
        const int qpos = 128 * qb + 32 * wq + r32;
        const float lt = l_run + xhalf(l_run);
        const float inv = 1.0f / lt;
        float* X = (float*)smem;
        if (mp == 1) {
#pragma unroll
            for (int et = 0; et < 4; ++et)
#pragma unroll
                for (int r = 0; r < 16; ++r) { const int e = 32 * et + (r & 3) + 8 * (r >> 2) + 4 * h; X[(wq * 128 + e) * 32 + r32] = O[et][r] * inv; }
        }
        __syncthreads();
        if (mp == 0) {
            float ssq = 0.f;
#pragma unroll
            for (int et = 0; et < 4; ++et)
#pragma unroll
                for (int r = 0; r < 16; ++r) { const int e = 32 * et + (r & 3) + 8 * (r >> 2) + 4 * h; const float d = O[et][r] * inv - lam * X[(wq * 128 + e) * 32 + r32]; O[et][r] = d; ssq += d * d; }
            ssq += xhalf(ssq);
            const float rstd = rsqrtf(ssq * (1.0f / 128.0f) + NORM_EPS) * 0.8f;
            bf16* dst = (bf16*)(ws + OFF_AQ) + (size_t)qpos * D + head * 128;
            const float* sw = p.in[8];
#pragma unroll
            for (int et = 0; et < 4; ++et)
#pragma unroll
                for (int q4 = 0; q4 < 4; ++q4) {
                    const int e0 = 32 * et + 8 * q4 + 4 * h;
                    const f32x4 w4 = *(const f32x4*)(sw + e0);
                    if (!dry) *(u32x2*)(dst + e0) = (u32x2){pk2(O[et][4 * q4] * rstd * w4[0], O[et][4 * q4 + 1] * rstd * w4[1]), pk2(O[et][4 * q4 + 2] * rstd * w4[2], O[et][4 * q4 + 3] * rstd * w4[3])};
                }
        }
        __syncthreads();
    }
}

DI void phase3(const Params& p, char* smem, int bid, int nblk, int dry = 0, int mode = 3) {
    if (mode & 1) for (int it = bid; it < 8 * SCAN_SPLIT; it += nblk) scan_head(p, smem, it / SCAN_SPLIT, it % SCAN_SPLIT, dry);
    if (!(mode & 2)) return;
    float d1 = 0.f, d2 = 0.f;
    for (int i = 0; i < 64; ++i) { d1 += p.in[4][i] * p.in[5][i]; d2 += p.in[6][i] * p.in[7][i]; }
    const float lam = __expf(d1) - __expf(d2) + 0.2f;
    unsigned* q = (unsigned*)(p.ws + OFF_SMALL + SM_CTL) + CW_ATTQ + (dry ? 16 : 0);
    for (;;) {
        if (threadIdx.x == 0) *(unsigned*)(smem + AT_MISC) = atomicAdd(q, 1u);
        __syncthreads();
        const unsigned u = *(unsigned*)(smem + AT_MISC);
        __syncthreads();
        if (u >= (unsigned)AT_UNITS) break;
        const int hd = (int)(u & 7u);
        const unsigned* nrm = (const unsigned*)(p.ws + OFF_SMALL + SM_CTL) + CW_NRM;
        float bnd = 0.f;
        for (int m2 = 0; m2 < 2; ++m2) {
            const float q2 = __builtin_bit_cast(float, LD_ATOMIC(nrm + 2 * hd + m2)), k2 = __builtin_bit_cast(float, LD_ATOMIC(nrm + 16 + 2 * hd + m2));
            bnd = fmaxf(bnd, sqrtf(q2 * k2) * (0.125f * LOG2E) * 1.02f);
        }
        attention_unit(p, smem, hd, NQB - 1 - (int)(u >> 3), lam, dry, bnd);
    }
}

DI void phase4(const Params& p, char* smem, int bid, int nblk) {
    const int tid = fresh_tid(), lane = tid & 63, wave = tid >> 6;
    const int gw = bid * 8 + wave, NGW = nblk * 8;
    unsigned char* ws = p.ws;
    char* wl = smem + wave * 16384;
    for (int it = gw; it < 32 * 384; it += NGW) {
        const int e = it / 384, r = it % 384, m = r >> 7, q = r & 127;
        if (m < 2) transpose_item(p.in[21 + m] + (size_t)e * 1024 * 256, 256, 1024, (bf16*)(ws + (m == 0 ? OFF_EXG : OFF_EXU)) + (size_t)e * 256 * 1024, (q >> 3) * 64, (q & 7) * 32, (q & 7) * 32, (float*)wl, lane);
        else transpose_item(p.in[23] + (size_t)e * 256 * 1024, 1024, 256, (bf16*)(ws + OFF_EXD) + (size_t)e * 1024 * 256, (q >> 5) * 64, (q & 31) * 32, (q & 31) * 32, (float*)wl, lane);
    }
    for (int R = gw; R < SEQ; R += NGW) {
        const float* xrow = p.in[0] + (size_t)R * D; bf16* urow = (bf16*)(ws + OFF_U) + (size_t)R * D;
        float4 v[4]; float ss = 0.f;
#pragma unroll
        for (int j = 0; j < 4; ++j) { v[j] = *(const float4*)(xrow + 4 * lane + 256 * j); ss += v[j].x * v[j].x + v[j].y * v[j].y + v[j].z * v[j].z + v[j].w * v[j].w; }
        ss = wave_sum(ss);
        const float rstd = rsqrtf(ss * (1.0f / D) + NORM_EPS);
#pragma unroll
        for (int j = 0; j < 4; ++j) {
            const float4 w4 = *(const float4*)(p.in[2] + 4 * lane + 256 * j);
            *(u32x2*)(urow + 4 * lane + 256 * j) = (u32x2){pk2(v[j].x * rstd * w4.x, v[j].y * rstd * w4.y), pk2(v[j].z * rstd * w4.z, v[j].w * rstd * w4.w)};
        }
    }
    for (int it = gw; it < (NCH - 1) * 8; it += NGW) {
        const int cm1 = it >> 3, head = it & 7;
        const bf16* reg = (const bf16*)(ws + OFF_V) + (size_t)cm1 * 64 * D + head * 128;
#pragma unroll 4
        for (int i = 0; i < 16; ++i) { const int row = i * 4 + (lane >> 4), ch = lane & 15; *(u32x4*)(wl + row * 256 + ch * 16) = *(const u32x4*)(reg + (size_t)row * D + ch * 8); }
        WAVE_SYNC();
        float ss = 0.f;
#pragma unroll 8
        for (int dv = 0; dv < 128; ++dv) { const float v = bf2f(*(const bf16*)(wl + (dv >> 1) * 256 + ((dv & 1) * 64 + lane) * 2)); ss += v * v; }
        const float rstd = rsqrtf(ss * (1.0f / 128.0f) + NORM_EPS);
        const size_t j = (size_t)cm1 * 64 + lane;
        const bf16* gsrc = (const bf16*)(ws + OFF_DG) + j * D + head * 128;
        bf16* dst = (bf16*)(ws + OFF_OD) + j * D + head * 128;
#pragma unroll 2
        for (int d8 = 0; d8 < 16; ++d8) {
            const u32x4 gv = *(const u32x4*)(gsrc + 8 * d8);
            const f32x4 w0 = *(const f32x4*)(p.in[12] + 8 * d8), w1 = *(const f32x4*)(p.in[12] + 8 * d8 + 4);
            float o[8];
#pragma unroll
            for (int c = 0; c < 8; ++c) { const int dv = 8 * d8 + c; o[c] = bf2f(*(const bf16*)(wl + (dv >> 1) * 256 + ((dv & 1) * 64 + lane) * 2)) * rstd; }
            o[0] *= w0[0] * siluf_(bflo(gv.x)); o[1] *= w0[1] * siluf_(bfhi(gv.x)); o[2] *= w0[2] * siluf_(bflo(gv.y)); o[3] *= w0[3] * siluf_(bfhi(gv.y));
            o[4] *= w1[0] * siluf_(bflo(gv.z)); o[5] *= w1[1] * siluf_(bfhi(gv.z)); o[6] *= w1[2] * siluf_(bflo(gv.w)); o[7] *= w1[3] * siluf_(bfhi(gv.w));
            *(u32x4*)(dst + 8 * d8) = (u32x4){pk2(o[0], o[1]), pk2(o[2], o[3]), pk2(o[4], o[5]), pk2(o[6], o[7])};
        }
        WAVE_SYNC();
    }
}

template <int NB, int NI>
DI void rowgemm64(const bf16* arow, const bf16* const (&bptr)[NB], char* stg, f32x16 (&acc)[NB][2][NI]) {
    const int tid = fresh_tid(), lane = tid & 63, r32 = lane & 31, h = lane >> 5;
    const int lrow = tid >> 3, lc = tid & 7;
    u32x4 ra = arow ? *(const u32x4*)arow : (u32x4){0u, 0u, 0u, 0u};
    bf16x8 bqA[4][NB][NI], bqB[4][NB][NI];
    auto bload = [&](bf16x8 (&dst)[4][NB][NI], int kc) {
#pragma unroll
        for (int ks = 0; ks < 4; ++ks)
#pragma unroll
            for (int b = 0; b < NB; ++b)
#pragma unroll
                for (int ni = 0; ni < NI; ++ni) dst[ks][b][ni] = *(const bf16x8*)(bptr[b] + (size_t)ni * 32 * 1024 + kc * 64 + ks * 16);
    };
    auto mma = [&](const bf16x8 (&bq)[4][NB][NI], int buf) {
#pragma unroll
        for (int ks = 0; ks < 4; ++ks) {
            bf16x8 af[2];
#pragma unroll
            for (int mi = 0; mi < 2; ++mi) af[mi] = *(const bf16x8*)(stg + buf * 8192 + swz128(32 * mi + r32, 2 * ks + h));
#pragma unroll
            for (int b = 0; b < NB; ++b)
#pragma unroll
                for (int ni = 0; ni < NI; ++ni)
#pragma unroll
                    for (int mi = 0; mi < 2; ++mi) acc[b][mi][ni] = MFMA32(af[mi], bq[ks][b][ni], acc[b][mi][ni]);
        }
    };
    bload(bqA, 0);
    *(u32x4*)(stg + swz128(lrow, lc)) = ra;
    __syncthreads();
    for (int kc = 0; kc < 16; kc += 2) {
        ra = arow ? *(const u32x4*)(arow + (kc + 1) * 64) : (u32x4){0u, 0u, 0u, 0u};
        bload(bqB, kc + 1);
        mma(bqA, 0);
        *(u32x4*)(stg + 8192 + swz128(lrow, lc)) = ra;
        __syncthreads();
        if (kc + 2 < 16) { ra = arow ? *(const u32x4*)(arow + (kc + 2) * 64) : (u32x4){0u, 0u, 0u, 0u}; bload(bqA, kc + 2); }
        mma(bqB, 1);
        if (kc + 2 < 16) *(u32x4*)(stg + swz128(lrow, lc)) = ra;
        __syncthreads();
    }
}

constexpr size_t OFF_MIX = OFF_V;
struct EpiSig {
    static constexpr bool PERM = true;
    bf16* sg;
    DM void operator()(const f32x4 (&acc)[2][2][4][2], const pg8::Unit& u, int wr, int wc, int fr, int fq) const {
        const int row0 = u.pm * 256 + wr * 64 + fr, col0 = u.pn * 256 + wc * 32 + 8 * fq;
#pragma unroll
        for (int ai = 0; ai < 2; ++ai)
#pragma unroll
            for (int m = 0; m < 4; ++m) {
                bf16* rowp = sg + (size_t)(row0 + ai * 128 + m * 16) * 2048 + col0;
#pragma unroll
                for (int bj = 0; bj < 2; ++bj) {
                    const f32x4 v0 = acc[ai][bj][m][0], v1 = acc[ai][bj][m][1];
                    *(u32x4*)(rowp + bj * 128) = (u32x4){pk2(sigmoidf_(v0[0]), sigmoidf_(v0[1])), pk2(sigmoidf_(v0[2]), sigmoidf_(v0[3])), pk2(sigmoidf_(v1[0]), sigmoidf_(v1[1])), pk2(sigmoidf_(v1[2]), sigmoidf_(v1[3]))};
                }
            }
    }
};
template <bool ADD> struct EpiGate {
    static constexpr bool PERM = true;
    const bf16* sg; bf16* mix; int goff;
    DM void operator()(const f32x4 (&acc)[2][2][4][2], const pg8::Unit& u, int wr, int wc, int fr, int fq) const {
        const int row0 = u.pm * 256 + wr * 64 + fr, col0 = u.pn * 256 + wc * 32 + 8 * fq;
#pragma unroll
        for (int ai = 0; ai < 2; ++ai)
#pragma unroll
            for (int m = 0; m < 4; ++m) {
                const size_t j = (size_t)(row0 + ai * 128 + m * 16);
#pragma unroll
                for (int bj = 0; bj < 2; ++bj) {
                    const u32x4 g = *(const u32x4*)(sg + j * 2048 + goff + col0 + bj * 128);
                    const f32x4 v0 = acc[ai][bj][m][0], v1 = acc[ai][bj][m][1];
                    float o[8] = {bflo(g.x) * v0[0], bfhi(g.x) * v0[1], bflo(g.y) * v0[2], bfhi(g.y) * v0[3], bflo(g.z) * v1[0], bfhi(g.z) * v1[1], bflo(g.w) * v1[2], bfhi(g.w) * v1[3]};
                    bf16* dst = mix + j * D + col0 + bj * 128;
                    if (ADD) { const u32x4 q = *(const u32x4*)dst; o[0] += bflo(q.x); o[1] += bfhi(q.x); o[2] += bflo(q.y); o[3] += bfhi(q.y); o[4] += bflo(q.z); o[5] += bfhi(q.z); o[6] += bflo(q.w); o[7] += bfhi(q.w); }
                    *(u32x4*)dst = (u32x4){pk2(o[0], o[1]), pk2(o[2], o[3]), pk2(o[4], o[5]), pk2(o[6], o[7])};
                }
            }
    }
};
struct EpiRes {
    static constexpr bool PERM = false;
    const float* x; float* hout;
    DM void operator()(const f32x4 (&acc)[2][2][4][2], const pg8::Unit& u, int wr, int wc, int fr, int fq) const {
        const int row0 = u.pm * 256 + wr * 64 + fr, col0 = u.pn * 256 + wc * 32 + 4 * fq;
#pragma unroll
        for (int ai = 0; ai < 2; ++ai)
#pragma unroll
            for (int m = 0; m < 4; ++m) {
                const size_t off = (size_t)(row0 + ai * 128 + m * 16) * D + col0;
#pragma unroll
                for (int bj = 0; bj < 2; ++bj)
#pragma unroll
                    for (int n = 0; n < 2; ++n) *(f32x4*)(hout + off + bj * 128 + n * 16) = *(const f32x4*)(x + off + bj * 128 + n * 16) + acc[ai][bj][m][n];
            }
    }
};
DI void phase5a(const Params& p, char* smem, int bid, int nblk) {
    pg8::Gemm g{(const bf16*)(p.ws + OFF_U), (const bf16*)(p.ws + OFF_WTIN) + (size_t)7168 * 1024, SEQ, 2048, 1024};
    pg8::StaticOrder S; S.init(SEQ, 2048, nblk, bid);
    EpiSig E{(bf16*)p.out};
    pg8::gemm_phase(smem, g, S, E);
}
DI void phase5b(const Params& p, char* smem, int bid, int nblk) {
    pg8::StaticOrder S; S.init(SEQ, 1024, nblk, bid);
    {
        pg8::Gemm g{(const bf16*)(p.ws + OFF_AQ), (const bf16*)(p.ws + OFF_WTBA), SEQ, 1024, 1024};
        EpiGate<false> E{(const bf16*)p.out, (bf16*)(p.ws + OFF_MIX), 0};
        pg8::gemm_phase(smem, g, S, E);
    }
    {
        pg8::Gemm g{(const bf16*)(p.ws + OFF_OD), (const bf16*)(p.ws + OFF_WTBD), SEQ, 1024, 1024};
        EpiGate<true> E{(const bf16*)p.out, (bf16*)(p.ws + OFF_MIX), 1024};
        pg8::gemm_phase(smem, g, S, E);
    }
}
DI void phase5c(const Params& p, char* smem, int bid, int nblk) {
    pg8::Gemm g{(const bf16*)(p.ws + OFF_MIX), (const bf16*)(p.ws + OFF_WTOUT), SEQ, 1024, 1024};
    pg8::StaticOrder S; S.init(SEQ, 1024, nblk, bid);
    EpiRes E{p.in[0], p.out};
    pg8::gemm_phase(smem, g, S, E);
}
constexpr int P5_PLP = 65, P5_PL = 0, P5_SS = 8 * 64 * P5_PLP * 4, P5_MISC = P5_SS + 8 * 64 * 4;
DI void post_rows(const Params& p, char* smem, int rb, int dry) {
    const int tid = fresh_tid(), lane = tid & 63, wave = tid >> 6, r32 = lane & 31, h = lane >> 5;
    unsigned char* ws = p.ws;
    const int row0 = rb * 64;
    float* rstdl = (float*)(smem + P5_MISC); float* logl = (float*)(smem + P5_MISC + 256);
    {
        const bf16* WH = (const bf16*)(ws + OFF_SMALL + SM_WR); const bf16* WL = WH + 64 * 1024;
        f32x16 acc[2][2];
#pragma unroll
        for (int mi = 0; mi < 2; ++mi)
#pragma unroll
            for (int ni = 0; ni < 2; ++ni) acc[mi][ni] = zero16();
        float ss[2] = {0.f, 0.f};
#pragma unroll 2
        for (int ks = 0; ks < 8; ++ks) {
            const int k0 = 128 * wave + 16 * ks + 8 * h;
            bf16x8 ah[2], al[2];
#pragma unroll
            for (int mi = 0; mi < 2; ++mi) {
                const float* hp = p.out + (size_t)(row0 + 32 * mi + r32) * D + k0;
                const f32x4 a = *(const f32x4*)hp, b = *(const f32x4*)(hp + 4);
                ss[mi] += a[0] * a[0] + a[1] * a[1] + a[2] * a[2] + a[3] * a[3] + b[0] * b[0] + b[1] * b[1] + b[2] * b[2] + b[3] * b[3];
                const u32x4 hi = {pk2(a[0], a[1]), pk2(a[2], a[3]), pk2(b[0], b[1]), pk2(b[2], b[3])};
                const u32x4 lo = {pk2(a[0] - bflo(hi.x), a[1] - bfhi(hi.x)), pk2(a[2] - bflo(hi.y), a[3] - bfhi(hi.y)), pk2(b[0] - bflo(hi.z), b[1] - bfhi(hi.z)), pk2(b[2] - bflo(hi.w), b[3] - bfhi(hi.w))};
                ah[mi] = __builtin_bit_cast(bf16x8, hi); al[mi] = __builtin_bit_cast(bf16x8, lo);
            }
#pragma unroll
            for (int ni = 0; ni < 2; ++ni) {
                const bf16x8 bh = *(const bf16x8*)(WH + (size_t)(32 * ni + r32) * 1024 + k0), bl = *(const bf16x8*)(WL + (size_t)(32 * ni + r32) * 1024 + k0);
#pragma unroll
                for (int mi = 0; mi < 2; ++mi) { acc[mi][ni] = MFMA32(ah[mi], bh, acc[mi][ni]); acc[mi][ni] = MFMA32(ah[mi], bl, acc[mi][ni]); acc[mi][ni] = MFMA32(al[mi], bh, acc[mi][ni]); }
            }
        }
        float* PL = (float*)(smem + P5_PL) + wave * 64 * P5_PLP; float* SS = (float*)(smem + P5_SS) + wave * 64;
#pragma unroll
        for (int mi = 0; mi < 2; ++mi) {
#pragma unroll
            for (int ni = 0; ni < 2; ++ni)
#pragma unroll
                for (int r = 0; r < 16; ++r) PL[(32 * mi + (r & 3) + 8 * (r >> 2) + 4 * h) * P5_PLP + 32 * ni + r32] = acc[mi][ni][r];
            const float s = ss[mi] + xhalf(ss[mi]);
            if (h == 0) SS[32 * mi + r32] = s;
        }
    }
    __syncthreads();
    if (tid < 64) {
        float s = 0.f;
#pragma unroll
        for (int w = 0; w < 8; ++w) s += ((const float*)(smem + P5_SS))[w * 64 + tid];
        const float rs = rsqrtf(s * (1.0f / D) + NORM_EPS);
        rstdl[tid] = rs;
        for (int c = 0; c < 36; ++c) { float t = 0.f; for (int w = 0; w < 8; ++w) t += ((const float*)(smem + P5_PL))[w * 64 * P5_PLP + tid * P5_PLP + c]; logl[tid * 41 + c] = t * rs + (c < 4 ? p.in[18][c] : p.in[20][c - 4]); }
        const float* L = logl + tid * 41;
        int gi = 0; float gm = L[0];
        for (int c = 1; c < 4; ++c) if (L[c] > gm) { gm = L[c]; gi = c; }
        float gs = 0.f; for (int c = 0; c < 4; ++c) gs += __expf(L[c] - gm);
        const float gw = 1.0f / gs;
        const float* E = L + 4 + 8 * gi;
        int i1 = 0; float l1 = E[0];
        for (int c = 1; c < 8; ++c) if (E[c] > l1) { l1 = E[c]; i1 = c; }
        int i2 = -1; float l2 = -3.0e38f;
        for (int c = 0; c < 8; ++c) if (c != i1 && E[c] > l2) { l2 = E[c]; i2 = c; }
        const float t = __expf(l2 - l1), w1 = 1.0f / (1.0f + t), w2 = t / (1.0f + t);
        unsigned* cnt = (unsigned*)(ws + OFF_SMALL + SM_CTL) + CW_ECNT;
        int* lists = (int*)(ws + OFF_SMALL + SM_TAILS); float* RW = (float*)(ws + OFF_SMALL + SM_RW);
        const int j = row0 + tid;
        const int e1 = 8 * gi + i1, e2 = 8 * gi + i2;
        if (!dry) {
        const unsigned p1 = atomicAdd(cnt + e1, 1u); ST_ATOMIC(lists + (size_t)e1 * SEQ + p1, (j << 1)); RW[2 * j] = gw * w1;
        const unsigned p2 = atomicAdd(cnt + e2, 1u); ST_ATOMIC(lists + (size_t)e2 * SEQ + p2, (j << 1) | 1); RW[2 * j + 1] = gw * w2;
        } else { asm volatile("" :: "v"(e1), "v"(e2), "v"(gw * w1), "v"(gw * w2)); }
    }
    __syncthreads();
#pragma unroll 2
    for (int i = 0; i < 16; ++i) {
        const int idx = tid + NT * i, row = idx >> 7, ch = idx & 127;
        const float* hp = p.out + (size_t)(row0 + row) * D + ch * 8;
        const f32x4 a = *(const f32x4*)hp, b = *(const f32x4*)(hp + 4);
        const f32x4 w0 = *(const f32x4*)(p.in[16] + ch * 8), w1 = *(const f32x4*)(p.in[16] + ch * 8 + 4);
        const float rs = rstdl[row];
        if (!dry) *(u32x4*)((bf16*)(ws + OFF_OD) + (size_t)(row0 + row) * D + ch * 8) =
            (u32x4){pk2(a[0] * rs * w0[0], a[1] * rs * w0[1]), pk2(a[2] * rs * w0[2], a[3] * rs * w0[3]), pk2(b[0] * rs * w1[0], b[1] * rs * w1[1]), pk2(b[2] * rs * w1[2], b[3] * rs * w1[3])};
    }
    __syncthreads();
}
DI void phase5d(const Params& p, char* smem, int bid, int nblk, int dry = 0) {
    for (int rb = bid; rb < SEQ / 64; rb += nblk) post_rows(p, smem, rb, dry);
}

constexpr int P6_HL = 0, P6_PITCH = 528, P6_STG = 64 * P6_PITCH, P6_TOK = P6_STG + 16384, P6_RW = P6_TOK + 256, P6_TS = P6_RW + 256;
DI void moe_item(const Params& p, char* smem, int e, int mt, int cnt_e) {
    const int tid = fresh_tid(), lane = tid & 63, wave = tid >> 6, r32 = lane & 31, h = lane >> 5;
    unsigned char* ws = p.ws;
    int* tokl = (int*)(smem + P6_TOK); float* rwl = (float*)(smem + P6_RW);
    if (tid < 64) {
        const int idx = 64 * mt + tid; int ent = -1; float w = 0.f;
        if (idx < cnt_e) { ent = ((const int*)(ws + OFF_SMALL + SM_TAILS))[(size_t)e * SEQ + idx]; w = ((const float*)(ws + OFF_SMALL + SM_RW))[ent]; }
        tokl[tid] = ent; rwl[tid] = w;
    }
    __syncthreads();
    const int lrow = tid >> 3, lc = tid & 7;
    const int lent = tokl[lrow];
    f32x16 GU[2][2][1];
#pragma unroll
    for (int b = 0; b < 2; ++b)
#pragma unroll
        for (int mi = 0; mi < 2; ++mi) GU[b][mi][0] = zero16();
    {
        const bf16* const bp[2] = {(const bf16*)(ws + OFF_EXG) + ((size_t)e * 256 + 32 * wave + r32) * 1024 + 8 * h, (const bf16*)(ws + OFF_EXU) + ((size_t)e * 256 + 32 * wave + r32) * 1024 + 8 * h};
        rowgemm64<2, 1>(lent >= 0 ? (const bf16*)(ws + OFF_OD) + (size_t)(lent >> 1) * D + lc * 8 : nullptr, bp, smem + P6_STG, GU);
    }
#pragma unroll
    for (int mi = 0; mi < 2; ++mi)
#pragma unroll
        for (int r = 0; r < 16; ++r) {
            const int row = 32 * mi + (r & 3) + 8 * (r >> 2) + 4 * h, col = 32 * wave + r32;
            *(bf16*)(smem + P6_HL + row * P6_PITCH + col * 2) = (bf16)f2bf(siluf_(GU[0][mi][0][r]) * GU[1][mi][0][r]);
        }
    __syncthreads();
#pragma unroll 1
    for (int ps = 0; ps < 2; ++ps) {
        f32x16 Y[2][2];
#pragma unroll
        for (int mi = 0; mi < 2; ++mi)
#pragma unroll
            for (int ni = 0; ni < 2; ++ni) Y[mi][ni] = zero16();
        const bf16* bp = (const bf16*)(ws + OFF_EXD) + ((size_t)e * 1024 + 128 * wave + 64 * ps + r32) * 256 + 8 * h;
        bf16x8 bwA[4][2], bwB[4][2];
        auto wload = [&](bf16x8 (&dst)[4][2], int hb) {
#pragma unroll
            for (int q = 0; q < 4; ++q)
#pragma unroll
                for (int ni = 0; ni < 2; ++ni) dst[q][ni] = *(const bf16x8*)(bp + (size_t)ni * 32 * 256 + (4 * hb + q) * 16);
        };
        auto wmma = [&](const bf16x8 (&bw)[4][2], int hb) {
#pragma unroll
            for (int q = 0; q < 4; ++q) {
                const int ks = 4 * hb + q;
                bf16x8 af[2];
#pragma unroll
                for (int mi = 0; mi < 2; ++mi) af[mi] = *(const bf16x8*)(smem + P6_HL + (32 * mi + r32) * P6_PITCH + (2 * ks + h) * 16);
#pragma unroll
                for (int ni = 0; ni < 2; ++ni)
#pragma unroll
                    for (int mi = 0; mi < 2; ++mi) Y[mi][ni] = MFMA32(af[mi], bw[q][ni], Y[mi][ni]);
            }
        };
        wload(bwA, 0); wload(bwB, 1); wmma(bwA, 0); wload(bwA, 2); wmma(bwB, 1); wload(bwB, 3); wmma(bwA, 2); wmma(bwB, 3);
#ifndef EMU
        asm volatile("" ::: "memory");
#endif
#pragma unroll
        for (int mi = 0; mi < 2; ++mi)
#pragma unroll
            for (int r = 0; r < 16; ++r) {
                const int row = 32 * mi + (r & 3) + 8 * (r >> 2) + 4 * h; const int ent = tokl[row];
                if (ent >= 0) {
                    const float w = rwl[row]; bf16* dst = (bf16*)(ws + OFF_Y) + (size_t)ent * D + 128 * wave + 64 * ps + r32;
#pragma unroll
                    for (int ni = 0; ni < 2; ++ni) dst[32 * ni] = (bf16)f2bf(Y[mi][ni][r] * w);
                }
            }
    }
    __syncthreads();
}
DI void phase6(const Params& p, char* smem, int bid, int nblk) {
    int* ts = (int*)(smem + P6_TS);
    unsigned* cnt = (unsigned*)(p.ws + OFF_SMALL + SM_CTL) + CW_ECNT;
    int* tc = (int*)(smem + P6_TS + 256);
    if (threadIdx.x < 32) tc[threadIdx.x] = (int)LD_ATOMIC(cnt + threadIdx.x);
    __syncthreads();
    if (threadIdx.x == 0) { int s = 0; for (int e = 0; e < 32; ++e) { ts[e] = s; s += (tc[e] + 63) >> 6; } ts[32] = s; }
    __syncthreads();
    const int total = ts[32];
    for (int t = bid; t < total; t += nblk) {
        int e = 0;
#pragma unroll 1
        for (int q = 1; q < 32; ++q) if (ts[q] <= t) e = q;
        moe_item(p, smem, e, t - ts[e], tc[e]);
    }
}

DI void phase7(const Params& p, char* smem, int bid, int nblk, int dry = 0) {
    const int tid = fresh_tid(), lane = tid & 63, wave = tid >> 6;
    const int gw = bid * 8 + wave, NGW = nblk * 8;
    for (int j = gw; j < SEQ; j += NGW) {
        float* hrow = p.out + (size_t)j * D;
        const bf16* y0 = (const bf16*)(p.ws + OFF_Y) + (size_t)j * 2 * D;
        float4 v[4]; float ss = 0.f;
#pragma unroll
        for (int q = 0; q < 4; ++q) {
            const int c = 4 * lane + 256 * q;
            v[q] = *(const float4*)(hrow + c);
            const u32x2 a = *(const u32x2*)(y0 + c), b = *(const u32x2*)(y0 + D + c);
            v[q].x += bflo(a.x) + bflo(b.x); v[q].y += bfhi(a.x) + bfhi(b.x); v[q].z += bflo(a.y) + bflo(b.y); v[q].w += bfhi(a.y) + bfhi(b.y);
            ss += v[q].x * v[q].x + v[q].y * v[q].y + v[q].z * v[q].z + v[q].w * v[q].w;
        }
        ss = wave_sum(ss);
        const float rstd = rsqrtf(ss * (1.0f / D) + NORM_EPS);
#pragma unroll
        for (int q = 0; q < 4; ++q) {
            const int c = 4 * lane + 256 * q; const float4 w4 = *(const float4*)(p.in[24] + c);
            if (!dry) *(float4*)(hrow + c) = make_float4(v[q].x * rstd * w4.x, v[q].y * rstd * w4.y, v[q].z * rstd * w4.z, v[q].w * rstd * w4.w);
        }
    }
}

__global__ void __launch_bounds__(NT) k_phase0(Params p) { SMEM_DECL; phase0(p, smem, blockIdx.x, gridDim.x); }
__global__ void __launch_bounds__(NT) k_phase1(Params p) { SMEM_DECL; phase1(p, smem, blockIdx.x, gridDim.x); }
__global__ void __launch_bounds__(NT) k_phase2(Params p) { SMEM_DECL; phase2(p, smem, blockIdx.x, gridDim.x, 0); }
__global__ void __launch_bounds__(NT) k_phase3(Params p) { SMEM_DECL; phase3(p, smem, blockIdx.x, gridDim.x); }
__global__ void __launch_bounds__(NT) k_phase4(Params p) { SMEM_DECL; phase4(p, smem, blockIdx.x, gridDim.x); }
__global__ void __launch_bounds__(NT) k_phase5a(Params p) { SMEM_DECL; phase5a(p, smem, blockIdx.x, gridDim.x); }
__global__ void __launch_bounds__(NT) k_phase5b(Params p) { SMEM_DECL; phase5b(p, smem, blockIdx.x, gridDim.x); }
__global__ void __launch_bounds__(NT) k_phase5c(Params p) { SMEM_DECL; phase5c(p, smem, blockIdx.x, gridDim.x); }
__global__ void __launch_bounds__(NT) k_phase5d(Params p) { SMEM_DECL; phase5d(p, smem, blockIdx.x, gridDim.x); }
__global__ void __launch_bounds__(NT) k_phase6(Params p) { SMEM_DECL; phase6(p, smem, blockIdx.x, gridDim.x); }
__global__ void __launch_bounds__(NT) k_phase7(Params p) { SMEM_DECL; phase7(p, smem, blockIdx.x, gridDim.x); }

constexpr int LDS_BYTES = 160 * 1024 - 256;
constexpr int LDS_BARST = LDS_BYTES - 16;

#ifndef EMU
#define LAS __attribute__((address_space(3)))
#define XB_TMO      128
#define XB_XCNT(j)  (256  + 64 * (j))
#define XB_XSUB(j)  (1280 + 64 * (j))
#define XB_XGEN(j)  (2304 + 64 * (j))
#define XB_TOP      3328
#define XB_TOPGEN   3392
#define XCD_BAR_WORDS 3456
#define XB_SPIN_CAP (1u << 22)
__device__ __forceinline__ unsigned xb_ld(unsigned* p)              { return __hip_atomic_load(p, __ATOMIC_RELAXED, __HIP_MEMORY_SCOPE_AGENT); }
__device__ __forceinline__ unsigned xb_add(unsigned* p, unsigned v) { return __hip_atomic_fetch_add(p, v, __ATOMIC_RELAXED, __HIP_MEMORY_SCOPE_AGENT); }
__device__ __forceinline__ unsigned xb_xcc_id() { return (unsigned)__builtin_amdgcn_s_getreg((3 << 11) | 20) & 0xFu; }
#define XB_SPIN(cond, bar) do { unsigned _sp = 0; while (cond) { __builtin_amdgcn_s_sleep(1); \
    if ((++_sp & 255u) == 0u) { if (xb_ld(&(bar)[XB_TMO])) break; if (_sp > XB_SPIN_CAP) { atomicAdd(&(bar)[XB_TMO], 1u); break; } } } } while (0)
struct XcdBarrier { unsigned* bar; unsigned x; volatile LAS unsigned* st; };
__device__ __forceinline__ XcdBarrier xcd_barrier_post(unsigned* bar, volatile LAS unsigned* st) {
    XcdBarrier b; b.bar = bar; b.x = xb_xcc_id(); b.st = st;
    if (threadIdx.x == 0) (void)xb_add(&bar[XB_XCNT(b.x)], 1u);
    return b;
}
__device__ __forceinline__ void xcd_barrier_complete(unsigned* bar, unsigned x, unsigned& nloc, unsigned& nx) {
    const unsigned G = gridDim.x * gridDim.y * gridDim.z;
    unsigned sum, cnt, mine, sp = 0u;
    for (;;) {
        sum = 0u; cnt = 0u; mine = 0u;
#pragma unroll
        for (unsigned j = 0; j < 16; ++j) { const unsigned c = xb_ld(&bar[XB_XCNT(j)]); sum += c; cnt += (c > 0u) ? 1u : 0u; mine = (j == x) ? c : mine; }
        if (sum == G) break;
        __builtin_amdgcn_s_sleep(1);
        if ((++sp & 255u) == 0u) { if (xb_ld(&bar[XB_TMO])) break; if (sp > XB_SPIN_CAP) { atomicAdd(&bar[XB_TMO], 1u); break; } }
    }
    nloc = mine > 0u ? mine : 1u; nx = cnt > 0u ? cnt : 1u;
}
__device__ __forceinline__ void xcd_barrier(const XcdBarrier& b) {
    asm volatile("s_waitcnt vmcnt(0)" ::: "memory");
    __syncthreads();
    if (threadIdx.x == 0) {
        unsigned* bar = b.bar;
        __builtin_amdgcn_s_waitcnt(0);
        unsigned nloc = b.st[0], nx = b.st[1];
        if (nloc == 0u) { xcd_barrier_complete(bar, b.x, nloc, nx); b.st[0] = nloc; b.st[1] = nx; }
        const unsigned old = xb_add(&bar[XB_XSUB(b.x)], 1u);
        const unsigned gen = old / nloc;
        if (old + 1u == (gen + 1u) * nloc) {
            __builtin_amdgcn_fence(__ATOMIC_RELEASE, "agent");
            asm volatile("s_waitcnt vmcnt(0)" ::: "memory");
            const unsigned og = xb_add(&bar[XB_TOP], 1u);
            const unsigned tg = og / nx;
            if (og + 1u == (tg + 1u) * nx) xb_add(&bar[XB_TOPGEN], 1u);
            else XB_SPIN(xb_ld(&bar[XB_TOPGEN]) == tg, bar);
            __builtin_amdgcn_fence(__ATOMIC_ACQUIRE, "agent");
            xb_add(&bar[XB_XGEN(b.x)], 1u);
            asm volatile("s_waitcnt vmcnt(0)" ::: "memory");
        } else {
            XB_SPIN(xb_ld(&bar[XB_XGEN(b.x)]) == gen, bar);
            __builtin_amdgcn_fence(__ATOMIC_ACQUIRE, "agent");
            asm volatile("s_waitcnt vmcnt(0)" ::: "memory");
        }
    }
    __syncthreads();
}
#endif

#ifdef EMU
#define GRID_SYNC() emu_grid_sync()
#define GRID_SYNC_CG() emu_grid_sync()
#else
#define GRID_SYNC_CG() do { \
    asm volatile("s_waitcnt vmcnt(0)" ::: "memory"); \
    __syncthreads(); \
    cooperative_groups::this_grid().sync(); \
    if (threadIdx.x == 0) { __builtin_amdgcn_fence(__ATOMIC_ACQUIRE, "agent"); asm volatile("s_waitcnt vmcnt(0)" ::: "memory"); } \
    __syncthreads(); \
} while (0)
#define GRID_SYNC() xcd_barrier(xbar)
#endif
__global__ void __launch_bounds__(NT) fwd_megakernel(Params p) {
    SMEM_DECL;
    const int bid = blockIdx.x, nblk = gridDim.x;
#ifndef EMU
    if (threadIdx.x < 4) ((volatile LAS unsigned*)(smem + LDS_BARST))[threadIdx.x] = 0u;
    __syncthreads();
    const XcdBarrier xbar = xcd_barrier_post((unsigned*)(p.ws + OFF_SMALL + SM_CTL) + CW_BAR, (volatile LAS unsigned*)(smem + LDS_BARST));
#endif
#if defined(DRY_PHASE) && !defined(EMU)
    int dryflag = 1; asm volatile("" : "+s"(dryflag));
#define EXTRA(k, call) do { if (DRY_PHASE == (k)) { call; GRID_SYNC(); } } while (0)
#else
#define EXTRA(k, call) do {} while (0)
    const int dryflag = 0; (void)dryflag;
#endif
    EXTRA(0, phase0(p, smem, bid, nblk));
    phase0(p, smem, bid, nblk); GRID_SYNC_CG();
    EXTRA(1, phase1(p, smem, bid, nblk));
    phase1(p, smem, bid, nblk); GRID_SYNC();
    EXTRA(2, phase2(p, smem, bid, nblk, dryflag));
    phase2(p, smem, bid, nblk); GRID_SYNC();
    EXTRA(3, phase3(p, smem, bid, nblk, dryflag));
    EXTRA(8, phase3(p, smem, bid, nblk, dryflag, 1));
    EXTRA(9, phase3(p, smem, bid, nblk, dryflag, 2));
    phase3(p, smem, bid, nblk); GRID_SYNC();
    EXTRA(4, phase4(p, smem, bid, nblk));
    phase4(p, smem, bid, nblk); GRID_SYNC();
    EXTRA(5, phase5a(p, smem, bid, nblk));
    phase5a(p, smem, bid, nblk); GRID_SYNC();
    EXTRA(10, phase5b(p, smem, bid, nblk));
    phase5b(p, smem, bid, nblk); GRID_SYNC();
    EXTRA(11, phase5c(p, smem, bid, nblk));
    phase5c(p, smem, bid, nblk); GRID_SYNC();
    EXTRA(12, phase5d(p, smem, bid, nblk, dryflag));
    phase5d(p, smem, bid, nblk); GRID_SYNC();
    EXTRA(6, phase6(p, smem, bid, nblk));
    phase6(p, smem, bid, nblk); GRID_SYNC();
    EXTRA(7, phase7(p, smem, bid, nblk, dryflag));
    phase7(p, smem, bid, nblk);
}

#ifndef EMU
extern "C" void kernel_launch(void* const* d_in, const int* in_sizes, int n_in, void* d_out, int out_size, void* d_ws, size_t ws_size, hipStream_t stream) {
    static int grid = 0;
    if (grid == 0) {
        if (n_in != 25 || ws_size < WS_END || out_size != SEQ * D) { fprintf(stderr, "kernel_launch: unexpected problem (n_in %d, ws %zu, out %d)\n", n_in, ws_size, out_size); grid = -1; return; }
        int dev = 0, cus = 0, per_cu = 0;
        (void)hipGetDevice(&dev);
        (void)hipDeviceGetAttribute(&cus, hipDeviceAttributeMultiprocessorCount, dev);
        (void)hipFuncSetAttribute((const void*)fwd_megakernel, hipFuncAttributeMaxDynamicSharedMemorySize, LDS_BYTES);
        (void)hipOccupancyMaxActiveBlocksPerMultiprocessor(&per_cu, (const void*)fwd_megakernel, NT, LDS_BYTES);
        if (per_cu < 1) { fprintf(stderr, "kernel_launch: occupancy query returned %d\n", per_cu); per_cu = 1; }
        grid = cus * per_cu;
    }
    if (grid < 0) return;
    Params p{};
    for (int i = 0; i < 25; ++i) p.in[i] = (const float*)d_in[i];
    p.out = (float*)d_out; p.ws = (unsigned char*)d_ws;
    (void)hipMemsetAsync((unsigned char*)d_ws + OFF_SMALL + SM_CTL + (size_t)CW_BAR * 4, 0, (size_t)XCD_BAR_WORDS * 4, stream);
    void* args[] = {&p};
    hipError_t e = hipLaunchCooperativeKernel((const void*)fwd_megakernel, dim3(grid), dim3(NT), args, LDS_BYTES, stream);
    if (e != hipSuccess) fprintf(stderr, "cooperative launch failed: %s (grid %d)\n", hipGetErrorString(e), grid);
}
#endif

#ifdef EMU
static void run_phases(Params p, int upto, int grid) {
    if (upto == 100) { emu::launch([=] { fwd_megakernel(p); }, grid, NT, LDS_BYTES, true); return; }
    if (upto >= 0) emu::launch([=] { k_phase0(p); }, grid, NT, LDS_BYTES, false);
    if (upto >= 1) emu::launch([=] { k_phase1(p); }, grid, NT, LDS_BYTES, false);
    if (upto >= 2) emu::launch([=] { k_phase2(p); }, grid, NT, LDS_BYTES, false);
    if (upto >= 3) emu::launch([=] { k_phase3(p); }, grid, NT, LDS_BYTES, false);
    if (upto >= 4) emu::launch([=] { k_phase4(p); }, grid, NT, LDS_BYTES, false);
    if (upto >= 5) { emu::launch([=] { k_phase5a(p); }, grid, NT, LDS_BYTES, false); emu::launch([=] { k_phase5b(p); }, grid, NT, LDS_BYTES, false); emu::launch([=] { k_phase5c(p); }, grid, NT, LDS_BYTES, false); emu::launch([=] { k_phase5d(p); }, grid, NT, LDS_BYTES, false); }
    if (upto >= 6) emu::launch([=] { k_phase6(p); }, grid, NT, LDS_BYTES, false);
    if (upto >= 7) emu::launch([=] { k_phase7(p); }, grid, NT, LDS_BYTES, false);
}
#endif
```

```cpp
#include <type_traits>
#ifndef EMU
#include <hip/hip_runtime.h>
#include <hip/hip_cooperative_groups.h>
#include <cstdio>
#include <cstdint>
#include <cmath>
#endif

#ifndef SEQ
#define SEQ 16384
#endif

typedef unsigned short bf16;
typedef short bf16x8 __attribute__((ext_vector_type(8)));
typedef short bf16x4 __attribute__((ext_vector_type(4)));
typedef float f32x16 __attribute__((ext_vector_type(16)));
typedef float f32x4 __attribute__((ext_vector_type(4)));
typedef unsigned u32x4 __attribute__((ext_vector_type(4)));
typedef unsigned u32x2 __attribute__((ext_vector_type(2)));

#ifdef EMU
#define MFMA32(a, b, c) emu_mfma_32x32x16((a), (b), (c))
#define MFMA16(a, b, c) emu_mfma_16x16x32((a), (b), (c))
#define DI static inline
#define DM inline
#define EXP2F(x) exp2f(x)
#define WAVE_SYNC() emu_wave_sync()
#define LD_NT(p) (*(p))
#define LD_ATOMIC(p) (*(p))
#define ST_ATOMIC(p, v) (*(p) = (v))
#define SCHED_FENCE() do {} while (0)
#else
#define WAVE_SYNC() do { __builtin_amdgcn_fence(__ATOMIC_RELEASE, "wavefront"); __builtin_amdgcn_wave_barrier(); __builtin_amdgcn_fence(__ATOMIC_ACQUIRE, "wavefront"); } while (0)
#define MFMA32(a, b, c) __builtin_amdgcn_mfma_f32_32x32x16_bf16((a), (b), (c), 0, 0, 0)
#define LD_NT(p) __builtin_nontemporal_load(p)
#define LD_ATOMIC(p) __hip_atomic_load((p), __ATOMIC_RELAXED, __HIP_MEMORY_SCOPE_AGENT)
#define ST_ATOMIC(p, v) __hip_atomic_store((p), (v), __ATOMIC_RELAXED, __HIP_MEMORY_SCOPE_AGENT)
#define SCHED_FENCE() __builtin_amdgcn_sched_barrier(0)
#define MFMA16(a, b, c) __builtin_amdgcn_mfma_f32_16x16x32_bf16((a), (b), (c), 0, 0, 0)
#define DI __device__ __forceinline__
#define DM __device__ __forceinline__
#define EXP2F(x) __builtin_amdgcn_exp2f(x)
#endif

constexpr int D = 1024;
constexpr int NMETA = 16;
constexpr int LTOK = SEQ + NMETA;
constexpr int NCH = SEQ / 64 + 1;
constexpr int NT = 512;
constexpr int W_IN_COLS = 9232;
constexpr float NORM_EPS = 1e-6f;
constexpr float LOG2E = 1.4426950408889634f;

constexpr size_t UNIT = (size_t)SEQ * D * 2;
constexpr size_t OFF_WTIN = 0;
constexpr size_t OFF_WTBA = OFF_WTIN + (size_t)9216 * 1024 * 2;
constexpr size_t OFF_WTBD = OFF_WTBA + (size_t)1024 * 1024 * 2;
constexpr size_t OFF_WTOUT = OFF_WTBD + (size_t)1024 * 1024 * 2;
constexpr size_t OFF_SMALL = OFF_WTOUT + (size_t)1024 * 1024 * 2;
constexpr size_t SM_CTL = 0;
constexpr size_t SM_UMETA = SM_CTL + 65536;
constexpr size_t SM_AKMETA = SM_UMETA + 16 * 1024 * 2;
constexpr size_t SM_AVTMETA = SM_AKMETA + 16 * 1024 * 2;
constexpr size_t SM_C0Q = SM_AVTMETA + 8 * 128 * 16 * 2;
constexpr size_t SM_C0K = SM_C0Q + 64 * 1024 * 2;
constexpr size_t SM_C0V = SM_C0K + 64 * 1024 * 2;
constexpr size_t SM_C0W = SM_C0V + 64 * 1024 * 2;
constexpr size_t SM_C0QK = SM_C0W + 8 * 64 * 128 * 2;
constexpr size_t SM_BETA = SM_C0QK + 8 * 64 * 64 * 2;
constexpr size_t SM_G = SM_BETA + (size_t)NCH * 64 * 8 * 4;
constexpr size_t SM_GC = SM_G + (size_t)NCH * 64 * 8 * 4;
constexpr size_t SM_WR = SM_GC + (size_t)NCH * 8 * 64 * 4;
constexpr size_t SM_RIDS = SM_WR + 2 * 64 * 1024 * 2;
constexpr size_t SM_RW = SM_RIDS + 0;
constexpr size_t SM_TAILS = SM_RW + (size_t)SEQ * 2 * 4;
constexpr size_t SM_TAILS_BYTES = ((size_t)NCH * 3 * 3072 * 2 > (size_t)32 * SEQ * 4) ? (size_t)NCH * 3 * 3072 * 2 : (size_t)32 * SEQ * 4;
constexpr size_t SM_END = SM_TAILS + SM_TAILS_BYTES;
constexpr size_t SMALL_BYTES = (SM_END + 255) & ~(size_t)255;
constexpr size_t OFF_U = ((OFF_SMALL + SMALL_BYTES + (1u << 20) - 1) >> 20) << 20;
constexpr size_t OFF_W = OFF_U + UNIT;
constexpr size_t OFF_KN = OFF_W + UNIT;
constexpr size_t OFF_QN = OFF_KN + UNIT;
constexpr size_t OFF_DG = OFF_QN + UNIT;
constexpr size_t OFF_V = OFF_DG + UNIT;
constexpr size_t OFF_AQ = OFF_V + UNIT;
constexpr size_t WS_BASE_END = OFF_AQ + UNIT;
constexpr size_t EXPERT_BYTES = (size_t)32 * 3 * 1024 * 256 * 2;
constexpr size_t OFF_EXP = (2 * UNIT >= EXPERT_BYTES) ? OFF_W : WS_BASE_END;
constexpr size_t WS_END1 = (OFF_EXP == OFF_W) ? WS_BASE_END : WS_BASE_END + EXPERT_BYTES;
constexpr size_t H_BYTES = ((size_t)2 * SEQ + 32 * 256) * 256 * 2;
constexpr size_t OFF_H = (H_BYTES <= UNIT) ? (OFF_SMALL + SMALL_BYTES + ((1u << 20) - 1)) / (1u << 20) * (1u << 20) : WS_END1;
constexpr size_t WS_END = (H_BYTES <= UNIT) ? WS_END1 : WS_END1 + H_BYTES;
constexpr size_t OFF_EXG = OFF_EXP, OFF_EXU = OFF_EXP + EXPERT_BYTES / 3, OFF_EXD = OFF_EXP + 2 * (EXPERT_BYTES / 3);
constexpr size_t OFF_QKB = OFF_U;
constexpr size_t OFF_OD = OFF_QN;
constexpr size_t OFF_Y = OFF_V;
#if SEQ == 16384
static_assert(WS_END <= (size_t)256 << 20, "workspace map exceeds 256 MiB");
static_assert(EXPERT_BYTES <= 2 * UNIT, "experts fit R2+R3");
#endif
constexpr int CW_ATTQ = 64;
constexpr int CW_ECNT = 128;
constexpr int CW_NRM = 256;
constexpr int CW_BAR = 1024;

struct Params {
    const float* in[25];
    float* out;
    unsigned char* ws;
};

#ifdef EMU
DI unsigned f2bf(float f) { unsigned u = __builtin_bit_cast(unsigned, f); return (u + 0x7fffu + ((u >> 16) & 1u)) >> 16; }
#else
DI unsigned f2bf(float f) { return (unsigned)__builtin_bit_cast(unsigned short, (__bf16)f); }
#endif

DI float bf2f(unsigned b) { return __builtin_bit_cast(float, (b & 0xffffu) << 16); }
#ifdef EMU
DI unsigned pk2(float lo, float hi) { return f2bf(lo) | (f2bf(hi) << 16); }
DI bool wave_any(bool pr) { int v = pr ? 1 : 0;
    for (int o = 1; o < 64; o <<= 1) v |= __shfl_xor(v, o);
    return v != 0; }
#else
typedef __bf16 hwbf2 __attribute__((ext_vector_type(2)));
typedef float f32x2_ __attribute__((ext_vector_type(2)));
DI unsigned pk2(float lo, float hi) { return __builtin_bit_cast(unsigned, __builtin_convertvector((f32x2_){lo, hi}, hwbf2)); }
DI bool wave_any(bool pr) { return __any(pr) != 0; }
#endif
DI float bflo(unsigned w) { return __builtin_bit_cast(float, w << 16); }
DI float bfhi(unsigned w) { return __builtin_bit_cast(float, w & 0xffff0000u); }
DI float sigmoidf_(float x) { return 1.0f / (1.0f + __expf(-x)); }
DI float siluf_(float x) { return x / (1.0f + __expf(-x)); }
DI float wave_sum(float v) {
#pragma unroll
    for (int o = 1; o < 64; o <<= 1) v += __shfl_xor(v, o);
    return v;
}
DI int fresh_tid() {
    int t = threadIdx.x;
#ifndef EMU
    asm volatile("" : "+v"(t));
#endif
    return t;
}
#ifdef EMU
DI float xhalf(float v) { return __shfl_xor(v, 32); }
#else
DI float xhalf(float v) { const unsigned u = __builtin_bit_cast(unsigned, v); const auto r = __builtin_amdgcn_permlane32_swap(u, u, false, false); return __builtin_bit_cast(float, (threadIdx.x & 32) ? r[0] : r[1]); }
#endif
DI f32x16 zero16() { f32x16 z; for (int i = 0; i < 16; ++i) z[i] = 0.f; return z; }
DI f32x4 zero4() { f32x4 z; for (int i = 0; i < 4; ++i) z[i] = 0.f; return z; }
DI int swz128(int row, int c) { return row * 128 + ((c ^ ((row >> 1) & 7)) << 4); }
DI int swz128t(int row, int c) { return row * 128 + ((c ^ ((row >> 1) & 7) ^ ((row >> 4) & 7)) << 4); }
DI int swz128_8(int row, int s) { return row * 128 + ((s ^ (((row >> 1) & 7) << 1)) << 3); }
DI int swzrow(int row, int pitch, int c) { return row * pitch + ((c ^ (row & 15)) << 4); }

#ifdef EMU
#define SMEM_DECL char* smem = emu_smem()
#else
#define SMEM_DECL extern __shared__ __attribute__((aligned(16))) char smem[]
#endif

DI void transpose_item(const float* W, int ldw, int K, bf16* Wt, int k0, int src_n0, int dst_n0, float* scr, int lane, int il = 0) {
#pragma unroll 8
    for (int i = 0; i < 32; ++i) { const int kk = 2 * i + (lane >> 5); scr[kk * 33 + (lane & 31)] = W[(size_t)(k0 + kk) * ldw + src_n0 + (lane & 31)]; }
    WAVE_SYNC();
    const int c = lane & 7;
#pragma unroll
    for (int j = 0; j < 4; ++j) {
        const int n = (lane >> 3) + 8 * j; const float* s = scr + (8 * c) * 33 + n;
        u32x4 o; o.x = pk2(s[0 * 33], s[1 * 33]); o.y = pk2(s[2 * 33], s[3 * 33]); o.z = pk2(s[4 * 33], s[5 * 33]); o.w = pk2(s[6 * 33], s[7 * 33]);
        const int hid = dst_n0 + n, drow = il ? 8 * (hid >> 2) + 4 * (il - 1) + (hid & 3) : hid;
        *(u32x4*)(Wt + (size_t)drow * K + k0 + 8 * c) = o;
    }
    WAVE_SYNC();
}

DI void phase0(const Params& p, char* smem, int bid, int nblk) {
    const int tid = fresh_tid(), lane = tid & 63, wave = tid >> 6;
    const int gw = bid * 8 + wave, NGW = nblk * 8;
    unsigned char* ws = p.ws;
    if (bid == 0) {
        unsigned* ctl = (unsigned*)(ws + OFF_SMALL + SM_CTL);
        for (int i = tid; i < 1024; i += NT) ctl[i] = 0u;
        float* be = (float*)(ws + OFF_SMALL + SM_BETA); float* gg = (float*)(ws + OFF_SMALL + SM_G);
        for (int i = tid; i < 48 * 8; i += NT) { be[i] = 0.f; gg[i] = 0.f; }
    }
    {
        float* scr = (float*)(smem + 65536) + wave * (64 * 33);
        constexpr int I_IN = 16 * (9216 / 32), I_SQ = 16 * 32;
        constexpr int NITEMS = I_IN + 3 * I_SQ;
        for (int it = gw; it < NITEMS; it += NGW) {
            int r = it;
            if (r < I_IN) { const int kb = r / 288, nb = r % 288; const int dn = nb * 32; const int sn = dn < 7168 ? dn : dn + 16;
                transpose_item(p.in[3], W_IN_COLS, 1024, (bf16*)(ws + OFF_WTIN), kb * 64, sn, dn, scr, lane); continue; }
            r -= I_IN;
            const int m = r / I_SQ; r %= I_SQ;
            const float* src = m == 0 ? p.in[13] : (m == 1 ? p.in[14] : p.in[15]);
            bf16* dst = (bf16*)(ws + (m == 0 ? OFF_WTBA : (m == 1 ? OFF_WTBD : OFF_WTOUT)));
            transpose_item(src, 1024, 1024, dst, (r / 32) * 64, (r % 32) * 32, (r % 32) * 32, scr, lane);
        }
    }
    {
        bf16* WH = (bf16*)(ws + OFF_SMALL + SM_WR); bf16* WL = WH + 64 * 1024;
        for (int i = bid * NT + tid; i < 64 * 1024; i += nblk * NT) {
            const int n = i >> 10, kk = i & 1023; float v = 0.f;
            if (n < 4) v = p.in[17][kk * 4 + n]; else if (n < 36) v = p.in[19][kk * 32 + (n - 4)];
            v *= p.in[16][kk];
            const unsigned hb = f2bf(v); const float lo = v - bf2f(hb);
            WH[i] = (bf16)hb; WL[i] = (bf16)f2bf(lo);
        }
    }
    float* wbd = (float*)smem;
    for (int i = tid; i < 1024 * 16; i += NT) { const int k = i >> 4, c = i & 15; wbd[c * 1024 + k] = p.in[3][(size_t)k * W_IN_COLS + 7168 + c]; }
    __syncthreads();
    const float* nw = p.in[2];
    for (int R = gw; R < LTOK; R += NGW) {
        const float* xrow = R < NMETA ? p.in[1] + (size_t)R * D : p.in[0] + (size_t)(R - NMETA) * D;
        bf16* urow = R < NMETA ? (bf16*)(ws + OFF_SMALL + SM_UMETA) + (size_t)R * D : (bf16*)(ws + OFF_U) + (size_t)(R - NMETA) * D;
        float ss = 0.f;
#pragma unroll
        for (int j = 0; j < 4; ++j) { const float4 v = *(const float4*)(xrow + 4 * lane + 256 * j); ss += v.x * v.x + v.y * v.y + v.z * v.z + v.w * v.w; }
        ss = wave_sum(ss);
        const float rstd = rsqrtf(ss * (1.0f / D) + NORM_EPS);
        float acc[16];
#pragma unroll
        for (int c = 0; c < 16; ++c) acc[c] = 0.f;
#pragma unroll 1
        for (int j = 0; j < 4; ++j) {
            const float4 w4 = *(const float4*)(nw + 4 * lane + 256 * j);
            const float4 xv = *(const float4*)(xrow + 4 * lane + 256 * j);
            float uu[4] = {xv.x * rstd * w4.x, xv.y * rstd * w4.y, xv.z * rstd * w4.z, xv.w * rstd * w4.w};
            u32x2 o; o.x = pk2(uu[0], uu[1]); o.y = pk2(uu[2], uu[3]);
            *(u32x2*)(urow + 4 * lane + 256 * j) = o;
#pragma unroll
            for (int c = 0; c < 16; ++c) {
                const f32x4 w = *(const f32x4*)(wbd + c * 1024 + 4 * lane + 256 * j);
                acc[c] += uu[0] * w[0] + uu[1] * w[1] + uu[2] * w[2] + uu[3] * w[3];
            }
        }
        float v8[8], v4[4], v2[2], a;
        {
            const bool b0 = lane & 1, b1 = lane & 2, b2 = lane & 4, b3 = lane & 8;
#pragma unroll
            for (int i = 0; i < 8; ++i) { const float keep = b0 ? acc[i + 8] : acc[i], send = b0 ? acc[i] : acc[i + 8]; v8[i] = keep + __shfl_xor(send, 1); }
#pragma unroll
            for (int i = 0; i < 4; ++i) { const float keep = b1 ? v8[i + 4] : v8[i], send = b1 ? v8[i] : v8[i + 4]; v4[i] = keep + __shfl_xor(send, 2); }
#pragma unroll
            for (int i = 0; i < 2; ++i) { const float keep = b2 ? v4[i + 2] : v4[i], send = b2 ? v4[i] : v4[i + 2]; v2[i] = keep + __shfl_xor(send, 4); }
            { const float keep = b3 ? v2[1] : v2[0], send = b3 ? v2[0] : v2[1]; a = keep + __shfl_xor(send, 8); }
            a += __shfl_xor(a, 16); a += __shfl_xor(a, 32);
        }
        if (lane < 16) {
            const int cc = ((lane & 1) << 3) | ((lane & 2) << 1) | ((lane & 4) >> 1) | ((lane & 8) >> 3);
            const size_t pos = 48 + R;
            if (cc < 8) { ((float*)(ws + OFF_SMALL + SM_BETA))[pos * 8 + cc] = sigmoidf_(a); }
            else { const int hh = cc - 8; const float z = a + p.in[11][hh]; const float sp = fmaxf(z, 0.f) + log1pf(__expf(-fabsf(z)));
                   ((float*)(ws + OFF_SMALL + SM_G))[pos * 8 + hh] = -__expf(p.in[10][hh]) * sp; }
        }
    }
}

namespace pg8 {
constexpr int BM = 256, BK = 64, HALF = 128, HTB = HALF * BK * 2, NXCD = 8, WGM = 8;
DI int lds_byte(int r, int c) { const int st = (r >> 4) * 2 + (c >> 5), rr = r & 15, cc = c & 31, ob = rr * 64 + cc * 2; return st * 1024 + (ob ^ (((ob >> 9) & 1) << 5)); }
DI void stage_rc(int b, int& R, int& C) { const int st = b / 1024, sb = b % 1024, swz = sb ^ (((sb >> 9) & 1) << 5); R = (st >> 1) * 16 + swz / 64; C = (st & 1) * 32 + (swz % 64) / 2; }
DI int perm32(int rho) { const int n = rho >> 4, i = rho & 15; return 8 * (i >> 2) + 4 * n + (i & 3); }
struct Unit { int pm, pn, e; };
struct Gemm { const bf16* A; const bf16* Bt; int M, N, K; };
struct StaticOrder {
    static constexpr bool GATHER = false;
    int nM, nN, nwg, G, c;
    DM void init(int M, int N, int G_, int c_) { nM = M / BM; nN = N / BM; nwg = nM * nN; G = G_; c = c_; }
    DM bool next(int i, Unit& u) const {
        const long L = (long)i * G + c; if (L >= nwg) return false;
        int wgid = (int)L; { const int q = nwg / NXCD, r = nwg % NXCD, xcd = wgid % NXCD, off = wgid / NXCD; wgid = (xcd < r ? xcd * (q + 1) : r * (q + 1) + (xcd - r) * q) + off; }
        const int nig = WGM * nN, gid = wgid / nig, fm = gid * WGM, gsz = (nM - fm) < WGM ? (nM - fm) : WGM;
        u.pm = fm + ((wgid % nig) % gsz); u.pn = (wgid % nig) / gsz; u.e = 0; return true;
    }
    DM const char* a_tile(const Gemm& g, const Unit& u) const { return (const char*)g.A + (size_t)u.pm * 256 * g.K * 2; }
    DM const char* b_tile(const Gemm& g, const Unit& u) const { return (const char*)g.Bt + (size_t)u.pn * 256 * g.K * 2; }
    DM int a_row(const Unit&, int) const { return 0; }
};
#ifdef EMU
template <class Epi, class Sched>
DI void gemm_phase(char* lds, const Gemm g, const Sched& S, const Epi& E) {
    const int tid = threadIdx.x, wid = tid >> 6, lane = tid & 63, wr = wid >> 2, wc = wid & 3, fr = lane & 15, fq = lane >> 4;
    Unit u;
    for (int ui = 0; S.next(ui, u); ++ui) {
        f32x4 acc[2][2][4][2];
        const bf16* bt = (const bf16*)S.b_tile(g, u);
        for (int ai = 0; ai < 2; ++ai) for (int bj = 0; bj < 2; ++bj) for (int m = 0; m < 4; ++m) for (int n = 0; n < 2; ++n) for (int e = 0; e < 4; ++e) {
            const int r = 128 * ai + 64 * wr + 16 * m + fr;
            const int c = 128 * bj + 32 * wc + (Epi::PERM ? 8 * fq + 4 * n : 16 * n + 4 * fq) + e;
            const bf16* a = Sched::GATHER ? g.A + (size_t)S.a_row(u, r) * g.K : (const bf16*)S.a_tile(g, u) + (size_t)r * g.K;
            const bf16* b = bt + (size_t)c * g.K; float s = 0.f;
            for (int kk = 0; kk < g.K; ++kk) s += bf2f(a[kk]) * bf2f(b[kk]);
            acc[ai][bj][m][n][e] = s;
        }
        E(acc, u, wr, wc, fr, fq);
    }
    __syncthreads();
}
#else
#define PG8_LAS __attribute__((address_space(3)))
template <class Epi, class Sched>
__device__ __forceinline__ void gemm_phase(char* lds_, const Gemm g, const Sched& S, const Epi& E) {
    PG8_LAS unsigned char* lds = (PG8_LAS unsigned char*)lds_;
    const int tid = fresh_tid(), wid = __builtin_amdgcn_readfirstlane(tid >> 6), lane = tid & 63, wr = wid >> 2, wc = wid & 3, fr = lane & 15, fq = lane >> 4;
    const int K = g.K, nt = K / BK;
    unsigned voffA[2], voffB[2]; int RA[2], CA[2];
#pragma unroll
    for (int i = 0; i < 2; ++i) { int R, C; stage_rc(tid * 16 + i * 8192, R, C); const int Rb = Epi::PERM ? ((R & ~31) + perm32(R & 31)) : R;
        voffA[i] = (unsigned)(R * K + C) * 2u; voffB[i] = (unsigned)(Rb * K + C) * 2u; RA[i] = R; CA[i] = C; }
    const size_t kstep = (size_t)(BK * 2);
    const size_t hstep = (size_t)HALF * K * 2;
    const unsigned ldsw = (unsigned)wid * 1024u;
    const int aoff = lds_byte(wr * 64 + fr, fq * 8), boff = lds_byte(wc * 32 + fr, fq * 8);
#define PG8_SA(b, h) (((b) * 2 + (h)) * HTB)
#define PG8_SB(b, h) ((4 + (b) * 2 + (h)) * HTB)
#define PG8_STAGE(bufoff, gbase, voff) do { _Pragma("unroll") for (int _i = 0; _i < 2; ++_i) \
        __builtin_amdgcn_global_load_lds((const unsigned*)((const char*)(gbase) + (voff)[_i]), (PG8_LAS unsigned*)(lds + (bufoff) + ldsw + _i * 8192), 16, 0, 0); } while (0)
#define PG8_STAGE_A(bufoff, base, PA, half, koff) do { if constexpr (Sched::GATHER) { _Pragma("unroll") for (int _i = 0; _i < 2; ++_i) \
        __builtin_amdgcn_global_load_lds((const unsigned*)((PA)[half][_i] + (koff)), (PG8_LAS unsigned*)(lds + (bufoff) + ldsw + _i * 8192), 16, 0, 0); } \
        else { PG8_STAGE(bufoff, (base) + (half) * hstep + (koff), voffA); } } while (0)
#define PG8_LDA(dst, b, h) do { _Pragma("unroll") for (int m = 0; m < 4; ++m) _Pragma("unroll") for (int k = 0; k < 2; ++k) dst[m][k] = *(const PG8_LAS bf16x8*)(lds + PG8_SA(b, h) + aoff + m * 2048 + k * 1024); } while (0)
#define PG8_LDB(dst, b, h) do { _Pragma("unroll") for (int n = 0; n < 2; ++n) _Pragma("unroll") for (int k = 0; k < 2; ++k) dst[n][k] = *(const PG8_LAS bf16x8*)(lds + PG8_SB(b, h) + boff + n * 2048 + k * 1024); } while (0)
#define PG8_MMA(ai, bj, At, Bt) do { __builtin_amdgcn_s_setprio(1); _Pragma("unroll") for (int m = 0; m < 4; ++m) _Pragma("unroll") for (int n = 0; n < 2; ++n) _Pragma("unroll") for (int k = 0; k < 2; ++k) \
        acc[ai][bj][m][n] = __builtin_amdgcn_mfma_f32_16x16x32_bf16(Bt[n][k], At[m][k], acc[ai][bj][m][n], 0, 0, 0); __builtin_amdgcn_s_setprio(0); } while (0)
#define PG8_WAIT_V(n) asm volatile("s_waitcnt vmcnt(" #n ")" ::: "memory")
#define PG8_WAIT_L(n) asm volatile("s_waitcnt lgkmcnt(" #n ")" ::: "memory")
#define PG8_BAR __builtin_amdgcn_s_barrier()
#define PG8_SCHED __builtin_amdgcn_sched_barrier(0)
    Unit cur, nxt; int ui = 0;
    if (S.next(0, cur)) {
    f32x4 acc[2][2][4][2];
#pragma unroll
    for (int a = 0; a < 2; ++a)
#pragma unroll
        for (int b = 0; b < 2; ++b)
#pragma unroll
            for (int m = 0; m < 4; ++m)
#pragma unroll
                for (int n = 0; n < 2; ++n) acc[a][b][m][n] = (f32x4){0.f, 0.f, 0.f, 0.f};
    bf16x8 At[4][2], B0[2][2], B1[2][2];
    const char* PAc[2][2]; const char* PAn[2][2];
    auto gather_ptrs = [&](const Unit& u, const char* (&PA)[2][2]) {
        if constexpr (Sched::GATHER) {
#pragma unroll
            for (int hh = 0; hh < 2; ++hh)
#pragma unroll
                for (int i = 0; i < 2; ++i) PA[hh][i] = (const char*)g.A + ((size_t)S.a_row(u, hh * 128 + RA[i]) * K + CA[i]) * 2;
        }
    };
    const char* cA = Sched::GATHER ? nullptr : S.a_tile(g, cur); const char* cB = S.b_tile(g, cur);
    gather_ptrs(cur, PAc);
    PG8_STAGE(PG8_SB(0, 0), cB, voffB); PG8_STAGE_A(PG8_SA(0, 0), cA, PAc, 0, 0); PG8_STAGE(PG8_SB(0, 1), cB + hstep, voffB); PG8_STAGE_A(PG8_SA(0, 1), cA, PAc, 1, 0);
    if (wr == 1) PG8_BAR;
    PG8_WAIT_V(4); PG8_BAR;
    PG8_STAGE(PG8_SB(1, 0), cB + kstep, voffB); PG8_STAGE_A(PG8_SA(1, 0), cA, PAc, 0, kstep); PG8_STAGE(PG8_SB(1, 1), cB + hstep + kstep, voffB);
    PG8_WAIT_V(6); PG8_BAR;
    for (;;) {
        const bool has_next = S.next(ui + 1, nxt);
        const char* nA = Sched::GATHER ? nullptr : (has_next ? S.a_tile(g, nxt) : cA); const char* nB = has_next ? S.b_tile(g, nxt) : cB;
        if (has_next) gather_ptrs(nxt, PAn); else { if constexpr (Sched::GATHER) { PAn[0][0] = PAc[0][0]; PAn[0][1] = PAc[0][1]; PAn[1][0] = PAc[1][0]; PAn[1][1] = PAc[1][1]; } }
        for (int t = 0; t < nt; t += 2) {
            const bool last = (t == nt - 2);
            const size_t k1 = (size_t)(t + 1) * kstep;
            const char* a2 = last ? nA : cA; const char* b2 = last ? nB : cB + (size_t)(t + 2) * kstep;
            const size_t k2 = last ? 0 : (size_t)(t + 2) * kstep, k3 = k2 + kstep;
            const char* b3 = b2 + kstep;
            const char* P2[2][2];
            if constexpr (Sched::GATHER) {
#pragma unroll
                for (int hh = 0; hh < 2; ++hh)
#pragma unroll
                    for (int i = 0; i < 2; ++i) P2[hh][i] = last ? PAn[hh][i] : PAc[hh][i];
            }
            PG8_LDB(B0, 0, 0); PG8_SCHED; PG8_LDA(At, 0, 0); PG8_STAGE_A(PG8_SA(1, 1), cA, PAc, 1, k1);
            PG8_WAIT_L(8); PG8_BAR; PG8_WAIT_L(0); PG8_MMA(0, 0, At, B0); PG8_BAR; PG8_SCHED;
            PG8_LDB(B1, 0, 1); PG8_STAGE(PG8_SB(0, 0), b2, voffB);
            PG8_BAR; PG8_WAIT_L(0); PG8_MMA(0, 1, At, B1); PG8_BAR;
            PG8_LDA(At, 0, 1); PG8_STAGE_A(PG8_SA(0, 0), a2, P2, 0, k2);
            PG8_BAR; PG8_WAIT_L(0); PG8_MMA(1, 0, At, B0); PG8_BAR; PG8_SCHED;
            PG8_STAGE(PG8_SB(0, 1), b2 + hstep, voffB);
            PG8_WAIT_V(6); PG8_BAR; PG8_MMA(1, 1, At, B1); PG8_BAR;
            PG8_LDB(B0, 1, 0); PG8_SCHED; PG8_LDA(At, 1, 0); PG8_STAGE_A(PG8_SA(0, 1), a2, P2, 1, k2);
            PG8_WAIT_L(8); PG8_BAR; PG8_WAIT_L(0); PG8_MMA(0, 0, At, B0); PG8_BAR; PG8_SCHED;
            PG8_LDB(B1, 1, 1); PG8_STAGE(PG8_SB(1, 0), b3, voffB);
            PG8_BAR; PG8_WAIT_L(0); PG8_MMA(0, 1, At, B1); PG8_BAR;
            PG8_LDA(At, 1, 1); PG8_STAGE_A(PG8_SA(1, 0), a2, P2, 0, k3);
            PG8_BAR; PG8_WAIT_L(0); PG8_MMA(1, 0, At, B0); PG8_BAR; PG8_SCHED;
            PG8_STAGE(PG8_SB(1, 1), b3 + hstep, voffB);
            PG8_WAIT_V(6); PG8_BAR; PG8_MMA(1, 1, At, B1); PG8_BAR;
        }
        E(acc, cur, wr, wc, fr, fq);
        if (!has_next) break;
#pragma unroll
        for (int a = 0; a < 2; ++a)
#pragma unroll
            for (int b = 0; b < 2; ++b)
#pragma unroll
                for (int m = 0; m < 4; ++m)
#pragma unroll
                    for (int n = 0; n < 2; ++n) acc[a][b][m][n] = (f32x4){0.f, 0.f, 0.f, 0.f};
        cur = nxt; cA = nA; cB = nB; ++ui;
        if constexpr (Sched::GATHER) { PAc[0][0] = PAn[0][0]; PAc[0][1] = PAn[0][1]; PAc[1][0] = PAn[1][0]; PAc[1][1] = PAn[1][1]; }
    }
    PG8_WAIT_V(0);
    if (wr == 0) PG8_BAR;
    PG8_BAR;
    }
    __syncthreads();
#undef PG8_SA
#undef PG8_SB
#undef PG8_STAGE
#undef PG8_STAGE_A
#undef PG8_LDA
#undef PG8_LDB
#undef PG8_MMA
#undef PG8_WAIT_V
#undef PG8_WAIT_L
#undef PG8_BAR
#undef PG8_SCHED
}
#endif
}

constexpr int G_BM = 256, G_BN = 128, G_BK = 64;
constexpr int G_LDS_A = G_BM * G_BK * 2, G_LDS_B = G_BN * G_BK * 2;
constexpr int G_STAGE_PITCH = 132;
constexpr int G_LDS_BYTES = G_BM * G_STAGE_PITCH * 4;
constexpr int G_MT = SEQ / 256 + 1, G_NTILES = 56;

DI void gemm_inproj_tile(const Params& p, char* smem, int mt, int nt) {
    const int tid = fresh_tid(), lane = tid & 63, wave = tid >> 6;
    const int wm = wave >> 1, wn = wave & 1, r32 = lane & 31, h = lane >> 5;
    unsigned char* ws = p.ws;
    const bool meta = (mt == G_MT - 1);
    const bf16* A = meta ? (const bf16*)(ws + OFF_SMALL + SM_UMETA) : (const bf16*)(ws + OFF_U) + (size_t)mt * 256 * D;
    const int vrows = meta ? NMETA : 256;
    const bf16* Bt = (const bf16*)(ws + OFF_WTIN) + (size_t)nt * 128 * D;
    char* ldsA[2] = {smem, smem + G_LDS_A + G_LDS_B};
    char* ldsB[2] = {smem + G_LDS_A, smem + 2 * G_LDS_A + G_LDS_B};
    f32x16 acc[2][2];
#pragma unroll
    for (int i = 0; i < 2; ++i)
#pragma unroll
        for (int j = 0; j < 2; ++j) acc[i][j] = zero16();
    const int lrow = tid >> 3, lc = tid & 7;
    u32x4 ra[4], rb[2];
    auto gload = [&](int kt) {
#pragma unroll
        for (int i = 0; i < 4; ++i) { const int row = lrow + 64 * i; ra[i] = row < vrows ? *(const u32x4*)(A + (size_t)row * D + kt * 64 + lc * 8) : (u32x4){0u, 0u, 0u, 0u}; }
#pragma unroll
        for (int i = 0; i < 2; ++i) { const int row = lrow + 64 * i; rb[i] = *(const u32x4*)(Bt + (size_t)row * D + kt * 64 + lc * 8); }
    };
    auto lstore = [&](int buf) {
#pragma unroll
        for (int i = 0; i < 4; ++i) *(u32x4*)(ldsA[buf] + swz128(lrow + 64 * i, lc)) = ra[i];
#pragma unroll
        for (int i = 0; i < 2; ++i) *(u32x4*)(ldsB[buf] + swz128(lrow + 64 * i, lc)) = rb[i];
    };
    gload(0); lstore(0); __syncthreads();
    for (int kt = 0; kt < 16; ++kt) {
        const int buf = kt & 1;
        if (kt + 1 < 16) gload(kt + 1);
#pragma unroll
        for (int ks = 0; ks < 4; ++ks) {
            bf16x8 af[2], bfr[2];
#pragma unroll
            for (int i = 0; i < 2; ++i) af[i] = *(const bf16x8*)(ldsA[buf] + swz128(64 * wm + 32 * i + r32, 2 * ks + h));
#pragma unroll
            for (int j = 0; j < 2; ++j) bfr[j] = *(const bf16x8*)(ldsB[buf] + swz128(64 * wn + 32 * j + r32, 2 * ks + h));
#pragma unroll
            for (int i = 0; i < 2; ++i)
#pragma unroll
                for (int j = 0; j < 2; ++j) acc[i][j] = MFMA32(af[i], bfr[j], acc[i][j]);
        }
        if (kt + 1 < 16) lstore(buf ^ 1);
        __syncthreads();
    }
    float* st = (float*)smem;
#pragma unroll
    for (int i = 0; i < 2; ++i)
#pragma unroll
        for (int j = 0; j < 2; ++j)
#pragma unroll
            for (int r = 0; r < 16; ++r) {
                const int row = 64 * wm + 32 * i + (r & 3) + 8 * (r >> 2) + 4 * h, col = 64 * wn + 32 * j + r32;
                st[row * G_STAGE_PITCH + col] = acc[i][j][r];
            }
    __syncthreads();
    const int tid2 = fresh_tid();
    const int sec = nt >> 3, cb = (nt & 7) * 128;
    {
        bf16* base; bool has_meta = true; bf16* mbase = nullptr; int mrow0 = 0;
        if (sec == 0) { base = (bf16*)(ws + OFF_AQ); has_meta = false; }
        else if (sec == 1) { base = (bf16*)p.out; mbase = (bf16*)(ws + OFF_SMALL + SM_AKMETA); }
        else if (sec == 2) { base = (bf16*)p.out + (size_t)SEQ * D; mbase = (bf16*)(ws + OFF_SMALL + SM_AVTMETA); }
        else if (sec == 3) { base = (bf16*)(ws + OFF_QN); mbase = (bf16*)(ws + OFF_SMALL + SM_C0Q); mrow0 = 48; }
        else if (sec == 4) { base = (bf16*)(ws + OFF_KN); mbase = (bf16*)(ws + OFF_SMALL + SM_C0K); mrow0 = 48; }
        else if (sec == 5) { base = (bf16*)(ws + OFF_V); mbase = (bf16*)(ws + OFF_SMALL + SM_C0V); mrow0 = 48; }
        else { base = (bf16*)(ws + OFF_DG); has_meta = false; }
        const bool dqkv = (sec >= 3 && sec <= 5);
        bf16* tails = (bf16*)(ws + OFF_SMALL + SM_TAILS);
        if (!meta || has_meta) {
#pragma unroll
            for (int i = 0; i < 8; ++i) {
                const int idx = tid2 + NT * i, row = idx >> 4, cg = idx & 15;
                if (row < vrows) {
                    const float* s = st + row * G_STAGE_PITCH + cg * 8;
                    const f32x4 a = *(const f32x4*)s, b = *(const f32x4*)(s + 4);
                    u32x4 o; o.x = pk2(a[0], a[1]); o.y = pk2(a[2], a[3]); o.z = pk2(b[0], b[1]); o.w = pk2(b[2], b[3]);
                    if (!meta) {
                        const int j = mt * 256 + row;
                        *(u32x4*)(base + (size_t)j * D + cb + cg * 8) = o;
                        if (dqkv && (j & 63) >= 61) *(u32x4*)(tails + ((size_t)(j / 64 + 1) * 3 + ((j & 63) - 61)) * 3072 + (sec - 3) * 1024 + cb + cg * 8) = o;
                    } else {
                        *(u32x4*)(mbase + (size_t)(mrow0 + row) * D + cb + cg * 8) = o;
                        if (dqkv && row >= 13) *(u32x4*)(tails + ((size_t)0 * 3 + (row - 13)) * 3072 + (sec - 3) * 1024 + cb + cg * 8) = o;
                    }
                }
            }
        }
    }
    __syncthreads();
}

struct EpiInproj {
    static constexpr bool PERM = true;
    unsigned char* ws; bf16* out16;
    DM void operator()(const f32x4 (&acc)[2][2][4][2], const pg8::Unit& u, int wr, int wc, int fr, int fq) const {
        const int colt = u.pn * 256, sec = colt >> 10, cb = colt & 1023;
        bf16* base = sec == 0 ? (bf16*)(ws + OFF_AQ) : sec == 1 ? out16 : sec == 2 ? out16 + (size_t)SEQ * D : sec == 3 ? (bf16*)(ws + OFF_QN) : sec == 4 ? (bf16*)(ws + OFF_KN)
                   : sec == 5 ? (bf16*)(ws + OFF_V) : (bf16*)(ws + OFF_DG);
        const bool dqkv = sec >= 3 && sec <= 5;
        bf16* tails = (bf16*)(ws + OFF_SMALL + SM_TAILS) + (sec - 3) * 1024;
        const int row0 = u.pm * 256 + wr * 64 + fr, col0 = cb + wc * 32 + 8 * fq;
#pragma unroll
        for (int ai = 0; ai < 2; ++ai)
#pragma unroll
            for (int m = 0; m < 4; ++m) {
                const int j = row0 + ai * 128 + m * 16;
                bf16* rowp = base + (size_t)j * D + col0;
                const bool tl = dqkv && (j & 63) >= 61;
#pragma unroll
                for (int bj = 0; bj < 2; ++bj) {
                    const f32x4 v0 = acc[ai][bj][m][0], v1 = acc[ai][bj][m][1];
                    const u32x4 w = {pk2(v0[0], v0[1]), pk2(v0[2], v0[3]), pk2(v1[0], v1[1]), pk2(v1[2], v1[3])};
                    *(u32x4*)(rowp + bj * 128) = w;
                    if (tl) *(u32x4*)(tails + ((size_t)(j / 64 + 1) * 3 + ((j & 63) - 61)) * 3072 + col0 + bj * 128) = w;
                }
            }
    }
};
DI void phase1(const Params& p, char* smem, int bid, int nblk) {
    for (int it = bid; it < 40; it += nblk) gemm_inproj_tile(p, smem, G_MT - 1, 8 + it);
    pg8::Gemm g{(const bf16*)(p.ws + OFF_U), (const bf16*)(p.ws + OFF_WTIN), SEQ, 7168, 1024};
    pg8::StaticOrder S; S.init(SEQ, 7168, nblk, bid);
    EpiInproj E{p.ws, (bf16*)p.out};
    pg8::gemm_phase(smem, g, S, E);
}

constexpr int P2_KN = 0, P2_KB = 16384, P2_QN = 32768, P2_KBGT = 49152, P2_VBT = 65536, P2_KDT = 81920, P2_ALDS = 98304, P2_TLDS = P2_ALDS + 64 * 64 * 4,
              P2_GC = P2_TLDS + 8192, P2_BET = P2_GC + 256, P2_EG = P2_BET + 256, P2_EKD = P2_EG + 256;

DI void prep_item(const Params& p, char* smem, int chunk, int head, int dry) {
    const int tid = fresh_tid(), lane = tid & 63, wave = tid >> 6, r32 = lane & 31, h = lane >> 5;
    unsigned char* ws = p.ws;
    float* gcl = (float*)(smem + P2_GC); float* betl = (float*)(smem + P2_BET); float* egl = (float*)(smem + P2_EG); float* ekdl = (float*)(smem + P2_EKD);
    if (wave == 0) {
        const size_t pos = (size_t)chunk * 64 + lane;
        float v = ((const float*)(ws + OFF_SMALL + SM_G))[pos * 8 + head];
        const float b = ((const float*)(ws + OFF_SMALL + SM_BETA))[pos * 8 + head];
#pragma unroll
        for (int o = 1; o < 64; o <<= 1) { const float t = __shfl_up(v, o); if (lane >= o) v += t; }
        const float gl = __shfl(v, 63);
        gcl[lane] = v; betl[lane] = b; egl[lane] = __expf(v); ekdl[lane] = __expf(gl - v);
        if (!dry) ((float*)(ws + OFF_SMALL + SM_GC))[((size_t)chunk * 8 + head) * 64 + lane] = v;
    }
    __syncthreads();
    {
        const int r = tid >> 3, cg = tid & 7, col0 = head * 128 + 16 * cg;
        const bool zero_row = (chunk == 0 && r < 48);
        const float beta = betl[r], eg = egl[r], ekd = ekdl[r];
        const bf16* tails = (const bf16*)(ws + OFF_SMALL + SM_TAILS);
#pragma unroll 1
        for (int mat = 0; mat < 3; ++mat) {
            bf16* mainb = (bf16*)(ws + (mat == 0 ? OFF_QN : (mat == 1 ? OFF_KN : OFF_V)));
            bf16* c0b = (bf16*)(ws + OFF_SMALL + (mat == 0 ? SM_C0Q : (mat == 1 ? SM_C0K : SM_C0V)));
            float y[16];
#pragma unroll
            for (int c = 0; c < 16; ++c) y[c] = 0.f;
#pragma unroll
            for (int jj = 0; jj < 4; ++jj) {
                const int rr = r - 3 + jj;
                const bf16* src = nullptr;
                if (chunk == 0) { if (rr >= 48) src = c0b + (size_t)rr * D + col0; }
                else if (rr >= 0) src = mainb + ((size_t)(chunk - 1) * 64 + rr) * D + col0;
                else src = tails + ((size_t)(chunk - 1) * 3 + (3 + rr)) * 3072 + mat * 1024 + col0;
                u32x4 a = {0u, 0u, 0u, 0u}, b = {0u, 0u, 0u, 0u};
                if (src) { a = *(const u32x4*)src; b = *(const u32x4*)(src + 8); }
                const float* cw = p.in[9] + (size_t)jj * 3072 + mat * 1024 + col0;
                const f32x4 w0 = *(const f32x4*)cw, w1 = *(const f32x4*)(cw + 4), w2 = *(const f32x4*)(cw + 8), w3 = *(const f32x4*)(cw + 12);
                y[0] += w0[0] * bflo(a.x); y[1] += w0[1] * bfhi(a.x); y[2] += w0[2] * bflo(a.y); y[3] += w0[3] * bfhi(a.y);
                y[4] += w1[0] * bflo(a.z); y[5] += w1[1] * bfhi(a.z); y[6] += w1[2] * bflo(a.w); y[7] += w1[3] * bfhi(a.w);
                y[8] += w2[0] * bflo(b.x); y[9] += w2[1] * bfhi(b.x); y[10] += w2[2] * bflo(b.y); y[11] += w2[3] * bfhi(b.y);
                y[12] += w3[0] * bflo(b.z); y[13] += w3[1] * bfhi(b.z); y[14] += w3[2] * bflo(b.w); y[15] += w3[3] * bfhi(b.w);
            }
            if (mat == 0) __syncthreads();
            float ss = 0.f;
#pragma unroll
            for (int c = 0; c < 16; ++c) { y[c] = zero_row ? 0.f : siluf_(y[c]); ss += y[c] * y[c]; }
            if (mat < 2) {
                ss += __shfl_xor(ss, 1); ss += __shfl_xor(ss, 2); ss += __shfl_xor(ss, 4);
                const float sc = rsqrtf(ss + 1e-6f) * (mat == 0 ? 0.08838834764831845f : 1.0f);
                unsigned pk[8];
#pragma unroll
                for (int c = 0; c < 8; ++c) pk[c] = pk2(y[2 * c] * sc, y[2 * c + 1] * sc);
                if (mat == 0) {
                    *(u32x4*)(smem + P2_QN + swzrow(r, 256, 2 * cg)) = (u32x4){pk[0], pk[1], pk[2], pk[3]};
                    *(u32x4*)(smem + P2_QN + swzrow(r, 256, 2 * cg + 1)) = (u32x4){pk[4], pk[5], pk[6], pk[7]};
                    unsigned qd[8];
#pragma unroll
                    for (int c = 0; c < 8; ++c) qd[c] = pk2(bflo(pk[c]) * eg, bfhi(pk[c]) * eg);
                    bf16* dst = (chunk == 0) ? c0b + (size_t)r * D + col0 : mainb + ((size_t)(chunk - 1) * 64 + r) * D + col0;
                    if (!dry) { *(u32x4*)dst = (u32x4){qd[0], qd[1], qd[2], qd[3]}; *(u32x4*)(dst + 8) = (u32x4){qd[4], qd[5], qd[6], qd[7]}; }
                } else {
                    *(u32x4*)(smem + P2_KN + swzrow(r, 256, 2 * cg)) = (u32x4){pk[0], pk[1], pk[2], pk[3]};
                    *(u32x4*)(smem + P2_KN + swzrow(r, 256, 2 * cg + 1)) = (u32x4){pk[4], pk[5], pk[6], pk[7]};
                    unsigned kb[8];
#pragma unroll
                    for (int c = 0; c < 8; ++c) {
                        const float kr0 = bflo(pk[c]), kr1 = bfhi(pk[c]);
                        const float k0 = kr0 * beta, k1 = kr1 * beta;
                        kb[c] = pk2(k0, k1);
                        const int d0 = 16 * cg + 2 * c;
                        *(bf16*)(smem + P2_KBGT + swz128t(d0, r >> 3) + (r & 7) * 2) = (bf16)f2bf(k0 * eg);
                        *(bf16*)(smem + P2_KBGT + swz128t(d0 + 1, r >> 3) + (r & 7) * 2) = (bf16)f2bf(k1 * eg);
                        *(bf16*)(smem + P2_KDT + swz128t(d0, r >> 3) + (r & 7) * 2) = (bf16)f2bf(kr0 * ekd);
                        *(bf16*)(smem + P2_KDT + swz128t(d0 + 1, r >> 3) + (r & 7) * 2) = (bf16)f2bf(kr1 * ekd);
                    }
                    *(u32x4*)(smem + P2_KB + swzrow(r, 256, 2 * cg)) = (u32x4){kb[0], kb[1], kb[2], kb[3]};
                    *(u32x4*)(smem + P2_KB + swzrow(r, 256, 2 * cg + 1)) = (u32x4){kb[4], kb[5], kb[6], kb[7]};
                }
            } else {
#pragma unroll
                for (int c = 0; c < 16; ++c) {
                    const int e = 16 * cg + c;
                    *(bf16*)(smem + P2_VBT + swz128t(e, r >> 3) + (r & 7) * 2) = (bf16)f2bf(y[c] * beta);
                }
            }
        }
    }
    __syncthreads();
    {
        const int tile = wave & 3, m0 = tile >> 1, n0 = tile & 1;
        f32x16 acc = zero16();
        if (wave < 4) {
            if (n0 <= m0) {
#pragma unroll
                for (int ks = 0; ks < 8; ++ks) {
                    const bf16x8 a = *(const bf16x8*)(smem + P2_KB + swzrow(32 * m0 + r32, 256, 2 * ks + h));
                    const bf16x8 b = *(const bf16x8*)(smem + P2_KN + swzrow(32 * n0 + r32, 256, 2 * ks + h));
                    acc = MFMA32(a, b, acc);
                }
            }
            float* Al = (float*)(smem + P2_ALDS);
            const int j = 32 * n0 + r32; const float gj = gcl[j];
#pragma unroll
            for (int r = 0; r < 16; ++r) {
                const int i = 32 * m0 + (r & 3) + 8 * (r >> 2) + 4 * h;
                const float dv = acc[r] * __expf(gcl[i] - gj);
                Al[i * 64 + (j & 3) * 16 + (j >> 2)] = (j < i) ? dv : 0.f;
            }
        } else {
            if (m0 <= n0) {
#pragma unroll
                for (int ks = 0; ks < 8; ++ks) {
                    const bf16x8 a = *(const bf16x8*)(smem + P2_KN + swzrow(32 * m0 + r32, 256, 2 * ks + h));
                    const bf16x8 b = *(const bf16x8*)(smem + P2_QN + swzrow(32 * n0 + r32, 256, 2 * ks + h));
                    acc = MFMA32(a, b, acc);
                }
            }
            const int i = 32 * n0 + r32; const float gi = gcl[i];
            bf16* qkb = (chunk == 0) ? (bf16*)(ws + OFF_SMALL + SM_C0QK) + (size_t)head * 4096 : (bf16*)(ws + OFF_QKB) + ((size_t)(chunk - 1) * 8 + head) * 4096;
#pragma unroll
            for (int q4 = 0; q4 < 4; ++q4) {
                const int j0 = 32 * m0 + 8 * q4 + 4 * h; float v[4];
#pragma unroll
                for (int c = 0; c < 4; ++c) { const int j = j0 + c; const float dv = acc[4 * q4 + c] * __expf(gi - gcl[j]); v[c] = (j <= i) ? dv : 0.f; }
                if (!dry) *(u32x2*)(qkb + i * 64 + j0) = (u32x2){pk2(v[0], v[1]), pk2(v[2], v[3])};
            }
        }
        bf16* kbase = (chunk == 0) ? (bf16*)(ws + OFF_SMALL + SM_C0K) : (bf16*)(ws + OFF_KN) + (size_t)(chunk - 1) * 64 * D;
#pragma unroll
        for (int i2 = 0; i2 < 2; ++i2) {
            const int idx = tid + NT * i2, dk = idx >> 3, ch = idx & 7;
            const u32x4 v = *(const u32x4*)(smem + P2_KDT + swz128t(dk, ch));
            if (!dry) *(u32x4*)(kbase + (size_t)(dk >> 1) * D + head * 128 + (dk & 1) * 64 + ch * 8) = v;
        }
    }
    __syncthreads();
    if (wave < 4) {
        const float* Al = (const float*)(smem + P2_ALDS);
        const int c = lane >> 2, q = lane & 3, C = 16 * wave + c;
        float tq[16];
#pragma unroll
        for (int m = 0; m < 16; ++m) tq[m] = 0.f;
#pragma unroll
        for (int i = 0; i < 64; ++i) {
            constexpr int dummy = 0; (void)dummy;
            const int nm = (i + 3) >> 2;
            float s0 = 0.f, s1 = 0.f;
            const float* ar = Al + i * 64 + q * 16;
#pragma unroll
            for (int m = 0; m < 16; ++m) if (m < nm) { if (m & 1) s1 += ar[m] * tq[m]; else s0 += ar[m] * tq[m]; }
            float s = s0 + s1;
            s += __shfl_xor(s, 1); s += __shfl_xor(s, 2);
            const float ti = ((i == C) ? 1.f : 0.f) - s;
            if (q == (i & 3)) tq[i >> 2] = ti;
        }
#pragma unroll
        for (int m = 0; m < 16; ++m) { const int row = 4 * m + q; *(bf16*)(smem + P2_TLDS + swz128(row, C >> 3) + (C & 7) * 2) = (bf16)f2bf(tq[m]); }
    }
    __syncthreads();
    {
        const int mi = wave >> 2, ni = wave & 3;
        f32x16 acc = zero16();
#pragma unroll
        for (int ks = 0; ks < 4; ++ks) {
            const bf16x8 a = *(const bf16x8*)(smem + P2_TLDS + swz128(32 * mi + r32, 2 * ks + h));
            const bf16x8 b = *(const bf16x8*)(smem + P2_VBT + swz128t(32 * ni + r32, 2 * ks + h));
            acc = MFMA32(a, b, acc);
        }
        const int e = 32 * ni + r32;
        bf16* base = (chunk == 0) ? (bf16*)(ws + OFF_SMALL + SM_C0V) : (bf16*)(ws + OFF_V) + (size_t)(chunk - 1) * 64 * D;
        bf16* dst = base + (size_t)(e >> 1) * D + head * 128 + (e & 1) * 64;
#pragma unroll
        for (int q4 = 0; q4 < 4; ++q4) {
            const int c0 = 32 * mi + 8 * q4 + 4 * h;
            if (!dry) *(u32x2*)(dst + c0) = (u32x2){pk2(acc[4 * q4], acc[4 * q4 + 1]), pk2(acc[4 * q4 + 2], acc[4 * q4 + 3])};
        }
    }
    {
        const int mi = wave >> 1, ni = wave & 1;
        f32x16 acc = zero16();
#pragma unroll
        for (int ks = 0; ks < 4; ++ks) {
            const bf16x8 a = *(const bf16x8*)(smem + P2_KBGT + swz128t(32 * mi + r32, 2 * ks + h));
            const bf16x8 b = *(const bf16x8*)(smem + P2_TLDS + swz128(32 * ni + r32, 2 * ks + h));
            acc = MFMA32(a, b, acc);
        }
        const int c = 32 * ni + r32;
        bf16* wb = (chunk == 0) ? (bf16*)(ws + OFF_SMALL + SM_C0W) + (size_t)head * 8192 : (bf16*)(ws + OFF_W) + ((size_t)(chunk - 1) * 8 + head) * 8192;
#pragma unroll
        for (int q4 = 0; q4 < 4; ++q4) {
            const int dk0 = 32 * mi + 8 * q4 + 4 * h;
            if (!dry) *(u32x2*)(wb + c * 128 + dk0) = (u32x2){pk2(acc[4 * q4], acc[4 * q4 + 1]), pk2(acc[4 * q4 + 2], acc[4 * q4 + 3])};
        }
    }
    __syncthreads();
}

DI void phase2(const Params& p, char* smem, int bid, int nblk, int dry = 0) {
    for (int it = bid; it < NCH * 8; it += nblk) prep_item(p, smem, it >> 3, it & 7, dry);
    {
        const int tid = fresh_tid(), lane = tid & 63, wave = tid >> 6;
        const int gw = bid * 8 + wave, NGW = nblk * 8;
        float mq = 0.f, mk = 0.f;
        for (int j = gw; j < SEQ + NMETA; j += NGW) {
            const bf16* kr = j < SEQ ? (const bf16*)p.out + (size_t)j * D + lane * 16 : (const bf16*)(p.ws + OFF_SMALL + SM_AKMETA) + (size_t)(j - SEQ) * D + lane * 16;
            const u32x4 a = *(const u32x4*)kr, b = *(const u32x4*)(kr + 8);
            float s = bflo(a.x) * bflo(a.x) + bfhi(a.x) * bfhi(a.x) + bflo(a.y) * bflo(a.y) + bfhi(a.y) * bfhi(a.y) + bflo(a.z) * bflo(a.z) + bfhi(a.z) * bfhi(a.z) + bflo(a.w) * bflo(a.w) + bfhi(a.w) * bfhi(a.w)
                    + bflo(b.x) * bflo(b.x) + bfhi(b.x) * bfhi(b.x) + bflo(b.y) * bflo(b.y) + bfhi(b.y) * bfhi(b.y) + bflo(b.z) * bflo(b.z) + bfhi(b.z) * bfhi(b.z) + bflo(b.w) * bflo(b.w) + bfhi(b.w) * bfhi(b.w);
            s += __shfl_xor(s, 1); s += __shfl_xor(s, 2);
            mk = fmaxf(mk, s);
            if (j < SEQ) {
                const bf16* qr = (const bf16*)(p.ws + OFF_AQ) + (size_t)j * D + lane * 16;
                const u32x4 c = *(const u32x4*)qr, d = *(const u32x4*)(qr + 8);
                float t = bflo(c.x) * bflo(c.x) + bfhi(c.x) * bfhi(c.x) + bflo(c.y) * bflo(c.y) + bfhi(c.y) * bfhi(c.y) + bflo(c.z) * bflo(c.z) + bfhi(c.z) * bfhi(c.z) + bflo(c.w) * bflo(c.w) + bfhi(c.w) * bfhi(c.w)
                        + bflo(d.x) * bflo(d.x) + bfhi(d.x) * bfhi(d.x) + bflo(d.y) * bflo(d.y) + bfhi(d.y) * bfhi(d.y) + bflo(d.z) * bflo(d.z) + bfhi(d.z) * bfhi(d.z) + bflo(d.w) * bflo(d.w) + bfhi(d.w) * bfhi(d.w);
                t += __shfl_xor(t, 1); t += __shfl_xor(t, 2);
                mq = fmaxf(mq, t);
            }
        }
        if ((lane & 3) == 0) {
            unsigned* nrm = (unsigned*)(p.ws + OFF_SMALL + SM_CTL) + CW_NRM;
            atomicMax(nrm + (lane >> 2), __builtin_bit_cast(unsigned, mq));
            atomicMax(nrm + 16 + (lane >> 2), __builtin_bit_cast(unsigned, mk));
        }
    }
}

DI int swzrow8(int row, int pitch, int s) { return row * pitch + ((((s >> 1) ^ (row & 15)) << 4) | ((s & 1) << 3)); }
DI bf16x8 pack8(f32x4 a, f32x4 b) {
    u32x4 o; o.x = pk2(a[0], a[1]); o.y = pk2(a[2], a[3]); o.z = pk2(b[0], b[1]); o.w = pk2(b[2], b[3]);
    return __builtin_bit_cast(bf16x8, o);
}
DI bf16x8 ld2x8(const char* p0, const char* p1) {
    const u32x2 a = *(const u32x2*)p0, b = *(const u32x2*)p1; u32x4 o; o.x = a.x; o.y = a.y; o.z = b.x; o.w = b.y;
    return __builtin_bit_cast(bf16x8, o);
}
constexpr int SC_W = 0, SC_QD = 16384, SC_KDT = 32768, SC_QK = 49152, SC_BUF = 57344;

constexpr int SCAN_SPLIT = 4;
DI void scan_head(const Params& p, char* smem, int head, int sidx, int dry) {
    const int tid = fresh_tid(), lane = tid & 63, wave = tid >> 6, r16 = lane & 15, g = lane >> 4;
    const bool active = wave < 8 / SCAN_SPLIT; const int slice = sidx * (8 / SCAN_SPLIT) + (active ? wave : 0);
    unsigned char* ws = p.ws;
    const int lrow = tid >> 3, lch = (tid & 7) * 2;
    f32x4 S[8];
#pragma unroll
    for (int i = 0; i < 8; ++i) S[i] = zero4();
    u32x4 rw[2], rq[2], rk[2], rqk; u32x2 unext[4], ucur[4]; float gnext = 0.f, gcur = 0.f;
    auto uaddr = [&](int n, int mt) -> bf16* {
        const int e = 16 * slice + r16;
        bf16* base = n == 0 ? (bf16*)(ws + OFF_SMALL + SM_C0V) : (bf16*)(ws + OFF_V) + (size_t)(n - 1) * 64 * D;
        return base + (size_t)(e >> 1) * D + head * 128 + (e & 1) * 64 + 16 * mt + 4 * g;
    };
    auto gloadA = [&](int n) {
        const bf16* wsrc = (n == 0 ? (const bf16*)(ws + OFF_SMALL + SM_C0W) + (size_t)head * 8192 : (const bf16*)(ws + OFF_W) + ((size_t)(n - 1) * 8 + head) * 8192) + lrow * 128 + lch * 8;
        rw[0] = *(const u32x4*)wsrc; rw[1] = *(const u32x4*)(wsrc + 8);
        const bf16* qs = (n == 0 ? (const bf16*)(ws + OFF_SMALL + SM_C0Q) : (const bf16*)(ws + OFF_QN) + (size_t)(n - 1) * 64 * D) + (size_t)lrow * D + head * 128 + lch * 8;
        rq[0] = *(const u32x4*)qs; rq[1] = *(const u32x4*)(qs + 8);
        const bf16* ks = (n == 0 ? (const bf16*)(ws + OFF_SMALL + SM_C0K) : (const bf16*)(ws + OFF_KN) + (size_t)(n - 1) * 64 * D) + (size_t)lrow * D + head * 128 + lch * 8;
        rk[0] = *(const u32x4*)ks; rk[1] = *(const u32x4*)(ks + 8);
        const bf16* qk = (n == 0 ? (const bf16*)(ws + OFF_SMALL + SM_C0QK) + (size_t)head * 4096 : (const bf16*)(ws + OFF_QKB) + ((size_t)(n - 1) * 8 + head) * 4096) + tid * 8;
        rqk = *(const u32x4*)qk;
    };
    auto gloadU = [&](int n) {
#pragma unroll
        for (int mt = 0; mt < 4; ++mt) unext[mt] = *(const u32x2*)uaddr(n, mt);
        gnext = ((const float*)(ws + OFF_SMALL + SM_GC))[((size_t)n * 8 + head) * 64 + 63];
    };
    auto lwrite = [&](int buf) {
        char* b = smem + buf * SC_BUF;
        const int c7 = tid & 7, kb = c7 >> 1, hf = c7 & 1;
        {
            char* w = b + SC_W + lrow * 256 + hf * 8; char* q = b + SC_QD + lrow * 256 + hf * 8; const int x = lrow & 15;
            *(u32x2*)(w + (((4 * kb + 0) ^ x) << 4)) = (u32x2){rw[0].x, rw[0].y}; *(u32x2*)(w + (((4 * kb + 1) ^ x) << 4)) = (u32x2){rw[0].z, rw[0].w};
            *(u32x2*)(w + (((4 * kb + 2) ^ x) << 4)) = (u32x2){rw[1].x, rw[1].y}; *(u32x2*)(w + (((4 * kb + 3) ^ x) << 4)) = (u32x2){rw[1].z, rw[1].w};
            *(u32x2*)(q + (((4 * kb + 0) ^ x) << 4)) = (u32x2){rq[0].x, rq[0].y}; *(u32x2*)(q + (((4 * kb + 1) ^ x) << 4)) = (u32x2){rq[0].z, rq[0].w};
            *(u32x2*)(q + (((4 * kb + 2) ^ x) << 4)) = (u32x2){rq[1].x, rq[1].y}; *(u32x2*)(q + (((4 * kb + 3) ^ x) << 4)) = (u32x2){rq[1].z, rq[1].w};
        }
        {
            const int dk = 2 * lrow + (c7 >> 2), kb2 = (c7 & 3) >> 1, x = (dk >> 1) & 7;
            char* kt = b + SC_KDT + dk * 128 + hf * 8;
            *(u32x2*)(kt + (((4 * kb2 + 0) ^ x) << 4)) = (u32x2){rk[0].x, rk[0].y}; *(u32x2*)(kt + (((4 * kb2 + 1) ^ x) << 4)) = (u32x2){rk[0].z, rk[0].w};
            *(u32x2*)(kt + (((4 * kb2 + 2) ^ x) << 4)) = (u32x2){rk[1].x, rk[1].y}; *(u32x2*)(kt + (((4 * kb2 + 3) ^ x) << 4)) = (u32x2){rk[1].z, rk[1].w};
        }
        {
            const int row = tid >> 3, kb2 = c7 >> 2, g0 = 2 * (c7 & 1), hf2 = (c7 >> 1) & 1, x = (row >> 1) & 7;
            char* qk = b + SC_QK + row * 128 + hf2 * 8;
            *(u32x2*)(qk + (((4 * kb2 + g0) ^ x) << 4)) = (u32x2){rqk.x, rqk.y}; *(u32x2*)(qk + (((4 * kb2 + g0 + 1) ^ x) << 4)) = (u32x2){rqk.z, rqk.w};
        }
    };
    gloadA(0); gloadU(0);
    lwrite(0);
#pragma unroll
    for (int mt = 0; mt < 4; ++mt) ucur[mt] = unext[mt];
    gcur = gnext;
    if (NCH > 1) gloadA(1);
    __syncthreads();
    for (int n = 0; n < NCH; ++n) {
        const char* b = smem + (n & 1) * SC_BUF;
        if (n + 1 < NCH) { lwrite((n + 1) & 1); gloadU(n + 1); }
        if (n + 2 < NCH) gloadA(n + 2);
        if (active) {
        const float gtot = __expf(gcur);
        bf16x8 sf[4];
#pragma unroll
        for (int kb = 0; kb < 4; ++kb) sf[kb] = pack8(S[2 * kb], S[2 * kb + 1]);
        f32x4 Vn[4], O[4];
#pragma unroll
        for (int mt = 0; mt < 4; ++mt) {
            f32x4 P = zero4(), Q = zero4();
            const int row = 16 * mt + r16;
#pragma unroll
            for (int kb = 0; kb < 4; ++kb) {
                const bf16x8 wf = *(const bf16x8*)(b + SC_W + swzrow(row, 256, 4 * kb + g));
                const bf16x8 qf = *(const bf16x8*)(b + SC_QD + swzrow(row, 256, 4 * kb + g));
                P = MFMA16(wf, sf[kb], P);
                Q = MFMA16(qf, sf[kb], Q);
            }
            const float u0 = bflo(ucur[mt].x), u1 = bfhi(ucur[mt].x), u2 = bflo(ucur[mt].y), u3 = bfhi(ucur[mt].y);
            Vn[mt] = (f32x4){u0 - P[0], u1 - P[1], u2 - P[2], u3 - P[3]};
            O[mt] = Q;
        }
        const bf16x8 vf[2] = {pack8(Vn[0], Vn[1]), pack8(Vn[2], Vn[3])};
#pragma unroll
        for (int mt = 0; mt < 8; ++mt) {
            const int row = 16 * mt + r16;
            f32x4 acc = S[mt] * gtot;
#pragma unroll
            for (int kb = 0; kb < 2; ++kb) {
                const bf16x8 kf = *(const bf16x8*)(b + SC_KDT + swz128(row, 4 * kb + g));
                acc = MFMA16(kf, vf[kb], acc);
            }
            S[mt] = acc;
        }
#pragma unroll
        for (int mt = 0; mt < 4; ++mt) {
            const int row = 16 * mt + r16;
#pragma unroll
            for (int kb = 0; kb < 2; ++kb) {
                const bf16x8 qk = *(const bf16x8*)(b + SC_QK + swz128(row, 4 * kb + g));
                O[mt] = MFMA16(qk, vf[kb], O[mt]);
            }
            if (n >= 1 && !dry) *(u32x2*)uaddr(n, mt) = (u32x2){pk2(O[mt][0], O[mt][1]), pk2(O[mt][2], O[mt][3])};
        }
        }
#pragma unroll
        for (int mt = 0; mt < 4; ++mt) ucur[mt] = unext[mt];
        gcur = gnext;
        __syncthreads();
    }
}

constexpr int AT_BUF = 32768, AT_MISC = 65536, NQB = SEQ / 128, AT_UNITS = 8 * NQB;
DI int vt_off8(int e, int s) { return e * 128 + ((s ^ ((e >> 1) & 15)) << 3); }

DI void attention_unit(const Params& p, char* smem, int head, int qb, float lam, int dry, float bound) {
    const int tid = fresh_tid(), lane = tid & 63, wave = tid >> 6, r32 = lane & 31, h = lane >> 5;
    const int wq = wave & 3, mp = wave >> 2;
    unsigned char* ws = p.ws;
    const bf16* AK = (const bf16*)p.out; const bf16* AVT = (const bf16*)p.out + (size_t)SEQ * D;
    const int q0 = 128 * qb, qpos = q0 + 32 * wq + r32;
    const float c1 = 0.125f * LOG2E, c2 = exp2f(-(float)(head + 1)) * LOG2E;
    bf16x8 Qf[4];
    {
        const bf16* qsrc = (const bf16*)(ws + OFF_AQ) + (size_t)qpos * D + head * 128 + mp * 64 + 8 * h;
#pragma unroll
        for (int ks = 0; ks < 4; ++ks) {
            const u32x4 v = *(const u32x4*)(qsrc + 16 * ks); u32x4 o;
            o.x = pk2(bflo(v.x) * c1, bfhi(v.x) * c1); o.y = pk2(bflo(v.y) * c1, bfhi(v.y) * c1); o.z = pk2(bflo(v.z) * c1, bfhi(v.z) * c1); o.w = pk2(bflo(v.w) * c1, bfhi(v.w) * c1);
            Qf[ks] = __builtin_bit_cast(bf16x8, o);
        }
    }
    f32x16 O[4];
#pragma unroll
    for (int i = 0; i < 4; ++i) O[i] = zero16();
    float l_run = 0.f; const float mfix = fminf(bound, 40.0f);
    const float wdist = (150.0f + 2.0f * bound) / c2;
    int ntiles = 2 * qb + 3;
    {
        const float lim = (float)q0 - 63.0f - wdist;
        int ktmin = 0;
        if (lim > 0.f) ktmin = (int)(lim * (1.0f / 64.0f));
        const bool keep_meta = !((float)(q0 + NMETA - 15) > wdist);
        if (ktmin > 0 || !keep_meta) ntiles = (2 * qb + 1 - ktmin + 1) + (keep_meta ? 1 : 0);
    }
    const int nreal = (ntiles == 2 * qb + 3) ? 2 * qb + 2 : ntiles;
    const int kkey = tid >> 3, kcc = (tid & 7) * 2;
    const int va = tid >> 5, vb4 = tid & 31;
    u32x4 rk[2]; u32x2 rv[4];
    auto tile_kt = [&](int it) -> int { return it < nreal ? 2 * qb + 1 - it : -1; };
    auto gload = [&](int it) {
        const int kt = tile_kt(it);
        if (kt >= 0) {
            const bf16* ks = AK + ((size_t)kt * 64 + kkey) * D + head * 128 + kcc * 8;
            rk[0] = *(const u32x4*)ks; rk[1] = *(const u32x4*)(ks + 8);
            const bf16* vs = AVT + ((size_t)kt * 64 + 4 * va) * D + head * 128 + 4 * vb4;
#pragma unroll
            for (int i = 0; i < 4; ++i) rv[i] = *(const u32x2*)(vs + (size_t)i * D);
        } else {
            rk[0] = rk[1] = (u32x4){0u, 0u, 0u, 0u};
#pragma unroll
            for (int i = 0; i < 4; ++i) rv[i] = (u32x2){0u, 0u};
            if (kkey < NMETA) { const bf16* ks = (const bf16*)(ws + OFF_SMALL + SM_AKMETA) + (size_t)kkey * D + head * 128 + kcc * 8; rk[0] = *(const u32x4*)ks; rk[1] = *(const u32x4*)(ks + 8); }
            if (va < NMETA / 4) { const bf16* vs = (const bf16*)(ws + OFF_SMALL + SM_AVTMETA) + (size_t)(4 * va) * D + head * 128 + 4 * vb4;
#pragma unroll
                for (int i = 0; i < 4; ++i) rv[i] = *(const u32x2*)(vs + (size_t)i * D); }
        }
    };
    auto lwrite = [&](int buf) {
        char* kb = smem + buf * AT_BUF + (kcc >> 3) * 8192;
        *(u32x4*)(kb + swz128(kkey, kcc & 7)) = rk[0]; *(u32x4*)(kb + swz128(kkey, (kcc & 7) + 1)) = rk[1];
        const unsigned t0x = (rv[0].x & 0xffffu) | (rv[1].x << 16), t1x = (rv[0].x >> 16) | (rv[1].x & 0xffff0000u), t0y = (rv[2].x & 0xffffu) | (rv[3].x << 16), t1y = (rv[2].x >> 16) | (rv[3].x & 0xffff0000u);
        const unsigned t2x = (rv[0].y & 0xffffu) | (rv[1].y << 16), t3x = (rv[0].y >> 16) | (rv[1].y & 0xffff0000u), t2y = (rv[2].y & 0xffffu) | (rv[3].y << 16), t3y = (rv[2].y >> 16) | (rv[3].y & 0xffff0000u);
        const int sub = va >> 3, a = va & 7, a2 = (a & 4) | ((a & 1) << 1) | ((a >> 1) & 1);
        char* vbase = smem + buf * AT_BUF + 16384 + (a2 & 1) * 8;
        const int s16 = 4 * sub + (a2 >> 1), e0 = 4 * vb4;
        *(u32x2*)(vbase + (e0 + 0) * 128 + ((s16 ^ (((e0 + 0) >> 1) & 7)) << 4)) = (u32x2){t0x, t0y};
        *(u32x2*)(vbase + (e0 + 1) * 128 + ((s16 ^ (((e0 + 1) >> 1) & 7)) << 4)) = (u32x2){t1x, t1y};
        *(u32x2*)(vbase + (e0 + 2) * 128 + ((s16 ^ (((e0 + 2) >> 1) & 7)) << 4)) = (u32x2){t2x, t2y};
        *(u32x2*)(vbase + (e0 + 3) * 128 + ((s16 ^ (((e0 + 3) >> 1) & 7)) << 4)) = (u32x2){t3x, t3y};
    };
    auto tile_body = [&](auto mode_tag, int buf, int kdist0, int klim) {
        constexpr bool MASKED = decltype(mode_tag)::value;
        const char* kb = smem + buf * AT_BUF + mp * 8192;
        const char* vb = smem + buf * AT_BUF + 16384;
        f32x16 s[2];
#pragma unroll
        for (int sub = 0; sub < 2; ++sub) {
            f32x16 acc;
            const float base = -c2 * (float)(kdist0 - 32 * sub - 4 * h) - mfix;
#pragma unroll
            for (int r = 0; r < 16; ++r) acc[r] = base + c2 * (float)((r & 3) + 8 * (r >> 2));
#pragma unroll
            for (int ks = 0; ks < 4; ++ks) {
                const bf16x8 a = *(const bf16x8*)(kb + swz128(32 * sub + r32, 2 * ks + h));
                acc = MFMA32(a, Qf[ks], acc);
            }
            if (MASKED) {
#pragma unroll
                for (int r = 0; r < 16; ++r) { const int key = 32 * sub + (r & 3) + 8 * (r >> 2) + 4 * h; if (key > klim) acc[r] = -1e30f; }
            }
            s[sub] = acc;
        }
        float ls = 0.f;
#pragma unroll
        for (int sub = 0; sub < 2; ++sub) {
#pragma unroll
            for (int r = 0; r < 16; ++r) { const float pv = EXP2F(s[sub][r]); s[sub][r] = pv; ls += pv; }
            bf16x8 Pf[2];
#pragma unroll
            for (int ss = 0; ss < 2; ++ss) {
                u32x4 o; o.x = pk2(s[sub][8 * ss], s[sub][8 * ss + 1]); o.y = pk2(s[sub][8 * ss + 2], s[sub][8 * ss + 3]);
                o.z = pk2(s[sub][8 * ss + 4], s[sub][8 * ss + 5]); o.w = pk2(s[sub][8 * ss + 6], s[sub][8 * ss + 7]);
                Pf[ss] = __builtin_bit_cast(bf16x8, o);
            }
#pragma unroll
            for (int et = 0; et < 4; ++et) {
                const int e = 32 * et + r32;
#pragma unroll
                for (int ss = 0; ss < 2; ++ss) {
                    const bf16x8 a = *(const bf16x8*)(vb + swz128(e, 4 * sub + 2 * ss + h));
                    O[et] = MFMA32(a, Pf[ss], O[et]);
                }
            }
            SCHED_FENCE();
        }
        l_run += ls;
    };
    gload(0); lwrite(0); __syncthreads();
    for (int it = 0; it < ntiles; ++it) {
        const int buf = it & 1, kt = tile_kt(it);
        if (it + 1 < ntiles) gload(it + 1);
        const int k0 = kt * 64;
        if (kt >= 0 && k0 > q0 + 32 * wq + 31) {   }
        else if (kt >= 0 && k0 + 63 <= q0 + 32 * wq) tile_body(std::false_type{}, buf, qpos - k0, 0);
        else tile_body(std::true_type{}, buf, kt < 0 ? NMETA + qpos : qpos - k0, kt < 0 ? NMETA - 1 : qpos - k0);
        if (it + 1 < ntiles) lwrite(buf ^ 1);
        __syncthreads();
    }
    {
        const int tid = fresh_tid(), lane = tid & 63, wave = tid >> 6, r32 = lane & 31, h = lane >> 5, wq = wave & 3, mp = wave >> 2;
        const int qpos = 128 * qb + 32 * wq + r32;
        const float lt = l_run + xhalf(l_run);
        const float inv = 1.0f / lt;
        float* X = (float*)smem;
        if (mp == 1) {
#pragma unroll
            for (int et = 0; et < 4; ++et)
#pragma unroll
                for (int r = 0; r < 16; ++r) { const int e = 32 * et + (r & 3) + 8 * (r >> 2) + 4 * h; X[(wq * 128 + e) * 32 + r32] = O[et][r] * inv; }
        }
        __syncthreads();
        if (mp == 0) {
            float ssq = 0.f;
#pragma unroll
            for (int et = 0; et < 4; ++et)
#pragma unroll
                for (int r = 0; r < 16; ++r) { const int e = 32 * et + (r & 3) + 8 * (r >> 2) + 4 * h; const float d = O[et][r] * inv - lam * X[(wq * 128 + e) * 32 + r32]; O[et][r] = d; ssq += d * d; }
            ssq += xhalf(ssq);
            const float rstd = rsqrtf(ssq * (1.0f / 128.0f) + NORM_EPS) * 0.8f;
            bf16* dst = (bf16*)(ws + OFF_AQ) + (size_t)qpos * D + head * 128;
            const float* sw = p.in[8];
#pragma unroll
            for (int et = 0; et < 4; ++et)
#pragma unroll
                for (int q4 = 0; q4 < 4; ++q4) {
                    const int e0 = 32 * et + 8 * q4 + 4 * h;
                    const f32x4 w4 = *(const f32x4*)(sw + e0);
                    if (!dry) *(u32x2*)(dst + e0) = (u32x2){pk2(O[et][4 * q4] * rstd * w4[0], O[et][4 * q4 + 1] * rstd * w4[1]), pk2(O[et][4 * q4 + 2] * rstd * w4[2], O[et][4 * q4 + 3] * rstd * w4[3])};
                }
        }
        __syncthreads();
    }
}

DI void phase3(const Params& p, char* smem, int bid, int nblk, int dry = 0, int mode = 3) {
    if (mode & 1) for (int it = bid; it < 8 * SCAN_SPLIT; it += nblk) scan_head(p, smem, it / SCAN_SPLIT, it % SCAN_SPLIT, dry);
    if (!(mode & 2)) return;
    float d1 = 0.f, d2 = 0.f;
    for (int i = 0; i < 64; ++i) { d1 += p.in[4][i] * p.in[5][i]; d2 += p.in[6][i] * p.in[7][i]; }
    const float lam = __expf(d1) - __expf(d2) + 0.2f;
    unsigned* q = (unsigned*)(p.ws + OFF_SMALL + SM_CTL) + CW_ATTQ + (dry ? 16 : 0);
    for (;;) {
        if (threadIdx.x == 0) *(unsigned*)(smem + AT_MISC) = atomicAdd(q, 1u);
        __syncthreads();
        const unsigned u = *(unsigned*)(smem + AT_MISC);
        __syncthreads();
        if (u >= (unsigned)AT_UNITS) break;
        const int hd = (int)(u & 7u);
        const unsigned* nrm = (const unsigned*)(p.ws + OFF_SMALL + SM_CTL) + CW_NRM;
        float bnd = 0.f;
        for (int m2 = 0; m2 < 2; ++m2) {
            const float q2 = __builtin_bit_cast(float, LD_ATOMIC(nrm + 2 * hd + m2)), k2 = __builtin_bit_cast(float, LD_ATOMIC(nrm + 16 + 2 * hd + m2));
            bnd = fmaxf(bnd, sqrtf(q2 * k2) * (0.125f * LOG2E) * 1.02f);
        }
        attention_unit(p, smem, hd, NQB - 1 - (int)(u >> 3), lam, dry, bnd);
    }
}

DI void phase4(const Params& p, char* smem, int bid, int nblk) {
    const int tid = fresh_tid(), lane = tid & 63, wave = tid >> 6;
    const int gw = bid * 8 + wave, NGW = nblk * 8;
    unsigned char* ws = p.ws;
    char* wl = smem + wave * 16384;
    for (int it = gw; it < 32 * 384; it += NGW) {
        const int e = it / 384, r = it % 384, m = r >> 7, q = r & 127;
        if (m < 2) transpose_item(p.in[21 + m] + (size_t)e * 1024 * 256, 256, 1024, (bf16*)(ws + OFF_EXG) + (size_t)e * 512 * 1024, (q >> 3) * 64, (q & 7) * 32, (q & 7) * 32, (float*)wl, lane, m + 1);
        else transpose_item(p.in[23] + (size_t)e * 256 * 1024, 1024, 256, (bf16*)(ws + OFF_EXD) + (size_t)e * 1024 * 256, (q >> 5) * 64, (q & 31) * 32, (q & 31) * 32, (float*)wl, lane);
    }
    for (int R = gw; R < SEQ; R += NGW) {
        const float* xrow = p.in[0] + (size_t)R * D; bf16* urow = (bf16*)(ws + OFF_U) + (size_t)R * D;
        float4 v[4]; float ss = 0.f;
#pragma unroll
        for (int j = 0; j < 4; ++j) { v[j] = *(const float4*)(xrow + 4 * lane + 256 * j); ss += v[j].x * v[j].x + v[j].y * v[j].y + v[j].z * v[j].z + v[j].w * v[j].w; }
        ss = wave_sum(ss);
        const float rstd = rsqrtf(ss * (1.0f / D) + NORM_EPS);
#pragma unroll
        for (int j = 0; j < 4; ++j) {
            const float4 w4 = *(const float4*)(p.in[2] + 4 * lane + 256 * j);
            *(u32x2*)(urow + 4 * lane + 256 * j) = (u32x2){pk2(v[j].x * rstd * w4.x, v[j].y * rstd * w4.y), pk2(v[j].z * rstd * w4.z, v[j].w * rstd * w4.w)};
        }
    }
    for (int it = gw; it < (NCH - 1) * 8; it += NGW) {
        const int cm1 = it >> 3, head = it & 7;
        const bf16* reg = (const bf16*)(ws + OFF_V) + (size_t)cm1 * 64 * D + head * 128;
#pragma unroll 4
        for (int i = 0; i < 16; ++i) { const int row = i * 4 + (lane >> 4), ch = lane & 15; *(u32x4*)(wl + row * 256 + ch * 16) = *(const u32x4*)(reg + (size_t)row * D + ch * 8); }
        WAVE_SYNC();
        float ss = 0.f;
#pragma unroll 8
        for (int dv = 0; dv < 128; ++dv) { const float v = bf2f(*(const bf16*)(wl + (dv >> 1) * 256 + ((dv & 1) * 64 + lane) * 2)); ss += v * v; }
        const float rstd = rsqrtf(ss * (1.0f / 128.0f) + NORM_EPS);
        const size_t j = (size_t)cm1 * 64 + lane;
        const bf16* gsrc = (const bf16*)(ws + OFF_DG) + j * D + head * 128;
        bf16* dst = (bf16*)(ws + OFF_OD) + j * D + head * 128;
#pragma unroll 2
        for (int d8 = 0; d8 < 16; ++d8) {
            const u32x4 gv = *(const u32x4*)(gsrc + 8 * d8);
            const f32x4 w0 = *(const f32x4*)(p.in[12] + 8 * d8), w1 = *(const f32x4*)(p.in[12] + 8 * d8 + 4);
            float o[8];
#pragma unroll
            for (int c = 0; c < 8; ++c) { const int dv = 8 * d8 + c; o[c] = bf2f(*(const bf16*)(wl + (dv >> 1) * 256 + ((dv & 1) * 64 + lane) * 2)) * rstd; }
            o[0] *= w0[0] * siluf_(bflo(gv.x)); o[1] *= w0[1] * siluf_(bfhi(gv.x)); o[2] *= w0[2] * siluf_(bflo(gv.y)); o[3] *= w0[3] * siluf_(bfhi(gv.y));
            o[4] *= w1[0] * siluf_(bflo(gv.z)); o[5] *= w1[1] * siluf_(bfhi(gv.z)); o[6] *= w1[2] * siluf_(bflo(gv.w)); o[7] *= w1[3] * siluf_(bfhi(gv.w));
            *(u32x4*)(dst + 8 * d8) = (u32x4){pk2(o[0], o[1]), pk2(o[2], o[3]), pk2(o[4], o[5]), pk2(o[6], o[7])};
        }
        WAVE_SYNC();
    }
}

template <int NB, int NI>
DI void rowgemm64(const bf16* arow, const bf16* const (&bptr)[NB], char* stg, f32x16 (&acc)[NB][2][NI]) {
    const int tid = fresh_tid(), lane = tid & 63, r32 = lane & 31, h = lane >> 5;
    const int lrow = tid >> 3, lc = tid & 7;
    u32x4 ra = arow ? *(const u32x4*)arow : (u32x4){0u, 0u, 0u, 0u};
    bf16x8 bqA[4][NB][NI], bqB[4][NB][NI];
    auto bload = [&](bf16x8 (&dst)[4][NB][NI], int kc) {
#pragma unroll
        for (int ks = 0; ks < 4; ++ks)
#pragma unroll
            for (int b = 0; b < NB; ++b)
#pragma unroll
                for (int ni = 0; ni < NI; ++ni) dst[ks][b][ni] = *(const bf16x8*)(bptr[b] + (size_t)ni * 32 * 1024 + kc * 64 + ks * 16);
    };
    auto mma = [&](const bf16x8 (&bq)[4][NB][NI], int buf) {
#pragma unroll
        for (int ks = 0; ks < 4; ++ks) {
            bf16x8 af[2];
#pragma unroll
            for (int mi = 0; mi < 2; ++mi) af[mi] = *(const bf16x8*)(stg + buf * 8192 + swz128(32 * mi + r32, 2 * ks + h));
#pragma unroll
            for (int b = 0; b < NB; ++b)
#pragma unroll
                for (int ni = 0; ni < NI; ++ni)
#pragma unroll
                    for (int mi = 0; mi < 2; ++mi) acc[b][mi][ni] = MFMA32(af[mi], bq[ks][b][ni], acc[b][mi][ni]);
        }
    };
    bload(bqA, 0);
    *(u32x4*)(stg + swz128(lrow, lc)) = ra;
    __syncthreads();
    for (int kc = 0; kc < 16; kc += 2) {
        ra = arow ? *(const u32x4*)(arow + (kc + 1) * 64) : (u32x4){0u, 0u, 0u, 0u};
        bload(bqB, kc + 1);
        mma(bqA, 0);
        *(u32x4*)(stg + 8192 + swz128(lrow, lc)) = ra;
        __syncthreads();
        if (kc + 2 < 16) { ra = arow ? *(const u32x4*)(arow + (kc + 2) * 64) : (u32x4){0u, 0u, 0u, 0u}; bload(bqA, kc + 2); }
        mma(bqB, 1);
        if (kc + 2 < 16) *(u32x4*)(stg + swz128(lrow, lc)) = ra;
        __syncthreads();
    }
}

constexpr size_t OFF_MIX = OFF_V;
struct EpiSig {
    static constexpr bool PERM = true;
    bf16* sg;
    DM void operator()(const f32x4 (&acc)[2][2][4][2], const pg8::Unit& u, int wr, int wc, int fr, int fq) const {
        const int row0 = u.pm * 256 + wr * 64 + fr, col0 = u.pn * 256 + wc * 32 + 8 * fq;
#pragma unroll
        for (int ai = 0; ai < 2; ++ai)
#pragma unroll
            for (int m = 0; m < 4; ++m) {
                bf16* rowp = sg + (size_t)(row0 + ai * 128 + m * 16) * 2048 + col0;
#pragma unroll
                for (int bj = 0; bj < 2; ++bj) {
                    const f32x4 v0 = acc[ai][bj][m][0], v1 = acc[ai][bj][m][1];
                    *(u32x4*)(rowp + bj * 128) = (u32x4){pk2(sigmoidf_(v0[0]), sigmoidf_(v0[1])), pk2(sigmoidf_(v0[2]), sigmoidf_(v0[3])), pk2(sigmoidf_(v1[0]), sigmoidf_(v1[1])), pk2(sigmoidf_(v1[2]), sigmoidf_(v1[3]))};
                }
            }
    }
};
template <bool ADD> struct EpiGate {
    static constexpr bool PERM = true;
    const bf16* sg; bf16* mix; int goff;
    DM void operator()(const f32x4 (&acc)[2][2][4][2], const pg8::Unit& u, int wr, int wc, int fr, int fq) const {
        const int row0 = u.pm * 256 + wr * 64 + fr, col0 = u.pn * 256 + wc * 32 + 8 * fq;
#pragma unroll
        for (int ai = 0; ai < 2; ++ai)
#pragma unroll
            for (int m = 0; m < 4; ++m) {
                const size_t j = (size_t)(row0 + ai * 128 + m * 16);
#pragma unroll
                for (int bj = 0; bj < 2; ++bj) {
                    const u32x4 g = *(const u32x4*)(sg + j * 2048 + goff + col0 + bj * 128);
                    const f32x4 v0 = acc[ai][bj][m][0], v1 = acc[ai][bj][m][1];
                    float o[8] = {bflo(g.x) * v0[0], bfhi(g.x) * v0[1], bflo(g.y) * v0[2], bfhi(g.y) * v0[3], bflo(g.z) * v1[0], bfhi(g.z) * v1[1], bflo(g.w) * v1[2], bfhi(g.w) * v1[3]};
                    bf16* dst = mix + j * D + col0 + bj * 128;
                    if (ADD) { const u32x4 q = *(const u32x4*)dst; o[0] += bflo(q.x); o[1] += bfhi(q.x); o[2] += bflo(q.y); o[3] += bfhi(q.y); o[4] += bflo(q.z); o[5] += bfhi(q.z); o[6] += bflo(q.w); o[7] += bfhi(q.w); }
                    *(u32x4*)dst = (u32x4){pk2(o[0], o[1]), pk2(o[2], o[3]), pk2(o[4], o[5]), pk2(o[6], o[7])};
                }
            }
    }
};
struct EpiRes {
    static constexpr bool PERM = false;
    const float* x; float* hout;
    DM void operator()(const f32x4 (&acc)[2][2][4][2], const pg8::Unit& u, int wr, int wc, int fr, int fq) const {
        const int row0 = u.pm * 256 + wr * 64 + fr, col0 = u.pn * 256 + wc * 32 + 4 * fq;
#pragma unroll
        for (int ai = 0; ai < 2; ++ai)
#pragma unroll
            for (int m = 0; m < 4; ++m) {
                const size_t off = (size_t)(row0 + ai * 128 + m * 16) * D + col0;
#pragma unroll
                for (int bj = 0; bj < 2; ++bj)
#pragma unroll
                    for (int n = 0; n < 2; ++n) *(f32x4*)(hout + off + bj * 128 + n * 16) = *(const f32x4*)(x + off + bj * 128 + n * 16) + acc[ai][bj][m][n];
            }
    }
};
DI void phase5a(const Params& p, char* smem, int bid, int nblk) {
    pg8::Gemm g{(const bf16*)(p.ws + OFF_U), (const bf16*)(p.ws + OFF_WTIN) + (size_t)7168 * 1024, SEQ, 2048, 1024};
    pg8::StaticOrder S; S.init(SEQ, 2048, nblk, bid);
    EpiSig E{(bf16*)p.out};
    pg8::gemm_phase(smem, g, S, E);
}
DI void phase5b(const Params& p, char* smem, int bid, int nblk) {
    pg8::StaticOrder S; S.init(SEQ, 1024, nblk, bid);
    {
        pg8::Gemm g{(const bf16*)(p.ws + OFF_AQ), (const bf16*)(p.ws + OFF_WTBA), SEQ, 1024, 1024};
        EpiGate<false> E{(const bf16*)p.out, (bf16*)(p.ws + OFF_MIX), 0};
        pg8::gemm_phase(smem, g, S, E);
    }
    {
        pg8::Gemm g{(const bf16*)(p.ws + OFF_OD), (const bf16*)(p.ws + OFF_WTBD), SEQ, 1024, 1024};
        EpiGate<true> E{(const bf16*)p.out, (bf16*)(p.ws + OFF_MIX), 1024};
        pg8::gemm_phase(smem, g, S, E);
    }
}
DI void phase5c(const Params& p, char* smem, int bid, int nblk) {
    pg8::Gemm g{(const bf16*)(p.ws + OFF_MIX), (const bf16*)(p.ws + OFF_WTOUT), SEQ, 1024, 1024};
    pg8::StaticOrder S; S.init(SEQ, 1024, nblk, bid);
    EpiRes E{p.in[0], p.out};
    pg8::gemm_phase(smem, g, S, E);
}
constexpr int P5_PLP = 65, P5_PL = 0, P5_SS = 8 * 64 * P5_PLP * 4, P5_MISC = P5_SS + 8 * 64 * 4;
DI void post_rows(const Params& p, char* smem, int rb, int dry) {
    const int tid = fresh_tid(), lane = tid & 63, wave = tid >> 6, r32 = lane & 31, h = lane >> 5;
    unsigned char* ws = p.ws;
    const int row0 = rb * 64;
    float* rstdl = (float*)(smem + P5_MISC); float* logl = (float*)(smem + P5_MISC + 256);
    {
        const bf16* WH = (const bf16*)(ws + OFF_SMALL + SM_WR); const bf16* WL = WH + 64 * 1024;
        f32x16 acc[2][2];
#pragma unroll
        for (int mi = 0; mi < 2; ++mi)
#pragma unroll
            for (int ni = 0; ni < 2; ++ni) acc[mi][ni] = zero16();
        float ss[2] = {0.f, 0.f};
#pragma unroll 2
        for (int ks = 0; ks < 8; ++ks) {
            const int k0 = 128 * wave + 16 * ks + 8 * h;
            bf16x8 ah[2], al[2];
#pragma unroll
            for (int mi = 0; mi < 2; ++mi) {
                const float* hp = p.out + (size_t)(row0 + 32 * mi + r32) * D + k0;
                const f32x4 a = *(const f32x4*)hp, b = *(const f32x4*)(hp + 4);
                ss[mi] += a[0] * a[0] + a[1] * a[1] + a[2] * a[2] + a[3] * a[3] + b[0] * b[0] + b[1] * b[1] + b[2] * b[2] + b[3] * b[3];
                const u32x4 hi = {pk2(a[0], a[1]), pk2(a[2], a[3]), pk2(b[0], b[1]), pk2(b[2], b[3])};
                const u32x4 lo = {pk2(a[0] - bflo(hi.x), a[1] - bfhi(hi.x)), pk2(a[2] - bflo(hi.y), a[3] - bfhi(hi.y)), pk2(b[0] - bflo(hi.z), b[1] - bfhi(hi.z)), pk2(b[2] - bflo(hi.w), b[3] - bfhi(hi.w))};
                ah[mi] = __builtin_bit_cast(bf16x8, hi); al[mi] = __builtin_bit_cast(bf16x8, lo);
            }
#pragma unroll
            for (int ni = 0; ni < 2; ++ni) {
                const bf16x8 bh = *(const bf16x8*)(WH + (size_t)(32 * ni + r32) * 1024 + k0), bl = *(const bf16x8*)(WL + (size_t)(32 * ni + r32) * 1024 + k0);
#pragma unroll
                for (int mi = 0; mi < 2; ++mi) { acc[mi][ni] = MFMA32(ah[mi], bh, acc[mi][ni]); acc[mi][ni] = MFMA32(ah[mi], bl, acc[mi][ni]); acc[mi][ni] = MFMA32(al[mi], bh, acc[mi][ni]); }
            }
        }
        float* PL = (float*)(smem + P5_PL) + wave * 64 * P5_PLP; float* SS = (float*)(smem + P5_SS) + wave * 64;
#pragma unroll
        for (int mi = 0; mi < 2; ++mi) {
#pragma unroll
            for (int ni = 0; ni < 2; ++ni)
#pragma unroll
                for (int r = 0; r < 16; ++r) PL[(32 * mi + (r & 3) + 8 * (r >> 2) + 4 * h) * P5_PLP + 32 * ni + r32] = acc[mi][ni][r];
            const float s = ss[mi] + xhalf(ss[mi]);
            if (h == 0) SS[32 * mi + r32] = s;
        }
    }
    __syncthreads();
    if (tid < 64) {
        float s = 0.f;
#pragma unroll
        for (int w = 0; w < 8; ++w) s += ((const float*)(smem + P5_SS))[w * 64 + tid];
        const float rs = rsqrtf(s * (1.0f / D) + NORM_EPS);
        rstdl[tid] = rs;
        for (int c = 0; c < 36; ++c) { float t = 0.f; for (int w = 0; w < 8; ++w) t += ((const float*)(smem + P5_PL))[w * 64 * P5_PLP + tid * P5_PLP + c]; logl[tid * 41 + c] = t * rs + (c < 4 ? p.in[18][c] : p.in[20][c - 4]); }
        const float* L = logl + tid * 41;
        int gi = 0; float gm = L[0];
        for (int c = 1; c < 4; ++c) if (L[c] > gm) { gm = L[c]; gi = c; }
        float gs = 0.f; for (int c = 0; c < 4; ++c) gs += __expf(L[c] - gm);
        const float gw = 1.0f / gs;
        const float* E = L + 4 + 8 * gi;
        int i1 = 0; float l1 = E[0];
        for (int c = 1; c < 8; ++c) if (E[c] > l1) { l1 = E[c]; i1 = c; }
        int i2 = -1; float l2 = -3.0e38f;
        for (int c = 0; c < 8; ++c) if (c != i1 && E[c] > l2) { l2 = E[c]; i2 = c; }
        const float t = __expf(l2 - l1), w1 = 1.0f / (1.0f + t), w2 = t / (1.0f + t);
        unsigned* cnt = (unsigned*)(ws + OFF_SMALL + SM_CTL) + CW_ECNT;
        int* lists = (int*)(ws + OFF_SMALL + SM_TAILS); float* RW = (float*)(ws + OFF_SMALL + SM_RW);
        const int j = row0 + tid;
        const int e1 = 8 * gi + i1, e2 = 8 * gi + i2;
        if (!dry) {
        const unsigned p1 = atomicAdd(cnt + e1, 1u); ST_ATOMIC(lists + (size_t)e1 * SEQ + p1, (j << 1)); RW[2 * j] = gw * w1;
        const unsigned p2 = atomicAdd(cnt + e2, 1u); ST_ATOMIC(lists + (size_t)e2 * SEQ + p2, (j << 1) | 1); RW[2 * j + 1] = gw * w2;
        } else { asm volatile("" :: "v"(e1), "v"(e2), "v"(gw * w1), "v"(gw * w2)); }
    }
    __syncthreads();
#pragma unroll 2
    for (int i = 0; i < 16; ++i) {
        const int idx = tid + NT * i, row = idx >> 7, ch = idx & 127;
        const float* hp = p.out + (size_t)(row0 + row) * D + ch * 8;
        const f32x4 a = *(const f32x4*)hp, b = *(const f32x4*)(hp + 4);
        const f32x4 w0 = *(const f32x4*)(p.in[16] + ch * 8), w1 = *(const f32x4*)(p.in[16] + ch * 8 + 4);
        const float rs = rstdl[row];
        if (!dry) *(u32x4*)((bf16*)(ws + OFF_OD) + (size_t)(row0 + row) * D + ch * 8) =
            (u32x4){pk2(a[0] * rs * w0[0], a[1] * rs * w0[1]), pk2(a[2] * rs * w0[2], a[3] * rs * w0[3]), pk2(b[0] * rs * w1[0], b[1] * rs * w1[1]), pk2(b[2] * rs * w1[2], b[3] * rs * w1[3])};
    }
    __syncthreads();
}
DI void phase5d(const Params& p, char* smem, int bid, int nblk, int dry = 0) {
    for (int rb = bid; rb < SEQ / 64; rb += nblk) post_rows(p, smem, rb, dry);
}

constexpr int P6_TBL = 131072 + 1024;
template <int NPN> struct MoeSched {
    static constexpr bool GATHER = (NPN == 2);
    const int* tbl; const int* lists; int G, c; size_t btile;
    DM bool next(int i, pg8::Unit& u) const {
        const long L = (long)i * G + c; const int total = tbl[64 + 33 + 32] * NPN; if (L >= total) return false;
        const int ru = (int)L / NPN; u.pn = (int)L % NPN;
        int e = 0;
#pragma unroll 1
        for (int q = 1; q < 32; ++q) if (tbl[64 + 33 + q] <= ru) e = q;
        u.e = e; u.pm = ru - tbl[64 + 33 + e]; return true;
    }
    DM const char* a_tile(const pg8::Gemm& g, const pg8::Unit& u) const { return (const char*)g.A + ((size_t)tbl[32 + u.e] + (size_t)u.pm * 256) * g.K * 2; }
    DM const char* b_tile(const pg8::Gemm& g, const pg8::Unit& u) const { return (const char*)g.Bt + (size_t)u.e * btile + (size_t)u.pn * 256 * g.K * 2; }
    DM int a_row(const pg8::Unit& u, int r) const { const int loc = u.pm * 256 + r; return loc < tbl[u.e] ? (lists[(size_t)u.e * SEQ + loc] >> 1) : 0; }
};
DI void moe_table(const Params& p, char* smem) {
    int* tbl = (int*)(smem + P6_TBL);
    unsigned* cnt = (unsigned*)(p.ws + OFF_SMALL + SM_CTL) + CW_ECNT;
    if (threadIdx.x < 32) tbl[threadIdx.x] = (int)LD_ATOMIC(cnt + threadIdx.x);
    __syncthreads();
    if (threadIdx.x == 0) { int hb = 0, ub = 0; for (int e = 0; e < 32; ++e) { tbl[32 + e] = hb; tbl[64 + 33 + e] = ub; const int nru = (tbl[e] + 255) >> 8; hb += nru * 256; ub += nru; } tbl[32 + 32] = hb; tbl[64 + 33 + 32] = ub; }
    __syncthreads();
}
struct EpiSwiGLU {
    static constexpr bool PERM = true;
    bf16* H; const int* tbl;
    DM void operator()(const f32x4 (&acc)[2][2][4][2], const pg8::Unit& u, int wr, int wc, int fr, int fq) const {
        const size_t grow0 = (size_t)tbl[32 + u.e] + (size_t)u.pm * 256 + wr * 64 + fr; const int hid0 = (u.pn * 256 + wc * 32 + 8 * fq) >> 1;
#pragma unroll
        for (int ai = 0; ai < 2; ++ai)
#pragma unroll
            for (int m = 0; m < 4; ++m) {
                bf16* rowp = H + (grow0 + ai * 128 + m * 16) * 256 + hid0;
#pragma unroll
                for (int bj = 0; bj < 2; ++bj) {
                    const f32x4 gt = acc[ai][bj][m][0], up = acc[ai][bj][m][1];
                    *(u32x2*)(rowp + bj * 64) = (u32x2){pk2(siluf_(gt[0]) * up[0], siluf_(gt[1]) * up[1]), pk2(siluf_(gt[2]) * up[2], siluf_(gt[3]) * up[3])};
                }
            }
    }
};
struct EpiScatter {
    static constexpr bool PERM = true;
    bf16* Y; const int* tbl; const int* lists; const float* RW;
    DM void operator()(const f32x4 (&acc)[2][2][4][2], const pg8::Unit& u, int wr, int wc, int fr, int fq) const {
        const int loc0 = u.pm * 256 + wr * 64 + fr, col0 = u.pn * 256 + wc * 32 + 8 * fq, cnt = tbl[u.e];
#pragma unroll
        for (int ai = 0; ai < 2; ++ai)
#pragma unroll
            for (int m = 0; m < 4; ++m) {
                const int loc = loc0 + ai * 128 + m * 16;
                if (loc < cnt) {
                    const int ent = lists[(size_t)u.e * SEQ + loc]; const float w = RW[ent];
                    bf16* rowp = Y + (size_t)ent * D + col0;
#pragma unroll
                    for (int bj = 0; bj < 2; ++bj) {
                        const f32x4 v0 = acc[ai][bj][m][0] * w, v1 = acc[ai][bj][m][1] * w;
                        *(u32x4*)(rowp + bj * 128) = (u32x4){pk2(v0[0], v0[1]), pk2(v0[2], v0[3]), pk2(v1[0], v1[1]), pk2(v1[2], v1[3])};
                    }
                }
            }
    }
};
DI void phase6a(const Params& p, char* smem, int bid, int nblk) {
    moe_table(p, smem);
    const int* tbl = (const int*)(smem + P6_TBL); const int* lists = (const int*)(p.ws + OFF_SMALL + SM_TAILS);
    pg8::Gemm g{(const bf16*)(p.ws + OFF_OD), (const bf16*)(p.ws + OFF_EXG), 0, 512, 1024};
    MoeSched<2> S{tbl, lists, nblk, bid, (size_t)512 * 1024 * 2};
    EpiSwiGLU E{(bf16*)(p.ws + OFF_H), tbl};
    pg8::gemm_phase(smem, g, S, E);
}
DI void phase6b(const Params& p, char* smem, int bid, int nblk) {
    moe_table(p, smem);
    const int* tbl = (const int*)(smem + P6_TBL); const int* lists = (const int*)(p.ws + OFF_SMALL + SM_TAILS);
    pg8::Gemm g{(const bf16*)(p.ws + OFF_H), (const bf16*)(p.ws + OFF_EXD), 0, 1024, 256};
    MoeSched<4> S{tbl, lists, nblk, bid, (size_t)1024 * 256 * 2};
    EpiScatter E{(bf16*)(p.ws + OFF_Y), tbl, lists, (const float*)(p.ws + OFF_SMALL + SM_RW)};
    pg8::gemm_phase(smem, g, S, E);
}

DI void phase7(const Params& p, char* smem, int bid, int nblk, int dry = 0) {
    const int tid = fresh_tid(), lane = tid & 63, wave = tid >> 6;
    const int gw = bid * 8 + wave, NGW = nblk * 8;
    for (int j = gw; j < SEQ; j += NGW) {
        float* hrow = p.out + (size_t)j * D;
        const bf16* y0 = (const bf16*)(p.ws + OFF_Y) + (size_t)j * 2 * D;
        float4 v[4]; float ss = 0.f;
#pragma unroll
        for (int q = 0; q < 4; ++q) {
            const int c = 4 * lane + 256 * q;
            v[q] = *(const float4*)(hrow + c);
            const u32x2 a = *(const u32x2*)(y0 + c), b = *(const u32x2*)(y0 + D + c);
            v[q].x += bflo(a.x) + bflo(b.x); v[q].y += bfhi(a.x) + bfhi(b.x); v[q].z += bflo(a.y) + bflo(b.y); v[q].w += bfhi(a.y) + bfhi(b.y);
            ss += v[q].x * v[q].x + v[q].y * v[q].y + v[q].z * v[q].z + v[q].w * v[q].w;
        }
        ss = wave_sum(ss);
        const float rstd = rsqrtf(ss * (1.0f / D) + NORM_EPS);
#pragma unroll
        for (int q = 0; q < 4; ++q) {
            const int c = 4 * lane + 256 * q; const float4 w4 = *(const float4*)(p.in[24] + c);
            if (!dry) *(float4*)(hrow + c) = make_float4(v[q].x * rstd * w4.x, v[q].y * rstd * w4.y, v[q].z * rstd * w4.z, v[q].w * rstd * w4.w);
        }
    }
}

#ifdef EMU
__global__ void __launch_bounds__(NT) k_phase0(Params p) { SMEM_DECL; phase0(p, smem, blockIdx.x, gridDim.x); }
__global__ void __launch_bounds__(NT) k_phase1(Params p) { SMEM_DECL; phase1(p, smem, blockIdx.x, gridDim.x); }
__global__ void __launch_bounds__(NT) k_phase2(Params p) { SMEM_DECL; phase2(p, smem, blockIdx.x, gridDim.x, 0); }
__global__ void __launch_bounds__(NT) k_phase3(Params p) { SMEM_DECL; phase3(p, smem, blockIdx.x, gridDim.x); }
__global__ void __launch_bounds__(NT) k_phase4(Params p) { SMEM_DECL; phase4(p, smem, blockIdx.x, gridDim.x); }
__global__ void __launch_bounds__(NT) k_phase5a(Params p) { SMEM_DECL; phase5a(p, smem, blockIdx.x, gridDim.x); }
__global__ void __launch_bounds__(NT) k_phase5b(Params p) { SMEM_DECL; phase5b(p, smem, blockIdx.x, gridDim.x); }
__global__ void __launch_bounds__(NT) k_phase5c(Params p) { SMEM_DECL; phase5c(p, smem, blockIdx.x, gridDim.x); }
__global__ void __launch_bounds__(NT) k_phase5d(Params p) { SMEM_DECL; phase5d(p, smem, blockIdx.x, gridDim.x); }
__global__ void __launch_bounds__(NT) k_phase6a(Params p) { SMEM_DECL; phase6a(p, smem, blockIdx.x, gridDim.x); }
__global__ void __launch_bounds__(NT) k_phase6b(Params p) { SMEM_DECL; phase6b(p, smem, blockIdx.x, gridDim.x); }
__global__ void __launch_bounds__(NT) k_phase7(Params p) { SMEM_DECL; phase7(p, smem, blockIdx.x, gridDim.x); }

#endif

constexpr int LDS_BYTES = 160 * 1024 - 256;
constexpr int LDS_BARST = LDS_BYTES - 16;

#ifndef EMU
#define LAS __attribute__((address_space(3)))
#define XB_TMO      128
#define XB_XCNT(j)  (256  + 64 * (j))
#define XB_XSUB(j)  (1280 + 64 * (j))
#define XB_XGEN(j)  (2304 + 64 * (j))
#define XB_TOP      3328
#define XB_TOPGEN   3392
#define XCD_BAR_WORDS 3456
#define XB_SPIN_CAP (1u << 22)
__device__ __forceinline__ unsigned xb_ld(unsigned* p)              { return __hip_atomic_load(p, __ATOMIC_RELAXED, __HIP_MEMORY_SCOPE_AGENT); }
__device__ __forceinline__ unsigned xb_add(unsigned* p, unsigned v) { return __hip_atomic_fetch_add(p, v, __ATOMIC_RELAXED, __HIP_MEMORY_SCOPE_AGENT); }
__device__ __forceinline__ unsigned xb_xcc_id() { return (unsigned)__builtin_amdgcn_s_getreg((3 << 11) | 20) & 0xFu; }
#define XB_SPIN(cond, bar) do { unsigned _sp = 0; while (cond) { __builtin_amdgcn_s_sleep(1); \
    if ((++_sp & 255u) == 0u) { if (xb_ld(&(bar)[XB_TMO])) break; if (_sp > XB_SPIN_CAP) { atomicAdd(&(bar)[XB_TMO], 1u); break; } } } } while (0)
struct XcdBarrier { unsigned* bar; unsigned x; volatile LAS unsigned* st; };
__device__ __forceinline__ XcdBarrier xcd_barrier_post(unsigned* bar, volatile LAS unsigned* st) {
    XcdBarrier b; b.bar = bar; b.x = xb_xcc_id(); b.st = st;
    if (threadIdx.x == 0) (void)xb_add(&bar[XB_XCNT(b.x)], 1u);
    return b;
}
__device__ __forceinline__ void xcd_barrier_complete(unsigned* bar, unsigned x, unsigned& nloc, unsigned& nx) {
    const unsigned G = gridDim.x * gridDim.y * gridDim.z;
    unsigned sum, cnt, mine, sp = 0u;
    for (;;) {
        sum = 0u; cnt = 0u; mine = 0u;
#pragma unroll
        for (unsigned j = 0; j < 16; ++j) { const unsigned c = xb_ld(&bar[XB_XCNT(j)]); sum += c; cnt += (c > 0u) ? 1u : 0u; mine = (j == x) ? c : mine; }
        if (sum == G) break;
        __builtin_amdgcn_s_sleep(1);
        if ((++sp & 255u) == 0u) { if (xb_ld(&bar[XB_TMO])) break; if (sp > XB_SPIN_CAP) { atomicAdd(&bar[XB_TMO], 1u); break; } }
    }
    nloc = mine > 0u ? mine : 1u; nx = cnt > 0u ? cnt : 1u;
}
__device__ __forceinline__ void xcd_barrier(const XcdBarrier& b) {
    asm volatile("s_waitcnt vmcnt(0)" ::: "memory");
    __syncthreads();
    if (threadIdx.x == 0) {
        unsigned* bar = b.bar;
        __builtin_amdgcn_s_waitcnt(0);
        unsigned nloc = b.st[0], nx = b.st[1];
        if (nloc == 0u) { xcd_barrier_complete(bar, b.x, nloc, nx); b.st[0] = nloc; b.st[1] = nx; }
        const unsigned old = xb_add(&bar[XB_XSUB(b.x)], 1u);
        const unsigned gen = old / nloc;
        if (old + 1u == (gen + 1u) * nloc) {
            __builtin_amdgcn_fence(__ATOMIC_RELEASE, "agent");
            asm volatile("s_waitcnt vmcnt(0)" ::: "memory");
            const unsigned og = xb_add(&bar[XB_TOP], 1u);
            const unsigned tg = og / nx;
            if (og + 1u == (tg + 1u) * nx) xb_add(&bar[XB_TOPGEN], 1u);
            else XB_SPIN(xb_ld(&bar[XB_TOPGEN]) == tg, bar);
            __builtin_amdgcn_fence(__ATOMIC_ACQUIRE, "agent");
            xb_add(&bar[XB_XGEN(b.x)], 1u);
            asm volatile("s_waitcnt vmcnt(0)" ::: "memory");
        } else {
            XB_SPIN(xb_ld(&bar[XB_XGEN(b.x)]) == gen, bar);
            __builtin_amdgcn_fence(__ATOMIC_ACQUIRE, "agent");
            asm volatile("s_waitcnt vmcnt(0)" ::: "memory");
        }
    }
    __syncthreads();
}
#endif

#ifdef EMU
#define GRID_SYNC() emu_grid_sync()
#define GRID_SYNC_CG() emu_grid_sync()
#else
#define GRID_SYNC_CG() do { \
    asm volatile("s_waitcnt vmcnt(0)" ::: "memory"); \
    __syncthreads(); \
    cooperative_groups::this_grid().sync(); \
    if (threadIdx.x == 0) { __builtin_amdgcn_fence(__ATOMIC_ACQUIRE, "agent"); asm volatile("s_waitcnt vmcnt(0)" ::: "memory"); } \
    __syncthreads(); \
} while (0)
#define GRID_SYNC() xcd_barrier(xbar)
#endif
__global__ void __launch_bounds__(NT) fwd_megakernel(Params p) {
    SMEM_DECL;
    const int bid = blockIdx.x, nblk = gridDim.x;
#ifndef EMU
    if (threadIdx.x < 4) ((volatile LAS unsigned*)(smem + LDS_BARST))[threadIdx.x] = 0u;
    __syncthreads();
    const XcdBarrier xbar = xcd_barrier_post((unsigned*)(p.ws + OFF_SMALL + SM_CTL) + CW_BAR, (volatile LAS unsigned*)(smem + LDS_BARST));
#endif
#if defined(DRY_PHASE) && !defined(EMU)
    int dryflag = 1; asm volatile("" : "+s"(dryflag));
#define EXTRA(k, call) do { if (DRY_PHASE == (k)) { call; GRID_SYNC(); } } while (0)
#else
#define EXTRA(k, call) do {} while (0)
    const int dryflag = 0; (void)dryflag;
#endif
    EXTRA(0, phase0(p, smem, bid, nblk));
    phase0(p, smem, bid, nblk); GRID_SYNC_CG();
    EXTRA(1, phase1(p, smem, bid, nblk));
    phase1(p, smem, bid, nblk); GRID_SYNC();
    EXTRA(2, phase2(p, smem, bid, nblk, dryflag));
    phase2(p, smem, bid, nblk); GRID_SYNC();
    EXTRA(3, phase3(p, smem, bid, nblk, dryflag));
    EXTRA(8, phase3(p, smem, bid, nblk, dryflag, 1));
    EXTRA(9, phase3(p, smem, bid, nblk, dryflag, 2));
    phase3(p, smem, bid, nblk); GRID_SYNC();
    EXTRA(4, phase4(p, smem, bid, nblk));
    phase4(p, smem, bid, nblk); GRID_SYNC();
    EXTRA(5, phase5a(p, smem, bid, nblk));
    phase5a(p, smem, bid, nblk); GRID_SYNC();
    EXTRA(10, phase5b(p, smem, bid, nblk));
    phase5b(p, smem, bid, nblk); GRID_SYNC();
    EXTRA(11, phase5c(p, smem, bid, nblk));
    phase5c(p, smem, bid, nblk); GRID_SYNC();
    EXTRA(12, phase5d(p, smem, bid, nblk, dryflag));
    phase5d(p, smem, bid, nblk); GRID_SYNC();
    EXTRA(6, phase6a(p, smem, bid, nblk));
    phase6a(p, smem, bid, nblk); GRID_SYNC();
    EXTRA(13, phase6b(p, smem, bid, nblk));
    phase6b(p, smem, bid, nblk); GRID_SYNC();
    EXTRA(7, phase7(p, smem, bid, nblk, dryflag));
    phase7(p, smem, bid, nblk);
}

#ifndef EMU
extern "C" void kernel_launch(void* const* d_in, const int* in_sizes, int n_in, void* d_out, int out_size, void* d_ws, size_t ws_size, hipStream_t stream) {
    static int grid = 0;
    if (grid == 0) {
        if (n_in != 25 || ws_size < WS_END || out_size != SEQ * D) { fprintf(stderr, "kernel_launch: unexpected problem (n_in %d, ws %zu, out %d)\n", n_in, ws_size, out_size); grid = -1; return; }
        int dev = 0, cus = 0, per_cu = 0;
        (void)hipGetDevice(&dev);
        (void)hipDeviceGetAttribute(&cus, hipDeviceAttributeMultiprocessorCount, dev);
        (void)hipFuncSetAttribute((const void*)fwd_megakernel, hipFuncAttributeMaxDynamicSharedMemorySize, LDS_BYTES);
        (void)hipOccupancyMaxActiveBlocksPerMultiprocessor(&per_cu, (const void*)fwd_megakernel, NT, LDS_BYTES);
        if (per_cu < 1) { fprintf(stderr, "kernel_launch: occupancy query returned %d\n", per_cu); per_cu = 1; }
        grid = cus * per_cu;
    }
    if (grid < 0) return;
    Params p{};
    for (int i = 0; i < 25; ++i) p.in[i] = (const float*)d_in[i];
    p.out = (float*)d_out; p.ws = (unsigned char*)d_ws;
    (void)hipMemsetAsync((unsigned char*)d_ws + OFF_SMALL + SM_CTL + (size_t)CW_BAR * 4, 0, (size_t)XCD_BAR_WORDS * 4, stream);
    void* args[] = {&p};
    hipError_t e = hipLaunchCooperativeKernel((const void*)fwd_megakernel, dim3(grid), dim3(NT), args, LDS_BYTES, stream);
    if (e != hipSuccess) fprintf(stderr, "cooperative launch failed: %s (grid %d)\n", hipGetErrorString(e), grid);
}
#endif

#ifdef EMU
static void run_phases(Params p, int upto, int grid) {
    if (upto == 100) { emu::launch([=] { fwd_megakernel(p); }, grid, NT, LDS_BYTES, true); return; }
    if (upto >= 0) emu::launch([=] { k_phase0(p); }, grid, NT, LDS_BYTES, false);
    if (upto >= 1) emu::launch([=] { k_phase1(p); }, grid, NT, LDS_BYTES, false);
    if (upto >= 2) emu::launch([=] { k_phase2(p); }, grid, NT, LDS_BYTES, false);
    if (upto >= 3) emu::launch([=] { k_phase3(p); }, grid, NT, LDS_BYTES, false);
    if (upto >= 4) emu::launch([=] { k_phase4(p); }, grid, NT, LDS_BYTES, false);
    if (upto >= 5) { emu::launch([=] { k_phase5a(p); }, grid, NT, LDS_BYTES, false); emu::launch([=] { k_phase5b(p); }, grid, NT, LDS_BYTES, false); emu::launch([=] { k_phase5c(p); }, grid, NT, LDS_BYTES, false); emu::launch([=] { k_phase5d(p); }, grid, NT, LDS_BYTES, false); }
    if (upto >= 6) { emu::launch([=] { k_phase6a(p); }, grid, NT, LDS_BYTES, false); emu::launch([=] { k_phase6b(p); }, grid, NT, LDS_BYTES, false); }
    if (upto >= 7) emu::launch([=] { k_phase7(p); }, grid, NT, LDS_BYTES, false);
}
#endif
```

```cpp
#include <type_traits>
#ifndef EMU
#include <hip/hip_runtime.h>
#include <hip/hip_cooperative_groups.h>
#include <cstdio>
#include <cstdint>
#include <cmath>
#endif

#ifndef SEQ
#define SEQ 16384
#endif

typedef unsigned short bf16;
typedef short bf16x8 __attribute__((ext_vector_type(8)));
typedef short bf16x4 __attribute__((ext_vector_type(4)));
typedef float f32x16 __attribute__((ext_vector_type(16)));
typedef float f32x4 __attribute__((ext_vector_type(4)));
typedef unsigned u32x4 __attribute__((ext_vector_type(4)));
typedef unsigned u32x2 __attribute__((ext_vector_type(2)));

#ifdef EMU
#define MFMA32(a, b, c) emu_mfma_32x32x16((a), (b), (c))
#define MFMA16(a, b, c) emu_mfma_16x16x32((a), (b), (c))
#define DI static inline
#define DM inline
#define EXP2F(x) exp2f(x)
#define WAVE_SYNC() emu_wave_sync()
#define LD_NT(p) (*(p))
#define LD_ATOMIC(p) (*(p))
#define ST_ATOMIC(p, v) (*(p) = (v))
#define SCHED_FENCE() do {} while (0)
#else
#define WAVE_SYNC() do { __builtin_amdgcn_fence(__ATOMIC_RELEASE, "wavefront"); __builtin_amdgcn_wave_barrier(); __builtin_amdgcn_fence(__ATOMIC_ACQUIRE, "wavefront"); } while (0)
#define MFMA32(a, b, c) __builtin_amdgcn_mfma_f32_32x32x16_bf16((a), (b), (c), 0, 0, 0)
#define LD_NT(p) __builtin_nontemporal_load(p)
#define LD_ATOMIC(p) __hip_atomic_load((p), __ATOMIC_RELAXED, __HIP_MEMORY_SCOPE_AGENT)
#define ST_ATOMIC(p, v) __hip_atomic_store((p), (v), __ATOMIC_RELAXED, __HIP_MEMORY_SCOPE_AGENT)
#define SCHED_FENCE() __builtin_amdgcn_sched_barrier(0)
#define MFMA16(a, b, c) __builtin_amdgcn_mfma_f32_16x16x32_bf16((a), (b), (c), 0, 0, 0)
#define DI __device__ __forceinline__
#define DM __device__ __forceinline__
#define EXP2F(x) __builtin_amdgcn_exp2f(x)
#endif

constexpr int D = 1024;
constexpr int NMETA = 16;
constexpr int LTOK = SEQ + NMETA;
constexpr int NCH = SEQ / 64 + 1;
constexpr int NT = 512;
constexpr int W_IN_COLS = 9232;
constexpr float NORM_EPS = 1e-6f;
constexpr float LOG2E = 1.4426950408889634f;

constexpr size_t UNIT = (size_t)SEQ * D * 2;
constexpr size_t OFF_WTIN = 0;
constexpr size_t OFF_WTBA = OFF_WTIN + (size_t)9216 * 1024 * 2;
constexpr size_t OFF_WTBD = OFF_WTBA + (size_t)1024 * 1024 * 2;
constexpr size_t OFF_WTOUT = OFF_WTBD + (size_t)1024 * 1024 * 2;
constexpr size_t OFF_SMALL = OFF_WTOUT + (size_t)1024 * 1024 * 2;
constexpr size_t SM_CTL = 0;
constexpr size_t SM_UMETA = SM_CTL + 65536;
constexpr size_t SM_AKMETA = SM_UMETA + 16 * 1024 * 2;
constexpr size_t SM_AVTMETA = SM_AKMETA + 16 * 1024 * 2;
constexpr size_t SM_C0Q = SM_AVTMETA + 8 * 128 * 16 * 2;
constexpr size_t SM_C0K = SM_C0Q + 64 * 1024 * 2;
constexpr size_t SM_C0V = SM_C0K + 64 * 1024 * 2;
constexpr size_t SM_C0W = SM_C0V + 64 * 1024 * 2;
constexpr size_t SM_C0QK = SM_C0W + 8 * 64 * 128 * 2;
constexpr size_t SM_BETA = SM_C0QK + 8 * 64 * 64 * 2;
constexpr size_t SM_G = SM_BETA + (size_t)NCH * 64 * 8 * 4;
constexpr size_t SM_GC = SM_G + (size_t)NCH * 64 * 8 * 4;
constexpr size_t SM_WR = SM_GC + (size_t)NCH * 8 * 64 * 4;
constexpr size_t SM_RIDS = SM_WR + 2 * 64 * 1024 * 2;
constexpr size_t SM_RW = SM_RIDS + 0;
constexpr size_t SM_TAILS = SM_RW + (size_t)SEQ * 2 * 4;
constexpr size_t SM_TAILS_BYTES = ((size_t)NCH * 3 * 3072 * 2 > (size_t)32 * SEQ * 4) ? (size_t)NCH * 3 * 3072 * 2 : (size_t)32 * SEQ * 4;
constexpr size_t SM_END = SM_TAILS + SM_TAILS_BYTES;
constexpr size_t SMALL_BYTES = (SM_END + 255) & ~(size_t)255;
constexpr size_t OFF_U = ((OFF_SMALL + SMALL_BYTES + (1u << 20) - 1) >> 20) << 20;
constexpr size_t OFF_W = OFF_U + UNIT;
constexpr size_t OFF_KN = OFF_W + UNIT;
constexpr size_t OFF_QN = OFF_KN + UNIT;
constexpr size_t OFF_DG = OFF_QN + UNIT;
constexpr size_t OFF_V = OFF_DG + UNIT;
constexpr size_t OFF_AQ = OFF_V + UNIT;
constexpr size_t WS_BASE_END = OFF_AQ + UNIT;
constexpr size_t EXPERT_BYTES = (size_t)32 * 3 * 1024 * 256 * 2;
constexpr size_t OFF_EXP = (2 * UNIT >= EXPERT_BYTES) ? OFF_W : WS_BASE_END;
constexpr size_t WS_END1 = (OFF_EXP == OFF_W) ? WS_BASE_END : WS_BASE_END + EXPERT_BYTES;
constexpr size_t H_BYTES = ((size_t)2 * SEQ + 32 * 256) * 256 * 2;
constexpr size_t OFF_H = (H_BYTES <= UNIT) ? (OFF_SMALL + SMALL_BYTES + ((1u << 20) - 1)) / (1u << 20) * (1u << 20) : WS_END1;
constexpr size_t WS_END = (H_BYTES <= UNIT) ? WS_END1 : WS_END1 + H_BYTES;
constexpr size_t OFF_EXG = OFF_EXP, OFF_EXU = OFF_EXP + EXPERT_BYTES / 3, OFF_EXD = OFF_EXP + 2 * (EXPERT_BYTES / 3);
constexpr size_t OFF_QKB = OFF_U;
constexpr size_t OFF_OD = OFF_QN;
constexpr size_t OFF_Y = OFF_V;
#if SEQ == 16384
static_assert(WS_END <= (size_t)256 << 20, "workspace map exceeds 256 MiB");
static_assert(EXPERT_BYTES <= 2 * UNIT, "experts fit R2+R3");
#endif
constexpr int CW_ATTQ = 64;
constexpr int CW_ECNT = 128;
constexpr int CW_NRM = 256;
constexpr int CW_BAR = 1024;

struct Params {
    const float* in[25];
    float* out;
    unsigned char* ws;
};

#ifdef EMU
DI unsigned f2bf(float f) { unsigned u = __builtin_bit_cast(unsigned, f); return (u + 0x7fffu + ((u >> 16) & 1u)) >> 16; }
#else
DI unsigned f2bf(float f) { return (unsigned)__builtin_bit_cast(unsigned short, (__bf16)f); }
#endif

DI float bf2f(unsigned b) { return __builtin_bit_cast(float, (b & 0xffffu) << 16); }
#ifdef EMU
DI unsigned pk2(float lo, float hi) { return f2bf(lo) | (f2bf(hi) << 16); }
DI bool wave_any(bool pr) { int v = pr ? 1 : 0;
    for (int o = 1; o < 64; o <<= 1) v |= __shfl_xor(v, o);
    return v != 0; }
#else
typedef __bf16 hwbf2 __attribute__((ext_vector_type(2)));
typedef float f32x2_ __attribute__((ext_vector_type(2)));
DI unsigned pk2(float lo, float hi) { return __builtin_bit_cast(unsigned, __builtin_convertvector((f32x2_){lo, hi}, hwbf2)); }
DI bool wave_any(bool pr) { return __any(pr) != 0; }
#endif
DI float bflo(unsigned w) { return __builtin_bit_cast(float, w << 16); }
DI float bfhi(unsigned w) { return __builtin_bit_cast(float, w & 0xffff0000u); }
#ifdef EMU
DI float rcpf_(float x) { return 1.0f / x; }
#else
DI float rcpf_(float x) { return __builtin_amdgcn_rcpf(x); }
#endif
DI float sigmoidf_(float x) { return rcpf_(1.0f + __expf(-x)); }
DI float siluf_(float x) { return x * rcpf_(1.0f + __expf(-x)); }
DI float wave_sum(float v) {
#pragma unroll
    for (int o = 1; o < 64; o <<= 1) v += __shfl_xor(v, o);
    return v;
}
DI int fresh_tid() {
    int t = threadIdx.x;
#ifndef EMU
    asm volatile("" : "+v"(t));
#endif
    return t;
}
#ifdef EMU
DI float xhalf(float v) { return __shfl_xor(v, 32); }
#else
DI float xhalf(float v) { const unsigned u = __builtin_bit_cast(unsigned, v); const auto r = __builtin_amdgcn_permlane32_swap(u, u, false, false); return __builtin_bit_cast(float, (threadIdx.x & 32) ? r[0] : r[1]); }
#endif
DI f32x16 zero16() { f32x16 z; for (int i = 0; i < 16; ++i) z[i] = 0.f; return z; }
DI f32x4 zero4() { f32x4 z; for (int i = 0; i < 4; ++i) z[i] = 0.f; return z; }
DI int swz128(int row, int c) { return row * 128 + ((c ^ ((row >> 1) & 7)) << 4); }
DI int swz128t(int row, int c) { return row * 128 + ((c ^ ((row >> 1) & 7) ^ ((row >> 4) & 7)) << 4); }
DI int swz128_8(int row, int s) { return row * 128 + ((s ^ (((row >> 1) & 7) << 1)) << 3); }
DI int swzrow(int row, int pitch, int c) { return row * pitch + ((c ^ (row & 15)) << 4); }

#ifdef EMU
#define SMEM_DECL char* smem = emu_smem()
#else
#define SMEM_DECL extern __shared__ __attribute__((aligned(16))) char smem[]
#endif

DI void transpose_item(const float* W, int ldw, int K, bf16* Wt, int k0, int src_n0, int dst_n0, float* scr, int lane, int il = 0) {
#pragma unroll 8
    for (int i = 0; i < 32; ++i) { const int kk = 2 * i + (lane >> 5); scr[kk * 33 + (lane & 31)] = W[(size_t)(k0 + kk) * ldw + src_n0 + (lane & 31)]; }
    WAVE_SYNC();
    const int c = lane & 7;
#pragma unroll
    for (int j = 0; j < 4; ++j) {
        const int n = (lane >> 3) + 8 * j; const float* s = scr + (8 * c) * 33 + n;
        u32x4 o; o.x = pk2(s[0 * 33], s[1 * 33]); o.y = pk2(s[2 * 33], s[3 * 33]); o.z = pk2(s[4 * 33], s[5 * 33]); o.w = pk2(s[6 * 33], s[7 * 33]);
        const int hid = dst_n0 + n, drow = il ? 8 * (hid >> 2) + 4 * (il - 1) + (hid & 3) : hid;
        *(u32x4*)(Wt + (size_t)drow * K + k0 + 8 * c) = o;
    }
    WAVE_SYNC();
}

DI void phase0(const Params& p, char* smem, int bid, int nblk) {
    const int tid = fresh_tid(), lane = tid & 63, wave = tid >> 6;
    const int gw = bid * 8 + wave, NGW = nblk * 8;
    unsigned char* ws = p.ws;
    if (bid == 0) {
        unsigned* ctl = (unsigned*)(ws + OFF_SMALL + SM_CTL);
        for (int i = tid; i < 1024; i += NT) ctl[i] = 0u;
        float* be = (float*)(ws + OFF_SMALL + SM_BETA); float* gg = (float*)(ws + OFF_SMALL + SM_G);
        for (int i = tid; i < 48 * 8; i += NT) { be[i] = 0.f; gg[i] = 0.f; }
    }
    {
        float* scr = (float*)(smem + 65536) + wave * (64 * 33);
        constexpr int I_IN = 16 * (9216 / 32), I_SQ = 16 * 32;
        constexpr int NITEMS = I_IN + 3 * I_SQ;
        for (int it = gw; it < NITEMS; it += NGW) {
            int r = it;
            if (r < I_IN) { const int kb = r / 288, nb = r % 288; const int dn = nb * 32; const int sn = dn < 7168 ? dn : dn + 16;
                transpose_item(p.in[3], W_IN_COLS, 1024, (bf16*)(ws + OFF_WTIN), kb * 64, sn, dn, scr, lane); continue; }
            r -= I_IN;
            const int m = r / I_SQ; r %= I_SQ;
            const float* src = m == 0 ? p.in[13] : (m == 1 ? p.in[14] : p.in[15]);
            bf16* dst = (bf16*)(ws + (m == 0 ? OFF_WTBA : (m == 1 ? OFF_WTBD : OFF_WTOUT)));
            transpose_item(src, 1024, 1024, dst, (r / 32) * 64, (r % 32) * 32, (r % 32) * 32, scr, lane);
        }
    }
    {
        bf16* WH = (bf16*)(ws + OFF_SMALL + SM_WR); bf16* WL = WH + 64 * 1024;
        for (int i = bid * NT + tid; i < 64 * 1024; i += nblk * NT) {
            const int n = i >> 10, kk = i & 1023; float v = 0.f;
            if (n < 4) v = p.in[17][kk * 4 + n]; else if (n < 36) v = p.in[19][kk * 32 + (n - 4)];
            v *= p.in[16][kk];
            const unsigned hb = f2bf(v); const float lo = v - bf2f(hb);
            WH[i] = (bf16)hb; WL[i] = (bf16)f2bf(lo);
        }
    }
    float* wbd = (float*)smem;
    for (int i = tid; i < 1024 * 16; i += NT) { const int k = i >> 4, c = i & 15; wbd[c * 1024 + k] = p.in[3][(size_t)k * W_IN_COLS + 7168 + c]; }
    __syncthreads();
    const float* nw = p.in[2];
    for (int R = gw; R < LTOK; R += NGW) {
        const float* xrow = R < NMETA ? p.in[1] + (size_t)R * D : p.in[0] + (size_t)(R - NMETA) * D;
        bf16* urow = R < NMETA ? (bf16*)(ws + OFF_SMALL + SM_UMETA) + (size_t)R * D : (bf16*)(ws + OFF_U) + (size_t)(R - NMETA) * D;
        float ss = 0.f;
#pragma unroll
        for (int j = 0; j < 4; ++j) { const float4 v = *(const float4*)(xrow + 4 * lane + 256 * j); ss += v.x * v.x + v.y * v.y + v.z * v.z + v.w * v.w; }
        ss = wave_sum(ss);
        const float rstd = rsqrtf(ss * (1.0f / D) + NORM_EPS);
        float acc[16];
#pragma unroll
        for (int c = 0; c < 16; ++c) acc[c] = 0.f;
#pragma unroll 1
        for (int j = 0; j < 4; ++j) {
            const float4 w4 = *(const float4*)(nw + 4 * lane + 256 * j);
            const float4 xv = *(const float4*)(xrow + 4 * lane + 256 * j);
            float uu[4] = {xv.x * rstd * w4.x, xv.y * rstd * w4.y, xv.z * rstd * w4.z, xv.w * rstd * w4.w};
            u32x2 o; o.x = pk2(uu[0], uu[1]); o.y = pk2(uu[2], uu[3]);
            *(u32x2*)(urow + 4 * lane + 256 * j) = o;
#pragma unroll
            for (int c = 0; c < 16; ++c) {
                const f32x4 w = *(const f32x4*)(wbd + c * 1024 + 4 * lane + 256 * j);
                acc[c] += uu[0] * w[0] + uu[1] * w[1] + uu[2] * w[2] + uu[3] * w[3];
            }
        }
        float v8[8], v4[4], v2[2], a;
        {
            const bool b0 = lane & 1, b1 = lane & 2, b2 = lane & 4, b3 = lane & 8;
#pragma unroll
            for (int i = 0; i < 8; ++i) { const float keep = b0 ? acc[i + 8] : acc[i], send = b0 ? acc[i] : acc[i + 8]; v8[i] = keep + __shfl_xor(send, 1); }
#pragma unroll
            for (int i = 0; i < 4; ++i) { const float keep = b1 ? v8[i + 4] : v8[i], send = b1 ? v8[i] : v8[i + 4]; v4[i] = keep + __shfl_xor(send, 2); }
#pragma unroll
            for (int i = 0; i < 2; ++i) { const float keep = b2 ? v4[i + 2] : v4[i], send = b2 ? v4[i] : v4[i + 2]; v2[i] = keep + __shfl_xor(send, 4); }
            { const float keep = b3 ? v2[1] : v2[0], send = b3 ? v2[0] : v2[1]; a = keep + __shfl_xor(send, 8); }
            a += __shfl_xor(a, 16); a += __shfl_xor(a, 32);
        }
        if (lane < 16) {
            const int cc = ((lane & 1) << 3) | ((lane & 2) << 1) | ((lane & 4) >> 1) | ((lane & 8) >> 3);
            const size_t pos = 48 + R;
            if (cc < 8) { ((float*)(ws + OFF_SMALL + SM_BETA))[pos * 8 + cc] = sigmoidf_(a); }
            else { const int hh = cc - 8; const float z = a + p.in[11][hh]; const float sp = fmaxf(z, 0.f) + log1pf(__expf(-fabsf(z)));
                   ((float*)(ws + OFF_SMALL + SM_G))[pos * 8 + hh] = -__expf(p.in[10][hh]) * sp; }
        }
    }
}

namespace pg8 {
constexpr int BM = 256, BK = 64, HALF = 128, HTB = HALF * BK * 2, NXCD = 8, WGM = 8;
DI int lds_byte(int r, int c) { const int st = (r >> 4) * 2 + (c >> 5), rr = r & 15, cc = c & 31, ob = rr * 64 + cc * 2; return st * 1024 + (ob ^ (((ob >> 9) & 1) << 5)); }
DI void stage_rc(int b, int& R, int& C) { const int st = b / 1024, sb = b % 1024, swz = sb ^ (((sb >> 9) & 1) << 5); R = (st >> 1) * 16 + swz / 64; C = (st & 1) * 32 + (swz % 64) / 2; }
DI int perm32(int rho) { const int n = rho >> 4, i = rho & 15; return 8 * (i >> 2) + 4 * n + (i & 3); }
struct Unit { int pm, pn, e; };
struct Gemm { const bf16* A; const bf16* Bt; int M, N, K; };
struct StaticOrder {
    static constexpr bool GATHER = false;
    int nM, nN, nwg, G, c;
    DM void init(int M, int N, int G_, int c_) { nM = M / BM; nN = N / BM; nwg = nM * nN; G = G_; c = c_; }
    DM bool next(int i, Unit& u) const {
        const long L = (long)i * G + c; if (L >= nwg) return false;
        int wgid = (int)L; { const int q = nwg / NXCD, r = nwg % NXCD, xcd = wgid % NXCD, off = wgid / NXCD; wgid = (xcd < r ? xcd * (q + 1) : r * (q + 1) + (xcd - r) * q) + off; }
        const int nig = WGM * nN, gid = wgid / nig, fm = gid * WGM, gsz = (nM - fm) < WGM ? (nM - fm) : WGM;
        u.pm = fm + ((wgid % nig) % gsz); u.pn = (wgid % nig) / gsz; u.e = 0; return true;
    }
    DM const char* a_tile(const Gemm& g, const Unit& u) const { return (const char*)g.A + (size_t)u.pm * 256 * g.K * 2; }
    DM const char* b_tile(const Gemm& g, const Unit& u) const { return (const char*)g.Bt + (size_t)u.pn * 256 * g.K * 2; }
    DM int a_row(const Unit&, int) const { return 0; }
};
#ifdef EMU
template <class Epi, class Sched>
DI void gemm_phase(char* lds, const Gemm g, const Sched& S, const Epi& E) {
    const int tid = threadIdx.x, wid = tid >> 6, lane = tid & 63, wr = wid >> 2, wc = wid & 3, fr = lane & 15, fq = lane >> 4;
    Unit u;
    for (int ui = 0; S.next(ui, u); ++ui) {
        f32x4 acc[2][2][4][2];
        const bf16* bt = (const bf16*)S.b_tile(g, u);
        for (int ai = 0; ai < 2; ++ai) for (int bj = 0; bj < 2; ++bj) for (int m = 0; m < 4; ++m) for (int n = 0; n < 2; ++n) for (int e = 0; e < 4; ++e) {
            const int r = 128 * ai + 64 * wr + 16 * m + fr;
            const int c = 128 * bj + 32 * wc + (Epi::PERM ? 8 * fq + 4 * n : 16 * n + 4 * fq) + e;
            const bf16* a = Sched::GATHER ? g.A + (size_t)S.a_row(u, r) * g.K : (const bf16*)S.a_tile(g, u) + (size_t)r * g.K;
            const bf16* b = bt + (size_t)c * g.K; float s = 0.f;
            for (int kk = 0; kk < g.K; ++kk) s += bf2f(a[kk]) * bf2f(b[kk]);
            acc[ai][bj][m][n][e] = s;
        }
        E(acc, u, wr, wc, fr, fq);
    }
    __syncthreads();
}
#else
#define PG8_LAS __attribute__((address_space(3)))
template <class Epi, class Sched>
__device__ __forceinline__ void gemm_phase(char* lds_, const Gemm g, const Sched& S, const Epi& E) {
    PG8_LAS unsigned char* lds = (PG8_LAS unsigned char*)lds_;
    const int tid = fresh_tid(), wid = __builtin_amdgcn_readfirstlane(tid >> 6), lane = tid & 63, wr = wid >> 2, wc = wid & 3, fr = lane & 15, fq = lane >> 4;
    const int K = g.K, nt = K / BK;
    unsigned voffA[2], voffB[2]; int RA[2], CA[2];
#pragma unroll
    for (int i = 0; i < 2; ++i) { int R, C; stage_rc(tid * 16 + i * 8192, R, C); const int Rb = Epi::PERM ? ((R & ~31) + perm32(R & 31)) : R;
        voffA[i] = (unsigned)(R * K + C) * 2u; voffB[i] = (unsigned)(Rb * K + C) * 2u; RA[i] = R; CA[i] = C; }
    const size_t kstep = (size_t)(BK * 2);
    const size_t hstep = (size_t)HALF * K * 2;
    const unsigned ldsw = (unsigned)wid * 1024u;
    const int aoff = lds_byte(wr * 64 + fr, fq * 8), boff = lds_byte(wc * 32 + fr, fq * 8);
#define PG8_SA(b, h) (((b) * 2 + (h)) * HTB)
#define PG8_SB(b, h) ((4 + (b) * 2 + (h)) * HTB)
#define PG8_STAGE(bufoff, gbase, voff) do { _Pragma("unroll") for (int _i = 0; _i < 2; ++_i) \
        __builtin_amdgcn_global_load_lds((const unsigned*)((const char*)(gbase) + (voff)[_i]), (PG8_LAS unsigned*)(lds + (bufoff) + ldsw + _i * 8192), 16, 0, 0); } while (0)
#define PG8_STAGE_A(bufoff, base, PA, half, koff) do { if constexpr (Sched::GATHER) { _Pragma("unroll") for (int _i = 0; _i < 2; ++_i) \
        __builtin_amdgcn_global_load_lds((const unsigned*)((PA)[half][_i] + (koff)), (PG8_LAS unsigned*)(lds + (bufoff) + ldsw + _i * 8192), 16, 0, 0); } \
        else { PG8_STAGE(bufoff, (base) + (half) * hstep + (koff), voffA); } } while (0)
#define PG8_LDA(dst, b, h) do { _Pragma("unroll") for (int m = 0; m < 4; ++m) _Pragma("unroll") for (int k = 0; k < 2; ++k) dst[m][k] = *(const PG8_LAS bf16x8*)(lds + PG8_SA(b, h) + aoff + m * 2048 + k * 1024); } while (0)
#define PG8_LDB(dst, b, h) do { _Pragma("unroll") for (int n = 0; n < 2; ++n) _Pragma("unroll") for (int k = 0; k < 2; ++k) dst[n][k] = *(const PG8_LAS bf16x8*)(lds + PG8_SB(b, h) + boff + n * 2048 + k * 1024); } while (0)
#define PG8_MMA(ai, bj, At, Bt) do { __builtin_amdgcn_s_setprio(1); _Pragma("unroll") for (int m = 0; m < 4; ++m) _Pragma("unroll") for (int n = 0; n < 2; ++n) _Pragma("unroll") for (int k = 0; k < 2; ++k) \
        acc[ai][bj][m][n] = __builtin_amdgcn_mfma_f32_16x16x32_bf16(Bt[n][k], At[m][k], acc[ai][bj][m][n], 0, 0, 0); __builtin_amdgcn_s_setprio(0); } while (0)
#define PG8_WAIT_V(n) asm volatile("s_waitcnt vmcnt(" #n ")" ::: "memory")
#define PG8_WAIT_L(n) asm volatile("s_waitcnt lgkmcnt(" #n ")" ::: "memory")
#define PG8_BAR __builtin_amdgcn_s_barrier()
#define PG8_SCHED __builtin_amdgcn_sched_barrier(0)
    Unit cur, nxt; int ui = 0;
    if (S.next(0, cur)) {
    f32x4 acc[2][2][4][2];
#pragma unroll
    for (int a = 0; a < 2; ++a)
#pragma unroll
        for (int b = 0; b < 2; ++b)
#pragma unroll
            for (int m = 0; m < 4; ++m)
#pragma unroll
                for (int n = 0; n < 2; ++n) acc[a][b][m][n] = (f32x4){0.f, 0.f, 0.f, 0.f};
    bf16x8 At[4][2], B0[2][2], B1[2][2];
    const char* PAc[2][2]; const char* PAn[2][2];
    auto gather_ptrs = [&](const Unit& u, const char* (&PA)[2][2]) {
        if constexpr (Sched::GATHER) {
#pragma unroll
            for (int hh = 0; hh < 2; ++hh)
#pragma unroll
                for (int i = 0; i < 2; ++i) PA[hh][i] = (const char*)g.A + ((size_t)S.a_row(u, hh * 128 + RA[i]) * K + CA[i]) * 2;
        }
    };
    const char* cA = Sched::GATHER ? nullptr : S.a_tile(g, cur); const char* cB = S.b_tile(g, cur);
    gather_ptrs(cur, PAc);
    PG8_STAGE(PG8_SB(0, 0), cB, voffB); PG8_STAGE_A(PG8_SA(0, 0), cA, PAc, 0, 0); PG8_STAGE(PG8_SB(0, 1), cB + hstep, voffB); PG8_STAGE_A(PG8_SA(0, 1), cA, PAc, 1, 0);
    if (wr == 1) PG8_BAR;
    PG8_WAIT_V(4); PG8_BAR;
    PG8_STAGE(PG8_SB(1, 0), cB + kstep, voffB); PG8_STAGE_A(PG8_SA(1, 0), cA, PAc, 0, kstep); PG8_STAGE(PG8_SB(1, 1), cB + hstep + kstep, voffB);
    PG8_WAIT_V(6); PG8_BAR;
    for (;;) {
        const bool has_next = S.next(ui + 1, nxt);
        const char* nA = Sched::GATHER ? nullptr : (has_next ? S.a_tile(g, nxt) : cA); const char* nB = has_next ? S.b_tile(g, nxt) : cB;
        if (has_next) gather_ptrs(nxt, PAn); else { if constexpr (Sched::GATHER) { PAn[0][0] = PAc[0][0]; PAn[0][1] = PAc[0][1]; PAn[1][0] = PAc[1][0]; PAn[1][1] = PAc[1][1]; } }
        for (int t = 0; t < nt; t += 2) {
            const bool last = (t == nt - 2);
            const size_t k1 = (size_t)(t + 1) * kstep;
            const char* a2 = last ? nA : cA; const char* b2 = last ? nB : cB + (size_t)(t + 2) * kstep;
            const size_t k2 = last ? 0 : (size_t)(t + 2) * kstep, k3 = k2 + kstep;
            const char* b3 = b2 + kstep;
            const char* P2[2][2];
            if constexpr (Sched::GATHER) {
#pragma unroll
                for (int hh = 0; hh < 2; ++hh)
#pragma unroll
                    for (int i = 0; i < 2; ++i) P2[hh][i] = last ? PAn[hh][i] : PAc[hh][i];
            }
            PG8_LDB(B0, 0, 0); PG8_SCHED; PG8_LDA(At, 0, 0); PG8_STAGE_A(PG8_SA(1, 1), cA, PAc, 1, k1);
            PG8_WAIT_L(8); PG8_BAR; PG8_WAIT_L(0); PG8_MMA(0, 0, At, B0); PG8_BAR; PG8_SCHED;
            PG8_LDB(B1, 0, 1); PG8_STAGE(PG8_SB(0, 0), b2, voffB);
            PG8_BAR; PG8_WAIT_L(0); PG8_MMA(0, 1, At, B1); PG8_BAR;
            PG8_LDA(At, 0, 1); PG8_STAGE_A(PG8_SA(0, 0), a2, P2, 0, k2);
            PG8_BAR; PG8_WAIT_L(0); PG8_MMA(1, 0, At, B0); PG8_BAR; PG8_SCHED;
            PG8_STAGE(PG8_SB(0, 1), b2 + hstep, voffB);
            PG8_WAIT_V(6); PG8_BAR; PG8_MMA(1, 1, At, B1); PG8_BAR;
            PG8_LDB(B0, 1, 0); PG8_SCHED; PG8_LDA(At, 1, 0); PG8_STAGE_A(PG8_SA(0, 1), a2, P2, 1, k2);
            PG8_WAIT_L(8); PG8_BAR; PG8_WAIT_L(0); PG8_MMA(0, 0, At, B0); PG8_BAR; PG8_SCHED;
            PG8_LDB(B1, 1, 1); PG8_STAGE(PG8_SB(1, 0), b3, voffB);
            PG8_BAR; PG8_WAIT_L(0); PG8_MMA(0, 1, At, B1); PG8_BAR;
            PG8_LDA(At, 1, 1); PG8_STAGE_A(PG8_SA(1, 0), a2, P2, 0, k3);
            PG8_BAR; PG8_WAIT_L(0); PG8_MMA(1, 0, At, B0); PG8_BAR; PG8_SCHED;
            PG8_STAGE(PG8_SB(1, 1), b3 + hstep, voffB);
            PG8_WAIT_V(6); PG8_BAR; PG8_MMA(1, 1, At, B1); PG8_BAR;
        }
        E(acc, cur, wr, wc, fr, fq);
        if (!has_next) break;
#pragma unroll
        for (int a = 0; a < 2; ++a)
#pragma unroll
            for (int b = 0; b < 2; ++b)
#pragma unroll
                for (int m = 0; m < 4; ++m)
#pragma unroll
                    for (int n = 0; n < 2; ++n) acc[a][b][m][n] = (f32x4){0.f, 0.f, 0.f, 0.f};
        cur = nxt; cA = nA; cB = nB; ++ui;
        if constexpr (Sched::GATHER) { PAc[0][0] = PAn[0][0]; PAc[0][1] = PAn[0][1]; PAc[1][0] = PAn[1][0]; PAc[1][1] = PAn[1][1]; }
    }
    PG8_WAIT_V(0);
    if (wr == 0) PG8_BAR;
    PG8_BAR;
    }
    __syncthreads();
#undef PG8_SA
#undef PG8_SB
#undef PG8_STAGE
#undef PG8_STAGE_A
#undef PG8_LDA
#undef PG8_LDB
#undef PG8_MMA
#undef PG8_WAIT_V
#undef PG8_WAIT_L
#undef PG8_BAR
#undef PG8_SCHED
}
#endif
}

constexpr int G_BM = 256, G_BN = 128, G_BK = 64;
constexpr int G_LDS_A = G_BM * G_BK * 2, G_LDS_B = G_BN * G_BK * 2;
constexpr int G_STAGE_PITCH = 132;
constexpr int G_LDS_BYTES = G_BM * G_STAGE_PITCH * 4;
constexpr int G_MT = SEQ / 256 + 1, G_NTILES = 56;

DI void gemm_inproj_tile(const Params& p, char* smem, int mt, int nt) {
    const int tid = fresh_tid(), lane = tid & 63, wave = tid >> 6;
    const int wm = wave >> 1, wn = wave & 1, r32 = lane & 31, h = lane >> 5;
    unsigned char* ws = p.ws;
    const bool meta = (mt == G_MT - 1);
    const bf16* A = meta ? (const bf16*)(ws + OFF_SMALL + SM_UMETA) : (const bf16*)(ws + OFF_U) + (size_t)mt * 256 * D;
    const int vrows = meta ? NMETA : 256;
    const bf16* Bt = (const bf16*)(ws + OFF_WTIN) + (size_t)nt * 128 * D;
    char* ldsA[2] = {smem, smem + G_LDS_A + G_LDS_B};
    char* ldsB[2] = {smem + G_LDS_A, smem + 2 * G_LDS_A + G_LDS_B};
    f32x16 acc[2][2];
#pragma unroll
    for (int i = 0; i < 2; ++i)
#pragma unroll
        for (int j = 0; j < 2; ++j) acc[i][j] = zero16();
    const int lrow = tid >> 3, lc = tid & 7;
    u32x4 ra[4], rb[2];
    auto gload = [&](int kt) {
#pragma unroll
        for (int i = 0; i < 4; ++i) { const int row = lrow + 64 * i; ra[i] = row < vrows ? *(const u32x4*)(A + (size_t)row * D + kt * 64 + lc * 8) : (u32x4){0u, 0u, 0u, 0u}; }
#pragma unroll
        for (int i = 0; i < 2; ++i) { const int row = lrow + 64 * i; rb[i] = *(const u32x4*)(Bt + (size_t)row * D + kt * 64 + lc * 8); }
    };
    auto lstore = [&](int buf) {
#pragma unroll
        for (int i = 0; i < 4; ++i) *(u32x4*)(ldsA[buf] + swz128(lrow + 64 * i, lc)) = ra[i];
#pragma unroll
        for (int i = 0; i < 2; ++i) *(u32x4*)(ldsB[buf] + swz128(lrow + 64 * i, lc)) = rb[i];
    };
    gload(0); lstore(0); __syncthreads();
    for (int kt = 0; kt < 16; ++kt) {
        const int buf = kt & 1;
        if (kt + 1 < 16) gload(kt + 1);
#pragma unroll
        for (int ks = 0; ks < 4; ++ks) {
            bf16x8 af[2], bfr[2];
#pragma unroll
            for (int i = 0; i < 2; ++i) af[i] = *(const bf16x8*)(ldsA[buf] + swz128(64 * wm + 32 * i + r32, 2 * ks + h));
#pragma unroll
            for (int j = 0; j < 2; ++j) bfr[j] = *(const bf16x8*)(ldsB[buf] + swz128(64 * wn + 32 * j + r32, 2 * ks + h));
#pragma unroll
            for (int i = 0; i < 2; ++i)
#pragma unroll
                for (int j = 0; j < 2; ++j) acc[i][j] = MFMA32(af[i], bfr[j], acc[i][j]);
        }
        if (kt + 1 < 16) lstore(buf ^ 1);
        __syncthreads();
    }
    float* st = (float*)smem;
#pragma unroll
    for (int i = 0; i < 2; ++i)
#pragma unroll
        for (int j = 0; j < 2; ++j)
#pragma unroll
            for (int r = 0; r < 16; ++r) {
                const int row = 64 * wm + 32 * i + (r & 3) + 8 * (r >> 2) + 4 * h, col = 64 * wn + 32 * j + r32;
                st[row * G_STAGE_PITCH + col] = acc[i][j][r];
            }
    __syncthreads();
    const int tid2 = fresh_tid();
    const int sec = nt >> 3, cb = (nt & 7) * 128;
    {
        bf16* base; bool has_meta = true; bf16* mbase = nullptr; int mrow0 = 0;
        if (sec == 0) { base = (bf16*)(ws + OFF_AQ); has_meta = false; }
        else if (sec == 1) { base = (bf16*)p.out; mbase = (bf16*)(ws + OFF_SMALL + SM_AKMETA); }
        else if (sec == 2) { base = (bf16*)p.out + (size_t)SEQ * D; mbase = (bf16*)(ws + OFF_SMALL + SM_AVTMETA); }
        else if (sec == 3) { base = (bf16*)(ws + OFF_QN); mbase = (bf16*)(ws + OFF_SMALL + SM_C0Q); mrow0 = 48; }
        else if (sec == 4) { base = (bf16*)(ws + OFF_KN); mbase = (bf16*)(ws + OFF_SMALL + SM_C0K); mrow0 = 48; }
        else if (sec == 5) { base = (bf16*)(ws + OFF_V); mbase = (bf16*)(ws + OFF_SMALL + SM_C0V); mrow0 = 48; }
        else { base = (bf16*)(ws + OFF_DG); has_meta = false; }
        const bool dqkv = (sec >= 3 && sec <= 5);
        bf16* tails = (bf16*)(ws + OFF_SMALL + SM_TAILS);
        if (!meta || has_meta) {
#pragma unroll
            for (int i = 0; i < 8; ++i) {
                const int idx = tid2 + NT * i, row = idx >> 4, cg = idx & 15;
                if (row < vrows) {
                    const float* s = st + row * G_STAGE_PITCH + cg * 8;
                    const f32x4 a = *(const f32x4*)s, b = *(const f32x4*)(s + 4);
                    u32x4 o; o.x = pk2(a[0], a[1]); o.y = pk2(a[2], a[3]); o.z = pk2(b[0], b[1]); o.w = pk2(b[2], b[3]);
                    if (!meta) {
                        const int j = mt * 256 + row;
                        *(u32x4*)(base + (size_t)j * D + cb + cg * 8) = o;
                        if (dqkv && (j & 63) >= 61) *(u32x4*)(tails + ((size_t)(j / 64 + 1) * 3 + ((j & 63) - 61)) * 3072 + (sec - 3) * 1024 + cb + cg * 8) = o;
                    } else {
                        *(u32x4*)(mbase + (size_t)(mrow0 + row) * D + cb + cg * 8) = o;
                        if (dqkv && row >= 13) *(u32x4*)(tails + ((size_t)0 * 3 + (row - 13)) * 3072 + (sec - 3) * 1024 + cb + cg * 8) = o;
                    }
                }
            }
        }
    }
    __syncthreads();
}

struct EpiInproj {
    static constexpr bool PERM = true;
    unsigned char* ws; bf16* out16;
    DM void operator()(const f32x4 (&acc)[2][2][4][2], const pg8::Unit& u, int wr, int wc, int fr, int fq) const {
        const int colt = u.pn * 256, sec = colt >> 10, cb = colt & 1023;
        bf16* base = sec == 0 ? (bf16*)(ws + OFF_AQ) : sec == 1 ? out16 : sec == 2 ? out16 + (size_t)SEQ * D : sec == 3 ? (bf16*)(ws + OFF_QN) : sec == 4 ? (bf16*)(ws + OFF_KN)
                   : sec == 5 ? (bf16*)(ws + OFF_V) : (bf16*)(ws + OFF_DG);
        const bool dqkv = sec >= 3 && sec <= 5;
        bf16* tails = (bf16*)(ws + OFF_SMALL + SM_TAILS) + (sec - 3) * 1024;
        const int row0 = u.pm * 256 + wr * 64 + fr, col0 = cb + wc * 32 + 8 * fq;
#pragma unroll
        for (int ai = 0; ai < 2; ++ai)
#pragma unroll
            for (int m = 0; m < 4; ++m) {
                const int j = row0 + ai * 128 + m * 16;
                bf16* rowp = base + (size_t)j * D + col0;
                const bool tl = dqkv && (j & 63) >= 61;
#pragma unroll
                for (int bj = 0; bj < 2; ++bj) {
                    const f32x4 v0 = acc[ai][bj][m][0], v1 = acc[ai][bj][m][1];
                    const u32x4 w = {pk2(v0[0], v0[1]), pk2(v0[2], v0[3]), pk2(v1[0], v1[1]), pk2(v1[2], v1[3])};
                    *(u32x4*)(rowp + bj * 128) = w;
                    if (tl) *(u32x4*)(tails + ((size_t)(j / 64 + 1) * 3 + ((j & 63) - 61)) * 3072 + col0 + bj * 128) = w;
                }
            }
    }
};
DI void phase1(const Params& p, char* smem, int bid, int nblk) {
    for (int it = bid; it < 40; it += nblk) gemm_inproj_tile(p, smem, G_MT - 1, 8 + it);
    pg8::Gemm g{(const bf16*)(p.ws + OFF_U), (const bf16*)(p.ws + OFF_WTIN), SEQ, 7168, 1024};
    pg8::StaticOrder S; S.init(SEQ, 7168, nblk, bid);
    EpiInproj E{p.ws, (bf16*)p.out};
    pg8::gemm_phase(smem, g, S, E);
}

constexpr int P2_KN = 0, P2_KB = 16384, P2_QN = 32768, P2_KBGT = 49152, P2_VBT = 65536, P2_KDT = 81920, P2_ALDS = 98304, P2_TLDS = P2_ALDS + 64 * 64 * 4,
              P2_GC = P2_TLDS + 8192, P2_BET = P2_GC + 256, P2_EG = P2_BET + 256, P2_EKD = P2_EG + 256, P2_CW = P2_EKD + 256;

DI void prep_item(const Params& p, char* smem, int chunk, int head, int dry, bool load_cw) {
    const int tid = fresh_tid(), lane = tid & 63, wave = tid >> 6, r32 = lane & 31, h = lane >> 5;
    unsigned char* ws = p.ws;
    float* gcl = (float*)(smem + P2_GC); float* betl = (float*)(smem + P2_BET); float* egl = (float*)(smem + P2_EG); float* ekdl = (float*)(smem + P2_EKD);
    if (load_cw) {
        float* cwl = (float*)(smem + P2_CW);
        for (int i = tid; i < 4 * 3 * 128; i += NT) { const int jj = i / 384, rem = i % 384, mat = rem >> 7, c = rem & 127; cwl[i] = p.in[9][(size_t)jj * 3072 + mat * 1024 + head * 128 + c]; }
    }
    const int r = tid >> 3, cg = tid & 7, col0 = head * 128 + 16 * cg;
    const bf16* tails = (const bf16*)(ws + OFF_SMALL + SM_TAILS);
        u32x4 raw[3][4][2];
#pragma unroll
    for (int mat = 0; mat < 3; ++mat) {
        const bf16* mainb = (const bf16*)(ws + (mat == 0 ? OFF_QN : (mat == 1 ? OFF_KN : OFF_V)));
        const bf16* c0b = (const bf16*)(ws + OFF_SMALL + (mat == 0 ? SM_C0Q : (mat == 1 ? SM_C0K : SM_C0V)));
#pragma unroll
        for (int jj = 0; jj < 4; ++jj) {
            const int rr = r - 3 + jj;
            const bf16* src = nullptr;
            if (chunk == 0) { if (rr >= 48) src = c0b + (size_t)rr * D + col0; }
            else if (rr >= 0) src = mainb + ((size_t)(chunk - 1) * 64 + rr) * D + col0;
            else src = tails + ((size_t)(chunk - 1) * 3 + (3 + rr)) * 3072 + mat * 1024 + col0;
            raw[mat][jj][0] = (u32x4){0u, 0u, 0u, 0u}; raw[mat][jj][1] = (u32x4){0u, 0u, 0u, 0u};
            if (src) { raw[mat][jj][0] = *(const u32x4*)src; raw[mat][jj][1] = *(const u32x4*)(src + 8); }
        }
    }
    if (wave == 0) {
        const size_t pos = (size_t)chunk * 64 + lane;
        float v = ((const float*)(ws + OFF_SMALL + SM_G))[pos * 8 + head];
        const float b = ((const float*)(ws + OFF_SMALL + SM_BETA))[pos * 8 + head];
#pragma unroll
        for (int o = 1; o < 64; o <<= 1) { const float t = __shfl_up(v, o); if (lane >= o) v += t; }
        const float gl = __shfl(v, 63);
        gcl[lane] = v; betl[lane] = b; egl[lane] = __expf(v); ekdl[lane] = __expf(gl - v);
        if (!dry) ((float*)(ws + OFF_SMALL + SM_GC))[((size_t)chunk * 8 + head) * 64 + lane] = v;
    }
    __syncthreads();
    {
        const bool zero_row = (chunk == 0 && r < 48);
        const float beta = betl[r], eg = egl[r], ekd = ekdl[r];
#pragma unroll
        for (int mat = 0; mat < 3; ++mat) {
            bf16* mainb = (bf16*)(ws + (mat == 0 ? OFF_QN : (mat == 1 ? OFF_KN : OFF_V)));
            bf16* c0b = (bf16*)(ws + OFF_SMALL + (mat == 0 ? SM_C0Q : (mat == 1 ? SM_C0K : SM_C0V)));
            float y[16];
#pragma unroll
            for (int c = 0; c < 16; ++c) y[c] = 0.f;
#pragma unroll
            for (int jj = 0; jj < 4; ++jj) {
                const u32x4 a = raw[mat][jj][0], b = raw[mat][jj][1];
                const float* cw = (const float*)(smem + P2_CW) + (jj * 3 + mat) * 128 + 16 * cg;
                const f32x4 w0 = *(const f32x4*)cw, w1 = *(const f32x4*)(cw + 4), w2 = *(const f32x4*)(cw + 8), w3 = *(const f32x4*)(cw + 12);
                y[0] += w0[0] * bflo(a.x); y[1] += w0[1] * bfhi(a.x); y[2] += w0[2] * bflo(a.y); y[3] += w0[3] * bfhi(a.y);
                y[4] += w1[0] * bflo(a.z); y[5] += w1[1] * bfhi(a.z); y[6] += w1[2] * bflo(a.w); y[7] += w1[3] * bfhi(a.w);
                y[8] += w2[0] * bflo(b.x); y[9] += w2[1] * bfhi(b.x); y[10] += w2[2] * bflo(b.y); y[11] += w2[3] * bfhi(b.y);
                y[12] += w3[0] * bflo(b.z); y[13] += w3[1] * bfhi(b.z); y[14] += w3[2] * bflo(b.w); y[15] += w3[3] * bfhi(b.w);
            }
            if (mat == 0) __syncthreads();
            float ss = 0.f;
#pragma unroll
            for (int c = 0; c < 16; ++c) { y[c] = zero_row ? 0.f : siluf_(y[c]); ss += y[c] * y[c]; }
            if (mat < 2) {
                ss += __shfl_xor(ss, 1); ss += __shfl_xor(ss, 2); ss += __shfl_xor(ss, 4);
                const float sc = rsqrtf(ss + 1e-6f) * (mat == 0 ? 0.08838834764831845f : 1.0f);
                unsigned pk[8];
#pragma unroll
                for (int c = 0; c < 8; ++c) pk[c] = pk2(y[2 * c] * sc, y[2 * c + 1] * sc);
                if (mat == 0) {
                    *(u32x4*)(smem + P2_QN + swzrow(r, 256, 2 * cg)) = (u32x4){pk[0], pk[1], pk[2], pk[3]};
                    *(u32x4*)(smem + P2_QN + swzrow(r, 256, 2 * cg + 1)) = (u32x4){pk[4], pk[5], pk[6], pk[7]};
                    unsigned qd[8];
#pragma unroll
                    for (int c = 0; c < 8; ++c) qd[c] = pk2(bflo(pk[c]) * eg, bfhi(pk[c]) * eg);
                    bf16* dst = (chunk == 0) ? c0b + (size_t)r * D + col0 : mainb + ((size_t)(chunk - 1) * 64 + r) * D + col0;
                    if (!dry) { *(u32x4*)dst = (u32x4){qd[0], qd[1], qd[2], qd[3]}; *(u32x4*)(dst + 8) = (u32x4){qd[4], qd[5], qd[6], qd[7]}; }
                } else {
                    *(u32x4*)(smem + P2_KN + swzrow(r, 256, 2 * cg)) = (u32x4){pk[0], pk[1], pk[2], pk[3]};
                    *(u32x4*)(smem + P2_KN + swzrow(r, 256, 2 * cg + 1)) = (u32x4){pk[4], pk[5], pk[6], pk[7]};
                    unsigned kb[8];
#pragma unroll
                    for (int c = 0; c < 8; ++c) {
                        const float kr0 = bflo(pk[c]), kr1 = bfhi(pk[c]);
                        const float k0 = kr0 * beta, k1 = kr1 * beta;
                        kb[c] = pk2(k0, k1);
                        const int d0 = 16 * cg + 2 * c;
                        *(bf16*)(smem + P2_KBGT + swz128t(d0, r >> 3) + (r & 7) * 2) = (bf16)f2bf(k0 * eg);
                        *(bf16*)(smem + P2_KBGT + swz128t(d0 + 1, r >> 3) + (r & 7) * 2) = (bf16)f2bf(k1 * eg);
                        *(bf16*)(smem + P2_KDT + swz128t(d0, r >> 3) + (r & 7) * 2) = (bf16)f2bf(kr0 * ekd);
                        *(bf16*)(smem + P2_KDT + swz128t(d0 + 1, r >> 3) + (r & 7) * 2) = (bf16)f2bf(kr1 * ekd);
                    }
                    *(u32x4*)(smem + P2_KB + swzrow(r, 256, 2 * cg)) = (u32x4){kb[0], kb[1], kb[2], kb[3]};
                    *(u32x4*)(smem + P2_KB + swzrow(r, 256, 2 * cg + 1)) = (u32x4){kb[4], kb[5], kb[6], kb[7]};
                }
            } else {
#pragma unroll
                for (int c = 0; c < 16; ++c) {
                    const int e = 16 * cg + c;
                    *(bf16*)(smem + P2_VBT + swz128t(e, r >> 3) + (r & 7) * 2) = (bf16)f2bf(y[c] * beta);
                }
            }
        }
    }
    __syncthreads();
    {
        const int tile = wave & 3, m0 = tile >> 1, n0 = tile & 1;
        f32x16 acc = zero16();
        if (wave < 4) {
            if (n0 <= m0) {
#pragma unroll
                for (int ks = 0; ks < 8; ++ks) {
                    const bf16x8 a = *(const bf16x8*)(smem + P2_KB + swzrow(32 * m0 + r32, 256, 2 * ks + h));
                    const bf16x8 b = *(const bf16x8*)(smem + P2_KN + swzrow(32 * n0 + r32, 256, 2 * ks + h));
                    acc = MFMA32(a, b, acc);
                }
            }
            float* Al = (float*)(smem + P2_ALDS);
            const int j = 32 * n0 + r32; const float gj = gcl[j];
#pragma unroll
            for (int r = 0; r < 16; ++r) {
                const int i = 32 * m0 + (r & 3) + 8 * (r >> 2) + 4 * h;
                const float dv = acc[r] * __expf(gcl[i] - gj);
                Al[i * 64 + (j & 3) * 16 + (j >> 2)] = (j < i) ? dv : 0.f;
            }
        } else {
            if (m0 <= n0) {
#pragma unroll
                for (int ks = 0; ks < 8; ++ks) {
                    const bf16x8 a = *(const bf16x8*)(smem + P2_KN + swzrow(32 * m0 + r32, 256, 2 * ks + h));
                    const bf16x8 b = *(const bf16x8*)(smem + P2_QN + swzrow(32 * n0 + r32, 256, 2 * ks + h));
                    acc = MFMA32(a, b, acc);
                }
            }
            const int i = 32 * n0 + r32; const float gi = gcl[i];
            bf16* qkb = (chunk == 0) ? (bf16*)(ws + OFF_SMALL + SM_C0QK) + (size_t)head * 4096 : (bf16*)(ws + OFF_QKB) + ((size_t)(chunk - 1) * 8 + head) * 4096;
#pragma unroll
            for (int q4 = 0; q4 < 4; ++q4) {
                const int j0 = 32 * m0 + 8 * q4 + 4 * h; float v[4];
#pragma unroll
                for (int c = 0; c < 4; ++c) { const int j = j0 + c; const float dv = acc[4 * q4 + c] * __expf(gi - gcl[j]); v[c] = (j <= i) ? dv : 0.f; }
                if (!dry) *(u32x2*)(qkb + i * 64 + j0) = (u32x2){pk2(v[0], v[1]), pk2(v[2], v[3])};
            }
        }
        bf16* kbase = (chunk == 0) ? (bf16*)(ws + OFF_SMALL + SM_C0K) : (bf16*)(ws + OFF_KN) + (size_t)(chunk - 1) * 64 * D;
#pragma unroll
        for (int i2 = 0; i2 < 2; ++i2) {
            const int idx = tid + NT * i2, dk = idx >> 3, ch = idx & 7;
            const u32x4 v = *(const u32x4*)(smem + P2_KDT + swz128t(dk, ch));
            if (!dry) *(u32x4*)(kbase + (size_t)(dk >> 1) * D + head * 128 + (dk & 1) * 64 + ch * 8) = v;
        }
    }
    __syncthreads();
    if (wave < 4) {
        const float* Al = (const float*)(smem + P2_ALDS);
        const int c = lane >> 2, q = lane & 3, C = 16 * wave + c;
        float tq[16];
#pragma unroll
        for (int m = 0; m < 16; ++m) tq[m] = 0.f;
#pragma unroll
        for (int i = 0; i < 64; ++i) {
            constexpr int dummy = 0; (void)dummy;
            const int nm = (i + 3) >> 2;
            float s0 = 0.f, s1 = 0.f;
            const float* ar = Al + i * 64 + q * 16;
#pragma unroll
            for (int m = 0; m < 16; ++m) if (m < nm) { if (m & 1) s1 += ar[m] * tq[m]; else s0 += ar[m] * tq[m]; }
            float s = s0 + s1;
            s += __shfl_xor(s, 1); s += __shfl_xor(s, 2);
            const float ti = ((i == C) ? 1.f : 0.f) - s;
            if (q == (i & 3)) tq[i >> 2] = ti;
        }
#pragma unroll
        for (int m = 0; m < 16; ++m) { const int row = 4 * m + q; *(bf16*)(smem + P2_TLDS + swz128(row, C >> 3) + (C & 7) * 2) = (bf16)f2bf(tq[m]); }
    }
    __syncthreads();
    {
        const int mi = wave >> 2, ni = wave & 3;
        f32x16 acc = zero16();
#pragma unroll
        for (int ks = 0; ks < 4; ++ks) {
            const bf16x8 a = *(const bf16x8*)(smem + P2_TLDS + swz128(32 * mi + r32, 2 * ks + h));
            const bf16x8 b = *(const bf16x8*)(smem + P2_VBT + swz128t(32 * ni + r32, 2 * ks + h));
            acc = MFMA32(a, b, acc);
        }
        const int e = 32 * ni + r32;
        bf16* base = (chunk == 0) ? (bf16*)(ws + OFF_SMALL + SM_C0V) : (bf16*)(ws + OFF_V) + (size_t)(chunk - 1) * 64 * D;
        bf16* dst = base + (size_t)(e >> 1) * D + head * 128 + (e & 1) * 64;
#pragma unroll
        for (int q4 = 0; q4 < 4; ++q4) {
            const int c0 = 32 * mi + 8 * q4 + 4 * h;
            if (!dry) *(u32x2*)(dst + c0) = (u32x2){pk2(acc[4 * q4], acc[4 * q4 + 1]), pk2(acc[4 * q4 + 2], acc[4 * q4 + 3])};
        }
    }
    {
        const int mi = wave >> 1, ni = wave & 1;
        f32x16 acc = zero16();
#pragma unroll
        for (int ks = 0; ks < 4; ++ks) {
            const bf16x8 a = *(const bf16x8*)(smem + P2_KBGT + swz128t(32 * mi + r32, 2 * ks + h));
            const bf16x8 b = *(const bf16x8*)(smem + P2_TLDS + swz128(32 * ni + r32, 2 * ks + h));
            acc = MFMA32(a, b, acc);
        }
        const int c = 32 * ni + r32;
        bf16* wb = (chunk == 0) ? (bf16*)(ws + OFF_SMALL + SM_C0W) + (size_t)head * 8192 : (bf16*)(ws + OFF_W) + ((size_t)(chunk - 1) * 8 + head) * 8192;
#pragma unroll
        for (int q4 = 0; q4 < 4; ++q4) {
            const int dk0 = 32 * mi + 8 * q4 + 4 * h;
            if (!dry) *(u32x2*)(wb + c * 128 + dk0) = (u32x2){pk2(acc[4 * q4], acc[4 * q4 + 1]), pk2(acc[4 * q4 + 2], acc[4 * q4 + 3])};
        }
    }
    __syncthreads();
}

DI void phase2(const Params& p, char* smem, int bid, int nblk, int dry = 0) {
    { int cur_head = -1; for (int it = bid; it < NCH * 8; it += nblk) { const int hd = it & 7; prep_item(p, smem, it >> 3, hd, dry, hd != cur_head); cur_head = hd; } }
    {
        const int tid = fresh_tid(), lane = tid & 63, wave = tid >> 6;
        const int nextra = (NCH * 8) % nblk, skip = (nextra > 0 && 2 * nextra < nblk) ? nextra : 0;
        const int gw = (bid - skip) * 8 + wave, NGW = (nblk - skip) * 8;
        float mq = 0.f, mk = 0.f;
        auto sq16 = [](const u32x4& a, const u32x4& b) -> float {
            return bflo(a.x) * bflo(a.x) + bfhi(a.x) * bfhi(a.x) + bflo(a.y) * bflo(a.y) + bfhi(a.y) * bfhi(a.y) + bflo(a.z) * bflo(a.z) + bfhi(a.z) * bfhi(a.z) + bflo(a.w) * bflo(a.w) + bfhi(a.w) * bfhi(a.w)
                 + bflo(b.x) * bflo(b.x) + bfhi(b.x) * bfhi(b.x) + bflo(b.y) * bflo(b.y) + bfhi(b.y) * bfhi(b.y) + bflo(b.z) * bflo(b.z) + bfhi(b.z) * bfhi(b.z) + bflo(b.w) * bflo(b.w) + bfhi(b.w) * bfhi(b.w); };
        for (int j0 = (bid < skip ? SEQ + NMETA : gw); j0 < SEQ + NMETA; j0 += 4 * NGW) {
            u32x4 ka[4][2], qa[4][2];
#pragma unroll
            for (int u4 = 0; u4 < 4; ++u4) {
                const int j = j0 + u4 * NGW;
                ka[u4][0] = ka[u4][1] = qa[u4][0] = qa[u4][1] = (u32x4){0u, 0u, 0u, 0u};
                if (j < SEQ + NMETA) {
                    const bf16* kr = j < SEQ ? (const bf16*)p.out + (size_t)j * D + lane * 16 : (const bf16*)(p.ws + OFF_SMALL + SM_AKMETA) + (size_t)(j - SEQ) * D + lane * 16;
                    ka[u4][0] = *(const u32x4*)kr; ka[u4][1] = *(const u32x4*)(kr + 8);
                    if (j < SEQ) { const bf16* qr = (const bf16*)(p.ws + OFF_AQ) + (size_t)j * D + lane * 16; qa[u4][0] = *(const u32x4*)qr; qa[u4][1] = *(const u32x4*)(qr + 8); }
                }
            }
#pragma unroll
            for (int u4 = 0; u4 < 4; ++u4) {
                float s = sq16(ka[u4][0], ka[u4][1]), t = sq16(qa[u4][0], qa[u4][1]);
                s += __shfl_xor(s, 1); s += __shfl_xor(s, 2); t += __shfl_xor(t, 1); t += __shfl_xor(t, 2);
                mk = fmaxf(mk, s); mq = fmaxf(mq, t);
            }
        }
        float* red = (float*)smem;
        __syncthreads();
        if ((lane & 3) == 0) { red[wave * 32 + (lane >> 2)] = mq; red[wave * 32 + 16 + (lane >> 2)] = mk; }
        __syncthreads();
        if (tid < 32) {
            float m = 0.f;
#pragma unroll
            for (int w = 0; w < 8; ++w) m = fmaxf(m, red[w * 32 + tid]);
            unsigned* nrm = (unsigned*)(p.ws + OFF_SMALL + SM_CTL) + CW_NRM;
            atomicMax(nrm + tid, __builtin_bit_cast(unsigned, m));
        }
        __syncthreads();
    }
}

DI int swzrow8(int row, int pitch, int s) { return row * pitch + ((((s >> 1) ^ (row & 15)) << 4) | ((s & 1) << 3)); }
DI bf16x8 pack8(f32x4 a, f32x4 b) {
    u32x4 o; o.x = pk2(a[0], a[1]); o.y = pk2(a[2], a[3]); o.z = pk2(b[0], b[1]); o.w = pk2(b[2], b[3]);
    return __builtin_bit_cast(bf16x8, o);
}
DI bf16x8 ld2x8(const char* p0, const char* p1) {
    const u32x2 a = *(const u32x2*)p0, b = *(const u32x2*)p1; u32x4 o; o.x = a.x; o.y = a.y; o.z = b.x; o.w = b.y;
    return __builtin_bit_cast(bf16x8, o);
}
constexpr int SC_W = 0, SC_QD = 16384, SC_KDT = 32768, SC_QK = 49152, SC_BUF = 57344;

constexpr int SCAN_SPLIT = 2;
DI void scan_head(const Params& p, char* smem, int head, int sidx, int dry) {
    const int tid = fresh_tid(), lane = tid & 63, wave = tid >> 6, r16 = lane & 15, g = lane >> 4;
    const bool active = wave < 8 / SCAN_SPLIT; const int slice = sidx * (8 / SCAN_SPLIT) + (active ? wave : 0);
    unsigned char* ws = p.ws;
    const int lrow = tid >> 3, lch = (tid & 7) * 2;
    f32x4 S[8];
#pragma unroll
    for (int i = 0; i < 8; ++i) S[i] = zero4();
    u32x4 rw[2], rq[2], rk[2], rqk; u32x2 unext[4], ucur[4]; float gnext = 0.f, gcur = 0.f;
    auto uaddr = [&](int n, int mt) -> bf16* {
        const int e = 16 * slice + r16;
        bf16* base = n == 0 ? (bf16*)(ws + OFF_SMALL + SM_C0V) : (bf16*)(ws + OFF_V) + (size_t)(n - 1) * 64 * D;
        return base + (size_t)(e >> 1) * D + head * 128 + (e & 1) * 64 + 16 * mt + 4 * g;
    };
    auto gloadA = [&](int n) {
        const bf16* wsrc = (n == 0 ? (const bf16*)(ws + OFF_SMALL + SM_C0W) + (size_t)head * 8192 : (const bf16*)(ws + OFF_W) + ((size_t)(n - 1) * 8 + head) * 8192) + lrow * 128 + lch * 8;
        rw[0] = *(const u32x4*)wsrc; rw[1] = *(const u32x4*)(wsrc + 8);
        const bf16* qs = (n == 0 ? (const bf16*)(ws + OFF_SMALL + SM_C0Q) : (const bf16*)(ws + OFF_QN) + (size_t)(n - 1) * 64 * D) + (size_t)lrow * D + head * 128 + lch * 8;
        rq[0] = *(const u32x4*)qs; rq[1] = *(const u32x4*)(qs + 8);
        const bf16* ks = (n == 0 ? (const bf16*)(ws + OFF_SMALL + SM_C0K) : (const bf16*)(ws + OFF_KN) + (size_t)(n - 1) * 64 * D) + (size_t)lrow * D + head * 128 + lch * 8;
        rk[0] = *(const u32x4*)ks; rk[1] = *(const u32x4*)(ks + 8);
        const bf16* qk = (n == 0 ? (const bf16*)(ws + OFF_SMALL + SM_C0QK) + (size_t)head * 4096 : (const bf16*)(ws + OFF_QKB) + ((size_t)(n - 1) * 8 + head) * 4096) + tid * 8;
        rqk = *(const u32x4*)qk;
    };
    auto gloadU = [&](int n) {
#pragma unroll
        for (int mt = 0; mt < 4; ++mt) unext[mt] = *(const u32x2*)uaddr(n, mt);
        gnext = ((const float*)(ws + OFF_SMALL + SM_GC))[((size_t)n * 8 + head) * 64 + 63];
    };
    auto lwrite = [&](int buf) {
        char* b = smem + buf * SC_BUF;
        const int c7 = tid & 7, kb = c7 >> 1, hf = c7 & 1;
        {
            char* w = b + SC_W + lrow * 256 + hf * 8; char* q = b + SC_QD + lrow * 256 + hf * 8; const int x = lrow & 15;
            *(u32x2*)(w + (((4 * kb + 0) ^ x) << 4)) = (u32x2){rw[0].x, rw[0].y}; *(u32x2*)(w + (((4 * kb + 1) ^ x) << 4)) = (u32x2){rw[0].z, rw[0].w};
            *(u32x2*)(w + (((4 * kb + 2) ^ x) << 4)) = (u32x2){rw[1].x, rw[1].y}; *(u32x2*)(w + (((4 * kb + 3) ^ x) << 4)) = (u32x2){rw[1].z, rw[1].w};
            *(u32x2*)(q + (((4 * kb + 0) ^ x) << 4)) = (u32x2){rq[0].x, rq[0].y}; *(u32x2*)(q + (((4 * kb + 1) ^ x) << 4)) = (u32x2){rq[0].z, rq[0].w};
            *(u32x2*)(q + (((4 * kb + 2) ^ x) << 4)) = (u32x2){rq[1].x, rq[1].y}; *(u32x2*)(q + (((4 * kb + 3) ^ x) << 4)) = (u32x2){rq[1].z, rq[1].w};
        }
        {
            const int dk = 2 * lrow + (c7 >> 2), kb2 = (c7 & 3) >> 1, x = (dk >> 1) & 7;
            char* kt = b + SC_KDT + dk * 128 + hf * 8;
            *(u32x2*)(kt + (((4 * kb2 + 0) ^ x) << 4)) = (u32x2){rk[0].x, rk[0].y}; *(u32x2*)(kt + (((4 * kb2 + 1) ^ x) << 4)) = (u32x2){rk[0].z, rk[0].w};
            *(u32x2*)(kt + (((4 * kb2 + 2) ^ x) << 4)) = (u32x2){rk[1].x, rk[1].y}; *(u32x2*)(kt + (((4 * kb2 + 3) ^ x) << 4)) = (u32x2){rk[1].z, rk[1].w};
        }
        {
            const int row = tid >> 3, kb2 = c7 >> 2, g0 = 2 * (c7 & 1), hf2 = (c7 >> 1) & 1, x = (row >> 1) & 7;
            char* qk = b + SC_QK + row * 128 + hf2 * 8;
            *(u32x2*)(qk + (((4 * kb2 + g0) ^ x) << 4)) = (u32x2){rqk.x, rqk.y}; *(u32x2*)(qk + (((4 * kb2 + g0 + 1) ^ x) << 4)) = (u32x2){rqk.z, rqk.w};
        }
    };
    gloadA(0); gloadU(0);
    lwrite(0);
#pragma unroll
    for (int mt = 0; mt < 4; ++mt) ucur[mt] = unext[mt];
    gcur = gnext;
    if (NCH > 1) gloadA(1);
    __syncthreads();
    for (int n = 0; n < NCH; ++n) {
        const char* b = smem + (n & 1) * SC_BUF;
        if (n + 1 < NCH) { lwrite((n + 1) & 1); gloadU(n + 1); }
        if (n + 2 < NCH) gloadA(n + 2);
        if (active) {
        const float gtot = __expf(gcur);
        bf16x8 sf[4];
#pragma unroll
        for (int kb = 0; kb < 4; ++kb) sf[kb] = pack8(S[2 * kb], S[2 * kb + 1]);
        f32x4 Vn[4], O[4];
#pragma unroll
        for (int mt = 0; mt < 4; ++mt) {
            f32x4 P = zero4(), Q = zero4();
            const int row = 16 * mt + r16;
#pragma unroll
            for (int kb = 0; kb < 4; ++kb) {
                const bf16x8 wf = *(const bf16x8*)(b + SC_W + swzrow(row, 256, 4 * kb + g));
                const bf16x8 qf = *(const bf16x8*)(b + SC_QD + swzrow(row, 256, 4 * kb + g));
                P = MFMA16(wf, sf[kb], P);
                Q = MFMA16(qf, sf[kb], Q);
            }
            const float u0 = bflo(ucur[mt].x), u1 = bfhi(ucur[mt].x), u2 = bflo(ucur[mt].y), u3 = bfhi(ucur[mt].y);
            Vn[mt] = (f32x4){u0 - P[0], u1 - P[1], u2 - P[2], u3 - P[3]};
            O[mt] = Q;
        }
        const bf16x8 vf[2] = {pack8(Vn[0], Vn[1]), pack8(Vn[2], Vn[3])};
#pragma unroll
        for (int mt = 0; mt < 8; ++mt) {
            const int row = 16 * mt + r16;
            f32x4 acc = S[mt] * gtot;
#pragma unroll
            for (int kb = 0; kb < 2; ++kb) {
                const bf16x8 kf = *(const bf16x8*)(b + SC_KDT + swz128(row, 4 * kb + g));
                acc = MFMA16(kf, vf[kb], acc);
            }
            S[mt] = acc;
        }
#pragma unroll
        for (int mt = 0; mt < 4; ++mt) {
            const int row = 16 * mt + r16;
#pragma unroll
            for (int kb = 0; kb < 2; ++kb) {
                const bf16x8 qk = *(const bf16x8*)(b + SC_QK + swz128(row, 4 * kb + g));
                O[mt] = MFMA16(qk, vf[kb], O[mt]);
            }
            if (n >= 1 && !dry) *(u32x2*)uaddr(n, mt) = (u32x2){pk2(O[mt][0], O[mt][1]), pk2(O[mt][2], O[mt][3])};
        }
        }
#pragma unroll
        for (int mt = 0; mt < 4; ++mt) ucur[mt] = unext[mt];
        gcur = gnext;
        __syncthreads();
    }
}

constexpr int AT_BUF = 32768, AT_MISC = 65536, NQB = SEQ / 128, AT_UNITS = 8 * NQB;
DI int vt_off8(int e, int s) { return e * 128 + ((s ^ ((e >> 1) & 15)) << 3); }

DI void attention_unit(const Params& p, char* smem, int head, int qb, float lam, int dry, float bound) {
    const int tid = fresh_tid(), lane = tid & 63, wave = tid >> 6, r32 = lane & 31, h = lane >> 5;
    const int wq = wave & 3, mp = wave >> 2;
    unsigned char* ws = p.ws;
    const bf16* AK = (const bf16*)p.out; const bf16* AVT = (const bf16*)p.out + (size_t)SEQ * D;
    const int q0 = 128 * qb, qpos = q0 + 32 * wq + r32;
    const float c1 = 0.125f * LOG2E, c2 = exp2f(-(float)(head + 1)) * LOG2E;
    bf16x8 Qf[4];
    {
        const bf16* qsrc = (const bf16*)(ws + OFF_AQ) + (size_t)qpos * D + head * 128 + mp * 64 + 8 * h;
#pragma unroll
        for (int ks = 0; ks < 4; ++ks) {
            const u32x4 v = *(const u32x4*)(qsrc + 16 * ks); u32x4 o;
            o.x = pk2(bflo(v.x) * c1, bfhi(v.x) * c1); o.y = pk2(bflo(v.y) * c1, bfhi(v.y) * c1); o.z = pk2(bflo(v.z) * c1, bfhi(v.z) * c1); o.w = pk2(bflo(v.w) * c1, bfhi(v.w) * c1);
            Qf[ks] = __builtin_bit_cast(bf16x8, o);
        }
    }
    f32x16 O[4];
#pragma unroll
    for (int i = 0; i < 4; ++i) O[i] = zero16();
    float l_run = 0.f; const float mfix = fminf(bound, 40.0f);
    const float wdist = (150.0f + 2.0f * bound) / c2;
    int ntiles = 2 * qb + 3;
    {
        const float lim = (float)q0 - 63.0f - wdist;
        int ktmin = 0;
        if (lim > 0.f) ktmin = (int)(lim * (1.0f / 64.0f));
        const bool keep_meta = !((float)(q0 + NMETA - 15) > wdist);
        if (ktmin > 0 || !keep_meta) ntiles = (2 * qb + 1 - ktmin + 1) + (keep_meta ? 1 : 0);
    }
    const int nreal = (ntiles == 2 * qb + 3) ? 2 * qb + 2 : ntiles;
    const int kkey = tid >> 3, kcc = (tid & 7) * 2;
    const int va = tid >> 5, vb4 = tid & 31;
    u32x4 rk[2]; u32x2 rv[4];
    auto tile_kt = [&](int it) -> int { return it < nreal ? 2 * qb + 1 - it : -1; };
    auto gload = [&](int it) {
        const int kt = tile_kt(it);
        if (kt >= 0) {
            const bf16* ks = AK + ((size_t)kt * 64 + kkey) * D + head * 128 + kcc * 8;
            rk[0] = *(const u32x4*)ks; rk[1] = *(const u32x4*)(ks + 8);
            const bf16* vs = AVT + ((size_t)kt * 64 + 4 * va) * D + head * 128 + 4 * vb4;
#pragma unroll
            for (int i = 0; i < 4; ++i) rv[i] = *(const u32x2*)(vs + (size_t)i * D);
        } else {
            rk[0] = rk[1] = (u32x4){0u, 0u, 0u, 0u};
#pragma unroll
            for (int i = 0; i < 4; ++i) rv[i] = (u32x2){0u, 0u};
            if (kkey < NMETA) { const bf16* ks = (const bf16*)(ws + OFF_SMALL + SM_AKMETA) + (size_t)kkey * D + head * 128 + kcc * 8; rk[0] = *(const u32x4*)ks; rk[1] = *(const u32x4*)(ks + 8); }
            if (va < NMETA / 4) { const bf16* vs = (const bf16*)(ws + OFF_SMALL + SM_AVTMETA) + (size_t)(4 * va) * D + head * 128 + 4 * vb4;
#pragma unroll
                for (int i = 0; i < 4; ++i) rv[i] = *(const u32x2*)(vs + (size_t)i * D); }
        }
    };
    auto lwrite = [&](int buf) {
        char* kb = smem + buf * AT_BUF + (kcc >> 3) * 8192;
        *(u32x4*)(kb + swz128(kkey, kcc & 7)) = rk[0]; *(u32x4*)(kb + swz128(kkey, (kcc & 7) + 1)) = rk[1];
        const unsigned t0x = (rv[0].x & 0xffffu) | (rv[1].x << 16), t1x = (rv[0].x >> 16) | (rv[1].x & 0xffff0000u), t0y = (rv[2].x & 0xffffu) | (rv[3].x << 16), t1y = (rv[2].x >> 16) | (rv[3].x & 0xffff0000u);
        const unsigned t2x = (rv[0].y & 0xffffu) | (rv[1].y << 16), t3x = (rv[0].y >> 16) | (rv[1].y & 0xffff0000u), t2y = (rv[2].y & 0xffffu) | (rv[3].y << 16), t3y = (rv[2].y >> 16) | (rv[3].y & 0xffff0000u);
        const int sub = va >> 3, a = va & 7, a2 = (a & 4) | ((a & 1) << 1) | ((a >> 1) & 1);
        char* vbase = smem + buf * AT_BUF + 16384 + (a2 & 1) * 8;
        const int s16 = 4 * sub + (a2 >> 1), e0 = 4 * vb4;
        *(u32x2*)(vbase + (e0 + 0) * 128 + ((s16 ^ (((e0 + 0) >> 1) & 7)) << 4)) = (u32x2){t0x, t0y};
        *(u32x2*)(vbase + (e0 + 1) * 128 + ((s16 ^ (((e0 + 1) >> 1) & 7)) << 4)) = (u32x2){t1x, t1y};
        *(u32x2*)(vbase + (e0 + 2) * 128 + ((s16 ^ (((e0 + 2) >> 1) & 7)) << 4)) = (u32x2){t2x, t2y};
        *(u32x2*)(vbase + (e0 + 3) * 128 + ((s16 ^ (((e0 + 3) >> 1) & 7)) << 4)) = (u32x2){t3x, t3y};
    };
    auto tile_body = [&](auto mode_tag, int buf, int kdist0, int klim) {
        constexpr bool MASKED = decltype(mode_tag)::value;
        const char* kb = smem + buf * AT_BUF + mp * 8192;
        const char* vb = smem + buf * AT_BUF + 16384;
        f32x16 s[2];
#pragma unroll
        for (int sub = 0; sub < 2; ++sub) {
            f32x16 acc;
            const float base = -c2 * (float)(kdist0 - 32 * sub - 4 * h) - mfix;
#pragma unroll
            for (int r = 0; r < 16; ++r) acc[r] = base + c2 * (float)((r & 3) + 8 * (r >> 2));
#pragma unroll
            for (int ks = 0; ks < 4; ++ks) {
                const bf16x8 a = *(const bf16x8*)(kb + swz128(32 * sub + r32, 2 * ks + h));
                acc = MFMA32(a, Qf[ks], acc);
            }
            if (MASKED) {
#pragma unroll
                for (int r = 0; r < 16; ++r) { const int key = 32 * sub + (r & 3) + 8 * (r >> 2) + 4 * h; if (key > klim) acc[r] = -1e30f; }
            }
            s[sub] = acc;
        }
        float ls = 0.f;
#pragma unroll
        for (int sub = 0; sub < 2; ++sub) {
#pragma unroll
            for (int r = 0; r < 16; ++r) { const float pv = EXP2F(s[sub][r]); s[sub][r] = pv; ls += pv; }
            bf16x8 Pf[2];
#pragma unroll
            for (int ss = 0; ss < 2; ++ss) {
                u32x4 o; o.x = pk2(s[sub][8 * ss], s[sub][8 * ss + 1]); o.y = pk2(s[sub][8 * ss + 2], s[sub][8 * ss + 3]);
                o.z = pk2(s[sub][8 * ss + 4], s[sub][8 * ss + 5]); o.w = pk2(s[sub][8 * ss + 6], s[sub][8 * ss + 7]);
                Pf[ss] = __builtin_bit_cast(bf16x8, o);
            }
#pragma unroll
            for (int et = 0; et < 4; ++et) {
                const int e = 32 * et + r32;
#pragma unroll
                for (int ss = 0; ss < 2; ++ss) {
                    const bf16x8 a = *(const bf16x8*)(vb + swz128(e, 4 * sub + 2 * ss + h));
                    O[et] = MFMA32(a, Pf[ss], O[et]);
                }
            }
            SCHED_FENCE();
        }
        l_run += ls;
    };
    gload(0); lwrite(0); __syncthreads();
    for (int it = 0; it < ntiles; ++it) {
        const int buf = it & 1, kt = tile_kt(it);
        if (it + 1 < ntiles) gload(it + 1);
        const int k0 = kt * 64;
        if (kt >= 0 && k0 > q0 + 32 * wq + 31) {   }
        else if (kt >= 0 && k0 + 63 <= q0 + 32 * wq) tile_body(std::false_type{}, buf, qpos - k0, 0);
        else tile_body(std::true_type{}, buf, kt < 0 ? NMETA + qpos : qpos - k0, kt < 0 ? NMETA - 1 : qpos - k0);
        if (it + 1 < ntiles) lwrite(buf ^ 1);
        __syncthreads();
    }
    {
        const int tid = fresh_tid(), lane = tid & 63, wave = tid >> 6, r32 = lane & 31, h = lane >> 5, wq = wave & 3, mp = wave >> 2;
        const int qpos = 128 * qb + 32 * wq + r32;
        const float lt = l_run + xhalf(l_run);
        const float inv = 1.0f / lt;
        float* X = (float*)smem;
        if (mp == 1) {
#pragma unroll
            for (int et = 0; et < 4; ++et)
#pragma unroll
                for (int r = 0; r < 16; ++r) { const int e = 32 * et + (r & 3) + 8 * (r >> 2) + 4 * h; X[(wq * 128 + e) * 32 + r32] = O[et][r] * inv; }
        }
        __syncthreads();
        if (mp == 0) {
            float ssq = 0.f;
#pragma unroll
            for (int et = 0; et < 4; ++et)
#pragma unroll
                for (int r = 0; r < 16; ++r) { const int e = 32 * et + (r & 3) + 8 * (r >> 2) + 4 * h; const float d = O[et][r] * inv - lam * X[(wq * 128 + e) * 32 + r32]; O[et][r] = d; ssq += d * d; }
            ssq += xhalf(ssq);
            const float rstd = rsqrtf(ssq * (1.0f / 128.0f) + NORM_EPS) * 0.8f;
            bf16* dst = (bf16*)(ws + OFF_AQ) + (size_t)qpos * D + head * 128;
            const float* sw = p.in[8];
#pragma unroll
            for (int et = 0; et < 4; ++et)
#pragma unroll
                for (int q4 = 0; q4 < 4; ++q4) {
                    const int e0 = 32 * et + 8 * q4 + 4 * h;
                    const f32x4 w4 = *(const f32x4*)(sw + e0);
                    if (!dry) *(u32x2*)(dst + e0) = (u32x2){pk2(O[et][4 * q4] * rstd * w4[0], O[et][4 * q4 + 1] * rstd * w4[1]), pk2(O[et][4 * q4 + 2] * rstd * w4[2], O[et][4 * q4 + 3] * rstd * w4[3])};
                }
        }
        __syncthreads();
    }
}

DI void phase3(const Params& p, char* smem, int bid, int nblk, int dry = 0, int mode = 3) {
    if (mode & 1) for (int it = bid; it < 8 * SCAN_SPLIT; it += nblk) scan_head(p, smem, it / SCAN_SPLIT, it % SCAN_SPLIT, dry);
    if (!(mode & 2)) return;
    float d1 = 0.f, d2 = 0.f;
    for (int i = 0; i < 64; ++i) { d1 += p.in[4][i] * p.in[5][i]; d2 += p.in[6][i] * p.in[7][i]; }
    const float lam = __expf(d1) - __expf(d2) + 0.2f;
    unsigned* q = (unsigned*)(p.ws + OFF_SMALL + SM_CTL) + CW_ATTQ + (dry ? 16 : 0);
    for (;;) {
        if (threadIdx.x == 0) *(unsigned*)(smem + AT_MISC) = atomicAdd(q, 1u);
        __syncthreads();
        const unsigned u = *(unsigned*)(smem + AT_MISC);
        __syncthreads();
        if (u >= (unsigned)AT_UNITS) break;
        const int hd = (int)(u & 7u);
        const unsigned* nrm = (const unsigned*)(p.ws + OFF_SMALL + SM_CTL) + CW_NRM;
        float bnd = 0.f;
        for (int m2 = 0; m2 < 2; ++m2) {
            const float q2 = __builtin_bit_cast(float, LD_ATOMIC(nrm + 2 * hd + m2)), k2 = __builtin_bit_cast(float, LD_ATOMIC(nrm + 16 + 2 * hd + m2));
            bnd = fmaxf(bnd, sqrtf(q2 * k2) * (0.125f * LOG2E) * 1.02f);
        }
        attention_unit(p, smem, hd, NQB - 1 - (int)(u >> 3), lam, dry, bnd);
    }
}

DI void phase4(const Params& p, char* smem, int bid, int nblk) {
    const int tid = fresh_tid(), lane = tid & 63, wave = tid >> 6;
    const int gw = bid * 8 + wave, NGW = nblk * 8;
    unsigned char* ws = p.ws;
    char* wl = smem + wave * 16384;
    for (int it = gw; it < 32 * 384; it += NGW) {
        const int e = it / 384, r = it % 384, m = r >> 7, q = r & 127;
        if (m < 2) transpose_item(p.in[21 + m] + (size_t)e * 1024 * 256, 256, 1024, (bf16*)(ws + OFF_EXG) + (size_t)e * 512 * 1024, (q >> 3) * 64, (q & 7) * 32, (q & 7) * 32, (float*)wl, lane, m + 1);
        else transpose_item(p.in[23] + (size_t)e * 256 * 1024, 1024, 256, (bf16*)(ws + OFF_EXD) + (size_t)e * 1024 * 256, (q >> 5) * 64, (q & 31) * 32, (q & 31) * 32, (float*)wl, lane);
    }
    for (int R = gw; R < SEQ; R += NGW) {
        const float* xrow = p.in[0] + (size_t)R * D; bf16* urow = (bf16*)(ws + OFF_U) + (size_t)R * D;
        float4 v[4]; float ss = 0.f;
#pragma unroll
        for (int j = 0; j < 4; ++j) { v[j] = *(const float4*)(xrow + 4 * lane + 256 * j); ss += v[j].x * v[j].x + v[j].y * v[j].y + v[j].z * v[j].z + v[j].w * v[j].w; }
        ss = wave_sum(ss);
        const float rstd = rsqrtf(ss * (1.0f / D) + NORM_EPS);
#pragma unroll
        for (int j = 0; j < 4; ++j) {
            const float4 w4 = *(const float4*)(p.in[2] + 4 * lane + 256 * j);
            *(u32x2*)(urow + 4 * lane + 256 * j) = (u32x2){pk2(v[j].x * rstd * w4.x, v[j].y * rstd * w4.y), pk2(v[j].z * rstd * w4.z, v[j].w * rstd * w4.w)};
        }
    }
    for (int it = gw; it < (NCH - 1) * 8; it += NGW) {
        const int cm1 = it >> 3, head = it & 7;
        const bf16* reg = (const bf16*)(ws + OFF_V) + (size_t)cm1 * 64 * D + head * 128;
#pragma unroll 4
        for (int i = 0; i < 16; ++i) { const int row = i * 4 + (lane >> 4), ch = lane & 15; *(u32x4*)(wl + row * 256 + ch * 16) = *(const u32x4*)(reg + (size_t)row * D + ch * 8); }
        WAVE_SYNC();
        float ss = 0.f;
#pragma unroll 8
        for (int dv = 0; dv < 128; ++dv) { const float v = bf2f(*(const bf16*)(wl + (dv >> 1) * 256 + ((dv & 1) * 64 + lane) * 2)); ss += v * v; }
        const float rstd = rsqrtf(ss * (1.0f / 128.0f) + NORM_EPS);
        const size_t j = (size_t)cm1 * 64 + lane;
        const bf16* gsrc = (const bf16*)(ws + OFF_DG) + j * D + head * 128;
        bf16* dst = (bf16*)(ws + OFF_OD) + j * D + head * 128;
#pragma unroll 2
        for (int d8 = 0; d8 < 16; ++d8) {
            const u32x4 gv = *(const u32x4*)(gsrc + 8 * d8);
            const f32x4 w0 = *(const f32x4*)(p.in[12] + 8 * d8), w1 = *(const f32x4*)(p.in[12] + 8 * d8 + 4);
            float o[8];
#pragma unroll
            for (int c = 0; c < 8; ++c) { const int dv = 8 * d8 + c; o[c] = bf2f(*(const bf16*)(wl + (dv >> 1) * 256 + ((dv & 1) * 64 + lane) * 2)) * rstd; }
            o[0] *= w0[0] * siluf_(bflo(gv.x)); o[1] *= w0[1] * siluf_(bfhi(gv.x)); o[2] *= w0[2] * siluf_(bflo(gv.y)); o[3] *= w0[3] * siluf_(bfhi(gv.y));
            o[4] *= w1[0] * siluf_(bflo(gv.z)); o[5] *= w1[1] * siluf_(bfhi(gv.z)); o[6] *= w1[2] * siluf_(bflo(gv.w)); o[7] *= w1[3] * siluf_(bfhi(gv.w));
            *(u32x4*)(dst + 8 * d8) = (u32x4){pk2(o[0], o[1]), pk2(o[2], o[3]), pk2(o[4], o[5]), pk2(o[6], o[7])};
        }
        WAVE_SYNC();
    }
}

template <int NB, int NI>
DI void rowgemm64(const bf16* arow, const bf16* const (&bptr)[NB], char* stg, f32x16 (&acc)[NB][2][NI]) {
    const int tid = fresh_tid(), lane = tid & 63, r32 = lane & 31, h = lane >> 5;
    const int lrow = tid >> 3, lc = tid & 7;
    u32x4 ra = arow ? *(const u32x4*)arow : (u32x4){0u, 0u, 0u, 0u};
    bf16x8 bqA[4][NB][NI], bqB[4][NB][NI];
    auto bload = [&](bf16x8 (&dst)[4][NB][NI], int kc) {
#pragma unroll
        for (int ks = 0; ks < 4; ++ks)
#pragma unroll
            for (int b = 0; b < NB; ++b)
#pragma unroll
                for (int ni = 0; ni < NI; ++ni) dst[ks][b][ni] = *(const bf16x8*)(bptr[b] + (size_t)ni * 32 * 1024 + kc * 64 + ks * 16);
    };
    auto mma = [&](const bf16x8 (&bq)[4][NB][NI], int buf) {
#pragma unroll
        for (int ks = 0; ks < 4; ++ks) {
            bf16x8 af[2];
#pragma unroll
            for (int mi = 0; mi < 2; ++mi) af[mi] = *(const bf16x8*)(stg + buf * 8192 + swz128(32 * mi + r32, 2 * ks + h));
#pragma unroll
            for (int b = 0; b < NB; ++b)
#pragma unroll
                for (int ni = 0; ni < NI; ++ni)
#pragma unroll
                    for (int mi = 0; mi < 2; ++mi) acc[b][mi][ni] = MFMA32(af[mi], bq[ks][b][ni], acc[b][mi][ni]);
        }
    };
    bload(bqA, 0);
    *(u32x4*)(stg + swz128(lrow, lc)) = ra;
    __syncthreads();
    for (int kc = 0; kc < 16; kc += 2) {
        ra = arow ? *(const u32x4*)(arow + (kc + 1) * 64) : (u32x4){0u, 0u, 0u, 0u};
        bload(bqB, kc + 1);
        mma(bqA, 0);
        *(u32x4*)(stg + 8192 + swz128(lrow, lc)) = ra;
        __syncthreads();
        if (kc + 2 < 16) { ra = arow ? *(const u32x4*)(arow + (kc + 2) * 64) : (u32x4){0u, 0u, 0u, 0u}; bload(bqA, kc + 2); }
        mma(bqB, 1);
        if (kc + 2 < 16) *(u32x4*)(stg + swz128(lrow, lc)) = ra;
        __syncthreads();
    }
}

constexpr size_t OFF_MIX = OFF_V;
struct EpiSig {
    static constexpr bool PERM = true;
    bf16* sg;
    DM void operator()(const f32x4 (&acc)[2][2][4][2], const pg8::Unit& u, int wr, int wc, int fr, int fq) const {
        const int row0 = u.pm * 256 + wr * 64 + fr, col0 = u.pn * 256 + wc * 32 + 8 * fq;
#pragma unroll
        for (int ai = 0; ai < 2; ++ai)
#pragma unroll
            for (int m = 0; m < 4; ++m) {
                bf16* rowp = sg + (size_t)(row0 + ai * 128 + m * 16) * 2048 + col0;
#pragma unroll
                for (int bj = 0; bj < 2; ++bj) {
                    const f32x4 v0 = acc[ai][bj][m][0], v1 = acc[ai][bj][m][1];
                    *(u32x4*)(rowp + bj * 128) = (u32x4){pk2(sigmoidf_(v0[0]), sigmoidf_(v0[1])), pk2(sigmoidf_(v0[2]), sigmoidf_(v0[3])), pk2(sigmoidf_(v1[0]), sigmoidf_(v1[1])), pk2(sigmoidf_(v1[2]), sigmoidf_(v1[3]))};
                }
            }
    }
};
template <bool ADD> struct EpiGate {
    static constexpr bool PERM = true;
    const bf16* sg; bf16* mix; int goff;
    DM void operator()(const f32x4 (&acc)[2][2][4][2], const pg8::Unit& u, int wr, int wc, int fr, int fq) const {
        const int row0 = u.pm * 256 + wr * 64 + fr, col0 = u.pn * 256 + wc * 32 + 8 * fq;
#pragma unroll
        for (int ai = 0; ai < 2; ++ai)
#pragma unroll
            for (int m = 0; m < 4; ++m) {
                const size_t j = (size_t)(row0 + ai * 128 + m * 16);
#pragma unroll
                for (int bj = 0; bj < 2; ++bj) {
                    const u32x4 g = *(const u32x4*)(sg + j * 2048 + goff + col0 + bj * 128);
                    const f32x4 v0 = acc[ai][bj][m][0], v1 = acc[ai][bj][m][1];
                    float o[8] = {bflo(g.x) * v0[0], bfhi(g.x) * v0[1], bflo(g.y) * v0[2], bfhi(g.y) * v0[3], bflo(g.z) * v1[0], bfhi(g.z) * v1[1], bflo(g.w) * v1[2], bfhi(g.w) * v1[3]};
                    bf16* dst = mix + j * D + col0 + bj * 128;
                    if (ADD) { const u32x4 q = *(const u32x4*)dst; o[0] += bflo(q.x); o[1] += bfhi(q.x); o[2] += bflo(q.y); o[3] += bfhi(q.y); o[4] += bflo(q.z); o[5] += bfhi(q.z); o[6] += bflo(q.w); o[7] += bfhi(q.w); }
                    *(u32x4*)dst = (u32x4){pk2(o[0], o[1]), pk2(o[2], o[3]), pk2(o[4], o[5]), pk2(o[6], o[7])};
                }
            }
    }
};
struct EpiRes {
    static constexpr bool PERM = false;
    const float* x; float* hout;
    DM void operator()(const f32x4 (&acc)[2][2][4][2], const pg8::Unit& u, int wr, int wc, int fr, int fq) const {
        const int row0 = u.pm * 256 + wr * 64 + fr, col0 = u.pn * 256 + wc * 32 + 4 * fq;
#pragma unroll
        for (int ai = 0; ai < 2; ++ai)
#pragma unroll
            for (int m = 0; m < 4; ++m) {
                const size_t off = (size_t)(row0 + ai * 128 + m * 16) * D + col0;
#pragma unroll
                for (int bj = 0; bj < 2; ++bj)
#pragma unroll
                    for (int n = 0; n < 2; ++n) *(f32x4*)(hout + off + bj * 128 + n * 16) = *(const f32x4*)(x + off + bj * 128 + n * 16) + acc[ai][bj][m][n];
            }
    }
};
DI void phase5a(const Params& p, char* smem, int bid, int nblk) {
    pg8::Gemm g{(const bf16*)(p.ws + OFF_U), (const bf16*)(p.ws + OFF_WTIN) + (size_t)7168 * 1024, SEQ, 2048, 1024};
    pg8::StaticOrder S; S.init(SEQ, 2048, nblk, bid);
    EpiSig E{(bf16*)p.out};
    pg8::gemm_phase(smem, g, S, E);
}
DI void phase5b(const Params& p, char* smem, int bid, int nblk) {
    pg8::StaticOrder S; S.init(SEQ, 1024, nblk, bid);
    {
        pg8::Gemm g{(const bf16*)(p.ws + OFF_AQ), (const bf16*)(p.ws + OFF_WTBA), SEQ, 1024, 1024};
        EpiGate<false> E{(const bf16*)p.out, (bf16*)(p.ws + OFF_MIX), 0};
        pg8::gemm_phase(smem, g, S, E);
    }
    {
        pg8::Gemm g{(const bf16*)(p.ws + OFF_OD), (const bf16*)(p.ws + OFF_WTBD), SEQ, 1024, 1024};
        EpiGate<true> E{(const bf16*)p.out, (bf16*)(p.ws + OFF_MIX), 1024};
        pg8::gemm_phase(smem, g, S, E);
    }
}
DI void phase5c(const Params& p, char* smem, int bid, int nblk) {
    pg8::Gemm g{(const bf16*)(p.ws + OFF_MIX), (const bf16*)(p.ws + OFF_WTOUT), SEQ, 1024, 1024};
    pg8::StaticOrder S; S.init(SEQ, 1024, nblk, bid);
    EpiRes E{p.in[0], p.out};
    pg8::gemm_phase(smem, g, S, E);
}
constexpr int P5_PLP = 65, P5_PL = 0, P5_SS = 8 * 64 * P5_PLP * 4, P5_MISC = P5_SS + 8 * 64 * 4;
DI void post_rows(const Params& p, char* smem, int rb, int dry) {
    const int tid = fresh_tid(), lane = tid & 63, wave = tid >> 6, r32 = lane & 31, h = lane >> 5;
    unsigned char* ws = p.ws;
    const int row0 = rb * 64;
    float* rstdl = (float*)(smem + P5_MISC); float* logl = (float*)(smem + P5_MISC + 256);
    {
        const bf16* WH = (const bf16*)(ws + OFF_SMALL + SM_WR); const bf16* WL = WH + 64 * 1024;
        f32x16 acc[2][2];
#pragma unroll
        for (int mi = 0; mi < 2; ++mi)
#pragma unroll
            for (int ni = 0; ni < 2; ++ni) acc[mi][ni] = zero16();
        float ss[2] = {0.f, 0.f};
#pragma unroll 2
        for (int ks = 0; ks < 8; ++ks) {
            const int k0 = 128 * wave + 16 * ks + 8 * h;
            bf16x8 ah[2], al[2];
#pragma unroll
            for (int mi = 0; mi < 2; ++mi) {
                const float* hp = p.out + (size_t)(row0 + 32 * mi + r32) * D + k0;
                const f32x4 a = *(const f32x4*)hp, b = *(const f32x4*)(hp + 4);
                ss[mi] += a[0] * a[0] + a[1] * a[1] + a[2] * a[2] + a[3] * a[3] + b[0] * b[0] + b[1] * b[1] + b[2] * b[2] + b[3] * b[3];
                const u32x4 hi = {pk2(a[0], a[1]), pk2(a[2], a[3]), pk2(b[0], b[1]), pk2(b[2], b[3])};
                const u32x4 lo = {pk2(a[0] - bflo(hi.x), a[1] - bfhi(hi.x)), pk2(a[2] - bflo(hi.y), a[3] - bfhi(hi.y)), pk2(b[0] - bflo(hi.z), b[1] - bfhi(hi.z)), pk2(b[2] - bflo(hi.w), b[3] - bfhi(hi.w))};
                ah[mi] = __builtin_bit_cast(bf16x8, hi); al[mi] = __builtin_bit_cast(bf16x8, lo);
            }
#pragma unroll
            for (int ni = 0; ni < 2; ++ni) {
                const bf16x8 bh = *(const bf16x8*)(WH + (size_t)(32 * ni + r32) * 1024 + k0), bl = *(const bf16x8*)(WL + (size_t)(32 * ni + r32) * 1024 + k0);
#pragma unroll
                for (int mi = 0; mi < 2; ++mi) { acc[mi][ni] = MFMA32(ah[mi], bh, acc[mi][ni]); acc[mi][ni] = MFMA32(ah[mi], bl, acc[mi][ni]); acc[mi][ni] = MFMA32(al[mi], bh, acc[mi][ni]); }
            }
        }
        float* PL = (float*)(smem + P5_PL) + wave * 64 * P5_PLP; float* SS = (float*)(smem + P5_SS) + wave * 64;
#pragma unroll
        for (int mi = 0; mi < 2; ++mi) {
#pragma unroll
            for (int ni = 0; ni < 2; ++ni)
#pragma unroll
                for (int r = 0; r < 16; ++r) PL[(32 * mi + (r & 3) + 8 * (r >> 2) + 4 * h) * P5_PLP + 32 * ni + r32] = acc[mi][ni][r];
            const float s = ss[mi] + xhalf(ss[mi]);
            if (h == 0) SS[32 * mi + r32] = s;
        }
    }
    __syncthreads();
    if (tid < 64) {
        float s = 0.f;
#pragma unroll
        for (int w = 0; w < 8; ++w) s += ((const float*)(smem + P5_SS))[w * 64 + tid];
        const float rs = rsqrtf(s * (1.0f / D) + NORM_EPS);
        rstdl[tid] = rs;
        for (int c = 0; c < 36; ++c) { float t = 0.f; for (int w = 0; w < 8; ++w) t += ((const float*)(smem + P5_PL))[w * 64 * P5_PLP + tid * P5_PLP + c]; logl[tid * 41 + c] = t * rs + (c < 4 ? p.in[18][c] : p.in[20][c - 4]); }
        const float* L = logl + tid * 41;
        int gi = 0; float gm = L[0];
        for (int c = 1; c < 4; ++c) if (L[c] > gm) { gm = L[c]; gi = c; }
        float gs = 0.f; for (int c = 0; c < 4; ++c) gs += __expf(L[c] - gm);
        const float gw = 1.0f / gs;
        const float* E = L + 4 + 8 * gi;
        int i1 = 0; float l1 = E[0];
        for (int c = 1; c < 8; ++c) if (E[c] > l1) { l1 = E[c]; i1 = c; }
        int i2 = -1; float l2 = -3.0e38f;
        for (int c = 0; c < 8; ++c) if (c != i1 && E[c] > l2) { l2 = E[c]; i2 = c; }
        const float t = __expf(l2 - l1), w1 = 1.0f / (1.0f + t), w2 = t / (1.0f + t);
        unsigned* cnt = (unsigned*)(ws + OFF_SMALL + SM_CTL) + CW_ECNT;
        int* lists = (int*)(ws + OFF_SMALL + SM_TAILS); float* RW = (float*)(ws + OFF_SMALL + SM_RW);
        const int j = row0 + tid;
        const int e1 = 8 * gi + i1, e2 = 8 * gi + i2;
        if (!dry) {
        const unsigned p1 = atomicAdd(cnt + e1, 1u); ST_ATOMIC(lists + (size_t)e1 * SEQ + p1, (j << 1)); RW[2 * j] = gw * w1;
        const unsigned p2 = atomicAdd(cnt + e2, 1u); ST_ATOMIC(lists + (size_t)e2 * SEQ + p2, (j << 1) | 1); RW[2 * j + 1] = gw * w2;
        } else { asm volatile("" :: "v"(e1), "v"(e2), "v"(gw * w1), "v"(gw * w2)); }
    }
    __syncthreads();
#pragma unroll 2
    for (int i = 0; i < 16; ++i) {
        const int idx = tid + NT * i, row = idx >> 7, ch = idx & 127;
        const float* hp = p.out + (size_t)(row0 + row) * D + ch * 8;
        const f32x4 a = *(const f32x4*)hp, b = *(const f32x4*)(hp + 4);
        const f32x4 w0 = *(const f32x4*)(p.in[16] + ch * 8), w1 = *(const f32x4*)(p.in[16] + ch * 8 + 4);
        const float rs = rstdl[row];
        if (!dry) *(u32x4*)((bf16*)(ws + OFF_OD) + (size_t)(row0 + row) * D + ch * 8) =
            (u32x4){pk2(a[0] * rs * w0[0], a[1] * rs * w0[1]), pk2(a[2] * rs * w0[2], a[3] * rs * w0[3]), pk2(b[0] * rs * w1[0], b[1] * rs * w1[1]), pk2(b[2] * rs * w1[2], b[3] * rs * w1[3])};
    }
    __syncthreads();
}
DI void phase5d(const Params& p, char* smem, int bid, int nblk, int dry = 0) {
    for (int rb = bid; rb < SEQ / 64; rb += nblk) post_rows(p, smem, rb, dry);
}

constexpr int P6_TBL = 131072 + 1024;
template <int NPN> struct MoeSched {
    static constexpr bool GATHER = (NPN == 2);
    const int* tbl; const int* lists; int G, c; size_t btile;
    DM bool next(int i, pg8::Unit& u) const {
        const long L = (long)i * G + c; const int total = tbl[64 + 33 + 32] * NPN; if (L >= total) return false;
        const int ru = (int)L / NPN; u.pn = (int)L % NPN;
        int e = 0;
#pragma unroll 1
        for (int q = 1; q < 32; ++q) if (tbl[64 + 33 + q] <= ru) e = q;
        u.e = e; u.pm = ru - tbl[64 + 33 + e]; return true;
    }
    DM const char* a_tile(const pg8::Gemm& g, const pg8::Unit& u) const { return (const char*)g.A + ((size_t)tbl[32 + u.e] + (size_t)u.pm * 256) * g.K * 2; }
    DM const char* b_tile(const pg8::Gemm& g, const pg8::Unit& u) const { return (const char*)g.Bt + (size_t)u.e * btile + (size_t)u.pn * 256 * g.K * 2; }
    DM int a_row(const pg8::Unit& u, int r) const { const int loc = u.pm * 256 + r; return loc < tbl[u.e] ? (lists[(size_t)u.e * SEQ + loc] >> 1) : 0; }
};
DI void moe_table(const Params& p, char* smem) {
    int* tbl = (int*)(smem + P6_TBL);
    unsigned* cnt = (unsigned*)(p.ws + OFF_SMALL + SM_CTL) + CW_ECNT;
    if (threadIdx.x < 32) tbl[threadIdx.x] = (int)LD_ATOMIC(cnt + threadIdx.x);
    __syncthreads();
    if (threadIdx.x == 0) { int hb = 0, ub = 0; for (int e = 0; e < 32; ++e) { tbl[32 + e] = hb; tbl[64 + 33 + e] = ub; const int nru = (tbl[e] + 255) >> 8; hb += nru * 256; ub += nru; } tbl[32 + 32] = hb; tbl[64 + 33 + 32] = ub; }
    __syncthreads();
}
struct EpiSwiGLU {
    static constexpr bool PERM = true;
    bf16* H; const int* tbl;
    DM void operator()(const f32x4 (&acc)[2][2][4][2], const pg8::Unit& u, int wr, int wc, int fr, int fq) const {
        const size_t grow0 = (size_t)tbl[32 + u.e] + (size_t)u.pm * 256 + wr * 64 + fr; const int hid0 = (u.pn * 256 + wc * 32 + 8 * fq) >> 1;
#pragma unroll
        for (int ai = 0; ai < 2; ++ai)
#pragma unroll
            for (int m = 0; m < 4; ++m) {
                bf16* rowp = H + (grow0 + ai * 128 + m * 16) * 256 + hid0;
#pragma unroll
                for (int bj = 0; bj < 2; ++bj) {
                    const f32x4 gt = acc[ai][bj][m][0], up = acc[ai][bj][m][1];
                    *(u32x2*)(rowp + bj * 64) = (u32x2){pk2(siluf_(gt[0]) * up[0], siluf_(gt[1]) * up[1]), pk2(siluf_(gt[2]) * up[2], siluf_(gt[3]) * up[3])};
                }
            }
    }
};
struct EpiScatter {
    static constexpr bool PERM = true;
    bf16* Y; const int* tbl; const int* lists; const float* RW;
    DM void operator()(const f32x4 (&acc)[2][2][4][2], const pg8::Unit& u, int wr, int wc, int fr, int fq) const {
        const int loc0 = u.pm * 256 + wr * 64 + fr, col0 = u.pn * 256 + wc * 32 + 8 * fq, cnt = tbl[u.e];
#pragma unroll
        for (int ai = 0; ai < 2; ++ai)
#pragma unroll
            for (int m = 0; m < 4; ++m) {
                const int loc = loc0 + ai * 128 + m * 16;
                if (loc < cnt) {
                    const int ent = lists[(size_t)u.e * SEQ + loc]; const float w = RW[ent];
                    bf16* rowp = Y + (size_t)ent * D + col0;
#pragma unroll
                    for (int bj = 0; bj < 2; ++bj) {
                        const f32x4 v0 = acc[ai][bj][m][0] * w, v1 = acc[ai][bj][m][1] * w;
                        *(u32x4*)(rowp + bj * 128) = (u32x4){pk2(v0[0], v0[1]), pk2(v0[2], v0[3]), pk2(v1[0], v1[1]), pk2(v1[2], v1[3])};
                    }
                }
            }
    }
};
DI void phase6a(const Params& p, char* smem, int bid, int nblk) {
    moe_table(p, smem);
    const int* tbl = (const int*)(smem + P6_TBL); const int* lists = (const int*)(p.ws + OFF_SMALL + SM_TAILS);
    pg8::Gemm g{(const bf16*)(p.ws + OFF_OD), (const bf16*)(p.ws + OFF_EXG), 0, 512, 1024};
    MoeSched<2> S{tbl, lists, nblk, bid, (size_t)512 * 1024 * 2};
    EpiSwiGLU E{(bf16*)(p.ws + OFF_H), tbl};
    pg8::gemm_phase(smem, g, S, E);
}
DI void phase6b(const Params& p, char* smem, int bid, int nblk) {
    moe_table(p, smem);
    const int* tbl = (const int*)(smem + P6_TBL); const int* lists = (const int*)(p.ws + OFF_SMALL + SM_TAILS);
    pg8::Gemm g{(const bf16*)(p.ws + OFF_H), (const bf16*)(p.ws + OFF_EXD), 0, 1024, 256};
    MoeSched<4> S{tbl, lists, nblk, bid, (size_t)1024 * 256 * 2};
    EpiScatter E{(bf16*)(p.ws + OFF_Y), tbl, lists, (const float*)(p.ws + OFF_SMALL + SM_RW)};
    pg8::gemm_phase(smem, g, S, E);
}

DI void phase7(const Params& p, char* smem, int bid, int nblk, int dry = 0) {
    const int tid = fresh_tid(), lane = tid & 63, wave = tid >> 6;
    const int gw = bid * 8 + wave, NGW = nblk * 8;
    for (int j = gw; j < SEQ; j += NGW) {
        float* hrow = p.out + (size_t)j * D;
        const bf16* y0 = (const bf16*)(p.ws + OFF_Y) + (size_t)j * 2 * D;
        float4 v[4]; float ss = 0.f;
#pragma unroll
        for (int q = 0; q < 4; ++q) {
            const int c = 4 * lane + 256 * q;
            v[q] = *(const float4*)(hrow + c);
            const u32x2 a = *(const u32x2*)(y0 + c), b = *(const u32x2*)(y0 + D + c);
            v[q].x += bflo(a.x) + bflo(b.x); v[q].y += bfhi(a.x) + bfhi(b.x); v[q].z += bflo(a.y) + bflo(b.y); v[q].w += bfhi(a.y) + bfhi(b.y);
            ss += v[q].x * v[q].x + v[q].y * v[q].y + v[q].z * v[q].z + v[q].w * v[q].w;
        }
        ss = wave_sum(ss);
        const float rstd = rsqrtf(ss * (1.0f / D) + NORM_EPS);
#pragma unroll
        for (int q = 0; q < 4; ++q) {
            const int c = 4 * lane + 256 * q; const float4 w4 = *(const float4*)(p.in[24] + c);
            if (!dry) *(float4*)(hrow + c) = make_float4(v[q].x * rstd * w4.x, v[q].y * rstd * w4.y, v[q].z * rstd * w4.z, v[q].w * rstd * w4.w);
        }
    }
}

#ifdef EMU
__global__ void __launch_bounds__(NT) k_phase0(Params p) { SMEM_DECL; phase0(p, smem, blockIdx.x, gridDim.x); }
__global__ void __launch_bounds__(NT) k_phase1(Params p) { SMEM_DECL; phase1(p, smem, blockIdx.x, gridDim.x); }
__global__ void __launch_bounds__(NT) k_phase2(Params p) { SMEM_DECL; phase2(p, smem, blockIdx.x, gridDim.x, 0); }
__global__ void __launch_bounds__(NT) k_phase3(Params p) { SMEM_DECL; phase3(p, smem, blockIdx.x, gridDim.x); }
__global__ void __launch_bounds__(NT) k_phase4(Params p) { SMEM_DECL; phase4(p, smem, blockIdx.x, gridDim.x); }
__global__ void __launch_bounds__(NT) k_phase5a(Params p) { SMEM_DECL; phase5a(p, smem, blockIdx.x, gridDim.x); }
__global__ void __launch_bounds__(NT) k_phase5b(Params p) { SMEM_DECL; phase5b(p, smem, blockIdx.x, gridDim.x); }
__global__ void __launch_bounds__(NT) k_phase5c(Params p) { SMEM_DECL; phase5c(p, smem, blockIdx.x, gridDim.x); }
__global__ void __launch_bounds__(NT) k_phase5d(Params p) { SMEM_DECL; phase5d(p, smem, blockIdx.x, gridDim.x); }
__global__ void __launch_bounds__(NT) k_phase6a(Params p) { SMEM_DECL; phase6a(p, smem, blockIdx.x, gridDim.x); }
__global__ void __launch_bounds__(NT) k_phase6b(Params p) { SMEM_DECL; phase6b(p, smem, blockIdx.x, gridDim.x); }
__global__ void __launch_bounds__(NT) k_phase7(Params p) { SMEM_DECL; phase7(p, smem, blockIdx.x, gridDim.x); }

#endif

constexpr int LDS_BYTES = 160 * 1024 - 256;
constexpr int LDS_BARST = LDS_BYTES - 16;

#ifndef EMU
#define LAS __attribute__((address_space(3)))
#define XB_TMO      128
#define XB_XCNT(j)  (256  + 64 * (j))
#define XB_XSUB(j)  (1280 + 64 * (j))
#define XB_XGEN(j)  (2304 + 64 * (j))
#define XB_TOP      3328
#define XB_TOPGEN   3392
#define XCD_BAR_WORDS 3456
#define XB_SPIN_CAP (1u << 22)
__device__ __forceinline__ unsigned xb_ld(unsigned* p)              { return __hip_atomic_load(p, __ATOMIC_RELAXED, __HIP_MEMORY_SCOPE_AGENT); }
__device__ __forceinline__ unsigned xb_add(unsigned* p, unsigned v) { return __hip_atomic_fetch_add(p, v, __ATOMIC_RELAXED, __HIP_MEMORY_SCOPE_AGENT); }
__device__ __forceinline__ unsigned xb_xcc_id() { return (unsigned)__builtin_amdgcn_s_getreg((3 << 11) | 20) & 0xFu; }
#define XB_SPIN(cond, bar) do { unsigned _sp = 0; while (cond) { __builtin_amdgcn_s_sleep(1); \
    if ((++_sp & 255u) == 0u) { if (xb_ld(&(bar)[XB_TMO])) break; if (_sp > XB_SPIN_CAP) { atomicAdd(&(bar)[XB_TMO], 1u); break; } } } } while (0)
struct XcdBarrier { unsigned* bar; unsigned x; volatile LAS unsigned* st; };
__device__ __forceinline__ XcdBarrier xcd_barrier_post(unsigned* bar, volatile LAS unsigned* st) {
    XcdBarrier b; b.bar = bar; b.x = xb_xcc_id(); b.st = st;
    if (threadIdx.x == 0) (void)xb_add(&bar[XB_XCNT(b.x)], 1u);
    return b;
}
__device__ __forceinline__ void xcd_barrier_complete(unsigned* bar, unsigned x, unsigned& nloc, unsigned& nx) {
    const unsigned G = gridDim.x * gridDim.y * gridDim.z;
    unsigned sum, cnt, mine, sp = 0u;
    for (;;) {
        sum = 0u; cnt = 0u; mine = 0u;
#pragma unroll
        for (unsigned j = 0; j < 16; ++j) { const unsigned c = xb_ld(&bar[XB_XCNT(j)]); sum += c; cnt += (c > 0u) ? 1u : 0u; mine = (j == x) ? c : mine; }
        if (sum == G) break;
        __builtin_amdgcn_s_sleep(1);
        if ((++sp & 255u) == 0u) { if (xb_ld(&bar[XB_TMO])) break; if (sp > XB_SPIN_CAP) { atomicAdd(&bar[XB_TMO], 1u); break; } }
    }
    nloc = mine > 0u ? mine : 1u; nx = cnt > 0u ? cnt : 1u;
}
__device__ __forceinline__ void xcd_barrier(const XcdBarrier& b) {
    asm volatile("s_waitcnt vmcnt(0)" ::: "memory");
    __syncthreads();
    if (threadIdx.x == 0) {
        unsigned* bar = b.bar;
        __builtin_amdgcn_s_waitcnt(0);
        unsigned nloc = b.st[0], nx = b.st[1];
        if (nloc == 0u) { xcd_barrier_complete(bar, b.x, nloc, nx); b.st[0] = nloc; b.st[1] = nx; }
        const unsigned old = xb_add(&bar[XB_XSUB(b.x)], 1u);
        const unsigned gen = old / nloc;
        if (old + 1u == (gen + 1u) * nloc) {
            __builtin_amdgcn_fence(__ATOMIC_RELEASE, "agent");
            asm volatile("s_waitcnt vmcnt(0)" ::: "memory");
            const unsigned og = xb_add(&bar[XB_TOP], 1u);
            const unsigned tg = og / nx;
            if (og + 1u == (tg + 1u) * nx) xb_add(&bar[XB_TOPGEN], 1u);
            else XB_SPIN(xb_ld(&bar[XB_TOPGEN]) == tg, bar);
            __builtin_amdgcn_fence(__ATOMIC_ACQUIRE, "agent");
            xb_add(&bar[XB_XGEN(b.x)], 1u);
            asm volatile("s_waitcnt vmcnt(0)" ::: "memory");
        } else {
            XB_SPIN(xb_ld(&bar[XB_XGEN(b.x)]) == gen, bar);
            __builtin_amdgcn_fence(__ATOMIC_ACQUIRE, "agent");
            asm volatile("s_waitcnt vmcnt(0)" ::: "memory");
        }
    }
    __syncthreads();
}
#endif

#ifdef EMU
#define GRID_SYNC() emu_grid_sync()
#define GRID_SYNC_CG() emu_grid_sync()
#else
#define GRID_SYNC_CG() do { \
    asm volatile("s_waitcnt vmcnt(0)" ::: "memory"); \
    __syncthreads(); \
    cooperative_groups::this_grid().sync(); \
    if (threadIdx.x == 0) { __builtin_amdgcn_fence(__ATOMIC_ACQUIRE, "agent"); asm volatile("s_waitcnt vmcnt(0)" ::: "memory"); } \
    __syncthreads(); \
} while (0)
#define GRID_SYNC() xcd_barrier(xbar)
#endif
__global__ void __launch_bounds__(NT) fwd_megakernel(Params p) {
    SMEM_DECL;
    const int bid = blockIdx.x, nblk = gridDim.x;
#ifndef EMU
    if (threadIdx.x < 4) ((volatile LAS unsigned*)(smem + LDS_BARST))[threadIdx.x] = 0u;
    __syncthreads();
    const XcdBarrier xbar = xcd_barrier_post((unsigned*)(p.ws + OFF_SMALL + SM_CTL) + CW_BAR, (volatile LAS unsigned*)(smem + LDS_BARST));
#endif
#if defined(DRY_PHASE) && !defined(EMU)
    int dryflag = 1; asm volatile("" : "+s"(dryflag));
#define EXTRA(k, call) do { if (DRY_PHASE == (k)) { call; GRID_SYNC(); } } while (0)
#else
#define EXTRA(k, call) do {} while (0)
    const int dryflag = 0; (void)dryflag;
#endif
    EXTRA(0, phase0(p, smem, bid, nblk));
    phase0(p, smem, bid, nblk); GRID_SYNC_CG();
    EXTRA(1, phase1(p, smem, bid, nblk));
    phase1(p, smem, bid, nblk); GRID_SYNC();
    EXTRA(2, phase2(p, smem, bid, nblk, dryflag));
    phase2(p, smem, bid, nblk); GRID_SYNC();
    EXTRA(3, phase3(p, smem, bid, nblk, dryflag));
    EXTRA(8, phase3(p, smem, bid, nblk, dryflag, 1));
    EXTRA(9, phase3(p, smem, bid, nblk, dryflag, 2));
    phase3(p, smem, bid, nblk); GRID_SYNC();
    EXTRA(4, phase4(p, smem, bid, nblk));
    phase4(p, smem, bid, nblk); GRID_SYNC();
    EXTRA(5, phase5a(p, smem, bid, nblk));
    phase5a(p, smem, bid, nblk); GRID_SYNC();
    EXTRA(10, phase5b(p, smem, bid, nblk));
    phase5b(p, smem, bid, nblk); GRID_SYNC();
    EXTRA(11, phase5c(p, smem, bid, nblk));
    phase5c(p, smem, bid, nblk); GRID_SYNC();
    EXTRA(12, phase5d(p, smem, bid, nblk, dryflag));
    phase5d(p, smem, bid, nblk); GRID_SYNC();
    EXTRA(6, phase6a(p, smem, bid, nblk));
    phase6a(p, smem, bid, nblk); GRID_SYNC();
    EXTRA(13, phase6b(p, smem, bid, nblk));
    phase6b(p, smem, bid, nblk); GRID_SYNC();
    EXTRA(7, phase7(p, smem, bid, nblk, dryflag));
    phase7(p, smem, bid, nblk);
}

#ifndef EMU
extern "C" void kernel_launch(void* const* d_in, const int* in_sizes, int n_in, void* d_out, int out_size, void* d_ws, size_t ws_size, hipStream_t stream) {
    static int grid = 0;
    if (grid == 0) {
        if (n_in != 25 || ws_size < WS_END || out_size != SEQ * D) { fprintf(stderr, "kernel_launch: unexpected problem (n_in %d, ws %zu, out %d)\n", n_in, ws_size, out_size); grid = -1; return; }
        int dev = 0, cus = 0, per_cu = 0;
        (void)hipGetDevice(&dev);
        (void)hipDeviceGetAttribute(&cus, hipDeviceAttributeMultiprocessorCount, dev);
        (void)hipFuncSetAttribute((const void*)fwd_megakernel, hipFuncAttributeMaxDynamicSharedMemorySize, LDS_BYTES);
        (void)hipOccupancyMaxActiveBlocksPerMultiprocessor(&per_cu, (const void*)fwd_megakernel, NT, LDS_BYTES);
        if (per_cu < 1) { fprintf(stderr, "kernel_launch: occupancy query returned %d\n", per_cu); per_cu = 1; }
        grid = cus * per_cu;
    }
    if (grid < 0) return;
    Params p{};
    for (int i = 0; i < 25; ++i) p.in[i] = (const float*)d_in[i];
    p.out = (float*)d_out; p.ws = (unsigned char*)d_ws;
    (void)hipMemsetAsync((unsigned char*)d_ws + OFF_SMALL + SM_CTL + (size_t)CW_BAR * 4, 0, (size_t)XCD_BAR_WORDS * 4, stream);
    void* args[] = {&p};
    hipError_t e = hipLaunchCooperativeKernel((const void*)fwd_megakernel, dim3(grid), dim3(NT), args, LDS_BYTES, stream);
    if (e != hipSuccess) fprintf(stderr, "cooperative launch failed: %s (grid %d)\n", hipGetErrorString(e), grid);
}
#endif

#ifdef EMU
static void run_phases(Params p, int upto, int grid) {
    if (upto == 100) { emu::launch([=] { fwd_megakernel(p); }, grid, NT, LDS_BYTES, true); return; }
    if (upto >= 0) emu::launch([=] { k_phase0(p); }, grid, NT, LDS_BYTES, false);
    if (upto >= 1) emu::launch([=] { k_phase1(p); }, grid, NT, LDS_BYTES, false);
    if (upto >= 2) emu::launch([=] { k_phase2(p); }, grid, NT, LDS_BYTES, false);
    if (upto >= 3) emu::launch([=] { k_phase3(p); }, grid, NT, LDS_BYTES, false);
    if (upto >= 4) emu::launch([=] { k_phase4(p); }, grid, NT, LDS_BYTES, false);
    if (upto >= 5) { emu::launch([=] { k_phase5a(p); }, grid, NT, LDS_BYTES, false); emu::launch([=] { k_phase5b(p); }, grid, NT, LDS_BYTES, false); emu::launch([=] { k_phase5c(p); }, grid, NT, LDS_BYTES, false); emu::launch([=] { k_phase5d(p); }, grid, NT, LDS_BYTES, false); }
    if (upto >= 6) { emu::launch([=] { k_phase6a(p); }, grid, NT, LDS_BYTES, false); emu::launch([=] { k_phase6b(p); }, grid, NT, LDS_BYTES, false); }
    if (upto >= 7) emu::launch([=] { k_phase7(p); }, grid, NT, LDS_BYTES, false);
}
#endif
```

```cpp
#include <type_traits>
#ifndef EMU
#include <hip/hip_runtime.h>
#include <hip/hip_cooperative_groups.h>
#include <cstdio>
#include <cstdint>
#include <cmath>
#endif

#ifndef SEQ
#define SEQ 16384
#endif

typedef unsigned short bf16;
typedef short bf16x8 __attribute__((ext_vector_type(8)));
typedef short bf16x4 __attribute__((ext_vector_type(4)));
typedef float f32x16 __attribute__((ext_vector_type(16)));
typedef float f32x4 __attribute__((ext_vector_type(4)));
typedef unsigned u32x4 __attribute__((ext_vector_type(4)));
typedef unsigned u32x2 __attribute__((ext_vector_type(2)));

#ifdef EMU
#define MFMA32(a, b, c) emu_mfma_32x32x16((a), (b), (c))
#define MFMA16(a, b, c) emu_mfma_16x16x32((a), (b), (c))
#define DI static inline
#define DM inline
#define EXP2F(x) exp2f(x)
#define WAVE_SYNC() emu_wave_sync()
#define LD_NT(p) (*(p))
#define LD_ATOMIC(p) (*(p))
#define ST_ATOMIC(p, v) (*(p) = (v))
#define SCHED_FENCE() do {} while (0)
#else
#define WAVE_SYNC() do { __builtin_amdgcn_fence(__ATOMIC_RELEASE, "wavefront"); __builtin_amdgcn_wave_barrier(); __builtin_amdgcn_fence(__ATOMIC_ACQUIRE, "wavefront"); } while (0)
#define MFMA32(a, b, c) __builtin_amdgcn_mfma_f32_32x32x16_bf16((a), (b), (c), 0, 0, 0)
#define LD_NT(p) __builtin_nontemporal_load(p)
#define LD_ATOMIC(p) __hip_atomic_load((p), __ATOMIC_RELAXED, __HIP_MEMORY_SCOPE_AGENT)
#define ST_ATOMIC(p, v) __hip_atomic_store((p), (v), __ATOMIC_RELAXED, __HIP_MEMORY_SCOPE_AGENT)
#define SCHED_FENCE() __builtin_amdgcn_sched_barrier(0)
#define MFMA16(a, b, c) __builtin_amdgcn_mfma_f32_16x16x32_bf16((a), (b), (c), 0, 0, 0)
#define DI __device__ __forceinline__
#define DM __device__ __forceinline__
#define EXP2F(x) __builtin_amdgcn_exp2f(x)
#endif

constexpr int D = 1024;
constexpr int NMETA = 16;
constexpr int LTOK = SEQ + NMETA;
constexpr int NCH = SEQ / 64 + 1;
constexpr int NT = 512;
constexpr int W_IN_COLS = 9232;
constexpr float NORM_EPS = 1e-6f;
constexpr float LOG2E = 1.4426950408889634f;

constexpr size_t UNIT = (size_t)SEQ * D * 2;
constexpr size_t OFF_WTIN = 0;
constexpr size_t OFF_WTBA = OFF_WTIN + (size_t)9216 * 1024 * 2;
constexpr size_t OFF_WTBD = OFF_WTBA + (size_t)1024 * 1024 * 2;
constexpr size_t OFF_WTOUT = OFF_WTBD + (size_t)1024 * 1024 * 2;
constexpr size_t OFF_SMALL = OFF_WTOUT + (size_t)1024 * 1024 * 2;
constexpr size_t SM_CTL = 0;
constexpr size_t SM_UMETA = SM_CTL + 65536;
constexpr size_t SM_AKMETA = SM_UMETA + 16 * 1024 * 2;
constexpr size_t SM_AVTMETA = SM_AKMETA + 16 * 1024 * 2;
constexpr size_t SM_C0Q = SM_AVTMETA + 8 * 128 * 16 * 2;
constexpr size_t SM_C0K = SM_C0Q + 64 * 1024 * 2;
constexpr size_t SM_C0V = SM_C0K + 64 * 1024 * 2;
constexpr size_t SM_C0W = SM_C0V + 64 * 1024 * 2;
constexpr size_t SM_C0QK = SM_C0W + 8 * 64 * 128 * 2;
constexpr size_t SM_BETA = SM_C0QK + 8 * 64 * 64 * 2;
constexpr size_t SM_G = SM_BETA + (size_t)NCH * 64 * 8 * 4;
constexpr size_t SM_GC = SM_G + (size_t)NCH * 64 * 8 * 4;
constexpr size_t SM_WR = SM_GC + (size_t)NCH * 8 * 64 * 4;
constexpr size_t SM_RIDS = SM_WR + 2 * 64 * 1024 * 2;
constexpr size_t SM_RW = SM_RIDS + 0;
constexpr size_t SM_TAILS = SM_RW + (size_t)SEQ * 2 * 4;
constexpr size_t SM_TAILS_BYTES = ((size_t)NCH * 3 * 3072 * 2 > (size_t)32 * SEQ * 4) ? (size_t)NCH * 3 * 3072 * 2 : (size_t)32 * SEQ * 4;
constexpr size_t SM_END = SM_TAILS + SM_TAILS_BYTES;
constexpr size_t SMALL_BYTES = (SM_END + 255) & ~(size_t)255;
constexpr size_t OFF_U = ((OFF_SMALL + SMALL_BYTES + (1u << 20) - 1) >> 20) << 20;
constexpr size_t OFF_W = OFF_U + UNIT;
constexpr size_t OFF_KN = OFF_W + UNIT;
constexpr size_t OFF_QN = OFF_KN + UNIT;
constexpr size_t OFF_DG = OFF_QN + UNIT;
constexpr size_t OFF_V = OFF_DG + UNIT;
constexpr size_t OFF_AQ = OFF_V + UNIT;
constexpr size_t WS_BASE_END = OFF_AQ + UNIT;
constexpr size_t EXPERT_BYTES = (size_t)32 * 3 * 1024 * 256 * 2;
constexpr size_t OFF_EXP = (2 * UNIT >= EXPERT_BYTES) ? OFF_W : WS_BASE_END;
constexpr size_t WS_END1 = (OFF_EXP == OFF_W) ? WS_BASE_END : WS_BASE_END + EXPERT_BYTES;
constexpr size_t H_BYTES = ((size_t)2 * SEQ + 32 * 256) * 256 * 2;
constexpr size_t OFF_H = (H_BYTES <= UNIT) ? (OFF_SMALL + SMALL_BYTES + ((1u << 20) - 1)) / (1u << 20) * (1u << 20) : WS_END1;
constexpr size_t WS_END = (H_BYTES <= UNIT) ? WS_END1 : WS_END1 + H_BYTES;
constexpr size_t OFF_EXG = OFF_EXP, OFF_EXU = OFF_EXP + EXPERT_BYTES / 3, OFF_EXD = OFF_EXP + 2 * (EXPERT_BYTES / 3);
constexpr size_t OFF_QKB = OFF_U;
constexpr size_t OFF_OD = OFF_QN;
constexpr size_t OFF_Y = OFF_V;
#if SEQ == 16384
static_assert(WS_END <= (size_t)256 << 20, "workspace map exceeds 256 MiB");
static_assert(EXPERT_BYTES <= 2 * UNIT, "experts fit R2+R3");
#endif
constexpr int CW_ATTQ = 64;
constexpr int CW_ECNT = 128;
constexpr int CW_NRM = 256;
constexpr int CW_BAR = 1024;

struct Params {
    const float* in[25];
    float* out;
    unsigned char* ws;
};

#ifdef EMU
DI unsigned f2bf(float f) { unsigned u = __builtin_bit_cast(unsigned, f); return (u + 0x7fffu + ((u >> 16) & 1u)) >> 16; }
#else
DI unsigned f2bf(float f) { return (unsigned)__builtin_bit_cast(unsigned short, (__bf16)f); }
#endif

DI float bf2f(unsigned b) { return __builtin_bit_cast(float, (b & 0xffffu) << 16); }
#ifdef EMU
DI unsigned pk2(float lo, float hi) { return f2bf(lo) | (f2bf(hi) << 16); }
DI bool wave_any(bool pr) { int v = pr ? 1 : 0;
    for (int o = 1; o < 64; o <<= 1) v |= __shfl_xor(v, o);
    return v != 0; }
#else
typedef __bf16 hwbf2 __attribute__((ext_vector_type(2)));
typedef float f32x2_ __attribute__((ext_vector_type(2)));
DI unsigned pk2(float lo, float hi) { return __builtin_bit_cast(unsigned, __builtin_convertvector((f32x2_){lo, hi}, hwbf2)); }
DI bool wave_any(bool pr) { return __any(pr) != 0; }
#endif
DI float bflo(unsigned w) { return __builtin_bit_cast(float, w << 16); }
DI float bfhi(unsigned w) { return __builtin_bit_cast(float, w & 0xffff0000u); }
#ifdef EMU
DI float rcpf_(float x) { return 1.0f / x; }
#else
DI float rcpf_(float x) { return __builtin_amdgcn_rcpf(x); }
#endif
DI float sigmoidf_(float x) { return rcpf_(1.0f + __expf(-x)); }
DI float siluf_(float x) { return x * rcpf_(1.0f + __expf(-x)); }
DI float wave_sum(float v) {
#pragma unroll
    for (int o = 1; o < 64; o <<= 1) v += __shfl_xor(v, o);
    return v;
}
DI int fresh_tid() {
    int t = threadIdx.x;
#ifndef EMU
    asm volatile("" : "+v"(t));
#endif
    return t;
}
#ifdef EMU
DI float xhalf(float v) { return __shfl_xor(v, 32); }
#else
DI float xhalf(float v) { const unsigned u = __builtin_bit_cast(unsigned, v); const auto r = __builtin_amdgcn_permlane32_swap(u, u, false, false); return __builtin_bit_cast(float, (threadIdx.x & 32) ? r[0] : r[1]); }
#endif
DI f32x16 zero16() { f32x16 z; for (int i = 0; i < 16; ++i) z[i] = 0.f; return z; }
DI f32x4 zero4() { f32x4 z; for (int i = 0; i < 4; ++i) z[i] = 0.f; return z; }
DI int swz128(int row, int c) { return row * 128 + ((c ^ ((row >> 1) & 7)) << 4); }
DI int swz128t(int row, int c) { return row * 128 + ((c ^ ((row >> 1) & 7) ^ ((row >> 4) & 7)) << 4); }
DI int swz128_8(int row, int s) { return row * 128 + ((s ^ (((row >> 1) & 7) << 1)) << 3); }
DI int swzrow(int row, int pitch, int c) { return row * pitch + ((c ^ (row & 15)) << 4); }

#ifdef EMU
#define SMEM_DECL char* smem = emu_smem()
#else
#define SMEM_DECL extern __shared__ __attribute__((aligned(16))) char smem[]
#endif

DI void transpose_item(const float* W, int ldw, int K, bf16* Wt, int k0, int src_n0, int dst_n0, float* scr, int lane, int il = 0) {
#pragma unroll 8
    for (int i = 0; i < 32; ++i) { const int kk = 2 * i + (lane >> 5); scr[kk * 33 + (lane & 31)] = W[(size_t)(k0 + kk) * ldw + src_n0 + (lane & 31)]; }
    WAVE_SYNC();
    const int c = lane & 7;
#pragma unroll
    for (int j = 0; j < 4; ++j) {
        const int n = (lane >> 3) + 8 * j; const float* s = scr + (8 * c) * 33 + n;
        u32x4 o; o.x = pk2(s[0 * 33], s[1 * 33]); o.y = pk2(s[2 * 33], s[3 * 33]); o.z = pk2(s[4 * 33], s[5 * 33]); o.w = pk2(s[6 * 33], s[7 * 33]);
        const int hid = dst_n0 + n, drow = il ? 8 * (hid >> 2) + 4 * (il - 1) + (hid & 3) : hid;
        *(u32x4*)(Wt + (size_t)drow * K + k0 + 8 * c) = o;
    }
    WAVE_SYNC();
}

DI void phase0(const Params& p, char* smem, int bid, int nblk) {
    const int tid = fresh_tid(), lane = tid & 63, wave = tid >> 6;
    const int gw = bid * 8 + wave, NGW = nblk * 8;
    unsigned char* ws = p.ws;
    if (bid == 0) {
        unsigned* ctl = (unsigned*)(ws + OFF_SMALL + SM_CTL);
        for (int i = tid; i < 1024; i += NT) ctl[i] = 0u;
        float* be = (float*)(ws + OFF_SMALL + SM_BETA); float* gg = (float*)(ws + OFF_SMALL + SM_G);
        for (int i = tid; i < 48 * 8; i += NT) { be[i] = 0.f; gg[i] = 0.f; }
    }
    {
        float* scr = (float*)(smem + 65536) + wave * (64 * 33);
        constexpr int I_IN = 16 * (9216 / 32), I_SQ = 16 * 32;
        constexpr int NITEMS = I_IN + 3 * I_SQ;
        for (int it = gw; it < NITEMS; it += NGW) {
            int r = it;
            if (r < I_IN) { const int kb = r / 288, nb = r % 288; const int dn = nb * 32; const int sn = dn < 7168 ? dn : dn + 16;
                transpose_item(p.in[3], W_IN_COLS, 1024, (bf16*)(ws + OFF_WTIN), kb * 64, sn, dn, scr, lane); continue; }
            r -= I_IN;
            const int m = r / I_SQ; r %= I_SQ;
            const float* src = m == 0 ? p.in[13] : (m == 1 ? p.in[14] : p.in[15]);
            bf16* dst = (bf16*)(ws + (m == 0 ? OFF_WTBA : (m == 1 ? OFF_WTBD : OFF_WTOUT)));
            transpose_item(src, 1024, 1024, dst, (r / 32) * 64, (r % 32) * 32, (r % 32) * 32, scr, lane);
        }
    }
    {
        bf16* WH = (bf16*)(ws + OFF_SMALL + SM_WR); bf16* WL = WH + 64 * 1024;
        for (int i = bid * NT + tid; i < 64 * 1024; i += nblk * NT) {
            const int n = i >> 10, kk = i & 1023; float v = 0.f;
            if (n < 4) v = p.in[17][kk * 4 + n]; else if (n < 36) v = p.in[19][kk * 32 + (n - 4)];
            v *= p.in[16][kk];
            const unsigned hb = f2bf(v); const float lo = v - bf2f(hb);
            WH[i] = (bf16)hb; WL[i] = (bf16)f2bf(lo);
        }
    }
    float* wbd = (float*)smem;
    for (int i = tid; i < 1024 * 16; i += NT) { const int k = i >> 4, c = i & 15; wbd[c * 1024 + k] = p.in[3][(size_t)k * W_IN_COLS + 7168 + c]; }
    __syncthreads();
    const float* nw = p.in[2];
    for (int R = gw; R < LTOK; R += NGW) {
        const float* xrow = R < NMETA ? p.in[1] + (size_t)R * D : p.in[0] + (size_t)(R - NMETA) * D;
        bf16* urow = R < NMETA ? (bf16*)(ws + OFF_SMALL + SM_UMETA) + (size_t)R * D : (bf16*)(ws + OFF_U) + (size_t)(R - NMETA) * D;
        float ss = 0.f;
#pragma unroll
        for (int j = 0; j < 4; ++j) { const float4 v = *(const float4*)(xrow + 4 * lane + 256 * j); ss += v.x * v.x + v.y * v.y + v.z * v.z + v.w * v.w; }
        ss = wave_sum(ss);
        const float rstd = rsqrtf(ss * (1.0f / D) + NORM_EPS);
        float acc[16];
#pragma unroll
        for (int c = 0; c < 16; ++c) acc[c] = 0.f;
#pragma unroll 1
        for (int j = 0; j < 4; ++j) {
            const float4 w4 = *(const float4*)(nw + 4 * lane + 256 * j);
            const float4 xv = *(const float4*)(xrow + 4 * lane + 256 * j);
            float uu[4] = {xv.x * rstd * w4.x, xv.y * rstd * w4.y, xv.z * rstd * w4.z, xv.w * rstd * w4.w};
            u32x2 o; o.x = pk2(uu[0], uu[1]); o.y = pk2(uu[2], uu[3]);
            *(u32x2*)(urow + 4 * lane + 256 * j) = o;
#pragma unroll
            for (int c = 0; c < 16; ++c) {
                const f32x4 w = *(const f32x4*)(wbd + c * 1024 + 4 * lane + 256 * j);
                acc[c] += uu[0] * w[0] + uu[1] * w[1] + uu[2] * w[2] + uu[3] * w[3];
            }
        }
        float v8[8], v4[4], v2[2], a;
        {
            const bool b0 = lane & 1, b1 = lane & 2, b2 = lane & 4, b3 = lane & 8;
#pragma unroll
            for (int i = 0; i < 8; ++i) { const float keep = b0 ? acc[i + 8] : acc[i], send = b0 ? acc[i] : acc[i + 8]; v8[i] = keep + __shfl_xor(send, 1); }
#pragma unroll
            for (int i = 0; i < 4; ++i) { const float keep = b1 ? v8[i + 4] : v8[i], send = b1 ? v8[i] : v8[i + 4]; v4[i] = keep + __shfl_xor(send, 2); }
#pragma unroll
            for (int i = 0; i < 2; ++i) { const float keep = b2 ? v4[i + 2] : v4[i], send = b2 ? v4[i] : v4[i + 2]; v2[i] = keep + __shfl_xor(send, 4); }
            { const float keep = b3 ? v2[1] : v2[0], send = b3 ? v2[0] : v2[1]; a = keep + __shfl_xor(send, 8); }
            a += __shfl_xor(a, 16); a += __shfl_xor(a, 32);
        }
        if (lane < 16) {
            const int cc = ((lane & 1) << 3) | ((lane & 2) << 1) | ((lane & 4) >> 1) | ((lane & 8) >> 3);
            const size_t pos = 48 + R;
            if (cc < 8) { ((float*)(ws + OFF_SMALL + SM_BETA))[pos * 8 + cc] = sigmoidf_(a); }
            else { const int hh = cc - 8; const float z = a + p.in[11][hh]; const float sp = fmaxf(z, 0.f) + log1pf(__expf(-fabsf(z)));
                   ((float*)(ws + OFF_SMALL + SM_G))[pos * 8 + hh] = -__expf(p.in[10][hh]) * sp; }
        }
    }
}

namespace pg8 {
constexpr int BM = 256, BK = 64, HALF = 128, HTB = HALF * BK * 2, NXCD = 8, WGM = 8;
DI int lds_byte(int r, int c) { const int st = (r >> 4) * 2 + (c >> 5), rr = r & 15, cc = c & 31, ob = rr * 64 + cc * 2; return st * 1024 + (ob ^ (((ob >> 9) & 1) << 5)); }
DI void stage_rc(int b, int& R, int& C) { const int st = b / 1024, sb = b % 1024, swz = sb ^ (((sb >> 9) & 1) << 5); R = (st >> 1) * 16 + swz / 64; C = (st & 1) * 32 + (swz % 64) / 2; }
DI int perm32(int rho) { const int n = rho >> 4, i = rho & 15; return 8 * (i >> 2) + 4 * n + (i & 3); }
struct Unit { int pm, pn, e; };
struct Gemm { const bf16* A; const bf16* Bt; int M, N, K; };
struct StaticOrder {
    static constexpr bool GATHER = false;
    int nM, nN, nwg, G, c;
    DM void init(int M, int N, int G_, int c_) { nM = M / BM; nN = N / BM; nwg = nM * nN; G = G_; c = c_; }
    DM bool next(int i, Unit& u) const {
        const long L = (long)i * G + c; if (L >= nwg) return false;
        int wgid = (int)L; { const int q = nwg / NXCD, r = nwg % NXCD, xcd = wgid % NXCD, off = wgid / NXCD; wgid = (xcd < r ? xcd * (q + 1) : r * (q + 1) + (xcd - r) * q) + off; }
        const int nig = WGM * nN, gid = wgid / nig, fm = gid * WGM, gsz = (nM - fm) < WGM ? (nM - fm) : WGM;
        u.pm = fm + ((wgid % nig) % gsz); u.pn = (wgid % nig) / gsz; u.e = 0; return true;
    }
    DM const char* a_tile(const Gemm& g, const Unit& u) const { return (const char*)g.A + (size_t)u.pm * 256 * g.K * 2; }
    DM const char* b_tile(const Gemm& g, const Unit& u) const { return (const char*)g.Bt + (size_t)u.pn * 256 * g.K * 2; }
    DM int a_row(const Unit&, int) const { return 0; }
};
#ifdef EMU
template <class Epi, class Sched>
DI void gemm_phase(char* lds, const Gemm g, const Sched& S, const Epi& E) {
    const int tid = threadIdx.x, wid = tid >> 6, lane = tid & 63, wr = wid >> 2, wc = wid & 3, fr = lane & 15, fq = lane >> 4;
    Unit u;
    for (int ui = 0; S.next(ui, u); ++ui) {
        f32x4 acc[2][2][4][2];
        const bf16* bt = (const bf16*)S.b_tile(g, u);
        for (int ai = 0; ai < 2; ++ai) for (int bj = 0; bj < 2; ++bj) for (int m = 0; m < 4; ++m) for (int n = 0; n < 2; ++n) for (int e = 0; e < 4; ++e) {
            const int r = 128 * ai + 64 * wr + 16 * m + fr;
            const int c = 128 * bj + 32 * wc + (Epi::PERM ? 8 * fq + 4 * n : 16 * n + 4 * fq) + e;
            const bf16* a = Sched::GATHER ? g.A + (size_t)S.a_row(u, r) * g.K : (const bf16*)S.a_tile(g, u) + (size_t)r * g.K;
            const bf16* b = bt + (size_t)c * g.K; float s = 0.f;
            for (int kk = 0; kk < g.K; ++kk) s += bf2f(a[kk]) * bf2f(b[kk]);
            acc[ai][bj][m][n][e] = s;
        }
        E(acc, u, wr, wc, fr, fq);
    }
    __syncthreads();
}
#else
#define PG8_LAS __attribute__((address_space(3)))
template <class Epi, class Sched>
__device__ __forceinline__ void gemm_phase(char* lds_, const Gemm g, const Sched& S, const Epi& E) {
    PG8_LAS unsigned char* lds = (PG8_LAS unsigned char*)lds_;
    const int tid = fresh_tid(), wid = __builtin_amdgcn_readfirstlane(tid >> 6), lane = tid & 63, wr = wid >> 2, wc = wid & 3, fr = lane & 15, fq = lane >> 4;
    const int K = g.K, nt = K / BK;
    unsigned voffA[2], voffB[2]; int RA[2], CA[2];
#pragma unroll
    for (int i = 0; i < 2; ++i) { int R, C; stage_rc(tid * 16 + i * 8192, R, C); const int Rb = Epi::PERM ? ((R & ~31) + perm32(R & 31)) : R;
        voffA[i] = (unsigned)(R * K + C) * 2u; voffB[i] = (unsigned)(Rb * K + C) * 2u; RA[i] = R; CA[i] = C; }
    const size_t kstep = (size_t)(BK * 2);
    const size_t hstep = (size_t)HALF * K * 2;
    const unsigned ldsw = (unsigned)wid * 1024u;
    const int aoff = lds_byte(wr * 64 + fr, fq * 8), boff = lds_byte(wc * 32 + fr, fq * 8);
#define PG8_SA(b, h) (((b) * 2 + (h)) * HTB)
#define PG8_SB(b, h) ((4 + (b) * 2 + (h)) * HTB)
#define PG8_STAGE(bufoff, gbase, voff) do { _Pragma("unroll") for (int _i = 0; _i < 2; ++_i) \
        __builtin_amdgcn_global_load_lds((const unsigned*)((const char*)(gbase) + (voff)[_i]), (PG8_LAS unsigned*)(lds + (bufoff) + ldsw + _i * 8192), 16, 0, 0); } while (0)
#define PG8_STAGE_A(bufoff, base, PA, half, koff) do { if constexpr (Sched::GATHER) { _Pragma("unroll") for (int _i = 0; _i < 2; ++_i) \
        __builtin_amdgcn_global_load_lds((const unsigned*)((PA)[half][_i] + (koff)), (PG8_LAS unsigned*)(lds + (bufoff) + ldsw + _i * 8192), 16, 0, 0); } \
        else { PG8_STAGE(bufoff, (base) + (half) * hstep + (koff), voffA); } } while (0)
#define PG8_LDA(dst, b, h) do { _Pragma("unroll") for (int m = 0; m < 4; ++m) _Pragma("unroll") for (int k = 0; k < 2; ++k) dst[m][k] = *(const PG8_LAS bf16x8*)(lds + PG8_SA(b, h) + aoff + m * 2048 + k * 1024); } while (0)
#define PG8_LDB(dst, b, h) do { _Pragma("unroll") for (int n = 0; n < 2; ++n) _Pragma("unroll") for (int k = 0; k < 2; ++k) dst[n][k] = *(const PG8_LAS bf16x8*)(lds + PG8_SB(b, h) + boff + n * 2048 + k * 1024); } while (0)
#define PG8_MMA(ai, bj, At, Bt) do { __builtin_amdgcn_s_setprio(1); _Pragma("unroll") for (int m = 0; m < 4; ++m) _Pragma("unroll") for (int n = 0; n < 2; ++n) _Pragma("unroll") for (int k = 0; k < 2; ++k) \
        acc[ai][bj][m][n] = __builtin_amdgcn_mfma_f32_16x16x32_bf16(Bt[n][k], At[m][k], acc[ai][bj][m][n], 0, 0, 0); __builtin_amdgcn_s_setprio(0); } while (0)
#define PG8_WAIT_V(n) asm volatile("s_waitcnt vmcnt(" #n ")" ::: "memory")
#define PG8_WAIT_L(n) asm volatile("s_waitcnt lgkmcnt(" #n ")" ::: "memory")
#define PG8_BAR __builtin_amdgcn_s_barrier()
#define PG8_SCHED __builtin_amdgcn_sched_barrier(0)
    Unit cur, nxt; int ui = 0;
    if (S.next(0, cur)) {
    f32x4 acc[2][2][4][2];
#pragma unroll
    for (int a = 0; a < 2; ++a)
#pragma unroll
        for (int b = 0; b < 2; ++b)
#pragma unroll
            for (int m = 0; m < 4; ++m)
#pragma unroll
                for (int n = 0; n < 2; ++n) acc[a][b][m][n] = (f32x4){0.f, 0.f, 0.f, 0.f};
    bf16x8 At[4][2], B0[2][2], B1[2][2];
    const char* PAc[2][2]; const char* PAn[2][2];
    auto gather_ptrs = [&](const Unit& u, const char* (&PA)[2][2]) {
        if constexpr (Sched::GATHER) {
#pragma unroll
            for (int hh = 0; hh < 2; ++hh)
#pragma unroll
                for (int i = 0; i < 2; ++i) PA[hh][i] = (const char*)g.A + ((size_t)S.a_row(u, hh * 128 + RA[i]) * K + CA[i]) * 2;
        }
    };
    const char* cA = Sched::GATHER ? nullptr : S.a_tile(g, cur); const char* cB = S.b_tile(g, cur);
    gather_ptrs(cur, PAc);
    PG8_STAGE(PG8_SB(0, 0), cB, voffB); PG8_STAGE_A(PG8_SA(0, 0), cA, PAc, 0, 0); PG8_STAGE(PG8_SB(0, 1), cB + hstep, voffB); PG8_STAGE_A(PG8_SA(0, 1), cA, PAc, 1, 0);
    if (wr == 1) PG8_BAR;
    PG8_WAIT_V(4); PG8_BAR;
    PG8_STAGE(PG8_SB(1, 0), cB + kstep, voffB); PG8_STAGE_A(PG8_SA(1, 0), cA, PAc, 0, kstep); PG8_STAGE(PG8_SB(1, 1), cB + hstep + kstep, voffB);
    PG8_WAIT_V(6); PG8_BAR;
    for (;;) {
        const bool has_next = S.next(ui + 1, nxt);
        const char* nA = Sched::GATHER ? nullptr : (has_next ? S.a_tile(g, nxt) : cA); const char* nB = has_next ? S.b_tile(g, nxt) : cB;
        if (has_next) gather_ptrs(nxt, PAn); else { if constexpr (Sched::GATHER) { PAn[0][0] = PAc[0][0]; PAn[0][1] = PAc[0][1]; PAn[1][0] = PAc[1][0]; PAn[1][1] = PAc[1][1]; } }
        for (int t = 0; t < nt; t += 2) {
            const bool last = (t == nt - 2);
            const size_t k1 = (size_t)(t + 1) * kstep;
            const char* a2 = last ? nA : cA; const char* b2 = last ? nB : cB + (size_t)(t + 2) * kstep;
            const size_t k2 = last ? 0 : (size_t)(t + 2) * kstep, k3 = k2 + kstep;
            const char* b3 = b2 + kstep;
            const char* P2[2][2];
            if constexpr (Sched::GATHER) {
#pragma unroll
                for (int hh = 0; hh < 2; ++hh)
#pragma unroll
                    for (int i = 0; i < 2; ++i) P2[hh][i] = last ? PAn[hh][i] : PAc[hh][i];
            }
            PG8_LDB(B0, 0, 0); PG8_SCHED; PG8_LDA(At, 0, 0); PG8_STAGE_A(PG8_SA(1, 1), cA, PAc, 1, k1);
            PG8_WAIT_L(8); PG8_BAR; PG8_WAIT_L(0); PG8_MMA(0, 0, At, B0); PG8_BAR; PG8_SCHED;
            PG8_LDB(B1, 0, 1); PG8_STAGE(PG8_SB(0, 0), b2, voffB);
            PG8_BAR; PG8_WAIT_L(0); PG8_MMA(0, 1, At, B1); PG8_BAR;
            PG8_LDA(At, 0, 1); PG8_STAGE_A(PG8_SA(0, 0), a2, P2, 0, k2);
            PG8_BAR; PG8_WAIT_L(0); PG8_MMA(1, 0, At, B0); PG8_BAR; PG8_SCHED;
            PG8_STAGE(PG8_SB(0, 1), b2 + hstep, voffB);
            PG8_WAIT_V(6); PG8_BAR; PG8_MMA(1, 1, At, B1); PG8_BAR;
            PG8_LDB(B0, 1, 0); PG8_SCHED; PG8_LDA(At, 1, 0); PG8_STAGE_A(PG8_SA(0, 1), a2, P2, 1, k2);
            PG8_WAIT_L(8); PG8_BAR; PG8_WAIT_L(0); PG8_MMA(0, 0, At, B0); PG8_BAR; PG8_SCHED;
            PG8_LDB(B1, 1, 1); PG8_STAGE(PG8_SB(1, 0), b3, voffB);
            PG8_BAR; PG8_WAIT_L(0); PG8_MMA(0, 1, At, B1); PG8_BAR;
            PG8_LDA(At, 1, 1); PG8_STAGE_A(PG8_SA(1, 0), a2, P2, 0, k3);
            PG8_BAR; PG8_WAIT_L(0); PG8_MMA(1, 0, At, B0); PG8_BAR; PG8_SCHED;
            PG8_STAGE(PG8_SB(1, 1), b3 + hstep, voffB);
            PG8_WAIT_V(6); PG8_BAR; PG8_MMA(1, 1, At, B1); PG8_BAR;
        }
        E(acc, cur, wr, wc, fr, fq);
        if (!has_next) break;
#pragma unroll
        for (int a = 0; a < 2; ++a)
#pragma unroll
            for (int b = 0; b < 2; ++b)
#pragma unroll
                for (int m = 0; m < 4; ++m)
#pragma unroll
                    for (int n = 0; n < 2; ++n) acc[a][b][m][n] = (f32x4){0.f, 0.f, 0.f, 0.f};
        cur = nxt; cA = nA; cB = nB; ++ui;
        if constexpr (Sched::GATHER) { PAc[0][0] = PAn[0][0]; PAc[0][1] = PAn[0][1]; PAc[1][0] = PAn[1][0]; PAc[1][1] = PAn[1][1]; }
    }
    PG8_WAIT_V(0);
    if (wr == 0) PG8_BAR;
    PG8_BAR;
    }
    __syncthreads();
#undef PG8_SA
#undef PG8_SB
#undef PG8_STAGE
#undef PG8_STAGE_A
#undef PG8_LDA
#undef PG8_LDB
#undef PG8_MMA
#undef PG8_WAIT_V
#undef PG8_WAIT_L
#undef PG8_BAR
#undef PG8_SCHED
}
#endif
}

constexpr int G_BM = 256, G_BN = 128, G_BK = 64;
constexpr int G_LDS_A = G_BM * G_BK * 2, G_LDS_B = G_BN * G_BK * 2;
constexpr int G_STAGE_PITCH = 132;
constexpr int G_LDS_BYTES = G_BM * G_STAGE_PITCH * 4;
constexpr int G_MT = SEQ / 256 + 1, G_NTILES = 56;

DI void gemm_inproj_tile(const Params& p, char* smem, int mt, int nt) {
    const int tid = fresh_tid(), lane = tid & 63, wave = tid >> 6;
    const int wm = wave >> 1, wn = wave & 1, r32 = lane & 31, h = lane >> 5;
    unsigned char* ws = p.ws;
    const bool meta = (mt == G_MT - 1);
    const bf16* A = meta ? (const bf16*)(ws + OFF_SMALL + SM_UMETA) : (const bf16*)(ws + OFF_U) + (size_t)mt * 256 * D;
    const int vrows = meta ? NMETA : 256;
    const bf16* Bt = (const bf16*)(ws + OFF_WTIN) + (size_t)nt * 128 * D;
    char* ldsA[2] = {smem, smem + G_LDS_A + G_LDS_B};
    char* ldsB[2] = {smem + G_LDS_A, smem + 2 * G_LDS_A + G_LDS_B};
    f32x16 acc[2][2];
#pragma unroll
    for (int i = 0; i < 2; ++i)
#pragma unroll
        for (int j = 0; j < 2; ++j) acc[i][j] = zero16();
    const int lrow = tid >> 3, lc = tid & 7;
    u32x4 ra[4], rb[2];
    auto gload = [&](int kt) {
#pragma unroll
        for (int i = 0; i < 4; ++i) { const int row = lrow + 64 * i; ra[i] = row < vrows ? *(const u32x4*)(A + (size_t)row * D + kt * 64 + lc * 8) : (u32x4){0u, 0u, 0u, 0u}; }
#pragma unroll
        for (int i = 0; i < 2; ++i) { const int row = lrow + 64 * i; rb[i] = *(const u32x4*)(Bt + (size_t)row * D + kt * 64 + lc * 8); }
    };
    auto lstore = [&](int buf) {
#pragma unroll
        for (int i = 0; i < 4; ++i) *(u32x4*)(ldsA[buf] + swz128(lrow + 64 * i, lc)) = ra[i];
#pragma unroll
        for (int i = 0; i < 2; ++i) *(u32x4*)(ldsB[buf] + swz128(lrow + 64 * i, lc)) = rb[i];
    };
    gload(0); lstore(0); __syncthreads();
    for (int kt = 0; kt < 16; ++kt) {
        const int buf = kt & 1;
        if (kt + 1 < 16) gload(kt + 1);
#pragma unroll
        for (int ks = 0; ks < 4; ++ks) {
            bf16x8 af[2], bfr[2];
#pragma unroll
            for (int i = 0; i < 2; ++i) af[i] = *(const bf16x8*)(ldsA[buf] + swz128(64 * wm + 32 * i + r32, 2 * ks + h));
#pragma unroll
            for (int j = 0; j < 2; ++j) bfr[j] = *(const bf16x8*)(ldsB[buf] + swz128(64 * wn + 32 * j + r32, 2 * ks + h));
#pragma unroll
            for (int i = 0; i < 2; ++i)
#pragma unroll
                for (int j = 0; j < 2; ++j) acc[i][j] = MFMA32(af[i], bfr[j], acc[i][j]);
        }
        if (kt + 1 < 16) lstore(buf ^ 1);
        __syncthreads();
    }
    float* st = (float*)smem;
#pragma unroll
    for (int i = 0; i < 2; ++i)
#pragma unroll
        for (int j = 0; j < 2; ++j)
#pragma unroll
            for (int r = 0; r < 16; ++r) {
                const int row = 64 * wm + 32 * i + (r & 3) + 8 * (r >> 2) + 4 * h, col = 64 * wn + 32 * j + r32;
                st[row * G_STAGE_PITCH + col] = acc[i][j][r];
            }
    __syncthreads();
    const int tid2 = fresh_tid();
    const int sec = nt >> 3, cb = (nt & 7) * 128;
    {
        bf16* base; bool has_meta = true; bf16* mbase = nullptr; int mrow0 = 0;
        if (sec == 0) { base = (bf16*)(ws + OFF_AQ); has_meta = false; }
        else if (sec == 1) { base = (bf16*)p.out; mbase = (bf16*)(ws + OFF_SMALL + SM_AKMETA); }
        else if (sec == 2) { base = (bf16*)p.out + (size_t)SEQ * D; mbase = (bf16*)(ws + OFF_SMALL + SM_AVTMETA); }
        else if (sec == 3) { base = (bf16*)(ws + OFF_QN); mbase = (bf16*)(ws + OFF_SMALL + SM_C0Q); mrow0 = 48; }
        else if (sec == 4) { base = (bf16*)(ws + OFF_KN); mbase = (bf16*)(ws + OFF_SMALL + SM_C0K); mrow0 = 48; }
        else if (sec == 5) { base = (bf16*)(ws + OFF_V); mbase = (bf16*)(ws + OFF_SMALL + SM_C0V); mrow0 = 48; }
        else { base = (bf16*)(ws + OFF_DG); has_meta = false; }
        const bool dqkv = (sec >= 3 && sec <= 5);
        bf16* tails = (bf16*)(ws + OFF_SMALL + SM_TAILS);
        if (!meta || has_meta) {
#pragma unroll
            for (int i = 0; i < 8; ++i) {
                const int idx = tid2 + NT * i, row = idx >> 4, cg = idx & 15;
                if (row < vrows) {
                    const float* s = st + row * G_STAGE_PITCH + cg * 8;
                    const f32x4 a = *(const f32x4*)s, b = *(const f32x4*)(s + 4);
                    u32x4 o; o.x = pk2(a[0], a[1]); o.y = pk2(a[2], a[3]); o.z = pk2(b[0], b[1]); o.w = pk2(b[2], b[3]);
                    if (!meta) {
                        const int j = mt * 256 + row;
                        *(u32x4*)(base + (size_t)j * D + cb + cg * 8) = o;
                        if (dqkv && (j & 63) >= 61) *(u32x4*)(tails + ((size_t)(j / 64 + 1) * 3 + ((j & 63) - 61)) * 3072 + (sec - 3) * 1024 + cb + cg * 8) = o;
                    } else {
                        *(u32x4*)(mbase + (size_t)(mrow0 + row) * D + cb + cg * 8) = o;
                        if (dqkv && row >= 13) *(u32x4*)(tails + ((size_t)0 * 3 + (row - 13)) * 3072 + (sec - 3) * 1024 + cb + cg * 8) = o;
                    }
                }
            }
        }
    }
    __syncthreads();
}

struct EpiInproj {
    static constexpr bool PERM = true;
    unsigned char* ws; bf16* out16;
    DM void operator()(const f32x4 (&acc)[2][2][4][2], const pg8::Unit& u, int wr, int wc, int fr, int fq) const {
        const int colt = u.pn * 256, sec = colt >> 10, cb = colt & 1023;
        bf16* base = sec == 0 ? (bf16*)(ws + OFF_AQ) : sec == 1 ? out16 : sec == 2 ? out16 + (size_t)SEQ * D : sec == 3 ? (bf16*)(ws + OFF_QN) : sec == 4 ? (bf16*)(ws + OFF_KN)
                   : sec == 5 ? (bf16*)(ws + OFF_V) : (bf16*)(ws + OFF_DG);
        const bool dqkv = sec >= 3 && sec <= 5;
        bf16* tails = (bf16*)(ws + OFF_SMALL + SM_TAILS) + (sec - 3) * 1024;
        const int row0 = u.pm * 256 + wr * 64 + fr, col0 = cb + wc * 32 + 8 * fq;
#pragma unroll
        for (int ai = 0; ai < 2; ++ai)
#pragma unroll
            for (int m = 0; m < 4; ++m) {
                const int j = row0 + ai * 128 + m * 16;
                bf16* rowp = base + (size_t)j * D + col0;
                const bool tl = dqkv && (j & 63) >= 61;
#pragma unroll
                for (int bj = 0; bj < 2; ++bj) {
                    const f32x4 v0 = acc[ai][bj][m][0], v1 = acc[ai][bj][m][1];
                    const u32x4 w = {pk2(v0[0], v0[1]), pk2(v0[2], v0[3]), pk2(v1[0], v1[1]), pk2(v1[2], v1[3])};
                    *(u32x4*)(rowp + bj * 128) = w;
                    if (tl) *(u32x4*)(tails + ((size_t)(j / 64 + 1) * 3 + ((j & 63) - 61)) * 3072 + col0 + bj * 128) = w;
                }
            }
    }
};
DI void phase1(const Params& p, char* smem, int bid, int nblk) {
    for (int it = bid; it < 40; it += nblk) gemm_inproj_tile(p, smem, G_MT - 1, 8 + it);
    pg8::Gemm g{(const bf16*)(p.ws + OFF_U), (const bf16*)(p.ws + OFF_WTIN), SEQ, 7168, 1024};
    pg8::StaticOrder S; S.init(SEQ, 7168, nblk, bid);
    EpiInproj E{p.ws, (bf16*)p.out};
    pg8::gemm_phase(smem, g, S, E);
}

constexpr int P2_KN = 0, P2_KB = 16384, P2_QN = 32768, P2_KBGT = 49152, P2_VBT = 65536, P2_KDT = 81920, P2_ALDS = 98304, P2_TLDS = P2_ALDS + 64 * 64 * 4,
              P2_GC = P2_TLDS + 8192, P2_BET = P2_GC + 256, P2_EG = P2_BET + 256, P2_EKD = P2_EG + 256, P2_CW = P2_EKD + 256;

DI void prep_item(const Params& p, char* smem, int chunk, int head, int dry, bool load_cw) {
    const int tid = fresh_tid(), lane = tid & 63, wave = tid >> 6, r32 = lane & 31, h = lane >> 5;
    unsigned char* ws = p.ws;
    float* gcl = (float*)(smem + P2_GC); float* betl = (float*)(smem + P2_BET); float* egl = (float*)(smem + P2_EG); float* ekdl = (float*)(smem + P2_EKD);
    if (load_cw) {
        float* cwl = (float*)(smem + P2_CW);
        for (int i = tid; i < 4 * 3 * 128; i += NT) { const int jj = i / 384, rem = i % 384, mat = rem >> 7, c = rem & 127; cwl[i] = p.in[9][(size_t)jj * 3072 + mat * 1024 + head * 128 + c]; }
    }
    const int r = tid >> 3, cg = tid & 7, col0 = head * 128 + 16 * cg;
    const bf16* tails = (const bf16*)(ws + OFF_SMALL + SM_TAILS);
        u32x4 raw[3][4][2];
#pragma unroll
    for (int mat = 0; mat < 3; ++mat) {
        const bf16* mainb = (const bf16*)(ws + (mat == 0 ? OFF_QN : (mat == 1 ? OFF_KN : OFF_V)));
        const bf16* c0b = (const bf16*)(ws + OFF_SMALL + (mat == 0 ? SM_C0Q : (mat == 1 ? SM_C0K : SM_C0V)));
#pragma unroll
        for (int jj = 0; jj < 4; ++jj) {
            const int rr = r - 3 + jj;
            const bf16* src = nullptr;
            if (chunk == 0) { if (rr >= 48) src = c0b + (size_t)rr * D + col0; }
            else if (rr >= 0) src = mainb + ((size_t)(chunk - 1) * 64 + rr) * D + col0;
            else src = tails + ((size_t)(chunk - 1) * 3 + (3 + rr)) * 3072 + mat * 1024 + col0;
            raw[mat][jj][0] = (u32x4){0u, 0u, 0u, 0u}; raw[mat][jj][1] = (u32x4){0u, 0u, 0u, 0u};
            if (src) { raw[mat][jj][0] = *(const u32x4*)src; raw[mat][jj][1] = *(const u32x4*)(src + 8); }
        }
    }
    if (wave == 0) {
        const size_t pos = (size_t)chunk * 64 + lane;
        float v = ((const float*)(ws + OFF_SMALL + SM_G))[pos * 8 + head];
        const float b = ((const float*)(ws + OFF_SMALL + SM_BETA))[pos * 8 + head];
#pragma unroll
        for (int o = 1; o < 64; o <<= 1) { const float t = __shfl_up(v, o); if (lane >= o) v += t; }
        const float gl = __shfl(v, 63);
        gcl[lane] = v; betl[lane] = b; egl[lane] = __expf(v); ekdl[lane] = __expf(gl - v);
        if (!dry) ((float*)(ws + OFF_SMALL + SM_GC))[((size_t)chunk * 8 + head) * 64 + lane] = v;
    }
    __syncthreads();
    {
        const bool zero_row = (chunk == 0 && r < 48);
        const float beta = betl[r], eg = egl[r], ekd = ekdl[r];
#pragma unroll
        for (int mat = 0; mat < 3; ++mat) {
            bf16* mainb = (bf16*)(ws + (mat == 0 ? OFF_QN : (mat == 1 ? OFF_KN : OFF_V)));
            bf16* c0b = (bf16*)(ws + OFF_SMALL + (mat == 0 ? SM_C0Q : (mat == 1 ? SM_C0K : SM_C0V)));
            float y[16];
#pragma unroll
            for (int c = 0; c < 16; ++c) y[c] = 0.f;
#pragma unroll
            for (int jj = 0; jj < 4; ++jj) {
                const u32x4 a = raw[mat][jj][0], b = raw[mat][jj][1];
                const float* cw = (const float*)(smem + P2_CW) + (jj * 3 + mat) * 128 + 16 * cg;
                const f32x4 w0 = *(const f32x4*)cw, w1 = *(const f32x4*)(cw + 4), w2 = *(const f32x4*)(cw + 8), w3 = *(const f32x4*)(cw + 12);
                y[0] += w0[0] * bflo(a.x); y[1] += w0[1] * bfhi(a.x); y[2] += w0[2] * bflo(a.y); y[3] += w0[3] * bfhi(a.y);
                y[4] += w1[0] * bflo(a.z); y[5] += w1[1] * bfhi(a.z); y[6] += w1[2] * bflo(a.w); y[7] += w1[3] * bfhi(a.w);
                y[8] += w2[0] * bflo(b.x); y[9] += w2[1] * bfhi(b.x); y[10] += w2[2] * bflo(b.y); y[11] += w2[3] * bfhi(b.y);
                y[12] += w3[0] * bflo(b.z); y[13] += w3[1] * bfhi(b.z); y[14] += w3[2] * bflo(b.w); y[15] += w3[3] * bfhi(b.w);
            }
            if (mat == 0) __syncthreads();
            float ss = 0.f;
#pragma unroll
            for (int c = 0; c < 16; ++c) { y[c] = zero_row ? 0.f : siluf_(y[c]); ss += y[c] * y[c]; }
            if (mat < 2) {
                ss += __shfl_xor(ss, 1); ss += __shfl_xor(ss, 2); ss += __shfl_xor(ss, 4);
                const float sc = rsqrtf(ss + 1e-6f) * (mat == 0 ? 0.08838834764831845f : 1.0f);
                unsigned pk[8];
#pragma unroll
                for (int c = 0; c < 8; ++c) pk[c] = pk2(y[2 * c] * sc, y[2 * c + 1] * sc);
                if (mat == 0) {
                    *(u32x4*)(smem + P2_QN + swzrow(r, 256, 2 * cg)) = (u32x4){pk[0], pk[1], pk[2], pk[3]};
                    *(u32x4*)(smem + P2_QN + swzrow(r, 256, 2 * cg + 1)) = (u32x4){pk[4], pk[5], pk[6], pk[7]};
                    unsigned qd[8];
#pragma unroll
                    for (int c = 0; c < 8; ++c) qd[c] = pk2(bflo(pk[c]) * eg, bfhi(pk[c]) * eg);
                    bf16* dst = (chunk == 0) ? c0b + (size_t)r * D + col0 : mainb + ((size_t)(chunk - 1) * 64 + r) * D + col0;
                    if (!dry) { *(u32x4*)dst = (u32x4){qd[0], qd[1], qd[2], qd[3]}; *(u32x4*)(dst + 8) = (u32x4){qd[4], qd[5], qd[6], qd[7]}; }
                } else {
                    *(u32x4*)(smem + P2_KN + swzrow(r, 256, 2 * cg)) = (u32x4){pk[0], pk[1], pk[2], pk[3]};
                    *(u32x4*)(smem + P2_KN + swzrow(r, 256, 2 * cg + 1)) = (u32x4){pk[4], pk[5], pk[6], pk[7]};
                    unsigned kb[8];
#pragma unroll
                    for (int c = 0; c < 8; ++c) {
                        const float kr0 = bflo(pk[c]), kr1 = bfhi(pk[c]);
                        const float k0 = kr0 * beta, k1 = kr1 * beta;
                        kb[c] = pk2(k0, k1);
                        const int d0 = 16 * cg + 2 * c;
                        *(bf16*)(smem + P2_KBGT + swz128t(d0, r >> 3) + (r & 7) * 2) = (bf16)f2bf(k0 * eg);
                        *(bf16*)(smem + P2_KBGT + swz128t(d0 + 1, r >> 3) + (r & 7) * 2) = (bf16)f2bf(k1 * eg);
                        *(bf16*)(smem + P2_KDT + swz128t(d0, r >> 3) + (r & 7) * 2) = (bf16)f2bf(kr0 * ekd);
                        *(bf16*)(smem + P2_KDT + swz128t(d0 + 1, r >> 3) + (r & 7) * 2) = (bf16)f2bf(kr1 * ekd);
                    }
                    *(u32x4*)(smem + P2_KB + swzrow(r, 256, 2 * cg)) = (u32x4){kb[0], kb[1], kb[2], kb[3]};
                    *(u32x4*)(smem + P2_KB + swzrow(r, 256, 2 * cg + 1)) = (u32x4){kb[4], kb[5], kb[6], kb[7]};
                }
            } else {
#pragma unroll
                for (int c = 0; c < 16; ++c) {
                    const int e = 16 * cg + c;
                    *(bf16*)(smem + P2_VBT + swz128t(e, r >> 3) + (r & 7) * 2) = (bf16)f2bf(y[c] * beta);
                }
            }
        }
    }
    __syncthreads();
    {
        const int tile = wave & 3, m0 = tile >> 1, n0 = tile & 1;
        f32x16 acc = zero16();
        if (wave < 4) {
            if (n0 <= m0) {
#pragma unroll
                for (int ks = 0; ks < 8; ++ks) {
                    const bf16x8 a = *(const bf16x8*)(smem + P2_KB + swzrow(32 * m0 + r32, 256, 2 * ks + h));
                    const bf16x8 b = *(const bf16x8*)(smem + P2_KN + swzrow(32 * n0 + r32, 256, 2 * ks + h));
                    acc = MFMA32(a, b, acc);
                }
            }
            float* Al = (float*)(smem + P2_ALDS);
            const int j = 32 * n0 + r32; const float gj = gcl[j];
#pragma unroll
            for (int r = 0; r < 16; ++r) {
                const int i = 32 * m0 + (r & 3) + 8 * (r >> 2) + 4 * h;
                const float dv = acc[r] * __expf(gcl[i] - gj);
                Al[i * 64 + (j & 3) * 16 + (j >> 2)] = (j < i) ? dv : 0.f;
            }
        } else {
            if (m0 <= n0) {
#pragma unroll
                for (int ks = 0; ks < 8; ++ks) {
                    const bf16x8 a = *(const bf16x8*)(smem + P2_KN + swzrow(32 * m0 + r32, 256, 2 * ks + h));
                    const bf16x8 b = *(const bf16x8*)(smem + P2_QN + swzrow(32 * n0 + r32, 256, 2 * ks + h));
                    acc = MFMA32(a, b, acc);
                }
            }
            const int i = 32 * n0 + r32; const float gi = gcl[i];
            bf16* qkb = (chunk == 0) ? (bf16*)(ws + OFF_SMALL + SM_C0QK) + (size_t)head * 4096 : (bf16*)(ws + OFF_QKB) + ((size_t)(chunk - 1) * 8 + head) * 4096;
#pragma unroll
            for (int q4 = 0; q4 < 4; ++q4) {
                const int j0 = 32 * m0 + 8 * q4 + 4 * h; float v[4];
#pragma unroll
                for (int c = 0; c < 4; ++c) { const int j = j0 + c; const float dv = acc[4 * q4 + c] * __expf(gi - gcl[j]); v[c] = (j <= i) ? dv : 0.f; }
                if (!dry) *(u32x2*)(qkb + i * 64 + j0) = (u32x2){pk2(v[0], v[1]), pk2(v[2], v[3])};
            }
        }
        bf16* kbase = (chunk == 0) ? (bf16*)(ws + OFF_SMALL + SM_C0K) : (bf16*)(ws + OFF_KN) + (size_t)(chunk - 1) * 64 * D;
#pragma unroll
        for (int i2 = 0; i2 < 2; ++i2) {
            const int idx = tid + NT * i2, dk = idx >> 3, ch = idx & 7;
            const u32x4 v = *(const u32x4*)(smem + P2_KDT + swz128t(dk, ch));
            if (!dry) *(u32x4*)(kbase + (size_t)(dk >> 1) * D + head * 128 + (dk & 1) * 64 + ch * 8) = v;
        }
    }
    __syncthreads();
    if (wave < 4) {
        const float* Al = (const float*)(smem + P2_ALDS);
        const int c = lane >> 2, q = lane & 3, C = 16 * wave + c;
        float tq[16];
#pragma unroll
        for (int m = 0; m < 16; ++m) tq[m] = 0.f;
#pragma unroll
        for (int i = 0; i < 64; ++i) {
            constexpr int dummy = 0; (void)dummy;
            const int nm = (i + 3) >> 2;
            float s0 = 0.f, s1 = 0.f;
            const float* ar = Al + i * 64 + q * 16;
#pragma unroll
            for (int m = 0; m < 16; ++m) if (m < nm) { if (m & 1) s1 += ar[m] * tq[m]; else s0 += ar[m] * tq[m]; }
            float s = s0 + s1;
            s += __shfl_xor(s, 1); s += __shfl_xor(s, 2);
            const float ti = ((i == C) ? 1.f : 0.f) - s;
            if (q == (i & 3)) tq[i >> 2] = ti;
        }
#pragma unroll
        for (int m = 0; m < 16; ++m) { const int row = 4 * m + q; *(bf16*)(smem + P2_TLDS + swz128(row, C >> 3) + (C & 7) * 2) = (bf16)f2bf(tq[m]); }
    }
    __syncthreads();
    {
        const int mi = wave >> 2, ni = wave & 3;
        f32x16 acc = zero16();
#pragma unroll
        for (int ks = 0; ks < 4; ++ks) {
            const bf16x8 a = *(const bf16x8*)(smem + P2_TLDS + swz128(32 * mi + r32, 2 * ks + h));
            const bf16x8 b = *(const bf16x8*)(smem + P2_VBT + swz128t(32 * ni + r32, 2 * ks + h));
            acc = MFMA32(a, b, acc);
        }
        const int e = 32 * ni + r32;
        bf16* base = (chunk == 0) ? (bf16*)(ws + OFF_SMALL + SM_C0V) : (bf16*)(ws + OFF_V) + (size_t)(chunk - 1) * 64 * D;
        bf16* dst = base + (size_t)(e >> 1) * D + head * 128 + (e & 1) * 64;
#pragma unroll
        for (int q4 = 0; q4 < 4; ++q4) {
            const int c0 = 32 * mi + 8 * q4 + 4 * h;
            if (!dry) *(u32x2*)(dst + c0) = (u32x2){pk2(acc[4 * q4], acc[4 * q4 + 1]), pk2(acc[4 * q4 + 2], acc[4 * q4 + 3])};
        }
    }
    {
        const int mi = wave >> 1, ni = wave & 1;
        f32x16 acc = zero16();
#pragma unroll
        for (int ks = 0; ks < 4; ++ks) {
            const bf16x8 a = *(const bf16x8*)(smem + P2_KBGT + swz128t(32 * mi + r32, 2 * ks + h));
            const bf16x8 b = *(const bf16x8*)(smem + P2_TLDS + swz128(32 * ni + r32, 2 * ks + h));
            acc = MFMA32(a, b, acc);
        }
        const int c = 32 * ni + r32;
        bf16* wb = (chunk == 0) ? (bf16*)(ws + OFF_SMALL + SM_C0W) + (size_t)head * 8192 : (bf16*)(ws + OFF_W) + ((size_t)(chunk - 1) * 8 + head) * 8192;
#pragma unroll
        for (int q4 = 0; q4 < 4; ++q4) {
            const int dk0 = 32 * mi + 8 * q4 + 4 * h;
            if (!dry) *(u32x2*)(wb + c * 128 + dk0) = (u32x2){pk2(acc[4 * q4], acc[4 * q4 + 1]), pk2(acc[4 * q4 + 2], acc[4 * q4 + 3])};
        }
    }
    __syncthreads();
}

DI void phase2(const Params& p, char* smem, int bid, int nblk, int dry = 0) {
    { int cur_head = -1; for (int it = bid; it < NCH * 8; it += nblk) { const int hd = it & 7; prep_item(p, smem, it >> 3, hd, dry, hd != cur_head); cur_head = hd; } }
    {
        const int tid = fresh_tid(), lane = tid & 63, wave = tid >> 6;
        const int nextra = (NCH * 8) % nblk, skip = (nextra > 0 && 2 * nextra < nblk) ? nextra : 0;
        const int gw = (bid - skip) * 8 + wave, NGW = (nblk - skip) * 8;
        float mq = 0.f, mk = 0.f;
        auto sq16 = [](const u32x4& a, const u32x4& b) -> float {
            return bflo(a.x) * bflo(a.x) + bfhi(a.x) * bfhi(a.x) + bflo(a.y) * bflo(a.y) + bfhi(a.y) * bfhi(a.y) + bflo(a.z) * bflo(a.z) + bfhi(a.z) * bfhi(a.z) + bflo(a.w) * bflo(a.w) + bfhi(a.w) * bfhi(a.w)
                 + bflo(b.x) * bflo(b.x) + bfhi(b.x) * bfhi(b.x) + bflo(b.y) * bflo(b.y) + bfhi(b.y) * bfhi(b.y) + bflo(b.z) * bflo(b.z) + bfhi(b.z) * bfhi(b.z) + bflo(b.w) * bflo(b.w) + bfhi(b.w) * bfhi(b.w); };
        for (int j0 = (bid < skip ? SEQ + NMETA : gw); j0 < SEQ + NMETA; j0 += 4 * NGW) {
            u32x4 ka[4][2], qa[4][2];
#pragma unroll
            for (int u4 = 0; u4 < 4; ++u4) {
                const int j = j0 + u4 * NGW;
                ka[u4][0] = ka[u4][1] = qa[u4][0] = qa[u4][1] = (u32x4){0u, 0u, 0u, 0u};
                if (j < SEQ + NMETA) {
                    const bf16* kr = j < SEQ ? (const bf16*)p.out + (size_t)j * D + lane * 16 : (const bf16*)(p.ws + OFF_SMALL + SM_AKMETA) + (size_t)(j - SEQ) * D + lane * 16;
                    ka[u4][0] = *(const u32x4*)kr; ka[u4][1] = *(const u32x4*)(kr + 8);
                    if (j < SEQ) { const bf16* qr = (const bf16*)(p.ws + OFF_AQ) + (size_t)j * D + lane * 16; qa[u4][0] = *(const u32x4*)qr; qa[u4][1] = *(const u32x4*)(qr + 8); }
                }
            }
#pragma unroll
            for (int u4 = 0; u4 < 4; ++u4) {
                float s = sq16(ka[u4][0], ka[u4][1]), t = sq16(qa[u4][0], qa[u4][1]);
                s += __shfl_xor(s, 1); s += __shfl_xor(s, 2); t += __shfl_xor(t, 1); t += __shfl_xor(t, 2);
                mk = fmaxf(mk, s); mq = fmaxf(mq, t);
            }
        }
        float* red = (float*)smem;
        __syncthreads();
        if ((lane & 3) == 0) { red[wave * 32 + (lane >> 2)] = mq; red[wave * 32 + 16 + (lane >> 2)] = mk; }
        __syncthreads();
        if (tid < 32) {
            float m = 0.f;
#pragma unroll
            for (int w = 0; w < 8; ++w) m = fmaxf(m, red[w * 32 + tid]);
            unsigned* nrm = (unsigned*)(p.ws + OFF_SMALL + SM_CTL) + CW_NRM;
            atomicMax(nrm + tid, __builtin_bit_cast(unsigned, m));
        }
        __syncthreads();
    }
}

DI int swzrow8(int row, int pitch, int s) { return row * pitch + ((((s >> 1) ^ (row & 15)) << 4) | ((s & 1) << 3)); }
DI bf16x8 pack8(f32x4 a, f32x4 b) {
    u32x4 o; o.x = pk2(a[0], a[1]); o.y = pk2(a[2], a[3]); o.z = pk2(b[0], b[1]); o.w = pk2(b[2], b[3]);
    return __builtin_bit_cast(bf16x8, o);
}
DI bf16x8 ld2x8(const char* p0, const char* p1) {
    const u32x2 a = *(const u32x2*)p0, b = *(const u32x2*)p1; u32x4 o; o.x = a.x; o.y = a.y; o.z = b.x; o.w = b.y;
    return __builtin_bit_cast(bf16x8, o);
}
constexpr int SC_W = 0, SC_QD = 16384, SC_KDT = 32768, SC_QK = 49152, SC_BUF = 57344;

constexpr int SCAN_SPLIT = 2;
DI void scan_head(const Params& p, char* smem, int head, int sidx, int dry) {
    const int tid = fresh_tid(), lane = tid & 63, wave = tid >> 6, r16 = lane & 15, g = lane >> 4;
    const bool active = wave < 8 / SCAN_SPLIT; const int slice = sidx * (8 / SCAN_SPLIT) + (active ? wave : 0);
    unsigned char* ws = p.ws;
    const int lrow = tid >> 3, lch = (tid & 7) * 2;
    f32x4 S[8];
#pragma unroll
    for (int i = 0; i < 8; ++i) S[i] = zero4();
    u32x4 rw[2], rq[2], rk[2], rqk; u32x2 unext[4], ucur[4]; float gnext = 0.f, gcur = 0.f;
    auto uaddr = [&](int n, int mt) -> bf16* {
        const int e = 16 * slice + r16;
        bf16* base = n == 0 ? (bf16*)(ws + OFF_SMALL + SM_C0V) : (bf16*)(ws + OFF_V) + (size_t)(n - 1) * 64 * D;
        return base + (size_t)(e >> 1) * D + head * 128 + (e & 1) * 64 + 16 * mt + 4 * g;
    };
    auto gloadA = [&](int n) {
        const bf16* wsrc = (n == 0 ? (const bf16*)(ws + OFF_SMALL + SM_C0W) + (size_t)head * 8192 : (const bf16*)(ws + OFF_W) + ((size_t)(n - 1) * 8 + head) * 8192) + lrow * 128 + lch * 8;
        rw[0] = *(const u32x4*)wsrc; rw[1] = *(const u32x4*)(wsrc + 8);
        const bf16* qs = (n == 0 ? (const bf16*)(ws + OFF_SMALL + SM_C0Q) : (const bf16*)(ws + OFF_QN) + (size_t)(n - 1) * 64 * D) + (size_t)lrow * D + head * 128 + lch * 8;
        rq[0] = *(const u32x4*)qs; rq[1] = *(const u32x4*)(qs + 8);
        const bf16* ks = (n == 0 ? (const bf16*)(ws + OFF_SMALL + SM_C0K) : (const bf16*)(ws + OFF_KN) + (size_t)(n - 1) * 64 * D) + (size_t)lrow * D + head * 128 + lch * 8;
        rk[0] = *(const u32x4*)ks; rk[1] = *(const u32x4*)(ks + 8);
        const bf16* qk = (n == 0 ? (const bf16*)(ws + OFF_SMALL + SM_C0QK) + (size_t)head * 4096 : (const bf16*)(ws + OFF_QKB) + ((size_t)(n - 1) * 8 + head) * 4096) + tid * 8;
        rqk = *(const u32x4*)qk;
    };
    auto gloadU = [&](int n) {
#pragma unroll
        for (int mt = 0; mt < 4; ++mt) unext[mt] = *(const u32x2*)uaddr(n, mt);
        gnext = ((const float*)(ws + OFF_SMALL + SM_GC))[((size_t)n * 8 + head) * 64 + 63];
    };
    auto lwrite = [&](int buf) {
        char* b = smem + buf * SC_BUF;
        const int c7 = tid & 7, kb = c7 >> 1, hf = c7 & 1;
        {
            char* w = b + SC_W + lrow * 256 + hf * 8; char* q = b + SC_QD + lrow * 256 + hf * 8; const int x = lrow & 15;
            *(u32x2*)(w + (((4 * kb + 0) ^ x) << 4)) = (u32x2){rw[0].x, rw[0].y}; *(u32x2*)(w + (((4 * kb + 1) ^ x) << 4)) = (u32x2){rw[0].z, rw[0].w};
            *(u32x2*)(w + (((4 * kb + 2) ^ x) << 4)) = (u32x2){rw[1].x, rw[1].y}; *(u32x2*)(w + (((4 * kb + 3) ^ x) << 4)) = (u32x2){rw[1].z, rw[1].w};
            *(u32x2*)(q + (((4 * kb + 0) ^ x) << 4)) = (u32x2){rq[0].x, rq[0].y}; *(u32x2*)(q + (((4 * kb + 1) ^ x) << 4)) = (u32x2){rq[0].z, rq[0].w};
            *(u32x2*)(q + (((4 * kb + 2) ^ x) << 4)) = (u32x2){rq[1].x, rq[1].y}; *(u32x2*)(q + (((4 * kb + 3) ^ x) << 4)) = (u32x2){rq[1].z, rq[1].w};
        }
        {
            const int dk = 2 * lrow + (c7 >> 2), kb2 = (c7 & 3) >> 1, x = (dk >> 1) & 7;
            char* kt = b + SC_KDT + dk * 128 + hf * 8;
            *(u32x2*)(kt + (((4 * kb2 + 0) ^ x) << 4)) = (u32x2){rk[0].x, rk[0].y}; *(u32x2*)(kt + (((4 * kb2 + 1) ^ x) << 4)) = (u32x2){rk[0].z, rk[0].w};
            *(u32x2*)(kt + (((4 * kb2 + 2) ^ x) << 4)) = (u32x2){rk[1].x, rk[1].y}; *(u32x2*)(kt + (((4 * kb2 + 3) ^ x) << 4)) = (u32x2){rk[1].z, rk[1].w};
        }
        {
            const int row = tid >> 3, kb2 = c7 >> 2, g0 = 2 * (c7 & 1), hf2 = (c7 >> 1) & 1, x = (row >> 1) & 7;
            char* qk = b + SC_QK + row * 128 + hf2 * 8;
            *(u32x2*)(qk + (((4 * kb2 + g0) ^ x) << 4)) = (u32x2){rqk.x, rqk.y}; *(u32x2*)(qk + (((4 * kb2 + g0 + 1) ^ x) << 4)) = (u32x2){rqk.z, rqk.w};
        }
    };
    gloadA(0); gloadU(0);
    lwrite(0);
#pragma unroll
    for (int mt = 0; mt < 4; ++mt) ucur[mt] = unext[mt];
    gcur = gnext;
    if (NCH > 1) gloadA(1);
    __syncthreads();
    for (int n = 0; n < NCH; ++n) {
        const char* b = smem + (n & 1) * SC_BUF;
        if (n + 1 < NCH) { lwrite((n + 1) & 1); gloadU(n + 1); }
        if (n + 2 < NCH) gloadA(n + 2);
        if (active) {
        const float gtot = __expf(gcur);
        bf16x8 sf[4];
#pragma unroll
        for (int kb = 0; kb < 4; ++kb) sf[kb] = pack8(S[2 * kb], S[2 * kb + 1]);
        f32x4 Vn[4], O[4];
#pragma unroll
        for (int mt = 0; mt < 4; ++mt) {
            f32x4 P = zero4(), Q = zero4();
            const int row = 16 * mt + r16;
#pragma unroll
            for (int kb = 0; kb < 4; ++kb) {
                const bf16x8 wf = *(const bf16x8*)(b + SC_W + swzrow(row, 256, 4 * kb + g));
                const bf16x8 qf = *(const bf16x8*)(b + SC_QD + swzrow(row, 256, 4 * kb + g));
                P = MFMA16(wf, sf[kb], P);
                Q = MFMA16(qf, sf[kb], Q);
            }
            const float u0 = bflo(ucur[mt].x), u1 = bfhi(ucur[mt].x), u2 = bflo(ucur[mt].y), u3 = bfhi(ucur[mt].y);
            Vn[mt] = (f32x4){u0 - P[0], u1 - P[1], u2 - P[2], u3 - P[3]};
            O[mt] = Q;
        }
        const bf16x8 vf[2] = {pack8(Vn[0], Vn[1]), pack8(Vn[2], Vn[3])};
#pragma unroll
        for (int mt = 0; mt < 8; ++mt) {
            const int row = 16 * mt + r16;
            f32x4 acc = S[mt] * gtot;
#pragma unroll
            for (int kb = 0; kb < 2; ++kb) {
                const bf16x8 kf = *(const bf16x8*)(b + SC_KDT + swz128(row, 4 * kb + g));
                acc = MFMA16(kf, vf[kb], acc);
            }
            S[mt] = acc;
        }
#pragma unroll
        for (int mt = 0; mt < 4; ++mt) {
            const int row = 16 * mt + r16;
#pragma unroll
            for (int kb = 0; kb < 2; ++kb) {
                const bf16x8 qk = *(const bf16x8*)(b + SC_QK + swz128(row, 4 * kb + g));
                O[mt] = MFMA16(qk, vf[kb], O[mt]);
            }
            if (n >= 1 && !dry) *(u32x2*)uaddr(n, mt) = (u32x2){pk2(O[mt][0], O[mt][1]), pk2(O[mt][2], O[mt][3])};
        }
        }
#pragma unroll
        for (int mt = 0; mt < 4; ++mt) ucur[mt] = unext[mt];
        gcur = gnext;
        __syncthreads();
    }
}

constexpr int AT_BUF = 32768, AT_MISC = 65536, NQB = SEQ / 128, AT_UNITS = 8 * NQB;
DI int vt_off8(int e, int s) { return e * 128 + ((s ^ ((e >> 1) & 15)) << 3); }

DI void attention_unit(const Params& p, char* smem, int head, int qb, float lam, int dry, float bound) {
    const int tid = fresh_tid(), lane = tid & 63, wave = tid >> 6, r32 = lane & 31, h = lane >> 5;
    const int wq = wave & 3, mp = wave >> 2;
    unsigned char* ws = p.ws;
    const bf16* AK = (const bf16*)p.out; const bf16* AVT = (const bf16*)p.out + (size_t)SEQ * D;
    const int q0 = 128 * qb, qpos = q0 + 32 * wq + r32;
    const float c1 = 0.125f * LOG2E, c2 = exp2f(-(float)(head + 1)) * LOG2E;
    bf16x8 Qf[4];
    {
        const bf16* qsrc = (const bf16*)(ws + OFF_AQ) + (size_t)qpos * D + head * 128 + mp * 64 + 8 * h;
#pragma unroll
        for (int ks = 0; ks < 4; ++ks) {
            const u32x4 v = *(const u32x4*)(qsrc + 16 * ks); u32x4 o;
            o.x = pk2(bflo(v.x) * c1, bfhi(v.x) * c1); o.y = pk2(bflo(v.y) * c1, bfhi(v.y) * c1); o.z = pk2(bflo(v.z) * c1, bfhi(v.z) * c1); o.w = pk2(bflo(v.w) * c1, bfhi(v.w) * c1);
            Qf[ks] = __builtin_bit_cast(bf16x8, o);
        }
    }
    f32x16 O[4];
#pragma unroll
    for (int i = 0; i < 4; ++i) O[i] = zero16();
    float l_run = 0.f; const float mfix = fminf(bound, 40.0f);
    const float wdist = (150.0f + 2.0f * bound) / c2;
    int ntiles = 2 * qb + 3;
    {
        const float lim = (float)q0 - 63.0f - wdist;
        int ktmin = 0;
        if (lim > 0.f) ktmin = (int)(lim * (1.0f / 64.0f));
        const bool keep_meta = !((float)(q0 + NMETA - 15) > wdist);
        if (ktmin > 0 || !keep_meta) ntiles = (2 * qb + 1 - ktmin + 1) + (keep_meta ? 1 : 0);
    }
    const int nreal = (ntiles == 2 * qb + 3) ? 2 * qb + 2 : ntiles;
    const int kkey = tid >> 3, kcc = (tid & 7) * 2;
    const int va = tid >> 5, vb4 = tid & 31;
    u32x4 rk[2]; u32x2 rv[4];
    auto tile_kt = [&](int it) -> int { return it < nreal ? 2 * qb + 1 - it : -1; };
    auto gload = [&](int it) {
        const int kt = tile_kt(it);
        if (kt >= 0) {
            const bf16* ks = AK + ((size_t)kt * 64 + kkey) * D + head * 128 + kcc * 8;
            rk[0] = *(const u32x4*)ks; rk[1] = *(const u32x4*)(ks + 8);
            const bf16* vs = AVT + ((size_t)kt * 64 + 4 * va) * D + head * 128 + 4 * vb4;
#pragma unroll
            for (int i = 0; i < 4; ++i) rv[i] = *(const u32x2*)(vs + (size_t)i * D);
        } else {
            rk[0] = rk[1] = (u32x4){0u, 0u, 0u, 0u};
#pragma unroll
            for (int i = 0; i < 4; ++i) rv[i] = (u32x2){0u, 0u};
            if (kkey < NMETA) { const bf16* ks = (const bf16*)(ws + OFF_SMALL + SM_AKMETA) + (size_t)kkey * D + head * 128 + kcc * 8; rk[0] = *(const u32x4*)ks; rk[1] = *(const u32x4*)(ks + 8); }
            if (va < NMETA / 4) { const bf16* vs = (const bf16*)(ws + OFF_SMALL + SM_AVTMETA) + (size_t)(4 * va) * D + head * 128 + 4 * vb4;
#pragma unroll
                for (int i = 0; i < 4; ++i) rv[i] = *(const u32x2*)(vs + (size_t)i * D); }
        }
    };
    auto lwrite = [&](int buf) {
        char* kb = smem + buf * AT_BUF + (kcc >> 3) * 8192;
        *(u32x4*)(kb + swz128(kkey, kcc & 7)) = rk[0]; *(u32x4*)(kb + swz128(kkey, (kcc & 7) + 1)) = rk[1];
        const unsigned t0x = (rv[0].x & 0xffffu) | (rv[1].x << 16), t1x = (rv[0].x >> 16) | (rv[1].x & 0xffff0000u), t0y = (rv[2].x & 0xffffu) | (rv[3].x << 16), t1y = (rv[2].x >> 16) | (rv[3].x & 0xffff0000u);
        const unsigned t2x = (rv[0].y & 0xffffu) | (rv[1].y << 16), t3x = (rv[0].y >> 16) | (rv[1].y & 0xffff0000u), t2y = (rv[2].y & 0xffffu) | (rv[3].y << 16), t3y = (rv[2].y >> 16) | (rv[3].y & 0xffff0000u);
        const int sub = va >> 3, a = va & 7, a2 = (a & 4) | ((a & 1) << 1) | ((a >> 1) & 1);
        char* vbase = smem + buf * AT_BUF + 16384 + (a2 & 1) * 8;
        const int s16 = 4 * sub + (a2 >> 1), e0 = 4 * vb4;
        *(u32x2*)(vbase + (e0 + 0) * 128 + ((s16 ^ (((e0 + 0) >> 1) & 7)) << 4)) = (u32x2){t0x, t0y};
        *(u32x2*)(vbase + (e0 + 1) * 128 + ((s16 ^ (((e0 + 1) >> 1) & 7)) << 4)) = (u32x2){t1x, t1y};
        *(u32x2*)(vbase + (e0 + 2) * 128 + ((s16 ^ (((e0 + 2) >> 1) & 7)) << 4)) = (u32x2){t2x, t2y};
        *(u32x2*)(vbase + (e0 + 3) * 128 + ((s16 ^ (((e0 + 3) >> 1) & 7)) << 4)) = (u32x2){t3x, t3y};
    };
    auto tile_body = [&](auto mode_tag, int buf, int kdist0, int klim) {
        constexpr bool MASKED = decltype(mode_tag)::value;
        const char* kb = smem + buf * AT_BUF + mp * 8192;
        const char* vb = smem + buf * AT_BUF + 16384;
        f32x16 s[2];
#pragma unroll
        for (int sub = 0; sub < 2; ++sub) {
            f32x16 acc;
            const float base = -c2 * (float)(kdist0 - 32 * sub - 4 * h) - mfix;
#pragma unroll
            for (int r = 0; r < 16; ++r) acc[r] = base + c2 * (float)((r & 3) + 8 * (r >> 2));
#pragma unroll
            for (int ks = 0; ks < 4; ++ks) {
                const bf16x8 a = *(const bf16x8*)(kb + swz128(32 * sub + r32, 2 * ks + h));
                acc = MFMA32(a, Qf[ks], acc);
            }
            if (MASKED) {
#pragma unroll
                for (int r = 0; r < 16; ++r) { const int key = 32 * sub + (r & 3) + 8 * (r >> 2) + 4 * h; if (key > klim) acc[r] = -1e30f; }
            }
            s[sub] = acc;
        }
        float ls = 0.f;
#pragma unroll
        for (int sub = 0; sub < 2; ++sub) {
#pragma unroll
            for (int r = 0; r < 16; ++r) { const float pv = EXP2F(s[sub][r]); s[sub][r] = pv; ls += pv; }
            bf16x8 Pf[2];
#pragma unroll
            for (int ss = 0; ss < 2; ++ss) {
                u32x4 o; o.x = pk2(s[sub][8 * ss], s[sub][8 * ss + 1]); o.y = pk2(s[sub][8 * ss + 2], s[sub][8 * ss + 3]);
                o.z = pk2(s[sub][8 * ss + 4], s[sub][8 * ss + 5]); o.w = pk2(s[sub][8 * ss + 6], s[sub][8 * ss + 7]);
                Pf[ss] = __builtin_bit_cast(bf16x8, o);
            }
#pragma unroll
            for (int et = 0; et < 4; ++et) {
                const int e = 32 * et + r32;
#pragma unroll
                for (int ss = 0; ss < 2; ++ss) {
                    const bf16x8 a = *(const bf16x8*)(vb + swz128(e, 4 * sub + 2 * ss + h));
                    O[et] = MFMA32(a, Pf[ss], O[et]);
                }
            }
            SCHED_FENCE();
        }
        l_run += ls;
    };
    gload(0); lwrite(0); __syncthreads();
    for (int it = 0; it < ntiles; ++it) {
        const int buf = it & 1, kt = tile_kt(it);
        if (it + 1 < ntiles) gload(it + 1);
        const int k0 = kt * 64;
        if (kt >= 0 && k0 > q0 + 32 * wq + 31) {   }
        else if (kt >= 0 && k0 + 63 <= q0 + 32 * wq) tile_body(std::false_type{}, buf, qpos - k0, 0);
        else tile_body(std::true_type{}, buf, kt < 0 ? NMETA + qpos : qpos - k0, kt < 0 ? NMETA - 1 : qpos - k0);
        if (it + 1 < ntiles) lwrite(buf ^ 1);
        __syncthreads();
    }
    {
        const int tid = fresh_tid(), lane = tid & 63, wave = tid >> 6, r32 = lane & 31, h = lane >> 5, wq = wave & 3, mp = wave >> 2;
        const int qpos = 128 * qb + 32 * wq + r32;
        const float lt = l_run + xhalf(l_run);
        const float inv = 1.0f / lt;
        float* X = (float*)smem;
        if (mp == 1) {
#pragma unroll
            for (int et = 0; et < 4; ++et)
#pragma unroll
                for (int r = 0; r < 16; ++r) { const int e = 32 * et + (r & 3) + 8 * (r >> 2) + 4 * h; X[(wq * 128 + e) * 32 + r32] = O[et][r] * inv; }
        }
        __syncthreads();
        if (mp == 0) {
            float ssq = 0.f;
#pragma unroll
            for (int et = 0; et < 4; ++et)
#pragma unroll
                for (int r = 0; r < 16; ++r) { const int e = 32 * et + (r & 3) + 8 * (r >> 2) + 4 * h; const float d = O[et][r] * inv - lam * X[(wq * 128 + e) * 32 + r32]; O[et][r] = d; ssq += d * d; }
            ssq += xhalf(ssq);
            const float rstd = rsqrtf(ssq * (1.0f / 128.0f) + NORM_EPS) * 0.8f;
            bf16* dst = (bf16*)(ws + OFF_AQ) + (size_t)qpos * D + head * 128;
            const float* sw = p.in[8];
#pragma unroll
            for (int et = 0; et < 4; ++et)
#pragma unroll
                for (int q4 = 0; q4 < 4; ++q4) {
                    const int e0 = 32 * et + 8 * q4 + 4 * h;
                    const f32x4 w4 = *(const f32x4*)(sw + e0);
                    if (!dry) *(u32x2*)(dst + e0) = (u32x2){pk2(O[et][4 * q4] * rstd * w4[0], O[et][4 * q4 + 1] * rstd * w4[1]), pk2(O[et][4 * q4 + 2] * rstd * w4[2], O[et][4 * q4 + 3] * rstd * w4[3])};
                }
        }
        __syncthreads();
    }
}

DI void phase3(const Params& p, char* smem, int bid, int nblk, int dry = 0, int mode = 3) {
    if (mode & 1) for (int it = bid; it < 8 * SCAN_SPLIT; it += nblk) scan_head(p, smem, it / SCAN_SPLIT, it % SCAN_SPLIT, dry);
    if (!(mode & 2)) return;
    float d1 = 0.f, d2 = 0.f;
    for (int i = 0; i < 64; ++i) { d1 += p.in[4][i] * p.in[5][i]; d2 += p.in[6][i] * p.in[7][i]; }
    const float lam = __expf(d1) - __expf(d2) + 0.2f;
    unsigned* q = (unsigned*)(p.ws + OFF_SMALL + SM_CTL) + CW_ATTQ + (dry ? 16 : 0);
    for (;;) {
        if (threadIdx.x == 0) *(unsigned*)(smem + AT_MISC) = atomicAdd(q, 1u);
        __syncthreads();
        const unsigned u = *(unsigned*)(smem + AT_MISC);
        __syncthreads();
        if (u >= (unsigned)AT_UNITS) break;
        const int hd = (int)(u & 7u);
        const unsigned* nrm = (const unsigned*)(p.ws + OFF_SMALL + SM_CTL) + CW_NRM;
        float bnd = 0.f;
        for (int m2 = 0; m2 < 2; ++m2) {
            const float q2 = __builtin_bit_cast(float, LD_ATOMIC(nrm + 2 * hd + m2)), k2 = __builtin_bit_cast(float, LD_ATOMIC(nrm + 16 + 2 * hd + m2));
            bnd = fmaxf(bnd, sqrtf(q2 * k2) * (0.125f * LOG2E) * 1.02f);
        }
        attention_unit(p, smem, hd, NQB - 1 - (int)(u >> 3), lam, dry, bnd);
    }
}

DI void phase4(const Params& p, char* smem, int bid, int nblk) {
    const int tid = fresh_tid(), lane = tid & 63, wave = tid >> 6;
    const int gw = bid * 8 + wave, NGW = nblk * 8;
    unsigned char* ws = p.ws;
    char* wl = smem + wave * 16384;
    for (int it = gw; it < 32 * 384; it += NGW) {
        const int e = it / 384, r = it % 384, m = r >> 7, q = r & 127;
        if (m < 2) transpose_item(p.in[21 + m] + (size_t)e * 1024 * 256, 256, 1024, (bf16*)(ws + OFF_EXG) + (size_t)e * 512 * 1024, (q >> 3) * 64, (q & 7) * 32, (q & 7) * 32, (float*)wl, lane, m + 1);
        else transpose_item(p.in[23] + (size_t)e * 256 * 1024, 1024, 256, (bf16*)(ws + OFF_EXD) + (size_t)e * 1024 * 256, (q >> 5) * 64, (q & 31) * 32, (q & 31) * 32, (float*)wl, lane);
    }
    for (int R = gw; R < SEQ; R += NGW) {
        const float* xrow = p.in[0] + (size_t)R * D; bf16* urow = (bf16*)(ws + OFF_U) + (size_t)R * D;
        float4 v[4]; float ss = 0.f;
#pragma unroll
        for (int j = 0; j < 4; ++j) { v[j] = *(const float4*)(xrow + 4 * lane + 256 * j); ss += v[j].x * v[j].x + v[j].y * v[j].y + v[j].z * v[j].z + v[j].w * v[j].w; }
        ss = wave_sum(ss);
        const float rstd = rsqrtf(ss * (1.0f / D) + NORM_EPS);
#pragma unroll
        for (int j = 0; j < 4; ++j) {
            const float4 w4 = *(const float4*)(p.in[2] + 4 * lane + 256 * j);
            *(u32x2*)(urow + 4 * lane + 256 * j) = (u32x2){pk2(v[j].x * rstd * w4.x, v[j].y * rstd * w4.y), pk2(v[j].z * rstd * w4.z, v[j].w * rstd * w4.w)};
        }
    }
    for (int it = gw; it < (NCH - 1) * 8; it += NGW) {
        const int cm1 = it >> 3, head = it & 7;
        const bf16* reg = (const bf16*)(ws + OFF_V) + (size_t)cm1 * 64 * D + head * 128;
#pragma unroll 4
        for (int i = 0; i < 16; ++i) { const int row = i * 4 + (lane >> 4), ch = lane & 15; *(u32x4*)(wl + row * 256 + ch * 16) = *(const u32x4*)(reg + (size_t)row * D + ch * 8); }
        WAVE_SYNC();
        float ss = 0.f;
#pragma unroll 8
        for (int dv = 0; dv < 128; ++dv) { const float v = bf2f(*(const bf16*)(wl + (dv >> 1) * 256 + ((dv & 1) * 64 + lane) * 2)); ss += v * v; }
        const float rstd = rsqrtf(ss * (1.0f / 128.0f) + NORM_EPS);
        const size_t j = (size_t)cm1 * 64 + lane;
        const bf16* gsrc = (const bf16*)(ws + OFF_DG) + j * D + head * 128;
        bf16* dst = (bf16*)(ws + OFF_OD) + j * D + head * 128;
#pragma unroll 2
        for (int d8 = 0; d8 < 16; ++d8) {
            const u32x4 gv = *(const u32x4*)(gsrc + 8 * d8);
            const f32x4 w0 = *(const f32x4*)(p.in[12] + 8 * d8), w1 = *(const f32x4*)(p.in[12] + 8 * d8 + 4);
            float o[8];
#pragma unroll
            for (int c = 0; c < 8; ++c) { const int dv = 8 * d8 + c; o[c] = bf2f(*(const bf16*)(wl + (dv >> 1) * 256 + ((dv & 1) * 64 + lane) * 2)) * rstd; }
            o[0] *= w0[0] * siluf_(bflo(gv.x)); o[1] *= w0[1] * siluf_(bfhi(gv.x)); o[2] *= w0[2] * siluf_(bflo(gv.y)); o[3] *= w0[3] * siluf_(bfhi(gv.y));
            o[4] *= w1[0] * siluf_(bflo(gv.z)); o[5] *= w1[1] * siluf_(bfhi(gv.z)); o[6] *= w1[2] * siluf_(bflo(gv.w)); o[7] *= w1[3] * siluf_(bfhi(gv.w));
            *(u32x4*)(dst + 8 * d8) = (u32x4){pk2(o[0], o[1]), pk2(o[2], o[3]), pk2(o[4], o[5]), pk2(o[6], o[7])};
        }
        WAVE_SYNC();
    }
}

template <int NB, int NI>
DI void rowgemm64(const bf16* arow, const bf16* const (&bptr)[NB], char* stg, f32x16 (&acc)[NB][2][NI]) {
    const int tid = fresh_tid(), lane = tid & 63, r32 = lane & 31, h = lane >> 5;
    const int lrow = tid >> 3, lc = tid & 7;
    u32x4 ra = arow ? *(const u32x4*)arow : (u32x4){0u, 0u, 0u, 0u};
    bf16x8 bqA[4][NB][NI], bqB[4][NB][NI];
    auto bload = [&](bf16x8 (&dst)[4][NB][NI], int kc) {
#pragma unroll
        for (int ks = 0; ks < 4; ++ks)
#pragma unroll
            for (int b = 0; b < NB; ++b)
#pragma unroll
                for (int ni = 0; ni < NI; ++ni) dst[ks][b][ni] = *(const bf16x8*)(bptr[b] + (size_t)ni * 32 * 1024 + kc * 64 + ks * 16);
    };
    auto mma = [&](const bf16x8 (&bq)[4][NB][NI], int buf) {
#pragma unroll
        for (int ks = 0; ks < 4; ++ks) {
            bf16x8 af[2];
#pragma unroll
            for (int mi = 0; mi < 2; ++mi) af[mi] = *(const bf16x8*)(stg + buf * 8192 + swz128(32 * mi + r32, 2 * ks + h));
#pragma unroll
            for (int b = 0; b < NB; ++b)
#pragma unroll
                for (int ni = 0; ni < NI; ++ni)
#pragma unroll
                    for (int mi = 0; mi < 2; ++mi) acc[b][mi][ni] = MFMA32(af[mi], bq[ks][b][ni], acc[b][mi][ni]);
        }
    };
    bload(bqA, 0);
    *(u32x4*)(stg + swz128(lrow, lc)) = ra;
    __syncthreads();
    for (int kc = 0; kc < 16; kc += 2) {
        ra = arow ? *(const u32x4*)(arow + (kc + 1) * 64) : (u32x4){0u, 0u, 0u, 0u};
        bload(bqB, kc + 1);
        mma(bqA, 0);
        *(u32x4*)(stg + 8192 + swz128(lrow, lc)) = ra;
        __syncthreads();
        if (kc + 2 < 16) { ra = arow ? *(const u32x4*)(arow + (kc + 2) * 64) : (u32x4){0u, 0u, 0u, 0u}; bload(bqA, kc + 2); }
        mma(bqB, 1);
        if (kc + 2 < 16) *(u32x4*)(stg + swz128(lrow, lc)) = ra;
        __syncthreads();
    }
}

constexpr size_t OFF_MIX = OFF_V;
struct EpiSig {
    static constexpr bool PERM = true;
    bf16* sg;
    DM void operator()(const f32x4 (&acc)[2][2][4][2], const pg8::Unit& u, int wr, int wc, int fr, int fq) const {
        const int row0 = u.pm * 256 + wr * 64 + fr, col0 = u.pn * 256 + wc * 32 + 8 * fq;
#pragma unroll
        for (int ai = 0; ai < 2; ++ai)
#pragma unroll
            for (int m = 0; m < 4; ++m) {
                bf16* rowp = sg + (size_t)(row0 + ai * 128 + m * 16) * 2048 + col0;
#pragma unroll
                for (int bj = 0; bj < 2; ++bj) {
                    const f32x4 v0 = acc[ai][bj][m][0], v1 = acc[ai][bj][m][1];
                    *(u32x4*)(rowp + bj * 128) = (u32x4){pk2(sigmoidf_(v0[0]), sigmoidf_(v0[1])), pk2(sigmoidf_(v0[2]), sigmoidf_(v0[3])), pk2(sigmoidf_(v1[0]), sigmoidf_(v1[1])), pk2(sigmoidf_(v1[2]), sigmoidf_(v1[3]))};
                }
            }
    }
};
template <bool ADD> struct EpiGate {
    static constexpr bool PERM = true;
    const bf16* sg; bf16* mix; int goff;
    DM void operator()(const f32x4 (&acc)[2][2][4][2], const pg8::Unit& u, int wr, int wc, int fr, int fq) const {
        const int row0 = u.pm * 256 + wr * 64 + fr, col0 = u.pn * 256 + wc * 32 + 8 * fq;
#pragma unroll
        for (int ai = 0; ai < 2; ++ai)
#pragma unroll
            for (int m = 0; m < 4; ++m) {
                const size_t j = (size_t)(row0 + ai * 128 + m * 16);
#pragma unroll
                for (int bj = 0; bj < 2; ++bj) {
                    const u32x4 g = *(const u32x4*)(sg + j * 2048 + goff + col0 + bj * 128);
                    const f32x4 v0 = acc[ai][bj][m][0], v1 = acc[ai][bj][m][1];
                    float o[8] = {bflo(g.x) * v0[0], bfhi(g.x) * v0[1], bflo(g.y) * v0[2], bfhi(g.y) * v0[3], bflo(g.z) * v1[0], bfhi(g.z) * v1[1], bflo(g.w) * v1[2], bfhi(g.w) * v1[3]};
                    bf16* dst = mix + j * D + col0 + bj * 128;
                    if (ADD) { const u32x4 q = *(const u32x4*)dst; o[0] += bflo(q.x); o[1] += bfhi(q.x); o[2] += bflo(q.y); o[3] += bfhi(q.y); o[4] += bflo(q.z); o[5] += bfhi(q.z); o[6] += bflo(q.w); o[7] += bfhi(q.w); }
                    *(u32x4*)dst = (u32x4){pk2(o[0], o[1]), pk2(o[2], o[3]), pk2(o[4], o[5]), pk2(o[6], o[7])};
                }
            }
    }
};
struct EpiRes {
    static constexpr bool PERM = false;
    const float* x; float* hout;
    DM void operator()(const f32x4 (&acc)[2][2][4][2], const pg8::Unit& u, int wr, int wc, int fr, int fq) const {
        const int row0 = u.pm * 256 + wr * 64 + fr, col0 = u.pn * 256 + wc * 32 + 4 * fq;
#pragma unroll
        for (int ai = 0; ai < 2; ++ai)
#pragma unroll
            for (int m = 0; m < 4; ++m) {
                const size_t off = (size_t)(row0 + ai * 128 + m * 16) * D + col0;
#pragma unroll
                for (int bj = 0; bj < 2; ++bj)
#pragma unroll
                    for (int n = 0; n < 2; ++n) *(f32x4*)(hout + off + bj * 128 + n * 16) = *(const f32x4*)(x + off + bj * 128 + n * 16) + acc[ai][bj][m][n];
            }
    }
};
DI void phase5a(const Params& p, char* smem, int bid, int nblk) {
    pg8::Gemm g{(const bf16*)(p.ws + OFF_U), (const bf16*)(p.ws + OFF_WTIN) + (size_t)7168 * 1024, SEQ, 2048, 1024};
    pg8::StaticOrder S; S.init(SEQ, 2048, nblk, bid);
    EpiSig E{(bf16*)p.out};
    pg8::gemm_phase(smem, g, S, E);
}
DI void phase5b(const Params& p, char* smem, int bid, int nblk) {
    pg8::StaticOrder S; S.init(SEQ, 1024, nblk, bid);
    {
        pg8::Gemm g{(const bf16*)(p.ws + OFF_AQ), (const bf16*)(p.ws + OFF_WTBA), SEQ, 1024, 1024};
        EpiGate<false> E{(const bf16*)p.out, (bf16*)(p.ws + OFF_MIX), 0};
        pg8::gemm_phase(smem, g, S, E);
    }
    {
        pg8::Gemm g{(const bf16*)(p.ws + OFF_OD), (const bf16*)(p.ws + OFF_WTBD), SEQ, 1024, 1024};
        EpiGate<true> E{(const bf16*)p.out, (bf16*)(p.ws + OFF_MIX), 1024};
        pg8::gemm_phase(smem, g, S, E);
    }
}
DI void phase5c(const Params& p, char* smem, int bid, int nblk) {
    pg8::Gemm g{(const bf16*)(p.ws + OFF_MIX), (const bf16*)(p.ws + OFF_WTOUT), SEQ, 1024, 1024};
    pg8::StaticOrder S; S.init(SEQ, 1024, nblk, bid);
    EpiRes E{p.in[0], p.out};
    pg8::gemm_phase(smem, g, S, E);
}
constexpr int P5_PLP = 65, P5_PL = 0, P5_SS = 8 * 64 * P5_PLP * 4, P5_MISC = P5_SS + 8 * 64 * 4;
DI void post_rows(const Params& p, char* smem, int rb, int dry) {
    const int tid = fresh_tid(), lane = tid & 63, wave = tid >> 6, r32 = lane & 31, h = lane >> 5;
    unsigned char* ws = p.ws;
    const int row0 = rb * 64;
    float* rstdl = (float*)(smem + P5_MISC); float* logl = (float*)(smem + P5_MISC + 256);
    {
        const bf16* WH = (const bf16*)(ws + OFF_SMALL + SM_WR); const bf16* WL = WH + 64 * 1024;
        f32x16 acc[2][2];
#pragma unroll
        for (int mi = 0; mi < 2; ++mi)
#pragma unroll
            for (int ni = 0; ni < 2; ++ni) acc[mi][ni] = zero16();
        float ss[2] = {0.f, 0.f};
#pragma unroll 2
        for (int ks = 0; ks < 8; ++ks) {
            const int k0 = 128 * wave + 16 * ks + 8 * h;
            bf16x8 ah[2], al[2];
#pragma unroll
            for (int mi = 0; mi < 2; ++mi) {
                const float* hp = p.out + (size_t)(row0 + 32 * mi + r32) * D + k0;
                const f32x4 a = *(const f32x4*)hp, b = *(const f32x4*)(hp + 4);
                ss[mi] += a[0] * a[0] + a[1] * a[1] + a[2] * a[2] + a[3] * a[3] + b[0] * b[0] + b[1] * b[1] + b[2] * b[2] + b[3] * b[3];
                const u32x4 hi = {pk2(a[0], a[1]), pk2(a[2], a[3]), pk2(b[0], b[1]), pk2(b[2], b[3])};
                const u32x4 lo = {pk2(a[0] - bflo(hi.x), a[1] - bfhi(hi.x)), pk2(a[2] - bflo(hi.y), a[3] - bfhi(hi.y)), pk2(b[0] - bflo(hi.z), b[1] - bfhi(hi.z)), pk2(b[2] - bflo(hi.w), b[3] - bfhi(hi.w))};
                ah[mi] = __builtin_bit_cast(bf16x8, hi); al[mi] = __builtin_bit_cast(bf16x8, lo);
            }
#pragma unroll
            for (int ni = 0; ni < 2; ++ni) {
                const bf16x8 bh = *(const bf16x8*)(WH + (size_t)(32 * ni + r32) * 1024 + k0), bl = *(const bf16x8*)(WL + (size_t)(32 * ni + r32) * 1024 + k0);
#pragma unroll
                for (int mi = 0; mi < 2; ++mi) { acc[mi][ni] = MFMA32(ah[mi], bh, acc[mi][ni]); acc[mi][ni] = MFMA32(ah[mi], bl, acc[mi][ni]); acc[mi][ni] = MFMA32(al[mi], bh, acc[mi][ni]); }
            }
        }
        float* PL = (float*)(smem + P5_PL) + wave * 64 * P5_PLP; float* SS = (float*)(smem + P5_SS) + wave * 64;
#pragma unroll
        for (int mi = 0; mi < 2; ++mi) {
#pragma unroll
            for (int ni = 0; ni < 2; ++ni)
#pragma unroll
                for (int r = 0; r < 16; ++r) PL[(32 * mi + (r & 3) + 8 * (r >> 2) + 4 * h) * P5_PLP + 32 * ni + r32] = acc[mi][ni][r];
            const float s = ss[mi] + xhalf(ss[mi]);
            if (h == 0) SS[32 * mi + r32] = s;
        }
    }
    __syncthreads();
    if (tid < 64) {
        float s = 0.f;
#pragma unroll
        for (int w = 0; w < 8; ++w) s += ((const float*)(smem + P5_SS))[w * 64 + tid];
        const float rs = rsqrtf(s * (1.0f / D) + NORM_EPS);
        rstdl[tid] = rs;
        for (int c = 0; c < 36; ++c) { float t = 0.f; for (int w = 0; w < 8; ++w) t += ((const float*)(smem + P5_PL))[w * 64 * P5_PLP + tid * P5_PLP + c]; logl[tid * 41 + c] = t * rs + (c < 4 ? p.in[18][c] : p.in[20][c - 4]); }
        const float* L = logl + tid * 41;
        int gi = 0; float gm = L[0];
        for (int c = 1; c < 4; ++c) if (L[c] > gm) { gm = L[c]; gi = c; }
        float gs = 0.f; for (int c = 0; c < 4; ++c) gs += __expf(L[c] - gm);
        const float gw = 1.0f / gs;
        const float* E = L + 4 + 8 * gi;
        int i1 = 0; float l1 = E[0];
        for (int c = 1; c < 8; ++c) if (E[c] > l1) { l1 = E[c]; i1 = c; }
        int i2 = -1; float l2 = -3.0e38f;
        for (int c = 0; c < 8; ++c) if (c != i1 && E[c] > l2) { l2 = E[c]; i2 = c; }
        const float t = __expf(l2 - l1), w1 = 1.0f / (1.0f + t), w2 = t / (1.0f + t);
        unsigned* cnt = (unsigned*)(ws + OFF_SMALL + SM_CTL) + CW_ECNT;
        int* lists = (int*)(ws + OFF_SMALL + SM_TAILS); float* RW = (float*)(ws + OFF_SMALL + SM_RW);
        const int j = row0 + tid;
        const int e1 = 8 * gi + i1, e2 = 8 * gi + i2;
        if (!dry) {
        const unsigned p1 = atomicAdd(cnt + e1, 1u); ST_ATOMIC(lists + (size_t)e1 * SEQ + p1, (j << 1)); RW[2 * j] = gw * w1;
        const unsigned p2 = atomicAdd(cnt + e2, 1u); ST_ATOMIC(lists + (size_t)e2 * SEQ + p2, (j << 1) | 1); RW[2 * j + 1] = gw * w2;
        } else { asm volatile("" :: "v"(e1), "v"(e2), "v"(gw * w1), "v"(gw * w2)); }
    }
    __syncthreads();
#pragma unroll 2
    for (int i = 0; i < 16; ++i) {
        const int idx = tid + NT * i, row = idx >> 7, ch = idx & 127;
        const float* hp = p.out + (size_t)(row0 + row) * D + ch * 8;
        const f32x4 a = *(const f32x4*)hp, b = *(const f32x4*)(hp + 4);
        const f32x4 w0 = *(const f32x4*)(p.in[16] + ch * 8), w1 = *(const f32x4*)(p.in[16] + ch * 8 + 4);
        const float rs = rstdl[row];
        if (!dry) *(u32x4*)((bf16*)(ws + OFF_OD) + (size_t)(row0 + row) * D + ch * 8) =
            (u32x4){pk2(a[0] * rs * w0[0], a[1] * rs * w0[1]), pk2(a[2] * rs * w0[2], a[3] * rs * w0[3]), pk2(b[0] * rs * w1[0], b[1] * rs * w1[1]), pk2(b[2] * rs * w1[2], b[3] * rs * w1[3])};
    }
    __syncthreads();
}
DI void phase5d(const Params& p, char* smem, int bid, int nblk, int dry = 0) {
    for (int rb = bid; rb < SEQ / 64; rb += nblk) post_rows(p, smem, rb, dry);
}

constexpr int P6_TBL = 131072 + 1024;
template <int NPN> struct MoeSched {
    static constexpr bool GATHER = (NPN == 2);
    const int* tbl; const int* lists; int G, c; size_t btile;
    DM bool next(int i, pg8::Unit& u) const {
        const long L = (long)i * G + c; const int total = tbl[64 + 33 + 32] * NPN; if (L >= total) return false;
        const int ru = (int)L / NPN; u.pn = (int)L % NPN;
        int e = 0;
#pragma unroll 1
        for (int q = 1; q < 32; ++q) if (tbl[64 + 33 + q] <= ru) e = q;
        u.e = e; u.pm = ru - tbl[64 + 33 + e]; return true;
    }
    DM const char* a_tile(const pg8::Gemm& g, const pg8::Unit& u) const { return (const char*)g.A + ((size_t)tbl[32 + u.e] + (size_t)u.pm * 256) * g.K * 2; }
    DM const char* b_tile(const pg8::Gemm& g, const pg8::Unit& u) const { return (const char*)g.Bt + (size_t)u.e * btile + (size_t)u.pn * 256 * g.K * 2; }
    DM int a_row(const pg8::Unit& u, int r) const { const int loc = u.pm * 256 + r; return loc < tbl[u.e] ? (lists[(size_t)u.e * SEQ + loc] >> 1) : 0; }
};
DI void moe_table(const Params& p, char* smem) {
    int* tbl = (int*)(smem + P6_TBL);
    unsigned* cnt = (unsigned*)(p.ws + OFF_SMALL + SM_CTL) + CW_ECNT;
    if (threadIdx.x < 32) tbl[threadIdx.x] = (int)LD_ATOMIC(cnt + threadIdx.x);
    __syncthreads();
    if (threadIdx.x == 0) { int hb = 0, ub = 0; for (int e = 0; e < 32; ++e) { tbl[32 + e] = hb; tbl[64 + 33 + e] = ub; const int nru = (tbl[e] + 255) >> 8; hb += nru * 256; ub += nru; } tbl[32 + 32] = hb; tbl[64 + 33 + 32] = ub; }
    __syncthreads();
}
struct EpiSwiGLU {
    static constexpr bool PERM = true;
    bf16* H; const int* tbl;
    DM void operator()(const f32x4 (&acc)[2][2][4][2], const pg8::Unit& u, int wr, int wc, int fr, int fq) const {
        const size_t grow0 = (size_t)tbl[32 + u.e] + (size_t)u.pm * 256 + wr * 64 + fr; const int hid0 = (u.pn * 256 + wc * 32 + 8 * fq) >> 1;
#pragma unroll
        for (int ai = 0; ai < 2; ++ai)
#pragma unroll
            for (int m = 0; m < 4; ++m) {
                bf16* rowp = H + (grow0 + ai * 128 + m * 16) * 256 + hid0;
#pragma unroll
                for (int bj = 0; bj < 2; ++bj) {
                    const f32x4 gt = acc[ai][bj][m][0], up = acc[ai][bj][m][1];
                    *(u32x2*)(rowp + bj * 64) = (u32x2){pk2(siluf_(gt[0]) * up[0], siluf_(gt[1]) * up[1]), pk2(siluf_(gt[2]) * up[2], siluf_(gt[3]) * up[3])};
                }
            }
    }
};
struct EpiScatter {
    static constexpr bool PERM = true;
    bf16* Y; const int* tbl; const int* lists; const float* RW;
    DM void operator()(const f32x4 (&acc)[2][2][4][2], const pg8::Unit& u, int wr, int wc, int fr, int fq) const {
        const int loc0 = u.pm * 256 + wr * 64 + fr, col0 = u.pn * 256 + wc * 32 + 8 * fq, cnt = tbl[u.e];
#pragma unroll
        for (int ai = 0; ai < 2; ++ai)
#pragma unroll
            for (int m = 0; m < 4; ++m) {
                const int loc = loc0 + ai * 128 + m * 16;
                if (loc < cnt) {
                    const int ent = lists[(size_t)u.e * SEQ + loc]; const float w = RW[ent];
                    bf16* rowp = Y + (size_t)ent * D + col0;
#pragma unroll
                    for (int bj = 0; bj < 2; ++bj) {
                        const f32x4 v0 = acc[ai][bj][m][0] * w, v1 = acc[ai][bj][m][1] * w;
                        *(u32x4*)(rowp + bj * 128) = (u32x4){pk2(v0[0], v0[1]), pk2(v0[2], v0[3]), pk2(v1[0], v1[1]), pk2(v1[2], v1[3])};
                    }
                }
            }
    }
};
DI void phase6a(const Params& p, char* smem, int bid, int nblk) {
    moe_table(p, smem);
    const int* tbl = (const int*)(smem + P6_TBL); const int* lists = (const int*)(p.ws + OFF_SMALL + SM_TAILS);
    pg8::Gemm g{(const bf16*)(p.ws + OFF_OD), (const bf16*)(p.ws + OFF_EXG), 0, 512, 1024};
    MoeSched<2> S{tbl, lists, nblk, bid, (size_t)512 * 1024 * 2};
    EpiSwiGLU E{(bf16*)(p.ws + OFF_H), tbl};
    pg8::gemm_phase(smem, g, S, E);
}
DI void phase6b(const Params& p, char* smem, int bid, int nblk) {
    moe_table(p, smem);
    const int* tbl = (const int*)(smem + P6_TBL); const int* lists = (const int*)(p.ws + OFF_SMALL + SM_TAILS);
    pg8::Gemm g{(const bf16*)(p.ws + OFF_H), (const bf16*)(p.ws + OFF_EXD), 0, 1024, 256};
    MoeSched<4> S{tbl, lists, nblk, bid, (size_t)1024 * 256 * 2};
    EpiScatter E{(bf16*)(p.ws + OFF_Y), tbl, lists, (const float*)(p.ws + OFF_SMALL + SM_RW)};
    pg8::gemm_phase(smem, g, S, E);
}

DI void phase7(const Params& p, char* smem, int bid, int nblk, int dry = 0) {
    const int tid = fresh_tid(), lane = tid & 63, wave = tid >> 6;
    const int gw = bid * 8 + wave, NGW = nblk * 8;
    for (int j = gw; j < SEQ; j += NGW) {
        float* hrow = p.out + (size_t)j * D;
        const bf16* y0 = (const bf16*)(p.ws + OFF_Y) + (size_t)j * 2 * D;
        float4 v[4]; float ss = 0.f;
#pragma unroll
        for (int q = 0; q < 4; ++q) {
            const int c = 4 * lane + 256 * q;
            v[q] = *(const float4*)(hrow + c);
            const u32x2 a = *(const u32x2*)(y0 + c), b = *(const u32x2*)(y0 + D + c);
            v[q].x += bflo(a.x) + bflo(b.x); v[q].y += bfhi(a.x) + bfhi(b.x); v[q].z += bflo(a.y) + bflo(b.y); v[q].w += bfhi(a.y) + bfhi(b.y);
            ss += v[q].x * v[q].x + v[q].y * v[q].y + v[q].z * v[q].z + v[q].w * v[q].w;
        }
        ss = wave_sum(ss);
        const float rstd = rsqrtf(ss * (1.0f / D) + NORM_EPS);
#pragma unroll
        for (int q = 0; q < 4; ++q) {
            const int c = 4 * lane + 256 * q; const float4 w4 = *(const float4*)(p.in[24] + c);
            if (!dry) *(float4*)(hrow + c) = make_float4(v[q].x * rstd * w4.x, v[q].y * rstd * w4.y, v[q].z * rstd * w4.z, v[q].w * rstd * w4.w);
        }
    }
}

#ifdef EMU
__global__ void __launch_bounds__(NT) k_phase0(Params p) { SMEM_DECL; phase0(p, smem, blockIdx.x, gridDim.x); }
__global__ void __launch_bounds__(NT) k_phase1(Params p) { SMEM_DECL; phase1(p, smem, blockIdx.x, gridDim.x); }
__global__ void __launch_bounds__(NT) k_phase2(Params p) { SMEM_DECL; phase2(p, smem, blockIdx.x, gridDim.x, 0); }
__global__ void __launch_bounds__(NT) k_phase3(Params p) { SMEM_DECL; phase3(p, smem, blockIdx.x, gridDim.x); }
__global__ void __launch_bounds__(NT) k_phase4(Params p) { SMEM_DECL; phase4(p, smem, blockIdx.x, gridDim.x); }
__global__ void __launch_bounds__(NT) k_phase5a(Params p) { SMEM_DECL; phase5a(p, smem, blockIdx.x, gridDim.x); }
__global__ void __launch_bounds__(NT) k_phase5b(Params p) { SMEM_DECL; phase5b(p, smem, blockIdx.x, gridDim.x); }
__global__ void __launch_bounds__(NT) k_phase5c(Params p) { SMEM_DECL; phase5c(p, smem, blockIdx.x, gridDim.x); }
__global__ void __launch_bounds__(NT) k_phase5d(Params p) { SMEM_DECL; phase5d(p, smem, blockIdx.x, gridDim.x); }
__global__ void __launch_bounds__(NT) k_phase6a(Params p) { SMEM_DECL; phase6a(p, smem, blockIdx.x, gridDim.x); }
__global__ void __launch_bounds__(NT) k_phase6b(Params p) { SMEM_DECL; phase6b(p, smem, blockIdx.x, gridDim.x); }
__global__ void __launch_bounds__(NT) k_phase7(Params p) { SMEM_DECL; phase7(p, smem, blockIdx.x, gridDim.x); }

#endif

constexpr int LDS_BYTES = 160 * 1024 - 256;
constexpr int LDS_BARST = LDS_BYTES - 16;

#ifndef EMU
#define LAS __attribute__((address_space(3)))
#define XB_TMO      128
#define XB_XCNT(j)  (256  + 64 * (j))
#define XB_XSUB(j)  (1280 + 64 * (j))
#define XB_XGEN(j)  (2304 + 64 * (j))
#define XB_TOP      3328
#define XB_TOPGEN   3392
#define XCD_BAR_WORDS 3456
#define XB_SPIN_CAP (1u << 22)
__device__ __forceinline__ unsigned xb_ld(unsigned* p)              { return __hip_atomic_load(p, __ATOMIC_RELAXED, __HIP_MEMORY_SCOPE_AGENT); }
__device__ __forceinline__ unsigned xb_add(unsigned* p, unsigned v) { return __hip_atomic_fetch_add(p, v, __ATOMIC_RELAXED, __HIP_MEMORY_SCOPE_AGENT); }
__device__ __forceinline__ unsigned xb_xcc_id() { return (unsigned)__builtin_amdgcn_s_getreg((3 << 11) | 20) & 0xFu; }
#define XB_SPIN(cond, bar) do { unsigned _sp = 0; while (cond) { __builtin_amdgcn_s_sleep(1); \
    if ((++_sp & 255u) == 0u) { if (xb_ld(&(bar)[XB_TMO])) break; if (_sp > XB_SPIN_CAP) { atomicAdd(&(bar)[XB_TMO], 1u); break; } } } } while (0)
struct XcdBarrier { unsigned* bar; unsigned x; volatile LAS unsigned* st; };
__device__ __forceinline__ XcdBarrier xcd_barrier_post(unsigned* bar, volatile LAS unsigned* st) {
    XcdBarrier b; b.bar = bar; b.x = xb_xcc_id(); b.st = st;
    if (threadIdx.x == 0) (void)xb_add(&bar[XB_XCNT(b.x)], 1u);
    return b;
}
__device__ __forceinline__ void xcd_barrier_complete(unsigned* bar, unsigned x, unsigned& nloc, unsigned& nx) {
    const unsigned G = gridDim.x * gridDim.y * gridDim.z;
    unsigned sum, cnt, mine, sp = 0u;
    for (;;) {
        sum = 0u; cnt = 0u; mine = 0u;
#pragma unroll
        for (unsigned j = 0; j < 16; ++j) { const unsigned c = xb_ld(&bar[XB_XCNT(j)]); sum += c; cnt += (c > 0u) ? 1u : 0u; mine = (j == x) ? c : mine; }
        if (sum == G) break;
        __builtin_amdgcn_s_sleep(1);
        if ((++sp & 255u) == 0u) { if (xb_ld(&bar[XB_TMO])) break; if (sp > XB_SPIN_CAP) { atomicAdd(&bar[XB_TMO], 1u); break; } }
    }
    nloc = mine > 0u ? mine : 1u; nx = cnt > 0u ? cnt : 1u;
}
__device__ __forceinline__ void xcd_barrier(const XcdBarrier& b) {
    asm volatile("s_waitcnt vmcnt(0)" ::: "memory");
    __syncthreads();
    if (threadIdx.x == 0) {
        unsigned* bar = b.bar;
        __builtin_amdgcn_s_waitcnt(0);
        unsigned nloc = b.st[0], nx = b.st[1];
        if (nloc == 0u) { xcd_barrier_complete(bar, b.x, nloc, nx); b.st[0] = nloc; b.st[1] = nx; }
        const unsigned old = xb_add(&bar[XB_XSUB(b.x)], 1u);
        const unsigned gen = old / nloc;
        if (old + 1u == (gen + 1u) * nloc) {
            __builtin_amdgcn_fence(__ATOMIC_RELEASE, "agent");
            asm volatile("s_waitcnt vmcnt(0)" ::: "memory");
            const unsigned og = xb_add(&bar[XB_TOP], 1u);
            const unsigned tg = og / nx;
            if (og + 1u == (tg + 1u) * nx) xb_add(&bar[XB_TOPGEN], 1u);
            else XB_SPIN(xb_ld(&bar[XB_TOPGEN]) == tg, bar);
            __builtin_amdgcn_fence(__ATOMIC_ACQUIRE, "agent");
            xb_add(&bar[XB_XGEN(b.x)], 1u);
            asm volatile("s_waitcnt vmcnt(0)" ::: "memory");
        } else {
            XB_SPIN(xb_ld(&bar[XB_XGEN(b.x)]) == gen, bar);
            __builtin_amdgcn_fence(__ATOMIC_ACQUIRE, "agent");
            asm volatile("s_waitcnt vmcnt(0)" ::: "memory");
        }
    }
    __syncthreads();
}
#endif

#ifdef EMU
#define GRID_SYNC() emu_grid_sync()
#define GRID_SYNC_CG() emu_grid_sync()
#else
#define GRID_SYNC_CG() do { \
    asm volatile("s_waitcnt vmcnt(0)" ::: "memory"); \
    __syncthreads(); \
    cooperative_groups::this_grid().sync(); \
    if (threadIdx.x == 0) { __builtin_amdgcn_fence(__ATOMIC_ACQUIRE, "agent"); asm volatile("s_waitcnt vmcnt(0)" ::: "memory"); } \
    __syncthreads(); \
} while (0)
#define GRID_SYNC() xcd_barrier(xbar)
#endif
__global__ void __launch_bounds__(NT) fwd_megakernel(Params p) {
    SMEM_DECL;
    const int bid = blockIdx.x, nblk = gridDim.x;
#ifndef EMU
    if (threadIdx.x < 4) ((volatile LAS unsigned*)(smem + LDS_BARST))[threadIdx.x] = 0u;
    __syncthreads();
    const XcdBarrier xbar = xcd_barrier_post((unsigned*)(p.ws + OFF_SMALL + SM_CTL) + CW_BAR, (volatile LAS unsigned*)(smem + LDS_BARST));
#endif
#if defined(DRY_PHASE) && !defined(EMU)
    int dryflag = 1; asm volatile("" : "+s"(dryflag));
#define EXTRA(k, call) do { if (DRY_PHASE == (k)) { call; GRID_SYNC(); } } while (0)
#else
#define EXTRA(k, call) do {} while (0)
    const int dryflag = 0; (void)dryflag;
#endif
    EXTRA(0, phase0(p, smem, bid, nblk));
    phase0(p, smem, bid, nblk); GRID_SYNC();
    EXTRA(1, phase1(p, smem, bid, nblk));
    phase1(p, smem, bid, nblk); GRID_SYNC();
    EXTRA(2, phase2(p, smem, bid, nblk, dryflag));
    phase2(p, smem, bid, nblk); GRID_SYNC();
    EXTRA(3, phase3(p, smem, bid, nblk, dryflag));
    EXTRA(8, phase3(p, smem, bid, nblk, dryflag, 1));
    EXTRA(9, phase3(p, smem, bid, nblk, dryflag, 2));
    phase3(p, smem, bid, nblk); GRID_SYNC();
    EXTRA(4, phase4(p, smem, bid, nblk));
    phase4(p, smem, bid, nblk); GRID_SYNC();
    EXTRA(5, phase5a(p, smem, bid, nblk));
    phase5a(p, smem, bid, nblk); GRID_SYNC();
    EXTRA(10, phase5b(p, smem, bid, nblk));
    phase5b(p, smem, bid, nblk); GRID_SYNC();
    EXTRA(11, phase5c(p, smem, bid, nblk));
    phase5c(p, smem, bid, nblk); GRID_SYNC();
    EXTRA(12, phase5d(p, smem, bid, nblk, dryflag));
    phase5d(p, smem, bid, nblk); GRID_SYNC();
    EXTRA(6, phase6a(p, smem, bid, nblk));
    phase6a(p, smem, bid, nblk); GRID_SYNC();
    EXTRA(13, phase6b(p, smem, bid, nblk));
    phase6b(p, smem, bid, nblk); GRID_SYNC();
    EXTRA(7, phase7(p, smem, bid, nblk, dryflag));
    phase7(p, smem, bid, nblk);
}

#ifndef EMU
extern "C" void kernel_launch(void* const* d_in, const int* in_sizes, int n_in, void* d_out, int out_size, void* d_ws, size_t ws_size, hipStream_t stream) {
    static int grid = 0;
    if (grid == 0) {
        if (n_in != 25 || ws_size < WS_END || out_size != SEQ * D) { fprintf(stderr, "kernel_launch: unexpected problem (n_in %d, ws %zu, out %d)\n", n_in, ws_size, out_size); grid = -1; return; }
        int dev = 0, cus = 0, per_cu = 0;
        (void)hipGetDevice(&dev);
        (void)hipDeviceGetAttribute(&cus, hipDeviceAttributeMultiprocessorCount, dev);
        (void)hipFuncSetAttribute((const void*)fwd_megakernel, hipFuncAttributeMaxDynamicSharedMemorySize, LDS_BYTES);
        (void)hipOccupancyMaxActiveBlocksPerMultiprocessor(&per_cu, (const void*)fwd_megakernel, NT, LDS_BYTES);
        if (per_cu < 1) { fprintf(stderr, "kernel_launch: occupancy query returned %d\n", per_cu); per_cu = 1; }
        grid = cus * per_cu;
    }
    if (grid < 0) return;
    Params p{};
    for (int i = 0; i < 25; ++i) p.in[i] = (const float*)d_in[i];
    p.out = (float*)d_out; p.ws = (unsigned char*)d_ws;
    (void)hipMemsetAsync((unsigned char*)d_ws + OFF_SMALL + SM_CTL + (size_t)CW_BAR * 4, 0, (size_t)XCD_BAR_WORDS * 4, stream);
    void* args[] = {&p};
    hipError_t e = hipLaunchCooperativeKernel((const void*)fwd_megakernel, dim3(grid), dim3(NT), args, LDS_BYTES, stream);
    if (e != hipSuccess) fprintf(stderr, "cooperative launch failed: %s (grid %d)\n", hipGetErrorString(e), grid);
}
#endif

#ifdef EMU
static void run_phases(Params p, int upto, int grid) {
    if (upto == 100) { emu::launch([=] { fwd_megakernel(p); }, grid, NT, LDS_BYTES, true); return; }
    if (upto >= 0) emu::launch([=] { k_phase0(p); }, grid, NT, LDS_BYTES, false);
    if (upto >= 1) emu::launch([=] { k_phase1(p); }, grid, NT, LDS_BYTES, false);
    if (upto >= 2) emu::launch([=] { k_phase2(p); }, grid, NT, LDS_BYTES, false);
    if (upto >= 3) emu::launch([=] { k_phase3(p); }, grid, NT, LDS_BYTES, false);
    if (upto >= 4) emu::launch([=] { k_phase4(p); }, grid, NT, LDS_BYTES, false);
    if (upto >= 5) { emu::launch([=] { k_phase5a(p); }, grid, NT, LDS_BYTES, false); emu::launch([=] { k_phase5b(p); }, grid, NT, LDS_BYTES, false); emu::launch([=] { k_phase5c(p); }, grid, NT, LDS_BYTES, false); emu::launch([=] { k_phase5d(p); }, grid, NT, LDS_BYTES, false); }
    if (upto >= 6) { emu::launch([=] { k_phase6a(p); }, grid, NT, LDS_BYTES, false); emu::launch([=] { k_phase6b(p); }, grid, NT, LDS_BYTES, false); }
    if (upto >= 7) emu::launch([=] { k_phase7(p); }, grid, NT, LDS_BYTES, false);
}
#endif
```

```cpp
#include <type_traits>
#ifndef EMU
#include <hip/hip_runtime.h>
#include <hip/hip_cooperative_groups.h>
#include <cstdio>
#include <cstdint>
#include <cmath>
#endif

#ifndef SEQ
#define SEQ 16384
#endif

typedef unsigned short bf16;
typedef short bf16x8 __attribute__((ext_vector_type(8)));
typedef short bf16x4 __attribute__((ext_vector_type(4)));
typedef float f32x16 __attribute__((ext_vector_type(16)));
typedef float f32x4 __attribute__((ext_vector_type(4)));
typedef unsigned u32x4 __attribute__((ext_vector_type(4)));
typedef unsigned u32x2 __attribute__((ext_vector_type(2)));

#ifdef EMU
#define MFMA32(a, b, c) emu_mfma_32x32x16((a), (b), (c))
#define MFMA16(a, b, c) emu_mfma_16x16x32((a), (b), (c))
#define DI static inline
#define DM inline
#define EXP2F(x) exp2f(x)
#define WAVE_SYNC() emu_wave_sync()
#define LD_NT(p) (*(p))
#define LD_ATOMIC(p) (*(p))
#define ST_ATOMIC(p, v) (*(p) = (v))
#define SCHED_FENCE() do {} while (0)
#define SETPRIO(x) do {} while (0)
#else
#define WAVE_SYNC() do { __builtin_amdgcn_fence(__ATOMIC_RELEASE, "wavefront"); __builtin_amdgcn_wave_barrier(); __builtin_amdgcn_fence(__ATOMIC_ACQUIRE, "wavefront"); } while (0)
#define MFMA32(a, b, c) __builtin_amdgcn_mfma_f32_32x32x16_bf16((a), (b), (c), 0, 0, 0)
#define LD_NT(p) __builtin_nontemporal_load(p)
#define LD_ATOMIC(p) __hip_atomic_load((p), __ATOMIC_RELAXED, __HIP_MEMORY_SCOPE_AGENT)
#define ST_ATOMIC(p, v) __hip_atomic_store((p), (v), __ATOMIC_RELAXED, __HIP_MEMORY_SCOPE_AGENT)
#define SCHED_FENCE() __builtin_amdgcn_sched_barrier(0)
#define SETPRIO(x) __builtin_amdgcn_s_setprio(x)
#define MFMA16(a, b, c) __builtin_amdgcn_mfma_f32_16x16x32_bf16((a), (b), (c), 0, 0, 0)
#define DI __device__ __forceinline__
#define DM __device__ __forceinline__
#define EXP2F(x) __builtin_amdgcn_exp2f(x)
#endif

constexpr int D = 1024;
constexpr int NMETA = 16;
constexpr int LTOK = SEQ + NMETA;
constexpr int NCH = SEQ / 64 + 1;
constexpr int NT = 512;
constexpr int W_IN_COLS = 9232;
constexpr float NORM_EPS = 1e-6f;
constexpr float LOG2E = 1.4426950408889634f;

constexpr size_t UNIT = (size_t)SEQ * D * 2;
constexpr size_t OFF_WTIN = 0;
constexpr size_t OFF_WTBA = OFF_WTIN + (size_t)9216 * 1024 * 2;
constexpr size_t OFF_WTBD = OFF_WTBA + (size_t)1024 * 1024 * 2;
constexpr size_t OFF_WTOUT = OFF_WTBD + (size_t)1024 * 1024 * 2;
constexpr size_t OFF_SMALL = OFF_WTOUT + (size_t)1024 * 1024 * 2;
constexpr size_t SM_CTL = 0;
constexpr size_t SM_UMETA = SM_CTL + 65536;
constexpr size_t SM_AKMETA = SM_UMETA + 16 * 1024 * 2;
constexpr size_t SM_AVTMETA = SM_AKMETA + 16 * 1024 * 2;
constexpr size_t SM_C0Q = SM_AVTMETA + 8 * 128 * 16 * 2;
constexpr size_t SM_C0K = SM_C0Q + 64 * 1024 * 2;
constexpr size_t SM_C0V = SM_C0K + 64 * 1024 * 2;
constexpr size_t SM_C0W = SM_C0V + 64 * 1024 * 2;
constexpr size_t SM_C0QK = SM_C0W + 8 * 64 * 128 * 2;
constexpr size_t SM_BETA = SM_C0QK + 8 * 64 * 64 * 2;
constexpr size_t SM_G = SM_BETA + (size_t)NCH * 64 * 8 * 4;
constexpr size_t SM_GC = SM_G + (size_t)NCH * 64 * 8 * 4;
constexpr size_t SM_WR = SM_GC + (size_t)NCH * 8 * 64 * 4;
constexpr size_t SM_RIDS = SM_WR + 2 * 64 * 1024 * 2;
constexpr size_t SM_RW = SM_RIDS + 0;
constexpr size_t SM_TAILS = SM_RW + (size_t)SEQ * 2 * 4;
constexpr size_t SM_TAILS_BYTES = ((size_t)NCH * 3 * 3072 * 2 > (size_t)32 * SEQ * 4) ? (size_t)NCH * 3 * 3072 * 2 : (size_t)32 * SEQ * 4;
constexpr size_t SM_END = SM_TAILS + SM_TAILS_BYTES;
constexpr size_t SMALL_BYTES = (SM_END + 255) & ~(size_t)255;
constexpr size_t OFF_U = ((OFF_SMALL + SMALL_BYTES + (1u << 20) - 1) >> 20) << 20;
constexpr size_t OFF_W = OFF_U + UNIT;
constexpr size_t OFF_KN = OFF_W + UNIT;
constexpr size_t OFF_QN = OFF_KN + UNIT;
constexpr size_t OFF_DG = OFF_QN + UNIT;
constexpr size_t OFF_V = OFF_DG + UNIT;
constexpr size_t OFF_AQ = OFF_V + UNIT;
constexpr size_t WS_BASE_END = OFF_AQ + UNIT;
constexpr size_t EXPERT_BYTES = (size_t)32 * 3 * 1024 * 256 * 2;
constexpr size_t OFF_EXP = (2 * UNIT >= EXPERT_BYTES) ? OFF_W : WS_BASE_END;
constexpr size_t WS_END1 = (OFF_EXP == OFF_W) ? WS_BASE_END : WS_BASE_END + EXPERT_BYTES;
constexpr size_t H_BYTES = ((size_t)2 * SEQ + 32 * 256) * 256 * 2;
constexpr size_t OFF_H = (H_BYTES <= UNIT) ? (OFF_SMALL + SMALL_BYTES + ((1u << 20) - 1)) / (1u << 20) * (1u << 20) : WS_END1;
constexpr size_t WS_END = (H_BYTES <= UNIT) ? WS_END1 : WS_END1 + H_BYTES;
constexpr size_t OFF_EXG = OFF_EXP, OFF_EXU = OFF_EXP + EXPERT_BYTES / 3, OFF_EXD = OFF_EXP + 2 * (EXPERT_BYTES / 3);
constexpr size_t OFF_QKB = OFF_U;
constexpr size_t OFF_OD = OFF_QN;
constexpr size_t OFF_Y = OFF_V;
#if SEQ == 16384
static_assert(WS_END <= (size_t)256 << 20, "workspace map exceeds 256 MiB");
static_assert(EXPERT_BYTES <= 2 * UNIT, "experts fit R2+R3");
#endif
constexpr int CW_ATTQ = 64;
constexpr int CW_ECNT = 128;
constexpr int CW_NRM = 256;
constexpr int CW_BAR = 1024;

struct Params {
    const float* in[25];
    float* out;
    unsigned char* ws;
};

#ifdef EMU
DI unsigned f2bf(float f) { unsigned u = __builtin_bit_cast(unsigned, f); return (u + 0x7fffu + ((u >> 16) & 1u)) >> 16; }
#else
DI unsigned f2bf(float f) { return (unsigned)__builtin_bit_cast(unsigned short, (__bf16)f); }
#endif

DI float bf2f(unsigned b) { return __builtin_bit_cast(float, (b & 0xffffu) << 16); }
#ifdef EMU
DI unsigned pk2(float lo, float hi) { return f2bf(lo) | (f2bf(hi) << 16); }
DI bool wave_any(bool pr) { int v = pr ? 1 : 0;
    for (int o = 1; o < 64; o <<= 1) v |= __shfl_xor(v, o);
    return v != 0; }
#else
typedef __bf16 hwbf2 __attribute__((ext_vector_type(2)));
typedef float f32x2_ __attribute__((ext_vector_type(2)));
DI unsigned pk2(float lo, float hi) { return __builtin_bit_cast(unsigned, __builtin_convertvector((f32x2_){lo, hi}, hwbf2)); }
DI bool wave_any(bool pr) { return __any(pr) != 0; }
#endif
DI float bflo(unsigned w) { return __builtin_bit_cast(float, w << 16); }
DI float bfhi(unsigned w) { return __builtin_bit_cast(float, w & 0xffff0000u); }
#ifdef EMU
DI float rcpf_(float x) { return 1.0f / x; }
#else
DI float rcpf_(float x) { return __builtin_amdgcn_rcpf(x); }
#endif
DI float sigmoidf_(float x) { return rcpf_(1.0f + __expf(-x)); }
DI float siluf_(float x) { return x * rcpf_(1.0f + __expf(-x)); }
DI float wave_sum(float v) {
#pragma unroll
    for (int o = 1; o < 64; o <<= 1) v += __shfl_xor(v, o);
    return v;
}
DI int fresh_tid() {
    int t = threadIdx.x;
#ifndef EMU
    asm volatile("" : "+v"(t));
#endif
    return t;
}
#ifdef EMU
DI float xhalf(float v) { return __shfl_xor(v, 32); }
#else
DI float xhalf(float v) { const unsigned u = __builtin_bit_cast(unsigned, v); const auto r = __builtin_amdgcn_permlane32_swap(u, u, false, false); return __builtin_bit_cast(float, (threadIdx.x & 32) ? r[0] : r[1]); }
#endif
DI f32x16 zero16() { f32x16 z; for (int i = 0; i < 16; ++i) z[i] = 0.f; return z; }
DI f32x4 zero4() { f32x4 z; for (int i = 0; i < 4; ++i) z[i] = 0.f; return z; }
DI int swz128(int row, int c) { return row * 128 + ((c ^ ((row >> 1) & 7)) << 4); }
DI int swz128t(int row, int c) { return row * 128 + ((c ^ ((row >> 1) & 7) ^ ((row >> 4) & 7)) << 4); }
DI int swz128_8(int row, int s) { return row * 128 + ((s ^ (((row >> 1) & 7) << 1)) << 3); }
DI int swzrow(int row, int pitch, int c) { return row * pitch + ((c ^ (row & 15)) << 4); }

#ifdef EMU
#define SMEM_DECL char* smem = emu_smem()
#else
#define SMEM_DECL extern __shared__ __attribute__((aligned(16))) char smem[]
#endif

DI void transpose_item(const float* W, int ldw, int K, bf16* Wt, int k0, int src_n0, int dst_n0, float* scr, int lane, int il = 0) {
#pragma unroll 8
    for (int i = 0; i < 32; ++i) { const int kk = 2 * i + (lane >> 5); scr[kk * 33 + (lane & 31)] = W[(size_t)(k0 + kk) * ldw + src_n0 + (lane & 31)]; }
    WAVE_SYNC();
    const int c = lane & 7;
#pragma unroll
    for (int j = 0; j < 4; ++j) {
        const int n = (lane >> 3) + 8 * j; const float* s = scr + (8 * c) * 33 + n;
        u32x4 o; o.x = pk2(s[0 * 33], s[1 * 33]); o.y = pk2(s[2 * 33], s[3 * 33]); o.z = pk2(s[4 * 33], s[5 * 33]); o.w = pk2(s[6 * 33], s[7 * 33]);
        const int hid = dst_n0 + n, drow = il ? 8 * (hid >> 2) + 4 * (il - 1) + (hid & 3) : hid;
        *(u32x4*)(Wt + (size_t)drow * K + k0 + 8 * c) = o;
    }
    WAVE_SYNC();
}

DI void phase0(const Params& p, char* smem, int bid, int nblk) {
    const int tid = fresh_tid(), lane = tid & 63, wave = tid >> 6;
    const int gw = bid * 8 + wave, NGW = nblk * 8;
    unsigned char* ws = p.ws;
    if (bid == 0) {
        unsigned* ctl = (unsigned*)(ws + OFF_SMALL + SM_CTL);
        for (int i = tid; i < 1024; i += NT) ctl[i] = 0u;
        float* be = (float*)(ws + OFF_SMALL + SM_BETA); float* gg = (float*)(ws + OFF_SMALL + SM_G);
        for (int i = tid; i < 48 * 8; i += NT) { be[i] = 0.f; gg[i] = 0.f; }
    }
    {
        float* scr = (float*)(smem + 65536) + wave * (64 * 33);
        constexpr int I_IN = 16 * (9216 / 32), I_SQ = 16 * 32;
        constexpr int NITEMS = I_IN + 3 * I_SQ;
        for (int it = gw; it < NITEMS; it += NGW) {
            int r = it;
            if (r < I_IN) { const int kb = r / 288, nb = r % 288; const int dn = nb * 32; const int sn = dn < 7168 ? dn : dn + 16;
                transpose_item(p.in[3], W_IN_COLS, 1024, (bf16*)(ws + OFF_WTIN), kb * 64, sn, dn, scr, lane); continue; }
            r -= I_IN;
            const int m = r / I_SQ; r %= I_SQ;
            const float* src = m == 0 ? p.in[13] : (m == 1 ? p.in[14] : p.in[15]);
            bf16* dst = (bf16*)(ws + (m == 0 ? OFF_WTBA : (m == 1 ? OFF_WTBD : OFF_WTOUT)));
            transpose_item(src, 1024, 1024, dst, (r / 32) * 64, (r % 32) * 32, (r % 32) * 32, scr, lane);
        }
    }
    {
        bf16* WH = (bf16*)(ws + OFF_SMALL + SM_WR); bf16* WL = WH + 64 * 1024;
        for (int i = bid * NT + tid; i < 64 * 1024; i += nblk * NT) {
            const int n = i >> 10, kk = i & 1023; float v = 0.f;
            if (n < 4) v = p.in[17][kk * 4 + n]; else if (n < 36) v = p.in[19][kk * 32 + (n - 4)];
            v *= p.in[16][kk];
            const unsigned hb = f2bf(v); const float lo = v - bf2f(hb);
            WH[i] = (bf16)hb; WL[i] = (bf16)f2bf(lo);
        }
    }
    float* wbd = (float*)smem;
    for (int i = tid; i < 1024 * 16; i += NT) { const int k = i >> 4, c = i & 15; wbd[c * 1024 + k] = p.in[3][(size_t)k * W_IN_COLS + 7168 + c]; }
    __syncthreads();
    const float* nw = p.in[2];
    for (int R = gw; R < LTOK; R += NGW) {
        const float* xrow = R < NMETA ? p.in[1] + (size_t)R * D : p.in[0] + (size_t)(R - NMETA) * D;
        bf16* urow = R < NMETA ? (bf16*)(ws + OFF_SMALL + SM_UMETA) + (size_t)R * D : (bf16*)(ws + OFF_U) + (size_t)(R - NMETA) * D;
        float ss = 0.f;
#pragma unroll
        for (int j = 0; j < 4; ++j) { const float4 v = *(const float4*)(xrow + 4 * lane + 256 * j); ss += v.x * v.x + v.y * v.y + v.z * v.z + v.w * v.w; }
        ss = wave_sum(ss);
        const float rstd = rsqrtf(ss * (1.0f / D) + NORM_EPS);
        float acc[16];
#pragma unroll
        for (int c = 0; c < 16; ++c) acc[c] = 0.f;
#pragma unroll 1
        for (int j = 0; j < 4; ++j) {
            const float4 w4 = *(const float4*)(nw + 4 * lane + 256 * j);
            const float4 xv = *(const float4*)(xrow + 4 * lane + 256 * j);
            float uu[4] = {xv.x * rstd * w4.x, xv.y * rstd * w4.y, xv.z * rstd * w4.z, xv.w * rstd * w4.w};
            u32x2 o; o.x = pk2(uu[0], uu[1]); o.y = pk2(uu[2], uu[3]);
            *(u32x2*)(urow + 4 * lane + 256 * j) = o;
#pragma unroll
            for (int c = 0; c < 16; ++c) {
                const f32x4 w = *(const f32x4*)(wbd + c * 1024 + 4 * lane + 256 * j);
                acc[c] += uu[0] * w[0] + uu[1] * w[1] + uu[2] * w[2] + uu[3] * w[3];
            }
        }
        float v8[8], v4[4], v2[2], a;
        {
            const bool b0 = lane & 1, b1 = lane & 2, b2 = lane & 4, b3 = lane & 8;
#pragma unroll
            for (int i = 0; i < 8; ++i) { const float keep = b0 ? acc[i + 8] : acc[i], send = b0 ? acc[i] : acc[i + 8]; v8[i] = keep + __shfl_xor(send, 1); }
#pragma unroll
            for (int i = 0; i < 4; ++i) { const float keep = b1 ? v8[i + 4] : v8[i], send = b1 ? v8[i] : v8[i + 4]; v4[i] = keep + __shfl_xor(send, 2); }
#pragma unroll
            for (int i = 0; i < 2; ++i) { const float keep = b2 ? v4[i + 2] : v4[i], send = b2 ? v4[i] : v4[i + 2]; v2[i] = keep + __shfl_xor(send, 4); }
            { const float keep = b3 ? v2[1] : v2[0], send = b3 ? v2[0] : v2[1]; a = keep + __shfl_xor(send, 8); }
            a += __shfl_xor(a, 16); a += __shfl_xor(a, 32);
        }
        if (lane < 16) {
            const int cc = ((lane & 1) << 3) | ((lane & 2) << 1) | ((lane & 4) >> 1) | ((lane & 8) >> 3);
            const size_t pos = 48 + R;
            if (cc < 8) { ((float*)(ws + OFF_SMALL + SM_BETA))[pos * 8 + cc] = sigmoidf_(a); }
            else { const int hh = cc - 8; const float z = a + p.in[11][hh]; const float sp = fmaxf(z, 0.f) + log1pf(__expf(-fabsf(z)));
                   ((float*)(ws + OFF_SMALL + SM_G))[pos * 8 + hh] = -__expf(p.in[10][hh]) * sp; }
        }
    }
}

namespace pg8 {
constexpr int BM = 256, BK = 64, HALF = 128, HTB = HALF * BK * 2, NXCD = 8, WGM = 8;
DI int lds_byte(int r, int c) { const int st = (r >> 4) * 2 + (c >> 5), rr = r & 15, cc = c & 31, ob = rr * 64 + cc * 2; return st * 1024 + (ob ^ (((ob >> 9) & 1) << 5)); }
DI void stage_rc(int b, int& R, int& C) { const int st = b / 1024, sb = b % 1024, swz = sb ^ (((sb >> 9) & 1) << 5); R = (st >> 1) * 16 + swz / 64; C = (st & 1) * 32 + (swz % 64) / 2; }
DI int perm32(int rho) { const int n = rho >> 4, i = rho & 15; return 8 * (i >> 2) + 4 * n + (i & 3); }
struct Unit { int pm, pn, e; };
struct Gemm { const bf16* A; const bf16* Bt; int M, N, K; };
struct StaticOrder {
    static constexpr bool GATHER = false;
    int nM, nN, nwg, G, c;
    DM void init(int M, int N, int G_, int c_) { nM = M / BM; nN = N / BM; nwg = nM * nN; G = G_; c = c_; }
    DM bool next(int i, Unit& u) const {
        const long L = (long)i * G + c; if (L >= nwg) return false;
        int wgid = (int)L; { const int q = nwg / NXCD, r = nwg % NXCD, xcd = wgid % NXCD, off = wgid / NXCD; wgid = (xcd < r ? xcd * (q + 1) : r * (q + 1) + (xcd - r) * q) + off; }
        const int nig = WGM * nN, gid = wgid / nig, fm = gid * WGM, gsz = (nM - fm) < WGM ? (nM - fm) : WGM;
        u.pm = fm + ((wgid % nig) % gsz); u.pn = (wgid % nig) / gsz; u.e = 0; return true;
    }
    DM const char* a_tile(const Gemm& g, const Unit& u) const { return (const char*)g.A + (size_t)u.pm * 256 * g.K * 2; }
    DM const char* b_tile(const Gemm& g, const Unit& u) const { return (const char*)g.Bt + (size_t)u.pn * 256 * g.K * 2; }
    DM int a_row(const Unit&, int) const { return 0; }
};
#ifdef EMU
template <class Epi, class Sched>
DI void gemm_phase(char* lds, const Gemm g, const Sched& S, const Epi& E) {
    const int tid = threadIdx.x, wid = tid >> 6, lane = tid & 63, wr = wid >> 2, wc = wid & 3, fr = lane & 15, fq = lane >> 4;
    Unit u;
    for (int ui = 0; S.next(ui, u); ++ui) {
        f32x4 acc[2][2][4][2];
        const bf16* bt = (const bf16*)S.b_tile(g, u);
        for (int ai = 0; ai < 2; ++ai) for (int bj = 0; bj < 2; ++bj) for (int m = 0; m < 4; ++m) for (int n = 0; n < 2; ++n) for (int e = 0; e < 4; ++e) {
            const int r = 128 * ai + 64 * wr + 16 * m + fr;
            const int c = 128 * bj + 32 * wc + (Epi::PERM ? 8 * fq + 4 * n : 16 * n + 4 * fq) + e;
            const bf16* a = Sched::GATHER ? g.A + (size_t)S.a_row(u, r) * g.K : (const bf16*)S.a_tile(g, u) + (size_t)r * g.K;
            const bf16* b = bt + (size_t)c * g.K; float s = 0.f;
            for (int kk = 0; kk < g.K; ++kk) s += bf2f(a[kk]) * bf2f(b[kk]);
            acc[ai][bj][m][n][e] = s;
        }
        E(acc, u, wr, wc, fr, fq);
    }
    __syncthreads();
}
#else
#define PG8_LAS __attribute__((address_space(3)))
template <class Epi, class Sched>
__device__ __forceinline__ void gemm_phase(char* lds_, const Gemm g, const Sched& S, const Epi& E) {
    PG8_LAS unsigned char* lds = (PG8_LAS unsigned char*)lds_;
    const int tid = fresh_tid(), wid = __builtin_amdgcn_readfirstlane(tid >> 6), lane = tid & 63, wr = wid >> 2, wc = wid & 3, fr = lane & 15, fq = lane >> 4;
    const int K = g.K, nt = K / BK;
    unsigned voffA[2], voffB[2]; int RA[2], CA[2];
#pragma unroll
    for (int i = 0; i < 2; ++i) { int R, C; stage_rc(tid * 16 + i * 8192, R, C); const int Rb = Epi::PERM ? ((R & ~31) + perm32(R & 31)) : R;
        voffA[i] = (unsigned)(R * K + C) * 2u; voffB[i] = (unsigned)(Rb * K + C) * 2u; RA[i] = R; CA[i] = C; }
    const size_t kstep = (size_t)(BK * 2);
    const size_t hstep = (size_t)HALF * K * 2;
    const unsigned ldsw = (unsigned)wid * 1024u;
    const int aoff = lds_byte(wr * 64 + fr, fq * 8), boff = lds_byte(wc * 32 + fr, fq * 8);
#define PG8_SA(b, h) (((b) * 2 + (h)) * HTB)
#define PG8_SB(b, h) ((4 + (b) * 2 + (h)) * HTB)
#define PG8_STAGE(bufoff, gbase, voff) do { _Pragma("unroll") for (int _i = 0; _i < 2; ++_i) \
        __builtin_amdgcn_global_load_lds((const unsigned*)((const char*)(gbase) + (voff)[_i]), (PG8_LAS unsigned*)(lds + (bufoff) + ldsw + _i * 8192), 16, 0, 0); } while (0)
#define PG8_STAGE_A(bufoff, base, PA, half, koff) do { if constexpr (Sched::GATHER) { _Pragma("unroll") for (int _i = 0; _i < 2; ++_i) \
        __builtin_amdgcn_global_load_lds((const unsigned*)((PA)[half][_i] + (koff)), (PG8_LAS unsigned*)(lds + (bufoff) + ldsw + _i * 8192), 16, 0, 0); } \
        else { PG8_STAGE(bufoff, (base) + (half) * hstep + (koff), voffA); } } while (0)
#define PG8_LDA(dst, b, h) do { _Pragma("unroll") for (int m = 0; m < 4; ++m) _Pragma("unroll") for (int k = 0; k < 2; ++k) dst[m][k] = *(const PG8_LAS bf16x8*)(lds + PG8_SA(b, h) + aoff + m * 2048 + k * 1024); } while (0)
#define PG8_LDB(dst, b, h) do { _Pragma("unroll") for (int n = 0; n < 2; ++n) _Pragma("unroll") for (int k = 0; k < 2; ++k) dst[n][k] = *(const PG8_LAS bf16x8*)(lds + PG8_SB(b, h) + boff + n * 2048 + k * 1024); } while (0)
#define PG8_MMA(ai, bj, At, Bt) do { __builtin_amdgcn_s_setprio(1); _Pragma("unroll") for (int m = 0; m < 4; ++m) _Pragma("unroll") for (int n = 0; n < 2; ++n) _Pragma("unroll") for (int k = 0; k < 2; ++k) \
        acc[ai][bj][m][n] = __builtin_amdgcn_mfma_f32_16x16x32_bf16(Bt[n][k], At[m][k], acc[ai][bj][m][n], 0, 0, 0); __builtin_amdgcn_s_setprio(0); } while (0)
#define PG8_WAIT_V(n) asm volatile("s_waitcnt vmcnt(" #n ")" ::: "memory")
#define PG8_WAIT_L(n) asm volatile("s_waitcnt lgkmcnt(" #n ")" ::: "memory")
#define PG8_BAR __builtin_amdgcn_s_barrier()
#define PG8_SCHED __builtin_amdgcn_sched_barrier(0)
    Unit cur, nxt; int ui = 0;
    if (S.next(0, cur)) {
    f32x4 acc[2][2][4][2];
#pragma unroll
    for (int a = 0; a < 2; ++a)
#pragma unroll
        for (int b = 0; b < 2; ++b)
#pragma unroll
            for (int m = 0; m < 4; ++m)
#pragma unroll
                for (int n = 0; n < 2; ++n) acc[a][b][m][n] = (f32x4){0.f, 0.f, 0.f, 0.f};
    bf16x8 At[4][2], B0[2][2], B1[2][2];
    const char* PAc[2][2]; const char* PAn[2][2];
    auto gather_ptrs = [&](const Unit& u, const char* (&PA)[2][2]) {
        if constexpr (Sched::GATHER) {
#pragma unroll
            for (int hh = 0; hh < 2; ++hh)
#pragma unroll
                for (int i = 0; i < 2; ++i) PA[hh][i] = (const char*)g.A + ((size_t)S.a_row(u, hh * 128 + RA[i]) * K + CA[i]) * 2;
        }
    };
    const char* cA = Sched::GATHER ? nullptr : S.a_tile(g, cur); const char* cB = S.b_tile(g, cur);
    gather_ptrs(cur, PAc);
    PG8_STAGE(PG8_SB(0, 0), cB, voffB); PG8_STAGE_A(PG8_SA(0, 0), cA, PAc, 0, 0); PG8_STAGE(PG8_SB(0, 1), cB + hstep, voffB); PG8_STAGE_A(PG8_SA(0, 1), cA, PAc, 1, 0);
    if (wr == 1) PG8_BAR;
    PG8_WAIT_V(4); PG8_BAR;
    PG8_STAGE(PG8_SB(1, 0), cB + kstep, voffB); PG8_STAGE_A(PG8_SA(1, 0), cA, PAc, 0, kstep); PG8_STAGE(PG8_SB(1, 1), cB + hstep + kstep, voffB);
    PG8_WAIT_V(6); PG8_BAR;
    for (;;) {
        const bool has_next = S.next(ui + 1, nxt);
        const char* nA = Sched::GATHER ? nullptr : (has_next ? S.a_tile(g, nxt) : cA); const char* nB = has_next ? S.b_tile(g, nxt) : cB;
        if (has_next) gather_ptrs(nxt, PAn); else { if constexpr (Sched::GATHER) { PAn[0][0] = PAc[0][0]; PAn[0][1] = PAc[0][1]; PAn[1][0] = PAc[1][0]; PAn[1][1] = PAc[1][1]; } }
        for (int t = 0; t < nt; t += 2) {
            const bool last = (t == nt - 2);
            const size_t k1 = (size_t)(t + 1) * kstep;
            const char* a2 = last ? nA : cA; const char* b2 = last ? nB : cB + (size_t)(t + 2) * kstep;
            const size_t k2 = last ? 0 : (size_t)(t + 2) * kstep, k3 = k2 + kstep;
            const char* b3 = b2 + kstep;
            const char* P2[2][2];
            if constexpr (Sched::GATHER) {
#pragma unroll
                for (int hh = 0; hh < 2; ++hh)
#pragma unroll
                    for (int i = 0; i < 2; ++i) P2[hh][i] = last ? PAn[hh][i] : PAc[hh][i];
            }
            PG8_LDB(B0, 0, 0); PG8_SCHED; PG8_LDA(At, 0, 0); PG8_STAGE_A(PG8_SA(1, 1), cA, PAc, 1, k1);
            PG8_WAIT_L(8); PG8_BAR; PG8_WAIT_L(0); PG8_MMA(0, 0, At, B0); PG8_BAR; PG8_SCHED;
            PG8_LDB(B1, 0, 1); PG8_STAGE(PG8_SB(0, 0), b2, voffB);
            PG8_BAR; PG8_WAIT_L(0); PG8_MMA(0, 1, At, B1); PG8_BAR;
            PG8_LDA(At, 0, 1); PG8_STAGE_A(PG8_SA(0, 0), a2, P2, 0, k2);
            PG8_BAR; PG8_WAIT_L(0); PG8_MMA(1, 0, At, B0); PG8_BAR; PG8_SCHED;
            PG8_STAGE(PG8_SB(0, 1), b2 + hstep, voffB);
            PG8_WAIT_V(6); PG8_BAR; PG8_MMA(1, 1, At, B1); PG8_BAR;
            PG8_LDB(B0, 1, 0); PG8_SCHED; PG8_LDA(At, 1, 0); PG8_STAGE_A(PG8_SA(0, 1), a2, P2, 1, k2);
            PG8_WAIT_L(8); PG8_BAR; PG8_WAIT_L(0); PG8_MMA(0, 0, At, B0); PG8_BAR; PG8_SCHED;
            PG8_LDB(B1, 1, 1); PG8_STAGE(PG8_SB(1, 0), b3, voffB);
            PG8_BAR; PG8_WAIT_L(0); PG8_MMA(0, 1, At, B1); PG8_BAR;
            PG8_LDA(At, 1, 1); PG8_STAGE_A(PG8_SA(1, 0), a2, P2, 0, k3);
            PG8_BAR; PG8_WAIT_L(0); PG8_MMA(1, 0, At, B0); PG8_BAR; PG8_SCHED;
            PG8_STAGE(PG8_SB(1, 1), b3 + hstep, voffB);
            PG8_WAIT_V(6); PG8_BAR; PG8_MMA(1, 1, At, B1); PG8_BAR;
        }
        E(acc, cur, wr, wc, fr, fq);
        if (!has_next) break;
#pragma unroll
        for (int a = 0; a < 2; ++a)
#pragma unroll
            for (int b = 0; b < 2; ++b)
#pragma unroll
                for (int m = 0; m < 4; ++m)
#pragma unroll
                    for (int n = 0; n < 2; ++n) acc[a][b][m][n] = (f32x4){0.f, 0.f, 0.f, 0.f};
        cur = nxt; cA = nA; cB = nB; ++ui;
        if constexpr (Sched::GATHER) { PAc[0][0] = PAn[0][0]; PAc[0][1] = PAn[0][1]; PAc[1][0] = PAn[1][0]; PAc[1][1] = PAn[1][1]; }
    }
    PG8_WAIT_V(0);
    if (wr == 0) PG8_BAR;
    PG8_BAR;
    }
    __syncthreads();
#undef PG8_SA
#undef PG8_SB
#undef PG8_STAGE
#undef PG8_STAGE_A
#undef PG8_LDA
#undef PG8_LDB
#undef PG8_MMA
#undef PG8_WAIT_V
#undef PG8_WAIT_L
#undef PG8_BAR
#undef PG8_SCHED
}
#endif
}

constexpr int G_BM = 256, G_BN = 128, G_BK = 64;
constexpr int G_LDS_A = G_BM * G_BK * 2, G_LDS_B = G_BN * G_BK * 2;
constexpr int G_STAGE_PITCH = 132;
constexpr int G_LDS_BYTES = G_BM * G_STAGE_PITCH * 4;
constexpr int G_MT = SEQ / 256 + 1, G_NTILES = 56;

DI void gemm_inproj_tile(const Params& p, char* smem, int mt, int nt) {
    const int tid = fresh_tid(), lane = tid & 63, wave = tid >> 6;
    const int wm = wave >> 1, wn = wave & 1, r32 = lane & 31, h = lane >> 5;
    unsigned char* ws = p.ws;
    const bool meta = (mt == G_MT - 1);
    const bf16* A = meta ? (const bf16*)(ws + OFF_SMALL + SM_UMETA) : (const bf16*)(ws + OFF_U) + (size_t)mt * 256 * D;
    const int vrows = meta ? NMETA : 256;
    const bf16* Bt = (const bf16*)(ws + OFF_WTIN) + (size_t)nt * 128 * D;
    char* ldsA[2] = {smem, smem + G_LDS_A + G_LDS_B};
    char* ldsB[2] = {smem + G_LDS_A, smem + 2 * G_LDS_A + G_LDS_B};
    f32x16 acc[2][2];
#pragma unroll
    for (int i = 0; i < 2; ++i)
#pragma unroll
        for (int j = 0; j < 2; ++j) acc[i][j] = zero16();
    const int lrow = tid >> 3, lc = tid & 7;
    u32x4 ra[4], rb[2];
    auto gload = [&](int kt) {
#pragma unroll
        for (int i = 0; i < 4; ++i) { const int row = lrow + 64 * i; ra[i] = row < vrows ? *(const u32x4*)(A + (size_t)row * D + kt * 64 + lc * 8) : (u32x4){0u, 0u, 0u, 0u}; }
#pragma unroll
        for (int i = 0; i < 2; ++i) { const int row = lrow + 64 * i; rb[i] = *(const u32x4*)(Bt + (size_t)row * D + kt * 64 + lc * 8); }
    };
    auto lstore = [&](int buf) {
#pragma unroll
        for (int i = 0; i < 4; ++i) *(u32x4*)(ldsA[buf] + swz128(lrow + 64 * i, lc)) = ra[i];
#pragma unroll
        for (int i = 0; i < 2; ++i) *(u32x4*)(ldsB[buf] + swz128(lrow + 64 * i, lc)) = rb[i];
    };
    gload(0); lstore(0); __syncthreads();
    for (int kt = 0; kt < 16; ++kt) {
        const int buf = kt & 1;
        if (kt + 1 < 16) gload(kt + 1);
#pragma unroll
        for (int ks = 0; ks < 4; ++ks) {
            bf16x8 af[2], bfr[2];
#pragma unroll
            for (int i = 0; i < 2; ++i) af[i] = *(const bf16x8*)(ldsA[buf] + swz128(64 * wm + 32 * i + r32, 2 * ks + h));
#pragma unroll
            for (int j = 0; j < 2; ++j) bfr[j] = *(const bf16x8*)(ldsB[buf] + swz128(64 * wn + 32 * j + r32, 2 * ks + h));
#pragma unroll
            for (int i = 0; i < 2; ++i)
#pragma unroll
                for (int j = 0; j < 2; ++j) acc[i][j] = MFMA32(af[i], bfr[j], acc[i][j]);
        }
        if (kt + 1 < 16) lstore(buf ^ 1);
        __syncthreads();
    }
    float* st = (float*)smem;
#pragma unroll
    for (int i = 0; i < 2; ++i)
#pragma unroll
        for (int j = 0; j < 2; ++j)
#pragma unroll
            for (int r = 0; r < 16; ++r) {
                const int row = 64 * wm + 32 * i + (r & 3) + 8 * (r >> 2) + 4 * h, col = 64 * wn + 32 * j + r32;
                st[row * G_STAGE_PITCH + col] = acc[i][j][r];
            }
    __syncthreads();
    const int tid2 = fresh_tid();
    const int sec = nt >> 3, cb = (nt & 7) * 128;
    {
        bf16* base; bool has_meta = true; bf16* mbase = nullptr; int mrow0 = 0;
        if (sec == 0) { base = (bf16*)(ws + OFF_AQ); has_meta = false; }
        else if (sec == 1) { base = (bf16*)p.out; mbase = (bf16*)(ws + OFF_SMALL + SM_AKMETA); }
        else if (sec == 2) { base = (bf16*)p.out + (size_t)SEQ * D; mbase = (bf16*)(ws + OFF_SMALL + SM_AVTMETA); }
        else if (sec == 3) { base = (bf16*)(ws + OFF_QN); mbase = (bf16*)(ws + OFF_SMALL + SM_C0Q); mrow0 = 48; }
        else if (sec == 4) { base = (bf16*)(ws + OFF_KN); mbase = (bf16*)(ws + OFF_SMALL + SM_C0K); mrow0 = 48; }
        else if (sec == 5) { base = (bf16*)(ws + OFF_V); mbase = (bf16*)(ws + OFF_SMALL + SM_C0V); mrow0 = 48; }
        else { base = (bf16*)(ws + OFF_DG); has_meta = false; }
        const bool dqkv = (sec >= 3 && sec <= 5);
        bf16* tails = (bf16*)(ws + OFF_SMALL + SM_TAILS);
        if (!meta || has_meta) {
#pragma unroll
            for (int i = 0; i < 8; ++i) {
                const int idx = tid2 + NT * i, row = idx >> 4, cg = idx & 15;
                if (row < vrows) {
                    const float* s = st + row * G_STAGE_PITCH + cg * 8;
                    const f32x4 a = *(const f32x4*)s, b = *(const f32x4*)(s + 4);
                    u32x4 o; o.x = pk2(a[0], a[1]); o.y = pk2(a[2], a[3]); o.z = pk2(b[0], b[1]); o.w = pk2(b[2], b[3]);
                    if (!meta) {
                        const int j = mt * 256 + row;
                        *(u32x4*)(base + (size_t)j * D + cb + cg * 8) = o;
                        if (dqkv && (j & 63) >= 61) *(u32x4*)(tails + ((size_t)(j / 64 + 1) * 3 + ((j & 63) - 61)) * 3072 + (sec - 3) * 1024 + cb + cg * 8) = o;
                    } else {
                        *(u32x4*)(mbase + (size_t)(mrow0 + row) * D + cb + cg * 8) = o;
                        if (dqkv && row >= 13) *(u32x4*)(tails + ((size_t)0 * 3 + (row - 13)) * 3072 + (sec - 3) * 1024 + cb + cg * 8) = o;
                    }
                }
            }
        }
    }
    __syncthreads();
}

struct EpiInproj {
    static constexpr bool PERM = true;
    unsigned char* ws; bf16* out16;
    DM void operator()(const f32x4 (&acc)[2][2][4][2], const pg8::Unit& u, int wr, int wc, int fr, int fq) const {
        const int colt = u.pn * 256, sec = colt >> 10, cb = colt & 1023;
        bf16* base = sec == 0 ? (bf16*)(ws + OFF_AQ) : sec == 1 ? out16 : sec == 2 ? out16 + (size_t)SEQ * D : sec == 3 ? (bf16*)(ws + OFF_QN) : sec == 4 ? (bf16*)(ws + OFF_KN)
                   : sec == 5 ? (bf16*)(ws + OFF_V) : (bf16*)(ws + OFF_DG);
        const bool dqkv = sec >= 3 && sec <= 5;
        bf16* tails = (bf16*)(ws + OFF_SMALL + SM_TAILS) + (sec - 3) * 1024;
        const int row0 = u.pm * 256 + wr * 64 + fr, col0 = cb + wc * 32 + 8 * fq;
#pragma unroll
        for (int ai = 0; ai < 2; ++ai)
#pragma unroll
            for (int m = 0; m < 4; ++m) {
                const int j = row0 + ai * 128 + m * 16;
                bf16* rowp = base + (size_t)j * D + col0;
                const bool tl = dqkv && (j & 63) >= 61;
#pragma unroll
                for (int bj = 0; bj < 2; ++bj) {
                    const f32x4 v0 = acc[ai][bj][m][0], v1 = acc[ai][bj][m][1];
                    const u32x4 w = {pk2(v0[0], v0[1]), pk2(v0[2], v0[3]), pk2(v1[0], v1[1]), pk2(v1[2], v1[3])};
                    *(u32x4*)(rowp + bj * 128) = w;
                    if (tl) *(u32x4*)(tails + ((size_t)(j / 64 + 1) * 3 + ((j & 63) - 61)) * 3072 + col0 + bj * 128) = w;
                }
            }
    }
};
DI void phase1(const Params& p, char* smem, int bid, int nblk) {
    for (int it = bid; it < 40; it += nblk) gemm_inproj_tile(p, smem, G_MT - 1, 8 + it);
    pg8::Gemm g{(const bf16*)(p.ws + OFF_U), (const bf16*)(p.ws + OFF_WTIN), SEQ, 7168, 1024};
    pg8::StaticOrder S; S.init(SEQ, 7168, nblk, bid);
    EpiInproj E{p.ws, (bf16*)p.out};
    pg8::gemm_phase(smem, g, S, E);
}

constexpr int P2_KN = 0, P2_KB = 16384, P2_QN = 32768, P2_KBGT = 49152, P2_VBT = 65536, P2_KDT = 81920, P2_ALDS = 98304, P2_TLDS = P2_ALDS + 64 * 64 * 4,
              P2_GC = P2_TLDS + 8192, P2_BET = P2_GC + 256, P2_EG = P2_BET + 256, P2_EKD = P2_EG + 256, P2_CW = P2_EKD + 256;

DI void prep_item(const Params& p, char* smem, int chunk, int head, int dry, bool load_cw) {
    const int tid = fresh_tid(), lane = tid & 63, wave = tid >> 6, r32 = lane & 31, h = lane >> 5;
    unsigned char* ws = p.ws;
    float* gcl = (float*)(smem + P2_GC); float* betl = (float*)(smem + P2_BET); float* egl = (float*)(smem + P2_EG); float* ekdl = (float*)(smem + P2_EKD);
    if (load_cw) {
        float* cwl = (float*)(smem + P2_CW);
        for (int i = tid; i < 4 * 3 * 128; i += NT) { const int jj = i / 384, rem = i % 384, mat = rem >> 7, c = rem & 127; cwl[i] = p.in[9][(size_t)jj * 3072 + mat * 1024 + head * 128 + c]; }
    }
    const int r = tid >> 3, cg = tid & 7, col0 = head * 128 + 16 * cg;
    const bf16* tails = (const bf16*)(ws + OFF_SMALL + SM_TAILS);
        u32x4 raw[3][4][2];
#pragma unroll
    for (int mat = 0; mat < 3; ++mat) {
        const bf16* mainb = (const bf16*)(ws + (mat == 0 ? OFF_QN : (mat == 1 ? OFF_KN : OFF_V)));
        const bf16* c0b = (const bf16*)(ws + OFF_SMALL + (mat == 0 ? SM_C0Q : (mat == 1 ? SM_C0K : SM_C0V)));
#pragma unroll
        for (int jj = 0; jj < 4; ++jj) {
            const int rr = r - 3 + jj;
            const bf16* src = nullptr;
            if (chunk == 0) { if (rr >= 48) src = c0b + (size_t)rr * D + col0; }
            else if (rr >= 0) src = mainb + ((size_t)(chunk - 1) * 64 + rr) * D + col0;
            else src = tails + ((size_t)(chunk - 1) * 3 + (3 + rr)) * 3072 + mat * 1024 + col0;
            raw[mat][jj][0] = (u32x4){0u, 0u, 0u, 0u}; raw[mat][jj][1] = (u32x4){0u, 0u, 0u, 0u};
            if (src) { raw[mat][jj][0] = *(const u32x4*)src; raw[mat][jj][1] = *(const u32x4*)(src + 8); }
        }
    }
    if (wave == 0) {
        const size_t pos = (size_t)chunk * 64 + lane;
        float v = ((const float*)(ws + OFF_SMALL + SM_G))[pos * 8 + head];
        const float b = ((const float*)(ws + OFF_SMALL + SM_BETA))[pos * 8 + head];
#pragma unroll
        for (int o = 1; o < 64; o <<= 1) { const float t = __shfl_up(v, o); if (lane >= o) v += t; }
        const float gl = __shfl(v, 63);
        gcl[lane] = v; betl[lane] = b; egl[lane] = __expf(v); ekdl[lane] = __expf(gl - v);
        if (!dry) ((float*)(ws + OFF_SMALL + SM_GC))[((size_t)chunk * 8 + head) * 64 + lane] = v;
    }
    __syncthreads();
    {
        const bool zero_row = (chunk == 0 && r < 48);
        const float beta = betl[r], eg = egl[r], ekd = ekdl[r];
#pragma unroll
        for (int mat = 0; mat < 3; ++mat) {
            bf16* mainb = (bf16*)(ws + (mat == 0 ? OFF_QN : (mat == 1 ? OFF_KN : OFF_V)));
            bf16* c0b = (bf16*)(ws + OFF_SMALL + (mat == 0 ? SM_C0Q : (mat == 1 ? SM_C0K : SM_C0V)));
            float y[16];
#pragma unroll
            for (int c = 0; c < 16; ++c) y[c] = 0.f;
#pragma unroll
            for (int jj = 0; jj < 4; ++jj) {
                const u32x4 a = raw[mat][jj][0], b = raw[mat][jj][1];
                const float* cw = (const float*)(smem + P2_CW) + (jj * 3 + mat) * 128 + 16 * cg;
                const f32x4 w0 = *(const f32x4*)cw, w1 = *(const f32x4*)(cw + 4), w2 = *(const f32x4*)(cw + 8), w3 = *(const f32x4*)(cw + 12);
                y[0] += w0[0] * bflo(a.x); y[1] += w0[1] * bfhi(a.x); y[2] += w0[2] * bflo(a.y); y[3] += w0[3] * bfhi(a.y);
                y[4] += w1[0] * bflo(a.z); y[5] += w1[1] * bfhi(a.z); y[6] += w1[2] * bflo(a.w); y[7] += w1[3] * bfhi(a.w);
                y[8] += w2[0] * bflo(b.x); y[9] += w2[1] * bfhi(b.x); y[10] += w2[2] * bflo(b.y); y[11] += w2[3] * bfhi(b.y);
                y[12] += w3[0] * bflo(b.z); y[13] += w3[1] * bfhi(b.z); y[14] += w3[2] * bflo(b.w); y[15] += w3[3] * bfhi(b.w);
            }
            if (mat == 0) __syncthreads();
            float ss = 0.f;
#pragma unroll
            for (int c = 0; c < 16; ++c) { y[c] = zero_row ? 0.f : siluf_(y[c]); ss += y[c] * y[c]; }
            if (mat < 2) {
                ss += __shfl_xor(ss, 1); ss += __shfl_xor(ss, 2); ss += __shfl_xor(ss, 4);
                const float sc = rsqrtf(ss + 1e-6f) * (mat == 0 ? 0.08838834764831845f : 1.0f);
                unsigned pk[8];
#pragma unroll
                for (int c = 0; c < 8; ++c) pk[c] = pk2(y[2 * c] * sc, y[2 * c + 1] * sc);
                if (mat == 0) {
                    *(u32x4*)(smem + P2_QN + swzrow(r, 256, 2 * cg)) = (u32x4){pk[0], pk[1], pk[2], pk[3]};
                    *(u32x4*)(smem + P2_QN + swzrow(r, 256, 2 * cg + 1)) = (u32x4){pk[4], pk[5], pk[6], pk[7]};
                    unsigned qd[8];
#pragma unroll
                    for (int c = 0; c < 8; ++c) qd[c] = pk2(bflo(pk[c]) * eg, bfhi(pk[c]) * eg);
                    bf16* dst = (chunk == 0) ? c0b + (size_t)r * D + col0 : mainb + ((size_t)(chunk - 1) * 64 + r) * D + col0;
                    if (!dry) { *(u32x4*)dst = (u32x4){qd[0], qd[1], qd[2], qd[3]}; *(u32x4*)(dst + 8) = (u32x4){qd[4], qd[5], qd[6], qd[7]}; }
                } else {
                    *(u32x4*)(smem + P2_KN + swzrow(r, 256, 2 * cg)) = (u32x4){pk[0], pk[1], pk[2], pk[3]};
                    *(u32x4*)(smem + P2_KN + swzrow(r, 256, 2 * cg + 1)) = (u32x4){pk[4], pk[5], pk[6], pk[7]};
                    unsigned kb[8];
#pragma unroll
                    for (int c = 0; c < 8; ++c) {
                        const float kr0 = bflo(pk[c]), kr1 = bfhi(pk[c]);
                        const float k0 = kr0 * beta, k1 = kr1 * beta;
                        kb[c] = pk2(k0, k1);
                        const int d0 = 16 * cg + 2 * c;
                        *(bf16*)(smem + P2_KBGT + swz128t(d0, r >> 3) + (r & 7) * 2) = (bf16)f2bf(k0 * eg);
                        *(bf16*)(smem + P2_KBGT + swz128t(d0 + 1, r >> 3) + (r & 7) * 2) = (bf16)f2bf(k1 * eg);
                        *(bf16*)(smem + P2_KDT + swz128t(d0, r >> 3) + (r & 7) * 2) = (bf16)f2bf(kr0 * ekd);
                        *(bf16*)(smem + P2_KDT + swz128t(d0 + 1, r >> 3) + (r & 7) * 2) = (bf16)f2bf(kr1 * ekd);
                    }
                    *(u32x4*)(smem + P2_KB + swzrow(r, 256, 2 * cg)) = (u32x4){kb[0], kb[1], kb[2], kb[3]};
                    *(u32x4*)(smem + P2_KB + swzrow(r, 256, 2 * cg + 1)) = (u32x4){kb[4], kb[5], kb[6], kb[7]};
                }
            } else {
#pragma unroll
                for (int c = 0; c < 16; ++c) {
                    const int e = 16 * cg + c;
                    *(bf16*)(smem + P2_VBT + swz128t(e, r >> 3) + (r & 7) * 2) = (bf16)f2bf(y[c] * beta);
                }
            }
        }
    }
    __syncthreads();
    {
        const int tile = wave & 3, m0 = tile >> 1, n0 = tile & 1;
        f32x16 acc = zero16();
        if (wave < 4) {
            if (n0 <= m0) {
#pragma unroll
                for (int ks = 0; ks < 8; ++ks) {
                    const bf16x8 a = *(const bf16x8*)(smem + P2_KB + swzrow(32 * m0 + r32, 256, 2 * ks + h));
                    const bf16x8 b = *(const bf16x8*)(smem + P2_KN + swzrow(32 * n0 + r32, 256, 2 * ks + h));
                    acc = MFMA32(a, b, acc);
                }
            }
            float* Al = (float*)(smem + P2_ALDS);
            const int j = 32 * n0 + r32; const float gj = gcl[j];
#pragma unroll
            for (int r = 0; r < 16; ++r) {
                const int i = 32 * m0 + (r & 3) + 8 * (r >> 2) + 4 * h;
                const float dv = acc[r] * __expf(gcl[i] - gj);
                Al[i * 64 + (j & 3) * 16 + (j >> 2)] = (j < i) ? dv : 0.f;
            }
        } else {
            if (m0 <= n0) {
#pragma unroll
                for (int ks = 0; ks < 8; ++ks) {
                    const bf16x8 a = *(const bf16x8*)(smem + P2_KN + swzrow(32 * m0 + r32, 256, 2 * ks + h));
                    const bf16x8 b = *(const bf16x8*)(smem + P2_QN + swzrow(32 * n0 + r32, 256, 2 * ks + h));
                    acc = MFMA32(a, b, acc);
                }
            }
            const int i = 32 * n0 + r32; const float gi = gcl[i];
            bf16* qkb = (chunk == 0) ? (bf16*)(ws + OFF_SMALL + SM_C0QK) + (size_t)head * 4096 : (bf16*)(ws + OFF_QKB) + ((size_t)(chunk - 1) * 8 + head) * 4096;
#pragma unroll
            for (int q4 = 0; q4 < 4; ++q4) {
                const int j0 = 32 * m0 + 8 * q4 + 4 * h; float v[4];
#pragma unroll
                for (int c = 0; c < 4; ++c) { const int j = j0 + c; const float dv = acc[4 * q4 + c] * __expf(gi - gcl[j]); v[c] = (j <= i) ? dv : 0.f; }
                if (!dry) *(u32x2*)(qkb + i * 64 + j0) = (u32x2){pk2(v[0], v[1]), pk2(v[2], v[3])};
            }
        }
        bf16* kbase = (chunk == 0) ? (bf16*)(ws + OFF_SMALL + SM_C0K) : (bf16*)(ws + OFF_KN) + (size_t)(chunk - 1) * 64 * D;
#pragma unroll
        for (int i2 = 0; i2 < 2; ++i2) {
            const int idx = tid + NT * i2, dk = idx >> 3, ch = idx & 7;
            const u32x4 v = *(const u32x4*)(smem + P2_KDT + swz128t(dk, ch));
            if (!dry) *(u32x4*)(kbase + (size_t)(dk >> 1) * D + head * 128 + (dk & 1) * 64 + ch * 8) = v;
        }
    }
    __syncthreads();
    if (wave < 4) {
        const float* Al = (const float*)(smem + P2_ALDS);
        const int c = lane >> 2, q = lane & 3, C = 16 * wave + c;
        float tq[16];
#pragma unroll
        for (int m = 0; m < 16; ++m) tq[m] = 0.f;
#pragma unroll
        for (int P = 0; P < 4; ++P) {
            float pre[16];
#pragma unroll
            for (int ii = 0; ii < 16; ++ii) {
                const float* ar = Al + (16 * P + ii) * 64 + q * 16;
                float s0 = 0.f, s1 = 0.f;
#pragma unroll
                for (int m = 0; m < 4 * P; ++m) { if (m & 1) s1 += ar[m] * tq[m]; else s0 += ar[m] * tq[m]; }
                pre[ii] = s0 + s1;
            }
#pragma unroll
            for (int ii = 0; ii < 16; ++ii) {
                const int i = 16 * P + ii;
                const float* ar = Al + i * 64 + q * 16;
                const int nm = (i + 3) >> 2;
                float s = pre[ii];
#pragma unroll
                for (int m = 4 * P; m < 4 * P + 4; ++m) if (m < nm) s += ar[m] * tq[m];
                s += __shfl_xor(s, 1); s += __shfl_xor(s, 2);
                const float ti = ((i == C) ? 1.f : 0.f) - s;
                if (q == (i & 3)) tq[i >> 2] = ti;
            }
        }
#pragma unroll
        for (int m = 0; m < 16; ++m) { const int row = 4 * m + q; *(bf16*)(smem + P2_TLDS + swz128(row, C >> 3) + (C & 7) * 2) = (bf16)f2bf(tq[m]); }
    }
    __syncthreads();
    {
        const int mi = wave >> 2, ni = wave & 3;
        f32x16 acc = zero16();
#pragma unroll
        for (int ks = 0; ks < 4; ++ks) {
            const bf16x8 a = *(const bf16x8*)(smem + P2_TLDS + swz128(32 * mi + r32, 2 * ks + h));
            const bf16x8 b = *(const bf16x8*)(smem + P2_VBT + swz128t(32 * ni + r32, 2 * ks + h));
            acc = MFMA32(a, b, acc);
        }
        const int e = 32 * ni + r32;
        bf16* base = (chunk == 0) ? (bf16*)(ws + OFF_SMALL + SM_C0V) : (bf16*)(ws + OFF_V) + (size_t)(chunk - 1) * 64 * D;
        bf16* dst = base + (size_t)(e >> 1) * D + head * 128 + (e & 1) * 64;
#pragma unroll
        for (int q4 = 0; q4 < 4; ++q4) {
            const int c0 = 32 * mi + 8 * q4 + 4 * h;
            if (!dry) *(u32x2*)(dst + c0) = (u32x2){pk2(acc[4 * q4], acc[4 * q4 + 1]), pk2(acc[4 * q4 + 2], acc[4 * q4 + 3])};
        }
    }
    {
        const int mi = wave >> 1, ni = wave & 1;
        f32x16 acc = zero16();
#pragma unroll
        for (int ks = 0; ks < 4; ++ks) {
            const bf16x8 a = *(const bf16x8*)(smem + P2_KBGT + swz128t(32 * mi + r32, 2 * ks + h));
            const bf16x8 b = *(const bf16x8*)(smem + P2_TLDS + swz128(32 * ni + r32, 2 * ks + h));
            acc = MFMA32(a, b, acc);
        }
        const int c = 32 * ni + r32;
        bf16* wb = (chunk == 0) ? (bf16*)(ws + OFF_SMALL + SM_C0W) + (size_t)head * 8192 : (bf16*)(ws + OFF_W) + ((size_t)(chunk - 1) * 8 + head) * 8192;
#pragma unroll
        for (int q4 = 0; q4 < 4; ++q4) {
            const int dk0 = 32 * mi + 8 * q4 + 4 * h;
            if (!dry) *(u32x2*)(wb + c * 128 + dk0) = (u32x2){pk2(acc[4 * q4], acc[4 * q4 + 1]), pk2(acc[4 * q4 + 2], acc[4 * q4 + 3])};
        }
    }
    __syncthreads();
}

DI void phase2(const Params& p, char* smem, int bid, int nblk, int dry = 0) {
    { int cur_head = -1; for (int it = bid; it < NCH * 8; it += nblk) { const int hd = it & 7; prep_item(p, smem, it >> 3, hd, dry, hd != cur_head); cur_head = hd; } }
    {
        const int tid = fresh_tid(), lane = tid & 63, wave = tid >> 6;
        const int nextra = (NCH * 8) % nblk, skip = (nextra > 0 && 2 * nextra < nblk) ? nextra : 0;
        const int gw = (bid - skip) * 8 + wave, NGW = (nblk - skip) * 8;
        float mq = 0.f, mk = 0.f;
        auto sq16 = [](const u32x4& a, const u32x4& b) -> float {
            return bflo(a.x) * bflo(a.x) + bfhi(a.x) * bfhi(a.x) + bflo(a.y) * bflo(a.y) + bfhi(a.y) * bfhi(a.y) + bflo(a.z) * bflo(a.z) + bfhi(a.z) * bfhi(a.z) + bflo(a.w) * bflo(a.w) + bfhi(a.w) * bfhi(a.w)
                 + bflo(b.x) * bflo(b.x) + bfhi(b.x) * bfhi(b.x) + bflo(b.y) * bflo(b.y) + bfhi(b.y) * bfhi(b.y) + bflo(b.z) * bflo(b.z) + bfhi(b.z) * bfhi(b.z) + bflo(b.w) * bflo(b.w) + bfhi(b.w) * bfhi(b.w); };
        for (int j0 = (bid < skip ? SEQ + NMETA : gw); j0 < SEQ + NMETA; j0 += 4 * NGW) {
            u32x4 ka[4][2], qa[4][2];
#pragma unroll
            for (int u4 = 0; u4 < 4; ++u4) {
                const int j = j0 + u4 * NGW;
                ka[u4][0] = ka[u4][1] = qa[u4][0] = qa[u4][1] = (u32x4){0u, 0u, 0u, 0u};
                if (j < SEQ + NMETA) {
                    const bf16* kr = j < SEQ ? (const bf16*)p.out + (size_t)j * D + lane * 16 : (const bf16*)(p.ws + OFF_SMALL + SM_AKMETA) + (size_t)(j - SEQ) * D + lane * 16;
                    ka[u4][0] = *(const u32x4*)kr; ka[u4][1] = *(const u32x4*)(kr + 8);
                    if (j < SEQ) { const bf16* qr = (const bf16*)(p.ws + OFF_AQ) + (size_t)j * D + lane * 16; qa[u4][0] = *(const u32x4*)qr; qa[u4][1] = *(const u32x4*)(qr + 8); }
                }
            }
#pragma unroll
            for (int u4 = 0; u4 < 4; ++u4) {
                float s = sq16(ka[u4][0], ka[u4][1]), t = sq16(qa[u4][0], qa[u4][1]);
                s += __shfl_xor(s, 1); s += __shfl_xor(s, 2); t += __shfl_xor(t, 1); t += __shfl_xor(t, 2);
                mk = fmaxf(mk, s); mq = fmaxf(mq, t);
            }
        }
        float* red = (float*)smem;
        __syncthreads();
        if ((lane & 3) == 0) { red[wave * 32 + (lane >> 2)] = mq; red[wave * 32 + 16 + (lane >> 2)] = mk; }
        __syncthreads();
        if (tid < 32) {
            float m = 0.f;
#pragma unroll
            for (int w = 0; w < 8; ++w) m = fmaxf(m, red[w * 32 + tid]);
            unsigned* nrm = (unsigned*)(p.ws + OFF_SMALL + SM_CTL) + CW_NRM;
            atomicMax(nrm + tid, __builtin_bit_cast(unsigned, m));
        }
        __syncthreads();
    }
}

DI int swzrow8(int row, int pitch, int s) { return row * pitch + ((((s >> 1) ^ (row & 15)) << 4) | ((s & 1) << 3)); }
DI bf16x8 pack8(f32x4 a, f32x4 b) {
    u32x4 o; o.x = pk2(a[0], a[1]); o.y = pk2(a[2], a[3]); o.z = pk2(b[0], b[1]); o.w = pk2(b[2], b[3]);
    return __builtin_bit_cast(bf16x8, o);
}
DI bf16x8 ld2x8(const char* p0, const char* p1) {
    const u32x2 a = *(const u32x2*)p0, b = *(const u32x2*)p1; u32x4 o; o.x = a.x; o.y = a.y; o.z = b.x; o.w = b.y;
    return __builtin_bit_cast(bf16x8, o);
}
constexpr int SC_W = 0, SC_QD = 16384, SC_KDT = 32768, SC_QK = 49152, SC_BUF = 57344;

constexpr int SCAN_SPLIT = 2;
DI void scan_head(const Params& p, char* smem, int head, int sidx, int dry) {
    const int tid = fresh_tid(), lane = tid & 63, wave = tid >> 6, r16 = lane & 15, g = lane >> 4;
    const bool active = wave < 8 / SCAN_SPLIT; const int slice = sidx * (8 / SCAN_SPLIT) + (active ? wave : 0);
    unsigned char* ws = p.ws;
    const int lrow = tid >> 3, lch = (tid & 7) * 2;
    f32x4 S[8];
#pragma unroll
    for (int i = 0; i < 8; ++i) S[i] = zero4();
    u32x4 rw[2], rq[2], rk[2], rqk; u32x2 unext[4], ucur[4]; float gnext = 0.f, gcur = 0.f;
    auto uaddr = [&](int n, int mt) -> bf16* {
        const int e = 16 * slice + r16;
        bf16* base = n == 0 ? (bf16*)(ws + OFF_SMALL + SM_C0V) : (bf16*)(ws + OFF_V) + (size_t)(n - 1) * 64 * D;
        return base + (size_t)(e >> 1) * D + head * 128 + (e & 1) * 64 + 16 * mt + 4 * g;
    };
    auto gloadA = [&](int n) {
        const bf16* wsrc = (n == 0 ? (const bf16*)(ws + OFF_SMALL + SM_C0W) + (size_t)head * 8192 : (const bf16*)(ws + OFF_W) + ((size_t)(n - 1) * 8 + head) * 8192) + lrow * 128 + lch * 8;
        rw[0] = *(const u32x4*)wsrc; rw[1] = *(const u32x4*)(wsrc + 8);
        const bf16* qs = (n == 0 ? (const bf16*)(ws + OFF_SMALL + SM_C0Q) : (const bf16*)(ws + OFF_QN) + (size_t)(n - 1) * 64 * D) + (size_t)lrow * D + head * 128 + lch * 8;
        rq[0] = *(const u32x4*)qs; rq[1] = *(const u32x4*)(qs + 8);
        const bf16* ks = (n == 0 ? (const bf16*)(ws + OFF_SMALL + SM_C0K) : (const bf16*)(ws + OFF_KN) + (size_t)(n - 1) * 64 * D) + (size_t)lrow * D + head * 128 + lch * 8;
        rk[0] = *(const u32x4*)ks; rk[1] = *(const u32x4*)(ks + 8);
        const bf16* qk = (n == 0 ? (const bf16*)(ws + OFF_SMALL + SM_C0QK) + (size_t)head * 4096 : (const bf16*)(ws + OFF_QKB) + ((size_t)(n - 1) * 8 + head) * 4096) + tid * 8;
        rqk = *(const u32x4*)qk;
    };
    auto gloadU = [&](int n) {
#pragma unroll
        for (int mt = 0; mt < 4; ++mt) unext[mt] = *(const u32x2*)uaddr(n, mt);
        gnext = ((const float*)(ws + OFF_SMALL + SM_GC))[((size_t)n * 8 + head) * 64 + 63];
    };
    auto lwrite = [&](int buf) {
        char* b = smem + buf * SC_BUF;
        const int c7 = tid & 7, kb = c7 >> 1, hf = c7 & 1;
        {
            char* w = b + SC_W + lrow * 256 + hf * 8; char* q = b + SC_QD + lrow * 256 + hf * 8; const int x = lrow & 15;
            *(u32x2*)(w + (((4 * kb + 0) ^ x) << 4)) = (u32x2){rw[0].x, rw[0].y}; *(u32x2*)(w + (((4 * kb + 1) ^ x) << 4)) = (u32x2){rw[0].z, rw[0].w};
            *(u32x2*)(w + (((4 * kb + 2) ^ x) << 4)) = (u32x2){rw[1].x, rw[1].y}; *(u32x2*)(w + (((4 * kb + 3) ^ x) << 4)) = (u32x2){rw[1].z, rw[1].w};
            *(u32x2*)(q + (((4 * kb + 0) ^ x) << 4)) = (u32x2){rq[0].x, rq[0].y}; *(u32x2*)(q + (((4 * kb + 1) ^ x) << 4)) = (u32x2){rq[0].z, rq[0].w};
            *(u32x2*)(q + (((4 * kb + 2) ^ x) << 4)) = (u32x2){rq[1].x, rq[1].y}; *(u32x2*)(q + (((4 * kb + 3) ^ x) << 4)) = (u32x2){rq[1].z, rq[1].w};
        }
        {
            const int dk = 2 * lrow + (c7 >> 2), kb2 = (c7 & 3) >> 1, x = (dk >> 1) & 7;
            char* kt = b + SC_KDT + dk * 128 + hf * 8;
            *(u32x2*)(kt + (((4 * kb2 + 0) ^ x) << 4)) = (u32x2){rk[0].x, rk[0].y}; *(u32x2*)(kt + (((4 * kb2 + 1) ^ x) << 4)) = (u32x2){rk[0].z, rk[0].w};
            *(u32x2*)(kt + (((4 * kb2 + 2) ^ x) << 4)) = (u32x2){rk[1].x, rk[1].y}; *(u32x2*)(kt + (((4 * kb2 + 3) ^ x) << 4)) = (u32x2){rk[1].z, rk[1].w};
        }
        {
            const int row = tid >> 3, kb2 = c7 >> 2, g0 = 2 * (c7 & 1), hf2 = (c7 >> 1) & 1, x = (row >> 1) & 7;
            char* qk = b + SC_QK + row * 128 + hf2 * 8;
            *(u32x2*)(qk + (((4 * kb2 + g0) ^ x) << 4)) = (u32x2){rqk.x, rqk.y}; *(u32x2*)(qk + (((4 * kb2 + g0 + 1) ^ x) << 4)) = (u32x2){rqk.z, rqk.w};
        }
    };
    gloadA(0); gloadU(0);
    lwrite(0);
#pragma unroll
    for (int mt = 0; mt < 4; ++mt) ucur[mt] = unext[mt];
    gcur = gnext;
    if (NCH > 1) gloadA(1);
    __syncthreads();
    for (int n = 0; n < NCH; ++n) {
        const char* b = smem + (n & 1) * SC_BUF;
        if (n + 1 < NCH) { lwrite((n + 1) & 1); gloadU(n + 1); }
        if (n + 2 < NCH) gloadA(n + 2);
        if (active) {
        const float gtot = __expf(gcur);
        bf16x8 sf[4];
#pragma unroll
        for (int kb = 0; kb < 4; ++kb) sf[kb] = pack8(S[2 * kb], S[2 * kb + 1]);
        f32x4 Vn[4], O[4];
#pragma unroll
        for (int mt = 0; mt < 4; ++mt) {
            f32x4 P = zero4(), Q = zero4();
            const int row = 16 * mt + r16;
#pragma unroll
            for (int kb = 0; kb < 4; ++kb) {
                const bf16x8 wf = *(const bf16x8*)(b + SC_W + swzrow(row, 256, 4 * kb + g));
                const bf16x8 qf = *(const bf16x8*)(b + SC_QD + swzrow(row, 256, 4 * kb + g));
                P = MFMA16(wf, sf[kb], P);
                Q = MFMA16(qf, sf[kb], Q);
            }
            const float u0 = bflo(ucur[mt].x), u1 = bfhi(ucur[mt].x), u2 = bflo(ucur[mt].y), u3 = bfhi(ucur[mt].y);
            Vn[mt] = (f32x4){u0 - P[0], u1 - P[1], u2 - P[2], u3 - P[3]};
            O[mt] = Q;
        }
        const bf16x8 vf[2] = {pack8(Vn[0], Vn[1]), pack8(Vn[2], Vn[3])};
#pragma unroll
        for (int mt = 0; mt < 8; ++mt) {
            const int row = 16 * mt + r16;
            f32x4 acc = S[mt] * gtot;
#pragma unroll
            for (int kb = 0; kb < 2; ++kb) {
                const bf16x8 kf = *(const bf16x8*)(b + SC_KDT + swz128(row, 4 * kb + g));
                acc = MFMA16(kf, vf[kb], acc);
            }
            S[mt] = acc;
        }
#pragma unroll
        for (int mt = 0; mt < 4; ++mt) {
            const int row = 16 * mt + r16;
#pragma unroll
            for (int kb = 0; kb < 2; ++kb) {
                const bf16x8 qk = *(const bf16x8*)(b + SC_QK + swz128(row, 4 * kb + g));
                O[mt] = MFMA16(qk, vf[kb], O[mt]);
            }
            if (n >= 1 && !dry) *(u32x2*)uaddr(n, mt) = (u32x2){pk2(O[mt][0], O[mt][1]), pk2(O[mt][2], O[mt][3])};
        }
        }
#pragma unroll
        for (int mt = 0; mt < 4; ++mt) ucur[mt] = unext[mt];
        gcur = gnext;
        __syncthreads();
    }
}

constexpr int AT_BUF = 32768, AT_MISC = 65536, NQB = SEQ / 128, AT_UNITS = 8 * NQB;
DI int vt_off8(int e, int s) { return e * 128 + ((s ^ ((e >> 1) & 15)) << 3); }

DI void attention_unit(const Params& p, char* smem, int head, int qb, float lam, int dry, float bound) {
    const int tid = fresh_tid(), lane = tid & 63, wave = tid >> 6, r32 = lane & 31, h = lane >> 5;
    const int wq = wave & 3, mp = wave >> 2;
    unsigned char* ws = p.ws;
    const bf16* AK = (const bf16*)p.out; const bf16* AVT = (const bf16*)p.out + (size_t)SEQ * D;
    const int q0 = 128 * qb, qpos = q0 + 32 * wq + r32;
    const float c1 = 0.125f * LOG2E, c2 = exp2f(-(float)(head + 1)) * LOG2E;
    bf16x8 Qf[4];
    {
        const bf16* qsrc = (const bf16*)(ws + OFF_AQ) + (size_t)qpos * D + head * 128 + mp * 64 + 8 * h;
#pragma unroll
        for (int ks = 0; ks < 4; ++ks) {
            const u32x4 v = *(const u32x4*)(qsrc + 16 * ks); u32x4 o;
            o.x = pk2(bflo(v.x) * c1, bfhi(v.x) * c1); o.y = pk2(bflo(v.y) * c1, bfhi(v.y) * c1); o.z = pk2(bflo(v.z) * c1, bfhi(v.z) * c1); o.w = pk2(bflo(v.w) * c1, bfhi(v.w) * c1);
            Qf[ks] = __builtin_bit_cast(bf16x8, o);
        }
    }
    f32x16 O[4];
#pragma unroll
    for (int i = 0; i < 4; ++i) O[i] = zero16();
    float l_run = 0.f; const float mfix = fminf(bound, 40.0f);
    const float wdist = (150.0f + 2.0f * bound) / c2;
    int ntiles = 2 * qb + 3;
    {
        const float lim = (float)q0 - 63.0f - wdist;
        int ktmin = 0;
        if (lim > 0.f) ktmin = (int)(lim * (1.0f / 64.0f));
        const bool keep_meta = !((float)(q0 + NMETA - 15) > wdist);
        if (ktmin > 0 || !keep_meta) ntiles = (2 * qb + 1 - ktmin + 1) + (keep_meta ? 1 : 0);
    }
    const int nreal = (ntiles == 2 * qb + 3) ? 2 * qb + 2 : ntiles;
    const int kkey = tid >> 3, kcc = (tid & 7) * 2;
    const int va = tid >> 5, vb4 = tid & 31;
    u32x4 rk[2]; u32x2 rv[4];
    auto tile_kt = [&](int it) -> int { return it < nreal ? 2 * qb + 1 - it : -1; };
    auto gload = [&](int it) {
        const int kt = tile_kt(it);
        if (kt >= 0) {
            const bf16* ks = AK + ((size_t)kt * 64 + kkey) * D + head * 128 + kcc * 8;
            rk[0] = *(const u32x4*)ks; rk[1] = *(const u32x4*)(ks + 8);
            const bf16* vs = AVT + ((size_t)kt * 64 + 4 * va) * D + head * 128 + 4 * vb4;
#pragma unroll
            for (int i = 0; i < 4; ++i) rv[i] = *(const u32x2*)(vs + (size_t)i * D);
        } else {
            rk[0] = rk[1] = (u32x4){0u, 0u, 0u, 0u};
#pragma unroll
            for (int i = 0; i < 4; ++i) rv[i] = (u32x2){0u, 0u};
            if (kkey < NMETA) { const bf16* ks = (const bf16*)(ws + OFF_SMALL + SM_AKMETA) + (size_t)kkey * D + head * 128 + kcc * 8; rk[0] = *(const u32x4*)ks; rk[1] = *(const u32x4*)(ks + 8); }
            if (va < NMETA / 4) { const bf16* vs = (const bf16*)(ws + OFF_SMALL + SM_AVTMETA) + (size_t)(4 * va) * D + head * 128 + 4 * vb4;
#pragma unroll
                for (int i = 0; i < 4; ++i) rv[i] = *(const u32x2*)(vs + (size_t)i * D); }
        }
    };
    auto lwrite = [&](int buf) {
        char* kb = smem + buf * AT_BUF + (kcc >> 3) * 8192;
        *(u32x4*)(kb + swz128(kkey, kcc & 7)) = rk[0]; *(u32x4*)(kb + swz128(kkey, (kcc & 7) + 1)) = rk[1];
        const unsigned t0x = (rv[0].x & 0xffffu) | (rv[1].x << 16), t1x = (rv[0].x >> 16) | (rv[1].x & 0xffff0000u), t0y = (rv[2].x & 0xffffu) | (rv[3].x << 16), t1y = (rv[2].x >> 16) | (rv[3].x & 0xffff0000u);
        const unsigned t2x = (rv[0].y & 0xffffu) | (rv[1].y << 16), t3x = (rv[0].y >> 16) | (rv[1].y & 0xffff0000u), t2y = (rv[2].y & 0xffffu) | (rv[3].y << 16), t3y = (rv[2].y >> 16) | (rv[3].y & 0xffff0000u);
        const int sub = va >> 3, a = va & 7, a2 = (a & 4) | ((a & 1) << 1) | ((a >> 1) & 1);
        char* vbase = smem + buf * AT_BUF + 16384 + (a2 & 1) * 8;
        const int s16 = 4 * sub + (a2 >> 1), e0 = 4 * vb4;
        *(u32x2*)(vbase + (e0 + 0) * 128 + ((s16 ^ (((e0 + 0) >> 1) & 7)) << 4)) = (u32x2){t0x, t0y};
        *(u32x2*)(vbase + (e0 + 1) * 128 + ((s16 ^ (((e0 + 1) >> 1) & 7)) << 4)) = (u32x2){t1x, t1y};
        *(u32x2*)(vbase + (e0 + 2) * 128 + ((s16 ^ (((e0 + 2) >> 1) & 7)) << 4)) = (u32x2){t2x, t2y};
        *(u32x2*)(vbase + (e0 + 3) * 128 + ((s16 ^ (((e0 + 3) >> 1) & 7)) << 4)) = (u32x2){t3x, t3y};
    };
    auto tile_body = [&](auto mode_tag, int buf, int kdist0, int klim) {
        constexpr bool MASKED = decltype(mode_tag)::value;
        const char* kb = smem + buf * AT_BUF + mp * 8192;
        const char* vb = smem + buf * AT_BUF + 16384;
        f32x16 s[2];
#pragma unroll
        for (int sub = 0; sub < 2; ++sub) {
            f32x16 acc;
            const float base = -c2 * (float)(kdist0 - 32 * sub - 4 * h) - mfix;
#pragma unroll
            for (int r = 0; r < 16; ++r) acc[r] = base + c2 * (float)((r & 3) + 8 * (r >> 2));
#pragma unroll
            for (int ks = 0; ks < 4; ++ks) {
                const bf16x8 a = *(const bf16x8*)(kb + swz128(32 * sub + r32, 2 * ks + h));
                acc = MFMA32(a, Qf[ks], acc);
            }
            if (MASKED) {
#pragma unroll
                for (int r = 0; r < 16; ++r) { const int key = 32 * sub + (r & 3) + 8 * (r >> 2) + 4 * h; if (key > klim) acc[r] = -1e30f; }
            }
            s[sub] = acc;
        }
        float ls = 0.f;
#pragma unroll
        for (int sub = 0; sub < 2; ++sub) {
#pragma unroll
            for (int r = 0; r < 16; ++r) { const float pv = EXP2F(s[sub][r]); s[sub][r] = pv; ls += pv; }
            bf16x8 Pf[2];
#pragma unroll
            for (int ss = 0; ss < 2; ++ss) {
                u32x4 o; o.x = pk2(s[sub][8 * ss], s[sub][8 * ss + 1]); o.y = pk2(s[sub][8 * ss + 2], s[sub][8 * ss + 3]);
                o.z = pk2(s[sub][8 * ss + 4], s[sub][8 * ss + 5]); o.w = pk2(s[sub][8 * ss + 6], s[sub][8 * ss + 7]);
                Pf[ss] = __builtin_bit_cast(bf16x8, o);
            }
            SETPRIO(1);
#pragma unroll
            for (int et = 0; et < 4; ++et) {
                const int e = 32 * et + r32;
#pragma unroll
                for (int ss = 0; ss < 2; ++ss) {
                    const bf16x8 a = *(const bf16x8*)(vb + swz128(e, 4 * sub + 2 * ss + h));
                    O[et] = MFMA32(a, Pf[ss], O[et]);
                }
            }
            SETPRIO(0);
            SCHED_FENCE();
        }
        l_run += ls;
    };
    gload(0); lwrite(0); __syncthreads();
    for (int it = 0; it < ntiles; ++it) {
        const int buf = it & 1, kt = tile_kt(it);
        if (it + 1 < ntiles) gload(it + 1);
        const int k0 = kt * 64;
        if (kt >= 0 && k0 > q0 + 32 * wq + 31) {   }
        else if (kt >= 0 && k0 + 63 <= q0 + 32 * wq) tile_body(std::false_type{}, buf, qpos - k0, 0);
        else tile_body(std::true_type{}, buf, kt < 0 ? NMETA + qpos : qpos - k0, kt < 0 ? NMETA - 1 : qpos - k0);
        if (it + 1 < ntiles) lwrite(buf ^ 1);
        __syncthreads();
    }
    {
        const int tid = fresh_tid(), lane = tid & 63, wave = tid >> 6, r32 = lane & 31, h = lane >> 5, wq = wave & 3, mp = wave >> 2;
        const int qpos = 128 * qb + 32 * wq + r32;
        const float lt = l_run + xhalf(l_run);
        const float inv = 1.0f / lt;
        float* X = (float*)smem;
        if (mp == 1) {
#pragma unroll
            for (int et = 0; et < 4; ++et)
#pragma unroll
                for (int r = 0; r < 16; ++r) { const int e = 32 * et + (r & 3) + 8 * (r >> 2) + 4 * h; X[(wq * 128 + e) * 32 + r32] = O[et][r] * inv; }
        }
        __syncthreads();
        if (mp == 0) {
            float ssq = 0.f;
#pragma unroll
            for (int et = 0; et < 4; ++et)
#pragma unroll
                for (int r = 0; r < 16; ++r) { const int e = 32 * et + (r & 3) + 8 * (r >> 2) + 4 * h; const float d = O[et][r] * inv - lam * X[(wq * 128 + e) * 32 + r32]; O[et][r] = d; ssq += d * d; }
            ssq += xhalf(ssq);
            const float rstd = rsqrtf(ssq * (1.0f / 128.0f) + NORM_EPS) * 0.8f;
            bf16* dst = (bf16*)(ws + OFF_AQ) + (size_t)qpos * D + head * 128;
            const float* sw = p.in[8];
#pragma unroll
            for (int et = 0; et < 4; ++et)
#pragma unroll
                for (int q4 = 0; q4 < 4; ++q4) {
                    const int e0 = 32 * et + 8 * q4 + 4 * h;
                    const f32x4 w4 = *(const f32x4*)(sw + e0);
                    if (!dry) *(u32x2*)(dst + e0) = (u32x2){pk2(O[et][4 * q4] * rstd * w4[0], O[et][4 * q4 + 1] * rstd * w4[1]), pk2(O[et][4 * q4 + 2] * rstd * w4[2], O[et][4 * q4 + 3] * rstd * w4[3])};
                }
        }
        __syncthreads();
    }
}

DI void phase3(const Params& p, char* smem, int bid, int nblk, int dry = 0, int mode = 3) {
    if (mode & 1) for (int it = bid; it < 8 * SCAN_SPLIT; it += nblk) scan_head(p, smem, it / SCAN_SPLIT, it % SCAN_SPLIT, dry);
    if (!(mode & 2)) return;
    float d1 = 0.f, d2 = 0.f;
    for (int i = 0; i < 64; ++i) { d1 += p.in[4][i] * p.in[5][i]; d2 += p.in[6][i] * p.in[7][i]; }
    const float lam = __expf(d1) - __expf(d2) + 0.2f;
    unsigned* q = (unsigned*)(p.ws + OFF_SMALL + SM_CTL) + CW_ATTQ + (dry ? 16 : 0);
    for (;;) {
        if (threadIdx.x == 0) *(unsigned*)(smem + AT_MISC) = atomicAdd(q, 1u);
        __syncthreads();
        const unsigned u = *(unsigned*)(smem + AT_MISC);
        __syncthreads();
        if (u >= (unsigned)AT_UNITS) break;
        const int hd = (int)(u & 7u);
        const unsigned* nrm = (const unsigned*)(p.ws + OFF_SMALL + SM_CTL) + CW_NRM;
        float bnd = 0.f;
        for (int m2 = 0; m2 < 2; ++m2) {
            const float q2 = __builtin_bit_cast(float, LD_ATOMIC(nrm + 2 * hd + m2)), k2 = __builtin_bit_cast(float, LD_ATOMIC(nrm + 16 + 2 * hd + m2));
            bnd = fmaxf(bnd, sqrtf(q2 * k2) * (0.125f * LOG2E) * 1.02f);
        }
        attention_unit(p, smem, hd, NQB - 1 - (int)(u >> 3), lam, dry, bnd);
    }
}

DI void phase4(const Params& p, char* smem, int bid, int nblk) {
    const int tid = fresh_tid(), lane = tid & 63, wave = tid >> 6;
    const int gw = bid * 8 + wave, NGW = nblk * 8;
    unsigned char* ws = p.ws;
    char* wl = smem + wave * 16384;
    for (int it = gw; it < 32 * 384; it += NGW) {
        const int e = it / 384, r = it % 384, m = r >> 7, q = r & 127;
        if (m < 2) transpose_item(p.in[21 + m] + (size_t)e * 1024 * 256, 256, 1024, (bf16*)(ws + OFF_EXG) + (size_t)e * 512 * 1024, (q >> 3) * 64, (q & 7) * 32, (q & 7) * 32, (float*)wl, lane, m + 1);
        else transpose_item(p.in[23] + (size_t)e * 256 * 1024, 1024, 256, (bf16*)(ws + OFF_EXD) + (size_t)e * 1024 * 256, (q >> 5) * 64, (q & 31) * 32, (q & 31) * 32, (float*)wl, lane);
    }
    for (int R = gw; R < SEQ; R += NGW) {
        const float* xrow = p.in[0] + (size_t)R * D; bf16* urow = (bf16*)(ws + OFF_U) + (size_t)R * D;
        float4 v[4]; float ss = 0.f;
#pragma unroll
        for (int j = 0; j < 4; ++j) { v[j] = *(const float4*)(xrow + 4 * lane + 256 * j); ss += v[j].x * v[j].x + v[j].y * v[j].y + v[j].z * v[j].z + v[j].w * v[j].w; }
        ss = wave_sum(ss);
        const float rstd = rsqrtf(ss * (1.0f / D) + NORM_EPS);
#pragma unroll
        for (int j = 0; j < 4; ++j) {
            const float4 w4 = *(const float4*)(p.in[2] + 4 * lane + 256 * j);
            *(u32x2*)(urow + 4 * lane + 256 * j) = (u32x2){pk2(v[j].x * rstd * w4.x, v[j].y * rstd * w4.y), pk2(v[j].z * rstd * w4.z, v[j].w * rstd * w4.w)};
        }
    }
    for (int it = gw; it < (NCH - 1) * 8; it += NGW) {
        const int cm1 = it >> 3, head = it & 7;
        const bf16* reg = (const bf16*)(ws + OFF_V) + (size_t)cm1 * 64 * D + head * 128;
#pragma unroll 4
        for (int i = 0; i < 16; ++i) { const int row = i * 4 + (lane >> 4), ch = lane & 15; *(u32x4*)(wl + row * 256 + ch * 16) = *(const u32x4*)(reg + (size_t)row * D + ch * 8); }
        WAVE_SYNC();
        float ss = 0.f;
#pragma unroll 8
        for (int dv = 0; dv < 128; ++dv) { const float v = bf2f(*(const bf16*)(wl + (dv >> 1) * 256 + ((dv & 1) * 64 + lane) * 2)); ss += v * v; }
        const float rstd = rsqrtf(ss * (1.0f / 128.0f) + NORM_EPS);
        const size_t j = (size_t)cm1 * 64 + lane;
        const bf16* gsrc = (const bf16*)(ws + OFF_DG) + j * D + head * 128;
        bf16* dst = (bf16*)(ws + OFF_OD) + j * D + head * 128;
#pragma unroll 2
        for (int d8 = 0; d8 < 16; ++d8) {
            const u32x4 gv = *(const u32x4*)(gsrc + 8 * d8);
            const f32x4 w0 = *(const f32x4*)(p.in[12] + 8 * d8), w1 = *(const f32x4*)(p.in[12] + 8 * d8 + 4);
            float o[8];
#pragma unroll
            for (int c = 0; c < 8; ++c) { const int dv = 8 * d8 + c; o[c] = bf2f(*(const bf16*)(wl + (dv >> 1) * 256 + ((dv & 1) * 64 + lane) * 2)) * rstd; }
            o[0] *= w0[0] * siluf_(bflo(gv.x)); o[1] *= w0[1] * siluf_(bfhi(gv.x)); o[2] *= w0[2] * siluf_(bflo(gv.y)); o[3] *= w0[3] * siluf_(bfhi(gv.y));
            o[4] *= w1[0] * siluf_(bflo(gv.z)); o[5] *= w1[1] * siluf_(bfhi(gv.z)); o[6] *= w1[2] * siluf_(bflo(gv.w)); o[7] *= w1[3] * siluf_(bfhi(gv.w));
            *(u32x4*)(dst + 8 * d8) = (u32x4){pk2(o[0], o[1]), pk2(o[2], o[3]), pk2(o[4], o[5]), pk2(o[6], o[7])};
        }
        WAVE_SYNC();
    }
}

template <int NB, int NI>
DI void rowgemm64(const bf16* arow, const bf16* const (&bptr)[NB], char* stg, f32x16 (&acc)[NB][2][NI]) {
    const int tid = fresh_tid(), lane = tid & 63, r32 = lane & 31, h = lane >> 5;
    const int lrow = tid >> 3, lc = tid & 7;
    u32x4 ra = arow ? *(const u32x4*)arow : (u32x4){0u, 0u, 0u, 0u};
    bf16x8 bqA[4][NB][NI], bqB[4][NB][NI];
    auto bload = [&](bf16x8 (&dst)[4][NB][NI], int kc) {
#pragma unroll
        for (int ks = 0; ks < 4; ++ks)
#pragma unroll
            for (int b = 0; b < NB; ++b)
#pragma unroll
                for (int ni = 0; ni < NI; ++ni) dst[ks][b][ni] = *(const bf16x8*)(bptr[b] + (size_t)ni * 32 * 1024 + kc * 64 + ks * 16);
    };
    auto mma = [&](const bf16x8 (&bq)[4][NB][NI], int buf) {
#pragma unroll
        for (int ks = 0; ks < 4; ++ks) {
            bf16x8 af[2];
#pragma unroll
            for (int mi = 0; mi < 2; ++mi) af[mi] = *(const bf16x8*)(stg + buf * 8192 + swz128(32 * mi + r32, 2 * ks + h));
#pragma unroll
            for (int b = 0; b < NB; ++b)
#pragma unroll
                for (int ni = 0; ni < NI; ++ni)
#pragma unroll
                    for (int mi = 0; mi < 2; ++mi) acc[b][mi][ni] = MFMA32(af[mi], bq[ks][b][ni], acc[b][mi][ni]);
        }
    };
    bload(bqA, 0);
    *(u32x4*)(stg + swz128(lrow, lc)) = ra;
    __syncthreads();
    for (int kc = 0; kc < 16; kc += 2) {
        ra = arow ? *(const u32x4*)(arow + (kc + 1) * 64) : (u32x4){0u, 0u, 0u, 0u};
        bload(bqB, kc + 1);
        mma(bqA, 0);
        *(u32x4*)(stg + 8192 + swz128(lrow, lc)) = ra;
        __syncthreads();
        if (kc + 2 < 16) { ra = arow ? *(const u32x4*)(arow + (kc + 2) * 64) : (u32x4){0u, 0u, 0u, 0u}; bload(bqA, kc + 2); }
        mma(bqB, 1);
        if (kc + 2 < 16) *(u32x4*)(stg + swz128(lrow, lc)) = ra;
        __syncthreads();
    }
}

constexpr size_t OFF_MIX = OFF_V;
struct EpiSig {
    static constexpr bool PERM = true;
    bf16* sg;
    DM void operator()(const f32x4 (&acc)[2][2][4][2], const pg8::Unit& u, int wr, int wc, int fr, int fq) const {
        const int row0 = u.pm * 256 + wr * 64 + fr, col0 = u.pn * 256 + wc * 32 + 8 * fq;
#pragma unroll
        for (int ai = 0; ai < 2; ++ai)
#pragma unroll
            for (int m = 0; m < 4; ++m) {
                bf16* rowp = sg + (size_t)(row0 + ai * 128 + m * 16) * 2048 + col0;
#pragma unroll
                for (int bj = 0; bj < 2; ++bj) {
                    const f32x4 v0 = acc[ai][bj][m][0], v1 = acc[ai][bj][m][1];
                    *(u32x4*)(rowp + bj * 128) = (u32x4){pk2(sigmoidf_(v0[0]), sigmoidf_(v0[1])), pk2(sigmoidf_(v0[2]), sigmoidf_(v0[3])), pk2(sigmoidf_(v1[0]), sigmoidf_(v1[1])), pk2(sigmoidf_(v1[2]), sigmoidf_(v1[3]))};
                }
            }
    }
};
template <bool ADD> struct EpiGate {
    static constexpr bool PERM = true;
    const bf16* sg; bf16* mix; int goff;
    DM void operator()(const f32x4 (&acc)[2][2][4][2], const pg8::Unit& u, int wr, int wc, int fr, int fq) const {
        const int row0 = u.pm * 256 + wr * 64 + fr, col0 = u.pn * 256 + wc * 32 + 8 * fq;
#pragma unroll
        for (int ai = 0; ai < 2; ++ai)
#pragma unroll
            for (int m = 0; m < 4; ++m) {
                const size_t j = (size_t)(row0 + ai * 128 + m * 16);
#pragma unroll
                for (int bj = 0; bj < 2; ++bj) {
                    const u32x4 g = *(const u32x4*)(sg + j * 2048 + goff + col0 + bj * 128);
                    const f32x4 v0 = acc[ai][bj][m][0], v1 = acc[ai][bj][m][1];
                    float o[8] = {bflo(g.x) * v0[0], bfhi(g.x) * v0[1], bflo(g.y) * v0[2], bfhi(g.y) * v0[3], bflo(g.z) * v1[0], bfhi(g.z) * v1[1], bflo(g.w) * v1[2], bfhi(g.w) * v1[3]};
                    bf16* dst = mix + j * D + col0 + bj * 128;
                    if (ADD) { const u32x4 q = *(const u32x4*)dst; o[0] += bflo(q.x); o[1] += bfhi(q.x); o[2] += bflo(q.y); o[3] += bfhi(q.y); o[4] += bflo(q.z); o[5] += bfhi(q.z); o[6] += bflo(q.w); o[7] += bfhi(q.w); }
                    *(u32x4*)dst = (u32x4){pk2(o[0], o[1]), pk2(o[2], o[3]), pk2(o[4], o[5]), pk2(o[6], o[7])};
                }
            }
    }
};
struct EpiRes {
    static constexpr bool PERM = false;
    const float* x; float* hout;
    DM void operator()(const f32x4 (&acc)[2][2][4][2], const pg8::Unit& u, int wr, int wc, int fr, int fq) const {
        const int row0 = u.pm * 256 + wr * 64 + fr, col0 = u.pn * 256 + wc * 32 + 4 * fq;
#pragma unroll
        for (int ai = 0; ai < 2; ++ai)
#pragma unroll
            for (int m = 0; m < 4; ++m) {
                const size_t off = (size_t)(row0 + ai * 128 + m * 16) * D + col0;
#pragma unroll
                for (int bj = 0; bj < 2; ++bj)
#pragma unroll
                    for (int n = 0; n < 2; ++n) *(f32x4*)(hout + off + bj * 128 + n * 16) = *(const f32x4*)(x + off + bj * 128 + n * 16) + acc[ai][bj][m][n];
            }
    }
};
DI void phase5a(const Params& p, char* smem, int bid, int nblk) {
    pg8::Gemm g{(const bf16*)(p.ws + OFF_U), (const bf16*)(p.ws + OFF_WTIN) + (size_t)7168 * 1024, SEQ, 2048, 1024};
    pg8::StaticOrder S; S.init(SEQ, 2048, nblk, bid);
    EpiSig E{(bf16*)p.out};
    pg8::gemm_phase(smem, g, S, E);
}
DI void phase5b(const Params& p, char* smem, int bid, int nblk) {
    pg8::StaticOrder S; S.init(SEQ, 1024, nblk, bid);
    {
        pg8::Gemm g{(const bf16*)(p.ws + OFF_AQ), (const bf16*)(p.ws + OFF_WTBA), SEQ, 1024, 1024};
        EpiGate<false> E{(const bf16*)p.out, (bf16*)(p.ws + OFF_MIX), 0};
        pg8::gemm_phase(smem, g, S, E);
    }
    {
        pg8::Gemm g{(const bf16*)(p.ws + OFF_OD), (const bf16*)(p.ws + OFF_WTBD), SEQ, 1024, 1024};
        EpiGate<true> E{(const bf16*)p.out, (bf16*)(p.ws + OFF_MIX), 1024};
        pg8::gemm_phase(smem, g, S, E);
    }
}
DI void phase5c(const Params& p, char* smem, int bid, int nblk) {
    pg8::Gemm g{(const bf16*)(p.ws + OFF_MIX), (const bf16*)(p.ws + OFF_WTOUT), SEQ, 1024, 1024};
    pg8::StaticOrder S; S.init(SEQ, 1024, nblk, bid);
    EpiRes E{p.in[0], p.out};
    pg8::gemm_phase(smem, g, S, E);
}
constexpr int P5_PLP = 65, P5_PL = 0, P5_SS = 8 * 64 * P5_PLP * 4, P5_MISC = P5_SS + 8 * 64 * 4;
DI void post_rows(const Params& p, char* smem, int rb, int dry) {
    const int tid = fresh_tid(), lane = tid & 63, wave = tid >> 6, r32 = lane & 31, h = lane >> 5;
    unsigned char* ws = p.ws;
    const int row0 = rb * 64;
    float* rstdl = (float*)(smem + P5_MISC); float* logl = (float*)(smem + P5_MISC + 256);
    {
        const bf16* WH = (const bf16*)(ws + OFF_SMALL + SM_WR); const bf16* WL = WH + 64 * 1024;
        f32x16 acc[2][2];
#pragma unroll
        for (int mi = 0; mi < 2; ++mi)
#pragma unroll
            for (int ni = 0; ni < 2; ++ni) acc[mi][ni] = zero16();
        float ss[2] = {0.f, 0.f};
#pragma unroll 2
        for (int ks = 0; ks < 8; ++ks) {
            const int k0 = 128 * wave + 16 * ks + 8 * h;
            bf16x8 ah[2], al[2];
#pragma unroll
            for (int mi = 0; mi < 2; ++mi) {
                const float* hp = p.out + (size_t)(row0 + 32 * mi + r32) * D + k0;
                const f32x4 a = *(const f32x4*)hp, b = *(const f32x4*)(hp + 4);
                ss[mi] += a[0] * a[0] + a[1] * a[1] + a[2] * a[2] + a[3] * a[3] + b[0] * b[0] + b[1] * b[1] + b[2] * b[2] + b[3] * b[3];
                const u32x4 hi = {pk2(a[0], a[1]), pk2(a[2], a[3]), pk2(b[0], b[1]), pk2(b[2], b[3])};
                const u32x4 lo = {pk2(a[0] - bflo(hi.x), a[1] - bfhi(hi.x)), pk2(a[2] - bflo(hi.y), a[3] - bfhi(hi.y)), pk2(b[0] - bflo(hi.z), b[1] - bfhi(hi.z)), pk2(b[2] - bflo(hi.w), b[3] - bfhi(hi.w))};
                ah[mi] = __builtin_bit_cast(bf16x8, hi); al[mi] = __builtin_bit_cast(bf16x8, lo);
            }
#pragma unroll
            for (int ni = 0; ni < 2; ++ni) {
                const bf16x8 bh = *(const bf16x8*)(WH + (size_t)(32 * ni + r32) * 1024 + k0), bl = *(const bf16x8*)(WL + (size_t)(32 * ni + r32) * 1024 + k0);
#pragma unroll
                for (int mi = 0; mi < 2; ++mi) { acc[mi][ni] = MFMA32(ah[mi], bh, acc[mi][ni]); acc[mi][ni] = MFMA32(ah[mi], bl, acc[mi][ni]); acc[mi][ni] = MFMA32(al[mi], bh, acc[mi][ni]); }
            }
        }
        float* PL = (float*)(smem + P5_PL) + wave * 64 * P5_PLP; float* SS = (float*)(smem + P5_SS) + wave * 64;
#pragma unroll
        for (int mi = 0; mi < 2; ++mi) {
#pragma unroll
            for (int ni = 0; ni < 2; ++ni)
#pragma unroll
                for (int r = 0; r < 16; ++r) PL[(32 * mi + (r & 3) + 8 * (r >> 2) + 4 * h) * P5_PLP + 32 * ni + r32] = acc[mi][ni][r];
            const float s = ss[mi] + xhalf(ss[mi]);
            if (h == 0) SS[32 * mi + r32] = s;
        }
    }
    __syncthreads();
    if (tid < 64) {
        float s = 0.f;
#pragma unroll
        for (int w = 0; w < 8; ++w) s += ((const float*)(smem + P5_SS))[w * 64 + tid];
        const float rs = rsqrtf(s * (1.0f / D) + NORM_EPS);
        rstdl[tid] = rs;
        for (int c = 0; c < 36; ++c) { float t = 0.f; for (int w = 0; w < 8; ++w) t += ((const float*)(smem + P5_PL))[w * 64 * P5_PLP + tid * P5_PLP + c]; logl[tid * 41 + c] = t * rs + (c < 4 ? p.in[18][c] : p.in[20][c - 4]); }
        const float* L = logl + tid * 41;
        int gi = 0; float gm = L[0];
        for (int c = 1; c < 4; ++c) if (L[c] > gm) { gm = L[c]; gi = c; }
        float gs = 0.f; for (int c = 0; c < 4; ++c) gs += __expf(L[c] - gm);
        const float gw = 1.0f / gs;
        const float* E = L + 4 + 8 * gi;
        int i1 = 0; float l1 = E[0];
        for (int c = 1; c < 8; ++c) if (E[c] > l1) { l1 = E[c]; i1 = c; }
        int i2 = -1; float l2 = -3.0e38f;
        for (int c = 0; c < 8; ++c) if (c != i1 && E[c] > l2) { l2 = E[c]; i2 = c; }
        const float t = __expf(l2 - l1), w1 = 1.0f / (1.0f + t), w2 = t / (1.0f + t);
        unsigned* cnt = (unsigned*)(ws + OFF_SMALL + SM_CTL) + CW_ECNT;
        int* lists = (int*)(ws + OFF_SMALL + SM_TAILS); float* RW = (float*)(ws + OFF_SMALL + SM_RW);
        const int j = row0 + tid;
        const int e1 = 8 * gi + i1, e2 = 8 * gi + i2;
        if (!dry) {
        const unsigned p1 = atomicAdd(cnt + e1, 1u); ST_ATOMIC(lists + (size_t)e1 * SEQ + p1, (j << 1)); RW[2 * j] = gw * w1;
        const unsigned p2 = atomicAdd(cnt + e2, 1u); ST_ATOMIC(lists + (size_t)e2 * SEQ + p2, (j << 1) | 1); RW[2 * j + 1] = gw * w2;
        } else { asm volatile("" :: "v"(e1), "v"(e2), "v"(gw * w1), "v"(gw * w2)); }
    }
    __syncthreads();
#pragma unroll 2
    for (int i = 0; i < 16; ++i) {
        const int idx = tid + NT * i, row = idx >> 7, ch = idx & 127;
        const float* hp = p.out + (size_t)(row0 + row) * D + ch * 8;
        const f32x4 a = *(const f32x4*)hp, b = *(const f32x4*)(hp + 4);
        const f32x4 w0 = *(const f32x4*)(p.in[16] + ch * 8), w1 = *(const f32x4*)(p.in[16] + ch * 8 + 4);
        const float rs = rstdl[row];
        if (!dry) *(u32x4*)((bf16*)(ws + OFF_OD) + (size_t)(row0 + row) * D + ch * 8) =
            (u32x4){pk2(a[0] * rs * w0[0], a[1] * rs * w0[1]), pk2(a[2] * rs * w0[2], a[3] * rs * w0[3]), pk2(b[0] * rs * w1[0], b[1] * rs * w1[1]), pk2(b[2] * rs * w1[2], b[3] * rs * w1[3])};
    }
    __syncthreads();
}
DI void phase5d(const Params& p, char* smem, int bid, int nblk, int dry = 0) {
    for (int rb = bid; rb < SEQ / 64; rb += nblk) post_rows(p, smem, rb, dry);
}

constexpr int P6_TBL = 131072 + 1024;
template <int NPN> struct MoeSched {
    static constexpr bool GATHER = (NPN == 2);
    const int* tbl; const int* lists; int G, c; size_t btile;
    DM bool next(int i, pg8::Unit& u) const {
        const long L = (long)i * G + c; const int total = tbl[64 + 33 + 32] * NPN; if (L >= total) return false;
        const int ru = (int)L / NPN; u.pn = (int)L % NPN;
        int e = 0;
#pragma unroll 1
        for (int q = 1; q < 32; ++q) if (tbl[64 + 33 + q] <= ru) e = q;
        u.e = e; u.pm = ru - tbl[64 + 33 + e]; return true;
    }
    DM const char* a_tile(const pg8::Gemm& g, const pg8::Unit& u) const { return (const char*)g.A + ((size_t)tbl[32 + u.e] + (size_t)u.pm * 256) * g.K * 2; }
    DM const char* b_tile(const pg8::Gemm& g, const pg8::Unit& u) const { return (const char*)g.Bt + (size_t)u.e * btile + (size_t)u.pn * 256 * g.K * 2; }
    DM int a_row(const pg8::Unit& u, int r) const { const int loc = u.pm * 256 + r; return loc < tbl[u.e] ? (lists[(size_t)u.e * SEQ + loc] >> 1) : 0; }
};
DI void moe_table(const Params& p, char* smem) {
    int* tbl = (int*)(smem + P6_TBL);
    unsigned* cnt = (unsigned*)(p.ws + OFF_SMALL + SM_CTL) + CW_ECNT;
    if (threadIdx.x < 32) tbl[threadIdx.x] = (int)LD_ATOMIC(cnt + threadIdx.x);
    __syncthreads();
    if (threadIdx.x == 0) { int hb = 0, ub = 0; for (int e = 0; e < 32; ++e) { tbl[32 + e] = hb; tbl[64 + 33 + e] = ub; const int nru = (tbl[e] + 255) >> 8; hb += nru * 256; ub += nru; } tbl[32 + 32] = hb; tbl[64 + 33 + 32] = ub; }
    __syncthreads();
}
struct EpiSwiGLU {
    static constexpr bool PERM = true;
    bf16* H; const int* tbl;
    DM void operator()(const f32x4 (&acc)[2][2][4][2], const pg8::Unit& u, int wr, int wc, int fr, int fq) const {
        const size_t grow0 = (size_t)tbl[32 + u.e] + (size_t)u.pm * 256 + wr * 64 + fr; const int hid0 = (u.pn * 256 + wc * 32 + 8 * fq) >> 1;
#pragma unroll
        for (int ai = 0; ai < 2; ++ai)
#pragma unroll
            for (int m = 0; m < 4; ++m) {
                bf16* rowp = H + (grow0 + ai * 128 + m * 16) * 256 + hid0;
#pragma unroll
                for (int bj = 0; bj < 2; ++bj) {
                    const f32x4 gt = acc[ai][bj][m][0], up = acc[ai][bj][m][1];
                    *(u32x2*)(rowp + bj * 64) = (u32x2){pk2(siluf_(gt[0]) * up[0], siluf_(gt[1]) * up[1]), pk2(siluf_(gt[2]) * up[2], siluf_(gt[3]) * up[3])};
                }
            }
    }
};
struct EpiScatter {
    static constexpr bool PERM = true;
    bf16* Y; const int* tbl; const int* lists; const float* RW;
    DM void operator()(const f32x4 (&acc)[2][2][4][2], const pg8::Unit& u, int wr, int wc, int fr, int fq) const {
        const int loc0 = u.pm * 256 + wr * 64 + fr, col0 = u.pn * 256 + wc * 32 + 8 * fq, cnt = tbl[u.e];
#pragma unroll
        for (int ai = 0; ai < 2; ++ai)
#pragma unroll
            for (int m = 0; m < 4; ++m) {
                const int loc = loc0 + ai * 128 + m * 16;
                if (loc < cnt) {
                    const int ent = lists[(size_t)u.e * SEQ + loc]; const float w = RW[ent];
                    bf16* rowp = Y + (size_t)ent * D + col0;
#pragma unroll
                    for (int bj = 0; bj < 2; ++bj) {
                        const f32x4 v0 = acc[ai][bj][m][0] * w, v1 = acc[ai][bj][m][1] * w;
                        *(u32x4*)(rowp + bj * 128) = (u32x4){pk2(v0[0], v0[1]), pk2(v0[2], v0[3]), pk2(v1[0], v1[1]), pk2(v1[2], v1[3])};
                    }
                }
            }
    }
};
DI void phase6a(const Params& p, char* smem, int bid, int nblk) {
    moe_table(p, smem);
    const int* tbl = (const int*)(smem + P6_TBL); const int* lists = (const int*)(p.ws + OFF_SMALL + SM_TAILS);
    pg8::Gemm g{(const bf16*)(p.ws + OFF_OD), (const bf16*)(p.ws + OFF_EXG), 0, 512, 1024};
    MoeSched<2> S{tbl, lists, nblk, bid, (size_t)512 * 1024 * 2};
    EpiSwiGLU E{(bf16*)(p.ws + OFF_H), tbl};
    pg8::gemm_phase(smem, g, S, E);
}
DI void phase6b(const Params& p, char* smem, int bid, int nblk) {
    moe_table(p, smem);
    const int* tbl = (const int*)(smem + P6_TBL); const int* lists = (const int*)(p.ws + OFF_SMALL + SM_TAILS);
    pg8::Gemm g{(const bf16*)(p.ws + OFF_H), (const bf16*)(p.ws + OFF_EXD), 0, 1024, 256};
    MoeSched<4> S{tbl, lists, nblk, bid, (size_t)1024 * 256 * 2};
    EpiScatter E{(bf16*)(p.ws + OFF_Y), tbl, lists, (const float*)(p.ws + OFF_SMALL + SM_RW)};
    pg8::gemm_phase(smem, g, S, E);
}

DI void phase7(const Params& p, char* smem, int bid, int nblk, int dry = 0) {
    const int tid = fresh_tid(), lane = tid & 63, wave = tid >> 6;
    const int gw = bid * 8 + wave, NGW = nblk * 8;
    for (int j = gw; j < SEQ; j += NGW) {
        float* hrow = p.out + (size_t)j * D;
        const bf16* y0 = (const bf16*)(p.ws + OFF_Y) + (size_t)j * 2 * D;
        float4 v[4]; float ss = 0.f;
#pragma unroll
        for (int q = 0; q < 4; ++q) {
            const int c = 4 * lane + 256 * q;
            v[q] = *(const float4*)(hrow + c);
            const u32x2 a = *(const u32x2*)(y0 + c), b = *(const u32x2*)(y0 + D + c);
            v[q].x += bflo(a.x) + bflo(b.x); v[q].y += bfhi(a.x) + bfhi(b.x); v[q].z += bflo(a.y) + bflo(b.y); v[q].w += bfhi(a.y) + bfhi(b.y);
            ss += v[q].x * v[q].x + v[q].y * v[q].y + v[q].z * v[q].z + v[q].w * v[q].w;
        }
        ss = wave_sum(ss);
        const float rstd = rsqrtf(ss * (1.0f / D) + NORM_EPS);
#pragma unroll
        for (int q = 0; q < 4; ++q) {
            const int c = 4 * lane + 256 * q; const float4 w4 = *(const float4*)(p.in[24] + c);
            if (!dry) *(float4*)(hrow + c) = make_float4(v[q].x * rstd * w4.x, v[q].y * rstd * w4.y, v[q].z * rstd * w4.z, v[q].w * rstd * w4.w);
        }
    }
}

#ifdef EMU
__global__ void __launch_bounds__(NT) k_phase0(Params p) { SMEM_DECL; phase0(p, smem, blockIdx.x, gridDim.x); }
__global__ void __launch_bounds__(NT) k_phase1(Params p) { SMEM_DECL; phase1(p, smem, blockIdx.x, gridDim.x); }
__global__ void __launch_bounds__(NT) k_phase2(Params p) { SMEM_DECL; phase2(p, smem, blockIdx.x, gridDim.x, 0); }
__global__ void __launch_bounds__(NT) k_phase3(Params p) { SMEM_DECL; phase3(p, smem, blockIdx.x, gridDim.x); }
__global__ void __launch_bounds__(NT) k_phase4(Params p) { SMEM_DECL; phase4(p, smem, blockIdx.x, gridDim.x); }
__global__ void __launch_bounds__(NT) k_phase5a(Params p) { SMEM_DECL; phase5a(p, smem, blockIdx.x, gridDim.x); }
__global__ void __launch_bounds__(NT) k_phase5b(Params p) { SMEM_DECL; phase5b(p, smem, blockIdx.x, gridDim.x); }
__global__ void __launch_bounds__(NT) k_phase5c(Params p) { SMEM_DECL; phase5c(p, smem, blockIdx.x, gridDim.x); }
__global__ void __launch_bounds__(NT) k_phase5d(Params p) { SMEM_DECL; phase5d(p, smem, blockIdx.x, gridDim.x); }
__global__ void __launch_bounds__(NT) k_phase6a(Params p) { SMEM_DECL; phase6a(p, smem, blockIdx.x, gridDim.x); }
__global__ void __launch_bounds__(NT) k_phase6b(Params p) { SMEM_DECL; phase6b(p, smem, blockIdx.x, gridDim.x); }
__global__ void __launch_bounds__(NT) k_phase7(Params p) { SMEM_DECL; phase7(p, smem, blockIdx.x, gridDim.x); }

#endif

constexpr int LDS_BYTES = 160 * 1024 - 256;
constexpr int LDS_BARST = LDS_BYTES - 16;

#ifndef EMU
#define LAS __attribute__((address_space(3)))
#define XB_TMO      128
#define XB_XCNT(j)  (256  + 64 * (j))
#define XB_XSUB(j)  (1280 + 64 * (j))
#define XB_XGEN(j)  (2304 + 64 * (j))
#define XB_TOP      3328
#define XB_TOPGEN   3392
#define XCD_BAR_WORDS 3456
#define XB_SPIN_CAP (1u << 22)
__device__ __forceinline__ unsigned xb_ld(unsigned* p)              { return __hip_atomic_load(p, __ATOMIC_RELAXED, __HIP_MEMORY_SCOPE_AGENT); }
__device__ __forceinline__ unsigned xb_add(unsigned* p, unsigned v) { return __hip_atomic_fetch_add(p, v, __ATOMIC_RELAXED, __HIP_MEMORY_SCOPE_AGENT); }
__device__ __forceinline__ unsigned xb_xcc_id() { return (unsigned)__builtin_amdgcn_s_getreg((3 << 11) | 20) & 0xFu; }
#define XB_SPIN(cond, bar) do { unsigned _sp = 0; while (cond) { __builtin_amdgcn_s_sleep(1); \
    if ((++_sp & 255u) == 0u) { if (xb_ld(&(bar)[XB_TMO])) break; if (_sp > XB_SPIN_CAP) { atomicAdd(&(bar)[XB_TMO], 1u); break; } } } } while (0)
struct XcdBarrier { unsigned* bar; unsigned x; volatile LAS unsigned* st; };
__device__ __forceinline__ XcdBarrier xcd_barrier_post(unsigned* bar, volatile LAS unsigned* st) {
    XcdBarrier b; b.bar = bar; b.x = xb_xcc_id(); b.st = st;
    if (threadIdx.x == 0) (void)xb_add(&bar[XB_XCNT(b.x)], 1u);
    return b;
}
__device__ __forceinline__ void xcd_barrier_complete(unsigned* bar, unsigned x, unsigned& nloc, unsigned& nx) {
    const unsigned G = gridDim.x * gridDim.y * gridDim.z;
    unsigned sum, cnt, mine, sp = 0u;
    for (;;) {
        sum = 0u; cnt = 0u; mine = 0u;
#pragma unroll
        for (unsigned j = 0; j < 16; ++j) { const unsigned c = xb_ld(&bar[XB_XCNT(j)]); sum += c; cnt += (c > 0u) ? 1u : 0u; mine = (j == x) ? c : mine; }
        if (sum == G) break;
        __builtin_amdgcn_s_sleep(1);
        if ((++sp & 255u) == 0u) { if (xb_ld(&bar[XB_TMO])) break; if (sp > XB_SPIN_CAP) { atomicAdd(&bar[XB_TMO], 1u); break; } }
    }
    nloc = mine > 0u ? mine : 1u; nx = cnt > 0u ? cnt : 1u;
}
__device__ __forceinline__ void xcd_barrier(const XcdBarrier& b) {
    asm volatile("s_waitcnt vmcnt(0)" ::: "memory");
    __syncthreads();
    if (threadIdx.x == 0) {
        unsigned* bar = b.bar;
        __builtin_amdgcn_s_waitcnt(0);
        unsigned nloc = b.st[0], nx = b.st[1];
        if (nloc == 0u) { xcd_barrier_complete(bar, b.x, nloc, nx); b.st[0] = nloc; b.st[1] = nx; }
        const unsigned old = xb_add(&bar[XB_XSUB(b.x)], 1u);
        const unsigned gen = old / nloc;
        if (old + 1u == (gen + 1u) * nloc) {
            __builtin_amdgcn_fence(__ATOMIC_RELEASE, "agent");
            asm volatile("s_waitcnt vmcnt(0)" ::: "memory");
            const unsigned og = xb_add(&bar[XB_TOP], 1u);
            const unsigned tg = og / nx;
            if (og + 1u == (tg + 1u) * nx) xb_add(&bar[XB_TOPGEN], 1u);
            else XB_SPIN(xb_ld(&bar[XB_TOPGEN]) == tg, bar);
            __builtin_amdgcn_fence(__ATOMIC_ACQUIRE, "agent");
            xb_add(&bar[XB_XGEN(b.x)], 1u);
            asm volatile("s_waitcnt vmcnt(0)" ::: "memory");
        } else {
            XB_SPIN(xb_ld(&bar[XB_XGEN(b.x)]) == gen, bar);
            __builtin_amdgcn_fence(__ATOMIC_ACQUIRE, "agent");
            asm volatile("s_waitcnt vmcnt(0)" ::: "memory");
        }
    }
    __syncthreads();
}
#endif

#ifdef EMU
#define GRID_SYNC() emu_grid_sync()
#define GRID_SYNC_CG() emu_grid_sync()
#else
#define GRID_SYNC_CG() do { \
    asm volatile("s_waitcnt vmcnt(0)" ::: "memory"); \
    __syncthreads(); \
    cooperative_groups::this_grid().sync(); \
    if (threadIdx.x == 0) { __builtin_amdgcn_fence(__ATOMIC_ACQUIRE, "agent"); asm volatile("s_waitcnt vmcnt(0)" ::: "memory"); } \
    __syncthreads(); \
} while (0)
#define GRID_SYNC() xcd_barrier(xbar)
#endif
__global__ void __launch_bounds__(NT) fwd_megakernel(Params p) {
    SMEM_DECL;
    const int bid = blockIdx.x, nblk = gridDim.x;
#ifndef EMU
    if (threadIdx.x < 4) ((volatile LAS unsigned*)(smem + LDS_BARST))[threadIdx.x] = 0u;
    __syncthreads();
    const XcdBarrier xbar = xcd_barrier_post((unsigned*)(p.ws + OFF_SMALL + SM_CTL) + CW_BAR, (volatile LAS unsigned*)(smem + LDS_BARST));
#endif
#if defined(DRY_PHASE) && !defined(EMU)
    int dryflag = 1; asm volatile("" : "+s"(dryflag));
#define EXTRA(k, call) do { if (DRY_PHASE == (k)) { call; GRID_SYNC(); } } while (0)
#else
#define EXTRA(k, call) do {} while (0)
    const int dryflag = 0; (void)dryflag;
#endif
    EXTRA(0, phase0(p, smem, bid, nblk));
    phase0(p, smem, bid, nblk); GRID_SYNC();
    EXTRA(1, phase1(p, smem, bid, nblk));
    phase1(p, smem, bid, nblk); GRID_SYNC();
    EXTRA(2, phase2(p, smem, bid, nblk, dryflag));
    phase2(p, smem, bid, nblk); GRID_SYNC();
    EXTRA(3, phase3(p, smem, bid, nblk, dryflag));
    EXTRA(8, phase3(p, smem, bid, nblk, dryflag, 1));
    EXTRA(9, phase3(p, smem, bid, nblk, dryflag, 2));
    phase3(p, smem, bid, nblk); GRID_SYNC();
    EXTRA(4, phase4(p, smem, bid, nblk));
    phase4(p, smem, bid, nblk); GRID_SYNC();
    EXTRA(5, phase5a(p, smem, bid, nblk));
    phase5a(p, smem, bid, nblk); GRID_SYNC();
    EXTRA(10, phase5b(p, smem, bid, nblk));
    phase5b(p, smem, bid, nblk); GRID_SYNC();
    EXTRA(11, phase5c(p, smem, bid, nblk));
    phase5c(p, smem, bid, nblk); GRID_SYNC();
    EXTRA(12, phase5d(p, smem, bid, nblk, dryflag));
    phase5d(p, smem, bid, nblk); GRID_SYNC();
    EXTRA(6, phase6a(p, smem, bid, nblk));
    phase6a(p, smem, bid, nblk); GRID_SYNC();
    EXTRA(13, phase6b(p, smem, bid, nblk));
    phase6b(p, smem, bid, nblk); GRID_SYNC();
    EXTRA(7, phase7(p, smem, bid, nblk, dryflag));
    phase7(p, smem, bid, nblk);
}

#ifndef EMU
extern "C" void kernel_launch(void* const* d_in, const int* in_sizes, int n_in, void* d_out, int out_size, void* d_ws, size_t ws_size, hipStream_t stream) {
    static int grid = 0;
    if (grid == 0) {
        if (n_in != 25 || ws_size < WS_END || out_size != SEQ * D) { fprintf(stderr, "kernel_launch: unexpected problem (n_in %d, ws %zu, out %d)\n", n_in, ws_size, out_size); grid = -1; return; }
        int dev = 0, cus = 0, per_cu = 0;
        (void)hipGetDevice(&dev);
        (void)hipDeviceGetAttribute(&cus, hipDeviceAttributeMultiprocessorCount, dev);
        (void)hipFuncSetAttribute((const void*)fwd_megakernel, hipFuncAttributeMaxDynamicSharedMemorySize, LDS_BYTES);
        (void)hipOccupancyMaxActiveBlocksPerMultiprocessor(&per_cu, (const void*)fwd_megakernel, NT, LDS_BYTES);
        if (per_cu < 1) { fprintf(stderr, "kernel_launch: occupancy query returned %d\n", per_cu); per_cu = 1; }
        grid = cus * per_cu;
    }
    if (grid < 0) return;
    Params p{};
    for (int i = 0; i < 25; ++i) p.in[i] = (const float*)d_in[i];
    p.out = (float*)d_out; p.ws = (unsigned char*)d_ws;
    (void)hipMemsetAsync((unsigned char*)d_ws + OFF_SMALL + SM_CTL + (size_t)CW_BAR * 4, 0, (size_t)XCD_BAR_WORDS * 4, stream);
    void* args[] = {&p};
    hipError_t e = hipLaunchCooperativeKernel((const void*)fwd_megakernel, dim3(grid), dim3(NT), args, LDS_BYTES, stream);
    if (e != hipSuccess) fprintf(stderr, "cooperative launch failed: %s (grid %d)\n", hipGetErrorString(e), grid);
}
#endif

#ifdef EMU
static void run_phases(Params p, int upto, int grid) {
    if (upto == 100) { emu::launch([=] { fwd_megakernel(p); }, grid, NT, LDS_BYTES, true); return; }
    if (upto >= 0) emu::launch([=] { k_phase0(p); }, grid, NT, LDS_BYTES, false);
    if (upto >= 1) emu::launch([=] { k_phase1(p); }, grid, NT, LDS_BYTES, false);
    if (upto >= 2) emu::launch([=] { k_phase2(p); }, grid, NT, LDS_BYTES, false);
    if (upto >= 3) emu::launch([=] { k_phase3(p); }, grid, NT, LDS_BYTES, false);
    if (upto >= 4) emu::launch([=] { k_phase4(p); }, grid, NT, LDS_BYTES, false);
    if (upto >= 5) { emu::launch([=] { k_phase5a(p); }, grid, NT, LDS_BYTES, false); emu::launch([=] { k_phase5b(p); }, grid, NT, LDS_BYTES, false); emu::launch([=] { k_phase5c(p); }, grid, NT, LDS_BYTES, false); emu::launch([=] { k_phase5d(p); }, grid, NT, LDS_BYTES, false); }
    if (upto >= 6) { emu::launch([=] { k_phase6a(p); }, grid, NT, LDS_BYTES, false); emu::launch([=] { k_phase6b(p); }, grid, NT, LDS_BYTES, false); }
    if (upto >= 7) emu::launch([=] { k_phase7(p); }, grid, NT, LDS_BYTES, false);
}
#endif
```

```cpp
#include <type_traits>
#ifndef EMU
#include <hip/hip_runtime.h>
#include <hip/hip_cooperative_groups.h>
#include <cstdio>
#include <cstdint>
#include <cmath>
#endif

#ifndef SEQ
#define SEQ 16384
#endif

typedef unsigned short bf16;
typedef short bf16x8 __attribute__((ext_vector_type(8)));
typedef short bf16x4 __attribute__((ext_vector_type(4)));
typedef float f32x16 __attribute__((ext_vector_type(16)));
typedef float f32x4 __attribute__((ext_vector_type(4)));
typedef unsigned u32x4 __attribute__((ext_vector_type(4)));
typedef unsigned u32x2 __attribute__((ext_vector_type(2)));

#ifdef EMU
#define MFMA32(a, b, c) emu_mfma_32x32x16((a), (b), (c))
#define MFMA16(a, b, c) emu_mfma_16x16x32((a), (b), (c))
#define DI static inline
#define DM inline
#define EXP2F(x) exp2f(x)
#define WAVE_SYNC() emu_wave_sync()
#define LD_NT(p) (*(p))
#define LD_ATOMIC(p) (*(p))
#define ST_ATOMIC(p, v) (*(p) = (v))
#define SCHED_FENCE() do {} while (0)
#define SETPRIO(x) do {} while (0)
#else
#define WAVE_SYNC() do { __builtin_amdgcn_fence(__ATOMIC_RELEASE, "wavefront"); __builtin_amdgcn_wave_barrier(); __builtin_amdgcn_fence(__ATOMIC_ACQUIRE, "wavefront"); } while (0)
#define MFMA32(a, b, c) __builtin_amdgcn_mfma_f32_32x32x16_bf16((a), (b), (c), 0, 0, 0)
#define LD_NT(p) __builtin_nontemporal_load(p)
#define LD_ATOMIC(p) __hip_atomic_load((p), __ATOMIC_RELAXED, __HIP_MEMORY_SCOPE_AGENT)
#define ST_ATOMIC(p, v) __hip_atomic_store((p), (v), __ATOMIC_RELAXED, __HIP_MEMORY_SCOPE_AGENT)
#define SCHED_FENCE() __builtin_amdgcn_sched_barrier(0)
#define SETPRIO(x) __builtin_amdgcn_s_setprio(x)
#define MFMA16(a, b, c) __builtin_amdgcn_mfma_f32_16x16x32_bf16((a), (b), (c), 0, 0, 0)
#define DI __device__ __forceinline__
#define DM __device__ __forceinline__
#define EXP2F(x) __builtin_amdgcn_exp2f(x)
#endif

constexpr int D = 1024;
constexpr int NMETA = 16;
constexpr int LTOK = SEQ + NMETA;
constexpr int NCH = SEQ / 64 + 1;
constexpr int NT = 512;
constexpr int W_IN_COLS = 9232;
constexpr float NORM_EPS = 1e-6f;
constexpr float LOG2E = 1.4426950408889634f;

constexpr size_t UNIT = (size_t)SEQ * D * 2;
constexpr size_t OFF_WTIN = 0;
constexpr size_t OFF_WTBA = OFF_WTIN + (size_t)9216 * 1024 * 2;
constexpr size_t OFF_WTBD = OFF_WTBA + (size_t)1024 * 1024 * 2;
constexpr size_t OFF_WTOUT = OFF_WTBD + (size_t)1024 * 1024 * 2;
constexpr size_t OFF_SMALL = OFF_WTOUT + (size_t)1024 * 1024 * 2;
constexpr size_t SM_CTL = 0;
constexpr size_t SM_UMETA = SM_CTL + 65536;
constexpr size_t SM_AKMETA = SM_UMETA + 16 * 1024 * 2;
constexpr size_t SM_AVTMETA = SM_AKMETA + 16 * 1024 * 2;
constexpr size_t SM_C0Q = SM_AVTMETA + 8 * 128 * 16 * 2;
constexpr size_t SM_C0K = SM_C0Q + 64 * 1024 * 2;
constexpr size_t SM_C0V = SM_C0K + 64 * 1024 * 2;
constexpr size_t SM_C0W = SM_C0V + 64 * 1024 * 2;
constexpr size_t SM_C0QK = SM_C0W + 8 * 64 * 128 * 2;
constexpr size_t SM_BETA = SM_C0QK + 8 * 64 * 64 * 2;
constexpr size_t SM_G = SM_BETA + (size_t)NCH * 64 * 8 * 4;
constexpr size_t SM_GC = SM_G + (size_t)NCH * 64 * 8 * 4;
constexpr size_t SM_WR = SM_GC + (size_t)NCH * 8 * 64 * 4;
constexpr size_t SM_RIDS = SM_WR + 2 * 64 * 1024 * 2;
constexpr size_t SM_RW = SM_RIDS + 0;
constexpr size_t SM_TAILS = SM_RW + (size_t)SEQ * 2 * 4;
constexpr size_t SM_TAILS_BYTES = ((size_t)NCH * 3 * 3072 * 2 > (size_t)32 * SEQ * 4) ? (size_t)NCH * 3 * 3072 * 2 : (size_t)32 * SEQ * 4;
constexpr size_t SM_END = SM_TAILS + SM_TAILS_BYTES;
constexpr size_t SMALL_BYTES = (SM_END + 255) & ~(size_t)255;
constexpr size_t OFF_U = ((OFF_SMALL + SMALL_BYTES + (1u << 20) - 1) >> 20) << 20;
constexpr size_t OFF_W = OFF_U + UNIT;
constexpr size_t OFF_KN = OFF_W + UNIT;
constexpr size_t OFF_QN = OFF_KN + UNIT;
constexpr size_t OFF_DG = OFF_QN + UNIT;
constexpr size_t OFF_V = OFF_DG + UNIT;
constexpr size_t OFF_AQ = OFF_V + UNIT;
constexpr size_t WS_BASE_END = OFF_AQ + UNIT;
constexpr size_t EXPERT_BYTES = (size_t)32 * 3 * 1024 * 256 * 2;
constexpr size_t OFF_EXP = (2 * UNIT >= EXPERT_BYTES) ? OFF_W : WS_BASE_END;
constexpr size_t WS_END1 = (OFF_EXP == OFF_W) ? WS_BASE_END : WS_BASE_END + EXPERT_BYTES;
constexpr size_t H_BYTES = ((size_t)2 * SEQ + 32 * 256) * 256 * 2;
constexpr size_t OFF_H = (H_BYTES <= UNIT) ? (OFF_SMALL + SMALL_BYTES + ((1u << 20) - 1)) / (1u << 20) * (1u << 20) : WS_END1;
constexpr size_t WS_END = (H_BYTES <= UNIT) ? WS_END1 : WS_END1 + H_BYTES;
constexpr size_t OFF_EXG = OFF_EXP, OFF_EXU = OFF_EXP + EXPERT_BYTES / 3, OFF_EXD = OFF_EXP + 2 * (EXPERT_BYTES / 3);
constexpr size_t OFF_QKB = OFF_U;
constexpr size_t OFF_OD = OFF_QN;
constexpr size_t OFF_Y = OFF_V;
#if SEQ == 16384
static_assert(WS_END <= (size_t)256 << 20, "workspace map exceeds 256 MiB");
static_assert(EXPERT_BYTES <= 2 * UNIT, "experts fit R2+R3");
#endif
constexpr int CW_ATTQ = 64;
constexpr int CW_ECNT = 128;
constexpr int CW_NRM = 256;
constexpr int CW_BAR = 1024;

struct Params {
    const float* in[25];
    float* out;
    unsigned char* ws;
};

#ifdef EMU
DI unsigned f2bf(float f) { unsigned u = __builtin_bit_cast(unsigned, f); return (u + 0x7fffu + ((u >> 16) & 1u)) >> 16; }
#else
DI unsigned f2bf(float f) { return (unsigned)__builtin_bit_cast(unsigned short, (__bf16)f); }
#endif

DI float bf2f(unsigned b) { return __builtin_bit_cast(float, (b & 0xffffu) << 16); }
#ifdef EMU
DI unsigned pk2(float lo, float hi) { return f2bf(lo) | (f2bf(hi) << 16); }
DI bool wave_any(bool pr) { int v = pr ? 1 : 0;
    for (int o = 1; o < 64; o <<= 1) v |= __shfl_xor(v, o);
    return v != 0; }
#else
typedef __bf16 hwbf2 __attribute__((ext_vector_type(2)));
typedef float f32x2_ __attribute__((ext_vector_type(2)));
DI unsigned pk2(float lo, float hi) { return __builtin_bit_cast(unsigned, __builtin_convertvector((f32x2_){lo, hi}, hwbf2)); }
DI bool wave_any(bool pr) { return __any(pr) != 0; }
#endif
DI float bflo(unsigned w) { return __builtin_bit_cast(float, w << 16); }
DI float bfhi(unsigned w) { return __builtin_bit_cast(float, w & 0xffff0000u); }
#ifdef EMU
DI float rcpf_(float x) { return 1.0f / x; }
#else
DI float rcpf_(float x) { return __builtin_amdgcn_rcpf(x); }
#endif
DI float sigmoidf_(float x) { return rcpf_(1.0f + __expf(-x)); }
DI float siluf_(float x) { return x * rcpf_(1.0f + __expf(-x)); }
DI float wave_sum(float v) {
#pragma unroll
    for (int o = 1; o < 64; o <<= 1) v += __shfl_xor(v, o);
    return v;
}
DI int fresh_tid() {
    int t = threadIdx.x;
#ifndef EMU
    asm volatile("" : "+v"(t));
#endif
    return t;
}
#ifdef EMU
DI float xhalf(float v) { return __shfl_xor(v, 32); }
#else
DI float xhalf(float v) { const unsigned u = __builtin_bit_cast(unsigned, v); const auto r = __builtin_amdgcn_permlane32_swap(u, u, false, false); return __builtin_bit_cast(float, (threadIdx.x & 32) ? r[0] : r[1]); }
#endif
DI f32x16 zero16() { f32x16 z; for (int i = 0; i < 16; ++i) z[i] = 0.f; return z; }
DI f32x4 zero4() { f32x4 z; for (int i = 0; i < 4; ++i) z[i] = 0.f; return z; }
DI int swz128(int row, int c) { return row * 128 + ((c ^ ((row >> 1) & 7)) << 4); }
DI int swz128t(int row, int c) { return row * 128 + ((c ^ ((row >> 1) & 7) ^ ((row >> 4) & 7)) << 4); }
DI int swz128_8(int row, int s) { return row * 128 + ((s ^ (((row >> 1) & 7) << 1)) << 3); }
DI int swzrow(int row, int pitch, int c) { return row * pitch + ((c ^ (row & 15)) << 4); }

#ifdef EMU
#define SMEM_DECL char* smem = emu_smem()
#else
#define SMEM_DECL extern __shared__ __attribute__((aligned(16))) char smem[]
#endif

DI void transpose_item(const float* W, int ldw, int K, bf16* Wt, int k0, int src_n0, int dst_n0, float* scr, int lane, int il = 0) {
#pragma unroll 8
    for (int i = 0; i < 32; ++i) { const int kk = 2 * i + (lane >> 5); scr[kk * 33 + (lane & 31)] = W[(size_t)(k0 + kk) * ldw + src_n0 + (lane & 31)]; }
    WAVE_SYNC();
    const int c = lane & 7;
#pragma unroll
    for (int j = 0; j < 4; ++j) {
        const int n = (lane >> 3) + 8 * j; const float* s = scr + (8 * c) * 33 + n;
        u32x4 o; o.x = pk2(s[0 * 33], s[1 * 33]); o.y = pk2(s[2 * 33], s[3 * 33]); o.z = pk2(s[4 * 33], s[5 * 33]); o.w = pk2(s[6 * 33], s[7 * 33]);
        const int hid = dst_n0 + n, drow = il ? 8 * (hid >> 2) + 4 * (il - 1) + (hid & 3) : hid;
        *(u32x4*)(Wt + (size_t)drow * K + k0 + 8 * c) = o;
    }
    WAVE_SYNC();
}

DI void phase0(const Params& p, char* smem, int bid, int nblk) {
    const int tid = fresh_tid(), lane = tid & 63, wave = tid >> 6;
    const int gw = bid * 8 + wave, NGW = nblk * 8;
    unsigned char* ws = p.ws;
    if (bid == 0) {
        unsigned* ctl = (unsigned*)(ws + OFF_SMALL + SM_CTL);
        for (int i = tid; i < 1024; i += NT) ctl[i] = 0u;
        float* be = (float*)(ws + OFF_SMALL + SM_BETA); float* gg = (float*)(ws + OFF_SMALL + SM_G);
        for (int i = tid; i < 48 * 8; i += NT) { be[i] = 0.f; gg[i] = 0.f; }
    }
    {
        float* scr = (float*)(smem + 65536) + wave * (64 * 33);
        constexpr int I_IN = 16 * (9216 / 32), I_SQ = 16 * 32;
        constexpr int NITEMS = I_IN + 3 * I_SQ;
        for (int it = gw; it < NITEMS; it += NGW) {
            int r = it;
            if (r < I_IN) { const int kb = r / 288, nb = r % 288; const int dn = nb * 32; const int sn = dn < 7168 ? dn : dn + 16;
                transpose_item(p.in[3], W_IN_COLS, 1024, (bf16*)(ws + OFF_WTIN), kb * 64, sn, dn, scr, lane); continue; }
            r -= I_IN;
            const int m = r / I_SQ; r %= I_SQ;
            const float* src = m == 0 ? p.in[13] : (m == 1 ? p.in[14] : p.in[15]);
            bf16* dst = (bf16*)(ws + (m == 0 ? OFF_WTBA : (m == 1 ? OFF_WTBD : OFF_WTOUT)));
            transpose_item(src, 1024, 1024, dst, (r / 32) * 64, (r % 32) * 32, (r % 32) * 32, scr, lane);
        }
    }
    {
        bf16* WH = (bf16*)(ws + OFF_SMALL + SM_WR); bf16* WL = WH + 64 * 1024;
        for (int i = bid * NT + tid; i < 64 * 1024; i += nblk * NT) {
            const int n = i >> 10, kk = i & 1023; float v = 0.f;
            if (n < 4) v = p.in[17][kk * 4 + n]; else if (n < 36) v = p.in[19][kk * 32 + (n - 4)];
            v *= p.in[16][kk];
            const unsigned hb = f2bf(v); const float lo = v - bf2f(hb);
            WH[i] = (bf16)hb; WL[i] = (bf16)f2bf(lo);
        }
    }
    float* wbd = (float*)smem;
    for (int i = tid; i < 1024 * 16; i += NT) { const int k = i >> 4, c = i & 15; wbd[c * 1024 + k] = p.in[3][(size_t)k * W_IN_COLS + 7168 + c]; }
    __syncthreads();
    const float* nw = p.in[2];
    for (int R = gw; R < LTOK; R += NGW) {
        const float* xrow = R < NMETA ? p.in[1] + (size_t)R * D : p.in[0] + (size_t)(R - NMETA) * D;
        bf16* urow = R < NMETA ? (bf16*)(ws + OFF_SMALL + SM_UMETA) + (size_t)R * D : (bf16*)(ws + OFF_U) + (size_t)(R - NMETA) * D;
        float ss = 0.f;
#pragma unroll
        for (int j = 0; j < 4; ++j) { const float4 v = *(const float4*)(xrow + 4 * lane + 256 * j); ss += v.x * v.x + v.y * v.y + v.z * v.z + v.w * v.w; }
        ss = wave_sum(ss);
        const float rstd = rsqrtf(ss * (1.0f / D) + NORM_EPS);
        float acc[16];
#pragma unroll
        for (int c = 0; c < 16; ++c) acc[c] = 0.f;
#pragma unroll 1
        for (int j = 0; j < 4; ++j) {
            const float4 w4 = *(const float4*)(nw + 4 * lane + 256 * j);
            const float4 xv = *(const float4*)(xrow + 4 * lane + 256 * j);
            float uu[4] = {xv.x * rstd * w4.x, xv.y * rstd * w4.y, xv.z * rstd * w4.z, xv.w * rstd * w4.w};
            u32x2 o; o.x = pk2(uu[0], uu[1]); o.y = pk2(uu[2], uu[3]);
            *(u32x2*)(urow + 4 * lane + 256 * j) = o;
#pragma unroll
            for (int c = 0; c < 16; ++c) {
                const f32x4 w = *(const f32x4*)(wbd + c * 1024 + 4 * lane + 256 * j);
                acc[c] += uu[0] * w[0] + uu[1] * w[1] + uu[2] * w[2] + uu[3] * w[3];
            }
        }
        float v8[8], v4[4], v2[2], a;
        {
            const bool b0 = lane & 1, b1 = lane & 2, b2 = lane & 4, b3 = lane & 8;
#pragma unroll
            for (int i = 0; i < 8; ++i) { const float keep = b0 ? acc[i + 8] : acc[i], send = b0 ? acc[i] : acc[i + 8]; v8[i] = keep + __shfl_xor(send, 1); }
#pragma unroll
            for (int i = 0; i < 4; ++i) { const float keep = b1 ? v8[i + 4] : v8[i], send = b1 ? v8[i] : v8[i + 4]; v4[i] = keep + __shfl_xor(send, 2); }
#pragma unroll
            for (int i = 0; i < 2; ++i) { const float keep = b2 ? v4[i + 2] : v4[i], send = b2 ? v4[i] : v4[i + 2]; v2[i] = keep + __shfl_xor(send, 4); }
            { const float keep = b3 ? v2[1] : v2[0], send = b3 ? v2[0] : v2[1]; a = keep + __shfl_xor(send, 8); }
            a += __shfl_xor(a, 16); a += __shfl_xor(a, 32);
        }
        if (lane < 16) {
            const int cc = ((lane & 1) << 3) | ((lane & 2) << 1) | ((lane & 4) >> 1) | ((lane & 8) >> 3);
            const size_t pos = 48 + R;
            if (cc < 8) { ((float*)(ws + OFF_SMALL + SM_BETA))[pos * 8 + cc] = sigmoidf_(a); }
            else { const int hh = cc - 8; const float z = a + p.in[11][hh]; const float sp = fmaxf(z, 0.f) + log1pf(__expf(-fabsf(z)));
                   ((float*)(ws + OFF_SMALL + SM_G))[pos * 8 + hh] = -__expf(p.in[10][hh]) * sp; }
        }
    }
}

namespace pg8 {
constexpr int BM = 256, BK = 64, HALF = 128, HTB = HALF * BK * 2, NXCD = 8, WGM = 8;
DI int lds_byte(int r, int c) { const int st = (r >> 4) * 2 + (c >> 5), rr = r & 15, cc = c & 31, ob = rr * 64 + cc * 2; return st * 1024 + (ob ^ (((ob >> 9) & 1) << 5)); }
DI void stage_rc(int b, int& R, int& C) { const int st = b / 1024, sb = b % 1024, swz = sb ^ (((sb >> 9) & 1) << 5); R = (st >> 1) * 16 + swz / 64; C = (st & 1) * 32 + (swz % 64) / 2; }
DI int perm32(int rho) { const int n = rho >> 4, i = rho & 15; return 8 * (i >> 2) + 4 * n + (i & 3); }
struct Unit { int pm, pn, e; };
struct Gemm { const bf16* A; const bf16* Bt; int M, N, K; };
struct StaticOrder {
    static constexpr bool GATHER = false;
    int nM, nN, nwg, G, c;
    DM void init(int M, int N, int G_, int c_) { nM = M / BM; nN = N / BM; nwg = nM * nN; G = G_; c = c_; }
    DM bool next(int i, Unit& u) const {
        const long L = (long)i * G + c; if (L >= nwg) return false;
        int wgid = (int)L; { const int q = nwg / NXCD, r = nwg % NXCD, xcd = wgid % NXCD, off = wgid / NXCD; wgid = (xcd < r ? xcd * (q + 1) : r * (q + 1) + (xcd - r) * q) + off; }
        const int nig = WGM * nN, gid = wgid / nig, fm = gid * WGM, gsz = (nM - fm) < WGM ? (nM - fm) : WGM;
        u.pm = fm + ((wgid % nig) % gsz); u.pn = (wgid % nig) / gsz; u.e = 0; return true;
    }
    DM const char* a_tile(const Gemm& g, const Unit& u) const { return (const char*)g.A + (size_t)u.pm * 256 * g.K * 2; }
    DM const char* b_tile(const Gemm& g, const Unit& u) const { return (const char*)g.Bt + (size_t)u.pn * 256 * g.K * 2; }
    DM int a_row(const Unit&, int) const { return 0; }
};
#ifdef EMU
template <class Epi, class Sched>
DI void gemm_phase(char* lds, const Gemm g, const Sched& S, const Epi& E) {
    const int tid = threadIdx.x, wid = tid >> 6, lane = tid & 63, wr = wid >> 2, wc = wid & 3, fr = lane & 15, fq = lane >> 4;
    Unit u;
    for (int ui = 0; S.next(ui, u); ++ui) {
        f32x4 acc[2][2][4][2];
        const bf16* bt = (const bf16*)S.b_tile(g, u);
        for (int ai = 0; ai < 2; ++ai) for (int bj = 0; bj < 2; ++bj) for (int m = 0; m < 4; ++m) for (int n = 0; n < 2; ++n) for (int e = 0; e < 4; ++e) {
            const int r = 128 * ai + 64 * wr + 16 * m + fr;
            const int c = 128 * bj + 32 * wc + (Epi::PERM ? 8 * fq + 4 * n : 16 * n + 4 * fq) + e;
            const bf16* a = Sched::GATHER ? g.A + (size_t)S.a_row(u, r) * g.K : (const bf16*)S.a_tile(g, u) + (size_t)r * g.K;
            const bf16* b = bt + (size_t)c * g.K; float s = 0.f;
            for (int kk = 0; kk < g.K; ++kk) s += bf2f(a[kk]) * bf2f(b[kk]);
            acc[ai][bj][m][n][e] = s;
        }
        E(acc, u, wr, wc, fr, fq);
    }
    __syncthreads();
}
#else
#define PG8_LAS __attribute__((address_space(3)))
template <class Epi, class Sched>
__device__ __forceinline__ void gemm_phase(char* lds_, const Gemm g, const Sched& S, const Epi& E) {
    PG8_LAS unsigned char* lds = (PG8_LAS unsigned char*)lds_;
    const int tid = fresh_tid(), wid = __builtin_amdgcn_readfirstlane(tid >> 6), lane = tid & 63, wr = wid >> 2, wc = wid & 3, fr = lane & 15, fq = lane >> 4;
    const int K = g.K, nt = K / BK;
    unsigned voffA[2], voffB[2]; int RA[2], CA[2];
#pragma unroll
    for (int i = 0; i < 2; ++i) { int R, C; stage_rc(tid * 16 + i * 8192, R, C); const int Rb = Epi::PERM ? ((R & ~31) + perm32(R & 31)) : R;
        voffA[i] = (unsigned)(R * K + C) * 2u; voffB[i] = (unsigned)(Rb * K + C) * 2u; RA[i] = R; CA[i] = C; }
    const size_t kstep = (size_t)(BK * 2);
    const size_t hstep = (size_t)HALF * K * 2;
    const unsigned ldsw = (unsigned)wid * 1024u;
    const int aoff = lds_byte(wr * 64 + fr, fq * 8), boff = lds_byte(wc * 32 + fr, fq * 8);
#define PG8_SA(b, h) (((b) * 2 + (h)) * HTB)
#define PG8_SB(b, h) ((4 + (b) * 2 + (h)) * HTB)
#define PG8_STAGE(bufoff, gbase, voff) do { _Pragma("unroll") for (int _i = 0; _i < 2; ++_i) \
        __builtin_amdgcn_global_load_lds((const unsigned*)((const char*)(gbase) + (voff)[_i]), (PG8_LAS unsigned*)(lds + (bufoff) + ldsw + _i * 8192), 16, 0, 0); } while (0)
#define PG8_STAGE_A(bufoff, base, PA, half, koff) do { if constexpr (Sched::GATHER) { _Pragma("unroll") for (int _i = 0; _i < 2; ++_i) \
        __builtin_amdgcn_global_load_lds((const unsigned*)((PA)[half][_i] + (koff)), (PG8_LAS unsigned*)(lds + (bufoff) + ldsw + _i * 8192), 16, 0, 0); } \
        else { PG8_STAGE(bufoff, (base) + (half) * hstep + (koff), voffA); } } while (0)
#define PG8_LDA(dst, b, h) do { _Pragma("unroll") for (int m = 0; m < 4; ++m) _Pragma("unroll") for (int k = 0; k < 2; ++k) dst[m][k] = *(const PG8_LAS bf16x8*)(lds + PG8_SA(b, h) + aoff + m * 2048 + k * 1024); } while (0)
#define PG8_LDB(dst, b, h) do { _Pragma("unroll") for (int n = 0; n < 2; ++n) _Pragma("unroll") for (int k = 0; k < 2; ++k) dst[n][k] = *(const PG8_LAS bf16x8*)(lds + PG8_SB(b, h) + boff + n * 2048 + k * 1024); } while (0)
#define PG8_MMA(ai, bj, At, Bt) do { __builtin_amdgcn_s_setprio(1); _Pragma("unroll") for (int m = 0; m < 4; ++m) _Pragma("unroll") for (int n = 0; n < 2; ++n) _Pragma("unroll") for (int k = 0; k < 2; ++k) \
        acc[ai][bj][m][n] = __builtin_amdgcn_mfma_f32_16x16x32_bf16(Bt[n][k], At[m][k], acc[ai][bj][m][n], 0, 0, 0); __builtin_amdgcn_s_setprio(0); } while (0)
#define PG8_WAIT_V(n) asm volatile("s_waitcnt vmcnt(" #n ")" ::: "memory")
#define PG8_WAIT_L(n) asm volatile("s_waitcnt lgkmcnt(" #n ")" ::: "memory")
#define PG8_BAR __builtin_amdgcn_s_barrier()
#define PG8_SCHED __builtin_amdgcn_sched_barrier(0)
    Unit cur, nxt; int ui = 0;
    if (S.next(0, cur)) {
    f32x4 acc[2][2][4][2];
#pragma unroll
    for (int a = 0; a < 2; ++a)
#pragma unroll
        for (int b = 0; b < 2; ++b)
#pragma unroll
            for (int m = 0; m < 4; ++m)
#pragma unroll
                for (int n = 0; n < 2; ++n) acc[a][b][m][n] = (f32x4){0.f, 0.f, 0.f, 0.f};
    bf16x8 At[4][2], B0[2][2], B1[2][2];
    const char* PAc[2][2]; const char* PAn[2][2];
    auto gather_ptrs = [&](const Unit& u, const char* (&PA)[2][2]) {
        if constexpr (Sched::GATHER) {
#pragma unroll
            for (int hh = 0; hh < 2; ++hh)
#pragma unroll
                for (int i = 0; i < 2; ++i) PA[hh][i] = (const char*)g.A + ((size_t)S.a_row(u, hh * 128 + RA[i]) * K + CA[i]) * 2;
        }
    };
    const char* cA = Sched::GATHER ? nullptr : S.a_tile(g, cur); const char* cB = S.b_tile(g, cur);
    gather_ptrs(cur, PAc);
    PG8_STAGE(PG8_SB(0, 0), cB, voffB); PG8_STAGE_A(PG8_SA(0, 0), cA, PAc, 0, 0); PG8_STAGE(PG8_SB(0, 1), cB + hstep, voffB); PG8_STAGE_A(PG8_SA(0, 1), cA, PAc, 1, 0);
    if (wr == 1) PG8_BAR;
    PG8_WAIT_V(4); PG8_BAR;
    PG8_STAGE(PG8_SB(1, 0), cB + kstep, voffB); PG8_STAGE_A(PG8_SA(1, 0), cA, PAc, 0, kstep); PG8_STAGE(PG8_SB(1, 1), cB + hstep + kstep, voffB);
    PG8_WAIT_V(6); PG8_BAR;
    for (;;) {
        const bool has_next = S.next(ui + 1, nxt);
        const char* nA = Sched::GATHER ? nullptr : (has_next ? S.a_tile(g, nxt) : cA); const char* nB = has_next ? S.b_tile(g, nxt) : cB;
        if (has_next) gather_ptrs(nxt, PAn); else { if constexpr (Sched::GATHER) { PAn[0][0] = PAc[0][0]; PAn[0][1] = PAc[0][1]; PAn[1][0] = PAc[1][0]; PAn[1][1] = PAc[1][1]; } }
        for (int t = 0; t < nt; t += 2) {
            const bool last = (t == nt - 2);
            const size_t k1 = (size_t)(t + 1) * kstep;
            const char* a2 = last ? nA : cA; const char* b2 = last ? nB : cB + (size_t)(t + 2) * kstep;
            const size_t k2 = last ? 0 : (size_t)(t + 2) * kstep, k3 = k2 + kstep;
            const char* b3 = b2 + kstep;
            const char* P2[2][2];
            if constexpr (Sched::GATHER) {
#pragma unroll
                for (int hh = 0; hh < 2; ++hh)
#pragma unroll
                    for (int i = 0; i < 2; ++i) P2[hh][i] = last ? PAn[hh][i] : PAc[hh][i];
            }
            PG8_LDB(B0, 0, 0); PG8_SCHED; PG8_LDA(At, 0, 0); PG8_STAGE_A(PG8_SA(1, 1), cA, PAc, 1, k1);
            PG8_WAIT_L(8); PG8_BAR; PG8_WAIT_L(0); PG8_MMA(0, 0, At, B0); PG8_BAR; PG8_SCHED;
            PG8_LDB(B1, 0, 1); PG8_STAGE(PG8_SB(0, 0), b2, voffB);
            PG8_BAR; PG8_WAIT_L(0); PG8_MMA(0, 1, At, B1); PG8_BAR;
            PG8_LDA(At, 0, 1); PG8_STAGE_A(PG8_SA(0, 0), a2, P2, 0, k2);
            PG8_BAR; PG8_WAIT_L(0); PG8_MMA(1, 0, At, B0); PG8_BAR; PG8_SCHED;
            PG8_STAGE(PG8_SB(0, 1), b2 + hstep, voffB);
            PG8_WAIT_V(6); PG8_BAR; PG8_MMA(1, 1, At, B1); PG8_BAR;
            PG8_LDB(B0, 1, 0); PG8_SCHED; PG8_LDA(At, 1, 0); PG8_STAGE_A(PG8_SA(0, 1), a2, P2, 1, k2);
            PG8_WAIT_L(8); PG8_BAR; PG8_WAIT_L(0); PG8_MMA(0, 0, At, B0); PG8_BAR; PG8_SCHED;
            PG8_LDB(B1, 1, 1); PG8_STAGE(PG8_SB(1, 0), b3, voffB);
            PG8_BAR; PG8_WAIT_L(0); PG8_MMA(0, 1, At, B1); PG8_BAR;
            PG8_LDA(At, 1, 1); PG8_STAGE_A(PG8_SA(1, 0), a2, P2, 0, k3);
            PG8_BAR; PG8_WAIT_L(0); PG8_MMA(1, 0, At, B0); PG8_BAR; PG8_SCHED;
            PG8_STAGE(PG8_SB(1, 1), b3 + hstep, voffB);
            PG8_WAIT_V(6); PG8_BAR; PG8_MMA(1, 1, At, B1); PG8_BAR;
        }
        E(acc, cur, wr, wc, fr, fq);
        if (!has_next) break;
#pragma unroll
        for (int a = 0; a < 2; ++a)
#pragma unroll
            for (int b = 0; b < 2; ++b)
#pragma unroll
                for (int m = 0; m < 4; ++m)
#pragma unroll
                    for (int n = 0; n < 2; ++n) acc[a][b][m][n] = (f32x4){0.f, 0.f, 0.f, 0.f};
        cur = nxt; cA = nA; cB = nB; ++ui;
        if constexpr (Sched::GATHER) { PAc[0][0] = PAn[0][0]; PAc[0][1] = PAn[0][1]; PAc[1][0] = PAn[1][0]; PAc[1][1] = PAn[1][1]; }
    }
    PG8_WAIT_V(0);
    if (wr == 0) PG8_BAR;
    PG8_BAR;
    }
    __syncthreads();
#undef PG8_SA
#undef PG8_SB
#undef PG8_STAGE
#undef PG8_STAGE_A
#undef PG8_LDA
#undef PG8_LDB
#undef PG8_MMA
#undef PG8_WAIT_V
#undef PG8_WAIT_L
#undef PG8_BAR
#undef PG8_SCHED
}
#endif
}

constexpr int G_BM = 256, G_BN = 128, G_BK = 64;
constexpr int G_LDS_A = G_BM * G_BK * 2, G_LDS_B = G_BN * G_BK * 2;
constexpr int G_STAGE_PITCH = 132;
constexpr int G_LDS_BYTES = G_BM * G_STAGE_PITCH * 4;
constexpr int G_MT = SEQ / 256 + 1, G_NTILES = 56;

DI void gemm_inproj_tile(const Params& p, char* smem, int mt, int nt) {
    const int tid = fresh_tid(), lane = tid & 63, wave = tid >> 6;
    const int wm = wave >> 1, wn = wave & 1, r32 = lane & 31, h = lane >> 5;
    unsigned char* ws = p.ws;
    const bool meta = (mt == G_MT - 1);
    const bf16* A = meta ? (const bf16*)(ws + OFF_SMALL + SM_UMETA) : (const bf16*)(ws + OFF_U) + (size_t)mt * 256 * D;
    const int vrows = meta ? NMETA : 256;
    const bf16* Bt = (const bf16*)(ws + OFF_WTIN) + (size_t)nt * 128 * D;
    char* ldsA[2] = {smem, smem + G_LDS_A + G_LDS_B};
    char* ldsB[2] = {smem + G_LDS_A, smem + 2 * G_LDS_A + G_LDS_B};
    f32x16 acc[2][2];
#pragma unroll
    for (int i = 0; i < 2; ++i)
#pragma unroll
        for (int j = 0; j < 2; ++j) acc[i][j] = zero16();
    const int lrow = tid >> 3, lc = tid & 7;
    u32x4 ra[4], rb[2];
    auto gload = [&](int kt) {
#pragma unroll
        for (int i = 0; i < 4; ++i) { const int row = lrow + 64 * i; ra[i] = row < vrows ? *(const u32x4*)(A + (size_t)row * D + kt * 64 + lc * 8) : (u32x4){0u, 0u, 0u, 0u}; }
#pragma unroll
        for (int i = 0; i < 2; ++i) { const int row = lrow + 64 * i; rb[i] = *(const u32x4*)(Bt + (size_t)row * D + kt * 64 + lc * 8); }
    };
    auto lstore = [&](int buf) {
#pragma unroll
        for (int i = 0; i < 4; ++i) *(u32x4*)(ldsA[buf] + swz128(lrow + 64 * i, lc)) = ra[i];
#pragma unroll
        for (int i = 0; i < 2; ++i) *(u32x4*)(ldsB[buf] + swz128(lrow + 64 * i, lc)) = rb[i];
    };
    gload(0); lstore(0); __syncthreads();
    for (int kt = 0; kt < 16; ++kt) {
        const int buf = kt & 1;
        if (kt + 1 < 16) gload(kt + 1);
#pragma unroll
        for (int ks = 0; ks < 4; ++ks) {
            bf16x8 af[2], bfr[2];
#pragma unroll
            for (int i = 0; i < 2; ++i) af[i] = *(const bf16x8*)(ldsA[buf] + swz128(64 * wm + 32 * i + r32, 2 * ks + h));
#pragma unroll
            for (int j = 0; j < 2; ++j) bfr[j] = *(const bf16x8*)(ldsB[buf] + swz128(64 * wn + 32 * j + r32, 2 * ks + h));
#pragma unroll
            for (int i = 0; i < 2; ++i)
#pragma unroll
                for (int j = 0; j < 2; ++j) acc[i][j] = MFMA32(af[i], bfr[j], acc[i][j]);
        }
        if (kt + 1 < 16) lstore(buf ^ 1);
        __syncthreads();
    }
    float* st = (float*)smem;
#pragma unroll
    for (int i = 0; i < 2; ++i)
#pragma unroll
        for (int j = 0; j < 2; ++j)
#pragma unroll
            for (int r = 0; r < 16; ++r) {
                const int row = 64 * wm + 32 * i + (r & 3) + 8 * (r >> 2) + 4 * h, col = 64 * wn + 32 * j + r32;
                st[row * G_STAGE_PITCH + col] = acc[i][j][r];
            }
    __syncthreads();
    const int tid2 = fresh_tid();
    const int sec = nt >> 3, cb = (nt & 7) * 128;
    {
        bf16* base; bool has_meta = true; bf16* mbase = nullptr; int mrow0 = 0;
        if (sec == 0) { base = (bf16*)(ws + OFF_AQ); has_meta = false; }
        else if (sec == 1) { base = (bf16*)p.out; mbase = (bf16*)(ws + OFF_SMALL + SM_AKMETA); }
        else if (sec == 2) { base = (bf16*)p.out + (size_t)SEQ * D; mbase = (bf16*)(ws + OFF_SMALL + SM_AVTMETA); }
        else if (sec == 3) { base = (bf16*)(ws + OFF_QN); mbase = (bf16*)(ws + OFF_SMALL + SM_C0Q); mrow0 = 48; }
        else if (sec == 4) { base = (bf16*)(ws + OFF_KN); mbase = (bf16*)(ws + OFF_SMALL + SM_C0K); mrow0 = 48; }
        else if (sec == 5) { base = (bf16*)(ws + OFF_V); mbase = (bf16*)(ws + OFF_SMALL + SM_C0V); mrow0 = 48; }
        else { base = (bf16*)(ws + OFF_DG); has_meta = false; }
        const bool dqkv = (sec >= 3 && sec <= 5);
        bf16* tails = (bf16*)(ws + OFF_SMALL + SM_TAILS);
        if (!meta || has_meta) {
#pragma unroll
            for (int i = 0; i < 8; ++i) {
                const int idx = tid2 + NT * i, row = idx >> 4, cg = idx & 15;
                if (row < vrows) {
                    const float* s = st + row * G_STAGE_PITCH + cg * 8;
                    const f32x4 a = *(const f32x4*)s, b = *(const f32x4*)(s + 4);
                    u32x4 o; o.x = pk2(a[0], a[1]); o.y = pk2(a[2], a[3]); o.z = pk2(b[0], b[1]); o.w = pk2(b[2], b[3]);
                    if (!meta) {
                        const int j = mt * 256 + row;
                        *(u32x4*)(base + (size_t)j * D + cb + cg * 8) = o;
                        if (dqkv && (j & 63) >= 61) *(u32x4*)(tails + ((size_t)(j / 64 + 1) * 3 + ((j & 63) - 61)) * 3072 + (sec - 3) * 1024 + cb + cg * 8) = o;
                    } else if (sec == 2) {
                        mbase[(size_t)(cb + cg * 8 + 0) * NMETA + row] = (bf16)(o.x & 0xffffu); mbase[(size_t)(cb + cg * 8 + 1) * NMETA + row] = (bf16)(o.x >> 16);
                        mbase[(size_t)(cb + cg * 8 + 2) * NMETA + row] = (bf16)(o.y & 0xffffu); mbase[(size_t)(cb + cg * 8 + 3) * NMETA + row] = (bf16)(o.y >> 16);
                        mbase[(size_t)(cb + cg * 8 + 4) * NMETA + row] = (bf16)(o.z & 0xffffu); mbase[(size_t)(cb + cg * 8 + 5) * NMETA + row] = (bf16)(o.z >> 16);
                        mbase[(size_t)(cb + cg * 8 + 6) * NMETA + row] = (bf16)(o.w & 0xffffu); mbase[(size_t)(cb + cg * 8 + 7) * NMETA + row] = (bf16)(o.w >> 16);
                    } else {
                        *(u32x4*)(mbase + (size_t)(mrow0 + row) * D + cb + cg * 8) = o;
                        if (dqkv && row >= 13) *(u32x4*)(tails + ((size_t)0 * 3 + (row - 13)) * 3072 + (sec - 3) * 1024 + cb + cg * 8) = o;
                    }
                }
            }
        }
    }
    __syncthreads();
}

struct EpiInproj {
    static constexpr bool PERM = true;
    unsigned char* ws; bf16* out16;
    DM void operator()(const f32x4 (&acc)[2][2][4][2], const pg8::Unit& u, int wr, int wc, int fr, int fq) const {
        if (u.e) {
            bf16* vt = out16 + (size_t)SEQ * D + (size_t)((u.pn - 8) * 256 + wr * 64 + fr) * SEQ + u.pm * 256 + wc * 32 + 8 * fq;
#pragma unroll
            for (int ai = 0; ai < 2; ++ai)
#pragma unroll
                for (int m = 0; m < 4; ++m)
#pragma unroll
                    for (int bj = 0; bj < 2; ++bj) {
                        const f32x4 v0 = acc[ai][bj][m][0], v1 = acc[ai][bj][m][1];
                        *(u32x4*)(vt + (size_t)(ai * 128 + m * 16) * SEQ + bj * 128) = (u32x4){pk2(v0[0], v0[1]), pk2(v0[2], v0[3]), pk2(v1[0], v1[1]), pk2(v1[2], v1[3])};
                    }
            return;
        }
        const int colt = u.pn * 256, sec = colt >> 10, cb = colt & 1023;
        bf16* base = sec == 0 ? (bf16*)(ws + OFF_AQ) : sec == 1 ? out16 : sec == 2 ? out16 + (size_t)SEQ * D : sec == 3 ? (bf16*)(ws + OFF_QN) : sec == 4 ? (bf16*)(ws + OFF_KN)
                   : sec == 5 ? (bf16*)(ws + OFF_V) : (bf16*)(ws + OFF_DG);
        const bool dqkv = sec >= 3 && sec <= 5;
        bf16* tails = (bf16*)(ws + OFF_SMALL + SM_TAILS) + (sec - 3) * 1024;
        const int row0 = u.pm * 256 + wr * 64 + fr, col0 = cb + wc * 32 + 8 * fq;
#pragma unroll
        for (int ai = 0; ai < 2; ++ai)
#pragma unroll
            for (int m = 0; m < 4; ++m) {
                const int j = row0 + ai * 128 + m * 16;
                bf16* rowp = base + (size_t)j * D + col0;
                const bool tl = dqkv && (j & 63) >= 61;
#pragma unroll
                for (int bj = 0; bj < 2; ++bj) {
                    const f32x4 v0 = acc[ai][bj][m][0], v1 = acc[ai][bj][m][1];
                    const u32x4 w = {pk2(v0[0], v0[1]), pk2(v0[2], v0[3]), pk2(v1[0], v1[1]), pk2(v1[2], v1[3])};
                    *(u32x4*)(rowp + bj * 128) = w;
                    if (tl) *(u32x4*)(tails + ((size_t)(j / 64 + 1) * 3 + ((j & 63) - 61)) * 3072 + col0 + bj * 128) = w;
                }
            }
    }
};
struct InprojOrder : pg8::StaticOrder {
    DM bool next(int i, pg8::Unit& u) const { const bool ok = pg8::StaticOrder::next(i, u); if (ok) u.e = (u.pn >= 8 && u.pn < 12) ? 1 : 0; return ok; }
    DM const char* a_tile(const pg8::Gemm& g, const pg8::Unit& u) const { return u.e ? (const char*)g.Bt + (size_t)u.pn * 256 * g.K * 2 : (const char*)g.A + (size_t)u.pm * 256 * g.K * 2; }
    DM const char* b_tile(const pg8::Gemm& g, const pg8::Unit& u) const { return u.e ? (const char*)g.A + (size_t)u.pm * 256 * g.K * 2 : (const char*)g.Bt + (size_t)u.pn * 256 * g.K * 2; }
};
DI void phase1(const Params& p, char* smem, int bid, int nblk) {
    for (int it = bid; it < 40; it += nblk) gemm_inproj_tile(p, smem, G_MT - 1, 8 + it);
    pg8::Gemm g{(const bf16*)(p.ws + OFF_U), (const bf16*)(p.ws + OFF_WTIN), SEQ, 7168, 1024};
    InprojOrder S; S.init(SEQ, 7168, nblk, bid);
    EpiInproj E{p.ws, (bf16*)p.out};
    pg8::gemm_phase(smem, g, S, E);
}

constexpr int P2_KN = 0, P2_KB = 16384, P2_QN = 32768, P2_KBGT = 49152, P2_VBT = 65536, P2_KDT = 81920, P2_ALDS = 98304, P2_TLDS = P2_ALDS + 64 * 64 * 4,
              P2_GC = P2_TLDS + 8192, P2_BET = P2_GC + 256, P2_EG = P2_BET + 256, P2_EKD = P2_EG + 256, P2_CW = P2_EKD + 256;

DI void prep_item(const Params& p, char* smem, int chunk, int head, int dry, bool load_cw) {
    const int tid = fresh_tid(), lane = tid & 63, wave = tid >> 6, r32 = lane & 31, h = lane >> 5;
    unsigned char* ws = p.ws;
    float* gcl = (float*)(smem + P2_GC); float* betl = (float*)(smem + P2_BET); float* egl = (float*)(smem + P2_EG); float* ekdl = (float*)(smem + P2_EKD);
    if (load_cw) {
        float* cwl = (float*)(smem + P2_CW);
        for (int i = tid; i < 4 * 3 * 128; i += NT) { const int jj = i / 384, rem = i % 384, mat = rem >> 7, c = rem & 127; cwl[i] = p.in[9][(size_t)jj * 3072 + mat * 1024 + head * 128 + c]; }
    }
    const int r = tid >> 3, cg = tid & 7, col0 = head * 128 + 16 * cg;
    const bf16* tails = (const bf16*)(ws + OFF_SMALL + SM_TAILS);
        u32x4 raw[3][4][2];
#pragma unroll
    for (int mat = 0; mat < 3; ++mat) {
        const bf16* mainb = (const bf16*)(ws + (mat == 0 ? OFF_QN : (mat == 1 ? OFF_KN : OFF_V)));
        const bf16* c0b = (const bf16*)(ws + OFF_SMALL + (mat == 0 ? SM_C0Q : (mat == 1 ? SM_C0K : SM_C0V)));
#pragma unroll
        for (int jj = 0; jj < 4; ++jj) {
            const int rr = r - 3 + jj;
            const bf16* src = nullptr;
            if (chunk == 0) { if (rr >= 48) src = c0b + (size_t)rr * D + col0; }
            else if (rr >= 0) src = mainb + ((size_t)(chunk - 1) * 64 + rr) * D + col0;
            else src = tails + ((size_t)(chunk - 1) * 3 + (3 + rr)) * 3072 + mat * 1024 + col0;
            raw[mat][jj][0] = (u32x4){0u, 0u, 0u, 0u}; raw[mat][jj][1] = (u32x4){0u, 0u, 0u, 0u};
            if (src) { raw[mat][jj][0] = *(const u32x4*)src; raw[mat][jj][1] = *(const u32x4*)(src + 8); }
        }
    }
    if (wave == 0) {
        const size_t pos = (size_t)chunk * 64 + lane;
        float v = ((const float*)(ws + OFF_SMALL + SM_G))[pos * 8 + head];
        const float b = ((const float*)(ws + OFF_SMALL + SM_BETA))[pos * 8 + head];
#pragma unroll
        for (int o = 1; o < 64; o <<= 1) { const float t = __shfl_up(v, o); if (lane >= o) v += t; }
        const float gl = __shfl(v, 63);
        gcl[lane] = v; betl[lane] = b; egl[lane] = __expf(v); ekdl[lane] = __expf(gl - v);
        if (!dry) ((float*)(ws + OFF_SMALL + SM_GC))[((size_t)chunk * 8 + head) * 64 + lane] = v;
    }
    __syncthreads();
    {
        const bool zero_row = (chunk == 0 && r < 48);
        const float beta = betl[r], eg = egl[r], ekd = ekdl[r];
#pragma unroll
        for (int mat = 0; mat < 3; ++mat) {
            bf16* mainb = (bf16*)(ws + (mat == 0 ? OFF_QN : (mat == 1 ? OFF_KN : OFF_V)));
            bf16* c0b = (bf16*)(ws + OFF_SMALL + (mat == 0 ? SM_C0Q : (mat == 1 ? SM_C0K : SM_C0V)));
            float y[16];
#pragma unroll
            for (int c = 0; c < 16; ++c) y[c] = 0.f;
#pragma unroll
            for (int jj = 0; jj < 4; ++jj) {
                const u32x4 a = raw[mat][jj][0], b = raw[mat][jj][1];
                const float* cw = (const float*)(smem + P2_CW) + (jj * 3 + mat) * 128 + 16 * cg;
                const f32x4 w0 = *(const f32x4*)cw, w1 = *(const f32x4*)(cw + 4), w2 = *(const f32x4*)(cw + 8), w3 = *(const f32x4*)(cw + 12);
                y[0] += w0[0] * bflo(a.x); y[1] += w0[1] * bfhi(a.x); y[2] += w0[2] * bflo(a.y); y[3] += w0[3] * bfhi(a.y);
                y[4] += w1[0] * bflo(a.z); y[5] += w1[1] * bfhi(a.z); y[6] += w1[2] * bflo(a.w); y[7] += w1[3] * bfhi(a.w);
                y[8] += w2[0] * bflo(b.x); y[9] += w2[1] * bfhi(b.x); y[10] += w2[2] * bflo(b.y); y[11] += w2[3] * bfhi(b.y);
                y[12] += w3[0] * bflo(b.z); y[13] += w3[1] * bfhi(b.z); y[14] += w3[2] * bflo(b.w); y[15] += w3[3] * bfhi(b.w);
            }
            if (mat == 0) __syncthreads();
            float ss = 0.f;
#pragma unroll
            for (int c = 0; c < 16; ++c) { y[c] = zero_row ? 0.f : siluf_(y[c]); ss += y[c] * y[c]; }
            if (mat < 2) {
                ss += __shfl_xor(ss, 1); ss += __shfl_xor(ss, 2); ss += __shfl_xor(ss, 4);
                const float sc = rsqrtf(ss + 1e-6f) * (mat == 0 ? 0.08838834764831845f : 1.0f);
                unsigned pk[8];
#pragma unroll
                for (int c = 0; c < 8; ++c) pk[c] = pk2(y[2 * c] * sc, y[2 * c + 1] * sc);
                if (mat == 0) {
                    *(u32x4*)(smem + P2_QN + swzrow(r, 256, 2 * cg)) = (u32x4){pk[0], pk[1], pk[2], pk[3]};
                    *(u32x4*)(smem + P2_QN + swzrow(r, 256, 2 * cg + 1)) = (u32x4){pk[4], pk[5], pk[6], pk[7]};
                    unsigned qd[8];
#pragma unroll
                    for (int c = 0; c < 8; ++c) qd[c] = pk2(bflo(pk[c]) * eg, bfhi(pk[c]) * eg);
                    bf16* dst = (chunk == 0) ? c0b + (size_t)r * D + col0 : mainb + ((size_t)(chunk - 1) * 64 + r) * D + col0;
                    if (!dry) { *(u32x4*)dst = (u32x4){qd[0], qd[1], qd[2], qd[3]}; *(u32x4*)(dst + 8) = (u32x4){qd[4], qd[5], qd[6], qd[7]}; }
                } else {
                    *(u32x4*)(smem + P2_KN + swzrow(r, 256, 2 * cg)) = (u32x4){pk[0], pk[1], pk[2], pk[3]};
                    *(u32x4*)(smem + P2_KN + swzrow(r, 256, 2 * cg + 1)) = (u32x4){pk[4], pk[5], pk[6], pk[7]};
                    unsigned kb[8];
#pragma unroll
                    for (int c = 0; c < 8; ++c) {
                        const float kr0 = bflo(pk[c]), kr1 = bfhi(pk[c]);
                        const float k0 = kr0 * beta, k1 = kr1 * beta;
                        kb[c] = pk2(k0, k1);
                        const int d0 = 16 * cg + 2 * c;
                        *(bf16*)(smem + P2_KBGT + swz128t(d0, r >> 3) + (r & 7) * 2) = (bf16)f2bf(k0 * eg);
                        *(bf16*)(smem + P2_KBGT + swz128t(d0 + 1, r >> 3) + (r & 7) * 2) = (bf16)f2bf(k1 * eg);
                        *(bf16*)(smem + P2_KDT + swz128t(d0, r >> 3) + (r & 7) * 2) = (bf16)f2bf(kr0 * ekd);
                        *(bf16*)(smem + P2_KDT + swz128t(d0 + 1, r >> 3) + (r & 7) * 2) = (bf16)f2bf(kr1 * ekd);
                    }
                    *(u32x4*)(smem + P2_KB + swzrow(r, 256, 2 * cg)) = (u32x4){kb[0], kb[1], kb[2], kb[3]};
                    *(u32x4*)(smem + P2_KB + swzrow(r, 256, 2 * cg + 1)) = (u32x4){kb[4], kb[5], kb[6], kb[7]};
                }
            } else {
#pragma unroll
                for (int c = 0; c < 16; ++c) {
                    const int e = 16 * cg + c;
                    *(bf16*)(smem + P2_VBT + swz128t(e, r >> 3) + (r & 7) * 2) = (bf16)f2bf(y[c] * beta);
                }
            }
        }
    }
    __syncthreads();
    {
        const int tile = wave & 3, m0 = tile >> 1, n0 = tile & 1;
        f32x16 acc = zero16();
        if (wave < 4) {
            if (n0 <= m0) {
#pragma unroll
                for (int ks = 0; ks < 8; ++ks) {
                    const bf16x8 a = *(const bf16x8*)(smem + P2_KB + swzrow(32 * m0 + r32, 256, 2 * ks + h));
                    const bf16x8 b = *(const bf16x8*)(smem + P2_KN + swzrow(32 * n0 + r32, 256, 2 * ks + h));
                    acc = MFMA32(a, b, acc);
                }
            }
            float* Al = (float*)(smem + P2_ALDS);
            const int j = 32 * n0 + r32; const float gj = gcl[j];
#pragma unroll
            for (int r = 0; r < 16; ++r) {
                const int i = 32 * m0 + (r & 3) + 8 * (r >> 2) + 4 * h;
                const float dv = acc[r] * __expf(gcl[i] - gj);
                Al[i * 64 + (j & 3) * 16 + (j >> 2)] = (j < i) ? dv : 0.f;
            }
        } else {
            if (m0 <= n0) {
#pragma unroll
                for (int ks = 0; ks < 8; ++ks) {
                    const bf16x8 a = *(const bf16x8*)(smem + P2_KN + swzrow(32 * m0 + r32, 256, 2 * ks + h));
                    const bf16x8 b = *(const bf16x8*)(smem + P2_QN + swzrow(32 * n0 + r32, 256, 2 * ks + h));
                    acc = MFMA32(a, b, acc);
                }
            }
            const int i = 32 * n0 + r32; const float gi = gcl[i];
            bf16* qkb = (chunk == 0) ? (bf16*)(ws + OFF_SMALL + SM_C0QK) + (size_t)head * 4096 : (bf16*)(ws + OFF_QKB) + ((size_t)(chunk - 1) * 8 + head) * 4096;
#pragma unroll
            for (int q4 = 0; q4 < 4; ++q4) {
                const int j0 = 32 * m0 + 8 * q4 + 4 * h; float v[4];
#pragma unroll
                for (int c = 0; c < 4; ++c) { const int j = j0 + c; const float dv = acc[4 * q4 + c] * __expf(gi - gcl[j]); v[c] = (j <= i) ? dv : 0.f; }
                if (!dry) *(u32x2*)(qkb + i * 64 + j0) = (u32x2){pk2(v[0], v[1]), pk2(v[2], v[3])};
            }
        }
        bf16* kbase = (chunk == 0) ? (bf16*)(ws + OFF_SMALL + SM_C0K) : (bf16*)(ws + OFF_KN) + (size_t)(chunk - 1) * 64 * D;
#pragma unroll
        for (int i2 = 0; i2 < 2; ++i2) {
            const int idx = tid + NT * i2, dk = idx >> 3, ch = idx & 7;
            const u32x4 v = *(const u32x4*)(smem + P2_KDT + swz128t(dk, ch));
            if (!dry) *(u32x4*)(kbase + (size_t)(dk >> 1) * D + head * 128 + (dk & 1) * 64 + ch * 8) = v;
        }
    }
    __syncthreads();
    if (wave < 4) {
        const float* Al = (const float*)(smem + P2_ALDS);
        const int c = lane >> 2, q = lane & 3, C = 16 * wave + c;
        float tq[16];
#pragma unroll
        for (int m = 0; m < 16; ++m) tq[m] = 0.f;
#pragma unroll
        for (int P = 0; P < 4; ++P) {
            float pre[16];
#pragma unroll
            for (int ii = 0; ii < 16; ++ii) {
                const float* ar = Al + (16 * P + ii) * 64 + q * 16;
                float s0 = 0.f, s1 = 0.f;
#pragma unroll
                for (int m = 0; m < 4 * P; ++m) { if (m & 1) s1 += ar[m] * tq[m]; else s0 += ar[m] * tq[m]; }
                pre[ii] = s0 + s1;
            }
#pragma unroll
            for (int ii = 0; ii < 16; ++ii) {
                const int i = 16 * P + ii;
                const float* ar = Al + i * 64 + q * 16;
                const int nm = (i + 3) >> 2;
                float s = pre[ii];
#pragma unroll
                for (int m = 4 * P; m < 4 * P + 4; ++m) if (m < nm) s += ar[m] * tq[m];
                s += __shfl_xor(s, 1); s += __shfl_xor(s, 2);
                const float ti = ((i == C) ? 1.f : 0.f) - s;
                if (q == (i & 3)) tq[i >> 2] = ti;
            }
        }
#pragma unroll
        for (int m = 0; m < 16; ++m) { const int row = 4 * m + q; *(bf16*)(smem + P2_TLDS + swz128(row, C >> 3) + (C & 7) * 2) = (bf16)f2bf(tq[m]); }
    }
    __syncthreads();
    {
        const int mi = wave >> 2, ni = wave & 3;
        f32x16 acc = zero16();
#pragma unroll
        for (int ks = 0; ks < 4; ++ks) {
            const bf16x8 a = *(const bf16x8*)(smem + P2_TLDS + swz128(32 * mi + r32, 2 * ks + h));
            const bf16x8 b = *(const bf16x8*)(smem + P2_VBT + swz128t(32 * ni + r32, 2 * ks + h));
            acc = MFMA32(a, b, acc);
        }
        const int e = 32 * ni + r32;
        bf16* base = (chunk == 0) ? (bf16*)(ws + OFF_SMALL + SM_C0V) : (bf16*)(ws + OFF_V) + (size_t)(chunk - 1) * 64 * D;
        bf16* dst = base + (size_t)(e >> 1) * D + head * 128 + (e & 1) * 64;
#pragma unroll
        for (int q4 = 0; q4 < 4; ++q4) {
            const int c0 = 32 * mi + 8 * q4 + 4 * h;
            if (!dry) *(u32x2*)(dst + c0) = (u32x2){pk2(acc[4 * q4], acc[4 * q4 + 1]), pk2(acc[4 * q4 + 2], acc[4 * q4 + 3])};
        }
    }
    {
        const int mi = wave >> 1, ni = wave & 1;
        f32x16 acc = zero16();
#pragma unroll
        for (int ks = 0; ks < 4; ++ks) {
            const bf16x8 a = *(const bf16x8*)(smem + P2_KBGT + swz128t(32 * mi + r32, 2 * ks + h));
            const bf16x8 b = *(const bf16x8*)(smem + P2_TLDS + swz128(32 * ni + r32, 2 * ks + h));
            acc = MFMA32(a, b, acc);
        }
        const int c = 32 * ni + r32;
        bf16* wb = (chunk == 0) ? (bf16*)(ws + OFF_SMALL + SM_C0W) + (size_t)head * 8192 : (bf16*)(ws + OFF_W) + ((size_t)(chunk - 1) * 8 + head) * 8192;
#pragma unroll
        for (int q4 = 0; q4 < 4; ++q4) {
            const int dk0 = 32 * mi + 8 * q4 + 4 * h;
            if (!dry) *(u32x2*)(wb + c * 128 + dk0) = (u32x2){pk2(acc[4 * q4], acc[4 * q4 + 1]), pk2(acc[4 * q4 + 2], acc[4 * q4 + 3])};
        }
    }
    __syncthreads();
}

DI void phase2(const Params& p, char* smem, int bid, int nblk, int dry = 0) {
    { int cur_head = -1; for (int it = bid; it < NCH * 8; it += nblk) { const int hd = it & 7; prep_item(p, smem, it >> 3, hd, dry, hd != cur_head); cur_head = hd; } }
    {
        const int tid = fresh_tid(), lane = tid & 63, wave = tid >> 6;
        const int nextra = (NCH * 8) % nblk, skip = (nextra > 0 && 2 * nextra < nblk) ? nextra : 0;
        const int gw = (bid - skip) * 8 + wave, NGW = (nblk - skip) * 8;
        float mq = 0.f, mk = 0.f;
        auto sq16 = [](const u32x4& a, const u32x4& b) -> float {
            return bflo(a.x) * bflo(a.x) + bfhi(a.x) * bfhi(a.x) + bflo(a.y) * bflo(a.y) + bfhi(a.y) * bfhi(a.y) + bflo(a.z) * bflo(a.z) + bfhi(a.z) * bfhi(a.z) + bflo(a.w) * bflo(a.w) + bfhi(a.w) * bfhi(a.w)
                 + bflo(b.x) * bflo(b.x) + bfhi(b.x) * bfhi(b.x) + bflo(b.y) * bflo(b.y) + bfhi(b.y) * bfhi(b.y) + bflo(b.z) * bflo(b.z) + bfhi(b.z) * bfhi(b.z) + bflo(b.w) * bflo(b.w) + bfhi(b.w) * bfhi(b.w); };
        for (int j0 = (bid < skip ? SEQ + NMETA : gw); j0 < SEQ + NMETA; j0 += 4 * NGW) {
            u32x4 ka[4][2], qa[4][2];
#pragma unroll
            for (int u4 = 0; u4 < 4; ++u4) {
                const int j = j0 + u4 * NGW;
                ka[u4][0] = ka[u4][1] = qa[u4][0] = qa[u4][1] = (u32x4){0u, 0u, 0u, 0u};
                if (j < SEQ + NMETA) {
                    const bf16* kr = j < SEQ ? (const bf16*)p.out + (size_t)j * D + lane * 16 : (const bf16*)(p.ws + OFF_SMALL + SM_AKMETA) + (size_t)(j - SEQ) * D + lane * 16;
                    ka[u4][0] = *(const u32x4*)kr; ka[u4][1] = *(const u32x4*)(kr + 8);
                    if (j < SEQ) { const bf16* qr = (const bf16*)(p.ws + OFF_AQ) + (size_t)j * D + lane * 16; qa[u4][0] = *(const u32x4*)qr; qa[u4][1] = *(const u32x4*)(qr + 8); }
                }
            }
#pragma unroll
            for (int u4 = 0; u4 < 4; ++u4) {
                float s = sq16(ka[u4][0], ka[u4][1]), t = sq16(qa[u4][0], qa[u4][1]);
                s += __shfl_xor(s, 1); s += __shfl_xor(s, 2); t += __shfl_xor(t, 1); t += __shfl_xor(t, 2);
                mk = fmaxf(mk, s); mq = fmaxf(mq, t);
            }
        }
        float* red = (float*)smem;
        __syncthreads();
        if ((lane & 3) == 0) { red[wave * 32 + (lane >> 2)] = mq; red[wave * 32 + 16 + (lane >> 2)] = mk; }
        __syncthreads();
        if (tid < 32) {
            float m = 0.f;
#pragma unroll
            for (int w = 0; w < 8; ++w) m = fmaxf(m, red[w * 32 + tid]);
            unsigned* nrm = (unsigned*)(p.ws + OFF_SMALL + SM_CTL) + CW_NRM;
            atomicMax(nrm + tid, __builtin_bit_cast(unsigned, m));
        }
        __syncthreads();
    }
}

DI int swzrow8(int row, int pitch, int s) { return row * pitch + ((((s >> 1) ^ (row & 15)) << 4) | ((s & 1) << 3)); }
DI bf16x8 pack8(f32x4 a, f32x4 b) {
    u32x4 o; o.x = pk2(a[0], a[1]); o.y = pk2(a[2], a[3]); o.z = pk2(b[0], b[1]); o.w = pk2(b[2], b[3]);
    return __builtin_bit_cast(bf16x8, o);
}
DI bf16x8 ld2x8(const char* p0, const char* p1) {
    const u32x2 a = *(const u32x2*)p0, b = *(const u32x2*)p1; u32x4 o; o.x = a.x; o.y = a.y; o.z = b.x; o.w = b.y;
    return __builtin_bit_cast(bf16x8, o);
}
constexpr int SC_W = 0, SC_QD = 16384, SC_KDT = 32768, SC_QK = 49152, SC_BUF = 57344;

constexpr int SCAN_SPLIT = 2;
DI void scan_head(const Params& p, char* smem, int head, int sidx, int dry) {
    const int tid = fresh_tid(), lane = tid & 63, wave = tid >> 6, r16 = lane & 15, g = lane >> 4;
    const bool active = wave < 8 / SCAN_SPLIT; const int slice = sidx * (8 / SCAN_SPLIT) + (active ? wave : 0);
    unsigned char* ws = p.ws;
    const int lrow = tid >> 3, lch = (tid & 7) * 2;
    f32x4 S[8];
#pragma unroll
    for (int i = 0; i < 8; ++i) S[i] = zero4();
    u32x4 rw[2], rq[2], rk[2], rqk; u32x2 unext[4], ucur[4]; float gnext = 0.f, gcur = 0.f;
    auto uaddr = [&](int n, int mt) -> bf16* {
        const int e = 16 * slice + r16;
        bf16* base = n == 0 ? (bf16*)(ws + OFF_SMALL + SM_C0V) : (bf16*)(ws + OFF_V) + (size_t)(n - 1) * 64 * D;
        return base + (size_t)(e >> 1) * D + head * 128 + (e & 1) * 64 + 16 * mt + 4 * g;
    };
    auto gloadA = [&](int n) {
        const bf16* wsrc = (n == 0 ? (const bf16*)(ws + OFF_SMALL + SM_C0W) + (size_t)head * 8192 : (const bf16*)(ws + OFF_W) + ((size_t)(n - 1) * 8 + head) * 8192) + lrow * 128 + lch * 8;
        rw[0] = *(const u32x4*)wsrc; rw[1] = *(const u32x4*)(wsrc + 8);
        const bf16* qs = (n == 0 ? (const bf16*)(ws + OFF_SMALL + SM_C0Q) : (const bf16*)(ws + OFF_QN) + (size_t)(n - 1) * 64 * D) + (size_t)lrow * D + head * 128 + lch * 8;
        rq[0] = *(const u32x4*)qs; rq[1] = *(const u32x4*)(qs + 8);
        const bf16* ks = (n == 0 ? (const bf16*)(ws + OFF_SMALL + SM_C0K) : (const bf16*)(ws + OFF_KN) + (size_t)(n - 1) * 64 * D) + (size_t)lrow * D + head * 128 + lch * 8;
        rk[0] = *(const u32x4*)ks; rk[1] = *(const u32x4*)(ks + 8);
        const bf16* qk = (n == 0 ? (const bf16*)(ws + OFF_SMALL + SM_C0QK) + (size_t)head * 4096 : (const bf16*)(ws + OFF_QKB) + ((size_t)(n - 1) * 8 + head) * 4096) + tid * 8;
        rqk = *(const u32x4*)qk;
    };
    auto gloadU = [&](int n) {
#pragma unroll
        for (int mt = 0; mt < 4; ++mt) unext[mt] = *(const u32x2*)uaddr(n, mt);
        gnext = ((const float*)(ws + OFF_SMALL + SM_GC))[((size_t)n * 8 + head) * 64 + 63];
    };
    auto lwrite = [&](int buf) {
        char* b = smem + buf * SC_BUF;
        const int c7 = tid & 7, kb = c7 >> 1, hf = c7 & 1;
        {
            char* w = b + SC_W + lrow * 256 + hf * 8; char* q = b + SC_QD + lrow * 256 + hf * 8; const int x = lrow & 15;
            *(u32x2*)(w + (((4 * kb + 0) ^ x) << 4)) = (u32x2){rw[0].x, rw[0].y}; *(u32x2*)(w + (((4 * kb + 1) ^ x) << 4)) = (u32x2){rw[0].z, rw[0].w};
            *(u32x2*)(w + (((4 * kb + 2) ^ x) << 4)) = (u32x2){rw[1].x, rw[1].y}; *(u32x2*)(w + (((4 * kb + 3) ^ x) << 4)) = (u32x2){rw[1].z, rw[1].w};
            *(u32x2*)(q + (((4 * kb + 0) ^ x) << 4)) = (u32x2){rq[0].x, rq[0].y}; *(u32x2*)(q + (((4 * kb + 1) ^ x) << 4)) = (u32x2){rq[0].z, rq[0].w};
            *(u32x2*)(q + (((4 * kb + 2) ^ x) << 4)) = (u32x2){rq[1].x, rq[1].y}; *(u32x2*)(q + (((4 * kb + 3) ^ x) << 4)) = (u32x2){rq[1].z, rq[1].w};
        }
        {
            const int dk = 2 * lrow + (c7 >> 2), kb2 = (c7 & 3) >> 1, x = (dk >> 1) & 7;
            char* kt = b + SC_KDT + dk * 128 + hf * 8;
            *(u32x2*)(kt + (((4 * kb2 + 0) ^ x) << 4)) = (u32x2){rk[0].x, rk[0].y}; *(u32x2*)(kt + (((4 * kb2 + 1) ^ x) << 4)) = (u32x2){rk[0].z, rk[0].w};
            *(u32x2*)(kt + (((4 * kb2 + 2) ^ x) << 4)) = (u32x2){rk[1].x, rk[1].y}; *(u32x2*)(kt + (((4 * kb2 + 3) ^ x) << 4)) = (u32x2){rk[1].z, rk[1].w};
        }
        {
            const int row = tid >> 3, kb2 = c7 >> 2, g0 = 2 * (c7 & 1), hf2 = (c7 >> 1) & 1, x = (row >> 1) & 7;
            char* qk = b + SC_QK + row * 128 + hf2 * 8;
            *(u32x2*)(qk + (((4 * kb2 + g0) ^ x) << 4)) = (u32x2){rqk.x, rqk.y}; *(u32x2*)(qk + (((4 * kb2 + g0 + 1) ^ x) << 4)) = (u32x2){rqk.z, rqk.w};
        }
    };
    gloadA(0); gloadU(0);
    lwrite(0);
#pragma unroll
    for (int mt = 0; mt < 4; ++mt) ucur[mt] = unext[mt];
    gcur = gnext;
    if (NCH > 1) gloadA(1);
    __syncthreads();
    for (int n = 0; n < NCH; ++n) {
        const char* b = smem + (n & 1) * SC_BUF;
        if (n + 1 < NCH) { lwrite((n + 1) & 1); gloadU(n + 1); }
        if (n + 2 < NCH) gloadA(n + 2);
        if (active) {
        const float gtot = __expf(gcur);
        bf16x8 sf[4];
#pragma unroll
        for (int kb = 0; kb < 4; ++kb) sf[kb] = pack8(S[2 * kb], S[2 * kb + 1]);
        f32x4 Vn[4], O[4];
#pragma unroll
        for (int mt = 0; mt < 4; ++mt) {
            f32x4 P = zero4(), Q = zero4();
            const int row = 16 * mt + r16;
#pragma unroll
            for (int kb = 0; kb < 4; ++kb) {
                const bf16x8 wf = *(const bf16x8*)(b + SC_W + swzrow(row, 256, 4 * kb + g));
                const bf16x8 qf = *(const bf16x8*)(b + SC_QD + swzrow(row, 256, 4 * kb + g));
                P = MFMA16(wf, sf[kb], P);
                Q = MFMA16(qf, sf[kb], Q);
            }
            const float u0 = bflo(ucur[mt].x), u1 = bfhi(ucur[mt].x), u2 = bflo(ucur[mt].y), u3 = bfhi(ucur[mt].y);
            Vn[mt] = (f32x4){u0 - P[0], u1 - P[1], u2 - P[2], u3 - P[3]};
            O[mt] = Q;
        }
        const bf16x8 vf[2] = {pack8(Vn[0], Vn[1]), pack8(Vn[2], Vn[3])};
#pragma unroll
        for (int mt = 0; mt < 8; ++mt) {
            const int row = 16 * mt + r16;
            f32x4 acc = S[mt] * gtot;
#pragma unroll
            for (int kb = 0; kb < 2; ++kb) {
                const bf16x8 kf = *(const bf16x8*)(b + SC_KDT + swz128(row, 4 * kb + g));
                acc = MFMA16(kf, vf[kb], acc);
            }
            S[mt] = acc;
        }
#pragma unroll
        for (int mt = 0; mt < 4; ++mt) {
            const int row = 16 * mt + r16;
#pragma unroll
            for (int kb = 0; kb < 2; ++kb) {
                const bf16x8 qk = *(const bf16x8*)(b + SC_QK + swz128(row, 4 * kb + g));
                O[mt] = MFMA16(qk, vf[kb], O[mt]);
            }
            if (n >= 1 && !dry) *(u32x2*)uaddr(n, mt) = (u32x2){pk2(O[mt][0], O[mt][1]), pk2(O[mt][2], O[mt][3])};
        }
        }
#pragma unroll
        for (int mt = 0; mt < 4; ++mt) ucur[mt] = unext[mt];
        gcur = gnext;
        __syncthreads();
    }
}

constexpr int AT_BUF = 32768, AT_MISC = 65536, NQB = SEQ / 128, AT_UNITS = 8 * NQB;
DI int vt_off8(int e, int s) { return e * 128 + ((s ^ ((e >> 1) & 15)) << 3); }

DI void attention_unit(const Params& p, char* smem, int head, int qb, float lam, int dry, float bound) {
    const int tid = fresh_tid(), lane = tid & 63, wave = tid >> 6, r32 = lane & 31, h = lane >> 5;
    const int wq = wave & 3, mp = wave >> 2;
    unsigned char* ws = p.ws;
    const bf16* AK = (const bf16*)p.out; const bf16* AVT = (const bf16*)p.out + (size_t)SEQ * D;
    const int q0 = 128 * qb, qpos = q0 + 32 * wq + r32;
    const float c1 = 0.125f * LOG2E, c2 = exp2f(-(float)(head + 1)) * LOG2E;
    bf16x8 Qf[4];
    {
        const bf16* qsrc = (const bf16*)(ws + OFF_AQ) + (size_t)qpos * D + head * 128 + mp * 64 + 8 * h;
#pragma unroll
        for (int ks = 0; ks < 4; ++ks) {
            const u32x4 v = *(const u32x4*)(qsrc + 16 * ks); u32x4 o;
            o.x = pk2(bflo(v.x) * c1, bfhi(v.x) * c1); o.y = pk2(bflo(v.y) * c1, bfhi(v.y) * c1); o.z = pk2(bflo(v.z) * c1, bfhi(v.z) * c1); o.w = pk2(bflo(v.w) * c1, bfhi(v.w) * c1);
            Qf[ks] = __builtin_bit_cast(bf16x8, o);
        }
    }
    f32x16 O[4];
#pragma unroll
    for (int i = 0; i < 4; ++i) O[i] = zero16();
    float l_run = 0.f; const float mfix = fminf(bound, 40.0f);
    const float wdist = (150.0f + 2.0f * bound) / c2;
    int ntiles = 2 * qb + 3;
    {
        const float lim = (float)q0 - 63.0f - wdist;
        int ktmin = 0;
        if (lim > 0.f) ktmin = (int)(lim * (1.0f / 64.0f));
        const bool keep_meta = !((float)(q0 + NMETA - 15) > wdist);
        if (ktmin > 0 || !keep_meta) ntiles = (2 * qb + 1 - ktmin + 1) + (keep_meta ? 1 : 0);
    }
    const int nreal = (ntiles == 2 * qb + 3) ? 2 * qb + 2 : ntiles;
    const int kkey = tid >> 3, kcc = (tid & 7) * 2;
    const int ve = tid >> 2, vp = tid & 3;
    u32x4 rk[2], rv[2];
    auto tile_kt = [&](int it) -> int { return it < nreal ? 2 * qb + 1 - it : -1; };
    auto gload = [&](int it) {
        const int kt = tile_kt(it);
        if (kt >= 0) {
            const bf16* ks = AK + ((size_t)kt * 64 + kkey) * D + head * 128 + kcc * 8;
            rk[0] = *(const u32x4*)ks; rk[1] = *(const u32x4*)(ks + 8);
            const bf16* vs = AVT + (size_t)(head * 128 + ve) * SEQ + (size_t)kt * 64 + vp * 16;
            rv[0] = *(const u32x4*)vs; rv[1] = *(const u32x4*)(vs + 8);
        } else {
            rk[0] = rk[1] = rv[0] = rv[1] = (u32x4){0u, 0u, 0u, 0u};
            if (kkey < NMETA) { const bf16* ks = (const bf16*)(ws + OFF_SMALL + SM_AKMETA) + (size_t)kkey * D + head * 128 + kcc * 8; rk[0] = *(const u32x4*)ks; rk[1] = *(const u32x4*)(ks + 8); }
            if (vp == 0) { const bf16* vs = (const bf16*)(ws + OFF_SMALL + SM_AVTMETA) + (size_t)(head * 128 + ve) * NMETA; rv[0] = *(const u32x4*)vs; rv[1] = *(const u32x4*)(vs + 8); }
        }
    };
    auto lwrite = [&](int buf) {
        char* kb = smem + buf * AT_BUF + (kcc >> 3) * 8192;
        const int krow = (kkey & ~12) | ((kkey & 4) << 1) | ((kkey & 8) >> 1);
        *(u32x4*)(kb + swz128(krow, kcc & 7)) = rk[0]; *(u32x4*)(kb + swz128(krow, (kcc & 7) + 1)) = rk[1];
        char* vbase = smem + buf * AT_BUF + 16384;
        *(u32x4*)(vbase + swz128(ve, 2 * vp)) = rv[0]; *(u32x4*)(vbase + swz128(ve, 2 * vp + 1)) = rv[1];
    };
    auto tile_body = [&](auto mode_tag, int buf, int kdist0, int klim) {
        constexpr bool MASKED = decltype(mode_tag)::value;
        const char* kb = smem + buf * AT_BUF + mp * 8192;
        const char* vb = smem + buf * AT_BUF + 16384;
        f32x16 s[2];
#pragma unroll
        for (int sub = 0; sub < 2; ++sub) {
            f32x16 acc;
            const float base = -c2 * (float)(kdist0 - 32 * sub - 8 * h) - mfix;
#pragma unroll
            for (int r = 0; r < 16; ++r) acc[r] = base + c2 * (float)((r & 7) + 16 * (r >> 3));
#pragma unroll
            for (int ks = 0; ks < 4; ++ks) {
                const bf16x8 a = *(const bf16x8*)(kb + swz128(32 * sub + r32, 2 * ks + h));
                acc = MFMA32(a, Qf[ks], acc);
            }
            if (MASKED) {
#pragma unroll
                for (int r = 0; r < 16; ++r) { const int key = 32 * sub + (r & 7) + 16 * (r >> 3) + 8 * h; if (key > klim) acc[r] = -1e30f; }
            }
            s[sub] = acc;
        }
        float ls = 0.f;
#pragma unroll
        for (int sub = 0; sub < 2; ++sub) {
#pragma unroll
            for (int r = 0; r < 16; ++r) { const float pv = EXP2F(s[sub][r]); s[sub][r] = pv; ls += pv; }
            bf16x8 Pf[2];
#pragma unroll
            for (int ss = 0; ss < 2; ++ss) {
                u32x4 o; o.x = pk2(s[sub][8 * ss], s[sub][8 * ss + 1]); o.y = pk2(s[sub][8 * ss + 2], s[sub][8 * ss + 3]);
                o.z = pk2(s[sub][8 * ss + 4], s[sub][8 * ss + 5]); o.w = pk2(s[sub][8 * ss + 6], s[sub][8 * ss + 7]);
                Pf[ss] = __builtin_bit_cast(bf16x8, o);
            }
            SETPRIO(1);
#pragma unroll
            for (int et = 0; et < 4; ++et) {
                const int e = 32 * et + r32;
#pragma unroll
                for (int ss = 0; ss < 2; ++ss) {
                    const bf16x8 a = *(const bf16x8*)(vb + swz128(e, 4 * sub + 2 * ss + h));
                    O[et] = MFMA32(a, Pf[ss], O[et]);
                }
            }
            SETPRIO(0);
            SCHED_FENCE();
        }
        l_run += ls;
    };
    gload(0); lwrite(0); __syncthreads();
    for (int it = 0; it < ntiles; ++it) {
        const int buf = it & 1, kt = tile_kt(it);
        if (it + 1 < ntiles) gload(it + 1);
        const int k0 = kt * 64;
        if (kt >= 0 && k0 > q0 + 32 * wq + 31) {   }
        else if (kt >= 0 && k0 + 63 <= q0 + 32 * wq) tile_body(std::false_type{}, buf, qpos - k0, 0);
        else tile_body(std::true_type{}, buf, kt < 0 ? NMETA + qpos : qpos - k0, kt < 0 ? NMETA - 1 : qpos - k0);
        if (it + 1 < ntiles) lwrite(buf ^ 1);
        __syncthreads();
    }
    {
        const int tid = fresh_tid(), lane = tid & 63, wave = tid >> 6, r32 = lane & 31, h = lane >> 5, wq = wave & 3, mp = wave >> 2;
        const int qpos = 128 * qb + 32 * wq + r32;
        const float lt = l_run + xhalf(l_run);
        const float inv = 1.0f / lt;
        float* X = (float*)smem;
        if (mp == 1) {
#pragma unroll
            for (int et = 0; et < 4; ++et)
#pragma unroll
                for (int r = 0; r < 16; ++r) { const int e = 32 * et + (r & 3) + 8 * (r >> 2) + 4 * h; X[(wq * 128 + e) * 32 + r32] = O[et][r] * inv; }
        }
        __syncthreads();
        if (mp == 0) {
            float ssq = 0.f;
#pragma unroll
            for (int et = 0; et < 4; ++et)
#pragma unroll
                for (int r = 0; r < 16; ++r) { const int e = 32 * et + (r & 3) + 8 * (r >> 2) + 4 * h; const float d = O[et][r] * inv - lam * X[(wq * 128 + e) * 32 + r32]; O[et][r] = d; ssq += d * d; }
            ssq += xhalf(ssq);
            const float rstd = rsqrtf(ssq * (1.0f / 128.0f) + NORM_EPS) * 0.8f;
            bf16* dst = (bf16*)(ws + OFF_AQ) + (size_t)qpos * D + head * 128;
            const float* sw = p.in[8];
#pragma unroll
            for (int et = 0; et < 4; ++et)
#pragma unroll
                for (int q4 = 0; q4 < 4; ++q4) {
                    const int e0 = 32 * et + 8 * q4 + 4 * h;
                    const f32x4 w4 = *(const f32x4*)(sw + e0);
                    if (!dry) *(u32x2*)(dst + e0) = (u32x2){pk2(O[et][4 * q4] * rstd * w4[0], O[et][4 * q4 + 1] * rstd * w4[1]), pk2(O[et][4 * q4 + 2] * rstd * w4[2], O[et][4 * q4 + 3] * rstd * w4[3])};
                }
        }
        __syncthreads();
    }
}

DI void phase3(const Params& p, char* smem, int bid, int nblk, int dry = 0, int mode = 3) {
    if (mode & 1) for (int it = bid; it < 8 * SCAN_SPLIT; it += nblk) scan_head(p, smem, it / SCAN_SPLIT, it % SCAN_SPLIT, dry);
    if (!(mode & 2)) return;
    float d1 = 0.f, d2 = 0.f;
    for (int i = 0; i < 64; ++i) { d1 += p.in[4][i] * p.in[5][i]; d2 += p.in[6][i] * p.in[7][i]; }
    const float lam = __expf(d1) - __expf(d2) + 0.2f;
    unsigned* q = (unsigned*)(p.ws + OFF_SMALL + SM_CTL) + CW_ATTQ + (dry ? 16 : 0);
    for (;;) {
        if (threadIdx.x == 0) *(unsigned*)(smem + AT_MISC) = atomicAdd(q, 1u);
        __syncthreads();
        const unsigned u = *(unsigned*)(smem + AT_MISC);
        __syncthreads();
        if (u >= (unsigned)AT_UNITS) break;
        const int hd = (int)(u & 7u);
        const unsigned* nrm = (const unsigned*)(p.ws + OFF_SMALL + SM_CTL) + CW_NRM;
        float bnd = 0.f;
        for (int m2 = 0; m2 < 2; ++m2) {
            const float q2 = __builtin_bit_cast(float, LD_ATOMIC(nrm + 2 * hd + m2)), k2 = __builtin_bit_cast(float, LD_ATOMIC(nrm + 16 + 2 * hd + m2));
            bnd = fmaxf(bnd, sqrtf(q2 * k2) * (0.125f * LOG2E) * 1.02f);
        }
        attention_unit(p, smem, hd, NQB - 1 - (int)(u >> 3), lam, dry, bnd);
    }
}

DI void phase4(const Params& p, char* smem, int bid, int nblk) {
    const int tid = fresh_tid(), lane = tid & 63, wave = tid >> 6;
    const int gw = bid * 8 + wave, NGW = nblk * 8;
    unsigned char* ws = p.ws;
    char* wl = smem + wave * 16384;
    for (int it = gw; it < 32 * 384; it += NGW) {
        const int e = it / 384, r = it % 384, m = r >> 7, q = r & 127;
        if (m < 2) transpose_item(p.in[21 + m] + (size_t)e * 1024 * 256, 256, 1024, (bf16*)(ws + OFF_EXG) + (size_t)e * 512 * 1024, (q >> 3) * 64, (q & 7) * 32, (q & 7) * 32, (float*)wl, lane, m + 1);
        else transpose_item(p.in[23] + (size_t)e * 256 * 1024, 1024, 256, (bf16*)(ws + OFF_EXD) + (size_t)e * 1024 * 256, (q >> 5) * 64, (q & 31) * 32, (q & 31) * 32, (float*)wl, lane);
    }
    for (int R = gw; R < SEQ; R += NGW) {
        const float* xrow = p.in[0] + (size_t)R * D; bf16* urow = (bf16*)(ws + OFF_U) + (size_t)R * D;
        float4 v[4]; float ss = 0.f;
#pragma unroll
        for (int j = 0; j < 4; ++j) { v[j] = *(const float4*)(xrow + 4 * lane + 256 * j); ss += v[j].x * v[j].x + v[j].y * v[j].y + v[j].z * v[j].z + v[j].w * v[j].w; }
        ss = wave_sum(ss);
        const float rstd = rsqrtf(ss * (1.0f / D) + NORM_EPS);
#pragma unroll
        for (int j = 0; j < 4; ++j) {
            const float4 w4 = *(const float4*)(p.in[2] + 4 * lane + 256 * j);
            *(u32x2*)(urow + 4 * lane + 256 * j) = (u32x2){pk2(v[j].x * rstd * w4.x, v[j].y * rstd * w4.y), pk2(v[j].z * rstd * w4.z, v[j].w * rstd * w4.w)};
        }
    }
    for (int it = gw; it < (NCH - 1) * 8; it += NGW) {
        const int cm1 = it >> 3, head = it & 7;
        const bf16* reg = (const bf16*)(ws + OFF_V) + (size_t)cm1 * 64 * D + head * 128;
#pragma unroll 4
        for (int i = 0; i < 16; ++i) { const int row = i * 4 + (lane >> 4), ch = lane & 15; *(u32x4*)(wl + row * 256 + ch * 16) = *(const u32x4*)(reg + (size_t)row * D + ch * 8); }
        WAVE_SYNC();
        float ss = 0.f;
#pragma unroll 8
        for (int dv = 0; dv < 128; ++dv) { const float v = bf2f(*(const bf16*)(wl + (dv >> 1) * 256 + ((dv & 1) * 64 + lane) * 2)); ss += v * v; }
        const float rstd = rsqrtf(ss * (1.0f / 128.0f) + NORM_EPS);
        const size_t j = (size_t)cm1 * 64 + lane;
        const bf16* gsrc = (const bf16*)(ws + OFF_DG) + j * D + head * 128;
        bf16* dst = (bf16*)(ws + OFF_OD) + j * D + head * 128;
#pragma unroll 2
        for (int d8 = 0; d8 < 16; ++d8) {
            const u32x4 gv = *(const u32x4*)(gsrc + 8 * d8);
            const f32x4 w0 = *(const f32x4*)(p.in[12] + 8 * d8), w1 = *(const f32x4*)(p.in[12] + 8 * d8 + 4);
            float o[8];
#pragma unroll
            for (int c = 0; c < 8; ++c) { const int dv = 8 * d8 + c; o[c] = bf2f(*(const bf16*)(wl + (dv >> 1) * 256 + ((dv & 1) * 64 + lane) * 2)) * rstd; }
            o[0] *= w0[0] * siluf_(bflo(gv.x)); o[1] *= w0[1] * siluf_(bfhi(gv.x)); o[2] *= w0[2] * siluf_(bflo(gv.y)); o[3] *= w0[3] * siluf_(bfhi(gv.y));
            o[4] *= w1[0] * siluf_(bflo(gv.z)); o[5] *= w1[1] * siluf_(bfhi(gv.z)); o[6] *= w1[2] * siluf_(bflo(gv.w)); o[7] *= w1[3] * siluf_(bfhi(gv.w));
            *(u32x4*)(dst + 8 * d8) = (u32x4){pk2(o[0], o[1]), pk2(o[2], o[3]), pk2(o[4], o[5]), pk2(o[6], o[7])};
        }
        WAVE_SYNC();
    }
}

template <int NB, int NI>
DI void rowgemm64(const bf16* arow, const bf16* const (&bptr)[NB], char* stg, f32x16 (&acc)[NB][2][NI]) {
    const int tid = fresh_tid(), lane = tid & 63, r32 = lane & 31, h = lane >> 5;
    const int lrow = tid >> 3, lc = tid & 7;
    u32x4 ra = arow ? *(const u32x4*)arow : (u32x4){0u, 0u, 0u, 0u};
    bf16x8 bqA[4][NB][NI], bqB[4][NB][NI];
    auto bload = [&](bf16x8 (&dst)[4][NB][NI], int kc) {
#pragma unroll
        for (int ks = 0; ks < 4; ++ks)
#pragma unroll
            for (int b = 0; b < NB; ++b)
#pragma unroll
                for (int ni = 0; ni < NI; ++ni) dst[ks][b][ni] = *(const bf16x8*)(bptr[b] + (size_t)ni * 32 * 1024 + kc * 64 + ks * 16);
    };
    auto mma = [&](const bf16x8 (&bq)[4][NB][NI], int buf) {
#pragma unroll
        for (int ks = 0; ks < 4; ++ks) {
            bf16x8 af[2];
#pragma unroll
            for (int mi = 0; mi < 2; ++mi) af[mi] = *(const bf16x8*)(stg + buf * 8192 + swz128(32 * mi + r32, 2 * ks + h));
#pragma unroll
            for (int b = 0; b < NB; ++b)
#pragma unroll
                for (int ni = 0; ni < NI; ++ni)
#pragma unroll
                    for (int mi = 0; mi < 2; ++mi) acc[b][mi][ni] = MFMA32(af[mi], bq[ks][b][ni], acc[b][mi][ni]);
        }
    };
    bload(bqA, 0);
    *(u32x4*)(stg + swz128(lrow, lc)) = ra;
    __syncthreads();
    for (int kc = 0; kc < 16; kc += 2) {
        ra = arow ? *(const u32x4*)(arow + (kc + 1) * 64) : (u32x4){0u, 0u, 0u, 0u};
        bload(bqB, kc + 1);
        mma(bqA, 0);
        *(u32x4*)(stg + 8192 + swz128(lrow, lc)) = ra;
        __syncthreads();
        if (kc + 2 < 16) { ra = arow ? *(const u32x4*)(arow + (kc + 2) * 64) : (u32x4){0u, 0u, 0u, 0u}; bload(bqA, kc + 2); }
        mma(bqB, 1);
        if (kc + 2 < 16) *(u32x4*)(stg + swz128(lrow, lc)) = ra;
        __syncthreads();
    }
}

constexpr size_t OFF_MIX = OFF_V;
struct EpiSig {
    static constexpr bool PERM = true;
    bf16* sg;
    DM void operator()(const f32x4 (&acc)[2][2][4][2], const pg8::Unit& u, int wr, int wc, int fr, int fq) const {
        const int row0 = u.pm * 256 + wr * 64 + fr, col0 = u.pn * 256 + wc * 32 + 8 * fq;
#pragma unroll
        for (int ai = 0; ai < 2; ++ai)
#pragma unroll
            for (int m = 0; m < 4; ++m) {
                bf16* rowp = sg + (size_t)(row0 + ai * 128 + m * 16) * 2048 + col0;
#pragma unroll
                for (int bj = 0; bj < 2; ++bj) {
                    const f32x4 v0 = acc[ai][bj][m][0], v1 = acc[ai][bj][m][1];
                    *(u32x4*)(rowp + bj * 128) = (u32x4){pk2(sigmoidf_(v0[0]), sigmoidf_(v0[1])), pk2(sigmoidf_(v0[2]), sigmoidf_(v0[3])), pk2(sigmoidf_(v1[0]), sigmoidf_(v1[1])), pk2(sigmoidf_(v1[2]), sigmoidf_(v1[3]))};
                }
            }
    }
};
template <bool ADD> struct EpiGate {
    static constexpr bool PERM = true;
    const bf16* sg; bf16* mix; int goff;
    DM void operator()(const f32x4 (&acc)[2][2][4][2], const pg8::Unit& u, int wr, int wc, int fr, int fq) const {
        const int row0 = u.pm * 256 + wr * 64 + fr, col0 = u.pn * 256 + wc * 32 + 8 * fq;
#pragma unroll
        for (int ai = 0; ai < 2; ++ai)
#pragma unroll
            for (int m = 0; m < 4; ++m) {
                const size_t j = (size_t)(row0 + ai * 128 + m * 16);
#pragma unroll
                for (int bj = 0; bj < 2; ++bj) {
                    const u32x4 g = *(const u32x4*)(sg + j * 2048 + goff + col0 + bj * 128);
                    const f32x4 v0 = acc[ai][bj][m][0], v1 = acc[ai][bj][m][1];
                    float o[8] = {bflo(g.x) * v0[0], bfhi(g.x) * v0[1], bflo(g.y) * v0[2], bfhi(g.y) * v0[3], bflo(g.z) * v1[0], bfhi(g.z) * v1[1], bflo(g.w) * v1[2], bfhi(g.w) * v1[3]};
                    bf16* dst = mix + j * D + col0 + bj * 128;
                    if (ADD) { const u32x4 q = *(const u32x4*)dst; o[0] += bflo(q.x); o[1] += bfhi(q.x); o[2] += bflo(q.y); o[3] += bfhi(q.y); o[4] += bflo(q.z); o[5] += bfhi(q.z); o[6] += bflo(q.w); o[7] += bfhi(q.w); }
                    *(u32x4*)dst = (u32x4){pk2(o[0], o[1]), pk2(o[2], o[3]), pk2(o[4], o[5]), pk2(o[6], o[7])};
                }
            }
    }
};
struct EpiRes {
    static constexpr bool PERM = false;
    const float* x; float* hout;
    DM void operator()(const f32x4 (&acc)[2][2][4][2], const pg8::Unit& u, int wr, int wc, int fr, int fq) const {
        const int row0 = u.pm * 256 + wr * 64 + fr, col0 = u.pn * 256 + wc * 32 + 4 * fq;
#pragma unroll
        for (int ai = 0; ai < 2; ++ai)
#pragma unroll
            for (int m = 0; m < 4; ++m) {
                const size_t off = (size_t)(row0 + ai * 128 + m * 16) * D + col0;
#pragma unroll
                for (int bj = 0; bj < 2; ++bj)
#pragma unroll
                    for (int n = 0; n < 2; ++n) *(f32x4*)(hout + off + bj * 128 + n * 16) = *(const f32x4*)(x + off + bj * 128 + n * 16) + acc[ai][bj][m][n];
            }
    }
};
DI void phase5a(const Params& p, char* smem, int bid, int nblk) {
    pg8::Gemm g{(const bf16*)(p.ws + OFF_U), (const bf16*)(p.ws + OFF_WTIN) + (size_t)7168 * 1024, SEQ, 2048, 1024};
    pg8::StaticOrder S; S.init(SEQ, 2048, nblk, bid);
    EpiSig E{(bf16*)p.out};
    pg8::gemm_phase(smem, g, S, E);
}
DI void phase5b(const Params& p, char* smem, int bid, int nblk) {
    pg8::StaticOrder S; S.init(SEQ, 1024, nblk, bid);
    {
        pg8::Gemm g{(const bf16*)(p.ws + OFF_AQ), (const bf16*)(p.ws + OFF_WTBA), SEQ, 1024, 1024};
        EpiGate<false> E{(const bf16*)p.out, (bf16*)(p.ws + OFF_MIX), 0};
        pg8::gemm_phase(smem, g, S, E);
    }
    {
        pg8::Gemm g{(const bf16*)(p.ws + OFF_OD), (const bf16*)(p.ws + OFF_WTBD), SEQ, 1024, 1024};
        EpiGate<true> E{(const bf16*)p.out, (bf16*)(p.ws + OFF_MIX), 1024};
        pg8::gemm_phase(smem, g, S, E);
    }
}
DI void phase5c(const Params& p, char* smem, int bid, int nblk) {
    pg8::Gemm g{(const bf16*)(p.ws + OFF_MIX), (const bf16*)(p.ws + OFF_WTOUT), SEQ, 1024, 1024};
    pg8::StaticOrder S; S.init(SEQ, 1024, nblk, bid);
    EpiRes E{p.in[0], p.out};
    pg8::gemm_phase(smem, g, S, E);
}
constexpr int P5_PLP = 65, P5_PL = 0, P5_SS = 8 * 64 * P5_PLP * 4, P5_MISC = P5_SS + 8 * 64 * 4;
DI void post_rows(const Params& p, char* smem, int rb, int dry) {
    const int tid = fresh_tid(), lane = tid & 63, wave = tid >> 6, r32 = lane & 31, h = lane >> 5;
    unsigned char* ws = p.ws;
    const int row0 = rb * 64;
    float* rstdl = (float*)(smem + P5_MISC); float* logl = (float*)(smem + P5_MISC + 256);
    {
        const bf16* WH = (const bf16*)(ws + OFF_SMALL + SM_WR); const bf16* WL = WH + 64 * 1024;
        f32x16 acc[2][2];
#pragma unroll
        for (int mi = 0; mi < 2; ++mi)
#pragma unroll
            for (int ni = 0; ni < 2; ++ni) acc[mi][ni] = zero16();
        float ss[2] = {0.f, 0.f};
#pragma unroll 2
        for (int ks = 0; ks < 8; ++ks) {
            const int k0 = 128 * wave + 16 * ks + 8 * h;
            bf16x8 ah[2], al[2];
#pragma unroll
            for (int mi = 0; mi < 2; ++mi) {
                const float* hp = p.out + (size_t)(row0 + 32 * mi + r32) * D + k0;
                const f32x4 a = *(const f32x4*)hp, b = *(const f32x4*)(hp + 4);
                ss[mi] += a[0] * a[0] + a[1] * a[1] + a[2] * a[2] + a[3] * a[3] + b[0] * b[0] + b[1] * b[1] + b[2] * b[2] + b[3] * b[3];
                const u32x4 hi = {pk2(a[0], a[1]), pk2(a[2], a[3]), pk2(b[0], b[1]), pk2(b[2], b[3])};
                const u32x4 lo = {pk2(a[0] - bflo(hi.x), a[1] - bfhi(hi.x)), pk2(a[2] - bflo(hi.y), a[3] - bfhi(hi.y)), pk2(b[0] - bflo(hi.z), b[1] - bfhi(hi.z)), pk2(b[2] - bflo(hi.w), b[3] - bfhi(hi.w))};
                ah[mi] = __builtin_bit_cast(bf16x8, hi); al[mi] = __builtin_bit_cast(bf16x8, lo);
            }
#pragma unroll
            for (int ni = 0; ni < 2; ++ni) {
                const bf16x8 bh = *(const bf16x8*)(WH + (size_t)(32 * ni + r32) * 1024 + k0), bl = *(const bf16x8*)(WL + (size_t)(32 * ni + r32) * 1024 + k0);
#pragma unroll
                for (int mi = 0; mi < 2; ++mi) { acc[mi][ni] = MFMA32(ah[mi], bh, acc[mi][ni]); acc[mi][ni] = MFMA32(ah[mi], bl, acc[mi][ni]); acc[mi][ni] = MFMA32(al[mi], bh, acc[mi][ni]); }
            }
        }
        float* PL = (float*)(smem + P5_PL) + wave * 64 * P5_PLP; float* SS = (float*)(smem + P5_SS) + wave * 64;
#pragma unroll
        for (int mi = 0; mi < 2; ++mi) {
#pragma unroll
            for (int ni = 0; ni < 2; ++ni)
#pragma unroll
                for (int r = 0; r < 16; ++r) PL[(32 * mi + (r & 3) + 8 * (r >> 2) + 4 * h) * P5_PLP + 32 * ni + r32] = acc[mi][ni][r];
            const float s = ss[mi] + xhalf(ss[mi]);
            if (h == 0) SS[32 * mi + r32] = s;
        }
    }
    __syncthreads();
    if (tid < 64) {
        float s = 0.f;
#pragma unroll
        for (int w = 0; w < 8; ++w) s += ((const float*)(smem + P5_SS))[w * 64 + tid];
        const float rs = rsqrtf(s * (1.0f / D) + NORM_EPS);
        rstdl[tid] = rs;
        for (int c = 0; c < 36; ++c) { float t = 0.f; for (int w = 0; w < 8; ++w) t += ((const float*)(smem + P5_PL))[w * 64 * P5_PLP + tid * P5_PLP + c]; logl[tid * 41 + c] = t * rs + (c < 4 ? p.in[18][c] : p.in[20][c - 4]); }
        const float* L = logl + tid * 41;
        int gi = 0; float gm = L[0];
        for (int c = 1; c < 4; ++c) if (L[c] > gm) { gm = L[c]; gi = c; }
        float gs = 0.f; for (int c = 0; c < 4; ++c) gs += __expf(L[c] - gm);
        const float gw = 1.0f / gs;
        const float* E = L + 4 + 8 * gi;
        int i1 = 0; float l1 = E[0];
        for (int c = 1; c < 8; ++c) if (E[c] > l1) { l1 = E[c]; i1 = c; }
        int i2 = -1; float l2 = -3.0e38f;
        for (int c = 0; c < 8; ++c) if (c != i1 && E[c] > l2) { l2 = E[c]; i2 = c; }
        const float t = __expf(l2 - l1), w1 = 1.0f / (1.0f + t), w2 = t / (1.0f + t);
        unsigned* cnt = (unsigned*)(ws + OFF_SMALL + SM_CTL) + CW_ECNT;
        int* lists = (int*)(ws + OFF_SMALL + SM_TAILS); float* RW = (float*)(ws + OFF_SMALL + SM_RW);
        const int j = row0 + tid;
        const int e1 = 8 * gi + i1, e2 = 8 * gi + i2;
        if (!dry) {
        const unsigned p1 = atomicAdd(cnt + e1, 1u); ST_ATOMIC(lists + (size_t)e1 * SEQ + p1, (j << 1)); RW[2 * j] = gw * w1;
        const unsigned p2 = atomicAdd(cnt + e2, 1u); ST_ATOMIC(lists + (size_t)e2 * SEQ + p2, (j << 1) | 1); RW[2 * j + 1] = gw * w2;
        } else { asm volatile("" :: "v"(e1), "v"(e2), "v"(gw * w1), "v"(gw * w2)); }
    }
    __syncthreads();
#pragma unroll 2
    for (int i = 0; i < 16; ++i) {
        const int idx = tid + NT * i, row = idx >> 7, ch = idx & 127;
        const float* hp = p.out + (size_t)(row0 + row) * D + ch * 8;
        const f32x4 a = *(const f32x4*)hp, b = *(const f32x4*)(hp + 4);
        const f32x4 w0 = *(const f32x4*)(p.in[16] + ch * 8), w1 = *(const f32x4*)(p.in[16] + ch * 8 + 4);
        const float rs = rstdl[row];
        if (!dry) *(u32x4*)((bf16*)(ws + OFF_OD) + (size_t)(row0 + row) * D + ch * 8) =
            (u32x4){pk2(a[0] * rs * w0[0], a[1] * rs * w0[1]), pk2(a[2] * rs * w0[2], a[3] * rs * w0[3]), pk2(b[0] * rs * w1[0], b[1] * rs * w1[1]), pk2(b[2] * rs * w1[2], b[3] * rs * w1[3])};
    }
    __syncthreads();
}
DI void phase5d(const Params& p, char* smem, int bid, int nblk, int dry = 0) {
    for (int rb = bid; rb < SEQ / 64; rb += nblk) post_rows(p, smem, rb, dry);
}

constexpr int P6_TBL = 131072 + 1024;
template <int NPN> struct MoeSched {
    static constexpr bool GATHER = (NPN == 2);
    const int* tbl; const int* lists; int G, c; size_t btile;
    DM bool next(int i, pg8::Unit& u) const {
        const long L = (long)i * G + c; const int total = tbl[64 + 33 + 32] * NPN; if (L >= total) return false;
        const int ru = (int)L / NPN; u.pn = (int)L % NPN;
        int e = 0;
#pragma unroll 1
        for (int q = 1; q < 32; ++q) if (tbl[64 + 33 + q] <= ru) e = q;
        u.e = e; u.pm = ru - tbl[64 + 33 + e]; return true;
    }
    DM const char* a_tile(const pg8::Gemm& g, const pg8::Unit& u) const { return (const char*)g.A + ((size_t)tbl[32 + u.e] + (size_t)u.pm * 256) * g.K * 2; }
    DM const char* b_tile(const pg8::Gemm& g, const pg8::Unit& u) const { return (const char*)g.Bt + (size_t)u.e * btile + (size_t)u.pn * 256 * g.K * 2; }
    DM int a_row(const pg8::Unit& u, int r) const { const int loc = u.pm * 256 + r; return loc < tbl[u.e] ? (lists[(size_t)u.e * SEQ + loc] >> 1) : 0; }
};
DI void moe_table(const Params& p, char* smem) {
    int* tbl = (int*)(smem + P6_TBL);
    unsigned* cnt = (unsigned*)(p.ws + OFF_SMALL + SM_CTL) + CW_ECNT;
    if (threadIdx.x < 32) tbl[threadIdx.x] = (int)LD_ATOMIC(cnt + threadIdx.x);
    __syncthreads();
    if (threadIdx.x == 0) { int hb = 0, ub = 0; for (int e = 0; e < 32; ++e) { tbl[32 + e] = hb; tbl[64 + 33 + e] = ub; const int nru = (tbl[e] + 255) >> 8; hb += nru * 256; ub += nru; } tbl[32 + 32] = hb; tbl[64 + 33 + 32] = ub; }
    __syncthreads();
}
struct EpiSwiGLU {
    static constexpr bool PERM = true;
    bf16* H; const int* tbl;
    DM void operator()(const f32x4 (&acc)[2][2][4][2], const pg8::Unit& u, int wr, int wc, int fr, int fq) const {
        const size_t grow0 = (size_t)tbl[32 + u.e] + (size_t)u.pm * 256 + wr * 64 + fr; const int hid0 = (u.pn * 256 + wc * 32 + 8 * fq) >> 1;
#pragma unroll
        for (int ai = 0; ai < 2; ++ai)
#pragma unroll
            for (int m = 0; m < 4; ++m) {
                bf16* rowp = H + (grow0 + ai * 128 + m * 16) * 256 + hid0;
#pragma unroll
                for (int bj = 0; bj < 2; ++bj) {
                    const f32x4 gt = acc[ai][bj][m][0], up = acc[ai][bj][m][1];
                    *(u32x2*)(rowp + bj * 64) = (u32x2){pk2(siluf_(gt[0]) * up[0], siluf_(gt[1]) * up[1]), pk2(siluf_(gt[2]) * up[2], siluf_(gt[3]) * up[3])};
                }
            }
    }
};
struct EpiScatter {
    static constexpr bool PERM = true;
    bf16* Y; const int* tbl; const int* lists; const float* RW;
    DM void operator()(const f32x4 (&acc)[2][2][4][2], const pg8::Unit& u, int wr, int wc, int fr, int fq) const {
        const int loc0 = u.pm * 256 + wr * 64 + fr, col0 = u.pn * 256 + wc * 32 + 8 * fq, cnt = tbl[u.e];
#pragma unroll
        for (int ai = 0; ai < 2; ++ai)
#pragma unroll
            for (int m = 0; m < 4; ++m) {
                const int loc = loc0 + ai * 128 + m * 16;
                if (loc < cnt) {
                    const int ent = lists[(size_t)u.e * SEQ + loc]; const float w = RW[ent];
                    bf16* rowp = Y + (size_t)ent * D + col0;
#pragma unroll
                    for (int bj = 0; bj < 2; ++bj) {
                        const f32x4 v0 = acc[ai][bj][m][0] * w, v1 = acc[ai][bj][m][1] * w;
                        *(u32x4*)(rowp + bj * 128) = (u32x4){pk2(v0[0], v0[1]), pk2(v0[2], v0[3]), pk2(v1[0], v1[1]), pk2(v1[2], v1[3])};
                    }
                }
            }
    }
};
DI void phase6a(const Params& p, char* smem, int bid, int nblk) {
    moe_table(p, smem);
    const int* tbl = (const int*)(smem + P6_TBL); const int* lists = (const int*)(p.ws + OFF_SMALL + SM_TAILS);
    pg8::Gemm g{(const bf16*)(p.ws + OFF_OD), (const bf16*)(p.ws + OFF_EXG), 0, 512, 1024};
    MoeSched<2> S{tbl, lists, nblk, bid, (size_t)512 * 1024 * 2};
    EpiSwiGLU E{(bf16*)(p.ws + OFF_H), tbl};
    pg8::gemm_phase(smem, g, S, E);
}
DI void phase6b(const Params& p, char* smem, int bid, int nblk) {
    moe_table(p, smem);
    const int* tbl = (const int*)(smem + P6_TBL); const int* lists = (const int*)(p.ws + OFF_SMALL + SM_TAILS);
    pg8::Gemm g{(const bf16*)(p.ws + OFF_H), (const bf16*)(p.ws + OFF_EXD), 0, 1024, 256};
    MoeSched<4> S{tbl, lists, nblk, bid, (size_t)1024 * 256 * 2};
    EpiScatter E{(bf16*)(p.ws + OFF_Y), tbl, lists, (const float*)(p.ws + OFF_SMALL + SM_RW)};
    pg8::gemm_phase(smem, g, S, E);
}

DI void phase7(const Params& p, char* smem, int bid, int nblk, int dry = 0) {
    const int tid = fresh_tid(), lane = tid & 63, wave = tid >> 6;
    const int gw = bid * 8 + wave, NGW = nblk * 8;
    for (int j = gw; j < SEQ; j += NGW) {
        float* hrow = p.out + (size_t)j * D;
        const bf16* y0 = (const bf16*)(p.ws + OFF_Y) + (size_t)j * 2 * D;
        float4 v[4]; float ss = 0.f;
#pragma unroll
        for (int q = 0; q < 4; ++q) {
            const int c = 4 * lane + 256 * q;
            v[q] = *(const float4*)(hrow + c);
            const u32x2 a = *(const u32x2*)(y0 + c), b = *(const u32x2*)(y0 + D + c);
            v[q].x += bflo(a.x) + bflo(b.x); v[q].y += bfhi(a.x) + bfhi(b.x); v[q].z += bflo(a.y) + bflo(b.y); v[q].w += bfhi(a.y) + bfhi(b.y);
            ss += v[q].x * v[q].x + v[q].y * v[q].y + v[q].z * v[q].z + v[q].w * v[q].w;
        }
        ss = wave_sum(ss);
        const float rstd = rsqrtf(ss * (1.0f / D) + NORM_EPS);
#pragma unroll
        for (int q = 0; q < 4; ++q) {
            const int c = 4 * lane + 256 * q; const float4 w4 = *(const float4*)(p.in[24] + c);
            if (!dry) *(float4*)(hrow + c) = make_float4(v[q].x * rstd * w4.x, v[q].y * rstd * w4.y, v[q].z * rstd * w4.z, v[q].w * rstd * w4.w);
        }
    }
}

#ifdef EMU
__global__ void __launch_bounds__(NT) k_phase0(Params p) { SMEM_DECL; phase0(p, smem, blockIdx.x, gridDim.x); }
__global__ void __launch_bounds__(NT) k_phase1(Params p) { SMEM_DECL; phase1(p, smem, blockIdx.x, gridDim.x); }
__global__ void __launch_bounds__(NT) k_phase2(Params p) { SMEM_DECL; phase2(p, smem, blockIdx.x, gridDim.x, 0); }
__global__ void __launch_bounds__(NT) k_phase3(Params p) { SMEM_DECL; phase3(p, smem, blockIdx.x, gridDim.x); }
__global__ void __launch_bounds__(NT) k_phase4(Params p) { SMEM_DECL; phase4(p, smem, blockIdx.x, gridDim.x); }
__global__ void __launch_bounds__(NT) k_phase5a(Params p) { SMEM_DECL; phase5a(p, smem, blockIdx.x, gridDim.x); }
__global__ void __launch_bounds__(NT) k_phase5b(Params p) { SMEM_DECL; phase5b(p, smem, blockIdx.x, gridDim.x); }
__global__ void __launch_bounds__(NT) k_phase5c(Params p) { SMEM_DECL; phase5c(p, smem, blockIdx.x, gridDim.x); }
__global__ void __launch_bounds__(NT) k_phase5d(Params p) { SMEM_DECL; phase5d(p, smem, blockIdx.x, gridDim.x); }
__global__ void __launch_bounds__(NT) k_phase6a(Params p) { SMEM_DECL; phase6a(p, smem, blockIdx.x, gridDim.x); }
__global__ void __launch_bounds__(NT) k_phase6b(Params p) { SMEM_DECL; phase6b(p, smem, blockIdx.x, gridDim.x); }
__global__ void __launch_bounds__(NT) k_phase7(Params p) { SMEM_DECL; phase7(p, smem, blockIdx.x, gridDim.x); }

#endif

constexpr int LDS_BYTES = 160 * 1024 - 256;
constexpr int LDS_BARST = LDS_BYTES - 16;

#ifndef EMU
#define LAS __attribute__((address_space(3)))
#define XB_TMO      128
#define XB_XCNT(j)  (256  + 64 * (j))
#define XB_XSUB(j)  (1280 + 64 * (j))
#define XB_XGEN(j)  (2304 + 64 * (j))
#define XB_TOP      3328
#define XB_TOPGEN   3392
#define XCD_BAR_WORDS 3456
#define XB_SPIN_CAP (1u << 22)
__device__ __forceinline__ unsigned xb_ld(unsigned* p)              { return __hip_atomic_load(p, __ATOMIC_RELAXED, __HIP_MEMORY_SCOPE_AGENT); }
__device__ __forceinline__ unsigned xb_add(unsigned* p, unsigned v) { return __hip_atomic_fetch_add(p, v, __ATOMIC_RELAXED, __HIP_MEMORY_SCOPE_AGENT); }
__device__ __forceinline__ unsigned xb_xcc_id() { return (unsigned)__builtin_amdgcn_s_getreg((3 << 11) | 20) & 0xFu; }
#define XB_SPIN(cond, bar) do { unsigned _sp = 0; while (cond) { __builtin_amdgcn_s_sleep(1); \
    if ((++_sp & 255u) == 0u) { if (xb_ld(&(bar)[XB_TMO])) break; if (_sp > XB_SPIN_CAP) { atomicAdd(&(bar)[XB_TMO], 1u); break; } } } } while (0)
struct XcdBarrier { unsigned* bar; unsigned x; volatile LAS unsigned* st; };
__device__ __forceinline__ XcdBarrier xcd_barrier_post(unsigned* bar, volatile LAS unsigned* st) {
    XcdBarrier b; b.bar = bar; b.x = xb_xcc_id(); b.st = st;
    if (threadIdx.x == 0) (void)xb_add(&bar[XB_XCNT(b.x)], 1u);
    return b;
}
__device__ __forceinline__ void xcd_barrier_complete(unsigned* bar, unsigned x, unsigned& nloc, unsigned& nx) {
    const unsigned G = gridDim.x * gridDim.y * gridDim.z;
    unsigned sum, cnt, mine, sp = 0u;
    for (;;) {
        sum = 0u; cnt = 0u; mine = 0u;
#pragma unroll
        for (unsigned j = 0; j < 16; ++j) { const unsigned c = xb_ld(&bar[XB_XCNT(j)]); sum += c; cnt += (c > 0u) ? 1u : 0u; mine = (j == x) ? c : mine; }
        if (sum == G) break;
        __builtin_amdgcn_s_sleep(1);
        if ((++sp & 255u) == 0u) { if (xb_ld(&bar[XB_TMO])) break; if (sp > XB_SPIN_CAP) { atomicAdd(&bar[XB_TMO], 1u); break; } }
    }
    nloc = mine > 0u ? mine : 1u; nx = cnt > 0u ? cnt : 1u;
}
__device__ __forceinline__ void xcd_barrier(const XcdBarrier& b) {
    asm volatile("s_waitcnt vmcnt(0)" ::: "memory");
    __syncthreads();
    if (threadIdx.x == 0) {
        unsigned* bar = b.bar;
        __builtin_amdgcn_s_waitcnt(0);
        unsigned nloc = b.st[0], nx = b.st[1];
        if (nloc == 0u) { xcd_barrier_complete(bar, b.x, nloc, nx); b.st[0] = nloc; b.st[1] = nx; }
        const unsigned old = xb_add(&bar[XB_XSUB(b.x)], 1u);
        const unsigned gen = old / nloc;
        if (old + 1u == (gen + 1u) * nloc) {
            __builtin_amdgcn_fence(__ATOMIC_RELEASE, "agent");
            asm volatile("s_waitcnt vmcnt(0)" ::: "memory");
            const unsigned og = xb_add(&bar[XB_TOP], 1u);
            const unsigned tg = og / nx;
            if (og + 1u == (tg + 1u) * nx) xb_add(&bar[XB_TOPGEN], 1u);
            else XB_SPIN(xb_ld(&bar[XB_TOPGEN]) == tg, bar);
            __builtin_amdgcn_fence(__ATOMIC_ACQUIRE, "agent");
            xb_add(&bar[XB_XGEN(b.x)], 1u);
            asm volatile("s_waitcnt vmcnt(0)" ::: "memory");
        } else {
            XB_SPIN(xb_ld(&bar[XB_XGEN(b.x)]) == gen, bar);
            __builtin_amdgcn_fence(__ATOMIC_ACQUIRE, "agent");
            asm volatile("s_waitcnt vmcnt(0)" ::: "memory");
        }
    }
    __syncthreads();
}
#endif

#ifdef EMU
#define GRID_SYNC() emu_grid_sync()
#define GRID_SYNC_CG() emu_grid_sync()
#else
#define GRID_SYNC_CG() do { \
    asm volatile("s_waitcnt vmcnt(0)" ::: "memory"); \
    __syncthreads(); \
    cooperative_groups::this_grid().sync(); \
    if (threadIdx.x == 0) { __builtin_amdgcn_fence(__ATOMIC_ACQUIRE, "agent"); asm volatile("s_waitcnt vmcnt(0)" ::: "memory"); } \
    __syncthreads(); \
} while (0)
#define GRID_SYNC() xcd_barrier(xbar)
#endif
__global__ void __launch_bounds__(NT) fwd_megakernel(Params p) {
    SMEM_DECL;
    const int bid = blockIdx.x, nblk = gridDim.x;
#ifndef EMU
    if (threadIdx.x < 4) ((volatile LAS unsigned*)(smem + LDS_BARST))[threadIdx.x] = 0u;
    __syncthreads();
    const XcdBarrier xbar = xcd_barrier_post((unsigned*)(p.ws + OFF_SMALL + SM_CTL) + CW_BAR, (volatile LAS unsigned*)(smem + LDS_BARST));
#endif
#if defined(DRY_PHASE) && !defined(EMU)
    int dryflag = 1; asm volatile("" : "+s"(dryflag));
#define EXTRA(k, call) do { if (DRY_PHASE == (k)) { call; GRID_SYNC(); } } while (0)
#else
#define EXTRA(k, call) do {} while (0)
    const int dryflag = 0; (void)dryflag;
#endif
    EXTRA(0, phase0(p, smem, bid, nblk));
    phase0(p, smem, bid, nblk); GRID_SYNC();
    EXTRA(1, phase1(p, smem, bid, nblk));
    phase1(p, smem, bid, nblk); GRID_SYNC();
    EXTRA(2, phase2(p, smem, bid, nblk, dryflag));
    phase2(p, smem, bid, nblk); GRID_SYNC();
    EXTRA(3, phase3(p, smem, bid, nblk, dryflag));
    EXTRA(8, phase3(p, smem, bid, nblk, dryflag, 1));
    EXTRA(9, phase3(p, smem, bid, nblk, dryflag, 2));
    phase3(p, smem, bid, nblk); GRID_SYNC();
    EXTRA(4, phase4(p, smem, bid, nblk));
    phase4(p, smem, bid, nblk); GRID_SYNC();
    EXTRA(5, phase5a(p, smem, bid, nblk));
    phase5a(p, smem, bid, nblk); GRID_SYNC();
    EXTRA(10, phase5b(p, smem, bid, nblk));
    phase5b(p, smem, bid, nblk); GRID_SYNC();
    EXTRA(11, phase5c(p, smem, bid, nblk));
    phase5c(p, smem, bid, nblk); GRID_SYNC();
    EXTRA(12, phase5d(p, smem, bid, nblk, dryflag));
    phase5d(p, smem, bid, nblk); GRID_SYNC();
    EXTRA(6, phase6a(p, smem, bid, nblk));
    phase6a(p, smem, bid, nblk); GRID_SYNC();
    EXTRA(13, phase6b(p, smem, bid, nblk));
    phase6b(p, smem, bid, nblk); GRID_SYNC();
    EXTRA(7, phase7(p, smem, bid, nblk, dryflag));
    phase7(p, smem, bid, nblk);
}

#ifndef EMU
extern "C" void kernel_launch(void* const* d_in, const int* in_sizes, int n_in, void* d_out, int out_size, void* d_ws, size_t ws_size, hipStream_t stream) {
    static int grid = 0;
    if (grid == 0) {
        if (n_in != 25 || ws_size < WS_END || out_size != SEQ * D) { fprintf(stderr, "kernel_launch: unexpected problem (n_in %d, ws %zu, out %d)\n", n_in, ws_size, out_size); grid = -1; return; }
        int dev = 0, cus = 0, per_cu = 0;
        (void)hipGetDevice(&dev);
        (void)hipDeviceGetAttribute(&cus, hipDeviceAttributeMultiprocessorCount, dev);
        (void)hipFuncSetAttribute((const void*)fwd_megakernel, hipFuncAttributeMaxDynamicSharedMemorySize, LDS_BYTES);
        (void)hipOccupancyMaxActiveBlocksPerMultiprocessor(&per_cu, (const void*)fwd_megakernel, NT, LDS_BYTES);
        if (per_cu < 1) { fprintf(stderr, "kernel_launch: occupancy query returned %d\n", per_cu); per_cu = 1; }
        grid = cus * per_cu;
    }
    if (grid < 0) return;
    Params p{};
    for (int i = 0; i < 25; ++i) p.in[i] = (const float*)d_in[i];
    p.out = (float*)d_out; p.ws = (unsigned char*)d_ws;
    (void)hipMemsetAsync((unsigned char*)d_ws + OFF_SMALL + SM_CTL + (size_t)CW_BAR * 4, 0, (size_t)XCD_BAR_WORDS * 4, stream);
    void* args[] = {&p};
    hipError_t e = hipLaunchCooperativeKernel((const void*)fwd_megakernel, dim3(grid), dim3(NT), args, LDS_BYTES, stream);
    if (e != hipSuccess) fprintf(stderr, "cooperative launch failed: %s (grid %d)\n", hipGetErrorString(e), grid);
}
#endif

#ifdef EMU
static void run_phases(Params p, int upto, int grid) {
    if (upto == 100) { emu::launch([=] { fwd_megakernel(p); }, grid, NT, LDS_BYTES, true); return; }
    if (upto >= 0) emu::launch([=] { k_phase0(p); }, grid, NT, LDS_BYTES, false);
    if (upto >= 1) emu::launch([=] { k_phase1(p); }, grid, NT, LDS_BYTES, false);
    if (upto >= 2) emu::launch([=] { k_phase2(p); }, grid, NT, LDS_BYTES, false);
    if (upto >= 3) emu::launch([=] { k_phase3(p); }, grid, NT, LDS_BYTES, false);
    if (upto >= 4) emu::launch([=] { k_phase4(p); }, grid, NT, LDS_BYTES, false);
    if (upto >= 5) { emu::launch([=] { k_phase5a(p); }, grid, NT, LDS_BYTES, false); emu::launch([=] { k_phase5b(p); }, grid, NT, LDS_BYTES, false); emu::launch([=] { k_phase5c(p); }, grid, NT, LDS_BYTES, false); emu::launch([=] { k_phase5d(p); }, grid, NT, LDS_BYTES, false); }
    if (upto >= 6) { emu::launch([=] { k_phase6a(p); }, grid, NT, LDS_BYTES, false); emu::launch([=] { k_phase6b(p); }, grid, NT, LDS_BYTES, false); }
    if (upto >= 7) emu::launch([=] { k_phase7(p); }, grid, NT, LDS_BYTES, false);
}
#endif
```

```cpp
#include <type_traits>
#ifndef EMU
#include <hip/hip_runtime.h>
#include <hip/hip_cooperative_groups.h>
#include <cstdio>
#include <cstdint>
#include <cmath>
#endif

#ifndef SEQ
#define SEQ 16384
#endif

typedef unsigned short bf16;
typedef short bf16x8 __attribute__((ext_vector_type(8)));
typedef short bf16x4 __attribute__((ext_vector_type(4)));
typedef float f32x16 __attribute__((ext_vector_type(16)));
typedef float f32x4 __attribute__((ext_vector_type(4)));
typedef unsigned u32x4 __attribute__((ext_vector_type(4)));
typedef unsigned u32x2 __attribute__((ext_vector_type(2)));

#ifdef EMU
#define MFMA32(a, b, c) emu_mfma_32x32x16((a), (b), (c))
#define MFMA16(a, b, c) emu_mfma_16x16x32((a), (b), (c))
#define DI static inline
#define DM inline
#define EXP2F(x) exp2f(x)
#define WAVE_SYNC() emu_wave_sync()
#define LD_NT(p) (*(p))
#define LD_ATOMIC(p) (*(p))
#define ST_ATOMIC(p, v) (*(p) = (v))
#define SCHED_FENCE() do {} while (0)
#define SETPRIO(x) do {} while (0)
#define SCAN_HEAD_DELAY() do {} while (0)
#define PIN(x) do {} while (0)
#define LDS_BARRIER() __syncthreads()
#else
#define WAVE_SYNC() do { __builtin_amdgcn_fence(__ATOMIC_RELEASE, "wavefront"); __builtin_amdgcn_wave_barrier(); __builtin_amdgcn_fence(__ATOMIC_ACQUIRE, "wavefront"); } while (0)
#define MFMA32(a, b, c) __builtin_amdgcn_mfma_f32_32x32x16_bf16((a), (b), (c), 0, 0, 0)
#define LD_NT(p) __builtin_nontemporal_load(p)
#define LD_ATOMIC(p) __hip_atomic_load((p), __ATOMIC_RELAXED, __HIP_MEMORY_SCOPE_AGENT)
#define ST_ATOMIC(p, v) __hip_atomic_store((p), (v), __ATOMIC_RELAXED, __HIP_MEMORY_SCOPE_AGENT)
#define SCHED_FENCE() __builtin_amdgcn_sched_barrier(0)
#define SETPRIO(x) __builtin_amdgcn_s_setprio(x)
#define SCAN_HEAD_DELAY() __builtin_amdgcn_s_sleep(8)
#define PIN(x) asm volatile("" : "+v"(x))
#define LDS_BARRIER() asm volatile("s_waitcnt lgkmcnt(0)\n\ts_barrier" ::: "memory")
#define MFMA16(a, b, c) __builtin_amdgcn_mfma_f32_16x16x32_bf16((a), (b), (c), 0, 0, 0)
#define DI __device__ __forceinline__
#define DM __device__ __forceinline__
#define EXP2F(x) __builtin_amdgcn_exp2f(x)
#endif

constexpr int D = 1024;
constexpr int NMETA = 16;
constexpr int LTOK = SEQ + NMETA;
constexpr int NCH = SEQ / 64 + 1;
constexpr int NT = 512;
constexpr int W_IN_COLS = 9232;
constexpr float NORM_EPS = 1e-6f;
constexpr float LOG2E = 1.4426950408889634f;

constexpr size_t UNIT = (size_t)SEQ * D * 2;
constexpr size_t OFF_WTIN = 0;
constexpr size_t OFF_WTBA = OFF_WTIN + (size_t)9216 * 1024 * 2;
constexpr size_t OFF_WTBD = OFF_WTBA + (size_t)1024 * 1024 * 2;
constexpr size_t OFF_WTOUT = OFF_WTBD + (size_t)1024 * 1024 * 2;
constexpr size_t OFF_SMALL = OFF_WTOUT + (size_t)1024 * 1024 * 2;
constexpr size_t SM_CTL = 0;
constexpr size_t SM_UMETA = SM_CTL + 65536;
constexpr size_t SM_AKMETA = SM_UMETA + 16 * 1024 * 2;
constexpr size_t SM_AVTMETA = SM_AKMETA + 16 * 1024 * 2;
constexpr size_t SM_C0Q = SM_AVTMETA + 8 * 128 * 16 * 2;
constexpr size_t SM_C0K = SM_C0Q + 64 * 1024 * 2;
constexpr size_t SM_C0V = SM_C0K + 64 * 1024 * 2;
constexpr size_t SM_C0W = SM_C0V + 64 * 1024 * 2;
constexpr size_t SM_C0QK = SM_C0W + 8 * 64 * 128 * 2;
constexpr size_t SM_BETA = SM_C0QK + 8 * 64 * 64 * 2;
constexpr size_t SM_G = SM_BETA + (size_t)NCH * 64 * 8 * 4;
constexpr size_t SM_GC = SM_G + (size_t)NCH * 64 * 8 * 4;
constexpr size_t SM_WR = SM_GC + (size_t)NCH * 8 * 64 * 4;
constexpr size_t SM_RIDS = SM_WR + 2 * 64 * 1024 * 2;
constexpr size_t SM_RW = SM_RIDS + 0;
constexpr size_t SM_TAILS = SM_RW + (size_t)SEQ * 2 * 4;
constexpr size_t SM_TAILS_BYTES = ((size_t)NCH * 3 * 3072 * 2 > (size_t)32 * SEQ * 4) ? (size_t)NCH * 3 * 3072 * 2 : (size_t)32 * SEQ * 4;
constexpr size_t SM_END = SM_TAILS + SM_TAILS_BYTES;
constexpr size_t SMALL_BYTES = (SM_END + 255) & ~(size_t)255;
constexpr size_t OFF_U = ((OFF_SMALL + SMALL_BYTES + (1u << 20) - 1) >> 20) << 20;
constexpr size_t OFF_W = OFF_U + UNIT;
constexpr size_t OFF_KN = OFF_W + UNIT;
constexpr size_t OFF_QN = OFF_KN + UNIT;
constexpr size_t OFF_DG = OFF_QN + UNIT;
constexpr size_t OFF_V = OFF_DG + UNIT;
constexpr size_t OFF_AQ = OFF_V + UNIT;
constexpr size_t WS_BASE_END = OFF_AQ + UNIT;
constexpr size_t EXPERT_BYTES = (size_t)32 * 3 * 1024 * 256 * 2;
constexpr size_t OFF_EXP = (2 * UNIT >= EXPERT_BYTES) ? OFF_W : WS_BASE_END;
constexpr size_t WS_END1 = (OFF_EXP == OFF_W) ? WS_BASE_END : WS_BASE_END + EXPERT_BYTES;
constexpr size_t H_BYTES = ((size_t)2 * SEQ + 32 * 256) * 256 * 2;
constexpr size_t OFF_H = (H_BYTES <= UNIT) ? (OFF_SMALL + SMALL_BYTES + ((1u << 20) - 1)) / (1u << 20) * (1u << 20) : WS_END1;
constexpr size_t WS_END = (H_BYTES <= UNIT) ? WS_END1 : WS_END1 + H_BYTES;
constexpr size_t OFF_EXG = OFF_EXP, OFF_EXU = OFF_EXP + EXPERT_BYTES / 3, OFF_EXD = OFF_EXP + 2 * (EXPERT_BYTES / 3);
constexpr size_t OFF_QKB = OFF_U;
constexpr size_t OFF_OD = OFF_QN;
constexpr size_t OFF_Y = OFF_V;
#if SEQ == 16384
static_assert(WS_END <= (size_t)256 << 20, "workspace map exceeds 256 MiB");
static_assert(EXPERT_BYTES <= 2 * UNIT, "experts fit R2+R3");
#endif
constexpr int CW_ATTQ = 64;
constexpr int CW_ECNT = 8192, ECNT_STRIDE = 32;
constexpr int CW_NRM = 9216, NRM_STRIDE = 32;
constexpr int CW_BAR = 1024;

struct Params {
    const float* in[25];
    float* out;
    unsigned char* ws;
};

#ifdef EMU
DI unsigned f2bf(float f) { unsigned u = __builtin_bit_cast(unsigned, f); return (u + 0x7fffu + ((u >> 16) & 1u)) >> 16; }
#else
DI unsigned f2bf(float f) { return (unsigned)__builtin_bit_cast(unsigned short, (__bf16)f); }
#endif

typedef float f32x2_ __attribute__((ext_vector_type(2)));
DI float bf2f(unsigned b) { return __builtin_bit_cast(float, (b & 0xffffu) << 16); }
#ifdef EMU
DI unsigned pk2(float lo, float hi) { return f2bf(lo) | (f2bf(hi) << 16); }
DI bool wave_any(bool pr) { int v = pr ? 1 : 0;
    for (int o = 1; o < 64; o <<= 1) v |= __shfl_xor(v, o);
    return v != 0; }
#else
typedef __bf16 hwbf2 __attribute__((ext_vector_type(2)));
DI unsigned pk2(float lo, float hi) { return __builtin_bit_cast(unsigned, __builtin_convertvector((f32x2_){lo, hi}, hwbf2)); }
DI bool wave_any(bool pr) { return __any(pr) != 0; }
#endif
DI float bflo(unsigned w) { return __builtin_bit_cast(float, w << 16); }
DI float bfhi(unsigned w) { return __builtin_bit_cast(float, w & 0xffff0000u); }
#ifdef EMU
DI float rcpf_(float x) { return 1.0f / x; }
#else
DI float rcpf_(float x) { return __builtin_amdgcn_rcpf(x); }
#endif
DI float sigmoidf_(float x) { return rcpf_(1.0f + __expf(-x)); }
DI float siluf_(float x) { return x * rcpf_(1.0f + __expf(-x)); }
DI float wave_sum(float v) {
#pragma unroll
    for (int o = 1; o < 64; o <<= 1) v += __shfl_xor(v, o);
    return v;
}
DI int fresh_tid() {
    int t = threadIdx.x;
#ifndef EMU
    asm volatile("" : "+v"(t));
#endif
    return t;
}
#ifdef EMU
DI float xhalf(float v) { return __shfl_xor(v, 32); }
#else
DI float xhalf(float v) { const unsigned u = __builtin_bit_cast(unsigned, v); const auto r = __builtin_amdgcn_permlane32_swap(u, u, false, false); return __builtin_bit_cast(float, (threadIdx.x & 32) ? r[0] : r[1]); }
#endif
DI f32x16 zero16() { f32x16 z; for (int i = 0; i < 16; ++i) z[i] = 0.f; return z; }
DI f32x4 zero4() { f32x4 z; for (int i = 0; i < 4; ++i) z[i] = 0.f; return z; }
DI int swz128(int row, int c) { return row * 128 + ((c ^ ((row >> 1) & 7)) << 4); }
DI int swz128t(int row, int c) { return row * 128 + ((c ^ ((row >> 1) & 7) ^ ((row >> 4) & 7)) << 4); }
DI int swz128_8(int row, int s) { return row * 128 + ((s ^ (((row >> 1) & 7) << 1)) << 3); }
DI int swzrow(int row, int pitch, int c) { return row * pitch + ((c ^ (row & 15)) << 4); }

#ifdef EMU
#define SMEM_DECL char* smem = emu_smem()
#else
#define SMEM_DECL extern __shared__ __attribute__((aligned(16))) char smem[]
#endif

DI void transpose_item(const float* W, int ldw, int K, bf16* Wt, int k0, int src_n0, int dst_n0, float* scr, int lane, int il = 0) {
#pragma unroll 8
    for (int i = 0; i < 32; ++i) { const int kk = 2 * i + (lane >> 5); scr[kk * 33 + (lane & 31)] = W[(size_t)(k0 + kk) * ldw + src_n0 + (lane & 31)]; }
    WAVE_SYNC();
    const int c = lane & 7;
#pragma unroll
    for (int j = 0; j < 4; ++j) {
        const int n = (lane >> 3) + 8 * j; const float* s = scr + (8 * c) * 33 + n;
        u32x4 o; o.x = pk2(s[0 * 33], s[1 * 33]); o.y = pk2(s[2 * 33], s[3 * 33]); o.z = pk2(s[4 * 33], s[5 * 33]); o.w = pk2(s[6 * 33], s[7 * 33]);
        const int hid = dst_n0 + n, drow = il ? 8 * (hid >> 2) + 4 * (il - 1) + (hid & 3) : hid;
        *(u32x4*)(Wt + (size_t)drow * K + k0 + 8 * c) = o;
    }
    WAVE_SYNC();
}

DI void phase0(const Params& p, char* smem, int bid, int nblk) {
    const int tid = fresh_tid(), lane = tid & 63, wave = tid >> 6;
    const int gw = bid * 8 + wave, NGW = nblk * 8;
    unsigned char* ws = p.ws;
    if (bid == 0) {
        unsigned* ctl = (unsigned*)(ws + OFF_SMALL + SM_CTL);
        for (int i = tid; i < 1024; i += NT) ctl[i] = 0u;
        if (tid < 32) { ctl[CW_ECNT + tid * ECNT_STRIDE] = 0u; ctl[CW_NRM + tid * NRM_STRIDE] = 0u; }
        float* be = (float*)(ws + OFF_SMALL + SM_BETA); float* gg = (float*)(ws + OFF_SMALL + SM_G);
        for (int i = tid; i < 48 * 8; i += NT) { be[i] = 0.f; gg[i] = 0.f; }
    }
    {
        float* scr = (float*)(smem + 65536) + wave * (64 * 33);
        constexpr int I_IN = 16 * (9216 / 32), I_SQ = 16 * 32;
        constexpr int NITEMS = I_IN + 3 * I_SQ;
        for (int it = gw; it < NITEMS; it += NGW) {
            int r = it;
            if (r < I_IN) { const int kb = r / 288, nb = r % 288; const int dn = nb * 32; const int sn = dn < 7168 ? dn : dn + 16;
                transpose_item(p.in[3], W_IN_COLS, 1024, (bf16*)(ws + OFF_WTIN), kb * 64, sn, dn, scr, lane); continue; }
            r -= I_IN;
            const int m = r / I_SQ; r %= I_SQ;
            const float* src = m == 0 ? p.in[13] : (m == 1 ? p.in[14] : p.in[15]);
            bf16* dst = (bf16*)(ws + (m == 0 ? OFF_WTBA : (m == 1 ? OFF_WTBD : OFF_WTOUT)));
            transpose_item(src, 1024, 1024, dst, (r / 32) * 64, (r % 32) * 32, (r % 32) * 32, scr, lane);
        }
    }
    {
        bf16* WH = (bf16*)(ws + OFF_SMALL + SM_WR); bf16* WL = WH + 64 * 1024;
        for (int i = bid * NT + tid; i < 64 * 1024; i += nblk * NT) {
            const int n = i >> 10, kk = i & 1023; float v = 0.f;
            if (n < 4) v = p.in[17][kk * 4 + n]; else if (n < 36) v = p.in[19][kk * 32 + (n - 4)];
            v *= p.in[16][kk];
            const unsigned hb = f2bf(v); const float lo = v - bf2f(hb);
            WH[i] = (bf16)hb; WL[i] = (bf16)f2bf(lo);
        }
    }
    float* wbd = (float*)smem;
    for (int i = tid; i < 1024 * 16; i += NT) { const int k = i >> 4, c = i & 15; wbd[c * 1024 + k] = p.in[3][(size_t)k * W_IN_COLS + 7168 + c]; }
    __syncthreads();
    const float* nw = p.in[2];
    for (int R = gw; R < LTOK; R += NGW) {
        const float* xrow = R < NMETA ? p.in[1] + (size_t)R * D : p.in[0] + (size_t)(R - NMETA) * D;
        bf16* urow = R < NMETA ? (bf16*)(ws + OFF_SMALL + SM_UMETA) + (size_t)R * D : (bf16*)(ws + OFF_U) + (size_t)(R - NMETA) * D;
        float ss = 0.f;
#pragma unroll
        for (int j = 0; j < 4; ++j) { const float4 v = *(const float4*)(xrow + 4 * lane + 256 * j); ss += v.x * v.x + v.y * v.y + v.z * v.z + v.w * v.w; }
        ss = wave_sum(ss);
        const float rstd = rsqrtf(ss * (1.0f / D) + NORM_EPS);
        float acc[16];
#pragma unroll
        for (int c = 0; c < 16; ++c) acc[c] = 0.f;
#pragma unroll 1
        for (int j = 0; j < 4; ++j) {
            const float4 w4 = *(const float4*)(nw + 4 * lane + 256 * j);
            const float4 xv = *(const float4*)(xrow + 4 * lane + 256 * j);
            float uu[4] = {xv.x * rstd * w4.x, xv.y * rstd * w4.y, xv.z * rstd * w4.z, xv.w * rstd * w4.w};
            u32x2 o; o.x = pk2(uu[0], uu[1]); o.y = pk2(uu[2], uu[3]);
            *(u32x2*)(urow + 4 * lane + 256 * j) = o;
#pragma unroll
            for (int c = 0; c < 16; ++c) {
                const f32x4 w = *(const f32x4*)(wbd + c * 1024 + 4 * lane + 256 * j);
                acc[c] += uu[0] * w[0] + uu[1] * w[1] + uu[2] * w[2] + uu[3] * w[3];
            }
        }
        float v8[8], v4[4], v2[2], a;
        {
            const bool b0 = lane & 1, b1 = lane & 2, b2 = lane & 4, b3 = lane & 8;
#pragma unroll
            for (int i = 0; i < 8; ++i) { const float keep = b0 ? acc[i + 8] : acc[i], send = b0 ? acc[i] : acc[i + 8]; v8[i] = keep + __shfl_xor(send, 1); }
#pragma unroll
            for (int i = 0; i < 4; ++i) { const float keep = b1 ? v8[i + 4] : v8[i], send = b1 ? v8[i] : v8[i + 4]; v4[i] = keep + __shfl_xor(send, 2); }
#pragma unroll
            for (int i = 0; i < 2; ++i) { const float keep = b2 ? v4[i + 2] : v4[i], send = b2 ? v4[i] : v4[i + 2]; v2[i] = keep + __shfl_xor(send, 4); }
            { const float keep = b3 ? v2[1] : v2[0], send = b3 ? v2[0] : v2[1]; a = keep + __shfl_xor(send, 8); }
            a += __shfl_xor(a, 16); a += __shfl_xor(a, 32);
        }
        if (lane < 16) {
            const int cc = ((lane & 1) << 3) | ((lane & 2) << 1) | ((lane & 4) >> 1) | ((lane & 8) >> 3);
            const size_t pos = 48 + R;
            if (cc < 8) { ((float*)(ws + OFF_SMALL + SM_BETA))[pos * 8 + cc] = sigmoidf_(a); }
            else { const int hh = cc - 8; const float z = a + p.in[11][hh]; const float sp = fmaxf(z, 0.f) + log1pf(__expf(-fabsf(z)));
                   ((float*)(ws + OFF_SMALL + SM_G))[pos * 8 + hh] = -__expf(p.in[10][hh]) * sp; }
        }
    }
}

namespace pg8 {
constexpr int BM = 256, BK = 64, HALF = 128, HTB = HALF * BK * 2, NXCD = 8, WGM = 8;
DI int lds_byte(int r, int c) { const int st = (r >> 4) * 2 + (c >> 5), rr = r & 15, cc = c & 31, ob = rr * 64 + cc * 2; return st * 1024 + (ob ^ (((ob >> 9) & 1) << 5)); }
DI void stage_rc(int b, int& R, int& C) { const int st = b / 1024, sb = b % 1024, swz = sb ^ (((sb >> 9) & 1) << 5); R = (st >> 1) * 16 + swz / 64; C = (st & 1) * 32 + (swz % 64) / 2; }
DI int perm32(int rho) { const int n = rho >> 4, i = rho & 15; return 8 * (i >> 2) + 4 * n + (i & 3); }
struct Unit { int pm, pn, e, half; };
struct Gemm { const bf16* A; const bf16* Bt; int M, N, K; };
struct StaticOrder {
    static constexpr bool GATHER = false;
    int nM, nN, nwg, G, c;
    DM void init(int M, int N, int G_, int c_) { nM = M / BM; nN = N / BM; nwg = nM * nN; G = G_; c = c_; }
    DM bool next(int i, Unit& u) const {
        const long L = (long)i * G + c; if (L >= nwg) return false;
        int wgid = (int)L; { const int q = nwg / NXCD, r = nwg % NXCD, xcd = wgid % NXCD, off = wgid / NXCD; wgid = (xcd < r ? xcd * (q + 1) : r * (q + 1) + (xcd - r) * q) + off; }
        const int nig = WGM * nN, gid = wgid / nig, fm = gid * WGM, gsz = (nM - fm) < WGM ? (nM - fm) : WGM;
        u.pm = fm + ((wgid % nig) % gsz); u.pn = (wgid % nig) / gsz; u.e = 0; u.half = 0; return true;
    }
    DM const char* a_tile(const Gemm& g, const Unit& u) const { return (const char*)g.A + (size_t)u.pm * 256 * g.K * 2; }
    DM const char* b_tile(const Gemm& g, const Unit& u) const { return (const char*)g.Bt + (size_t)u.pn * 256 * g.K * 2; }
    DM int a_row(const Unit&, int) const { return 0; }
};
#ifdef EMU
template <class Epi, class Sched>
DI void gemm_phase(char* lds, const Gemm g, const Sched& S, const Epi& E) {
    const int tid = threadIdx.x, wid = tid >> 6, lane = tid & 63, wr = wid >> 2, wc = wid & 3, fr = lane & 15, fq = lane >> 4;
    Unit u;
    for (int ui = 0; S.next(ui, u); ++ui) {
        f32x4 acc[2][2][4][2];
        const bf16* bt = (const bf16*)S.b_tile(g, u);
        for (int ai = 0; ai < 2; ++ai) for (int bj = 0; bj < 2; ++bj) for (int m = 0; m < 4; ++m) for (int n = 0; n < 2; ++n) for (int e = 0; e < 4; ++e) {
            const int r = 128 * ai + 64 * wr + 16 * m + fr;
            const int c = 128 * bj + 32 * wc + (Epi::PERM ? 8 * fq + 4 * n : 16 * n + 4 * fq) + e;
            const bf16* a = Sched::GATHER ? g.A + (size_t)S.a_row(u, r) * g.K : (const bf16*)S.a_tile(g, u) + (size_t)r * g.K;
            const bf16* b = bt + (size_t)c * g.K; float s = 0.f;
            for (int kk = 0; kk < g.K; ++kk) s += bf2f(a[kk]) * bf2f(b[kk]);
            acc[ai][bj][m][n][e] = s;
        }
        E(acc, u, wr, wc, fr, fq);
    }
    __syncthreads();
}
#else
#define PG8_LAS __attribute__((address_space(3)))
template <class Epi, class Sched>
__device__ __forceinline__ void gemm_phase(char* lds_, const Gemm g, const Sched& S, const Epi& E) {
    PG8_LAS unsigned char* lds = (PG8_LAS unsigned char*)lds_;
    const int tid = fresh_tid(), wid = __builtin_amdgcn_readfirstlane(tid >> 6), lane = tid & 63, wr = wid >> 2, wc = wid & 3, fr = lane & 15, fq = lane >> 4;
    const int K = g.K, nt = K / BK;
    unsigned voffA[2], voffB[2]; int RA[2], CA[2];
#pragma unroll
    for (int i = 0; i < 2; ++i) { int R, C; stage_rc(tid * 16 + i * 8192, R, C); const int Rb = Epi::PERM ? ((R & ~31) + perm32(R & 31)) : R;
        voffA[i] = (unsigned)(R * K + C) * 2u; voffB[i] = (unsigned)(Rb * K + C) * 2u; RA[i] = R; CA[i] = C; }
    const size_t kstep = (size_t)(BK * 2);
    const size_t hstep = (size_t)HALF * K * 2;
    const unsigned ldsw = (unsigned)wid * 1024u;
    const int aoff = lds_byte(wr * 64 + fr, fq * 8), boff = lds_byte(wc * 32 + fr, fq * 8);
#define PG8_SA(b, h) (((b) * 2 + (h)) * HTB)
#define PG8_SB(b, h) ((4 + (b) * 2 + (h)) * HTB)
#define PG8_STAGE(bufoff, gbase, voff) do { _Pragma("unroll") for (int _i = 0; _i < 2; ++_i) \
        __builtin_amdgcn_global_load_lds((const unsigned*)((const char*)(gbase) + (voff)[_i]), (PG8_LAS unsigned*)(lds + (bufoff) + ldsw + _i * 8192), 16, 0, 0); } while (0)
#define PG8_STAGE_A(bufoff, base, PA, half, koff) do { if constexpr (Sched::GATHER) { _Pragma("unroll") for (int _i = 0; _i < 2; ++_i) \
        __builtin_amdgcn_global_load_lds((const unsigned*)((PA)[half][_i] + (koff)), (PG8_LAS unsigned*)(lds + (bufoff) + ldsw + _i * 8192), 16, 0, 0); } \
        else { PG8_STAGE(bufoff, (base) + (half) * hstep + (koff), voffA); } } while (0)
#define PG8_LDA(dst, b, h) do { _Pragma("unroll") for (int m = 0; m < 4; ++m) _Pragma("unroll") for (int k = 0; k < 2; ++k) dst[m][k] = *(const PG8_LAS bf16x8*)(lds + PG8_SA(b, h) + aoff + m * 2048 + k * 1024); } while (0)
#define PG8_LDB(dst, b, h) do { _Pragma("unroll") for (int n = 0; n < 2; ++n) _Pragma("unroll") for (int k = 0; k < 2; ++k) dst[n][k] = *(const PG8_LAS bf16x8*)(lds + PG8_SB(b, h) + boff + n * 2048 + k * 1024); } while (0)
#define PG8_MMA(ai, bj, At, Bt) do { __builtin_amdgcn_s_setprio(1); _Pragma("unroll") for (int m = 0; m < 4; ++m) _Pragma("unroll") for (int n = 0; n < 2; ++n) _Pragma("unroll") for (int k = 0; k < 2; ++k) \
        acc[ai][bj][m][n] = __builtin_amdgcn_mfma_f32_16x16x32_bf16(Bt[n][k], At[m][k], acc[ai][bj][m][n], 0, 0, 0); __builtin_amdgcn_s_setprio(0); } while (0)
#define PG8_MMA_H(ai, bj, At, Bt) do { if (!half_cur) PG8_MMA(ai, bj, At, Bt); } while (0)
#define PG8_WAIT_V(n) asm volatile("s_waitcnt vmcnt(" #n ")" ::: "memory")
#define PG8_WAIT_L(n) asm volatile("s_waitcnt lgkmcnt(" #n ")" ::: "memory")
#define PG8_BAR __builtin_amdgcn_s_barrier()
#define PG8_SCHED __builtin_amdgcn_sched_barrier(0)
    Unit cur, nxt; int ui = 0;
    if (S.next(0, cur)) {
    f32x4 acc[2][2][4][2];
#pragma unroll
    for (int a = 0; a < 2; ++a)
#pragma unroll
        for (int b = 0; b < 2; ++b)
#pragma unroll
            for (int m = 0; m < 4; ++m)
#pragma unroll
                for (int n = 0; n < 2; ++n) acc[a][b][m][n] = (f32x4){0.f, 0.f, 0.f, 0.f};
    bf16x8 At[4][2], B0[2][2], B1[2][2];
    const char* PAc[2][2]; const char* PAn[2][2];
    auto gather_ptrs = [&](const Unit& u, const char* (&PA)[2][2]) {
        if constexpr (Sched::GATHER) {
#pragma unroll
            for (int hh = 0; hh < 2; ++hh)
#pragma unroll
                for (int i = 0; i < 2; ++i) PA[hh][i] = (const char*)g.A + ((size_t)S.a_row(u, hh * 128 + RA[i]) * K + CA[i]) * 2;
        }
    };
    const char* cA = Sched::GATHER ? nullptr : S.a_tile(g, cur); const char* cB = S.b_tile(g, cur);
    gather_ptrs(cur, PAc);
    PG8_STAGE(PG8_SB(0, 0), cB, voffB); PG8_STAGE_A(PG8_SA(0, 0), cA, PAc, 0, 0); PG8_STAGE(PG8_SB(0, 1), cB + hstep, voffB); PG8_STAGE_A(PG8_SA(0, 1), cA, PAc, 1, 0);
    if (wr == 1) PG8_BAR;
    PG8_WAIT_V(4); PG8_BAR;
    PG8_STAGE(PG8_SB(1, 0), cB + kstep, voffB); PG8_STAGE_A(PG8_SA(1, 0), cA, PAc, 0, kstep); PG8_STAGE(PG8_SB(1, 1), cB + hstep + kstep, voffB);
    PG8_WAIT_V(6); PG8_BAR;
    for (;;) {
        const bool has_next = S.next(ui + 1, nxt);
        const bool half_cur = __builtin_amdgcn_readfirstlane(cur.half) != 0;
        const char* nA = Sched::GATHER ? nullptr : (has_next ? S.a_tile(g, nxt) : cA); const char* nB = has_next ? S.b_tile(g, nxt) : cB;
        if (has_next) gather_ptrs(nxt, PAn); else { if constexpr (Sched::GATHER) { PAn[0][0] = PAc[0][0]; PAn[0][1] = PAc[0][1]; PAn[1][0] = PAc[1][0]; PAn[1][1] = PAc[1][1]; } }
        for (int t = 0; t < nt; t += 2) {
            const bool last = (t == nt - 2);
            const size_t k1 = (size_t)(t + 1) * kstep;
            const char* a2 = last ? nA : cA; const char* b2 = last ? nB : cB + (size_t)(t + 2) * kstep;
            const size_t k2 = last ? 0 : (size_t)(t + 2) * kstep, k3 = k2 + kstep;
            const char* b3 = b2 + kstep;
            const char* P2[2][2];
            if constexpr (Sched::GATHER) {
#pragma unroll
                for (int hh = 0; hh < 2; ++hh)
#pragma unroll
                    for (int i = 0; i < 2; ++i) P2[hh][i] = last ? PAn[hh][i] : PAc[hh][i];
            }
            PG8_LDB(B0, 0, 0); PG8_SCHED; PG8_LDA(At, 0, 0); PG8_STAGE_A(PG8_SA(1, 1), cA, PAc, 1, k1);
            PG8_WAIT_L(8); PG8_BAR; PG8_WAIT_L(0); PG8_MMA(0, 0, At, B0); PG8_BAR; PG8_SCHED;
            PG8_LDB(B1, 0, 1); PG8_STAGE(PG8_SB(0, 0), b2, voffB);
            PG8_BAR; PG8_WAIT_L(0); PG8_MMA(0, 1, At, B1); PG8_BAR;
            PG8_LDA(At, 0, 1); PG8_STAGE_A(PG8_SA(0, 0), a2, P2, 0, k2);
            PG8_BAR; PG8_WAIT_L(0); PG8_MMA_H(1, 0, At, B0); PG8_BAR; PG8_SCHED;
            PG8_STAGE(PG8_SB(0, 1), b2 + hstep, voffB);
            PG8_WAIT_V(6); PG8_BAR; PG8_MMA_H(1, 1, At, B1); PG8_BAR;
            PG8_LDB(B0, 1, 0); PG8_SCHED; PG8_LDA(At, 1, 0); PG8_STAGE_A(PG8_SA(0, 1), a2, P2, 1, k2);
            PG8_WAIT_L(8); PG8_BAR; PG8_WAIT_L(0); PG8_MMA(0, 0, At, B0); PG8_BAR; PG8_SCHED;
            PG8_LDB(B1, 1, 1); PG8_STAGE(PG8_SB(1, 0), b3, voffB);
            PG8_BAR; PG8_WAIT_L(0); PG8_MMA(0, 1, At, B1); PG8_BAR;
            PG8_LDA(At, 1, 1); PG8_STAGE_A(PG8_SA(1, 0), a2, P2, 0, k3);
            PG8_BAR; PG8_WAIT_L(0); PG8_MMA_H(1, 0, At, B0); PG8_BAR; PG8_SCHED;
            PG8_STAGE(PG8_SB(1, 1), b3 + hstep, voffB);
            PG8_WAIT_V(6); PG8_BAR; PG8_MMA_H(1, 1, At, B1); PG8_BAR;
        }
        E(acc, cur, wr, wc, fr, fq);
        if (!has_next) break;
#pragma unroll
        for (int a = 0; a < 2; ++a)
#pragma unroll
            for (int b = 0; b < 2; ++b)
#pragma unroll
                for (int m = 0; m < 4; ++m)
#pragma unroll
                    for (int n = 0; n < 2; ++n) acc[a][b][m][n] = (f32x4){0.f, 0.f, 0.f, 0.f};
        cur = nxt; cA = nA; cB = nB; ++ui;
        if constexpr (Sched::GATHER) { PAc[0][0] = PAn[0][0]; PAc[0][1] = PAn[0][1]; PAc[1][0] = PAn[1][0]; PAc[1][1] = PAn[1][1]; }
    }
    PG8_WAIT_V(0);
    if (wr == 0) PG8_BAR;
    PG8_BAR;
    }
    __syncthreads();
#undef PG8_SA
#undef PG8_SB
#undef PG8_STAGE
#undef PG8_STAGE_A
#undef PG8_LDA
#undef PG8_LDB
#undef PG8_MMA
#undef PG8_MMA_H
#undef PG8_WAIT_V
#undef PG8_WAIT_L
#undef PG8_BAR
#undef PG8_SCHED
}
#endif
}

constexpr int G_BM = 256, G_BN = 128, G_BK = 64;
constexpr int G_LDS_A = G_BM * G_BK * 2, G_LDS_B = G_BN * G_BK * 2;
constexpr int G_STAGE_PITCH = 132;
constexpr int G_LDS_BYTES = G_BM * G_STAGE_PITCH * 4;
constexpr int G_MT = SEQ / 256 + 1, G_NTILES = 56;

DI void gemm_inproj_tile(const Params& p, char* smem, int mt, int nt) {
    const int tid = fresh_tid(), lane = tid & 63, wave = tid >> 6;
    const int wm = wave >> 1, wn = wave & 1, r32 = lane & 31, h = lane >> 5;
    unsigned char* ws = p.ws;
    const bool meta = (mt == G_MT - 1);
    const bf16* A = meta ? (const bf16*)(ws + OFF_SMALL + SM_UMETA) : (const bf16*)(ws + OFF_U) + (size_t)mt * 256 * D;
    const int vrows = meta ? NMETA : 256;
    const bf16* Bt = (const bf16*)(ws + OFF_WTIN) + (size_t)nt * 128 * D;
    char* ldsA[2] = {smem, smem + G_LDS_A + G_LDS_B};
    char* ldsB[2] = {smem + G_LDS_A, smem + 2 * G_LDS_A + G_LDS_B};
    f32x16 acc[2][2];
#pragma unroll
    for (int i = 0; i < 2; ++i)
#pragma unroll
        for (int j = 0; j < 2; ++j) acc[i][j] = zero16();
    const int lrow = tid >> 3, lc = tid & 7;
    u32x4 ra[4], rb[2];
    auto gload = [&](int kt) {
#pragma unroll
        for (int i = 0; i < 4; ++i) { const int row = lrow + 64 * i; ra[i] = row < vrows ? *(const u32x4*)(A + (size_t)row * D + kt * 64 + lc * 8) : (u32x4){0u, 0u, 0u, 0u}; }
#pragma unroll
        for (int i = 0; i < 2; ++i) { const int row = lrow + 64 * i; rb[i] = *(const u32x4*)(Bt + (size_t)row * D + kt * 64 + lc * 8); }
    };
    auto lstore = [&](int buf) {
#pragma unroll
        for (int i = 0; i < 4; ++i) *(u32x4*)(ldsA[buf] + swz128(lrow + 64 * i, lc)) = ra[i];
#pragma unroll
        for (int i = 0; i < 2; ++i) *(u32x4*)(ldsB[buf] + swz128(lrow + 64 * i, lc)) = rb[i];
    };
    gload(0); lstore(0); __syncthreads();
    for (int kt = 0; kt < 16; ++kt) {
        const int buf = kt & 1;
        if (kt + 1 < 16) gload(kt + 1);
#pragma unroll
        for (int ks = 0; ks < 4; ++ks) {
            bf16x8 af[2], bfr[2];
#pragma unroll
            for (int i = 0; i < 2; ++i) af[i] = *(const bf16x8*)(ldsA[buf] + swz128(64 * wm + 32 * i + r32, 2 * ks + h));
#pragma unroll
            for (int j = 0; j < 2; ++j) bfr[j] = *(const bf16x8*)(ldsB[buf] + swz128(64 * wn + 32 * j + r32, 2 * ks + h));
#pragma unroll
            for (int i = 0; i < 2; ++i)
#pragma unroll
                for (int j = 0; j < 2; ++j) if (!meta || (wm == 0 && i == 0)) acc[i][j] = MFMA32(af[i], bfr[j], acc[i][j]);
        }
        if (kt + 1 < 16) lstore(buf ^ 1);
        __syncthreads();
    }
    float* st = (float*)smem;
#pragma unroll
    for (int i = 0; i < 2; ++i)
#pragma unroll
        for (int j = 0; j < 2; ++j)
#pragma unroll
            for (int r = 0; r < 16; ++r) {
                const int row = 64 * wm + 32 * i + (r & 3) + 8 * (r >> 2) + 4 * h, col = 64 * wn + 32 * j + r32;
                st[row * G_STAGE_PITCH + col] = acc[i][j][r];
            }
    __syncthreads();
    const int tid2 = fresh_tid();
    const int sec = nt >> 3, cb = (nt & 7) * 128;
    {
        bf16* base; bool has_meta = true; bf16* mbase = nullptr; int mrow0 = 0;
        if (sec == 0) { base = (bf16*)(ws + OFF_AQ); has_meta = false; }
        else if (sec == 1) { base = (bf16*)p.out; mbase = (bf16*)(ws + OFF_SMALL + SM_AKMETA); }
        else if (sec == 2) { base = (bf16*)p.out + (size_t)SEQ * D; mbase = (bf16*)(ws + OFF_SMALL + SM_AVTMETA); }
        else if (sec == 3) { base = (bf16*)(ws + OFF_QN); mbase = (bf16*)(ws + OFF_SMALL + SM_C0Q); mrow0 = 48; }
        else if (sec == 4) { base = (bf16*)(ws + OFF_KN); mbase = (bf16*)(ws + OFF_SMALL + SM_C0K); mrow0 = 48; }
        else if (sec == 5) { base = (bf16*)(ws + OFF_V); mbase = (bf16*)(ws + OFF_SMALL + SM_C0V); mrow0 = 48; }
        else { base = (bf16*)(ws + OFF_DG); has_meta = false; }
        const bool dqkv = (sec >= 3 && sec <= 5);
        bf16* tails = (bf16*)(ws + OFF_SMALL + SM_TAILS);
        if (!meta || has_meta) {
#pragma unroll
            for (int i = 0; i < 8; ++i) {
                const int idx = tid2 + NT * i, row = idx >> 4, cg = idx & 15;
                if (row < vrows) {
                    const float* s = st + row * G_STAGE_PITCH + cg * 8;
                    const f32x4 a = *(const f32x4*)s, b = *(const f32x4*)(s + 4);
                    u32x4 o; o.x = pk2(a[0], a[1]); o.y = pk2(a[2], a[3]); o.z = pk2(b[0], b[1]); o.w = pk2(b[2], b[3]);
                    if (!meta) {
                        const int j = mt * 256 + row;
                        *(u32x4*)(base + (size_t)j * D + cb + cg * 8) = o;
                        if (dqkv && (j & 63) >= 61) *(u32x4*)(tails + ((size_t)(j / 64 + 1) * 3 + ((j & 63) - 61)) * 3072 + (sec - 3) * 1024 + cb + cg * 8) = o;
                    } else if (sec == 2) {
                        mbase[(size_t)(cb + cg * 8 + 0) * NMETA + row] = (bf16)(o.x & 0xffffu); mbase[(size_t)(cb + cg * 8 + 1) * NMETA + row] = (bf16)(o.x >> 16);
                        mbase[(size_t)(cb + cg * 8 + 2) * NMETA + row] = (bf16)(o.y & 0xffffu); mbase[(size_t)(cb + cg * 8 + 3) * NMETA + row] = (bf16)(o.y >> 16);
                        mbase[(size_t)(cb + cg * 8 + 4) * NMETA + row] = (bf16)(o.z & 0xffffu); mbase[(size_t)(cb + cg * 8 + 5) * NMETA + row] = (bf16)(o.z >> 16);
                        mbase[(size_t)(cb + cg * 8 + 6) * NMETA + row] = (bf16)(o.w & 0xffffu); mbase[(size_t)(cb + cg * 8 + 7) * NMETA + row] = (bf16)(o.w >> 16);
                    } else {
                        *(u32x4*)(mbase + (size_t)(mrow0 + row) * D + cb + cg * 8) = o;
                        if (dqkv && row >= 13) *(u32x4*)(tails + ((size_t)0 * 3 + (row - 13)) * 3072 + (sec - 3) * 1024 + cb + cg * 8) = o;
                    }
                }
            }
        }
    }
    __syncthreads();
}

struct EpiInproj {
    static constexpr bool PERM = true;
    unsigned char* ws; bf16* out16;
    DM void operator()(const f32x4 (&acc)[2][2][4][2], const pg8::Unit& u, int wr, int wc, int fr, int fq) const {
        if (u.e) {
            bf16* vt = out16 + (size_t)SEQ * D;
            const int e0 = (u.pn - 8) * 256 + wr * 64 + fr, t0 = u.pm * 256 + wc * 32 + 8 * fq;
#pragma unroll
            for (int ai = 0; ai < 2; ++ai)
#pragma unroll
                for (int m = 0; m < 4; ++m)
#pragma unroll
                    for (int bj = 0; bj < 2; ++bj) {
                        const f32x4 v0 = acc[ai][bj][m][0], v1 = acc[ai][bj][m][1];
                        const int e = e0 + ai * 128 + m * 16, t = t0 + bj * 128;
                        *(u32x4*)(vt + (size_t)e * SEQ + ((((t >> 6) + 17 * e) & (SEQ / 64 - 1)) << 6) + (t & 63)) = (u32x4){pk2(v0[0], v0[1]), pk2(v0[2], v0[3]), pk2(v1[0], v1[1]), pk2(v1[2], v1[3])};
                    }
            return;
        }
        const int colt = u.pn * 256, sec = colt >> 10, cb = colt & 1023;
        bf16* base = sec == 0 ? (bf16*)(ws + OFF_AQ) : sec == 1 ? out16 : sec == 2 ? out16 + (size_t)SEQ * D : sec == 3 ? (bf16*)(ws + OFF_QN) : sec == 4 ? (bf16*)(ws + OFF_KN)
                   : sec == 5 ? (bf16*)(ws + OFF_V) : (bf16*)(ws + OFF_DG);
        const bool dqkv = sec >= 3 && sec <= 5;
        bf16* tails = (bf16*)(ws + OFF_SMALL + SM_TAILS) + (sec - 3) * 1024;
        const int row0 = u.pm * 256 + wr * 64 + fr, col0 = cb + wc * 32 + 8 * fq;
#pragma unroll
        for (int ai = 0; ai < 2; ++ai)
#pragma unroll
            for (int m = 0; m < 4; ++m) {
                const int j = row0 + ai * 128 + m * 16;
                bf16* rowp = base + (size_t)j * D + col0;
                const bool tl = dqkv && (j & 63) >= 61;
#pragma unroll
                for (int bj = 0; bj < 2; ++bj) {
                    const f32x4 v0 = acc[ai][bj][m][0], v1 = acc[ai][bj][m][1];
                    const u32x4 w = {pk2(v0[0], v0[1]), pk2(v0[2], v0[3]), pk2(v1[0], v1[1]), pk2(v1[2], v1[3])};
                    *(u32x4*)(rowp + bj * 128) = w;
                    if (tl) *(u32x4*)(tails + ((size_t)(j / 64 + 1) * 3 + ((j & 63) - 61)) * 3072 + col0 + bj * 128) = w;
                }
            }
    }
};
struct InprojOrder : pg8::StaticOrder {
    DM bool next(int i, pg8::Unit& u) const { const bool ok = pg8::StaticOrder::next(i, u); if (ok) u.e = (u.pn >= 8 && u.pn < 12) ? 1 : 0; return ok; }
    DM const char* a_tile(const pg8::Gemm& g, const pg8::Unit& u) const { return u.e ? (const char*)g.Bt + (size_t)u.pn * 256 * g.K * 2 : (const char*)g.A + (size_t)u.pm * 256 * g.K * 2; }
    DM const char* b_tile(const pg8::Gemm& g, const pg8::Unit& u) const { return u.e ? (const char*)g.A + (size_t)u.pm * 256 * g.K * 2 : (const char*)g.Bt + (size_t)u.pn * 256 * g.K * 2; }
};
DI void phase1(const Params& p, char* smem, int bid, int nblk) {
    for (int it = bid; it < 40; it += nblk) gemm_inproj_tile(p, smem, G_MT - 1, 8 + it);
    pg8::Gemm g{(const bf16*)(p.ws + OFF_U), (const bf16*)(p.ws + OFF_WTIN), SEQ, 7168, 1024};
    InprojOrder S; S.init(SEQ, 7168, nblk, bid);
    EpiInproj E{p.ws, (bf16*)p.out};
    pg8::gemm_phase(smem, g, S, E);
}

constexpr int P2_KN = 0, P2_KB = 16384, P2_QN = 32768, P2_KBGT = 49152, P2_VBT = 65536, P2_KDT = 81920, P2_ALDS = 98304, P2_TLDS = P2_ALDS + 64 * 64 * 4,
              P2_GC = P2_TLDS + 8192, P2_BET = P2_GC + 256, P2_EG = P2_BET + 256, P2_EKD = P2_EG + 256, P2_CW = P2_EKD + 256;

DI void prep_item(const Params& p, char* smem, int chunk, int head, int dry, bool load_cw) {
    const int tid = fresh_tid(), lane = tid & 63, wave = tid >> 6, r32 = lane & 31, h = lane >> 5;
    unsigned char* ws = p.ws;
    float* gcl = (float*)(smem + P2_GC); float* betl = (float*)(smem + P2_BET); float* egl = (float*)(smem + P2_EG); float* ekdl = (float*)(smem + P2_EKD);
    if (load_cw) {
        float* cwl = (float*)(smem + P2_CW);
        for (int i = tid; i < 4 * 3 * 128; i += NT) { const int jj = i / 384, rem = i % 384, mat = rem >> 7, c = rem & 127; cwl[i] = p.in[9][(size_t)jj * 3072 + mat * 1024 + head * 128 + c]; }
    }
    const int r = tid >> 3, cg = tid & 7, col0 = head * 128 + 16 * cg;
    const bf16* tails = (const bf16*)(ws + OFF_SMALL + SM_TAILS);
        u32x4 raw[3][4][2];
#pragma unroll
    for (int mat = 0; mat < 3; ++mat) {
        const bf16* mainb = (const bf16*)(ws + (mat == 0 ? OFF_QN : (mat == 1 ? OFF_KN : OFF_V)));
        const bf16* c0b = (const bf16*)(ws + OFF_SMALL + (mat == 0 ? SM_C0Q : (mat == 1 ? SM_C0K : SM_C0V)));
#pragma unroll
        for (int jj = 0; jj < 4; ++jj) {
            const int rr = r - 3 + jj;
            const bf16* src = nullptr;
            if (chunk == 0) { if (rr >= 48) src = c0b + (size_t)rr * D + col0; }
            else if (rr >= 0) src = mainb + ((size_t)(chunk - 1) * 64 + rr) * D + col0;
            else src = tails + ((size_t)(chunk - 1) * 3 + (3 + rr)) * 3072 + mat * 1024 + col0;
            raw[mat][jj][0] = (u32x4){0u, 0u, 0u, 0u}; raw[mat][jj][1] = (u32x4){0u, 0u, 0u, 0u};
            if (src) { raw[mat][jj][0] = *(const u32x4*)src; raw[mat][jj][1] = *(const u32x4*)(src + 8); }
        }
    }
    if (wave == 0) {
        const size_t pos = (size_t)chunk * 64 + lane;
        float v = ((const float*)(ws + OFF_SMALL + SM_G))[pos * 8 + head];
        const float b = ((const float*)(ws + OFF_SMALL + SM_BETA))[pos * 8 + head];
#pragma unroll
        for (int o = 1; o < 64; o <<= 1) { const float t = __shfl_up(v, o); if (lane >= o) v += t; }
        const float gl = __shfl(v, 63);
        gcl[lane] = v; betl[lane] = b; egl[lane] = __expf(v); ekdl[lane] = __expf(gl - v);
        if (!dry) ((float*)(ws + OFF_SMALL + SM_GC))[((size_t)chunk * 8 + head) * 64 + lane] = v;
    }
    __syncthreads();
    {
        const bool zero_row = (chunk == 0 && r < 48);
        const float beta = betl[r], eg = egl[r], ekd = ekdl[r];
#pragma unroll
        for (int mat = 0; mat < 3; ++mat) {
            bf16* mainb = (bf16*)(ws + (mat == 0 ? OFF_QN : (mat == 1 ? OFF_KN : OFF_V)));
            bf16* c0b = (bf16*)(ws + OFF_SMALL + (mat == 0 ? SM_C0Q : (mat == 1 ? SM_C0K : SM_C0V)));
            float y[16];
#pragma unroll
            for (int c = 0; c < 16; ++c) y[c] = 0.f;
#pragma unroll
            for (int jj = 0; jj < 4; ++jj) {
                const u32x4 a = raw[mat][jj][0], b = raw[mat][jj][1];
                const float* cw = (const float*)(smem + P2_CW) + (jj * 3 + mat) * 128 + 16 * cg;
                const f32x4 w0 = *(const f32x4*)cw, w1 = *(const f32x4*)(cw + 4), w2 = *(const f32x4*)(cw + 8), w3 = *(const f32x4*)(cw + 12);
                y[0] += w0[0] * bflo(a.x); y[1] += w0[1] * bfhi(a.x); y[2] += w0[2] * bflo(a.y); y[3] += w0[3] * bfhi(a.y);
                y[4] += w1[0] * bflo(a.z); y[5] += w1[1] * bfhi(a.z); y[6] += w1[2] * bflo(a.w); y[7] += w1[3] * bfhi(a.w);
                y[8] += w2[0] * bflo(b.x); y[9] += w2[1] * bfhi(b.x); y[10] += w2[2] * bflo(b.y); y[11] += w2[3] * bfhi(b.y);
                y[12] += w3[0] * bflo(b.z); y[13] += w3[1] * bfhi(b.z); y[14] += w3[2] * bflo(b.w); y[15] += w3[3] * bfhi(b.w);
            }
            if (mat == 0) __syncthreads();
            float ss = 0.f;
#pragma unroll
            for (int c = 0; c < 16; ++c) { y[c] = zero_row ? 0.f : siluf_(y[c]); ss += y[c] * y[c]; }
            if (mat < 2) {
                ss += __shfl_xor(ss, 1); ss += __shfl_xor(ss, 2); ss += __shfl_xor(ss, 4);
                const float sc = rsqrtf(ss + 1e-6f) * (mat == 0 ? 0.08838834764831845f : 1.0f);
                unsigned pk[8];
#pragma unroll
                for (int c = 0; c < 8; ++c) pk[c] = pk2(y[2 * c] * sc, y[2 * c + 1] * sc);
                if (mat == 0) {
                    *(u32x4*)(smem + P2_QN + swzrow(r, 256, 2 * cg)) = (u32x4){pk[0], pk[1], pk[2], pk[3]};
                    *(u32x4*)(smem + P2_QN + swzrow(r, 256, 2 * cg + 1)) = (u32x4){pk[4], pk[5], pk[6], pk[7]};
                    unsigned qd[8];
#pragma unroll
                    for (int c = 0; c < 8; ++c) qd[c] = pk2(bflo(pk[c]) * eg, bfhi(pk[c]) * eg);
                    bf16* dst = (chunk == 0) ? c0b + (size_t)r * D + col0 : mainb + ((size_t)(chunk - 1) * 64 + r) * D + col0;
                    if (!dry) { *(u32x4*)dst = (u32x4){qd[0], qd[1], qd[2], qd[3]}; *(u32x4*)(dst + 8) = (u32x4){qd[4], qd[5], qd[6], qd[7]}; }
                } else {
                    *(u32x4*)(smem + P2_KN + swzrow(r, 256, 2 * cg)) = (u32x4){pk[0], pk[1], pk[2], pk[3]};
                    *(u32x4*)(smem + P2_KN + swzrow(r, 256, 2 * cg + 1)) = (u32x4){pk[4], pk[5], pk[6], pk[7]};
                    unsigned kb[8];
#pragma unroll
                    for (int c = 0; c < 8; ++c) {
                        const float kr0 = bflo(pk[c]), kr1 = bfhi(pk[c]);
                        const float k0 = kr0 * beta, k1 = kr1 * beta;
                        kb[c] = pk2(k0, k1);
                        const int d0 = 16 * cg + 2 * c;
                        *(bf16*)(smem + P2_KBGT + swz128t(d0, r >> 3) + (r & 7) * 2) = (bf16)f2bf(k0 * eg);
                        *(bf16*)(smem + P2_KBGT + swz128t(d0 + 1, r >> 3) + (r & 7) * 2) = (bf16)f2bf(k1 * eg);
                        *(bf16*)(smem + P2_KDT + swz128t(d0, r >> 3) + (r & 7) * 2) = (bf16)f2bf(kr0 * ekd);
                        *(bf16*)(smem + P2_KDT + swz128t(d0 + 1, r >> 3) + (r & 7) * 2) = (bf16)f2bf(kr1 * ekd);
                    }
                    *(u32x4*)(smem + P2_KB + swzrow(r, 256, 2 * cg)) = (u32x4){kb[0], kb[1], kb[2], kb[3]};
                    *(u32x4*)(smem + P2_KB + swzrow(r, 256, 2 * cg + 1)) = (u32x4){kb[4], kb[5], kb[6], kb[7]};
                }
            } else {
#pragma unroll
                for (int c = 0; c < 16; ++c) {
                    const int e = 16 * cg + c;
                    *(bf16*)(smem + P2_VBT + swz128t(e, r >> 3) + (r & 7) * 2) = (bf16)f2bf(y[c] * beta);
                }
            }
        }
    }
    __syncthreads();
    {
        const int tile = wave & 3, m0 = tile >> 1, n0 = tile & 1;
        f32x16 acc = zero16();
        if (wave < 4) {
            if (n0 <= m0) {
#pragma unroll
                for (int ks = 0; ks < 8; ++ks) {
                    const bf16x8 a = *(const bf16x8*)(smem + P2_KB + swzrow(32 * m0 + r32, 256, 2 * ks + h));
                    const bf16x8 b = *(const bf16x8*)(smem + P2_KN + swzrow(32 * n0 + r32, 256, 2 * ks + h));
                    acc = MFMA32(a, b, acc);
                }
            }
            float* Al = (float*)(smem + P2_ALDS);
            const int j = 32 * n0 + r32; const float gj = gcl[j];
#pragma unroll
            for (int r = 0; r < 16; ++r) {
                const int i = 32 * m0 + (r & 3) + 8 * (r >> 2) + 4 * h;
                const float dv = acc[r] * __expf(gcl[i] - gj);
                Al[i * 64 + (j & 3) * 16 + (j >> 2)] = (j < i) ? dv : 0.f;
            }
        } else {
            if (m0 <= n0) {
#pragma unroll
                for (int ks = 0; ks < 8; ++ks) {
                    const bf16x8 a = *(const bf16x8*)(smem + P2_KN + swzrow(32 * m0 + r32, 256, 2 * ks + h));
                    const bf16x8 b = *(const bf16x8*)(smem + P2_QN + swzrow(32 * n0 + r32, 256, 2 * ks + h));
                    acc = MFMA32(a, b, acc);
                }
            }
            const int i = 32 * n0 + r32; const float gi = gcl[i];
            bf16* qkb = (chunk == 0) ? (bf16*)(ws + OFF_SMALL + SM_C0QK) + (size_t)head * 4096 : (bf16*)(ws + OFF_QKB) + ((size_t)(chunk - 1) * 8 + head) * 4096;
#pragma unroll
            for (int q4 = 0; q4 < 4; ++q4) {
                const int j0 = 32 * m0 + 8 * q4 + 4 * h; float v[4];
#pragma unroll
                for (int c = 0; c < 4; ++c) { const int j = j0 + c; const float dv = acc[4 * q4 + c] * __expf(gi - gcl[j]); v[c] = (j <= i) ? dv : 0.f; }
                if (!dry) *(u32x2*)(qkb + i * 64 + j0) = (u32x2){pk2(v[0], v[1]), pk2(v[2], v[3])};
            }
        }
        bf16* kbase = (chunk == 0) ? (bf16*)(ws + OFF_SMALL + SM_C0K) : (bf16*)(ws + OFF_KN) + (size_t)(chunk - 1) * 64 * D;
#pragma unroll
        for (int i2 = 0; i2 < 2; ++i2) {
            const int idx = tid + NT * i2, dk = idx >> 3, ch = idx & 7;
            const u32x4 v = *(const u32x4*)(smem + P2_KDT + swz128t(dk, ch));
            if (!dry) *(u32x4*)(kbase + (size_t)(dk >> 1) * D + head * 128 + (dk & 1) * 64 + ch * 8) = v;
        }
    }
    __syncthreads();
    if (wave < 4) {
        const float* Al = (const float*)(smem + P2_ALDS);
        const int c = lane >> 2, q = lane & 3, C = 16 * wave + c;
        float tq[16];
#pragma unroll
        for (int m = 0; m < 16; ++m) tq[m] = 0.f;
#pragma unroll
        for (int P = 0; P < 4; ++P) {
            float pre[16];
#pragma unroll
            for (int ii = 0; ii < 16; ++ii) {
                const float* ar = Al + (16 * P + ii) * 64 + q * 16;
                float s0 = 0.f, s1 = 0.f;
#pragma unroll
                for (int m = 0; m < 4 * P; ++m) { if (m & 1) s1 += ar[m] * tq[m]; else s0 += ar[m] * tq[m]; }
                pre[ii] = s0 + s1;
            }
#pragma unroll
            for (int ii = 0; ii < 16; ++ii) {
                const int i = 16 * P + ii;
                const float* ar = Al + i * 64 + q * 16;
                const int nm = (i + 3) >> 2;
                float s = pre[ii];
#pragma unroll
                for (int m = 4 * P; m < 4 * P + 4; ++m) if (m < nm) s += ar[m] * tq[m];
                s += __shfl_xor(s, 1); s += __shfl_xor(s, 2);
                const float ti = ((i == C) ? 1.f : 0.f) - s;
                if (q == (i & 3)) tq[i >> 2] = ti;
            }
        }
#pragma unroll
        for (int m = 0; m < 16; ++m) { const int row = 4 * m + q; *(bf16*)(smem + P2_TLDS + swz128(row, C >> 3) + (C & 7) * 2) = (bf16)f2bf(tq[m]); }
    }
    __syncthreads();
    {
        const int mi = wave >> 2, ni = wave & 3;
        f32x16 acc = zero16();
#pragma unroll
        for (int ks = 0; ks < 4; ++ks) {
            const bf16x8 a = *(const bf16x8*)(smem + P2_TLDS + swz128(32 * mi + r32, 2 * ks + h));
            const bf16x8 b = *(const bf16x8*)(smem + P2_VBT + swz128t(32 * ni + r32, 2 * ks + h));
            acc = MFMA32(a, b, acc);
        }
        const int e = 32 * ni + r32;
        bf16* base = (chunk == 0) ? (bf16*)(ws + OFF_SMALL + SM_C0V) : (bf16*)(ws + OFF_V) + (size_t)(chunk - 1) * 64 * D;
        bf16* dst = base + (size_t)(e >> 1) * D + head * 128 + (e & 1) * 64;
#pragma unroll
        for (int q4 = 0; q4 < 4; ++q4) {
            const int c0 = 32 * mi + 8 * q4 + 4 * h;
            if (!dry) *(u32x2*)(dst + c0) = (u32x2){pk2(acc[4 * q4], acc[4 * q4 + 1]), pk2(acc[4 * q4 + 2], acc[4 * q4 + 3])};
        }
    }
    {
        const int mi = wave >> 1, ni = wave & 1;
        f32x16 acc = zero16();
#pragma unroll
        for (int ks = 0; ks < 4; ++ks) {
            const bf16x8 a = *(const bf16x8*)(smem + P2_KBGT + swz128t(32 * mi + r32, 2 * ks + h));
            const bf16x8 b = *(const bf16x8*)(smem + P2_TLDS + swz128(32 * ni + r32, 2 * ks + h));
            acc = MFMA32(a, b, acc);
        }
        const int c = 32 * ni + r32;
        bf16* wb = (chunk == 0) ? (bf16*)(ws + OFF_SMALL + SM_C0W) + (size_t)head * 8192 : (bf16*)(ws + OFF_W) + ((size_t)(chunk - 1) * 8 + head) * 8192;
#pragma unroll
        for (int q4 = 0; q4 < 4; ++q4) {
            const int dk0 = 32 * mi + 8 * q4 + 4 * h;
            if (!dry) *(u32x2*)(wb + c * 128 + dk0) = (u32x2){pk2(acc[4 * q4], acc[4 * q4 + 1]), pk2(acc[4 * q4 + 2], acc[4 * q4 + 3])};
        }
    }
    __syncthreads();
}

DI void phase2(const Params& p, char* smem, int bid, int nblk, int dry = 0) {
    { int cur_head = -1; for (int it = bid; it < NCH * 8; it += nblk) { const int hd = it & 7; prep_item(p, smem, it >> 3, hd, dry, hd != cur_head); cur_head = hd; } }
    {
        const int tid = fresh_tid(), lane = tid & 63, wave = tid >> 6;
        const int nextra = (NCH * 8) % nblk, skip = (nextra > 0 && 2 * nextra < nblk) ? nextra : 0;
        const int gw = (bid - skip) * 8 + wave, NGW = (nblk - skip) * 8;
        float mq = 0.f, mk = 0.f;
        auto sq16 = [](const u32x4& a, const u32x4& b) -> float {
            return bflo(a.x) * bflo(a.x) + bfhi(a.x) * bfhi(a.x) + bflo(a.y) * bflo(a.y) + bfhi(a.y) * bfhi(a.y) + bflo(a.z) * bflo(a.z) + bfhi(a.z) * bfhi(a.z) + bflo(a.w) * bflo(a.w) + bfhi(a.w) * bfhi(a.w)
                 + bflo(b.x) * bflo(b.x) + bfhi(b.x) * bfhi(b.x) + bflo(b.y) * bflo(b.y) + bfhi(b.y) * bfhi(b.y) + bflo(b.z) * bflo(b.z) + bfhi(b.z) * bfhi(b.z) + bflo(b.w) * bflo(b.w) + bfhi(b.w) * bfhi(b.w); };
        for (int j0 = (bid < skip ? SEQ + NMETA : gw); j0 < SEQ + NMETA; j0 += 4 * NGW) {
            u32x4 ka[4][2], qa[4][2];
#pragma unroll
            for (int u4 = 0; u4 < 4; ++u4) {
                const int j = j0 + u4 * NGW;
                ka[u4][0] = ka[u4][1] = qa[u4][0] = qa[u4][1] = (u32x4){0u, 0u, 0u, 0u};
                if (j < SEQ + NMETA) {
                    const bf16* kr = j < SEQ ? (const bf16*)p.out + (size_t)j * D + lane * 16 : (const bf16*)(p.ws + OFF_SMALL + SM_AKMETA) + (size_t)(j - SEQ) * D + lane * 16;
                    ka[u4][0] = *(const u32x4*)kr; ka[u4][1] = *(const u32x4*)(kr + 8);
                    if (j < SEQ) { const bf16* qr = (const bf16*)(p.ws + OFF_AQ) + (size_t)j * D + lane * 16; qa[u4][0] = *(const u32x4*)qr; qa[u4][1] = *(const u32x4*)(qr + 8); }
                }
            }
#pragma unroll
            for (int u4 = 0; u4 < 4; ++u4) {
                float s = sq16(ka[u4][0], ka[u4][1]), t = sq16(qa[u4][0], qa[u4][1]);
                s += __shfl_xor(s, 1); s += __shfl_xor(s, 2); t += __shfl_xor(t, 1); t += __shfl_xor(t, 2);
                mk = fmaxf(mk, s); mq = fmaxf(mq, t);
            }
        }
        float* red = (float*)smem;
        __syncthreads();
        if ((lane & 3) == 0) { red[wave * 32 + (lane >> 2)] = mq; red[wave * 32 + 16 + (lane >> 2)] = mk; }
        __syncthreads();
        if (tid < 32) {
            float m = 0.f;
#pragma unroll
            for (int w = 0; w < 8; ++w) m = fmaxf(m, red[w * 32 + tid]);
            unsigned* nrm = (unsigned*)(p.ws + OFF_SMALL + SM_CTL) + CW_NRM;
            atomicMax(nrm + tid * NRM_STRIDE, __builtin_bit_cast(unsigned, m));
        }
        __syncthreads();
    }
}

constexpr int SCAN_SPLIT_ = 2;
DI int swzrow8(int row, int pitch, int s) { return row * pitch + ((((s >> 1) ^ (row & 15)) << 4) | ((s & 1) << 3)); }
DI bf16x8 pack8(f32x4 a, f32x4 b) {
    u32x4 o; o.x = pk2(a[0], a[1]); o.y = pk2(a[2], a[3]); o.z = pk2(b[0], b[1]); o.w = pk2(b[2], b[3]);
    return __builtin_bit_cast(bf16x8, o);
}
DI bf16x8 ld2x8(const char* p0, const char* p1) {
    const u32x2 a = *(const u32x2*)p0, b = *(const u32x2*)p1; u32x4 o; o.x = a.x; o.y = a.y; o.z = b.x; o.w = b.y;
    return __builtin_bit_cast(bf16x8, o);
}
constexpr int SC_W = 0, SC_QD = 16384, SC_KDT = 32768, SC_QK = 49152, SC_BUF = 57344;
constexpr int SC_OX = 2 * SC_BUF, SC_UX = SC_OX + 16384, SC_GX = SC_UX + 16384;
static_assert(SCAN_SPLIT_ == 2, "the role split assumes 4 computing + 4 staging waves");
static_assert((NCH & 1) == 1, "the staging loop is unrolled by two chunks plus one tail chunk");

constexpr int SCAN_SPLIT = SCAN_SPLIT_;
struct ScanSet { u32x4 rw[2][2], rq[2][2], rk[2][2], rqk[2]; u32x2 u[4]; float gd; };
DI void scan_head(const Params& p, char* smem, int head, int sidx, int dry) {
    const int tid = fresh_tid(), lane = tid & 63, wave = tid >> 6, r16 = lane & 15, g = lane >> 4;
    unsigned char* ws = p.ws;
    auto uaddr_s = [&](int sl, int n, int mt) -> bf16* {
        const int e = 16 * sl + r16;
        bf16* base = n == 0 ? (bf16*)(ws + OFF_SMALL + SM_C0V) : (bf16*)(ws + OFF_V) + (size_t)(n - 1) * 64 * D;
        return base + (size_t)(e >> 1) * D + head * 128 + (e & 1) * 64 + 16 * mt + 4 * g;
    };
    if (wave >= 4) {
        const int hid = tid - 256, w4 = wave - 4, myslice = sidx * 4 + w4;
        ScanSet R0, R1;
        auto gload = [&](ScanSet& R, int n) {
#pragma unroll
            for (int v = 0; v < 2; ++v) {
                const int vt = hid + 256 * v, lrow = vt >> 3, lch = (vt & 7) * 2;
                const bf16* wsrc = (n == 0 ? (const bf16*)(ws + OFF_SMALL + SM_C0W) + (size_t)head * 8192 : (const bf16*)(ws + OFF_W) + ((size_t)(n - 1) * 8 + head) * 8192) + lrow * 128 + lch * 8;
                R.rw[v][0] = *(const u32x4*)wsrc; R.rw[v][1] = *(const u32x4*)(wsrc + 8);
                const bf16* qs = (n == 0 ? (const bf16*)(ws + OFF_SMALL + SM_C0Q) : (const bf16*)(ws + OFF_QN) + (size_t)(n - 1) * 64 * D) + (size_t)lrow * D + head * 128 + lch * 8;
                R.rq[v][0] = *(const u32x4*)qs; R.rq[v][1] = *(const u32x4*)(qs + 8);
                const bf16* ks = (n == 0 ? (const bf16*)(ws + OFF_SMALL + SM_C0K) : (const bf16*)(ws + OFF_KN) + (size_t)(n - 1) * 64 * D) + (size_t)lrow * D + head * 128 + lch * 8;
                R.rk[v][0] = *(const u32x4*)ks; R.rk[v][1] = *(const u32x4*)(ks + 8);
                const bf16* qk = (n == 0 ? (const bf16*)(ws + OFF_SMALL + SM_C0QK) + (size_t)head * 4096 : (const bf16*)(ws + OFF_QKB) + ((size_t)(n - 1) * 8 + head) * 4096) + vt * 8;
                R.rqk[v] = *(const u32x4*)qk;
            }
#pragma unroll
            for (int mt = 0; mt < 4; ++mt) R.u[mt] = *(const u32x2*)uaddr_s(myslice, n, mt);
            R.gd = ((const float*)(ws + OFF_SMALL + SM_GC))[((size_t)n * 8 + head) * 64 + 63];
        };
        auto lwrite = [&](const ScanSet& R, int buf) {
            char* b = smem + buf * SC_BUF;
#pragma unroll
            for (int v = 0; v < 2; ++v) {
                const int vt = hid + 256 * v, lrow = vt >> 3, c7 = vt & 7, kb = c7 >> 1, hf = c7 & 1;
                {
                    char* w = b + SC_W + lrow * 256 + hf * 8; char* q = b + SC_QD + lrow * 256 + hf * 8; const int x = lrow & 15;
                    *(u32x2*)(w + (((4 * kb + 0) ^ x) << 4)) = (u32x2){R.rw[v][0].x, R.rw[v][0].y}; *(u32x2*)(w + (((4 * kb + 1) ^ x) << 4)) = (u32x2){R.rw[v][0].z, R.rw[v][0].w};
                    *(u32x2*)(w + (((4 * kb + 2) ^ x) << 4)) = (u32x2){R.rw[v][1].x, R.rw[v][1].y}; *(u32x2*)(w + (((4 * kb + 3) ^ x) << 4)) = (u32x2){R.rw[v][1].z, R.rw[v][1].w};
                    *(u32x2*)(q + (((4 * kb + 0) ^ x) << 4)) = (u32x2){R.rq[v][0].x, R.rq[v][0].y}; *(u32x2*)(q + (((4 * kb + 1) ^ x) << 4)) = (u32x2){R.rq[v][0].z, R.rq[v][0].w};
                    *(u32x2*)(q + (((4 * kb + 2) ^ x) << 4)) = (u32x2){R.rq[v][1].x, R.rq[v][1].y}; *(u32x2*)(q + (((4 * kb + 3) ^ x) << 4)) = (u32x2){R.rq[v][1].z, R.rq[v][1].w};
                }
                {
                    const int dk = 2 * lrow + (c7 >> 2), kb2 = (c7 & 3) >> 1, x = (dk >> 1) & 7;
                    char* kt = b + SC_KDT + dk * 128 + hf * 8;
                    *(u32x2*)(kt + (((4 * kb2 + 0) ^ x) << 4)) = (u32x2){R.rk[v][0].x, R.rk[v][0].y}; *(u32x2*)(kt + (((4 * kb2 + 1) ^ x) << 4)) = (u32x2){R.rk[v][0].z, R.rk[v][0].w};
                    *(u32x2*)(kt + (((4 * kb2 + 2) ^ x) << 4)) = (u32x2){R.rk[v][1].x, R.rk[v][1].y}; *(u32x2*)(kt + (((4 * kb2 + 3) ^ x) << 4)) = (u32x2){R.rk[v][1].z, R.rk[v][1].w};
                }
                {
                    const int row = vt >> 3, kb2 = c7 >> 2, g0 = 2 * (c7 & 1), hf2 = (c7 >> 1) & 1, x = (row >> 1) & 7;
                    char* qk = b + SC_QK + row * 128 + hf2 * 8;
                    *(u32x2*)(qk + (((4 * kb2 + g0) ^ x) << 4)) = (u32x2){R.rqk[v].x, R.rqk[v].y}; *(u32x2*)(qk + (((4 * kb2 + g0 + 1) ^ x) << 4)) = (u32x2){R.rqk[v].z, R.rqk[v].w};
                }
            }
#pragma unroll
            for (int mt = 0; mt < 4; ++mt) *(u32x2*)(smem + SC_UX + buf * 8192 + ((w4 * 4 + mt) * 64 + lane) * 8) = R.u[mt];
            if (hid == 0) *(float*)(smem + SC_GX + buf * 4) = R.gd;
        };
        auto ox_store = [&](int n) {
            const char* ox = smem + SC_OX + (n & 1) * 8192 + (w4 * 4 * 64 + lane) * 8;
            const bool real = n >= 1 && !dry;
#pragma unroll
            for (int mt = 0; mt < 4; ++mt) {
                bf16* dst = real ? uaddr_s(myslice, n, mt) : (bf16*)(ws + OFF_WTIN) + (size_t)tid * 16 + mt * 4;
                *(u32x2*)dst = *(const u32x2*)(ox + mt * 512);
            }
        };
        auto step = [&](int n, ScanSet& R) {
            lwrite(R, (n + 1) & 1);
            gload(R, n + 3 < NCH ? n + 3 : NCH - 1);
            ox_store(n >= 1 ? n - 1 : 0);
            LDS_BARRIER();
        };
        SETPRIO(3);
        gload(R0, 0); gload(R1, 1);
        lwrite(R0, 0);
        gload(R0, 2 < NCH ? 2 : NCH - 1);
        LDS_BARRIER();
        for (int n = 0; n + 1 < NCH; n += 2) { step(n, R1); step(n + 1, R0); }
        step(NCH - 1, R1);
        ox_store(NCH - 1);
        SETPRIO(0);
    } else {
        f32x4 S[8];
#pragma unroll
        for (int i = 0; i < 8; ++i) S[i] = zero4();
        LDS_BARRIER();
        for (int n = 0; n < NCH; ++n) {
            const char* b = smem + (n & 1) * SC_BUF;
            u32x2 ucur[4];
            SCAN_HEAD_DELAY();
#pragma unroll
            for (int mt = 0; mt < 4; ++mt) ucur[mt] = *(const u32x2*)(smem + SC_UX + (n & 1) * 8192 + ((wave * 4 + mt) * 64 + lane) * 8);
            const float gtot = __expf(*(const float*)(smem + SC_GX + (n & 1) * 4));
            bf16x8 A[4], B[4], C[4];
            const int rsw = (r16 * 256), x16 = r16 & 15;
#define SC_RD_W(X, mt) do { _Pragma("unroll") for (int kb = 0; kb < 4; ++kb) X[kb] = *(const bf16x8*)(b + SC_W + (mt) * 4096 + rsw + (((4 * kb + g) ^ x16) << 4)); SCHED_FENCE(); } while (0)
#define SC_RD_Q(X, mt) do { _Pragma("unroll") for (int kb = 0; kb < 4; ++kb) X[kb] = *(const bf16x8*)(b + SC_QD + (mt) * 4096 + rsw + (((4 * kb + g) ^ x16) << 4)); SCHED_FENCE(); } while (0)
#define SC_RD_KD(X, m0) do { _Pragma("unroll") for (int i = 0; i < 2; ++i) _Pragma("unroll") for (int kb = 0; kb < 2; ++kb) \
                X[2 * i + kb] = *(const bf16x8*)(b + SC_KDT + swz128(16 * ((m0) + i) + r16, 4 * kb + g)); SCHED_FENCE(); } while (0)
#define SC_RD_QK(X, m0) do { _Pragma("unroll") for (int i = 0; i < 2; ++i) _Pragma("unroll") for (int kb = 0; kb < 2; ++kb) \
                X[2 * i + kb] = *(const bf16x8*)(b + SC_QK + swz128(16 * ((m0) + i) + r16, 4 * kb + g)); SCHED_FENCE(); } while (0)
#define SC_MM_P(X, mt) do { f32x4 P = zero4(); _Pragma("unroll") for (int kb = 0; kb < 4; ++kb) P = MFMA16(X[kb], sf[kb], P); \
                const float u0 = bflo(ucur[mt].x), u1 = bfhi(ucur[mt].x), u2 = bflo(ucur[mt].y), u3 = bfhi(ucur[mt].y); \
                Vn[mt] = (f32x4){u0 - P[0], u1 - P[1], u2 - P[2], u3 - P[3]}; SCHED_FENCE(); } while (0)
#define SC_MM_Q(X, mt) do { f32x4 Q = zero4(); _Pragma("unroll") for (int kb = 0; kb < 4; ++kb) Q = MFMA16(X[kb], sf[kb], Q); O[mt] = Q; SCHED_FENCE(); } while (0)
#define SC_MM_S(X, m0) do { _Pragma("unroll") for (int i = 0; i < 2; ++i) { f32x4 acc = S[(m0) + i] * gtot; acc = MFMA16(X[2 * i], vf[0], acc); acc = MFMA16(X[2 * i + 1], vf[1], acc); S[(m0) + i] = acc; } SCHED_FENCE(); } while (0)
#define SC_MM_O(X, m0) do { _Pragma("unroll") for (int i = 0; i < 2; ++i) { const int mt = (m0) + i; O[mt] = MFMA16(X[2 * i], vf[0], O[mt]); O[mt] = MFMA16(X[2 * i + 1], vf[1], O[mt]); \
                *(u32x2*)(smem + SC_OX + (n & 1) * 8192 + ((wave * 4 + mt) * 64 + lane) * 8) = (u32x2){pk2(O[mt][0], O[mt][1]), pk2(O[mt][2], O[mt][3])}; } SCHED_FENCE(); } while (0)
            SC_RD_W(A, 0); SC_RD_Q(C, 0); SC_RD_W(B, 1);
            bf16x8 sf[4];
#pragma unroll
            for (int kb = 0; kb < 4; ++kb) sf[kb] = pack8(S[2 * kb], S[2 * kb + 1]);
            SCHED_FENCE();
            f32x4 Vn[4], O[4]; bf16x8 vf[2];
            SC_MM_P(A, 0); SC_RD_W(A, 2);
            SC_MM_Q(C, 0); SC_RD_Q(C, 1);
            SC_MM_P(B, 1); SC_RD_W(B, 3);
            vf[0] = pack8(Vn[0], Vn[1]); SCHED_FENCE();
            SC_MM_Q(C, 1); SC_RD_Q(C, 2);
            SC_MM_P(A, 2); SC_RD_KD(A, 0);
            SC_MM_Q(C, 2); SC_RD_Q(C, 3);
            SC_MM_P(B, 3); SC_RD_KD(B, 2);
            vf[1] = pack8(Vn[2], Vn[3]); SCHED_FENCE();
            SC_MM_S(A, 0); SC_RD_KD(A, 4);
            SC_MM_S(B, 2); SC_RD_KD(B, 6);
            SC_MM_Q(C, 3); SC_RD_QK(C, 0);
            SC_MM_S(A, 4); SC_RD_QK(A, 2);
            SC_MM_S(B, 6);
            SC_MM_O(C, 0);
            SC_MM_O(A, 2);
#undef SC_RD_W
#undef SC_RD_Q
#undef SC_RD_KD
#undef SC_RD_QK
#undef SC_MM_P
#undef SC_MM_Q
#undef SC_MM_S
#undef SC_MM_O
            LDS_BARRIER();
        }
    }
    __syncthreads();
}

constexpr int AT_BUF = 32768, AT_MISC = 65536, NQB = SEQ / 128, AT_UNITS = 8 * NQB;
DI int vt_off8(int e, int s) { return e * 128 + ((s ^ ((e >> 1) & 15)) << 3); }

DI void attention_unit(const Params& p, char* smem, int head, int qb, float lam, int dry, float bound) {
    const int tid = fresh_tid(), lane = tid & 63, wave = tid >> 6, r32 = lane & 31, h = lane >> 5;
    const int wq = wave & 3, mp = wave >> 2;
    unsigned char* ws = p.ws;
    const bf16* AK = (const bf16*)p.out; const bf16* AVT = (const bf16*)p.out + (size_t)SEQ * D;
    const int q0 = 128 * qb, qpos = q0 + 32 * wq + r32;
    const float c1 = 0.125f * LOG2E, c2 = exp2f(-(float)(head + 1)) * LOG2E;
    bf16x8 Qf[4];
    {
        const bf16* qsrc = (const bf16*)(ws + OFF_AQ) + (size_t)qpos * D + head * 128 + mp * 64 + 8 * h;
#pragma unroll
        for (int ks = 0; ks < 4; ++ks) {
            const u32x4 v = *(const u32x4*)(qsrc + 16 * ks); u32x4 o;
            o.x = pk2(bflo(v.x) * c1, bfhi(v.x) * c1); o.y = pk2(bflo(v.y) * c1, bfhi(v.y) * c1); o.z = pk2(bflo(v.z) * c1, bfhi(v.z) * c1); o.w = pk2(bflo(v.w) * c1, bfhi(v.w) * c1);
            Qf[ks] = __builtin_bit_cast(bf16x8, o);
        }
    }
    f32x16 O[4];
#pragma unroll
    for (int i = 0; i < 4; ++i) O[i] = zero16();
    float l_run = 0.f; f32x2_ l_run2 = {0.f, 0.f}; const float mfix = fminf(bound, 40.0f);
    const float wdist = (150.0f + 2.0f * bound) / c2;
    int ntiles = 2 * qb + 3;
    {
        const float lim = (float)q0 - 63.0f - wdist;
        int ktmin = 0;
        if (lim > 0.f) ktmin = (int)(lim * (1.0f / 64.0f));
        const bool keep_meta = !((float)(q0 + NMETA - 15) > wdist);
        if (ktmin > 0 || !keep_meta) ntiles = (2 * qb + 1 - ktmin + 1) + (keep_meta ? 1 : 0);
    }
    const int nreal = (ntiles == 2 * qb + 3) ? 2 * qb + 2 : ntiles;
    const int kkey = tid >> 3, kcc = (tid & 7) * 2;
    const int ve = tid >> 2, vp = tid & 3;
    u32x4 rk[2], rv[2];
    auto tile_kt = [&](int it) -> int { return it < nreal ? 2 * qb + 1 - it : -1; };
    auto gload = [&](int it) {
        const int kt = tile_kt(it);
        const bf16* ks = kt >= 0 ? AK + ((size_t)kt * 64 + kkey) * D + head * 128 + kcc * 8
                                 : (const bf16*)(ws + OFF_SMALL + SM_AKMETA) + (size_t)(kkey & (NMETA - 1)) * D + head * 128 + kcc * 8;
        const bf16* vs = kt >= 0 ? AVT + (size_t)(head * 128 + ve) * SEQ + (((kt + 17 * (head * 128 + ve)) & (SEQ / 64 - 1)) << 6) + vp * 16
                                 : (const bf16*)(ws + OFF_SMALL + SM_AVTMETA) + (size_t)(head * 128 + ve) * NMETA;
        rk[0] = *(const u32x4*)ks; rk[1] = *(const u32x4*)(ks + 8);
        rv[0] = *(const u32x4*)vs; rv[1] = *(const u32x4*)(vs + 8);
    };
    auto lwrite_p = [&](int buf, int piece) {
        const int krow = (kkey & ~12) | ((kkey & 4) << 1) | ((kkey & 8) >> 1);
        char* kb = smem + buf * AT_BUF + (kcc >> 3) * 8192; char* vbase = smem + buf * AT_BUF + 16384;
        if (piece == 0) *(u32x4*)(kb + swz128(krow, kcc & 7)) = rk[0];
        else if (piece == 1) *(u32x4*)(kb + swz128(krow, (kcc & 7) + 1)) = rk[1];
        else if (piece == 2) *(u32x4*)(vbase + swz128(ve, 2 * vp)) = rv[0];
        else *(u32x4*)(vbase + swz128(ve, 2 * vp + 1)) = rv[1];
    };
    auto lwrite = [&](int buf) { lwrite_p(buf, 0); lwrite_p(buf, 1); lwrite_p(buf, 2); lwrite_p(buf, 3); };
    auto tile_fast = [&](int buf, int kdist0) {
        const char* kb = smem + buf * AT_BUF + mp * 8192 + r32 * 128;
        const char* vb = smem + buf * AT_BUF + 16384 + r32 * 128;
        const int x = (r32 >> 1) & 7;
        const int c0 = ((0 + h) ^ x) << 4, c1 = ((2 + h) ^ x) << 4, c2o = ((4 + h) ^ x) << 4, c3 = ((6 + h) ^ x) << 4;
#define AT_KRD(i, off) kf##i = *(const bf16x8*)(kb + (off))
#define AT_VRD(dst, et, off) dst = *(const bf16x8*)(vb + (et) * 4096 + (off))
#define AT_EXP4(S, i) do { S[i] = EXP2F(S[i]); S[i + 1] = EXP2F(S[i + 1]); S[i + 2] = EXP2F(S[i + 2]); S[i + 3] = EXP2F(S[i + 3]); } while (0)
#define AT_PACK(S, i) __builtin_bit_cast(bf16x8, (u32x4){pk2(S[i], S[i + 1]), pk2(S[i + 2], S[i + 3]), pk2(S[i + 4], S[i + 5]), pk2(S[i + 6], S[i + 7])})
#define AT_SUM8(S, i) do { la += (f32x2_){S[i], S[i + 1]}; lb += (f32x2_){S[i + 2], S[i + 3]}; la += (f32x2_){S[i + 4], S[i + 5]}; lb += (f32x2_){S[i + 6], S[i + 7]}; } while (0)
        bf16x8 kf0, kf1, kf2, kf3, kf4, kf5, kf6, kf7, va, vb_, vc, vd, ve_, vf, vg, vh;
        AT_KRD(0, c0); AT_KRD(1, c1); AT_KRD(2, c2o); AT_KRD(3, c3); AT_KRD(4, 4096 + c0); AT_KRD(5, 4096 + c1); AT_KRD(6, 4096 + c2o); AT_KRD(7, 4096 + c3);
        SCHED_FENCE();
        f32x16 s0, s1;
        {
            const float base = -c2 * (float)(kdist0 - 8 * h) - mfix, c16 = 16.0f * c2, c32 = 32.0f * c2;
#pragma unroll
            for (int r = 0; r < 8; ++r) s0[r] = base + c2 * (float)r;
#pragma unroll
            for (int r = 0; r < 8; ++r) s0[8 + r] = s0[r] + c16;
#pragma unroll
            for (int r = 0; r < 16; ++r) s1[r] = s0[r] + c32;
        }
        PIN(s0); PIN(s1); SCHED_FENCE();
        f32x2_ la = {0.f, 0.f}, lb = {0.f, 0.f};
#define G_(mf, ...) do { mf; SCHED_FENCE(); __VA_ARGS__; SCHED_FENCE(); } while (0)
        G_(s0 = MFMA32(kf0, Qf[0], s0), AT_VRD(va, 0, c0); AT_VRD(vb_, 1, c0));
        G_(s0 = MFMA32(kf1, Qf[1], s0), AT_VRD(vc, 2, c0); AT_VRD(vd, 3, c0));
        G_(s0 = MFMA32(kf2, Qf[2], s0), AT_VRD(ve_, 0, c1); AT_VRD(vf, 1, c1));
        G_(s0 = MFMA32(kf3, Qf[3], s0), AT_VRD(vg, 2, c1); AT_VRD(vh, 3, c1));
        G_(s1 = MFMA32(kf4, Qf[0], s1), AT_EXP4(s0, 0); PIN(s0));
        G_(s1 = MFMA32(kf5, Qf[1], s1), AT_EXP4(s0, 4); PIN(s0));
        G_(s1 = MFMA32(kf6, Qf[2], s1), AT_EXP4(s0, 8); PIN(s0));
        G_(s1 = MFMA32(kf7, Qf[3], s1), AT_EXP4(s0, 12); PIN(s0));
        bf16x8 pa = AT_PACK(s0, 0), pb;
        PIN(pa); SCHED_FENCE();
        G_(O[0] = MFMA32(va, pa, O[0]), pb = AT_PACK(s0, 8); PIN(pb));
        G_(O[1] = MFMA32(vb_, pa, O[1]), AT_SUM8(s0, 0); PIN(la); PIN(lb));
        G_(O[2] = MFMA32(vc, pa, O[2]), AT_SUM8(s0, 8); PIN(la); PIN(lb));
        G_(O[3] = MFMA32(vd, pa, O[3]), AT_EXP4(s1, 0); PIN(s1));
        G_(O[0] = MFMA32(ve_, pb, O[0]), AT_EXP4(s1, 4); PIN(s1); AT_VRD(va, 0, c2o); AT_VRD(vb_, 1, c2o));
        G_(O[1] = MFMA32(vf, pb, O[1]), AT_EXP4(s1, 8); PIN(s1); AT_VRD(vc, 2, c2o); AT_VRD(vd, 3, c2o));
        G_(O[2] = MFMA32(vg, pb, O[2]), AT_EXP4(s1, 12); PIN(s1));
        G_(O[3] = MFMA32(vh, pb, O[3]), pa = AT_PACK(s1, 0); PIN(pa); AT_VRD(ve_, 0, c3); AT_VRD(vf, 1, c3));
        G_(O[0] = MFMA32(va, pa, O[0]), pb = AT_PACK(s1, 8); PIN(pb); AT_VRD(vg, 2, c3); AT_VRD(vh, 3, c3));
        G_(O[1] = MFMA32(vb_, pa, O[1]), AT_SUM8(s1, 0); PIN(la); PIN(lb));
        G_(O[2] = MFMA32(vc, pa, O[2]), AT_SUM8(s1, 8); PIN(la); PIN(lb));
        O[3] = MFMA32(vd, pa, O[3]); SCHED_FENCE();
        G_(O[0] = MFMA32(ve_, pb, O[0]), lwrite_p(buf ^ 1, 0));
        G_(O[1] = MFMA32(vf, pb, O[1]), lwrite_p(buf ^ 1, 1));
        G_(O[2] = MFMA32(vg, pb, O[2]), lwrite_p(buf ^ 1, 2));
        G_(O[3] = MFMA32(vh, pb, O[3]), lwrite_p(buf ^ 1, 3));
        l_run2 += la + lb;
#undef G_
#undef AT_KRD
#undef AT_VRD
#undef AT_EXP4
#undef AT_PACK
#undef AT_SUM8
    };
    auto tile_body = [&](auto mode_tag, int buf, int kdist0, int klim) {
        constexpr bool MASKED = decltype(mode_tag)::value;
        const char* kb = smem + buf * AT_BUF + mp * 8192;
        const char* vb = smem + buf * AT_BUF + 16384;
        f32x16 s[2];
#pragma unroll
        for (int sub = 0; sub < 2; ++sub) {
            f32x16 acc;
            const float base = -c2 * (float)(kdist0 - 32 * sub - 8 * h) - mfix;
#pragma unroll
            for (int r = 0; r < 16; ++r) acc[r] = base + c2 * (float)((r & 7) + 16 * (r >> 3));
#pragma unroll
            for (int ks = 0; ks < 4; ++ks) {
                const bf16x8 a = *(const bf16x8*)(kb + swz128(32 * sub + r32, 2 * ks + h));
                acc = MFMA32(a, Qf[ks], acc);
            }
            if (MASKED) {
#pragma unroll
                for (int r = 0; r < 16; ++r) { const int key = 32 * sub + (r & 7) + 16 * (r >> 3) + 8 * h; if (key > klim) acc[r] = -1e30f; }
            }
            s[sub] = acc;
        }
        float ls = 0.f;
#pragma unroll
        for (int sub = 0; sub < 2; ++sub) {
#pragma unroll
            for (int r = 0; r < 16; ++r) { const float pv = EXP2F(s[sub][r]); s[sub][r] = pv; ls += pv; }
            bf16x8 Pf[2];
#pragma unroll
            for (int ss = 0; ss < 2; ++ss) {
                u32x4 o; o.x = pk2(s[sub][8 * ss], s[sub][8 * ss + 1]); o.y = pk2(s[sub][8 * ss + 2], s[sub][8 * ss + 3]);
                o.z = pk2(s[sub][8 * ss + 4], s[sub][8 * ss + 5]); o.w = pk2(s[sub][8 * ss + 6], s[sub][8 * ss + 7]);
                Pf[ss] = __builtin_bit_cast(bf16x8, o);
            }
#pragma unroll
            for (int et = 0; et < 4; ++et) {
                const int e = 32 * et + r32;
#pragma unroll
                for (int ss = 0; ss < 2; ++ss) {
                    const bf16x8 a = *(const bf16x8*)(vb + swz128(e, 4 * sub + 2 * ss + h));
                    O[et] = MFMA32(a, Pf[ss], O[et]);
                }
            }
            SCHED_FENCE();
        }
        l_run += ls;
    };
    gload(0); lwrite(0); __syncthreads();
    if (mp) SETPRIO(1);
    for (int it = 0; it < ntiles; ++it) {
        const int buf = it & 1, kt = tile_kt(it);
        gload(it + 1 < ntiles ? it + 1 : it);
        const int k0 = kt * 64;
        if (kt >= 0 && k0 > q0 + 32 * wq + 31) lwrite(buf ^ 1);
        else if (kt >= 0 && k0 + 63 <= q0 + 32 * wq) tile_fast(buf, qpos - k0);
        else { tile_body(std::true_type{}, buf, kt < 0 ? NMETA + qpos : qpos - k0, kt < 0 ? NMETA - 1 : qpos - k0); lwrite(buf ^ 1); }
        __syncthreads();
    }
    SETPRIO(0);
    {
        const int tid = fresh_tid(), lane = tid & 63, wave = tid >> 6, r32 = lane & 31, h = lane >> 5, wq = wave & 3, mp = wave >> 2;
        const int qpos = 128 * qb + 32 * wq + r32;
        const float lsum = l_run + l_run2[0] + l_run2[1];
        const float lt = lsum + xhalf(lsum);
        const float inv = 1.0f / lt;
        float* X = (float*)smem;
        if (mp == 1) {
#pragma unroll
            for (int et = 0; et < 4; ++et)
#pragma unroll
                for (int r = 0; r < 16; ++r) { const int e = 32 * et + (r & 3) + 8 * (r >> 2) + 4 * h; X[(wq * 128 + e) * 32 + r32] = O[et][r] * inv; }
        }
        __syncthreads();
        if (mp == 0) {
            float ssq = 0.f;
#pragma unroll
            for (int et = 0; et < 4; ++et)
#pragma unroll
                for (int r = 0; r < 16; ++r) { const int e = 32 * et + (r & 3) + 8 * (r >> 2) + 4 * h; const float d = O[et][r] * inv - lam * X[(wq * 128 + e) * 32 + r32]; O[et][r] = d; ssq += d * d; }
            ssq += xhalf(ssq);
            const float rstd = rsqrtf(ssq * (1.0f / 128.0f) + NORM_EPS) * 0.8f;
            bf16* dst = (bf16*)(ws + OFF_AQ) + (size_t)qpos * D + head * 128;
            const float* sw = p.in[8];
#pragma unroll
            for (int et = 0; et < 4; ++et)
#pragma unroll
                for (int q4 = 0; q4 < 4; ++q4) {
                    const int e0 = 32 * et + 8 * q4 + 4 * h;
                    const f32x4 w4 = *(const f32x4*)(sw + e0);
                    if (!dry) *(u32x2*)(dst + e0) = (u32x2){pk2(O[et][4 * q4] * rstd * w4[0], O[et][4 * q4 + 1] * rstd * w4[1]), pk2(O[et][4 * q4 + 2] * rstd * w4[2], O[et][4 * q4 + 3] * rstd * w4[3])};
                }
        }
        __syncthreads();
    }
}

struct AttOrder { unsigned short v[AT_UNITS]; };
constexpr AttOrder make_att_order() {
    AttOrder o{};
    const int wcap[8] = {7, 10, 18, 32, 61, 119, 235, 100000};
    int cnt[2 * NQB + 8] = {};
    for (int i = 0; i < AT_UNITS; ++i) { const int hd = i & 7, qb = NQB - 1 - (i >> 3); int c = 2 * qb + 3; if (c > wcap[hd]) c = wcap[hd]; ++cnt[c]; }
    int start[2 * NQB + 8] = {}; int acc = 0;
    for (int c = 2 * NQB + 7; c >= 0; --c) { start[c] = acc; acc += cnt[c]; }
    for (int i = 0; i < AT_UNITS; ++i) { const int hd = i & 7, qb = NQB - 1 - (i >> 3); int c = 2 * qb + 3; if (c > wcap[hd]) c = wcap[hd]; o.v[start[c]++] = (unsigned short)i; }
    return o;
}
__device__ const AttOrder ATT_ORDER = make_att_order();
DI void phase3(const Params& p, char* smem, int bid, int nblk, int dry = 0, int mode = 3) {
    if (mode & 1) for (int it = bid; it < 8 * SCAN_SPLIT; it += nblk) scan_head(p, smem, it % 8, it / 8, dry);
    if (!(mode & 2)) return;
    float d1 = 0.f, d2 = 0.f;
    for (int i = 0; i < 64; ++i) { d1 += p.in[4][i] * p.in[5][i]; d2 += p.in[6][i] * p.in[7][i]; }
    const float lam = __expf(d1) - __expf(d2) + 0.2f;
    unsigned* q = (unsigned*)(p.ws + OFF_SMALL + SM_CTL) + CW_ATTQ + (dry ? 16 : 0);
    float* hb = (float*)(smem + AT_MISC + 64); unsigned short* otab = (unsigned short*)(smem + AT_MISC + 128);
    if (threadIdx.x < 8) {
        const unsigned* nrm = (const unsigned*)(p.ws + OFF_SMALL + SM_CTL) + CW_NRM; const int hd = threadIdx.x;
        float bnd = 0.f;
        for (int m2 = 0; m2 < 2; ++m2) {
            const float q2 = __builtin_bit_cast(float, LD_ATOMIC(nrm + (2 * hd + m2) * NRM_STRIDE)), k2 = __builtin_bit_cast(float, LD_ATOMIC(nrm + (16 + 2 * hd + m2) * NRM_STRIDE));
            bnd = fmaxf(bnd, sqrtf(q2 * k2) * (0.125f * LOG2E) * 1.02f);
        }
        hb[hd] = bnd;
    }
    for (int i = threadIdx.x; i < AT_UNITS; i += NT) otab[i] = ATT_ORDER.v[i];
    __syncthreads();
    for (;;) {
        if (threadIdx.x == 0) { const unsigned t = atomicAdd(q, 1u); *(unsigned*)(smem + AT_MISC) = t < (unsigned)AT_UNITS ? (unsigned)otab[t] : 0xffffffffu; }
        __syncthreads();
        const unsigned u = *(unsigned*)(smem + AT_MISC);
        __syncthreads();
        if (u >= (unsigned)AT_UNITS) break;
        const int hd = (int)(u & 7u);
        attention_unit(p, smem, hd, NQB - 1 - (int)(u >> 3), lam, dry, hb[hd]);
    }
}

DI void phase4(const Params& p, char* smem, int bid, int nblk) {
    const int tid = fresh_tid(), lane = tid & 63, wave = tid >> 6;
    const int gw = bid * 8 + wave, NGW = nblk * 8;
    unsigned char* ws = p.ws;
    char* wl = smem + wave * 16384;
    for (int it = gw; it < 32 * 256; it += NGW) {
        const int e = it >> 8, r = it & 255, m = r >> 7, q = r & 127;
        transpose_item(p.in[21 + m] + (size_t)e * 1024 * 256, 256, 1024, (bf16*)(ws + OFF_EXG) + (size_t)e * 512 * 1024, (q >> 3) * 64, (q & 7) * 32, (q & 7) * 32, (float*)wl, lane, m + 1);
    }
    for (int R = gw; R < SEQ; R += NGW) {
        const float* xrow = p.in[0] + (size_t)R * D; bf16* urow = (bf16*)(ws + OFF_U) + (size_t)R * D;
        float4 v[4]; float ss = 0.f;
#pragma unroll
        for (int j = 0; j < 4; ++j) { v[j] = *(const float4*)(xrow + 4 * lane + 256 * j); ss += v[j].x * v[j].x + v[j].y * v[j].y + v[j].z * v[j].z + v[j].w * v[j].w; }
        ss = wave_sum(ss);
        const float rstd = rsqrtf(ss * (1.0f / D) + NORM_EPS);
#pragma unroll
        for (int j = 0; j < 4; ++j) {
            const float4 w4 = *(const float4*)(p.in[2] + 4 * lane + 256 * j);
            *(u32x2*)(urow + 4 * lane + 256 * j) = (u32x2){pk2(v[j].x * rstd * w4.x, v[j].y * rstd * w4.y), pk2(v[j].z * rstd * w4.z, v[j].w * rstd * w4.w)};
        }
    }
    for (int it = gw; it < (NCH - 1) * 8; it += NGW) {
        const int cm1 = it >> 3, head = it & 7;
        const bf16* reg = (const bf16*)(ws + OFF_V) + (size_t)cm1 * 64 * D + head * 128;
#pragma unroll 4
        for (int i = 0; i < 16; ++i) { const int row = i * 4 + (lane >> 4), ch = lane & 15; *(u32x4*)(wl + row * 256 + ch * 16) = *(const u32x4*)(reg + (size_t)row * D + ch * 8); }
        WAVE_SYNC();
        float ss = 0.f;
#pragma unroll 8
        for (int dv = 0; dv < 128; ++dv) { const float v = bf2f(*(const bf16*)(wl + (dv >> 1) * 256 + ((dv & 1) * 64 + lane) * 2)); ss += v * v; }
        const float rstd = rsqrtf(ss * (1.0f / 128.0f) + NORM_EPS);
        const size_t j = (size_t)cm1 * 64 + lane;
        const bf16* gsrc = (const bf16*)(ws + OFF_DG) + j * D + head * 128;
        bf16* dst = (bf16*)(ws + OFF_OD) + j * D + head * 128;
#pragma unroll 2
        for (int d8 = 0; d8 < 16; ++d8) {
            const u32x4 gv = *(const u32x4*)(gsrc + 8 * d8);
            const f32x4 w0 = *(const f32x4*)(p.in[12] + 8 * d8), w1 = *(const f32x4*)(p.in[12] + 8 * d8 + 4);
            float o[8];
#pragma unroll
            for (int c = 0; c < 8; ++c) { const int dv = 8 * d8 + c; o[c] = bf2f(*(const bf16*)(wl + (dv >> 1) * 256 + ((dv & 1) * 64 + lane) * 2)) * rstd; }
            o[0] *= w0[0] * siluf_(bflo(gv.x)); o[1] *= w0[1] * siluf_(bfhi(gv.x)); o[2] *= w0[2] * siluf_(bflo(gv.y)); o[3] *= w0[3] * siluf_(bfhi(gv.y));
            o[4] *= w1[0] * siluf_(bflo(gv.z)); o[5] *= w1[1] * siluf_(bfhi(gv.z)); o[6] *= w1[2] * siluf_(bflo(gv.w)); o[7] *= w1[3] * siluf_(bfhi(gv.w));
            *(u32x4*)(dst + 8 * d8) = (u32x4){pk2(o[0], o[1]), pk2(o[2], o[3]), pk2(o[4], o[5]), pk2(o[6], o[7])};
        }
        WAVE_SYNC();
    }
}

template <int NB, int NI>
DI void rowgemm64(const bf16* arow, const bf16* const (&bptr)[NB], char* stg, f32x16 (&acc)[NB][2][NI]) {
    const int tid = fresh_tid(), lane = tid & 63, r32 = lane & 31, h = lane >> 5;
    const int lrow = tid >> 3, lc = tid & 7;
    u32x4 ra = arow ? *(const u32x4*)arow : (u32x4){0u, 0u, 0u, 0u};
    bf16x8 bqA[4][NB][NI], bqB[4][NB][NI];
    auto bload = [&](bf16x8 (&dst)[4][NB][NI], int kc) {
#pragma unroll
        for (int ks = 0; ks < 4; ++ks)
#pragma unroll
            for (int b = 0; b < NB; ++b)
#pragma unroll
                for (int ni = 0; ni < NI; ++ni) dst[ks][b][ni] = *(const bf16x8*)(bptr[b] + (size_t)ni * 32 * 1024 + kc * 64 + ks * 16);
    };
    auto mma = [&](const bf16x8 (&bq)[4][NB][NI], int buf) {
#pragma unroll
        for (int ks = 0; ks < 4; ++ks) {
            bf16x8 af[2];
#pragma unroll
            for (int mi = 0; mi < 2; ++mi) af[mi] = *(const bf16x8*)(stg + buf * 8192 + swz128(32 * mi + r32, 2 * ks + h));
#pragma unroll
            for (int b = 0; b < NB; ++b)
#pragma unroll
                for (int ni = 0; ni < NI; ++ni)
#pragma unroll
                    for (int mi = 0; mi < 2; ++mi) acc[b][mi][ni] = MFMA32(af[mi], bq[ks][b][ni], acc[b][mi][ni]);
        }
    };
    bload(bqA, 0);
    *(u32x4*)(stg + swz128(lrow, lc)) = ra;
    __syncthreads();
    for (int kc = 0; kc < 16; kc += 2) {
        ra = arow ? *(const u32x4*)(arow + (kc + 1) * 64) : (u32x4){0u, 0u, 0u, 0u};
        bload(bqB, kc + 1);
        mma(bqA, 0);
        *(u32x4*)(stg + 8192 + swz128(lrow, lc)) = ra;
        __syncthreads();
        if (kc + 2 < 16) { ra = arow ? *(const u32x4*)(arow + (kc + 2) * 64) : (u32x4){0u, 0u, 0u, 0u}; bload(bqA, kc + 2); }
        mma(bqB, 1);
        if (kc + 2 < 16) *(u32x4*)(stg + swz128(lrow, lc)) = ra;
        __syncthreads();
    }
}

constexpr size_t OFF_MIX = OFF_V;
struct EpiSig {
    static constexpr bool PERM = true;
    bf16* sg;
    DM void operator()(const f32x4 (&acc)[2][2][4][2], const pg8::Unit& u, int wr, int wc, int fr, int fq) const {
        const int row0 = u.pm * 256 + wr * 64 + fr, col0 = u.pn * 256 + wc * 32 + 8 * fq;
#pragma unroll
        for (int ai = 0; ai < 2; ++ai)
#pragma unroll
            for (int m = 0; m < 4; ++m) {
                bf16* rowp = sg + (size_t)(row0 + ai * 128 + m * 16) * 2048 + col0;
#pragma unroll
                for (int bj = 0; bj < 2; ++bj) {
                    const f32x4 v0 = acc[ai][bj][m][0], v1 = acc[ai][bj][m][1];
                    *(u32x4*)(rowp + bj * 128) = (u32x4){pk2(sigmoidf_(v0[0]), sigmoidf_(v0[1])), pk2(sigmoidf_(v0[2]), sigmoidf_(v0[3])), pk2(sigmoidf_(v1[0]), sigmoidf_(v1[1])), pk2(sigmoidf_(v1[2]), sigmoidf_(v1[3]))};
                }
            }
    }
};
template <bool ADD> struct EpiGate {
    static constexpr bool PERM = true;
    const bf16* sg; bf16* mix; int goff;
    DM void operator()(const f32x4 (&acc)[2][2][4][2], const pg8::Unit& u, int wr, int wc, int fr, int fq) const {
        const int row0 = u.pm * 256 + wr * 64 + fr, col0 = u.pn * 256 + wc * 32 + 8 * fq;
#pragma unroll
        for (int ai = 0; ai < 2; ++ai)
#pragma unroll
            for (int mp = 0; mp < 2; ++mp) {
                u32x4 gq[2][2], qq[2][2];
#pragma unroll
                for (int mm = 0; mm < 2; ++mm)
#pragma unroll
                    for (int bj = 0; bj < 2; ++bj) {
                        const size_t j = (size_t)(row0 + ai * 128 + (2 * mp + mm) * 16);
                        gq[mm][bj] = *(const u32x4*)(sg + j * 2048 + goff + col0 + bj * 128);
                        if (ADD) qq[mm][bj] = *(const u32x4*)(mix + j * D + col0 + bj * 128);
                    }
#pragma unroll
                for (int mm = 0; mm < 2; ++mm)
#pragma unroll
                    for (int bj = 0; bj < 2; ++bj) {
                        const int m = 2 * mp + mm; const size_t j = (size_t)(row0 + ai * 128 + m * 16);
                        const u32x4 g = gq[mm][bj];
                        const f32x4 v0 = acc[ai][bj][m][0], v1 = acc[ai][bj][m][1];
                        float o[8] = {bflo(g.x) * v0[0], bfhi(g.x) * v0[1], bflo(g.y) * v0[2], bfhi(g.y) * v0[3], bflo(g.z) * v1[0], bfhi(g.z) * v1[1], bflo(g.w) * v1[2], bfhi(g.w) * v1[3]};
                        if (ADD) { const u32x4 q = qq[mm][bj]; o[0] += bflo(q.x); o[1] += bfhi(q.x); o[2] += bflo(q.y); o[3] += bfhi(q.y); o[4] += bflo(q.z); o[5] += bfhi(q.z); o[6] += bflo(q.w); o[7] += bfhi(q.w); }
                        *(u32x4*)(mix + j * D + col0 + bj * 128) = (u32x4){pk2(o[0], o[1]), pk2(o[2], o[3]), pk2(o[4], o[5]), pk2(o[6], o[7])};
                    }
            }
    }
};
struct EpiRes {
    static constexpr bool PERM = false;
    const float* x; float* hout;
    DM void operator()(const f32x4 (&acc)[2][2][4][2], const pg8::Unit& u, int wr, int wc, int fr, int fq) const {
        const int row0 = u.pm * 256 + wr * 64 + fr, col0 = u.pn * 256 + wc * 32 + 4 * fq;
#pragma unroll
        for (int ai = 0; ai < 2; ++ai)
#pragma unroll
            for (int mp = 0; mp < 2; ++mp) {
                f32x4 xr[2][2][2];
#pragma unroll
                for (int mm = 0; mm < 2; ++mm)
#pragma unroll
                    for (int bj = 0; bj < 2; ++bj)
#pragma unroll
                        for (int n = 0; n < 2; ++n) xr[mm][bj][n] = *(const f32x4*)(x + (size_t)(row0 + ai * 128 + (2 * mp + mm) * 16) * D + col0 + bj * 128 + n * 16);
#pragma unroll
                for (int mm = 0; mm < 2; ++mm)
#pragma unroll
                    for (int bj = 0; bj < 2; ++bj)
#pragma unroll
                        for (int n = 0; n < 2; ++n) *(f32x4*)(hout + (size_t)(row0 + ai * 128 + (2 * mp + mm) * 16) * D + col0 + bj * 128 + n * 16) = xr[mm][bj][n] + acc[ai][bj][2 * mp + mm][n];
            }
    }
};
DI void phase5a(const Params& p, char* smem, int bid, int nblk) {
    pg8::Gemm g{(const bf16*)(p.ws + OFF_U), (const bf16*)(p.ws + OFF_WTIN) + (size_t)7168 * 1024, SEQ, 2048, 1024};
    pg8::StaticOrder S; S.init(SEQ, 2048, nblk, bid);
    EpiSig E{(bf16*)p.out};
    pg8::gemm_phase(smem, g, S, E);
}
DI void phase5b(const Params& p, char* smem, int bid, int nblk) {
    pg8::StaticOrder S; S.init(SEQ, 1024, nblk, bid);
    {
        pg8::Gemm g{(const bf16*)(p.ws + OFF_AQ), (const bf16*)(p.ws + OFF_WTBA), SEQ, 1024, 1024};
        EpiGate<false> E{(const bf16*)p.out, (bf16*)(p.ws + OFF_MIX), 0};
        pg8::gemm_phase(smem, g, S, E);
    }
    {
        pg8::Gemm g{(const bf16*)(p.ws + OFF_OD), (const bf16*)(p.ws + OFF_WTBD), SEQ, 1024, 1024};
        EpiGate<true> E{(const bf16*)p.out, (bf16*)(p.ws + OFF_MIX), 1024};
        pg8::gemm_phase(smem, g, S, E);
    }
}
DI void phase5c(const Params& p, char* smem, int bid, int nblk) {
    pg8::Gemm g{(const bf16*)(p.ws + OFF_MIX), (const bf16*)(p.ws + OFF_WTOUT), SEQ, 1024, 1024};
    pg8::StaticOrder S; S.init(SEQ, 1024, nblk, bid);
    EpiRes E{p.in[0], p.out};
    pg8::gemm_phase(smem, g, S, E);
}
constexpr int P5_PLP = 65, P5_PL = 0, P5_SS = 8 * 64 * P5_PLP * 4, P5_MISC = P5_SS + 8 * 64 * 4;
DI void post_rows(const Params& p, char* smem, int rb, int dry) {
    const int tid = fresh_tid(), lane = tid & 63, wave = tid >> 6, r32 = lane & 31, h = lane >> 5;
    unsigned char* ws = p.ws;
    const int row0 = rb * 64;
    float* rstdl = (float*)(smem + P5_MISC); float* logl = (float*)(smem + P5_MISC + 256);
    {
        const bf16* WH = (const bf16*)(ws + OFF_SMALL + SM_WR); const bf16* WL = WH + 64 * 1024;
        f32x16 acc[2][2];
#pragma unroll
        for (int mi = 0; mi < 2; ++mi)
#pragma unroll
            for (int ni = 0; ni < 2; ++ni) acc[mi][ni] = zero16();
        float ss[2] = {0.f, 0.f};
#pragma unroll 2
        for (int ks = 0; ks < 8; ++ks) {
            const int k0 = 128 * wave + 16 * ks + 8 * h;
            bf16x8 ah[2], al[2];
#pragma unroll
            for (int mi = 0; mi < 2; ++mi) {
                const float* hp = p.out + (size_t)(row0 + 32 * mi + r32) * D + k0;
                const f32x4 a = *(const f32x4*)hp, b = *(const f32x4*)(hp + 4);
                ss[mi] += a[0] * a[0] + a[1] * a[1] + a[2] * a[2] + a[3] * a[3] + b[0] * b[0] + b[1] * b[1] + b[2] * b[2] + b[3] * b[3];
                const u32x4 hi = {pk2(a[0], a[1]), pk2(a[2], a[3]), pk2(b[0], b[1]), pk2(b[2], b[3])};
                const u32x4 lo = {pk2(a[0] - bflo(hi.x), a[1] - bfhi(hi.x)), pk2(a[2] - bflo(hi.y), a[3] - bfhi(hi.y)), pk2(b[0] - bflo(hi.z), b[1] - bfhi(hi.z)), pk2(b[2] - bflo(hi.w), b[3] - bfhi(hi.w))};
                ah[mi] = __builtin_bit_cast(bf16x8, hi); al[mi] = __builtin_bit_cast(bf16x8, lo);
            }
#pragma unroll
            for (int ni = 0; ni < 2; ++ni) {
                const bf16x8 bh = *(const bf16x8*)(WH + (size_t)(32 * ni + r32) * 1024 + k0), bl = *(const bf16x8*)(WL + (size_t)(32 * ni + r32) * 1024 + k0);
#pragma unroll
                for (int mi = 0; mi < 2; ++mi) { acc[mi][ni] = MFMA32(ah[mi], bh, acc[mi][ni]); acc[mi][ni] = MFMA32(ah[mi], bl, acc[mi][ni]); acc[mi][ni] = MFMA32(al[mi], bh, acc[mi][ni]); }
            }
        }
        float* PL = (float*)(smem + P5_PL) + wave * 64 * P5_PLP; float* SS = (float*)(smem + P5_SS) + wave * 64;
#pragma unroll
        for (int mi = 0; mi < 2; ++mi) {
#pragma unroll
            for (int ni = 0; ni < 2; ++ni)
#pragma unroll
                for (int r = 0; r < 16; ++r) PL[(32 * mi + (r & 3) + 8 * (r >> 2) + 4 * h) * P5_PLP + 32 * ni + r32] = acc[mi][ni][r];
            const float s = ss[mi] + xhalf(ss[mi]);
            if (h == 0) SS[32 * mi + r32] = s;
        }
    }
    __syncthreads();
    if (tid < 64) {
        float s = 0.f;
#pragma unroll
        for (int w = 0; w < 8; ++w) s += ((const float*)(smem + P5_SS))[w * 64 + tid];
        const float rs = rsqrtf(s * (1.0f / D) + NORM_EPS);
        rstdl[tid] = rs;
        for (int c = 0; c < 36; ++c) { float t = 0.f; for (int w = 0; w < 8; ++w) t += ((const float*)(smem + P5_PL))[w * 64 * P5_PLP + tid * P5_PLP + c]; logl[tid * 41 + c] = t * rs + (c < 4 ? p.in[18][c] : p.in[20][c - 4]); }
        const float* L = logl + tid * 41;
        int gi = 0; float gm = L[0];
        for (int c = 1; c < 4; ++c) if (L[c] > gm) { gm = L[c]; gi = c; }
        float gs = 0.f; for (int c = 0; c < 4; ++c) gs += __expf(L[c] - gm);
        const float gw = 1.0f / gs;
        const float* E = L + 4 + 8 * gi;
        int i1 = 0; float l1 = E[0];
        for (int c = 1; c < 8; ++c) if (E[c] > l1) { l1 = E[c]; i1 = c; }
        int i2 = -1; float l2 = -3.0e38f;
        for (int c = 0; c < 8; ++c) if (c != i1 && E[c] > l2) { l2 = E[c]; i2 = c; }
        const float t = __expf(l2 - l1), w1 = 1.0f / (1.0f + t), w2 = t / (1.0f + t);
        unsigned* cnt = (unsigned*)(ws + OFF_SMALL + SM_CTL) + CW_ECNT;
        int* lists = (int*)(ws + OFF_SMALL + SM_TAILS); float* RW = (float*)(ws + OFF_SMALL + SM_RW);
        const int j = row0 + tid;
        const int e1 = 8 * gi + i1, e2 = 8 * gi + i2;
        unsigned* hist = (unsigned*)(smem + P5_MISC + 11264); unsigned* hbase = hist + 32;
        if (tid < 32) hist[tid] = 0u;
        WAVE_SYNC();
        const unsigned r1 = atomicAdd(hist + e1, 1u), r2 = atomicAdd(hist + e2, 1u);
        WAVE_SYNC();
        if (tid < 32) hbase[tid] = dry ? 0u : atomicAdd(cnt + tid * ECNT_STRIDE, hist[tid]);
        WAVE_SYNC();
        if (!dry) {
        const unsigned p1 = hbase[e1] + r1, p2 = hbase[e2] + r2;
        ST_ATOMIC(lists + (size_t)e1 * SEQ + p1, (j << 1)); RW[2 * j] = gw * w1;
        ST_ATOMIC(lists + (size_t)e2 * SEQ + p2, (j << 1) | 1); RW[2 * j + 1] = gw * w2;
        } else { asm volatile("" :: "v"(e1), "v"(e2), "v"(gw * w1), "v"(gw * w2)); }
    }
    __syncthreads();
#pragma unroll 2
    for (int i = 0; i < 16; ++i) {
        const int idx = tid + NT * i, row = idx >> 7, ch = idx & 127;
        const float* hp = p.out + (size_t)(row0 + row) * D + ch * 8;
        const f32x4 a = *(const f32x4*)hp, b = *(const f32x4*)(hp + 4);
        const f32x4 w0 = *(const f32x4*)(p.in[16] + ch * 8), w1 = *(const f32x4*)(p.in[16] + ch * 8 + 4);
        const float rs = rstdl[row];
        if (!dry) *(u32x4*)((bf16*)(ws + OFF_OD) + (size_t)(row0 + row) * D + ch * 8) =
            (u32x4){pk2(a[0] * rs * w0[0], a[1] * rs * w0[1]), pk2(a[2] * rs * w0[2], a[3] * rs * w0[3]), pk2(b[0] * rs * w1[0], b[1] * rs * w1[1]), pk2(b[2] * rs * w1[2], b[3] * rs * w1[3])};
    }
    __syncthreads();
}
DI void phase5d(const Params& p, char* smem, int bid, int nblk, int dry = 0) {
    for (int rb = bid; rb < SEQ / 64; rb += nblk) post_rows(p, smem, rb, dry);
}

constexpr int P6_TBL = 131072 + 1024;
template <int NPN> struct MoeSched {
    static constexpr bool GATHER = (NPN == 2);
    const int* tbl; const int* lists; int G, c; size_t btile;
    DM bool next(int i, pg8::Unit& u) const {
        int z0 = 0;
#ifndef EMU
        asm volatile("s_mov_b32 %0, 0" : "=s"(z0));
#endif
        const int* tbl = this->tbl + z0;
        const long L = (long)i * G + c; const int total = tbl[64 + 33 + 32] * NPN; if (L >= total) return false;
        int R = (int)L / NPN; u.pn = (int)L % NPN;
        const int NF = tbl[200 + 32];
        const int thin = R >= NF ? 1 : 0, tb = thin ? 240 : 200; if (thin) R -= NF;
        int e = 0;
#pragma unroll 1
        for (int q = 1; q < 32; ++q) if (tbl[tb + q] <= R) e = q;
        const int pm = thin ? tbl[200 + e + 1] - tbl[200 + e] : R - tbl[200 + e];
#ifdef EMU
        u.e = e; u.pm = pm; u.half = thin; return true;
#else
        u.e = __builtin_amdgcn_readfirstlane(e); u.pm = __builtin_amdgcn_readfirstlane(pm); u.pn = __builtin_amdgcn_readfirstlane(u.pn); u.half = thin; return true;
#endif
    }
    DM const char* a_tile(const pg8::Gemm& g, const pg8::Unit& u) const { return (const char*)g.A + ((size_t)tbl[32 + u.e] + (size_t)u.pm * 256) * g.K * 2; }
    DM const char* b_tile(const pg8::Gemm& g, const pg8::Unit& u) const { return (const char*)g.Bt + (size_t)u.e * btile + (size_t)u.pn * 256 * g.K * 2; }
    DM int a_row(const pg8::Unit& u, int r) const { const int loc = u.pm * 256 + r; return loc < tbl[u.e] ? (lists[(size_t)u.e * SEQ + loc] >> 1) : 0; }
};
DI void moe_table(const Params& p, char* smem) {
    int* tbl = (int*)(smem + P6_TBL);
    unsigned* cnt = (unsigned*)(p.ws + OFF_SMALL + SM_CTL) + CW_ECNT;
    if (threadIdx.x < 64) {
        const int lane = threadIdx.x;
        const int c = lane < 32 ? (int)LD_ATOMIC(cnt + lane * ECNT_STRIDE) : 0;
        const int nru = (c + 255) >> 8;
        int inc = nru;
#pragma unroll
        for (int o = 1; o < 32; o <<= 1) { const int t = __shfl_up(inc, o); if (lane >= o) inc += t; }
        const int ub = inc - nru;
        if (lane < 32) { tbl[lane] = c; tbl[32 + lane] = ub * 256; tbl[64 + 33 + lane] = ub; }
        if (lane == 31) { tbl[32 + 32] = inc * 256; tbl[64 + 33 + 32] = inc; }
        const int rem = c & 255, thin = (rem > 0 && rem <= 128) ? 1 : 0, nfull = nru - thin;
        int fi = nfull, ti = thin;
#pragma unroll
        for (int o = 1; o < 32; o <<= 1) { const int a = __shfl_up(fi, o), b = __shfl_up(ti, o); if (lane >= o) { fi += a; ti += b; } }
        if (lane < 32) { tbl[200 + lane] = fi - nfull; tbl[240 + lane] = ti - thin; }
        if (lane == 31) { tbl[200 + 32] = fi; tbl[240 + 32] = ti; }
    }
    __syncthreads();
}
struct EpiSwiGLU {
    static constexpr bool PERM = true;
    bf16* H; const int* tbl;
    DM void operator()(const f32x4 (&acc)[2][2][4][2], const pg8::Unit& u, int wr, int wc, int fr, int fq) const {
        const size_t grow0 = (size_t)tbl[32 + u.e] + (size_t)u.pm * 256 + wr * 64 + fr; const int hid0 = (u.pn * 256 + wc * 32 + 8 * fq) >> 1;
#pragma unroll
        for (int ai = 0; ai < 2; ++ai)
#pragma unroll
            for (int m = 0; m < 4; ++m) {
                bf16* rowp = H + (grow0 + ai * 128 + m * 16) * 256 + hid0;
#pragma unroll
                for (int bj = 0; bj < 2; ++bj) {
                    const f32x4 gt = acc[ai][bj][m][0], up = acc[ai][bj][m][1];
                    *(u32x2*)(rowp + bj * 64) = (u32x2){pk2(siluf_(gt[0]) * up[0], siluf_(gt[1]) * up[1]), pk2(siluf_(gt[2]) * up[2], siluf_(gt[3]) * up[3])};
                }
            }
    }
};
struct EpiScatter {
    static constexpr bool PERM = true;
    bf16* Y; const int* tbl; const int* lists; const float* RW;
    DM void operator()(const f32x4 (&acc)[2][2][4][2], const pg8::Unit& u, int wr_, int wc_, int fr_, int fq_) const {
        const int t_ = fresh_tid(), wr = (t_ >> 6) >> 2, wc = (t_ >> 6) & 3, fr = t_ & 15, fq = (t_ & 63) >> 4; (void)wr_; (void)wc_; (void)fr_; (void)fq_;
        const int loc0 = u.pm * 256 + wr * 64 + fr, col0 = u.pn * 256 + wc * 32 + 8 * fq, cnt = tbl[u.e];
        int ent[2][4]; float w[2][4];
#pragma unroll
        for (int ai = 0; ai < 2; ++ai)
#pragma unroll
            for (int m = 0; m < 4; ++m) { const int loc = loc0 + ai * 128 + m * 16; ent[ai][m] = lists[(size_t)u.e * SEQ + (loc < cnt ? loc : cnt - 1)]; }
#pragma unroll
        for (int ai = 0; ai < 2; ++ai)
#pragma unroll
            for (int m = 0; m < 4; ++m) w[ai][m] = RW[ent[ai][m]];
#pragma unroll
        for (int ai = 0; ai < 2; ++ai)
#pragma unroll
            for (int m = 0; m < 4; ++m) {
                const int loc = loc0 + ai * 128 + m * 16;
                if (loc < cnt) {
                    bf16* rowp = Y + (size_t)ent[ai][m] * D + col0; const float ww = w[ai][m];
#pragma unroll
                    for (int bj = 0; bj < 2; ++bj) {
                        const f32x4 v0 = acc[ai][bj][m][0] * ww, v1 = acc[ai][bj][m][1] * ww;
                        *(u32x4*)(rowp + bj * 128) = (u32x4){pk2(v0[0], v0[1]), pk2(v0[2], v0[3]), pk2(v1[0], v1[1]), pk2(v1[2], v1[3])};
                    }
                }
            }
    }
};
DI void phase6a(const Params& p, char* smem, int bid, int nblk) {
    moe_table(p, smem);
    const int* tbl = (const int*)(smem + P6_TBL); const int* lists = (const int*)(p.ws + OFF_SMALL + SM_TAILS);
    pg8::Gemm g{(const bf16*)(p.ws + OFF_OD), (const bf16*)(p.ws + OFF_EXG), 0, 512, 1024};
    MoeSched<2> S{tbl, lists, nblk, bid, (size_t)512 * 1024 * 2};
    EpiSwiGLU E{(bf16*)(p.ws + OFF_H), tbl};
    const int nru = tbl[64 + 33 + 32];
    pg8::gemm_phase(smem, g, S, E);
    {
        const int tid = fresh_tid(), lane = tid & 63, wave = tid >> 6;
        int X = 2 * nru - nblk; if (X < 0 || X >= nblk) X = 0;
        if (bid >= X) {
            char* wl = smem + wave * 16384;
            for (int it = (bid - X) * 8 + wave; it < 32 * 128; it += (nblk - X) * 8) {
                const int e = it >> 7, q = it & 127;
                transpose_item(p.in[23] + (size_t)e * 256 * 1024, 1024, 256, (bf16*)(p.ws + OFF_EXD) + (size_t)e * 1024 * 256, (q >> 5) * 64, (q & 31) * 32, (q & 31) * 32, (float*)wl, lane);
            }
        }
    }
}
DI void phase6b(const Params& p, char* smem, int bid, int nblk) {
    moe_table(p, smem);
    const int* tbl = (const int*)(smem + P6_TBL); const int* lists = (const int*)(p.ws + OFF_SMALL + SM_TAILS);
    pg8::Gemm g{(const bf16*)(p.ws + OFF_H), (const bf16*)(p.ws + OFF_EXD), 0, 1024, 256};
    MoeSched<4> S{tbl, lists, nblk, bid, (size_t)1024 * 256 * 2};
    EpiScatter E{(bf16*)(p.ws + OFF_Y), tbl, lists, (const float*)(p.ws + OFF_SMALL + SM_RW)};
    pg8::gemm_phase(smem, g, S, E);
}

DI void phase7(const Params& p, char* smem, int bid, int nblk, int dry = 0) {
    const int tid = fresh_tid(), lane = tid & 63, wave = tid >> 6;
    const int gw = bid * 8 + wave, NGW = nblk * 8;
    for (int j = gw; j < SEQ; j += NGW) {
        float* hrow = p.out + (size_t)j * D;
        const bf16* y0 = (const bf16*)(p.ws + OFF_Y) + (size_t)j * 2 * D;
        float4 v[4]; float ss = 0.f;
#pragma unroll
        for (int q = 0; q < 4; ++q) {
            const int c = 4 * lane + 256 * q;
            v[q] = *(const float4*)(hrow + c);
            const u32x2 a = *(const u32x2*)(y0 + c), b = *(const u32x2*)(y0 + D + c);
            v[q].x += bflo(a.x) + bflo(b.x); v[q].y += bfhi(a.x) + bfhi(b.x); v[q].z += bflo(a.y) + bflo(b.y); v[q].w += bfhi(a.y) + bfhi(b.y);
            ss += v[q].x * v[q].x + v[q].y * v[q].y + v[q].z * v[q].z + v[q].w * v[q].w;
        }
        ss = wave_sum(ss);
        const float rstd = rsqrtf(ss * (1.0f / D) + NORM_EPS);
#pragma unroll
        for (int q = 0; q < 4; ++q) {
            const int c = 4 * lane + 256 * q; const float4 w4 = *(const float4*)(p.in[24] + c);
            if (!dry) *(float4*)(hrow + c) = make_float4(v[q].x * rstd * w4.x, v[q].y * rstd * w4.y, v[q].z * rstd * w4.z, v[q].w * rstd * w4.w);
        }
    }
}

#ifdef EMU
__global__ void __launch_bounds__(NT) k_phase0(Params p) { SMEM_DECL; phase0(p, smem, blockIdx.x, gridDim.x); }
__global__ void __launch_bounds__(NT) k_phase1(Params p) { SMEM_DECL; phase1(p, smem, blockIdx.x, gridDim.x); }
__global__ void __launch_bounds__(NT) k_phase2(Params p) { SMEM_DECL; phase2(p, smem, blockIdx.x, gridDim.x, 0); }
__global__ void __launch_bounds__(NT) k_phase3(Params p) { SMEM_DECL; phase3(p, smem, blockIdx.x, gridDim.x); }
__global__ void __launch_bounds__(NT) k_phase4(Params p) { SMEM_DECL; phase4(p, smem, blockIdx.x, gridDim.x); }
__global__ void __launch_bounds__(NT) k_phase5a(Params p) { SMEM_DECL; phase5a(p, smem, blockIdx.x, gridDim.x); }
__global__ void __launch_bounds__(NT) k_phase5b(Params p) { SMEM_DECL; phase5b(p, smem, blockIdx.x, gridDim.x); }
__global__ void __launch_bounds__(NT) k_phase5c(Params p) { SMEM_DECL; phase5c(p, smem, blockIdx.x, gridDim.x); }
__global__ void __launch_bounds__(NT) k_phase5d(Params p) { SMEM_DECL; phase5d(p, smem, blockIdx.x, gridDim.x); }
__global__ void __launch_bounds__(NT) k_phase6a(Params p) { SMEM_DECL; phase6a(p, smem, blockIdx.x, gridDim.x); }
__global__ void __launch_bounds__(NT) k_phase6b(Params p) { SMEM_DECL; phase6b(p, smem, blockIdx.x, gridDim.x); }
__global__ void __launch_bounds__(NT) k_phase7(Params p) { SMEM_DECL; phase7(p, smem, blockIdx.x, gridDim.x); }

#endif

constexpr int LDS_BYTES = 160 * 1024 - 256;
constexpr int LDS_BARST = LDS_BYTES - 16;

#ifndef EMU
#define LAS __attribute__((address_space(3)))
#define XB_TMO      128
#define XB_XCNT(j)  (256  + 64 * (j))
#define XB_XSUB(j)  (1280 + 64 * (j))
#define XB_XGEN(j)  (2304 + 64 * (j))
#define XB_TOP      3328
#define XB_TOPGEN   3392
#define XCD_BAR_WORDS 3456
#define XB_SPIN_CAP (1u << 22)
__device__ __forceinline__ unsigned xb_ld(unsigned* p)              { return __hip_atomic_load(p, __ATOMIC_RELAXED, __HIP_MEMORY_SCOPE_AGENT); }
__device__ __forceinline__ unsigned xb_add(unsigned* p, unsigned v) { return __hip_atomic_fetch_add(p, v, __ATOMIC_RELAXED, __HIP_MEMORY_SCOPE_AGENT); }
__device__ __forceinline__ unsigned xb_xcc_id() { return (unsigned)__builtin_amdgcn_s_getreg((3 << 11) | 20) & 0xFu; }
#define XB_SPIN(cond, bar) do { unsigned _sp = 0; while (cond) { __builtin_amdgcn_s_sleep(1); \
    if ((++_sp & 255u) == 0u) { if (xb_ld(&(bar)[XB_TMO])) break; if (_sp > XB_SPIN_CAP) { atomicAdd(&(bar)[XB_TMO], 1u); break; } } } } while (0)
struct XcdBarrier { unsigned* bar; unsigned x; volatile LAS unsigned* st; };
__device__ __forceinline__ XcdBarrier xcd_barrier_post(unsigned* bar, volatile LAS unsigned* st) {
    XcdBarrier b; b.bar = bar; b.x = xb_xcc_id(); b.st = st;
    if (threadIdx.x == 0) (void)xb_add(&bar[XB_XCNT(b.x)], 1u);
    return b;
}
__device__ __forceinline__ void xcd_barrier_complete(unsigned* bar, unsigned x, unsigned& nloc, unsigned& nx) {
    const unsigned G = gridDim.x * gridDim.y * gridDim.z;
    unsigned sum, cnt, mine, sp = 0u;
    for (;;) {
        sum = 0u; cnt = 0u; mine = 0u;
#pragma unroll
        for (unsigned j = 0; j < 16; ++j) { const unsigned c = xb_ld(&bar[XB_XCNT(j)]); sum += c; cnt += (c > 0u) ? 1u : 0u; mine = (j == x) ? c : mine; }
        if (sum == G) break;
        __builtin_amdgcn_s_sleep(1);
        if ((++sp & 255u) == 0u) { if (xb_ld(&bar[XB_TMO])) break; if (sp > XB_SPIN_CAP) { atomicAdd(&bar[XB_TMO], 1u); break; } }
    }
    nloc = mine > 0u ? mine : 1u; nx = cnt > 0u ? cnt : 1u;
}
__device__ __forceinline__ void xcd_barrier(const XcdBarrier& b) {
    asm volatile("s_waitcnt vmcnt(0)" ::: "memory");
    __syncthreads();
    if (threadIdx.x == 0) {
        unsigned* bar = b.bar;
        __builtin_amdgcn_s_waitcnt(0);
        unsigned nloc = b.st[0], nx = b.st[1];
        if (nloc == 0u) { xcd_barrier_complete(bar, b.x, nloc, nx); b.st[0] = nloc; b.st[1] = nx; }
        const unsigned old = xb_add(&bar[XB_XSUB(b.x)], 1u);
        const unsigned gen = old / nloc;
        if (old + 1u == (gen + 1u) * nloc) {
            __builtin_amdgcn_fence(__ATOMIC_RELEASE, "agent");
            asm volatile("s_waitcnt vmcnt(0)" ::: "memory");
            const unsigned og = xb_add(&bar[XB_TOP], 1u);
            const unsigned tg = og / nx;
            if (og + 1u == (tg + 1u) * nx) xb_add(&bar[XB_TOPGEN], 1u);
            else XB_SPIN(xb_ld(&bar[XB_TOPGEN]) == tg, bar);
            __builtin_amdgcn_fence(__ATOMIC_ACQUIRE, "agent");
            xb_add(&bar[XB_XGEN(b.x)], 1u);
            asm volatile("s_waitcnt vmcnt(0)" ::: "memory");
        } else {
            XB_SPIN(xb_ld(&bar[XB_XGEN(b.x)]) == gen, bar);
            __builtin_amdgcn_fence(__ATOMIC_ACQUIRE, "agent");
            asm volatile("s_waitcnt vmcnt(0)" ::: "memory");
        }
    }
    __syncthreads();
}
#endif

#ifdef EMU
#define GRID_SYNC() emu_grid_sync()
#define GRID_SYNC_CG() emu_grid_sync()
#else
#define GRID_SYNC_CG() do { \
    asm volatile("s_waitcnt vmcnt(0)" ::: "memory"); \
    __syncthreads(); \
    cooperative_groups::this_grid().sync(); \
    if (threadIdx.x == 0) { __builtin_amdgcn_fence(__ATOMIC_ACQUIRE, "agent"); asm volatile("s_waitcnt vmcnt(0)" ::: "memory"); } \
    __syncthreads(); \
} while (0)
#define GRID_SYNC() xcd_barrier(xbar)
#endif
__global__ void __launch_bounds__(NT) fwd_megakernel(Params p) {
    SMEM_DECL;
    const int bid = blockIdx.x, nblk = gridDim.x;
#ifndef EMU
    if (threadIdx.x < 4) ((volatile LAS unsigned*)(smem + LDS_BARST))[threadIdx.x] = 0u;
    __syncthreads();
    const XcdBarrier xbar = xcd_barrier_post((unsigned*)(p.ws + OFF_SMALL + SM_CTL) + CW_BAR, (volatile LAS unsigned*)(smem + LDS_BARST));
#endif
#if defined(DRY_PHASE) && !defined(EMU)
    int dryflag = 1; asm volatile("" : "+s"(dryflag));
#define EXTRA(k, call) do { if (DRY_PHASE == (k)) { call; GRID_SYNC(); } } while (0)
#else
#define EXTRA(k, call) do {} while (0)
    const int dryflag = 0; (void)dryflag;
#endif
    EXTRA(0, phase0(p, smem, bid, nblk));
    phase0(p, smem, bid, nblk); GRID_SYNC();
    EXTRA(1, phase1(p, smem, bid, nblk));
    phase1(p, smem, bid, nblk); GRID_SYNC();
    EXTRA(2, phase2(p, smem, bid, nblk, dryflag));
    phase2(p, smem, bid, nblk); GRID_SYNC();
    EXTRA(3, phase3(p, smem, bid, nblk, dryflag));
    EXTRA(8, phase3(p, smem, bid, nblk, dryflag, 1));
    EXTRA(9, phase3(p, smem, bid, nblk, dryflag, 2));
    phase3(p, smem, bid, nblk); GRID_SYNC();
    EXTRA(4, phase4(p, smem, bid, nblk));
    phase4(p, smem, bid, nblk); GRID_SYNC();
    EXTRA(5, phase5a(p, smem, bid, nblk));
    phase5a(p, smem, bid, nblk); GRID_SYNC();
    EXTRA(10, phase5b(p, smem, bid, nblk));
    phase5b(p, smem, bid, nblk); GRID_SYNC();
    EXTRA(11, phase5c(p, smem, bid, nblk));
    phase5c(p, smem, bid, nblk); GRID_SYNC();
    EXTRA(12, phase5d(p, smem, bid, nblk, dryflag));
    phase5d(p, smem, bid, nblk); GRID_SYNC();
    EXTRA(6, phase6a(p, smem, bid, nblk));
    phase6a(p, smem, bid, nblk); GRID_SYNC();
    EXTRA(13, phase6b(p, smem, bid, nblk));
    phase6b(p, smem, bid, nblk); GRID_SYNC();
    EXTRA(7, phase7(p, smem, bid, nblk, dryflag));
    phase7(p, smem, bid, nblk);
}

#ifndef EMU
extern "C" void kernel_launch(void* const* d_in, const int* in_sizes, int n_in, void* d_out, int out_size, void* d_ws, size_t ws_size, hipStream_t stream) {
    static int grid = 0;
    if (grid == 0) {
        if (n_in != 25 || ws_size < WS_END || out_size != SEQ * D) { fprintf(stderr, "kernel_launch: unexpected problem (n_in %d, ws %zu, out %d)\n", n_in, ws_size, out_size); grid = -1; return; }
        int dev = 0, cus = 0, per_cu = 0;
        (void)hipGetDevice(&dev);
        (void)hipDeviceGetAttribute(&cus, hipDeviceAttributeMultiprocessorCount, dev);
        (void)hipFuncSetAttribute((const void*)fwd_megakernel, hipFuncAttributeMaxDynamicSharedMemorySize, LDS_BYTES);
        (void)hipOccupancyMaxActiveBlocksPerMultiprocessor(&per_cu, (const void*)fwd_megakernel, NT, LDS_BYTES);
        if (per_cu < 1) { fprintf(stderr, "kernel_launch: occupancy query returned %d\n", per_cu); per_cu = 1; }
        grid = cus * per_cu;
    }
    if (grid < 0) return;
    Params p{};
    for (int i = 0; i < 25; ++i) p.in[i] = (const float*)d_in[i];
    p.out = (float*)d_out; p.ws = (unsigned char*)d_ws;
    (void)hipMemsetAsync((unsigned char*)d_ws + OFF_SMALL + SM_CTL + (size_t)CW_BAR * 4, 0, (size_t)XCD_BAR_WORDS * 4, stream);
    void* args[] = {&p};
    hipError_t e = hipLaunchCooperativeKernel((const void*)fwd_megakernel, dim3(grid), dim3(NT), args, LDS_BYTES, stream);
    if (e != hipSuccess) fprintf(stderr, "cooperative launch failed: %s (grid %d)\n", hipGetErrorString(e), grid);
}
#endif

#ifdef EMU
static void run_phases(Params p, int upto, int grid) {
    if (upto == 100) { emu::launch([=] { fwd_megakernel(p); }, grid, NT, LDS_BYTES, true); return; }
    if (upto >= 0) emu::launch([=] { k_phase0(p); }, grid, NT, LDS_BYTES, false);
    if (upto >= 1) emu::launch([=] { k_phase1(p); }, grid, NT, LDS_BYTES, false);
    if (upto >= 2) emu::launch([=] { k_phase2(p); }, grid, NT, LDS_BYTES, false);
    if (upto >= 3) emu::launch([=] { k_phase3(p); }, grid, NT, LDS_BYTES, false);
    if (upto >= 4) emu::launch([=] { k_phase4(p); }, grid, NT, LDS_BYTES, false);
    if (upto >= 5) { emu::launch([=] { k_phase5a(p); }, grid, NT, LDS_BYTES, false); emu::launch([=] { k_phase5b(p); }, grid, NT, LDS_BYTES, false); emu::launch([=] { k_phase5c(p); }, grid, NT, LDS_BYTES, false); emu::launch([=] { k_phase5d(p); }, grid, NT, LDS_BYTES, false); }
    if (upto >= 6) { emu::launch([=] { k_phase6a(p); }, grid, NT, LDS_BYTES, false); emu::launch([=] { k_phase6b(p); }, grid, NT, LDS_BYTES, false); }
    if (upto >= 7) emu::launch([=] { k_phase7(p); }, grid, NT, LDS_BYTES, false);
}
#endif
```
